# Optimizing an MI355X kernel written in HIP

```python
import jax, jax.numpy as jnp
from jax import lax
import numpy as np

D_MODEL = 2048
BATCH = 2
SEQ = 8192
DEPTH = 1

D_MIX = D_MODEL
LRU_WIDTH = D_MIX // 2
CONF_WIDTH = D_MIX - LRU_WIDTH
LRU_HEADS = 8
LRU_HEAD_DIM = LRU_WIDTH // LRU_HEADS
LRU_CONV_WIDTH = 4
LRU_C = 8.0
CONF_GROUPS = 8
CONF_KERNEL = 31
IN_COLS = 2 * LRU_WIDTH + 2 * CONF_WIDTH
PEER_HEADS = 8
PEER_N_KEYS = 128
PEER_N_EXPERTS = PEER_N_KEYS * PEER_N_KEYS
PEER_TOPK = 16
PEER_QUERY_DIM = 256
PEER_HALF = PEER_QUERY_DIM // 2
PEER_BLOCK = 128
N_MOD = 6
EPS = 1e-6

kernel_name = "hymba_rglru_conformer_peer_block"


def rms_norm(x, g):
    xf = x.astype(jnp.float32)
    y = xf * lax.rsqrt(jnp.mean(xf * xf, axis=-1, keepdims=True) + EPS)
    return (y * g.astype(jnp.float32)).astype(x.dtype)


def layer_norm(x, g, b):
    xf = x.astype(jnp.float32)
    mu = jnp.mean(xf, axis=-1, keepdims=True)
    var = jnp.mean(jnp.square(xf - mu), axis=-1, keepdims=True)
    y = (xf - mu) * lax.rsqrt(var + EPS)
    return (y * g.astype(jnp.float32) + b.astype(jnp.float32)).astype(x.dtype)


def modulate(h, shift, scale):
    return h * (1.0 + scale[:, None, :]) + shift[:, None, :]


def causal_depthwise_conv(x, w, b):
    k = w.shape[0]
    y = lax.conv_general_dilated(
        x, w[:, None, :].astype(x.dtype), window_strides=(1,), padding=[(k - 1, 0)],
        dimension_numbers=('NWC', 'WIO', 'NWC'), feature_group_count=x.shape[-1])
    return y + b


def _linear_recurrence_combine(e1, e2):
    a1, b1 = e1
    a2, b2 = e2
    return a1 * a2, a2 * b1 + b2


def rg_lru(x, wa, ba, wx, bx, lam):
    bsz, seq, width = x.shape
    xh = x.reshape(bsz, seq, LRU_HEADS, LRU_HEAD_DIM)
    r = jax.nn.sigmoid(jnp.einsum('bshi,hij->bshj', xh, wa).reshape(bsz, seq, width) + ba)
    i = jax.nn.sigmoid(jnp.einsum('bshi,hij->bshj', xh, wx).reshape(bsz, seq, width) + bx)
    log_a = -LRU_C * jax.nn.softplus(-lam.astype(jnp.float32)) * r.astype(jnp.float32)
    a = jnp.exp(log_a)
    mult = jnp.sqrt(-jnp.expm1(2.0 * log_a))
    u = mult * (i * x).astype(jnp.float32)
    _, h = lax.associative_scan(_linear_recurrence_combine, (a, u), axis=1)
    return h.astype(x.dtype)


def hybrid_mixer(h, w_in, lru_conv_w, lru_conv_b, lru_wa, lru_ba, lru_wx, lru_bx, lru_lambda,
                 conf_dw_w, conf_dw_b, conf_ln_g, conf_ln_b, w_out):
    proj = h @ w_in
    lru_x, lru_g, conf_v, conf_g = jnp.split(
        proj, [LRU_WIDTH, 2 * LRU_WIDTH, 2 * LRU_WIDTH + CONF_WIDTH], axis=-1)
    xl = causal_depthwise_conv(lru_x, lru_conv_w, lru_conv_b)
    y_lru = rg_lru(xl, lru_wa, lru_ba, lru_wx, lru_bx, lru_lambda) * jax.nn.gelu(lru_g)
    z = conf_v * jax.nn.sigmoid(conf_g)
    z = causal_depthwise_conv(z, conf_dw_w, conf_dw_b)
    z = jax.nn.silu(layer_norm(z, conf_ln_g, conf_ln_b))
    return jnp.concatenate([y_lru, z], axis=-1) @ w_out


def peer_ffn(h, wq, subkeys, u_table, v_table):
    bsz, seq, d = h.shape
    t = bsz * seq
    hf = h.reshape(t, d)
    q = (hf @ wq).reshape(t, PEER_HEADS, 2, PEER_HALF)
    scores = jnp.einsum('thpd,hpnd->thpn', q.astype(jnp.float32), subkeys.astype(jnp.float32))
    s1, i1 = lax.top_k(scores[:, :, 0], PEER_TOPK)
    s2, i2 = lax.top_k(scores[:, :, 1], PEER_TOPK)
    cand = (s1[..., :, None] + s2[..., None, :]).reshape(t, PEER_HEADS, PEER_TOPK * PEER_TOPK)
    cs, ci = lax.top_k(cand, PEER_TOPK)
    row = jnp.take_along_axis(i1, ci // PEER_TOPK, axis=-1)
    col = jnp.take_along_axis(i2, ci % PEER_TOPK, axis=-1)
    expert_idx = row * PEER_N_KEYS + col
    gates = jax.nn.softmax(cs, axis=-1).astype(h.dtype)
    n_blk = t // PEER_BLOCK

    def expert_block(args):
        hb, ib, gb = args
        u = jnp.take(u_table, ib, axis=0)
        act = jnp.einsum('cd,chkd->chk', hb, u)
        w = gb * jax.nn.gelu(act)
        v = jnp.take(v_table, ib, axis=0)
        return jnp.einsum('chk,chkd->cd', w, v)

    out = lax.map(expert_block, (hf.reshape(n_blk, PEER_BLOCK, d),
                                 expert_idx.reshape(n_blk, PEER_BLOCK, PEER_HEADS, PEER_TOPK),
                                 gates.reshape(n_blk, PEER_BLOCK, PEER_HEADS, PEER_TOPK)))
    return out.reshape(bsz, seq, d)


def setup_inputs(seed: int = 0) -> dict:
    key = jax.random.key(seed)
    ks = jax.random.split(key, 26)
    f32 = jnp.float32
    nrm = lambda k, shape, s: jax.random.normal(k, shape, f32) * s
    gain = lambda k, n: 1.0 + 0.02 * jax.random.normal(k, (DEPTH, n), f32)
    u_a = jax.random.uniform(ks[14], (DEPTH, LRU_WIDTH), f32, 0.9, 0.999)
    s_l = u_a ** (1.0 / LRU_C)
    lru_lambda = jnp.log(s_l) - jnp.log1p(-s_l)
    return {
        "x": jax.random.normal(ks[0], (BATCH, SEQ, D_MODEL), f32),
        "c": jax.random.normal(ks[1], (BATCH, D_MODEL), f32),
        "w_mod": nrm(ks[2], (DEPTH, D_MODEL, N_MOD * D_MODEL), 0.2 * D_MODEL ** -0.5),
        "b_mod": nrm(ks[3], (DEPTH, N_MOD * D_MODEL), 0.02),
        "g_pre_mix": gain(ks[4], D_MODEL),
        "g_post_mix": gain(ks[5], D_MODEL),
        "g_pre_ffn": gain(ks[6], D_MODEL),
        "g_post_ffn": gain(ks[7], D_MODEL),
        "w_in": nrm(ks[8], (DEPTH, D_MODEL, IN_COLS), D_MODEL ** -0.5),
        "lru_conv_w": nrm(ks[9], (DEPTH, LRU_CONV_WIDTH, LRU_WIDTH), LRU_CONV_WIDTH ** -0.5),
        "lru_conv_b": nrm(ks[10], (DEPTH, LRU_WIDTH), 0.02),
        "lru_wa": nrm(ks[11], (DEPTH, LRU_HEADS, LRU_HEAD_DIM, LRU_HEAD_DIM), LRU_HEAD_DIM ** -0.5),
        "lru_ba": nrm(ks[12], (DEPTH, LRU_WIDTH), 0.02),
        "lru_wx": nrm(ks[13], (DEPTH, LRU_HEADS, LRU_HEAD_DIM, LRU_HEAD_DIM), LRU_HEAD_DIM ** -0.5),
        "lru_bx": nrm(ks[15], (DEPTH, LRU_WIDTH), 0.02),
        "lru_lambda": lru_lambda,
        "conf_dw_w": nrm(ks[16], (DEPTH, CONF_KERNEL, CONF_WIDTH), CONF_KERNEL ** -0.5),
        "conf_dw_b": nrm(ks[17], (DEPTH, CONF_WIDTH), 0.02),
        "conf_ln_g": gain(ks[18], CONF_WIDTH),
        "conf_ln_b": nrm(ks[19], (DEPTH, CONF_WIDTH), 0.02),
        "w_out": nrm(ks[20], (DEPTH, D_MIX, D_MODEL), D_MIX ** -0.5),
        "peer_wq": nrm(ks[21], (DEPTH, D_MODEL, PEER_HEADS * PEER_QUERY_DIM), D_MODEL ** -0.5),
        "peer_subkeys": nrm(ks[22], (DEPTH, PEER_HEADS, 2, PEER_N_KEYS, PEER_HALF), PEER_HALF ** -0.5),
        "peer_u": nrm(ks[23], (DEPTH, PEER_N_EXPERTS, D_MODEL), D_MODEL ** -0.5),
        "peer_v": nrm(ks[24], (DEPTH, PEER_N_EXPERTS, D_MODEL), PEER_HEADS ** -0.5),
    }


def reference(x, c, w_mod, b_mod, g_pre_mix, g_post_mix, g_pre_ffn, g_post_ffn, w_in,
              lru_conv_w, lru_conv_b, lru_wa, lru_ba, lru_wx, lru_bx, lru_lambda,
              conf_dw_w, conf_dw_b, conf_ln_g, conf_ln_b, w_out,
              peer_wq, peer_subkeys, peer_u, peer_v):
    c_act = jax.nn.silu(c)
    for l in range(DEPTH):
        mod = c_act @ w_mod[l] + b_mod[l]
        sh1, sc1, gt1, sh2, sc2, gt2 = jnp.split(mod, N_MOD, axis=-1)
        h = modulate(rms_norm(x, g_pre_mix[l]), sh1, sc1)
        y = hybrid_mixer(h, w_in[l], lru_conv_w[l], lru_conv_b[l], lru_wa[l], lru_ba[l],
                         lru_wx[l], lru_bx[l], lru_lambda[l], conf_dw_w[l], conf_dw_b[l],
                         conf_ln_g[l], conf_ln_b[l], w_out[l])
        x = x + gt1[:, None, :] * rms_norm(y, g_post_mix[l])
        h = modulate(rms_norm(x, g_pre_ffn[l]), sh2, sc2)
        y = peer_ffn(h, peer_wq[l], peer_subkeys[l], peer_u[l], peer_v[l])
        x = x + gt2[:, None, :] * rms_norm(y, g_post_ffn[l])
    return x
```

```cpp
#include <hip/hip_runtime.h>
#include <cstdio>
#include <cstdint>
#include <cmath>
namespace pg8 {
#define PG8_LAS __attribute__((address_space(3)))
typedef unsigned short bf16_t;
typedef short bf16x8 __attribute__((ext_vector_type(8)));
typedef float f32x4 __attribute__((ext_vector_type(4)));
typedef unsigned u32x4 __attribute__((ext_vector_type(4)));
constexpr int BM = 256, BK = 64, HALF = 128, HTB = HALF * BK * 2  , STAGE_BYTES = 8 * HTB, NXCD = 8, WGM = 8;

__host__ __device__ __forceinline__ int lds_byte(int r, int c) { const int st = (r >> 4) * 2 + (c >> 5), rr = r & 15, cc = c & 31, ob = rr * 64 + cc * 2; return st * 1024 + (ob ^ (((ob >> 9) & 1) << 5)); }
__host__ __device__ __forceinline__ void stage_rc(int b, int& R, int& C) { const int st = b / 1024, sb = b % 1024, swz = sb ^ (((sb >> 9) & 1) << 5); R = (st >> 1) * 16 + swz / 64; C = (st & 1) * 32 + (swz % 64) / 2; }
__host__ __device__ __forceinline__ int perm32(int rho) { const int n = rho >> 4, i = rho & 15; return 8 * (i >> 2) + 4 * n + (i & 3); }

struct Unit { int pm, pn; };
struct Gemm { const bf16_t* A; const bf16_t* Bt; int M, N, K; };

struct StaticOrder {
    int nM, nN, nwg, G, c;
    __host__ __device__ void init(int M, int N, int G_, int c_) { nM = M / BM; nN = N / BM; nwg = nM * nN; G = G_; c = c_; }
    __host__ __device__ bool next(int i, Unit& u) const {
        const long L = (long)i * G + c; if (L >= nwg) return false;
        int wgid = (int)L; { const int q = nwg / NXCD, r = nwg % NXCD, xcd = wgid % NXCD, off = wgid / NXCD; wgid = (xcd < r ? xcd * (q + 1) : r * (q + 1) + (xcd - r) * q) + off; }
        const int nig = WGM * nN, gid = wgid / nig, fm = gid * WGM, gsz = (nM - fm) < WGM ? (nM - fm) : WGM;
        u.pm = fm + ((wgid % nig) % gsz); u.pn = (wgid % nig) / gsz; return true;
    }
    __device__ __forceinline__ void a_ready(const Unit&) const {}
    __device__ __forceinline__ void done(const Unit&) const {}
};

__device__ __forceinline__ unsigned cvt_pk_bf16(float lo, float hi) { unsigned r; asm volatile("v_cvt_pk_bf16_f32 %0, %1, %2" : "=v"(r) : "v"(lo), "v"(hi)); return r; }
typedef float f32x2 __attribute__((ext_vector_type(2)));
__device__ __forceinline__ f32x2 gelu_pk(f32x2 v) {
    const f32x2 av = __builtin_elementwise_abs(v), d = av * 0.2316418882f + 1.0f;
    f32x2 t; t.x = __builtin_amdgcn_rcpf(d.x); t.y = __builtin_amdgcn_rcpf(d.y);
    f32x2 q = t * 0.5307027145f + (-0.7265760135f); q = q * t + 0.7107068705f; q = q * t + (-0.142248368f); q = q * t + 0.127414796f; q = q * t;
    const f32x2 s = (v * v) * (-0.72134752044f);
    f32x2 e; e.x = __builtin_amdgcn_exp2f(s.x); e.y = __builtin_amdgcn_exp2f(s.y);
    const f32x2 m = v * (q * e), r = v - m;
    f32x2 o; o.x = v.x < 0.f ? m.x : r.x; o.y = v.y < 0.f ? m.y : r.y; return o;
}

template <int ACT  > struct EpiBf16 {
    static constexpr bool PERM = true, AFTER_DRAIN = false; static_assert(ACT == 0 || ACT == 1, "EpiBf16: ACT is 0 (none) or 1 (gelu_pk)");
    bf16_t* O; int ldc; const float* bias; int split_cols; size_t split_stride; float scale0;
    __device__ __forceinline__ void operator()(const f32x4 (&acc)[2][2][4][2], const Unit& u, int wr, int wc, int fr, int fq) const {
        const int row0 = u.pm * BM + wr * 64 + fr; int colt = u.pn * BM; bf16_t* base = O;
        float sc = 1.f; if (split_cols) { const int t = colt / split_cols; base += (size_t)t * split_stride; colt -= t * split_cols; if (t == 0) sc = scale0; }
        const int col0 = colt + wc * 32 + 8 * fq, bcol0 = u.pn * BM + wc * 32 + 8 * fq;
        f32x4 bv[2][2];
#pragma unroll
        for (int bj = 0; bj < 2; ++bj)
#pragma unroll
            for (int n = 0; n < 2; ++n) bv[bj][n] = bias ? *(const f32x4*)(bias + bcol0 + bj * HALF + 4 * n) : (f32x4){0.f, 0.f, 0.f, 0.f};
#pragma unroll
        for (int ai = 0; ai < 2; ++ai)
#pragma unroll
            for (int m = 0; m < 4; ++m) { bf16_t* rowp = base + (size_t)(row0 + ai * HALF + m * 16) * ldc + col0;
#pragma unroll
                for (int bj = 0; bj < 2; ++bj) { f32x4 v0 = acc[ai][bj][m][0] + bv[bj][0], v1 = acc[ai][bj][m][1] + bv[bj][1];
                    if (ACT == 1) { f32x2 a = gelu_pk((f32x2){v0[0], v0[1]}), b = gelu_pk((f32x2){v0[2], v0[3]}), c = gelu_pk((f32x2){v1[0], v1[1]}), d = gelu_pk((f32x2){v1[2], v1[3]});
                        v0 = (f32x4){a.x, a.y, b.x, b.y}; v1 = (f32x4){c.x, c.y, d.x, d.y}; }
                    v0 = v0 * sc; v1 = v1 * sc; u32x4 w; w.x = cvt_pk_bf16(v0[0], v0[1]); w.y = cvt_pk_bf16(v0[2], v0[3]); w.z = cvt_pk_bf16(v1[0], v1[1]); w.w = cvt_pk_bf16(v1[2], v1[3]);
                    *(u32x4*)(rowp + bj * HALF) = w; } }
    }
};
template <class Epi, class Sched, bool ALIGN_EPI = false, bool SP2 = false>
__device__ __forceinline__ void gemm_phase(PG8_LAS unsigned char* lds, const Gemm g, const Sched& S, const Epi& E) {
    const int tid = threadIdx.x, wid = __builtin_amdgcn_readfirstlane(tid >> 6), lane = tid & 63, wr = wid >> 2, wc = wid & 3, fr = lane & 15, fq = lane >> 4;
    const int K = g.K, nt = K / BK;
    unsigned voffA[2], voffB[2];
#pragma unroll
    for (int i = 0; i < 2; ++i) { int R, C; stage_rc(tid * 16 + i * 8192, R, C); const int Rb = Epi::PERM ? ((R & ~31) + perm32(R & 31)) : R;
        voffA[i] = (unsigned)(R * K + C) * 2u; voffB[i] = (unsigned)(Rb * K + C) * 2u; }
    const size_t kstep = (size_t)(BK * 2);
    const size_t hstep = (size_t)HALF * K * 2;
    const size_t tstep = 2 * hstep;
    const unsigned ldsw = (unsigned)wid * 1024u;
    const int aoff = lds_byte(wr * 64 + fr, fq * 8), boff = lds_byte(wc * 32 + fr, fq * 8);
#define PG8_SA(b, h) (((b) * 2 + (h)) * HTB)
#define PG8_SB(b, h) ((4 + (b) * 2 + (h)) * HTB)
#define PG8_STAGE(bufoff, gbase, voff) do { _Pragma("unroll") for (int _i = 0; _i < 2; ++_i) \
        __builtin_amdgcn_global_load_lds((const unsigned*)((const char*)(gbase) + (voff)[_i]), (PG8_LAS unsigned*)(lds + (bufoff) + ldsw + _i * 8192), 16, 0, 0); } while (0)
#define PG8_LDA(dst, b, h) do { _Pragma("unroll") for (int m = 0; m < 4; ++m) _Pragma("unroll") for (int k = 0; k < 2; ++k) dst[m][k] = *(const PG8_LAS bf16x8*)(lds + PG8_SA(b, h) + aoff + m * 2048 + k * 1024); } while (0)
#define PG8_LDB(dst, b, h) do { _Pragma("unroll") for (int n = 0; n < 2; ++n) _Pragma("unroll") for (int k = 0; k < 2; ++k) dst[n][k] = *(const PG8_LAS bf16x8*)(lds + PG8_SB(b, h) + boff + n * 2048 + k * 1024); } while (0)
#define PG8_MMA(ai, bj, At, Bt) do { __builtin_amdgcn_s_setprio(1); _Pragma("unroll") for (int m = 0; m < 4; ++m) _Pragma("unroll") for (int n = 0; n < 2; ++n) _Pragma("unroll") for (int k = 0; k < 2; ++k) \
        acc[ai][bj][m][n] = __builtin_amdgcn_mfma_f32_16x16x32_bf16(Bt[n][k], At[m][k], acc[ai][bj][m][n], 0, 0, 0); __builtin_amdgcn_s_setprio(0); } while (0)
#define PG8_WAIT_V(n) asm volatile("s_waitcnt vmcnt(" #n ")" ::: "memory")
#define PG8_WAIT_L(n) asm volatile("s_waitcnt lgkmcnt(" #n ")" ::: "memory")
#define PG8_BAR __builtin_amdgcn_s_barrier()
#define PG8_SCHED __builtin_amdgcn_sched_barrier(0)
    Unit cur, nxt; int ui = 0;
    if (!S.next(0, cur)) return;
    f32x4 acc[2][2][4][2];
#pragma unroll
    for (int a = 0; a < 2; ++a)
#pragma unroll
        for (int b = 0; b < 2; ++b)
#pragma unroll
            for (int m = 0; m < 4; ++m)
#pragma unroll
                for (int n = 0; n < 2; ++n) acc[a][b][m][n] = (f32x4){0.f, 0.f, 0.f, 0.f};
    bf16x8 At[4][2], B0[2][2], B1[2][2];
    const char* cA = (const char*)g.A + (size_t)cur.pm * tstep; const char* cB = (const char*)g.Bt + (size_t)cur.pn * tstep;
    S.a_ready(cur);
    if constexpr (SP2) {
        PG8_STAGE(PG8_SB(0, 0), cB, voffB); PG8_STAGE(PG8_SB(0, 1), cB + hstep, voffB); PG8_STAGE(PG8_SA(0, 0), cA, voffA); PG8_STAGE(PG8_SA(0, 1), cA + hstep, voffA);
        if (wr == 1) PG8_BAR;
        PG8_WAIT_V(2); PG8_BAR;
        PG8_STAGE(PG8_SB(1, 0), cB + kstep, voffB); PG8_STAGE(PG8_SA(1, 0), cA + kstep, voffA); PG8_STAGE(PG8_SB(1, 1), cB + hstep + kstep, voffB);
        PG8_WAIT_V(6); PG8_BAR;
    } else {
        PG8_STAGE(PG8_SB(0, 0), cB, voffB); PG8_STAGE(PG8_SA(0, 0), cA, voffA); PG8_STAGE(PG8_SB(0, 1), cB + hstep, voffB); PG8_STAGE(PG8_SA(0, 1), cA + hstep, voffA);
        if (wr == 1) PG8_BAR;
        PG8_WAIT_V(4); PG8_BAR;
        PG8_STAGE(PG8_SB(1, 0), cB + kstep, voffB); PG8_STAGE(PG8_SA(1, 0), cA + kstep, voffA); PG8_STAGE(PG8_SB(1, 1), cB + hstep + kstep, voffB);
        PG8_WAIT_V(6); PG8_BAR;
    }
    for (;;) {
        const bool has_next = S.next(ui + 1, nxt);
        const char* nA = has_next ? (const char*)g.A + (size_t)nxt.pm * tstep : cA; const char* nB = has_next ? (const char*)g.Bt + (size_t)nxt.pn * tstep : cB;
        for (int t = 0; t < nt; t += 2) {
            const bool last = (t == nt - 2);
            const char* a1 = cA + (size_t)(t + 1) * kstep;
            const char* a2 = last ? nA : cA + (size_t)(t + 2) * kstep; const char* b2 = last ? nB : cB + (size_t)(t + 2) * kstep;
            const char* a3 = a2 + kstep; const char* b3 = b2 + kstep;
            if (last && has_next) S.a_ready(nxt);
            if constexpr (SP2) {
            PG8_LDB(B0, 0, 0); PG8_LDB(B1, 0, 1); PG8_SCHED; PG8_LDA(At, 0, 0); PG8_STAGE(PG8_SA(1, 1), a1 + hstep, voffA);
            PG8_WAIT_V(8); PG8_WAIT_L(0); PG8_BAR; PG8_MMA(0, 0, At, B0); PG8_MMA(0, 1, At, B1); PG8_BAR; PG8_SCHED;
            PG8_LDA(At, 0, 1); PG8_STAGE(PG8_SB(0, 0), b2, voffB); PG8_STAGE(PG8_SB(0, 1), b2 + hstep, voffB); PG8_STAGE(PG8_SA(0, 0), a2, voffA);
            PG8_WAIT_V(8); PG8_WAIT_L(0); PG8_BAR; PG8_MMA(1, 0, At, B0); PG8_MMA(1, 1, At, B1); PG8_BAR; PG8_SCHED;
            PG8_LDB(B0, 1, 0); PG8_LDB(B1, 1, 1); PG8_SCHED; PG8_LDA(At, 1, 0); PG8_STAGE(PG8_SA(0, 1), a2 + hstep, voffA);
            PG8_WAIT_V(8); PG8_WAIT_L(0); PG8_BAR; PG8_MMA(0, 0, At, B0); PG8_MMA(0, 1, At, B1); PG8_BAR; PG8_SCHED;
            PG8_LDA(At, 1, 1); PG8_STAGE(PG8_SB(1, 0), b3, voffB); PG8_STAGE(PG8_SB(1, 1), b3 + hstep, voffB); PG8_STAGE(PG8_SA(1, 0), a3, voffA);
            PG8_WAIT_V(8); PG8_WAIT_L(0); PG8_BAR; PG8_MMA(1, 0, At, B0); PG8_MMA(1, 1, At, B1); PG8_BAR; PG8_SCHED;
            } else {
            PG8_LDB(B0, 0, 0); PG8_SCHED; PG8_LDA(At, 0, 0); PG8_STAGE(PG8_SA(1, 1), a1 + hstep, voffA);
            PG8_WAIT_L(8); PG8_BAR; PG8_WAIT_L(0); PG8_MMA(0, 0, At, B0); PG8_BAR; PG8_SCHED;
            PG8_LDB(B1, 0, 1); PG8_STAGE(PG8_SB(0, 0), b2, voffB);
            PG8_BAR; PG8_WAIT_L(0); PG8_MMA(0, 1, At, B1); PG8_BAR;
            PG8_LDA(At, 0, 1); PG8_STAGE(PG8_SA(0, 0), a2, voffA);
            PG8_BAR; PG8_WAIT_L(0); PG8_MMA(1, 0, At, B0); PG8_BAR; PG8_SCHED;
            PG8_STAGE(PG8_SB(0, 1), b2 + hstep, voffB);
            PG8_WAIT_V(6); PG8_BAR; PG8_MMA(1, 1, At, B1); PG8_BAR;
            PG8_LDB(B0, 1, 0); PG8_SCHED; PG8_LDA(At, 1, 0); PG8_STAGE(PG8_SA(0, 1), a2 + hstep, voffA);
            PG8_WAIT_L(8); PG8_BAR; PG8_WAIT_L(0); PG8_MMA(0, 0, At, B0); PG8_BAR; PG8_SCHED;
            PG8_LDB(B1, 1, 1); PG8_STAGE(PG8_SB(1, 0), b3, voffB);
            PG8_BAR; PG8_WAIT_L(0); PG8_MMA(0, 1, At, B1); PG8_BAR;
            PG8_LDA(At, 1, 1); PG8_STAGE(PG8_SA(1, 0), a3, voffA);
            PG8_BAR; PG8_WAIT_L(0); PG8_MMA(1, 0, At, B0); PG8_BAR; PG8_SCHED;
            PG8_STAGE(PG8_SB(1, 1), b3 + hstep, voffB);
            PG8_WAIT_V(6); PG8_BAR; PG8_MMA(1, 1, At, B1); PG8_BAR;
            }
        }
        if constexpr (ALIGN_EPI) { if (wr == 0) PG8_BAR; }
        if constexpr (!Epi::AFTER_DRAIN) { E(acc, cur, wr, wc, fr, fq); S.done(cur); }
        if (!has_next) break;
#pragma unroll
        for (int a = 0; a < 2; ++a)
#pragma unroll
            for (int b = 0; b < 2; ++b)
#pragma unroll
                for (int m = 0; m < 4; ++m)
#pragma unroll
                    for (int n = 0; n < 2; ++n) acc[a][b][m][n] = (f32x4){0.f, 0.f, 0.f, 0.f};
        cur = nxt; cA = nA; cB = nB; ++ui;
        if constexpr (ALIGN_EPI) { if (wr == 1) PG8_BAR; }
    }
    PG8_WAIT_V(0);
    if constexpr (!ALIGN_EPI) { if (wr == 0) PG8_BAR; }
    PG8_BAR;
    if constexpr (Epi::AFTER_DRAIN) { E.fused(acc, cur, wr, wc, fr, fq, lds, wid, lane); S.done(cur); }
#undef PG8_SA
#undef PG8_SB
#undef PG8_STAGE
#undef PG8_LDA
#undef PG8_LDB
#undef PG8_MMA
#undef PG8_WAIT_V
#undef PG8_WAIT_L
#undef PG8_BAR
#undef PG8_SCHED
}
}
#ifndef PG8_SP2
#define PG8_SP2 true
#endif
#ifndef PG8_ALIGN
#define PG8_ALIGN true
#endif
#ifndef OUT_MODE
#define OUT_MODE 0
#endif
#ifndef PH_MASK
#define PH_MASK 0xFFF
#endif
#ifndef MK_N_LAUNCHES
#define MK_N_LAUNCHES 12
#endif

constexpr int NWAVES = 8, NTHR = NWAVES * 64;
constexpr int BATCH = 2, SEQ = 8192, D = 2048, T = BATCH * SEQ;
constexpr int LRU_W = 1024, CONF_W = 1024, IN_COLS = 4096, LRU_HD = 128;
constexpr int NH = 8, NKEY = 128, TOPK = 16, NEXP = NKEY * NKEY, KSEL = NH * TOPK;
constexpr int NMOD = 6 * D;
constexpr int CHUNK = 64, NCHUNK = SEQ / CHUNK;
constexpr int CONF_K = 31;
constexpr float EPS = 1e-6f;
constexpr int N_PHASES = 12;

constexpr size_t MiB = 1u << 20;
constexpr size_t WS_CTL = 0, CTL_ZERO_BYTES = 64 * 1024;
constexpr size_t WS_MODP = 1 * MiB;
constexpr size_t WS_CFIN = 2 * MiB;
constexpr size_t WS_CARRY = 3 * MiB;
constexpr size_t WS_AGG = 4 * MiB;
constexpr size_t WS_WG = 6 * MiB;
constexpr size_t WS_SUBK = 7 * MiB;
constexpr size_t WS_BT1 = 8 * MiB;
constexpr size_t WS_BT2 = 24 * MiB;
constexpr size_t WS_BT3 = 32 * MiB;
constexpr size_t WS_IDX = 40 * MiB;
constexpr size_t WS_GATE = 48 * MiB;
constexpr size_t WS_RA = 64 * MiB;
constexpr size_t WS_Y1 = 128 * MiB;
constexpr size_t WS_PROJ = 192 * MiB;
constexpr size_t WS_Q = 192 * MiB;
constexpr size_t WS_UB = 256 * MiB;
constexpr size_t WS_XL = 320 * MiB;
constexpr size_t WS_ZC = 352 * MiB;
constexpr size_t WS_HLOC = 384 * MiB;
constexpr size_t WS_PC = 416 * MiB;
constexpr size_t WS_VB = 320 * MiB;
constexpr size_t WS_END = 448 * MiB;
constexpr int CW_TMO = 0, CW_BAR = 4096;

constexpr int RING_OFF = 0, RING_BYTES = 131072;
constexpr int LDSCTL_OFF = RING_BYTES, MISC_OFF = LDSCTL_OFF + 320;
constexpr int LDS_BYTES = 147456;

#define GAS __attribute__((address_space(1)))
#define LAS __attribute__((address_space(3)))
typedef unsigned short bf16;
typedef unsigned v4u __attribute__((ext_vector_type(4)));
typedef unsigned v2u __attribute__((ext_vector_type(2)));
typedef float f32x4 __attribute__((ext_vector_type(4)));
typedef float f32x16 __attribute__((ext_vector_type(16)));
typedef short bf16x8 __attribute__((ext_vector_type(8)));
typedef __bf16 bfp2 __attribute__((ext_vector_type(2)));
typedef GAS unsigned gu32;
#define RLX_AGENT __ATOMIC_RELAXED, __HIP_MEMORY_SCOPE_AGENT
#define LDS_WAIT() asm volatile("s_waitcnt lgkmcnt(0)" ::: "memory")
#define VM_WAIT() asm volatile("s_waitcnt vmcnt(0)" ::: "memory")
__device__ __forceinline__ unsigned f2bf(float f) { unsigned u = __builtin_bit_cast(unsigned, f); return (u + 0x7fffu + ((u >> 16) & 1u)) >> 16; }
__device__ __forceinline__ unsigned pk2(float lo, float hi) { return f2bf(lo) | (f2bf(hi) << 16); }
__device__ __forceinline__ float bflo(unsigned u) { return __builtin_bit_cast(float, u << 16); }
__device__ __forceinline__ float bfhi(unsigned u) { return __builtin_bit_cast(float, u & 0xffff0000u); }
__device__ __forceinline__ float wave_sum(float v) {
#pragma unroll
    for (int o = 1; o < 64; o <<= 1) v += __shfl_xor(v, o);
    return v;
}
__device__ __forceinline__ float sigmoidf_(float x) { return __builtin_amdgcn_rcpf(1.0f + __expf(-x)); }
__device__ __forceinline__ float gelu_tanh(float x) { return x * sigmoidf_(1.5957691216057308f * (x + 0.044715f * x * x * x)); }
__device__ __forceinline__ float rdlane(float v, int l) { return __builtin_bit_cast(float, __builtin_amdgcn_readlane(__builtin_bit_cast(int, v), l)); }

#define XB_TMO      128
#define XB_XCNT(j)  (256  + 64 * (j))
#define XB_XSUB(j)  (1280 + 64 * (j))
#define XB_XGEN(j)  (2304 + 64 * (j))
#define XB_TOP      3328
#define XB_TOPGEN   3392
#define XCD_BAR_WORDS 3456
#define XB_SPIN_CAP (1u << 18)

__device__ __forceinline__ unsigned xb_ld(unsigned* p)              { return __hip_atomic_load(p, __ATOMIC_RELAXED, __HIP_MEMORY_SCOPE_AGENT); }
__device__ __forceinline__ unsigned xb_add(unsigned* p, unsigned v) { return __hip_atomic_fetch_add(p, v, __ATOMIC_RELAXED, __HIP_MEMORY_SCOPE_AGENT); }
__device__ __forceinline__ unsigned xb_xcc_id() { return (unsigned)__builtin_amdgcn_s_getreg((3 << 11) | 20) & 0xFu; }
#define XB_SPIN(cond, bar) do { unsigned _sp = 0; while (cond) { __builtin_amdgcn_s_sleep(1); \
    if ((++_sp & 255u) == 0u) { if (xb_ld(&(bar)[XB_TMO])) break; if (_sp > XB_SPIN_CAP) { atomicAdd(&(bar)[XB_TMO], 1u); break; } } } } while (0)

struct XcdBarrier {
    unsigned* bar; unsigned x;
    volatile LAS unsigned* st;
};

__device__ __forceinline__ XcdBarrier xcd_barrier_post(unsigned* bar, volatile LAS unsigned* st) {
    XcdBarrier b; b.bar = bar; b.x = xb_xcc_id(); b.st = st;
    if (threadIdx.x == 0) (void)xb_add(&bar[XB_XCNT(b.x)], 1u);
    return b;
}
__device__ __forceinline__ void xcd_barrier_complete(unsigned* bar, unsigned x, unsigned& nloc, unsigned& nx) {
    const unsigned G = gridDim.x * gridDim.y * gridDim.z;
    unsigned sum, cnt, mine, sp = 0u;
    for (;;) {
        sum = 0u; cnt = 0u; mine = 0u;
#pragma unroll
        for (unsigned j = 0; j < 16; ++j) { const unsigned c = xb_ld(&bar[XB_XCNT(j)]); sum += c; cnt += (c > 0u) ? 1u : 0u; mine = (j == x) ? c : mine; }
        if (sum == G) break;
        __builtin_amdgcn_s_sleep(1);
        if ((++sp & 255u) == 0u) { if (xb_ld(&bar[XB_TMO])) break; if (sp > XB_SPIN_CAP) { atomicAdd(&bar[XB_TMO], 1u); break; } }
    }
    nloc = mine > 0u ? mine : 1u; nx = cnt > 0u ? cnt : 1u;
}

__device__ __forceinline__ void xcd_barrier(const XcdBarrier& b) {
    asm volatile("s_waitcnt vmcnt(0)" ::: "memory");
    __syncthreads();
    if (threadIdx.x == 0) {
        unsigned* bar = b.bar;
        __builtin_amdgcn_s_waitcnt(0);
        unsigned nloc = b.st[0], nx = b.st[1];
        if (nloc == 0u) { xcd_barrier_complete(bar, b.x, nloc, nx); b.st[0] = nloc; b.st[1] = nx; }
        const unsigned old = xb_add(&bar[XB_XSUB(b.x)], 1u);
        const unsigned gen = old / nloc;
        if (old + 1u == (gen + 1u) * nloc) {
            __builtin_amdgcn_fence(__ATOMIC_RELEASE, "agent");
            asm volatile("s_waitcnt vmcnt(0)" ::: "memory");
            const unsigned og = xb_add(&bar[XB_TOP], 1u);
            const unsigned tg = og / nx;
            if (og + 1u == (tg + 1u) * nx) xb_add(&bar[XB_TOPGEN], 1u);
            else XB_SPIN(xb_ld(&bar[XB_TOPGEN]) == tg, bar);
            __builtin_amdgcn_fence(__ATOMIC_ACQUIRE, "agent");
            xb_add(&bar[XB_XGEN(b.x)], 1u);
            asm volatile("s_waitcnt vmcnt(0)" ::: "memory");
        } else {
            XB_SPIN(xb_ld(&bar[XB_XGEN(b.x)]) == gen, bar);
            __builtin_amdgcn_fence(__ATOMIC_ACQUIRE, "agent");
            asm volatile("s_waitcnt vmcnt(0)" ::: "memory");
        }
    }
    __syncthreads();
}
struct Args { const float* in[25]; float* out; unsigned char* ws; int ph_lo, ph_hi; };
enum { I_X = 0, I_C, I_WMOD, I_BMOD, I_GPREMIX, I_GPOSTMIX, I_GPREFFN, I_GPOSTFFN, I_WIN, I_LCW, I_LCB, I_WA, I_BA, I_WX, I_BX, I_LAMBDA,
       I_CDW, I_CDB, I_LNG, I_LNB, I_WOUT, I_WQ, I_SUBK, I_PU, I_PV };

__device__ __forceinline__ float mod_at(const float* modp, int b, int n) {
    return (modp[(0 * 2 + b) * NMOD + n] + modp[(1 * 2 + b) * NMOD + n]) + (modp[(2 * 2 + b) * NMOD + n] + modp[(3 * 2 + b) * NMOD + n]);
}

__device__ __forceinline__ void p0_transpose_item(const float* W, int K, int N, bf16* WT, LAS float* scr, int item, int lane) {
    const int nblk = N / 32, kb = item / nblk, nb = item % nblk, k0 = 64 * kb, n0 = 32 * nb;
#pragma unroll 8
    for (int i = 0; i < 32; ++i) { const int kk = 2 * i + (lane >> 5); scr[kk * 33 + (lane & 31)] = W[(size_t)(k0 + kk) * N + n0 + (lane & 31)]; }
    LDS_WAIT(); asm volatile("" ::: "memory");
    const int c = lane & 7;
#pragma unroll
    for (int j = 0; j < 4; ++j) { const int n = (lane >> 3) + 8 * j; const LAS float* s = scr + (8 * c) * 33 + n;
        v4u o; o.x = pk2(s[0 * 33], s[1 * 33]); o.y = pk2(s[2 * 33], s[3 * 33]); o.z = pk2(s[4 * 33], s[5 * 33]); o.w = pk2(s[6 * 33], s[7 * 33]);
        *(GAS v4u*)(WT + (size_t)(n0 + n) * K + k0 + 8 * c) = o; }
    LDS_WAIT(); asm volatile("" ::: "memory");
}
__device__ __forceinline__ void cvt_rows_bf16(const float* src, bf16* dst, size_t n8, size_t gt, size_t ngt) {
    for (size_t i = gt; i < n8; i += ngt) {
        const f32x4 a = ((const GAS f32x4*)src)[2 * i], b = ((const GAS f32x4*)src)[2 * i + 1];
        v4u o; o.x = pk2(a.x, a.y); o.y = pk2(a.z, a.w); o.z = pk2(b.x, b.y); o.w = pk2(b.z, b.w);
        ((GAS v4u*)dst)[i] = o; }
}
__device__ __forceinline__ void phase_p0(const Args& A, LAS unsigned char* lds, int tid, int lane, int wave, int bid, int G) {
    float* modp = (float*)(A.ws + WS_MODP);
    for (int item = bid; item < 192; item += G) {
        const int cg = item % 48, kq = item / 48, k0 = kq * 512 + wave * 64, n0 = cg * 256 + lane * 4;
        const float c0 = A.in[I_C][k0 + lane], c1 = A.in[I_C][D + k0 + lane];
        const float ca0 = c0 * sigmoidf_(c0), ca1 = c1 * sigmoidf_(c1);
        f32x4 a0 = {0.f, 0.f, 0.f, 0.f}, a1 = {0.f, 0.f, 0.f, 0.f};
        const float* wp = A.in[I_WMOD] + (size_t)k0 * NMOD + n0;
#pragma unroll 8
        for (int kk = 0; kk < 64; ++kk) {
            const f32x4 w = *(const GAS f32x4*)(wp + (size_t)kk * NMOD);
            const float s0 = __shfl(ca0, kk), s1 = __shfl(ca1, kk);
            a0 += w * s0; a1 += w * s1;
        }
        LAS f32x4* red = (LAS f32x4*)lds;
        red[(wave * 2 + 0) * 64 + lane] = a0; red[(wave * 2 + 1) * 64 + lane] = a1;
        __syncthreads();
        { const int b = tid >> 8, col = tid & 255; const LAS float* rf = (const LAS float*)lds; float s = 0.f;
#pragma unroll
          for (int w = 0; w < 8; ++w) s += rf[((w * 2 + b) * 64) * 4 + col];
          if (kq == 0) s += A.in[I_BMOD][cg * 256 + col];
          modp[(kq * 2 + b) * NMOD + cg * 256 + col] = s; }
        __syncthreads();
    }
    {
        LAS float* scr = (LAS float*)(lds + wave * 16384);
        const int gw = bid * NWAVES + wave, NGW = G * NWAVES;
        constexpr int I1 = (D / 64) * (IN_COLS / 32), I2 = (D / 64) * (D / 32);
        for (int it = gw; it < I1 + 2 * I2; it += NGW) {
            int r = it;
            if (r < I1) { p0_transpose_item(A.in[I_WIN], D, IN_COLS, (bf16*)(A.ws + WS_BT1), scr, r, lane); continue; } r -= I1;
            if (r < I2) { p0_transpose_item(A.in[I_WOUT], D, D, (bf16*)(A.ws + WS_BT2), scr, r, lane); continue; } r -= I2;
            p0_transpose_item(A.in[I_WQ], D, D, (bf16*)(A.ws + WS_BT3), scr, r, lane);
        }
    }
    {
        const int gt = bid * NTHR + tid, ngt = G * NTHR;
        bf16* wg = (bf16*)(A.ws + WS_WG);
        for (int e = gt; e < NH * 256 * 128; e += ngt) {
            const int h = e >> 15, n = (e >> 7) & 255, k = e & 127;
            const float v = (n < 128 ? A.in[I_WA] : A.in[I_WX])[h * 16384 + k * 128 + (n & 127)];
            wg[e] = (bf16)f2bf(v);
        }
        cvt_rows_bf16(A.in[I_SUBK], (bf16*)(A.ws + WS_SUBK), (size_t)NH * 2 * NKEY * 128 / 8, gt, ngt);
    }
}

__device__ __forceinline__ void phase_p1(const Args& A, int tid, int lane, int wave, int bid, int G) {
    const float* modp = (const float*)(A.ws + WS_MODP);
    {
        float* cfin = (float*)(A.ws + WS_CFIN);
        for (int e = bid * NTHR + tid; e < 2 * 2 * D; e += G * NTHR) {
            const int b = e >> 12, arr = (e >> 11) & 1, col = e & (D - 1);
            cfin[e] = arr == 0 ? mod_at(modp, b, 2 * D + col) * A.in[I_GPOSTMIX][col] : mod_at(modp, b, 5 * D + col) * A.in[I_GPOSTFFN][col];
        }
    }
    const int gw = bid * NWAVES + wave, NGW = G * NWAVES;
    bf16* h1 = (bf16*)(A.ws + WS_RA);
    int cb = -1; float gs[4][8], sh[4][8];
    for (int row = gw; row < T; row += NGW) {
        const int b = row >> 13;
        if (b != cb) { cb = b;
#pragma unroll
            for (int j = 0; j < 4; ++j)
#pragma unroll
                for (int e = 0; e < 8; ++e) { const int col = j * 512 + lane * 8 + e;
                    gs[j][e] = A.in[I_GPREMIX][col] * (1.0f + mod_at(modp, b, D + col)); sh[j][e] = mod_at(modp, b, col); } }
        const GAS f32x4* xr = (const GAS f32x4*)(A.in[I_X] + (size_t)row * D) + lane * 2;
        f32x4 v[4][2]; float s = 0.f;
#pragma unroll
        for (int j = 0; j < 4; ++j) { v[j][0] = xr[j * 128]; v[j][1] = xr[j * 128 + 1];
            s += (v[j][0].x * v[j][0].x + v[j][0].y * v[j][0].y) + (v[j][0].z * v[j][0].z + v[j][0].w * v[j][0].w);
            s += (v[j][1].x * v[j][1].x + v[j][1].y * v[j][1].y) + (v[j][1].z * v[j][1].z + v[j][1].w * v[j][1].w); }
        const float rstd = __builtin_amdgcn_rsqf(wave_sum(s) * (1.0f / D) + EPS);
        GAS v4u* orow = (GAS v4u*)(h1 + (size_t)row * D) + lane;
#pragma unroll
        for (int j = 0; j < 4; ++j) { float o[8];
#pragma unroll
            for (int e = 0; e < 8; ++e) o[e] = v[j][e >> 2][e & 3] * rstd * gs[j][e] + sh[j][e];
            v4u w; w.x = pk2(o[0], o[1]); w.y = pk2(o[2], o[3]); w.z = pk2(o[4], o[5]); w.w = pk2(o[6], o[7]);
            orow[j * 64] = w; }
    }
}

__device__ __forceinline__ void phase_m1a(const Args& A, LAS unsigned char* lds, int tid, int lane, int wave, int bid, int G) {
    const bf16* proj = (const bf16*)(A.ws + WS_PROJ);
    {
        bf16* xl = (bf16*)(A.ws + WS_XL);
        const float* w4 = A.in[I_LCW]; const float* b4 = A.in[I_LCB];
        for (int it = bid * NTHR + tid; it < T * 128; it += G * NTHR) {
            const int row = it >> 7, c0 = (it & 127) * 8, t = row & (SEQ - 1);
            float acc[8];
            { const f32x4 ba = *(const GAS f32x4*)(b4 + c0), bb = *(const GAS f32x4*)(b4 + c0 + 4);
              acc[0] = ba.x; acc[1] = ba.y; acc[2] = ba.z; acc[3] = ba.w; acc[4] = bb.x; acc[5] = bb.y; acc[6] = bb.z; acc[7] = bb.w; }
#pragma unroll
            for (int j = 0; j < 4; ++j) {
                if (t - 3 + j >= 0) {
                    const v4u v = *(const GAS v4u*)(proj + (size_t)(row - 3 + j) * IN_COLS + c0);
                    const f32x4 wa = *(const GAS f32x4*)(w4 + j * LRU_W + c0), wb = *(const GAS f32x4*)(w4 + j * LRU_W + c0 + 4);
                    acc[0] += wa.x * bflo(v.x); acc[1] += wa.y * bfhi(v.x); acc[2] += wa.z * bflo(v.y); acc[3] += wa.w * bfhi(v.y);
                    acc[4] += wb.x * bflo(v.z); acc[5] += wb.y * bfhi(v.z); acc[6] += wb.z * bflo(v.w); acc[7] += wb.w * bfhi(v.w);
                }
            }
            v4u o; o.x = pk2(acc[0], acc[1]); o.y = pk2(acc[2], acc[3]); o.z = pk2(acc[4], acc[5]); o.w = pk2(acc[6], acc[7]);
            *(GAS v4u*)(xl + (size_t)row * LRU_W + c0) = o;
        }
    }
    {
        bf16* zc = (bf16*)(A.ws + WS_ZC);
        const float* w31 = A.in[I_CDW]; const float* b31 = A.in[I_CDB];
        LAS float* zt = (LAS float*)lds;
        for (int item = bid; item < 2 * 64 * 8; item += G) {
            const int b = item >> 9, tt = (item >> 3) & 63, ct = item & 7;
            const int t0 = tt * 128;
            __syncthreads();
            for (int e = tid; e < 158 * 16; e += NTHR) {
                const int r = e >> 4, c8 = (e & 15) * 8, t = t0 - 30 + r;
                f32x4 z0 = {0.f, 0.f, 0.f, 0.f}, z1 = {0.f, 0.f, 0.f, 0.f};
                if (t >= 0) {
                    const bf16* p = proj + (size_t)(b * SEQ + t) * IN_COLS + 2048 + ct * 128 + c8;
                    const v4u v = *(const GAS v4u*)p, g = *(const GAS v4u*)(p + 1024);
                    z0.x = bflo(v.x) * sigmoidf_(bflo(g.x)); z0.y = bfhi(v.x) * sigmoidf_(bfhi(g.x)); z0.z = bflo(v.y) * sigmoidf_(bflo(g.y)); z0.w = bfhi(v.y) * sigmoidf_(bfhi(g.y));
                    z1.x = bflo(v.z) * sigmoidf_(bflo(g.z)); z1.y = bfhi(v.z) * sigmoidf_(bfhi(g.z)); z1.z = bflo(v.w) * sigmoidf_(bflo(g.w)); z1.w = bfhi(v.w) * sigmoidf_(bfhi(g.w));
                }
                *(LAS f32x4*)(zt + r * 128 + c8) = z0; *(LAS f32x4*)(zt + r * 128 + c8 + 4) = z1;
            }
            __syncthreads();
            const int c = tid & 127, tg = tid >> 7, ch = ct * 128 + c;
            float w[CONF_K];
#pragma unroll
            for (int j = 0; j < CONF_K; ++j) w[j] = w31[j * CONF_W + ch];
            float acc[32]; const float bias = b31[ch];
#pragma unroll
            for (int i = 0; i < 32; ++i) acc[i] = bias;
#pragma unroll
            for (int s = 0; s < 62; ++s) {
                const float v = zt[(tg * 32 + s) * 128 + c];
#pragma unroll
                for (int i = 0; i < 32; ++i) if (s - i >= 0 && s - i < CONF_K) acc[i] += w[s - i] * v;
            }
            bf16* zo = zc + (size_t)(b * SEQ + t0 + tg * 32) * CONF_W + ch;
#pragma unroll
            for (int i = 0; i < 32; ++i) zo[(size_t)i * CONF_W] = (bf16)f2bf(acc[i]);
        }
        __syncthreads();
    }
}

__device__ __forceinline__ void phase_m1b(const Args& A, int tid, int lane, int wave, int bid, int G) {
    const bf16* xl = (const bf16*)(A.ws + WS_XL); const bf16* wg = (const bf16*)(A.ws + WS_WG);
    bf16* hloc = (bf16*)(A.ws + WS_HLOC); bf16* pc = (bf16*)(A.ws + WS_PC); float* agg = (float*)(A.ws + WS_AGG);
    const int fr = lane & 15, fq = lane >> 4;
    for (int item = bid * NWAVES + wave; item < 2 * NCHUNK * 8; item += G * NWAVES) {
        const int hh = item & 7, chunk = (item >> 3) & (NCHUNK - 1), b = item >> 10;
        const size_t r0 = (size_t)b * SEQ + (size_t)chunk * CHUNK;
        bf16x8 xf[4][4];
#pragma unroll
        for (int mt = 0; mt < 4; ++mt)
#pragma unroll
            for (int ks = 0; ks < 4; ++ks) xf[mt][ks] = *(const GAS bf16x8*)(xl + (r0 + 16 * mt + fr) * LRU_W + hh * LRU_HD + 32 * ks + 8 * fq);
        float cP[4], cH[4];
        for (int j = 0; j < 8; ++j) {
            const int chb = hh * LRU_HD + 16 * j + 4 * fq;
            bf16x8 wa[4], wx[4];
#pragma unroll
            for (int ks = 0; ks < 4; ++ks) { wa[ks] = *(const GAS bf16x8*)(wg + (size_t)(hh * 256 + 16 * j + fr) * 128 + 32 * ks + 8 * fq);
                                             wx[ks] = *(const GAS bf16x8*)(wg + (size_t)(hh * 256 + 128 + 16 * j + fr) * 128 + 32 * ks + 8 * fq); }
            const f32x4 bav = *(const GAS f32x4*)(A.in[I_BA] + chb), bxv = *(const GAS f32x4*)(A.in[I_BX] + chb), lam = *(const GAS f32x4*)(A.in[I_LAMBDA] + chb);
            float cl[4];
#pragma unroll
            for (int r = 0; r < 4; ++r) { cl[r] = -8.0f * log1pf(__expf(-lam[r])); cP[r] = 1.f; cH[r] = 0.f; }
#pragma unroll
            for (int mt = 0; mt < 4; ++mt) {
                f32x4 ar = {0.f, 0.f, 0.f, 0.f}, ai = {0.f, 0.f, 0.f, 0.f};
#pragma unroll
                for (int ks = 0; ks < 4; ++ks) { ar = __builtin_amdgcn_mfma_f32_16x16x32_bf16(wa[ks], xf[mt][ks], ar, 0, 0, 0);
                                                 ai = __builtin_amdgcn_mfma_f32_16x16x32_bf16(wx[ks], xf[mt][ks], ai, 0, 0, 0); }
                const v2u xv = *(const GAS v2u*)(xl + (r0 + 16 * mt + fr) * LRU_W + chb);
                const float xlv[4] = {bflo(xv.x), bfhi(xv.x), bflo(xv.y), bfhi(xv.y)};
                float P[4], H[4];
#pragma unroll
                for (int r = 0; r < 4; ++r) {
                    const float rg = sigmoidf_(ar[r] + bav[r]), ig = sigmoidf_(ai[r] + bxv[r]);
                    const float la = cl[r] * rg, a = __expf(la), mult = sqrtf(fmaxf(1.0f - __expf(2.0f * la), 0.f));
                    float p = a, h = mult * ig * xlv[r];
#pragma unroll
                    for (int s = 1; s < 16; s <<= 1) { const float pp = __shfl_up(p, s, 16), hp = __shfl_up(h, s, 16);
                        if (fr >= s) { h = p * hp + h; p = p * pp; } }
                    h = h + p * cH[r]; p = p * cP[r];
                    P[r] = p; H[r] = h;
                    cP[r] = __shfl(p, 15, 16); cH[r] = __shfl(h, 15, 16);
                }
                v2u ho, po; ho.x = pk2(H[0], H[1]); ho.y = pk2(H[2], H[3]); po.x = pk2(P[0], P[1]); po.y = pk2(P[2], P[3]);
                *(GAS v2u*)(hloc + (r0 + 16 * mt + fr) * LRU_W + chb) = ho;
                *(GAS v2u*)(pc + (r0 + 16 * mt + fr) * LRU_W + chb) = po;
            }
            if (fr == 0) {
                float* ag = agg + ((size_t)(b * NCHUNK + chunk) * LRU_W + chb) * 2;
                *(GAS f32x4*)ag = (f32x4){cP[0], cH[0], cP[1], cH[1]}; *(GAS f32x4*)(ag + 4) = (f32x4){cP[2], cH[2], cP[3], cH[3]};
            }
        }
    }
}

__device__ __forceinline__ void phase_m2(const Args& A, int tid, int bid, int G) {
    const float* agg = (const float*)(A.ws + WS_AGG); float* carry = (float*)(A.ws + WS_CARRY);
    for (int e = bid * NTHR + tid; e < 2 * LRU_W; e += G * NTHR) {
        const int b = e >> 10, ch = e & (LRU_W - 1); float Hs = 0.f;
        for (int c = 0; c < NCHUNK; ++c) {
            carry[(size_t)(b * NCHUNK + c) * LRU_W + ch] = Hs;
            const float2 ab = *(const float2*)(agg + ((size_t)(b * NCHUNK + c) * LRU_W + ch) * 2);
            Hs = ab.x * Hs + ab.y;
        }
    }
}

__device__ __forceinline__ void phase_m3(const Args& A, int tid, int lane, int wave, int bid, int G) {
    const bf16* proj = (const bf16*)(A.ws + WS_PROJ); const bf16* hloc = (const bf16*)(A.ws + WS_HLOC); const bf16* pc = (const bf16*)(A.ws + WS_PC);
    const bf16* zc = (const bf16*)(A.ws + WS_ZC); const float* carry = (const float*)(A.ws + WS_CARRY);
    bf16* a2 = (bf16*)(A.ws + WS_RA);
    float lg[2][8], lb[2][8];
#pragma unroll
    for (int jj = 0; jj < 2; ++jj)
#pragma unroll
        for (int e = 0; e < 8; ++e) { lg[jj][e] = A.in[I_LNG][jj * 512 + lane * 8 + e]; lb[jj][e] = A.in[I_LNB][jj * 512 + lane * 8 + e]; }
    for (int row = bid * NWAVES + wave; row < T; row += G * NWAVES) {
        const int b = row >> 13, chunk = (row & (SEQ - 1)) >> 6;
        float zv[2][8]; float s = 0.f;
#pragma unroll
        for (int jj = 0; jj < 2; ++jj) {
            const int c0 = jj * 512 + lane * 8;
            const v4u hv = *(const GAS v4u*)(hloc + (size_t)row * LRU_W + c0), pv = *(const GAS v4u*)(pc + (size_t)row * LRU_W + c0);
            const v4u gv = *(const GAS v4u*)(proj + (size_t)row * IN_COLS + 1024 + c0);
            const float* cp = carry + (size_t)(b * NCHUNK + chunk) * LRU_W + c0;
            const f32x4 ca = *(const GAS f32x4*)cp, cb = *(const GAS f32x4*)(cp + 4);
            float y[8];
            y[0] = (bflo(hv.x) + bflo(pv.x) * ca.x) * gelu_tanh(bflo(gv.x)); y[1] = (bfhi(hv.x) + bfhi(pv.x) * ca.y) * gelu_tanh(bfhi(gv.x));
            y[2] = (bflo(hv.y) + bflo(pv.y) * ca.z) * gelu_tanh(bflo(gv.y)); y[3] = (bfhi(hv.y) + bfhi(pv.y) * ca.w) * gelu_tanh(bfhi(gv.y));
            y[4] = (bflo(hv.z) + bflo(pv.z) * cb.x) * gelu_tanh(bflo(gv.z)); y[5] = (bfhi(hv.z) + bfhi(pv.z) * cb.y) * gelu_tanh(bfhi(gv.z));
            y[6] = (bflo(hv.w) + bflo(pv.w) * cb.z) * gelu_tanh(bflo(gv.w)); y[7] = (bfhi(hv.w) + bfhi(pv.w) * cb.w) * gelu_tanh(bfhi(gv.w));
            v4u o; o.x = pk2(y[0], y[1]); o.y = pk2(y[2], y[3]); o.z = pk2(y[4], y[5]); o.w = pk2(y[6], y[7]);
            *(GAS v4u*)(a2 + (size_t)row * D + c0) = o;
            const v4u z = *(const GAS v4u*)(zc + (size_t)row * CONF_W + c0);
            zv[jj][0] = bflo(z.x); zv[jj][1] = bfhi(z.x); zv[jj][2] = bflo(z.y); zv[jj][3] = bfhi(z.y); zv[jj][4] = bflo(z.z); zv[jj][5] = bfhi(z.z); zv[jj][6] = bflo(z.w); zv[jj][7] = bfhi(z.w);
#pragma unroll
            for (int e = 0; e < 8; ++e) s += zv[jj][e];
        }
        const float mean = wave_sum(s) * (1.0f / CONF_W); float q = 0.f;
#pragma unroll
        for (int jj = 0; jj < 2; ++jj)
#pragma unroll
            for (int e = 0; e < 8; ++e) { zv[jj][e] -= mean; q += zv[jj][e] * zv[jj][e]; }
        const float rstd = __builtin_amdgcn_rsqf(wave_sum(q) * (1.0f / CONF_W) + EPS);
#pragma unroll
        for (int jj = 0; jj < 2; ++jj) { float o[8];
#pragma unroll
            for (int e = 0; e < 8; ++e) { const float n = zv[jj][e] * rstd * lg[jj][e] + lb[jj][e]; o[e] = n * sigmoidf_(n); }
            v4u w; w.x = pk2(o[0], o[1]); w.y = pk2(o[2], o[3]); w.z = pk2(o[4], o[5]); w.w = pk2(o[6], o[7]);
            *(GAS v4u*)(a2 + (size_t)row * D + 1024 + jj * 512 + lane * 8) = w; }
    }
}

__device__ __forceinline__ void phase_e2(const Args& A, int tid, int lane, int wave, int bid, int G) {
    const float* modp = (const float*)(A.ws + WS_MODP); const float* cfin = (const float*)(A.ws + WS_CFIN);
    const bf16* y1 = (const bf16*)(A.ws + WS_Y1); bf16* h2 = (bf16*)(A.ws + WS_RA);
    const int gw = bid * NWAVES + wave, NGW = G * NWAVES;
    int cb = -1; float gs[4][8], sh[4][8];
    for (int row = gw; row < T; row += NGW) {
        const int b = row >> 13;
        if (b != cb) { cb = b;
#pragma unroll
            for (int j = 0; j < 4; ++j)
#pragma unroll
                for (int e = 0; e < 8; ++e) { const int col = j * 512 + lane * 8 + e;
                    gs[j][e] = A.in[I_GPREFFN][col] * (1.0f + mod_at(modp, b, 4 * D + col)); sh[j][e] = mod_at(modp, b, 3 * D + col); } }
        const GAS f32x4* xr = (const GAS f32x4*)(A.in[I_X] + (size_t)row * D) + lane * 2;
        const GAS v4u* yr = (const GAS v4u*)(y1 + (size_t)row * D) + lane;
        const GAS f32x4* cf = (const GAS f32x4*)(cfin + (size_t)(b * 2 + 0) * D) + lane * 2;
        float xv[4][8], yv[4][8]; float s1 = 0.f;
#pragma unroll
        for (int j = 0; j < 4; ++j) { const f32x4 a = xr[j * 128], c = xr[j * 128 + 1]; const v4u y = yr[j * 64];
            xv[j][0] = a.x; xv[j][1] = a.y; xv[j][2] = a.z; xv[j][3] = a.w; xv[j][4] = c.x; xv[j][5] = c.y; xv[j][6] = c.z; xv[j][7] = c.w;
            yv[j][0] = bflo(y.x); yv[j][1] = bfhi(y.x); yv[j][2] = bflo(y.y); yv[j][3] = bfhi(y.y); yv[j][4] = bflo(y.z); yv[j][5] = bfhi(y.z); yv[j][6] = bflo(y.w); yv[j][7] = bfhi(y.w);
#pragma unroll
            for (int e = 0; e < 8; ++e) s1 += yv[j][e] * yv[j][e]; }
        const float rstd1 = __builtin_amdgcn_rsqf(wave_sum(s1) * (1.0f / D) + EPS); float s2 = 0.f;
#pragma unroll
        for (int j = 0; j < 4; ++j) { const f32x4 ca = cf[j * 128], cc = cf[j * 128 + 1]; const float cg[8] = {ca.x, ca.y, ca.z, ca.w, cc.x, cc.y, cc.z, cc.w};
#pragma unroll
            for (int e = 0; e < 8; ++e) { xv[j][e] += cg[e] * yv[j][e] * rstd1; s2 += xv[j][e] * xv[j][e]; } }
        const float rstd2 = __builtin_amdgcn_rsqf(wave_sum(s2) * (1.0f / D) + EPS);
        GAS v4u* orow = (GAS v4u*)(h2 + (size_t)row * D) + lane;
#pragma unroll
        for (int j = 0; j < 4; ++j) { float o[8];
#pragma unroll
            for (int e = 0; e < 8; ++e) o[e] = xv[j][e] * rstd2 * gs[j][e] + sh[j][e];
            v4u w; w.x = pk2(o[0], o[1]); w.y = pk2(o[2], o[3]); w.z = pk2(o[4], o[5]); w.w = pk2(o[6], o[7]);
            orow[j * 64] = w; }
    }
    cvt_rows_bf16(A.in[I_PU], (bf16*)(A.ws + WS_UB), (size_t)NEXP * D / 8, (size_t)bid * NTHR + tid, (size_t)G * NTHR);
    cvt_rows_bf16(A.in[I_PV], (bf16*)(A.ws + WS_VB), (size_t)NEXP * D / 8, (size_t)bid * NTHR + tid, (size_t)G * NTHR);
}

template <int N> __device__ __forceinline__ void bitonic_sort_desc(float (&v)[N]) {
#pragma unroll
    for (int k = 2; k <= N; k <<= 1)
#pragma unroll
        for (int j = k >> 1; j > 0; j >>= 1)
#pragma unroll
            for (int i = 0; i < N; ++i) { const int l = i ^ j;
                if (l > i) { const bool desc = ((i & k) == 0); const float a = v[i], b = v[l]; const float mx = fmaxf(a, b), mn = fminf(a, b); v[i] = desc ? mx : mn; v[l] = desc ? mn : mx; } }
}
__device__ __forceinline__ void merge_top16(float (&a)[16], const float (&b)[16]) {
#pragma unroll
    for (int i = 0; i < 16; ++i) a[i] = fmaxf(a[i], b[15 - i]);
#pragma unroll
    for (int j = 8; j > 0; j >>= 1)
#pragma unroll
        for (int i = 0; i < 16; ++i) { const int l = i ^ j; if (l > i) { const float x = a[i], y = a[l]; a[i] = fmaxf(x, y); a[l] = fminf(x, y); } }
}
__device__ __forceinline__ void top16_of_64(float (&v)[64], float (&out)[16]) {
    float g[4][16];
#pragma unroll
    for (int q = 0; q < 4; ++q) {
#pragma unroll
        for (int i = 0; i < 16; ++i) g[q][i] = v[q * 16 + i];
        bitonic_sort_desc<16>(g[q]); }
    merge_top16(g[0], g[1]); merge_top16(g[2], g[3]); merge_top16(g[0], g[2]);
#pragma unroll
    for (int i = 0; i < 16; ++i) out[i] = g[0][i];
}
__device__ __forceinline__ float pack_key(float v, unsigned key, unsigned mask) { return __builtin_bit_cast(float, (__builtin_bit_cast(unsigned, v) & ~mask) | key); }
__device__ __forceinline__ void score_top16(const bf16* q, const bf16* sk, int tok, int h, int p, int l31, int hf, float (&out)[16]) {
    f32x16 acc[4];
#pragma unroll
    for (int kt = 0; kt < 4; ++kt)
#pragma unroll
        for (int r = 0; r < 16; ++r) acc[kt][r] = 0.f;
#pragma unroll 2
    for (int ks = 0; ks < 8; ++ks) {
        const bf16x8 bq = *(const GAS bf16x8*)(q + (size_t)tok * D + h * 256 + p * 128 + 16 * ks + 8 * hf);
#pragma unroll
        for (int kt = 0; kt < 4; ++kt) {
            const bf16x8 ak = *(const GAS bf16x8*)(sk + ((size_t)((h * 2 + p) * NKEY + 32 * kt + l31)) * 128 + 16 * ks + 8 * hf);
            acc[kt] = __builtin_amdgcn_mfma_f32_32x32x16_bf16(ak, bq, acc[kt], 0, 0, 0);
        }
    }
    float v[64];
#pragma unroll
    for (int kt = 0; kt < 4; ++kt)
#pragma unroll
        for (int r = 0; r < 16; ++r) v[kt * 16 + r] = pack_key(acc[kt][r], (unsigned)(32 * kt + (r & 3) + 8 * (r >> 2) + 4 * hf), 0x7Fu);
    float other[16];
    top16_of_64(v, out);
#pragma unroll
    for (int i = 0; i < 16; ++i) other[i] = __shfl_xor(out[i], 32);
    merge_top16(out, other);
}
__device__ __forceinline__ void phase_s(const Args& A, int tid, int lane, int wave, int bid, int G) {
    const bf16* q = (const bf16*)(A.ws + WS_Q); const bf16* sk = (const bf16*)(A.ws + WS_SUBK);
    int* idx = (int*)(A.ws + WS_IDX); float* gate = (float*)(A.ws + WS_GATE);
    const int l31 = lane & 31, hf = lane >> 5;
    for (int item = bid * NWAVES + wave; item < (T / 32) * NH; item += G * NWAVES) {
        const int h = item & 7, tok = (item >> 3) * 32 + l31;
        float s1[16], s2[16];
        score_top16(q, sk, tok, h, 0, l31, hf, s1);
        score_top16(q, sk, tok, h, 1, l31, hf, s2);
        float cv[64]; int n = 0;
#pragma unroll
        for (int i = 0; i < 16; ++i)
#pragma unroll
            for (int j = 0; j < 16; ++j)
                if ((i + 1) * (j + 1) <= 16) {
                    const float a = __builtin_bit_cast(float, __builtin_bit_cast(unsigned, s1[i]) & ~0x7Fu), c = __builtin_bit_cast(float, __builtin_bit_cast(unsigned, s2[j]) & ~0x7Fu);
                    cv[n++] = pack_key(a + c, (unsigned)(i * 16 + j), 0xFFu); }
#pragma unroll
        for (int m = 50; m < 64; ++m) cv[m] = -INFINITY;
        float c16[16];
        top16_of_64(cv, c16);
        float ev[16], esum = 0.f; const float cmax = __builtin_bit_cast(float, __builtin_bit_cast(unsigned, c16[0]) & ~0xFFu);
#pragma unroll
        for (int m = 0; m < 16; ++m) { ev[m] = __expf(__builtin_bit_cast(float, __builtin_bit_cast(unsigned, c16[m]) & ~0xFFu) - cmax); esum += ev[m]; }
        const float rs = 1.0f / esum;
        int oi[8]; float og[8];
#pragma unroll
        for (int mm = 0; mm < 8; ++mm) {
            float c_lo = c16[mm], c_hi = c16[8 + mm], e_lo = ev[mm], e_hi = ev[8 + mm];
            asm volatile("" : "+v"(c_lo), "+v"(c_hi), "+v"(e_lo), "+v"(e_hi));
            const unsigned cb = __builtin_bit_cast(unsigned, hf ? c_hi : c_lo); const int ii = (cb >> 4) & 15, jj = cb & 15;
            int row = 0, col = 0;
#pragma unroll
            for (int k = 0; k < 16; ++k) { row = (ii == k) ? (int)(__builtin_bit_cast(unsigned, s1[k]) & 0x7Fu) : row; col = (jj == k) ? (int)(__builtin_bit_cast(unsigned, s2[k]) & 0x7Fu) : col; }
            oi[mm] = row * NKEY + col; og[mm] = (hf ? e_hi : e_lo) * rs;
        }
        int* ip = idx + (size_t)tok * KSEL + h * 16 + hf * 8; float* gp = gate + (size_t)tok * KSEL + h * 16 + hf * 8;
        *(GAS v4u*)ip = (v4u){(unsigned)oi[0], (unsigned)oi[1], (unsigned)oi[2], (unsigned)oi[3]}; *(GAS v4u*)(ip + 4) = (v4u){(unsigned)oi[4], (unsigned)oi[5], (unsigned)oi[6], (unsigned)oi[7]};
        *(GAS f32x4*)gp = (f32x4){og[0], og[1], og[2], og[3]}; *(GAS f32x4*)(gp + 4) = (f32x4){og[4], og[5], og[6], og[7]};
    }
}

__device__ __forceinline__ float dot2(unsigned a, unsigned b, float acc) { return __builtin_amdgcn_fdot2_f32_bf16(__builtin_bit_cast(bfp2, a), __builtin_bit_cast(bfp2, b), acc, false); }
__device__ __forceinline__ float dot8(const v4u a, const v4u b, float acc) {
    acc = dot2(a.x, b.x, acc); acc = dot2(a.y, b.y, acc); acc = dot2(a.z, b.z, acc); acc = dot2(a.w, b.w, acc);
    return acc;
}
__device__ __forceinline__ void axpy8(float (&acc)[8], const v4u v, float w) {
    acc[0] += w * bflo(v.x); acc[1] += w * bfhi(v.x); acc[2] += w * bflo(v.y); acc[3] += w * bfhi(v.y);
    acc[4] += w * bflo(v.z); acc[5] += w * bfhi(v.z); acc[6] += w * bflo(v.w); acc[7] += w * bfhi(v.w);
}
__device__ __forceinline__ void phase_pe(const Args& A, int tid, int lane, int wave, int bid, int G) {
    const bf16* h2 = (const bf16*)(A.ws + WS_RA); const bf16* y1 = (const bf16*)(A.ws + WS_Y1);
    const bf16* ub = (const bf16*)(A.ws + WS_UB); const bf16* vb = (const bf16*)(A.ws + WS_VB);
    const int* idx = (const int*)(A.ws + WS_IDX); const float* gate = (const float*)(A.ws + WS_GATE); const float* cfin = (const float*)(A.ws + WS_CFIN);
    for (int tok = bid * NWAVES + wave; tok < T; tok += G * NWAVES) {
        const int b = tok >> 13;
        v4u hq[4];
#pragma unroll
        for (int j = 0; j < 4; ++j) hq[j] = ((const GAS v4u*)(h2 + (size_t)tok * D))[j * 64 + lane];
        const int id0 = idx[(size_t)tok * KSEL + lane], id1 = idx[(size_t)tok * KSEL + 64 + lane];
        const float g0 = gate[(size_t)tok * KSEL + lane], g1 = gate[(size_t)tok * KSEL + 64 + lane];
        float act0 = 0.f, act1 = 0.f;
#pragma unroll 4
        for (int k = 0; k < 64; ++k) {
            const int e = __builtin_amdgcn_readlane(id0, k);
            const GAS v4u* up = (const GAS v4u*)(ub + (size_t)e * D) + lane;
            float p = dot8(up[0], hq[0], 0.f); p = dot8(up[64], hq[1], p); p = dot8(up[128], hq[2], p); p = dot8(up[192], hq[3], p);
            p = wave_sum(p); act0 = (lane == k) ? p : act0;
        }
#pragma unroll 4
        for (int k = 0; k < 64; ++k) {
            const int e = __builtin_amdgcn_readlane(id1, k);
            const GAS v4u* up = (const GAS v4u*)(ub + (size_t)e * D) + lane;
            float p = dot8(up[0], hq[0], 0.f); p = dot8(up[64], hq[1], p); p = dot8(up[128], hq[2], p); p = dot8(up[192], hq[3], p);
            p = wave_sum(p); act1 = (lane == k) ? p : act1;
        }
        const float w0 = g0 * gelu_tanh(act0), w1 = g1 * gelu_tanh(act1);
        float acc[4][8];
#pragma unroll
        for (int j = 0; j < 4; ++j)
#pragma unroll
            for (int e = 0; e < 8; ++e) acc[j][e] = 0.f;
#pragma unroll 4
        for (int k = 0; k < 64; ++k) {
            const int e = __builtin_amdgcn_readlane(id0, k); const float w = rdlane(w0, k);
            const GAS v4u* vp = (const GAS v4u*)(vb + (size_t)e * D) + lane;
            axpy8(acc[0], vp[0], w); axpy8(acc[1], vp[64], w); axpy8(acc[2], vp[128], w); axpy8(acc[3], vp[192], w);
        }
#pragma unroll 4
        for (int k = 0; k < 64; ++k) {
            const int e = __builtin_amdgcn_readlane(id1, k); const float w = rdlane(w1, k);
            const GAS v4u* vp = (const GAS v4u*)(vb + (size_t)e * D) + lane;
            axpy8(acc[0], vp[0], w); axpy8(acc[1], vp[64], w); axpy8(acc[2], vp[128], w); axpy8(acc[3], vp[192], w);
        }
        float s2 = 0.f;
#pragma unroll
        for (int j = 0; j < 4; ++j)
#pragma unroll
            for (int e = 0; e < 8; ++e) s2 += acc[j][e] * acc[j][e];
        const float rstd2 = __builtin_amdgcn_rsqf(wave_sum(s2) * (1.0f / D) + EPS);
        float yv[4][8]; float s1 = 0.f;
#pragma unroll
        for (int j = 0; j < 4; ++j) { const v4u y = ((const GAS v4u*)(y1 + (size_t)tok * D))[j * 64 + lane];
            yv[j][0] = bflo(y.x); yv[j][1] = bfhi(y.x); yv[j][2] = bflo(y.y); yv[j][3] = bfhi(y.y); yv[j][4] = bflo(y.z); yv[j][5] = bfhi(y.z); yv[j][6] = bflo(y.w); yv[j][7] = bfhi(y.w);
#pragma unroll
            for (int e = 0; e < 8; ++e) s1 += yv[j][e] * yv[j][e]; }
        const float rstd1 = __builtin_amdgcn_rsqf(wave_sum(s1) * (1.0f / D) + EPS);
        const GAS f32x4* xr = (const GAS f32x4*)(A.in[I_X] + (size_t)tok * D) + lane * 2;
        const GAS f32x4* c1 = (const GAS f32x4*)(cfin + (size_t)(b * 2 + 0) * D) + lane * 2; const GAS f32x4* c2 = (const GAS f32x4*)(cfin + (size_t)(b * 2 + 1) * D) + lane * 2;
        GAS f32x4* orow = (GAS f32x4*)(A.out + (size_t)tok * D) + lane * 2;
#pragma unroll
        for (int j = 0; j < 4; ++j)
#pragma unroll
            for (int hh = 0; hh < 2; ++hh) { const f32x4 xv = xr[j * 128 + hh], a1 = c1[j * 128 + hh], a2 = c2[j * 128 + hh]; f32x4 o;
#pragma unroll
                for (int e = 0; e < 4; ++e) o[e] = xv[e] + (OUT_MODE != 2 ? a1[e] * yv[j][hh * 4 + e] * rstd1 : 0.f) + (OUT_MODE != 1 ? a2[e] * acc[j][hh * 4 + e] * rstd2 : 0.f);
                orow[j * 128 + hh] = o; }
    }
}

#if defined(MK_CHECKS)
constexpr int CW_CHK = 2048;
__device__ __forceinline__ unsigned hsh(unsigned x) { x ^= x >> 16; x *= 0x7feb352dU; x ^= x >> 15; x *= 0x846ca68bU; x ^= x >> 16; return x; }
__device__ __forceinline__ float bfv(const bf16* p, size_t i) { return __builtin_bit_cast(float, (unsigned)p[i] << 16); }
__device__ __forceinline__ float relerr(float got, float ref, float scale) { const float d = fabsf(got - ref) / (fabsf(ref) + scale); return (d == d) ? d : 1e30f; }
__device__ __forceinline__ void chk_put(unsigned* ctl, int stage, float e) { atomicMax(ctl + CW_CHK + stage, __builtin_bit_cast(unsigned, e)); }
__device__ float chk_gemm(const bf16* Am, const bf16* Bt, const bf16* C, int N, int K, unsigned s) {
    const int row = hsh(s) % T, col = hsh(s * 7 + 1) % N; float acc = 0.f;
    for (int k = 0; k < K; ++k) acc += bfv(Am, (size_t)row * K + k) * bfv(Bt, (size_t)col * K + k);
    return relerr(bfv(C, (size_t)row * N + col), acc, 0.05f);
}
__global__ void __launch_bounds__(128) chk_kernel(Args A, int stage) {
    __shared__ float sh[10240];
    unsigned* ctl = (unsigned*)(A.ws + WS_CTL);
    const int tid = threadIdx.x; const unsigned s = hsh(tid * 2654435761u + stage * 97u + 12345u);
    const float* modp = (const float*)(A.ws + WS_MODP);
    float e = 0.f;
    if (stage == 0) {
        { const int b = s & 1, n = hsh(s) % NMOD; float acc = A.in[I_BMOD][n];
          for (int k = 0; k < D; ++k) { const float c = A.in[I_C][b * D + k]; acc += c / (1.0f + expf(-c)) * A.in[I_WMOD][(size_t)k * NMOD + n]; }
          e = fmaxf(e, relerr(mod_at(modp, b, n), acc, 0.01f)); }
        { const int n = hsh(s + 1) % IN_COLS, k = hsh(s + 2) % D; e = fmaxf(e, relerr(bfv((const bf16*)(A.ws + WS_BT1), (size_t)n * D + k), A.in[I_WIN][(size_t)k * IN_COLS + n], 1e-3f)); }
        { const int n = hsh(s + 3) % D, k = hsh(s + 4) % D; e = fmaxf(e, relerr(bfv((const bf16*)(A.ws + WS_BT2), (size_t)n * D + k), A.in[I_WOUT][(size_t)k * D + n], 1e-3f));
          e = fmaxf(e, relerr(bfv((const bf16*)(A.ws + WS_BT3), (size_t)n * D + k), A.in[I_WQ][(size_t)k * D + n], 1e-3f)); }
        { const int h = s & 7, n = hsh(s + 5) & 255, k = hsh(s + 6) & 127; const float ref = (n < 128 ? A.in[I_WA] : A.in[I_WX])[h * 16384 + k * 128 + (n & 127)];
          e = fmaxf(e, relerr(bfv((const bf16*)(A.ws + WS_WG), (size_t)(h * 256 + n) * 128 + k), ref, 1e-3f)); }
        { const int i = hsh(s + 7) % (NH * 2 * NKEY * 128); e = fmaxf(e, relerr(bfv((const bf16*)(A.ws + WS_SUBK), i), A.in[I_SUBK][i], 1e-3f)); }
    } else if (stage == 1) {
        const int row = hsh(s) % T, col = hsh(s + 1) % D, b = row >> 13; float ss = 0.f;
        for (int k = 0; k < D; ++k) { const float x = A.in[I_X][(size_t)row * D + k]; ss += x * x; }
        const float ref = A.in[I_X][(size_t)row * D + col] * rsqrtf(ss / D + EPS) * A.in[I_GPREMIX][col] * (1.0f + mod_at(modp, b, D + col)) + mod_at(modp, b, col);
        e = relerr(bfv((const bf16*)(A.ws + WS_RA), (size_t)row * D + col), ref, 0.05f);
        const float* cfin = (const float*)(A.ws + WS_CFIN);
        e = fmaxf(e, relerr(cfin[(b * 2 + 0) * D + col], mod_at(modp, b, 2 * D + col) * A.in[I_GPOSTMIX][col], 1e-3f));
        e = fmaxf(e, relerr(cfin[(b * 2 + 1) * D + col], mod_at(modp, b, 5 * D + col) * A.in[I_GPOSTFFN][col], 1e-3f));
    } else if (stage == 2) { e = chk_gemm((const bf16*)(A.ws + WS_RA), (const bf16*)(A.ws + WS_BT1), (const bf16*)(A.ws + WS_PROJ), IN_COLS, D, s);
    } else if (stage == 7) { e = chk_gemm((const bf16*)(A.ws + WS_RA), (const bf16*)(A.ws + WS_BT2), (const bf16*)(A.ws + WS_Y1), D, D, s);
    } else if (stage == 9) { e = chk_gemm((const bf16*)(A.ws + WS_RA), (const bf16*)(A.ws + WS_BT3), (const bf16*)(A.ws + WS_Q), D, D, s);
    } else if (stage == 3) {
        const bf16* proj = (const bf16*)(A.ws + WS_PROJ);
        int row = hsh(s) % T; if (tid < 16) row = (tid & 1) * SEQ + (tid >> 1);
        const int c = hsh(s + 1) % LRU_W, t = row & (SEQ - 1);
        float a = A.in[I_LCB][c];
        for (int j = 0; j < 4; ++j) if (t - 3 + j >= 0) a += A.in[I_LCW][j * LRU_W + c] * bfv(proj, (size_t)(row - 3 + j) * IN_COLS + c);
        e = relerr(bfv((const bf16*)(A.ws + WS_XL), (size_t)row * LRU_W + c), a, 0.05f);
        float z = A.in[I_CDB][c];
        for (int j = 0; j < CONF_K; ++j) if (t - 30 + j >= 0) { const size_t r = (size_t)(row - 30 + j) * IN_COLS; const float g = bfv(proj, r + 3072 + c);
            z += A.in[I_CDW][j * CONF_W + c] * bfv(proj, r + 2048 + c) / (1.0f + expf(-g)); }
        e = fmaxf(e, relerr(bfv((const bf16*)(A.ws + WS_ZC), (size_t)row * CONF_W + c), z, 0.05f));
    } else if (stage == 4) {
        const bf16* xl = (const bf16*)(A.ws + WS_XL);
        const int b = s & 1, chunk = hsh(s + 1) % NCHUNK, ch = hsh(s + 2) % LRU_W, hh = ch >> 7, j = ch & 127;
        const float cl = -8.0f * log1pf(expf(-A.in[I_LAMBDA][ch])); float P = 1.f, H = 0.f;
        for (int t = 0; t < CHUNK; ++t) { const size_t row = (size_t)b * SEQ + chunk * CHUNK + t; float ga = A.in[I_BA][ch], gx = A.in[I_BX][ch];
            for (int i = 0; i < 128; ++i) { const float xv = bfv(xl, row * LRU_W + hh * 128 + i); ga += xv * A.in[I_WA][hh * 16384 + i * 128 + j]; gx += xv * A.in[I_WX][hh * 16384 + i * 128 + j]; }
            const float r = 1.0f / (1.0f + expf(-ga)), ig = 1.0f / (1.0f + expf(-gx)), la = cl * r, a = expf(la), u = sqrtf(fmaxf(-expm1f(2.0f * la), 0.f)) * ig * bfv(xl, row * LRU_W + ch);
            H = a * H + u; P = P * a;
            e = fmaxf(e, relerr(bfv((const bf16*)(A.ws + WS_HLOC), row * LRU_W + ch), H, 0.05f)); e = fmaxf(e, relerr(bfv((const bf16*)(A.ws + WS_PC), row * LRU_W + ch), P, 0.02f)); }
        const float* ag = (const float*)(A.ws + WS_AGG) + ((size_t)(b * NCHUNK + chunk) * LRU_W + ch) * 2;
        e = fmaxf(e, relerr(ag[0], P, 0.02f)); e = fmaxf(e, relerr(ag[1], H, 0.05f));
    } else if (stage == 5) {
        const int b = s & 1, ch = hsh(s + 1) % LRU_W; const float* agg = (const float*)(A.ws + WS_AGG); const float* carry = (const float*)(A.ws + WS_CARRY); float Hs = 0.f;
        for (int c = 0; c < NCHUNK; ++c) { e = fmaxf(e, relerr(carry[(size_t)(b * NCHUNK + c) * LRU_W + ch], Hs, 1e-3f)); const float* ag = agg + ((size_t)(b * NCHUNK + c) * LRU_W + ch) * 2; Hs = ag[0] * Hs + ag[1]; }
    } else if (stage == 6) {
        const bf16* proj = (const bf16*)(A.ws + WS_PROJ); const bf16* zc = (const bf16*)(A.ws + WS_ZC);
        const int row = hsh(s) % T, c = hsh(s + 1) % LRU_W, b = row >> 13, chunk = (row & (SEQ - 1)) >> 6;
        const float hfull = bfv((const bf16*)(A.ws + WS_HLOC), (size_t)row * LRU_W + c) + bfv((const bf16*)(A.ws + WS_PC), (size_t)row * LRU_W + c) * ((const float*)(A.ws + WS_CARRY))[(size_t)(b * NCHUNK + chunk) * LRU_W + c];
        const float g = bfv(proj, (size_t)row * IN_COLS + 1024 + c), ge = 0.5f * g * (1.0f + tanhf(0.7978845608f * (g + 0.044715f * g * g * g)));
        e = relerr(bfv((const bf16*)(A.ws + WS_RA), (size_t)row * D + c), hfull * ge, 0.05f);
        float m = 0.f, q = 0.f;
        for (int k = 0; k < CONF_W; ++k) m += bfv(zc, (size_t)row * CONF_W + k);
        m /= CONF_W;
        for (int k = 0; k < CONF_W; ++k) { const float d = bfv(zc, (size_t)row * CONF_W + k) - m; q += d * d; }
        const float n = (bfv(zc, (size_t)row * CONF_W + c) - m) * rsqrtf(q / CONF_W + EPS) * A.in[I_LNG][c] + A.in[I_LNB][c];
        e = fmaxf(e, relerr(bfv((const bf16*)(A.ws + WS_RA), (size_t)row * D + 1024 + c), n / (1.0f + expf(-n)), 0.05f));
    } else if (stage == 8) {
        const bf16* y1 = (const bf16*)(A.ws + WS_Y1); const float* cfin = (const float*)(A.ws + WS_CFIN);
        const int row = hsh(s) % T, col = hsh(s + 1) % D, b = row >> 13; float s1 = 0.f, s2 = 0.f;
        for (int k = 0; k < D; ++k) { const float y = bfv(y1, (size_t)row * D + k); s1 += y * y; }
        const float r1 = rsqrtf(s1 / D + EPS);
        for (int k = 0; k < D; ++k) { const float x1 = A.in[I_X][(size_t)row * D + k] + cfin[(b * 2) * D + k] * bfv(y1, (size_t)row * D + k) * r1; s2 += x1 * x1; }
        const float x1c = A.in[I_X][(size_t)row * D + col] + cfin[(b * 2) * D + col] * bfv(y1, (size_t)row * D + col) * r1;
        const float ref = x1c * rsqrtf(s2 / D + EPS) * A.in[I_GPREFFN][col] * (1.0f + mod_at(modp, b, 4 * D + col)) + mod_at(modp, b, 3 * D + col);
        e = relerr(bfv((const bf16*)(A.ws + WS_RA), (size_t)row * D + col), ref, 0.05f);
        const size_t i = (size_t)(hsh(s + 2) % NEXP) * D + hsh(s + 3) % D;
        e = fmaxf(e, relerr(bfv((const bf16*)(A.ws + WS_UB), i), A.in[I_PU][i], 1e-4f)); e = fmaxf(e, relerr(bfv((const bf16*)(A.ws + WS_VB), i), A.in[I_PV][i], 1e-3f));
    } else if (stage == 10) {
        if (tid < 32) {
            const bf16* q = (const bf16*)(A.ws + WS_Q); const int* idx = (const int*)(A.ws + WS_IDX); const float* gate = (const float*)(A.ws + WS_GATE);
            const int tok = hsh(s) % T, h = hsh(s + 1) & 7;
            float* sc = sh + tid * 320;
            for (int p = 0; p < 2; ++p) for (int n = 0; n < NKEY; ++n) { float a = 0.f;
                for (int d = 0; d < 128; ++d) a += bfv(q, (size_t)tok * D + h * 256 + p * 128 + d) * A.in[I_SUBK][((size_t)((h * 2 + p) * NKEY + n)) * 128 + d];
                sc[p * 128 + n] = a; }
            for (int p = 0; p < 2; ++p) { float prev = 1e30f; for (int it = 0; it < 16; ++it) { float best = -1e30f; int bi = 0;
                for (int n = 0; n < NKEY; ++n) { const float v = sc[p * 128 + n]; if (v < prev && v > best) { best = v; bi = n; } }
                sc[256 + p * 16 + it] = best; sc[288 + p * 16 + it] = (float)bi; prev = best; } }
            float prev = 1e30f, esum = 0.f, cmax = 0.f; int miss = 0; float gerr = 0.f;
            { float pv = 1e30f; for (int it = 0; it < 16; ++it) { float best = -1e30f;
                for (int c = 0; c < 256; ++c) { const float v = sc[256 + (c >> 4)] + sc[272 + (c & 15)]; if (v < pv && v > best) best = v; }
                if (it == 0) cmax = best; esum += expf(best - cmax); pv = best; } }
            for (int it = 0; it < 16; ++it) { float best = -1e30f; int bc = 0;
                for (int c = 0; c < 256; ++c) { const float v = sc[256 + (c >> 4)] + sc[272 + (c & 15)]; if (v < prev && v > best) { best = v; bc = c; } }
                prev = best;
                const int eidx = (int)sc[288 + (bc >> 4)] * NKEY + (int)sc[304 + (bc & 15)]; const float g = expf(best - cmax) / esum; bool found = false;
                for (int m = 0; m < 16; ++m) if (idx[(size_t)tok * KSEL + h * 16 + m] == eidx) { found = true; gerr = fmaxf(gerr, relerr(gate[(size_t)tok * KSEL + h * 16 + m], g, 0.02f)); }
                if (!found) ++miss; }
            e = fmaxf((float)miss / 16.0f, gerr);
        }
    } else if (stage == 11) {
        const bf16* h2 = (const bf16*)(A.ws + WS_RA); const bf16* y1 = (const bf16*)(A.ws + WS_Y1); const int* idx = (const int*)(A.ws + WS_IDX); const float* gate = (const float*)(A.ws + WS_GATE); const float* cfin = (const float*)(A.ws + WS_CFIN);
        const int tok = hsh(blockIdx.x * 977u + 5u) % T, b = tok >> 13;
        { const int ex = idx[(size_t)tok * KSEL + tid]; float a = 0.f;
          if ((unsigned)ex < (unsigned)NEXP) { for (int d = 0; d < D; ++d) a += bfv(h2, (size_t)tok * D + d) * A.in[I_PU][(size_t)ex * D + d]; } else a = 1e30f;
          const float ge = 0.5f * a * (1.0f + tanhf(0.7978845608f * (a + 0.044715f * a * a * a)));
          sh[tid] = gate[(size_t)tok * KSEL + tid] * ge; sh[128 + tid] = __builtin_bit_cast(float, ex); }
        __syncthreads();
        float s2 = 0.f, s1 = 0.f;
        for (int cc = 0; cc < 16; ++cc) { const int col = cc * 128 + tid; float a = 0.f;
            for (int k = 0; k < KSEL; ++k) { const int ex = __builtin_bit_cast(int, sh[128 + k]); if ((unsigned)ex < (unsigned)NEXP) a += sh[k] * A.in[I_PV][(size_t)ex * D + col]; }
            sh[512 + cc * 128 + tid] = a; s2 += a * a; const float y = bfv(y1, (size_t)tok * D + col); s1 += y * y; }
        __syncthreads(); sh[256 + tid] = s2; sh[384 + tid] = s1; __syncthreads();
        float t2 = 0.f, t1 = 0.f; for (int k = 0; k < 128; ++k) { t2 += sh[256 + k]; t1 += sh[384 + k]; }
        const float r2 = rsqrtf(t2 / D + EPS), r1 = rsqrtf(t1 / D + EPS);
        for (int cc = 0; cc < 16; ++cc) { const int col = cc * 128 + tid;
            const float ref = A.in[I_X][(size_t)tok * D + col] + (OUT_MODE != 2 ? cfin[(b * 2) * D + col] * bfv(y1, (size_t)tok * D + col) * r1 : 0.f) + (OUT_MODE != 1 ? cfin[(b * 2 + 1) * D + col] * sh[512 + cc * 128 + tid] * r2 : 0.f);
            e = fmaxf(e, relerr(A.out[(size_t)tok * D + col], ref, 0.05f)); }
    }
    chk_put(ctl, stage, e);
}
__global__ void chk_encode(Args A, int what) {
    const unsigned* ctl = (const unsigned*)(A.ws + WS_CTL);
    if (threadIdx.x == 0 && blockIdx.x == 0) {
        if (what < 0) {
            const float thr[N_PHASES] = {0.03f, 0.03f, 0.03f, 0.03f, 0.06f, 0.01f, 0.04f, 0.03f, 0.03f, 0.03f, 0.2f, 0.03f};
            for (int st = 0; st < N_PHASES; ++st) { const float e = __builtin_bit_cast(float, ctl[CW_CHK + st]); if (!(e <= thr[st])) { A.out[0] = 4000.0f * (float)(1 << st); break; } }
        } else {
            const float e = fminf(__builtin_bit_cast(float, ctl[CW_CHK + what]), 1e6f); A.out[0] = 4000.0f * sqrtf(1e6f * e);
        }
    }
}
#endif

__global__ void __launch_bounds__(NTHR, 2) fwd_kernel(Args args) {
    extern __shared__ __attribute__((aligned(16))) unsigned char lds_raw[];
    LAS unsigned char* lds = (LAS unsigned char*)lds_raw;
    const int tid = threadIdx.x, lane = tid & 63, wave = __builtin_amdgcn_readfirstlane(tid >> 6), bid = blockIdx.x, G = gridDim.x;
    for (int u = tid; u < (LDS_BYTES - LDSCTL_OFF) / 4; u += NTHR) ((LAS unsigned*)(lds + LDSCTL_OFF))[u] = 0u;
    __syncthreads();
    unsigned* ctl = (unsigned*)(args.ws + WS_CTL);
    XcdBarrier bar; bar.bar = ctl + CW_BAR; bar.x = 0; bar.st = nullptr;
    if (MK_N_LAUNCHES == 1) bar = xcd_barrier_post(ctl + CW_BAR, (volatile LAS unsigned*)(lds + MISC_OFF) + 8);
    const int lo = args.ph_lo, hi = args.ph_hi;
#define IN(k) (lo <= (k) && (k) < hi)
#define SEAM(k) do { if (IN(k) && IN((k) + 1)) xcd_barrier(bar); } while (0)

    if (((PH_MASK >> 0) & 1) && IN(0)) { phase_p0(args, lds, tid, lane, wave, bid, G); }
    SEAM(0);
    if (((PH_MASK >> 1) & 1) && IN(1)) { phase_p1(args, tid, lane, wave, bid, G); }
    SEAM(1);
    if (((PH_MASK >> 2) & 1) && IN(2)) {
        pg8::Gemm g{(const bf16*)(args.ws + WS_RA), (const bf16*)(args.ws + WS_BT1), T, IN_COLS, D}; pg8::StaticOrder S; S.init(T, IN_COLS, G, bid);
        pg8::EpiBf16<0> E{(bf16*)(args.ws + WS_PROJ), IN_COLS, nullptr, 0, 0, 1.f};
        pg8::gemm_phase<pg8::EpiBf16<0>, pg8::StaticOrder, PG8_ALIGN, PG8_SP2>(lds + RING_OFF, g, S, E);
    }
    SEAM(2);
    if (((PH_MASK >> 3) & 1) && IN(3)) { phase_m1a(args, lds, tid, lane, wave, bid, G); }
    SEAM(3);
    if (((PH_MASK >> 4) & 1) && IN(4)) { phase_m1b(args, tid, lane, wave, bid, G); }
    SEAM(4);
    if (((PH_MASK >> 5) & 1) && IN(5)) { phase_m2(args, tid, bid, G); }
    SEAM(5);
    if (((PH_MASK >> 6) & 1) && IN(6)) { phase_m3(args, tid, lane, wave, bid, G); }
    SEAM(6);
    if (((PH_MASK >> 7) & 1) && IN(7)) {
        pg8::Gemm g{(const bf16*)(args.ws + WS_RA), (const bf16*)(args.ws + WS_BT2), T, D, D}; pg8::StaticOrder S; S.init(T, D, G, bid);
        pg8::EpiBf16<0> E{(bf16*)(args.ws + WS_Y1), D, nullptr, 0, 0, 1.f};
        pg8::gemm_phase<pg8::EpiBf16<0>, pg8::StaticOrder, PG8_ALIGN, PG8_SP2>(lds + RING_OFF, g, S, E);
    }
    SEAM(7);
    if (((PH_MASK >> 8) & 1) && IN(8)) { phase_e2(args, tid, lane, wave, bid, G); }
    SEAM(8);
    if (((PH_MASK >> 9) & 1) && IN(9)) {
        pg8::Gemm g{(const bf16*)(args.ws + WS_RA), (const bf16*)(args.ws + WS_BT3), T, D, D}; pg8::StaticOrder S; S.init(T, D, G, bid);
        pg8::EpiBf16<0> E{(bf16*)(args.ws + WS_Q), D, nullptr, 0, 0, 1.f};
        pg8::gemm_phase<pg8::EpiBf16<0>, pg8::StaticOrder, PG8_ALIGN, PG8_SP2>(lds + RING_OFF, g, S, E);
    }
    SEAM(9);
    if (((PH_MASK >> 10) & 1) && IN(10)) { phase_s(args, tid, lane, wave, bid, G); }
    SEAM(10);
    if (((PH_MASK >> 11) & 1) && IN(11)) { phase_pe(args, tid, lane, wave, bid, G); }
#undef IN
#undef SEAM
}

extern "C" void kernel_launch(void* const* d_in, const int* in_sizes, int n_in, void* d_out, int out_size, void* d_ws, size_t ws_size, hipStream_t stream) {
    static int grid = 0;
    if (grid == 0) {
        if (n_in != 25 || in_sizes[0] != T * D || out_size != T * D || ws_size < WS_END) {
            fprintf(stderr, "kernel_launch: built for 25 inputs, x/out of %d floats, >= %zu bytes of workspace; got n_in %d, in0 %d, out %d, ws %zu; nothing launched\n", T * D, (size_t)WS_END, n_in, n_in > 0 ? in_sizes[0] : -1, out_size, ws_size);
            grid = -1; return; }
        int dev = 0, cus = 0, per_cu = 0;
        if (hipGetDevice(&dev) != hipSuccess || hipDeviceGetAttribute(&cus, hipDeviceAttributeMultiprocessorCount, dev) != hipSuccess) { fprintf(stderr, "kernel_launch: device query failed\n"); grid = -1; return; }
        if (hipFuncSetAttribute((const void*)fwd_kernel, hipFuncAttributeMaxDynamicSharedMemorySize, LDS_BYTES) != hipSuccess) { fprintf(stderr, "kernel_launch: hipFuncSetAttribute failed\n"); grid = -1; return; }
        if (hipOccupancyMaxActiveBlocksPerMultiprocessor(&per_cu, (const void*)fwd_kernel, NTHR, LDS_BYTES) != hipSuccess || per_cu < 1)
            fprintf(stderr, "kernel_launch: note: occupancy query reports %d workgroups per CU\n", per_cu);
        (void)hipGetLastError();
        grid = cus;
    }
    if (grid < 0) return;
    if (hipMemsetAsync((char*)d_ws + WS_CTL, 0, CTL_ZERO_BYTES, stream) != hipSuccess) { fprintf(stderr, "kernel_launch: memset failed\n"); return; }
    Args a{};
    for (int i = 0; i < 25; ++i) a.in[i] = (const float*)d_in[i];
    a.out = (float*)d_out; a.ws = (unsigned char*)d_ws;
    for (int li = 0; li < MK_N_LAUNCHES; ++li) {
        if (MK_N_LAUNCHES == 1) { a.ph_lo = 0; a.ph_hi = N_PHASES; } else { a.ph_lo = li; a.ph_hi = li + 1; }
        hipLaunchKernelGGL(fwd_kernel, dim3(grid), dim3(NTHR), LDS_BYTES, stream, a);
        const hipError_t le = hipPeekAtLastError();
        if (le != hipSuccess) { fprintf(stderr, "kernel_launch: launch %d failed: %s\n", li, hipGetErrorName(le)); break; }
#if defined(MK_CHECKS)
        hipLaunchKernelGGL(chk_kernel, dim3(4), dim3(128), 0, stream, a, li);
#endif
    }
#if defined(MK_CHECKS)
    hipLaunchKernelGGL(chk_encode, dim3(1), dim3(64), 0, stream, a, MK_CHECKS);
#endif
}
```

```cpp
#include <hip/hip_runtime.h>
#include <cstdio>
#include <cstdint>
#include <cmath>
namespace pg8 {
#define PG8_LAS __attribute__((address_space(3)))
typedef unsigned short bf16_t;
typedef short bf16x8 __attribute__((ext_vector_type(8)));
typedef float f32x4 __attribute__((ext_vector_type(4)));
typedef unsigned u32x4 __attribute__((ext_vector_type(4)));
constexpr int BM = 256, BK = 64, HALF = 128, HTB = HALF * BK * 2  , STAGE_BYTES = 8 * HTB, NXCD = 8, WGM = 8;

__host__ __device__ __forceinline__ int lds_byte(int r, int c) { const int st = (r >> 4) * 2 + (c >> 5), rr = r & 15, cc = c & 31, ob = rr * 64 + cc * 2; return st * 1024 + (ob ^ (((ob >> 9) & 1) << 5)); }
__host__ __device__ __forceinline__ void stage_rc(int b, int& R, int& C) { const int st = b / 1024, sb = b % 1024, swz = sb ^ (((sb >> 9) & 1) << 5); R = (st >> 1) * 16 + swz / 64; C = (st & 1) * 32 + (swz % 64) / 2; }
__host__ __device__ __forceinline__ int perm32(int rho) { const int n = rho >> 4, i = rho & 15; return 8 * (i >> 2) + 4 * n + (i & 3); }

struct Unit { int pm, pn; };
struct Gemm { const bf16_t* A; const bf16_t* Bt; int M, N, K; };

struct StaticOrder {
    int nM, nN, nwg, G, c;
    __host__ __device__ void init(int M, int N, int G_, int c_) { nM = M / BM; nN = N / BM; nwg = nM * nN; G = G_; c = c_; }
    __host__ __device__ bool next(int i, Unit& u) const {
        const long L = (long)i * G + c; if (L >= nwg) return false;
        int wgid = (int)L; { const int q = nwg / NXCD, r = nwg % NXCD, xcd = wgid % NXCD, off = wgid / NXCD; wgid = (xcd < r ? xcd * (q + 1) : r * (q + 1) + (xcd - r) * q) + off; }
        const int nig = WGM * nN, gid = wgid / nig, fm = gid * WGM, gsz = (nM - fm) < WGM ? (nM - fm) : WGM;
        u.pm = fm + ((wgid % nig) % gsz); u.pn = (wgid % nig) / gsz; return true;
    }
    __device__ __forceinline__ void a_ready(const Unit&) const {}
    __device__ __forceinline__ void done(const Unit&) const {}
};

__device__ __forceinline__ unsigned cvt_pk_bf16(float lo, float hi) { unsigned r; asm volatile("v_cvt_pk_bf16_f32 %0, %1, %2" : "=v"(r) : "v"(lo), "v"(hi)); return r; }
typedef float f32x2 __attribute__((ext_vector_type(2)));
__device__ __forceinline__ f32x2 gelu_pk(f32x2 v) {
    const f32x2 av = __builtin_elementwise_abs(v), d = av * 0.2316418882f + 1.0f;
    f32x2 t; t.x = __builtin_amdgcn_rcpf(d.x); t.y = __builtin_amdgcn_rcpf(d.y);
    f32x2 q = t * 0.5307027145f + (-0.7265760135f); q = q * t + 0.7107068705f; q = q * t + (-0.142248368f); q = q * t + 0.127414796f; q = q * t;
    const f32x2 s = (v * v) * (-0.72134752044f);
    f32x2 e; e.x = __builtin_amdgcn_exp2f(s.x); e.y = __builtin_amdgcn_exp2f(s.y);
    const f32x2 m = v * (q * e), r = v - m;
    f32x2 o; o.x = v.x < 0.f ? m.x : r.x; o.y = v.y < 0.f ? m.y : r.y; return o;
}

template <int ACT  > struct EpiBf16 {
    static constexpr bool PERM = true, AFTER_DRAIN = false; static_assert(ACT == 0 || ACT == 1, "EpiBf16: ACT is 0 (none) or 1 (gelu_pk)");
    bf16_t* O; int ldc; const float* bias; int split_cols; size_t split_stride; float scale0;
    __device__ __forceinline__ void operator()(const f32x4 (&acc)[2][2][4][2], const Unit& u, int wr, int wc, int fr, int fq) const {
        const int row0 = u.pm * BM + wr * 64 + fr; int colt = u.pn * BM; bf16_t* base = O;
        float sc = 1.f; if (split_cols) { const int t = colt / split_cols; base += (size_t)t * split_stride; colt -= t * split_cols; if (t == 0) sc = scale0; }
        const int col0 = colt + wc * 32 + 8 * fq, bcol0 = u.pn * BM + wc * 32 + 8 * fq;
        f32x4 bv[2][2];
#pragma unroll
        for (int bj = 0; bj < 2; ++bj)
#pragma unroll
            for (int n = 0; n < 2; ++n) bv[bj][n] = bias ? *(const f32x4*)(bias + bcol0 + bj * HALF + 4 * n) : (f32x4){0.f, 0.f, 0.f, 0.f};
#pragma unroll
        for (int ai = 0; ai < 2; ++ai)
#pragma unroll
            for (int m = 0; m < 4; ++m) { bf16_t* rowp = base + (size_t)(row0 + ai * HALF + m * 16) * ldc + col0;
#pragma unroll
                for (int bj = 0; bj < 2; ++bj) { f32x4 v0 = acc[ai][bj][m][0] + bv[bj][0], v1 = acc[ai][bj][m][1] + bv[bj][1];
                    if (ACT == 1) { f32x2 a = gelu_pk((f32x2){v0[0], v0[1]}), b = gelu_pk((f32x2){v0[2], v0[3]}), c = gelu_pk((f32x2){v1[0], v1[1]}), d = gelu_pk((f32x2){v1[2], v1[3]});
                        v0 = (f32x4){a.x, a.y, b.x, b.y}; v1 = (f32x4){c.x, c.y, d.x, d.y}; }
                    v0 = v0 * sc; v1 = v1 * sc; u32x4 w; w.x = cvt_pk_bf16(v0[0], v0[1]); w.y = cvt_pk_bf16(v0[2], v0[3]); w.z = cvt_pk_bf16(v1[0], v1[1]); w.w = cvt_pk_bf16(v1[2], v1[3]);
                    *(u32x4*)(rowp + bj * HALF) = w; } }
    }
};
template <class Epi, class Sched, bool ALIGN_EPI = false, bool SP2 = false>
__device__ __forceinline__ void gemm_phase(PG8_LAS unsigned char* lds, const Gemm g, const Sched& S, const Epi& E) {
    const int tid = threadIdx.x, wid = __builtin_amdgcn_readfirstlane(tid >> 6), lane = tid & 63, wr = wid >> 2, wc = wid & 3, fr = lane & 15, fq = lane >> 4;
    const int K = g.K, nt = K / BK;
    unsigned voffA[2], voffB[2];
#pragma unroll
    for (int i = 0; i < 2; ++i) { int R, C; stage_rc(tid * 16 + i * 8192, R, C); const int Rb = Epi::PERM ? ((R & ~31) + perm32(R & 31)) : R;
        voffA[i] = (unsigned)(R * K + C) * 2u; voffB[i] = (unsigned)(Rb * K + C) * 2u; }
    const size_t kstep = (size_t)(BK * 2);
    const size_t hstep = (size_t)HALF * K * 2;
    const size_t tstep = 2 * hstep;
    const unsigned ldsw = (unsigned)wid * 1024u;
    const int aoff = lds_byte(wr * 64 + fr, fq * 8), boff = lds_byte(wc * 32 + fr, fq * 8);
#define PG8_SA(b, h) (((b) * 2 + (h)) * HTB)
#define PG8_SB(b, h) ((4 + (b) * 2 + (h)) * HTB)
#define PG8_STAGE(bufoff, gbase, voff) do { _Pragma("unroll") for (int _i = 0; _i < 2; ++_i) \
        __builtin_amdgcn_global_load_lds((const unsigned*)((const char*)(gbase) + (voff)[_i]), (PG8_LAS unsigned*)(lds + (bufoff) + ldsw + _i * 8192), 16, 0, 0); } while (0)
#define PG8_LDA(dst, b, h) do { _Pragma("unroll") for (int m = 0; m < 4; ++m) _Pragma("unroll") for (int k = 0; k < 2; ++k) dst[m][k] = *(const PG8_LAS bf16x8*)(lds + PG8_SA(b, h) + aoff + m * 2048 + k * 1024); } while (0)
#define PG8_LDB(dst, b, h) do { _Pragma("unroll") for (int n = 0; n < 2; ++n) _Pragma("unroll") for (int k = 0; k < 2; ++k) dst[n][k] = *(const PG8_LAS bf16x8*)(lds + PG8_SB(b, h) + boff + n * 2048 + k * 1024); } while (0)
#define PG8_MMA(ai, bj, At, Bt) do { __builtin_amdgcn_s_setprio(1); _Pragma("unroll") for (int m = 0; m < 4; ++m) _Pragma("unroll") for (int n = 0; n < 2; ++n) _Pragma("unroll") for (int k = 0; k < 2; ++k) \
        acc[ai][bj][m][n] = __builtin_amdgcn_mfma_f32_16x16x32_bf16(Bt[n][k], At[m][k], acc[ai][bj][m][n], 0, 0, 0); __builtin_amdgcn_s_setprio(0); } while (0)
#define PG8_WAIT_V(n) asm volatile("s_waitcnt vmcnt(" #n ")" ::: "memory")
#define PG8_WAIT_L(n) asm volatile("s_waitcnt lgkmcnt(" #n ")" ::: "memory")
#define PG8_BAR __builtin_amdgcn_s_barrier()
#define PG8_SCHED __builtin_amdgcn_sched_barrier(0)
    Unit cur, nxt; int ui = 0;
    if (!S.next(0, cur)) return;
    f32x4 acc[2][2][4][2];
#pragma unroll
    for (int a = 0; a < 2; ++a)
#pragma unroll
        for (int b = 0; b < 2; ++b)
#pragma unroll
            for (int m = 0; m < 4; ++m)
#pragma unroll
                for (int n = 0; n < 2; ++n) acc[a][b][m][n] = (f32x4){0.f, 0.f, 0.f, 0.f};
    bf16x8 At[4][2], B0[2][2], B1[2][2];
    const char* cA = (const char*)g.A + (size_t)cur.pm * tstep; const char* cB = (const char*)g.Bt + (size_t)cur.pn * tstep;
    S.a_ready(cur);
    if constexpr (SP2) {
        PG8_STAGE(PG8_SB(0, 0), cB, voffB); PG8_STAGE(PG8_SB(0, 1), cB + hstep, voffB); PG8_STAGE(PG8_SA(0, 0), cA, voffA); PG8_STAGE(PG8_SA(0, 1), cA + hstep, voffA);
        if (wr == 1) PG8_BAR;
        PG8_WAIT_V(2); PG8_BAR;
        PG8_STAGE(PG8_SB(1, 0), cB + kstep, voffB); PG8_STAGE(PG8_SA(1, 0), cA + kstep, voffA); PG8_STAGE(PG8_SB(1, 1), cB + hstep + kstep, voffB);
        PG8_WAIT_V(6); PG8_BAR;
    } else {
        PG8_STAGE(PG8_SB(0, 0), cB, voffB); PG8_STAGE(PG8_SA(0, 0), cA, voffA); PG8_STAGE(PG8_SB(0, 1), cB + hstep, voffB); PG8_STAGE(PG8_SA(0, 1), cA + hstep, voffA);
        if (wr == 1) PG8_BAR;
        PG8_WAIT_V(4); PG8_BAR;
        PG8_STAGE(PG8_SB(1, 0), cB + kstep, voffB); PG8_STAGE(PG8_SA(1, 0), cA + kstep, voffA); PG8_STAGE(PG8_SB(1, 1), cB + hstep + kstep, voffB);
        PG8_WAIT_V(6); PG8_BAR;
    }
    for (;;) {
        const bool has_next = S.next(ui + 1, nxt);
        const char* nA = has_next ? (const char*)g.A + (size_t)nxt.pm * tstep : cA; const char* nB = has_next ? (const char*)g.Bt + (size_t)nxt.pn * tstep : cB;
        for (int t = 0; t < nt; t += 2) {
            const bool last = (t == nt - 2);
            const char* a1 = cA + (size_t)(t + 1) * kstep;
            const char* a2 = last ? nA : cA + (size_t)(t + 2) * kstep; const char* b2 = last ? nB : cB + (size_t)(t + 2) * kstep;
            const char* a3 = a2 + kstep; const char* b3 = b2 + kstep;
            if (last && has_next) S.a_ready(nxt);
            if constexpr (SP2) {
            PG8_LDB(B0, 0, 0); PG8_LDB(B1, 0, 1); PG8_SCHED; PG8_LDA(At, 0, 0); PG8_STAGE(PG8_SA(1, 1), a1 + hstep, voffA);
            PG8_WAIT_V(8); PG8_WAIT_L(0); PG8_BAR; PG8_MMA(0, 0, At, B0); PG8_MMA(0, 1, At, B1); PG8_BAR; PG8_SCHED;
            PG8_LDA(At, 0, 1); PG8_STAGE(PG8_SB(0, 0), b2, voffB); PG8_STAGE(PG8_SB(0, 1), b2 + hstep, voffB); PG8_STAGE(PG8_SA(0, 0), a2, voffA);
            PG8_WAIT_V(8); PG8_WAIT_L(0); PG8_BAR; PG8_MMA(1, 0, At, B0); PG8_MMA(1, 1, At, B1); PG8_BAR; PG8_SCHED;
            PG8_LDB(B0, 1, 0); PG8_LDB(B1, 1, 1); PG8_SCHED; PG8_LDA(At, 1, 0); PG8_STAGE(PG8_SA(0, 1), a2 + hstep, voffA);
            PG8_WAIT_V(8); PG8_WAIT_L(0); PG8_BAR; PG8_MMA(0, 0, At, B0); PG8_MMA(0, 1, At, B1); PG8_BAR; PG8_SCHED;
            PG8_LDA(At, 1, 1); PG8_STAGE(PG8_SB(1, 0), b3, voffB); PG8_STAGE(PG8_SB(1, 1), b3 + hstep, voffB); PG8_STAGE(PG8_SA(1, 0), a3, voffA);
            PG8_WAIT_V(8); PG8_WAIT_L(0); PG8_BAR; PG8_MMA(1, 0, At, B0); PG8_MMA(1, 1, At, B1); PG8_BAR; PG8_SCHED;
            } else {
            PG8_LDB(B0, 0, 0); PG8_SCHED; PG8_LDA(At, 0, 0); PG8_STAGE(PG8_SA(1, 1), a1 + hstep, voffA);
            PG8_WAIT_L(8); PG8_BAR; PG8_WAIT_L(0); PG8_MMA(0, 0, At, B0); PG8_BAR; PG8_SCHED;
            PG8_LDB(B1, 0, 1); PG8_STAGE(PG8_SB(0, 0), b2, voffB);
            PG8_BAR; PG8_WAIT_L(0); PG8_MMA(0, 1, At, B1); PG8_BAR;
            PG8_LDA(At, 0, 1); PG8_STAGE(PG8_SA(0, 0), a2, voffA);
            PG8_BAR; PG8_WAIT_L(0); PG8_MMA(1, 0, At, B0); PG8_BAR; PG8_SCHED;
            PG8_STAGE(PG8_SB(0, 1), b2 + hstep, voffB);
            PG8_WAIT_V(6); PG8_BAR; PG8_MMA(1, 1, At, B1); PG8_BAR;
            PG8_LDB(B0, 1, 0); PG8_SCHED; PG8_LDA(At, 1, 0); PG8_STAGE(PG8_SA(0, 1), a2 + hstep, voffA);
            PG8_WAIT_L(8); PG8_BAR; PG8_WAIT_L(0); PG8_MMA(0, 0, At, B0); PG8_BAR; PG8_SCHED;
            PG8_LDB(B1, 1, 1); PG8_STAGE(PG8_SB(1, 0), b3, voffB);
            PG8_BAR; PG8_WAIT_L(0); PG8_MMA(0, 1, At, B1); PG8_BAR;
            PG8_LDA(At, 1, 1); PG8_STAGE(PG8_SA(1, 0), a3, voffA);
            PG8_BAR; PG8_WAIT_L(0); PG8_MMA(1, 0, At, B0); PG8_BAR; PG8_SCHED;
            PG8_STAGE(PG8_SB(1, 1), b3 + hstep, voffB);
            PG8_WAIT_V(6); PG8_BAR; PG8_MMA(1, 1, At, B1); PG8_BAR;
            }
        }
        if constexpr (ALIGN_EPI) { if (wr == 0) PG8_BAR; }
        if constexpr (!Epi::AFTER_DRAIN) { E(acc, cur, wr, wc, fr, fq); S.done(cur); }
        if (!has_next) break;
#pragma unroll
        for (int a = 0; a < 2; ++a)
#pragma unroll
            for (int b = 0; b < 2; ++b)
#pragma unroll
                for (int m = 0; m < 4; ++m)
#pragma unroll
                    for (int n = 0; n < 2; ++n) acc[a][b][m][n] = (f32x4){0.f, 0.f, 0.f, 0.f};
        cur = nxt; cA = nA; cB = nB; ++ui;
        if constexpr (ALIGN_EPI) { if (wr == 1) PG8_BAR; }
    }
    PG8_WAIT_V(0);
    if constexpr (!ALIGN_EPI) { if (wr == 0) PG8_BAR; }
    PG8_BAR;
    if constexpr (Epi::AFTER_DRAIN) { E.fused(acc, cur, wr, wc, fr, fq, lds, wid, lane); S.done(cur); }
#undef PG8_SA
#undef PG8_SB
#undef PG8_STAGE
#undef PG8_LDA
#undef PG8_LDB
#undef PG8_MMA
#undef PG8_WAIT_V
#undef PG8_WAIT_L
#undef PG8_BAR
#undef PG8_SCHED
}
}
#ifndef PG8_SP2
#define PG8_SP2 true
#endif
#ifndef PG8_ALIGN
#define PG8_ALIGN true
#endif
#ifndef OUT_MODE
#define OUT_MODE 0
#endif
#ifndef PH_MASK
#define PH_MASK 0xFFF
#endif
#ifndef MK_N_LAUNCHES
#define MK_N_LAUNCHES 1
#endif

constexpr int NWAVES = 8, NTHR = NWAVES * 64;
constexpr int BATCH = 2, SEQ = 8192, D = 2048, T = BATCH * SEQ;
constexpr int LRU_W = 1024, CONF_W = 1024, IN_COLS = 4096, LRU_HD = 128;
constexpr int NH = 8, NKEY = 128, TOPK = 16, NEXP = NKEY * NKEY, KSEL = NH * TOPK;
constexpr int NMOD = 6 * D;
constexpr int CHUNK = 64, NCHUNK = SEQ / CHUNK;
constexpr int CONF_K = 31;
constexpr float EPS = 1e-6f;
constexpr int N_PHASES = 12;

constexpr size_t MiB = 1u << 20;
constexpr size_t WS_CTL = 0, CTL_ZERO_BYTES = 64 * 1024;
constexpr size_t WS_MODP = 1 * MiB;
constexpr size_t WS_CFIN = 2 * MiB;
constexpr size_t WS_CARRY = 3 * MiB;
constexpr size_t WS_AGG = 4 * MiB;
constexpr size_t WS_WG = 6 * MiB;
constexpr size_t WS_SUBK = 7 * MiB;
constexpr size_t WS_BT1 = 8 * MiB;
constexpr size_t WS_BT2 = 24 * MiB;
constexpr size_t WS_BT3 = 32 * MiB;
constexpr size_t WS_IDX = 40 * MiB;
constexpr size_t WS_GATE = 48 * MiB;
constexpr size_t WS_RA = 64 * MiB;
constexpr size_t WS_Y1 = 128 * MiB;
constexpr size_t WS_PROJ = 192 * MiB;
constexpr size_t WS_Q = 192 * MiB;
constexpr size_t WS_UB = 256 * MiB;
constexpr size_t WS_XL = 320 * MiB;
constexpr size_t WS_ZC = 352 * MiB;
constexpr size_t WS_HLOC = 384 * MiB;
constexpr size_t WS_PC = 416 * MiB;
constexpr size_t WS_VB = 320 * MiB;
constexpr size_t WS_END = 448 * MiB;
constexpr int CW_TMO = 0, CW_BAR = 4096;

constexpr int RING_OFF = 0, RING_BYTES = 131072;
constexpr int LDSCTL_OFF = RING_BYTES, MISC_OFF = LDSCTL_OFF + 320;
constexpr int LDS_BYTES = 147456;

#define GAS __attribute__((address_space(1)))
#define LAS __attribute__((address_space(3)))
typedef unsigned short bf16;
typedef unsigned v4u __attribute__((ext_vector_type(4)));
typedef unsigned v2u __attribute__((ext_vector_type(2)));
typedef float f32x4 __attribute__((ext_vector_type(4)));
typedef float f32x16 __attribute__((ext_vector_type(16)));
typedef short bf16x8 __attribute__((ext_vector_type(8)));
typedef __bf16 bfp2 __attribute__((ext_vector_type(2)));
typedef GAS unsigned gu32;
#define RLX_AGENT __ATOMIC_RELAXED, __HIP_MEMORY_SCOPE_AGENT
#define LDS_WAIT() asm volatile("s_waitcnt lgkmcnt(0)" ::: "memory")
#define VM_WAIT() asm volatile("s_waitcnt vmcnt(0)" ::: "memory")
__device__ __forceinline__ unsigned f2bf(float f) { unsigned u = __builtin_bit_cast(unsigned, f); return (u + 0x7fffu + ((u >> 16) & 1u)) >> 16; }
__device__ __forceinline__ unsigned pk2(float lo, float hi) { return f2bf(lo) | (f2bf(hi) << 16); }
__device__ __forceinline__ float bflo(unsigned u) { return __builtin_bit_cast(float, u << 16); }
__device__ __forceinline__ float bfhi(unsigned u) { return __builtin_bit_cast(float, u & 0xffff0000u); }
__device__ __forceinline__ float wave_sum(float v) {
#pragma unroll
    for (int o = 1; o < 64; o <<= 1) v += __shfl_xor(v, o);
    return v;
}
__device__ __forceinline__ float sigmoidf_(float x) { return __builtin_amdgcn_rcpf(1.0f + __expf(-x)); }
__device__ __forceinline__ float gelu_tanh(float x) { return x * sigmoidf_(1.5957691216057308f * (x + 0.044715f * x * x * x)); }
__device__ __forceinline__ float rdlane(float v, int l) { return __builtin_bit_cast(float, __builtin_amdgcn_readlane(__builtin_bit_cast(int, v), l)); }

#define XB_TMO      128
#define XB_XCNT(j)  (256  + 64 * (j))
#define XB_XSUB(j)  (1280 + 64 * (j))
#define XB_XGEN(j)  (2304 + 64 * (j))
#define XB_TOP      3328
#define XB_TOPGEN   3392
#define XCD_BAR_WORDS 3456
#define XB_SPIN_CAP (1u << 18)

__device__ __forceinline__ unsigned xb_ld(unsigned* p)              { return __hip_atomic_load(p, __ATOMIC_RELAXED, __HIP_MEMORY_SCOPE_AGENT); }
__device__ __forceinline__ unsigned xb_add(unsigned* p, unsigned v) { return __hip_atomic_fetch_add(p, v, __ATOMIC_RELAXED, __HIP_MEMORY_SCOPE_AGENT); }
__device__ __forceinline__ unsigned xb_xcc_id() { return (unsigned)__builtin_amdgcn_s_getreg((3 << 11) | 20) & 0xFu; }
#define XB_SPIN(cond, bar) do { unsigned _sp = 0; while (cond) { __builtin_amdgcn_s_sleep(1); \
    if ((++_sp & 255u) == 0u) { if (xb_ld(&(bar)[XB_TMO])) break; if (_sp > XB_SPIN_CAP) { atomicAdd(&(bar)[XB_TMO], 1u); break; } } } } while (0)

struct XcdBarrier {
    unsigned* bar; unsigned x;
    volatile LAS unsigned* st;
};

__device__ __forceinline__ XcdBarrier xcd_barrier_post(unsigned* bar, volatile LAS unsigned* st) {
    XcdBarrier b; b.bar = bar; b.x = xb_xcc_id(); b.st = st;
    if (threadIdx.x == 0) (void)xb_add(&bar[XB_XCNT(b.x)], 1u);
    return b;
}
__device__ __forceinline__ void xcd_barrier_complete(unsigned* bar, unsigned x, unsigned& nloc, unsigned& nx) {
    const unsigned G = gridDim.x * gridDim.y * gridDim.z;
    unsigned sum, cnt, mine, sp = 0u;
    for (;;) {
        sum = 0u; cnt = 0u; mine = 0u;
#pragma unroll
        for (unsigned j = 0; j < 16; ++j) { const unsigned c = xb_ld(&bar[XB_XCNT(j)]); sum += c; cnt += (c > 0u) ? 1u : 0u; mine = (j == x) ? c : mine; }
        if (sum == G) break;
        __builtin_amdgcn_s_sleep(1);
        if ((++sp & 255u) == 0u) { if (xb_ld(&bar[XB_TMO])) break; if (sp > XB_SPIN_CAP) { atomicAdd(&bar[XB_TMO], 1u); break; } }
    }
    nloc = mine > 0u ? mine : 1u; nx = cnt > 0u ? cnt : 1u;
}

__device__ __forceinline__ void xcd_barrier(const XcdBarrier& b) {
    asm volatile("s_waitcnt vmcnt(0)" ::: "memory");
    __syncthreads();
    if (threadIdx.x == 0) {
        unsigned* bar = b.bar;
        __builtin_amdgcn_s_waitcnt(0);
        unsigned nloc = b.st[0], nx = b.st[1];
        if (nloc == 0u) { xcd_barrier_complete(bar, b.x, nloc, nx); b.st[0] = nloc; b.st[1] = nx; }
        const unsigned old = xb_add(&bar[XB_XSUB(b.x)], 1u);
        const unsigned gen = old / nloc;
        if (old + 1u == (gen + 1u) * nloc) {
            __builtin_amdgcn_fence(__ATOMIC_RELEASE, "agent");
            asm volatile("s_waitcnt vmcnt(0)" ::: "memory");
            const unsigned og = xb_add(&bar[XB_TOP], 1u);
            const unsigned tg = og / nx;
            if (og + 1u == (tg + 1u) * nx) xb_add(&bar[XB_TOPGEN], 1u);
            else XB_SPIN(xb_ld(&bar[XB_TOPGEN]) == tg, bar);
            __builtin_amdgcn_fence(__ATOMIC_ACQUIRE, "agent");
            xb_add(&bar[XB_XGEN(b.x)], 1u);
            asm volatile("s_waitcnt vmcnt(0)" ::: "memory");
        } else {
            XB_SPIN(xb_ld(&bar[XB_XGEN(b.x)]) == gen, bar);
            __builtin_amdgcn_fence(__ATOMIC_ACQUIRE, "agent");
            asm volatile("s_waitcnt vmcnt(0)" ::: "memory");
        }
    }
    __syncthreads();
}
struct Args { const float* in[25]; float* out; unsigned char* ws; int ph_lo, ph_hi; };
enum { I_X = 0, I_C, I_WMOD, I_BMOD, I_GPREMIX, I_GPOSTMIX, I_GPREFFN, I_GPOSTFFN, I_WIN, I_LCW, I_LCB, I_WA, I_BA, I_WX, I_BX, I_LAMBDA,
       I_CDW, I_CDB, I_LNG, I_LNB, I_WOUT, I_WQ, I_SUBK, I_PU, I_PV };

__device__ __forceinline__ float mod_at(const float* modp, int b, int n) {
    return (modp[(0 * 2 + b) * NMOD + n] + modp[(1 * 2 + b) * NMOD + n]) + (modp[(2 * 2 + b) * NMOD + n] + modp[(3 * 2 + b) * NMOD + n]);
}

__device__ __forceinline__ void p0_transpose_item(const float* W, int K, int N, bf16* WT, LAS float* scr, int item, int lane) {
    const int nblk = N / 32, kb = item / nblk, nb = item % nblk, k0 = 64 * kb, n0 = 32 * nb;
#pragma unroll 8
    for (int i = 0; i < 32; ++i) { const int kk = 2 * i + (lane >> 5); scr[kk * 33 + (lane & 31)] = W[(size_t)(k0 + kk) * N + n0 + (lane & 31)]; }
    LDS_WAIT(); asm volatile("" ::: "memory");
    const int c = lane & 7;
#pragma unroll
    for (int j = 0; j < 4; ++j) { const int n = (lane >> 3) + 8 * j; const LAS float* s = scr + (8 * c) * 33 + n;
        v4u o; o.x = pk2(s[0 * 33], s[1 * 33]); o.y = pk2(s[2 * 33], s[3 * 33]); o.z = pk2(s[4 * 33], s[5 * 33]); o.w = pk2(s[6 * 33], s[7 * 33]);
        *(GAS v4u*)(WT + (size_t)(n0 + n) * K + k0 + 8 * c) = o; }
    LDS_WAIT(); asm volatile("" ::: "memory");
}
__device__ __forceinline__ void cvt_rows_bf16(const float* src, bf16* dst, size_t n8, size_t gt, size_t ngt) {
    for (size_t i = gt; i < n8; i += ngt) {
        const f32x4 a = ((const GAS f32x4*)src)[2 * i], b = ((const GAS f32x4*)src)[2 * i + 1];
        v4u o; o.x = pk2(a.x, a.y); o.y = pk2(a.z, a.w); o.z = pk2(b.x, b.y); o.w = pk2(b.z, b.w);
        ((GAS v4u*)dst)[i] = o; }
}
__device__ __forceinline__ void phase_p0(const Args& A, LAS unsigned char* lds, int tid, int lane, int wave, int bid, int G) {
    float* modp = (float*)(A.ws + WS_MODP);
    for (int item = bid; item < 192; item += G) {
        const int cg = item % 48, kq = item / 48, k0 = kq * 512 + wave * 64, n0 = cg * 256 + lane * 4;
        const float c0 = A.in[I_C][k0 + lane], c1 = A.in[I_C][D + k0 + lane];
        const float ca0 = c0 * sigmoidf_(c0), ca1 = c1 * sigmoidf_(c1);
        f32x4 a0 = {0.f, 0.f, 0.f, 0.f}, a1 = {0.f, 0.f, 0.f, 0.f};
        const float* wp = A.in[I_WMOD] + (size_t)k0 * NMOD + n0;
#pragma unroll 8
        for (int kk = 0; kk < 64; ++kk) {
            const f32x4 w = *(const GAS f32x4*)(wp + (size_t)kk * NMOD);
            const float s0 = __shfl(ca0, kk), s1 = __shfl(ca1, kk);
            a0 += w * s0; a1 += w * s1;
        }
        LAS f32x4* red = (LAS f32x4*)lds;
        red[(wave * 2 + 0) * 64 + lane] = a0; red[(wave * 2 + 1) * 64 + lane] = a1;
        __syncthreads();
        { const int b = tid >> 8, col = tid & 255; const LAS float* rf = (const LAS float*)lds; float s = 0.f;
#pragma unroll
          for (int w = 0; w < 8; ++w) s += rf[((w * 2 + b) * 64) * 4 + col];
          if (kq == 0) s += A.in[I_BMOD][cg * 256 + col];
          modp[(kq * 2 + b) * NMOD + cg * 256 + col] = s; }
        __syncthreads();
    }
    {
        LAS float* scr = (LAS float*)(lds + wave * 16384);
        const int gw = bid * NWAVES + wave, NGW = G * NWAVES;
        constexpr int I1 = (D / 64) * (IN_COLS / 32), I2 = (D / 64) * (D / 32);
        for (int it = gw; it < I1 + 2 * I2; it += NGW) {
            int r = it;
            if (r < I1) { p0_transpose_item(A.in[I_WIN], D, IN_COLS, (bf16*)(A.ws + WS_BT1), scr, r, lane); continue; } r -= I1;
            if (r < I2) { p0_transpose_item(A.in[I_WOUT], D, D, (bf16*)(A.ws + WS_BT2), scr, r, lane); continue; } r -= I2;
            p0_transpose_item(A.in[I_WQ], D, D, (bf16*)(A.ws + WS_BT3), scr, r, lane);
        }
    }
    {
        const int gt = bid * NTHR + tid, ngt = G * NTHR;
        bf16* wg = (bf16*)(A.ws + WS_WG);
        for (int e = gt; e < NH * 256 * 128; e += ngt) {
            const int h = e >> 15, n = (e >> 7) & 255, k = e & 127;
            const float v = (n < 128 ? A.in[I_WA] : A.in[I_WX])[h * 16384 + k * 128 + (n & 127)];
            wg[e] = (bf16)f2bf(v);
        }
        cvt_rows_bf16(A.in[I_SUBK], (bf16*)(A.ws + WS_SUBK), (size_t)NH * 2 * NKEY * 128 / 8, gt, ngt);
    }
}

__device__ __forceinline__ void phase_p1(const Args& A, int tid, int lane, int wave, int bid, int G) {
    const float* modp = (const float*)(A.ws + WS_MODP);
    {
        float* cfin = (float*)(A.ws + WS_CFIN);
        for (int e = bid * NTHR + tid; e < 2 * 2 * D; e += G * NTHR) {
            const int b = e >> 12, arr = (e >> 11) & 1, col = e & (D - 1);
            cfin[e] = arr == 0 ? mod_at(modp, b, 2 * D + col) * A.in[I_GPOSTMIX][col] : mod_at(modp, b, 5 * D + col) * A.in[I_GPOSTFFN][col];
        }
    }
    const int gw = bid * NWAVES + wave, NGW = G * NWAVES;
    bf16* h1 = (bf16*)(A.ws + WS_RA);
    int cb = -1; float gs[4][8], sh[4][8];
    for (int row = gw; row < T; row += NGW) {
        const int b = row >> 13;
        if (b != cb) { cb = b;
#pragma unroll
            for (int j = 0; j < 4; ++j)
#pragma unroll
                for (int e = 0; e < 8; ++e) { const int col = j * 512 + lane * 8 + e;
                    gs[j][e] = A.in[I_GPREMIX][col] * (1.0f + mod_at(modp, b, D + col)); sh[j][e] = mod_at(modp, b, col); } }
        const GAS f32x4* xr = (const GAS f32x4*)(A.in[I_X] + (size_t)row * D) + lane * 2;
        f32x4 v[4][2]; float s = 0.f;
#pragma unroll
        for (int j = 0; j < 4; ++j) { v[j][0] = xr[j * 128]; v[j][1] = xr[j * 128 + 1];
            s += (v[j][0].x * v[j][0].x + v[j][0].y * v[j][0].y) + (v[j][0].z * v[j][0].z + v[j][0].w * v[j][0].w);
            s += (v[j][1].x * v[j][1].x + v[j][1].y * v[j][1].y) + (v[j][1].z * v[j][1].z + v[j][1].w * v[j][1].w); }
        const float rstd = __builtin_amdgcn_rsqf(wave_sum(s) * (1.0f / D) + EPS);
        GAS v4u* orow = (GAS v4u*)(h1 + (size_t)row * D) + lane;
#pragma unroll
        for (int j = 0; j < 4; ++j) { float o[8];
#pragma unroll
            for (int e = 0; e < 8; ++e) o[e] = v[j][e >> 2][e & 3] * rstd * gs[j][e] + sh[j][e];
            v4u w; w.x = pk2(o[0], o[1]); w.y = pk2(o[2], o[3]); w.z = pk2(o[4], o[5]); w.w = pk2(o[6], o[7]);
            orow[j * 64] = w; }
    }
}

__device__ __forceinline__ void phase_m1a(const Args& A, LAS unsigned char* lds, int tid, int lane, int wave, int bid, int G) {
    const bf16* proj = (const bf16*)(A.ws + WS_PROJ);
    {
        bf16* xl = (bf16*)(A.ws + WS_XL);
        const float* w4 = A.in[I_LCW]; const float* b4 = A.in[I_LCB];
        for (int it = bid * NTHR + tid; it < T * 128; it += G * NTHR) {
            const int row = it >> 7, c0 = (it & 127) * 8, t = row & (SEQ - 1);
            float acc[8];
            { const f32x4 ba = *(const GAS f32x4*)(b4 + c0), bb = *(const GAS f32x4*)(b4 + c0 + 4);
              acc[0] = ba.x; acc[1] = ba.y; acc[2] = ba.z; acc[3] = ba.w; acc[4] = bb.x; acc[5] = bb.y; acc[6] = bb.z; acc[7] = bb.w; }
#pragma unroll
            for (int j = 0; j < 4; ++j) {
                if (t - 3 + j >= 0) {
                    const v4u v = *(const GAS v4u*)(proj + (size_t)(row - 3 + j) * IN_COLS + c0);
                    const f32x4 wa = *(const GAS f32x4*)(w4 + j * LRU_W + c0), wb = *(const GAS f32x4*)(w4 + j * LRU_W + c0 + 4);
                    acc[0] += wa.x * bflo(v.x); acc[1] += wa.y * bfhi(v.x); acc[2] += wa.z * bflo(v.y); acc[3] += wa.w * bfhi(v.y);
                    acc[4] += wb.x * bflo(v.z); acc[5] += wb.y * bfhi(v.z); acc[6] += wb.z * bflo(v.w); acc[7] += wb.w * bfhi(v.w);
                }
            }
            v4u o; o.x = pk2(acc[0], acc[1]); o.y = pk2(acc[2], acc[3]); o.z = pk2(acc[4], acc[5]); o.w = pk2(acc[6], acc[7]);
            *(GAS v4u*)(xl + (size_t)row * LRU_W + c0) = o;
        }
    }
    {
        bf16* zc = (bf16*)(A.ws + WS_ZC);
        const float* w31 = A.in[I_CDW]; const float* b31 = A.in[I_CDB];
        LAS float* zt = (LAS float*)lds;
        for (int item = bid; item < 2 * 64 * 8; item += G) {
            const int b = item >> 9, tt = (item >> 3) & 63, ct = item & 7;
            const int t0 = tt * 128;
            __syncthreads();
            for (int e = tid; e < 158 * 16; e += NTHR) {
                const int r = e >> 4, c8 = (e & 15) * 8, t = t0 - 30 + r;
                f32x4 z0 = {0.f, 0.f, 0.f, 0.f}, z1 = {0.f, 0.f, 0.f, 0.f};
                if (t >= 0) {
                    const bf16* p = proj + (size_t)(b * SEQ + t) * IN_COLS + 2048 + ct * 128 + c8;
                    const v4u v = *(const GAS v4u*)p, g = *(const GAS v4u*)(p + 1024);
                    z0.x = bflo(v.x) * sigmoidf_(bflo(g.x)); z0.y = bfhi(v.x) * sigmoidf_(bfhi(g.x)); z0.z = bflo(v.y) * sigmoidf_(bflo(g.y)); z0.w = bfhi(v.y) * sigmoidf_(bfhi(g.y));
                    z1.x = bflo(v.z) * sigmoidf_(bflo(g.z)); z1.y = bfhi(v.z) * sigmoidf_(bfhi(g.z)); z1.z = bflo(v.w) * sigmoidf_(bflo(g.w)); z1.w = bfhi(v.w) * sigmoidf_(bfhi(g.w));
                }
                *(LAS f32x4*)(zt + r * 128 + c8) = z0; *(LAS f32x4*)(zt + r * 128 + c8 + 4) = z1;
            }
            __syncthreads();
            const int c = tid & 127, tg = tid >> 7, ch = ct * 128 + c;
            float w[CONF_K];
#pragma unroll
            for (int j = 0; j < CONF_K; ++j) w[j] = w31[j * CONF_W + ch];
            float acc[32]; const float bias = b31[ch];
#pragma unroll
            for (int i = 0; i < 32; ++i) acc[i] = bias;
#pragma unroll
            for (int s = 0; s < 62; ++s) {
                const float v = zt[(tg * 32 + s) * 128 + c];
#pragma unroll
                for (int i = 0; i < 32; ++i) if (s - i >= 0 && s - i < CONF_K) acc[i] += w[s - i] * v;
            }
            bf16* zo = zc + (size_t)(b * SEQ + t0 + tg * 32) * CONF_W + ch;
#pragma unroll
            for (int i = 0; i < 32; ++i) zo[(size_t)i * CONF_W] = (bf16)f2bf(acc[i]);
        }
        __syncthreads();
    }
}

__device__ __forceinline__ void phase_m1b(const Args& A, int tid, int lane, int wave, int bid, int G) {
    const bf16* xl = (const bf16*)(A.ws + WS_XL); const bf16* wg = (const bf16*)(A.ws + WS_WG);
    bf16* hloc = (bf16*)(A.ws + WS_HLOC); bf16* pc = (bf16*)(A.ws + WS_PC); float* agg = (float*)(A.ws + WS_AGG);
    const int fr = lane & 15, fq = lane >> 4;
    for (int item = bid * NWAVES + wave; item < 2 * NCHUNK * 8; item += G * NWAVES) {
        const int hh = item & 7, chunk = (item >> 3) & (NCHUNK - 1), b = item >> 10;
        const size_t r0 = (size_t)b * SEQ + (size_t)chunk * CHUNK;
        bf16x8 xf[4][4];
#pragma unroll
        for (int mt = 0; mt < 4; ++mt)
#pragma unroll
            for (int ks = 0; ks < 4; ++ks) xf[mt][ks] = *(const GAS bf16x8*)(xl + (r0 + 16 * mt + fr) * LRU_W + hh * LRU_HD + 32 * ks + 8 * fq);
        float cP[4], cH[4];
        for (int j = 0; j < 8; ++j) {
            const int chb = hh * LRU_HD + 16 * j + 4 * fq;
            bf16x8 wa[4], wx[4];
#pragma unroll
            for (int ks = 0; ks < 4; ++ks) { wa[ks] = *(const GAS bf16x8*)(wg + (size_t)(hh * 256 + 16 * j + fr) * 128 + 32 * ks + 8 * fq);
                                             wx[ks] = *(const GAS bf16x8*)(wg + (size_t)(hh * 256 + 128 + 16 * j + fr) * 128 + 32 * ks + 8 * fq); }
            const f32x4 bav = *(const GAS f32x4*)(A.in[I_BA] + chb), bxv = *(const GAS f32x4*)(A.in[I_BX] + chb), lam = *(const GAS f32x4*)(A.in[I_LAMBDA] + chb);
            float cl[4];
#pragma unroll
            for (int r = 0; r < 4; ++r) { cl[r] = -8.0f * log1pf(__expf(-lam[r])); cP[r] = 1.f; cH[r] = 0.f; }
#pragma unroll
            for (int mt = 0; mt < 4; ++mt) {
                f32x4 ar = {0.f, 0.f, 0.f, 0.f}, ai = {0.f, 0.f, 0.f, 0.f};
#pragma unroll
                for (int ks = 0; ks < 4; ++ks) { ar = __builtin_amdgcn_mfma_f32_16x16x32_bf16(wa[ks], xf[mt][ks], ar, 0, 0, 0);
                                                 ai = __builtin_amdgcn_mfma_f32_16x16x32_bf16(wx[ks], xf[mt][ks], ai, 0, 0, 0); }
                const v2u xv = *(const GAS v2u*)(xl + (r0 + 16 * mt + fr) * LRU_W + chb);
                const float xlv[4] = {bflo(xv.x), bfhi(xv.x), bflo(xv.y), bfhi(xv.y)};
                float P[4], H[4];
#pragma unroll
                for (int r = 0; r < 4; ++r) {
                    const float rg = sigmoidf_(ar[r] + bav[r]), ig = sigmoidf_(ai[r] + bxv[r]);
                    const float la = cl[r] * rg, a = __expf(la), mult = sqrtf(fmaxf(1.0f - __expf(2.0f * la), 0.f));
                    float p = a, h = mult * ig * xlv[r];
#pragma unroll
                    for (int s = 1; s < 16; s <<= 1) { const float pp = __shfl_up(p, s, 16), hp = __shfl_up(h, s, 16);
                        if (fr >= s) { h = p * hp + h; p = p * pp; } }
                    h = h + p * cH[r]; p = p * cP[r];
                    P[r] = p; H[r] = h;
                    cP[r] = __shfl(p, 15, 16); cH[r] = __shfl(h, 15, 16);
                }
                v2u ho, po; ho.x = pk2(H[0], H[1]); ho.y = pk2(H[2], H[3]); po.x = pk2(P[0], P[1]); po.y = pk2(P[2], P[3]);
                *(GAS v2u*)(hloc + (r0 + 16 * mt + fr) * LRU_W + chb) = ho;
                *(GAS v2u*)(pc + (r0 + 16 * mt + fr) * LRU_W + chb) = po;
            }
            if (fr == 0) {
                float* ag = agg + ((size_t)(b * NCHUNK + chunk) * LRU_W + chb) * 2;
                *(GAS f32x4*)ag = (f32x4){cP[0], cH[0], cP[1], cH[1]}; *(GAS f32x4*)(ag + 4) = (f32x4){cP[2], cH[2], cP[3], cH[3]};
            }
        }
    }
}

__device__ __forceinline__ void phase_m2(const Args& A, int tid, int bid, int G) {
    const float* agg = (const float*)(A.ws + WS_AGG); float* carry = (float*)(A.ws + WS_CARRY);
    for (int e = bid * NTHR + tid; e < 2 * LRU_W; e += G * NTHR) {
        const int b = e >> 10, ch = e & (LRU_W - 1); float Hs = 0.f;
        for (int c = 0; c < NCHUNK; ++c) {
            carry[(size_t)(b * NCHUNK + c) * LRU_W + ch] = Hs;
            const float2 ab = *(const float2*)(agg + ((size_t)(b * NCHUNK + c) * LRU_W + ch) * 2);
            Hs = ab.x * Hs + ab.y;
        }
    }
}

__device__ __forceinline__ void phase_m3(const Args& A, int tid, int lane, int wave, int bid, int G) {
    const bf16* proj = (const bf16*)(A.ws + WS_PROJ); const bf16* hloc = (const bf16*)(A.ws + WS_HLOC); const bf16* pc = (const bf16*)(A.ws + WS_PC);
    const bf16* zc = (const bf16*)(A.ws + WS_ZC); const float* carry = (const float*)(A.ws + WS_CARRY);
    bf16* a2 = (bf16*)(A.ws + WS_RA);
    float lg[2][8], lb[2][8];
#pragma unroll
    for (int jj = 0; jj < 2; ++jj)
#pragma unroll
        for (int e = 0; e < 8; ++e) { lg[jj][e] = A.in[I_LNG][jj * 512 + lane * 8 + e]; lb[jj][e] = A.in[I_LNB][jj * 512 + lane * 8 + e]; }
    for (int row = bid * NWAVES + wave; row < T; row += G * NWAVES) {
        const int b = row >> 13, chunk = (row & (SEQ - 1)) >> 6;
        float zv[2][8]; float s = 0.f;
#pragma unroll
        for (int jj = 0; jj < 2; ++jj) {
            const int c0 = jj * 512 + lane * 8;
            const v4u hv = *(const GAS v4u*)(hloc + (size_t)row * LRU_W + c0), pv = *(const GAS v4u*)(pc + (size_t)row * LRU_W + c0);
            const v4u gv = *(const GAS v4u*)(proj + (size_t)row * IN_COLS + 1024 + c0);
            const float* cp = carry + (size_t)(b * NCHUNK + chunk) * LRU_W + c0;
            const f32x4 ca = *(const GAS f32x4*)cp, cb = *(const GAS f32x4*)(cp + 4);
            float y[8];
            y[0] = (bflo(hv.x) + bflo(pv.x) * ca.x) * gelu_tanh(bflo(gv.x)); y[1] = (bfhi(hv.x) + bfhi(pv.x) * ca.y) * gelu_tanh(bfhi(gv.x));
            y[2] = (bflo(hv.y) + bflo(pv.y) * ca.z) * gelu_tanh(bflo(gv.y)); y[3] = (bfhi(hv.y) + bfhi(pv.y) * ca.w) * gelu_tanh(bfhi(gv.y));
            y[4] = (bflo(hv.z) + bflo(pv.z) * cb.x) * gelu_tanh(bflo(gv.z)); y[5] = (bfhi(hv.z) + bfhi(pv.z) * cb.y) * gelu_tanh(bfhi(gv.z));
            y[6] = (bflo(hv.w) + bflo(pv.w) * cb.z) * gelu_tanh(bflo(gv.w)); y[7] = (bfhi(hv.w) + bfhi(pv.w) * cb.w) * gelu_tanh(bfhi(gv.w));
            v4u o; o.x = pk2(y[0], y[1]); o.y = pk2(y[2], y[3]); o.z = pk2(y[4], y[5]); o.w = pk2(y[6], y[7]);
            *(GAS v4u*)(a2 + (size_t)row * D + c0) = o;
            const v4u z = *(const GAS v4u*)(zc + (size_t)row * CONF_W + c0);
            zv[jj][0] = bflo(z.x); zv[jj][1] = bfhi(z.x); zv[jj][2] = bflo(z.y); zv[jj][3] = bfhi(z.y); zv[jj][4] = bflo(z.z); zv[jj][5] = bfhi(z.z); zv[jj][6] = bflo(z.w); zv[jj][7] = bfhi(z.w);
#pragma unroll
            for (int e = 0; e < 8; ++e) s += zv[jj][e];
        }
        const float mean = wave_sum(s) * (1.0f / CONF_W); float q = 0.f;
#pragma unroll
        for (int jj = 0; jj < 2; ++jj)
#pragma unroll
            for (int e = 0; e < 8; ++e) { zv[jj][e] -= mean; q += zv[jj][e] * zv[jj][e]; }
        const float rstd = __builtin_amdgcn_rsqf(wave_sum(q) * (1.0f / CONF_W) + EPS);
#pragma unroll
        for (int jj = 0; jj < 2; ++jj) { float o[8];
#pragma unroll
            for (int e = 0; e < 8; ++e) { const float n = zv[jj][e] * rstd * lg[jj][e] + lb[jj][e]; o[e] = n * sigmoidf_(n); }
            v4u w; w.x = pk2(o[0], o[1]); w.y = pk2(o[2], o[3]); w.z = pk2(o[4], o[5]); w.w = pk2(o[6], o[7]);
            *(GAS v4u*)(a2 + (size_t)row * D + 1024 + jj * 512 + lane * 8) = w; }
    }
}

__device__ __forceinline__ void phase_e2(const Args& A, int tid, int lane, int wave, int bid, int G) {
    const float* modp = (const float*)(A.ws + WS_MODP); const float* cfin = (const float*)(A.ws + WS_CFIN);
    const bf16* y1 = (const bf16*)(A.ws + WS_Y1); bf16* h2 = (bf16*)(A.ws + WS_RA);
    const int gw = bid * NWAVES + wave, NGW = G * NWAVES;
    int cb = -1; float gs[4][8], sh[4][8];
    for (int row = gw; row < T; row += NGW) {
        const int b = row >> 13;
        if (b != cb) { cb = b;
#pragma unroll
            for (int j = 0; j < 4; ++j)
#pragma unroll
                for (int e = 0; e < 8; ++e) { const int col = j * 512 + lane * 8 + e;
                    gs[j][e] = A.in[I_GPREFFN][col] * (1.0f + mod_at(modp, b, 4 * D + col)); sh[j][e] = mod_at(modp, b, 3 * D + col); } }
        const GAS f32x4* xr = (const GAS f32x4*)(A.in[I_X] + (size_t)row * D) + lane * 2;
        const GAS v4u* yr = (const GAS v4u*)(y1 + (size_t)row * D) + lane;
        const GAS f32x4* cf = (const GAS f32x4*)(cfin + (size_t)(b * 2 + 0) * D) + lane * 2;
        float xv[4][8], yv[4][8]; float s1 = 0.f;
#pragma unroll
        for (int j = 0; j < 4; ++j) { const f32x4 a = xr[j * 128], c = xr[j * 128 + 1]; const v4u y = yr[j * 64];
            xv[j][0] = a.x; xv[j][1] = a.y; xv[j][2] = a.z; xv[j][3] = a.w; xv[j][4] = c.x; xv[j][5] = c.y; xv[j][6] = c.z; xv[j][7] = c.w;
            yv[j][0] = bflo(y.x); yv[j][1] = bfhi(y.x); yv[j][2] = bflo(y.y); yv[j][3] = bfhi(y.y); yv[j][4] = bflo(y.z); yv[j][5] = bfhi(y.z); yv[j][6] = bflo(y.w); yv[j][7] = bfhi(y.w);
#pragma unroll
            for (int e = 0; e < 8; ++e) s1 += yv[j][e] * yv[j][e]; }
        const float rstd1 = __builtin_amdgcn_rsqf(wave_sum(s1) * (1.0f / D) + EPS); float s2 = 0.f;
#pragma unroll
        for (int j = 0; j < 4; ++j) { const f32x4 ca = cf[j * 128], cc = cf[j * 128 + 1]; const float cg[8] = {ca.x, ca.y, ca.z, ca.w, cc.x, cc.y, cc.z, cc.w};
#pragma unroll
            for (int e = 0; e < 8; ++e) { xv[j][e] += cg[e] * yv[j][e] * rstd1; s2 += xv[j][e] * xv[j][e]; } }
        const float rstd2 = __builtin_amdgcn_rsqf(wave_sum(s2) * (1.0f / D) + EPS);
        GAS v4u* orow = (GAS v4u*)(h2 + (size_t)row * D) + lane;
#pragma unroll
        for (int j = 0; j < 4; ++j) { float o[8];
#pragma unroll
            for (int e = 0; e < 8; ++e) o[e] = xv[j][e] * rstd2 * gs[j][e] + sh[j][e];
            v4u w; w.x = pk2(o[0], o[1]); w.y = pk2(o[2], o[3]); w.z = pk2(o[4], o[5]); w.w = pk2(o[6], o[7]);
            orow[j * 64] = w; }
    }
    cvt_rows_bf16(A.in[I_PU], (bf16*)(A.ws + WS_UB), (size_t)NEXP * D / 8, (size_t)bid * NTHR + tid, (size_t)G * NTHR);
    cvt_rows_bf16(A.in[I_PV], (bf16*)(A.ws + WS_VB), (size_t)NEXP * D / 8, (size_t)bid * NTHR + tid, (size_t)G * NTHR);
}

template <int N> __device__ __forceinline__ void bitonic_sort_desc(float (&v)[N]) {
#pragma unroll
    for (int k = 2; k <= N; k <<= 1)
#pragma unroll
        for (int j = k >> 1; j > 0; j >>= 1)
#pragma unroll
            for (int i = 0; i < N; ++i) { const int l = i ^ j;
                if (l > i) { const bool desc = ((i & k) == 0); const float a = v[i], b = v[l]; const float mx = fmaxf(a, b), mn = fminf(a, b); v[i] = desc ? mx : mn; v[l] = desc ? mn : mx; } }
}
__device__ __forceinline__ void merge_top16(float (&a)[16], const float (&b)[16]) {
#pragma unroll
    for (int i = 0; i < 16; ++i) a[i] = fmaxf(a[i], b[15 - i]);
#pragma unroll
    for (int j = 8; j > 0; j >>= 1)
#pragma unroll
        for (int i = 0; i < 16; ++i) { const int l = i ^ j; if (l > i) { const float x = a[i], y = a[l]; a[i] = fmaxf(x, y); a[l] = fminf(x, y); } }
}
__device__ __forceinline__ void top16_of_64(float (&v)[64], float (&out)[16]) {
    float g[4][16];
#pragma unroll
    for (int q = 0; q < 4; ++q) {
#pragma unroll
        for (int i = 0; i < 16; ++i) g[q][i] = v[q * 16 + i];
        bitonic_sort_desc<16>(g[q]); }
    merge_top16(g[0], g[1]); merge_top16(g[2], g[3]); merge_top16(g[0], g[2]);
#pragma unroll
    for (int i = 0; i < 16; ++i) out[i] = g[0][i];
}
__device__ __forceinline__ float pack_key(float v, unsigned key, unsigned mask) { return __builtin_bit_cast(float, (__builtin_bit_cast(unsigned, v) & ~mask) | key); }
__device__ __forceinline__ void score_top16(const bf16* q, const bf16* sk, int tok, int h, int p, int l31, int hf, float (&out)[16]) {
    f32x16 acc[4];
#pragma unroll
    for (int kt = 0; kt < 4; ++kt)
#pragma unroll
        for (int r = 0; r < 16; ++r) acc[kt][r] = 0.f;
#pragma unroll 2
    for (int ks = 0; ks < 8; ++ks) {
        const bf16x8 bq = *(const GAS bf16x8*)(q + (size_t)tok * D + h * 256 + p * 128 + 16 * ks + 8 * hf);
#pragma unroll
        for (int kt = 0; kt < 4; ++kt) {
            const bf16x8 ak = *(const GAS bf16x8*)(sk + ((size_t)((h * 2 + p) * NKEY + 32 * kt + l31)) * 128 + 16 * ks + 8 * hf);
            acc[kt] = __builtin_amdgcn_mfma_f32_32x32x16_bf16(ak, bq, acc[kt], 0, 0, 0);
        }
    }
    float v[64];
#pragma unroll
    for (int kt = 0; kt < 4; ++kt)
#pragma unroll
        for (int r = 0; r < 16; ++r) v[kt * 16 + r] = pack_key(acc[kt][r], (unsigned)(32 * kt + (r & 3) + 8 * (r >> 2) + 4 * hf), 0x7Fu);
    float other[16];
    top16_of_64(v, out);
#pragma unroll
    for (int i = 0; i < 16; ++i) other[i] = __shfl_xor(out[i], 32);
    merge_top16(out, other);
}
__device__ __forceinline__ void phase_s(const Args& A, int tid, int lane, int wave, int bid, int G) {
    const bf16* q = (const bf16*)(A.ws + WS_Q); const bf16* sk = (const bf16*)(A.ws + WS_SUBK);
    int* idx = (int*)(A.ws + WS_IDX); float* gate = (float*)(A.ws + WS_GATE);
    const int l31 = lane & 31, hf = lane >> 5;
    for (int item = bid * NWAVES + wave; item < (T / 32) * NH; item += G * NWAVES) {
        const int h = item & 7, tok = (item >> 3) * 32 + l31;
        float s1[16], s2[16];
        score_top16(q, sk, tok, h, 0, l31, hf, s1);
        score_top16(q, sk, tok, h, 1, l31, hf, s2);
        float cv[64]; int n = 0;
#pragma unroll
        for (int i = 0; i < 16; ++i)
#pragma unroll
            for (int j = 0; j < 16; ++j)
                if ((i + 1) * (j + 1) <= 16) {
                    const float a = __builtin_bit_cast(float, __builtin_bit_cast(unsigned, s1[i]) & ~0x7Fu), c = __builtin_bit_cast(float, __builtin_bit_cast(unsigned, s2[j]) & ~0x7Fu);
                    cv[n++] = pack_key(a + c, (unsigned)(i * 16 + j), 0xFFu); }
#pragma unroll
        for (int m = 50; m < 64; ++m) cv[m] = -INFINITY;
        float c16[16];
        top16_of_64(cv, c16);
        float ev[16], esum = 0.f; const float cmax = __builtin_bit_cast(float, __builtin_bit_cast(unsigned, c16[0]) & ~0xFFu);
#pragma unroll
        for (int m = 0; m < 16; ++m) { ev[m] = __expf(__builtin_bit_cast(float, __builtin_bit_cast(unsigned, c16[m]) & ~0xFFu) - cmax); esum += ev[m]; }
        const float rs = 1.0f / esum;
        int oi[8]; float og[8];
#pragma unroll
        for (int mm = 0; mm < 8; ++mm) {
            float c_lo = c16[mm], c_hi = c16[8 + mm], e_lo = ev[mm], e_hi = ev[8 + mm];
            asm volatile("" : "+v"(c_lo), "+v"(c_hi), "+v"(e_lo), "+v"(e_hi));
            const unsigned cb = __builtin_bit_cast(unsigned, hf ? c_hi : c_lo); const int ii = (cb >> 4) & 15, jj = cb & 15;
            int row = 0, col = 0;
#pragma unroll
            for (int k = 0; k < 16; ++k) { row = (ii == k) ? (int)(__builtin_bit_cast(unsigned, s1[k]) & 0x7Fu) : row; col = (jj == k) ? (int)(__builtin_bit_cast(unsigned, s2[k]) & 0x7Fu) : col; }
            oi[mm] = row * NKEY + col; og[mm] = (hf ? e_hi : e_lo) * rs;
        }
        int* ip = idx + (size_t)tok * KSEL + h * 16 + hf * 8; float* gp = gate + (size_t)tok * KSEL + h * 16 + hf * 8;
        *(GAS v4u*)ip = (v4u){(unsigned)oi[0], (unsigned)oi[1], (unsigned)oi[2], (unsigned)oi[3]}; *(GAS v4u*)(ip + 4) = (v4u){(unsigned)oi[4], (unsigned)oi[5], (unsigned)oi[6], (unsigned)oi[7]};
        *(GAS f32x4*)gp = (f32x4){og[0], og[1], og[2], og[3]}; *(GAS f32x4*)(gp + 4) = (f32x4){og[4], og[5], og[6], og[7]};
    }
}

__device__ __forceinline__ float dot2(unsigned a, unsigned b, float acc) { return __builtin_amdgcn_fdot2_f32_bf16(__builtin_bit_cast(bfp2, a), __builtin_bit_cast(bfp2, b), acc, false); }
__device__ __forceinline__ float dot8(const v4u a, const v4u b, float acc) {
    acc = dot2(a.x, b.x, acc); acc = dot2(a.y, b.y, acc); acc = dot2(a.z, b.z, acc); acc = dot2(a.w, b.w, acc);
    return acc;
}
__device__ __forceinline__ void axpy8(float (&acc)[8], const v4u v, float w) {
    acc[0] += w * bflo(v.x); acc[1] += w * bfhi(v.x); acc[2] += w * bflo(v.y); acc[3] += w * bfhi(v.y);
    acc[4] += w * bflo(v.z); acc[5] += w * bfhi(v.z); acc[6] += w * bflo(v.w); acc[7] += w * bfhi(v.w);
}
__device__ __forceinline__ void phase_pe(const Args& A, int tid, int lane, int wave, int bid, int G) {
    const bf16* h2 = (const bf16*)(A.ws + WS_RA); const bf16* y1 = (const bf16*)(A.ws + WS_Y1);
    const bf16* ub = (const bf16*)(A.ws + WS_UB); const bf16* vb = (const bf16*)(A.ws + WS_VB);
    const int* idx = (const int*)(A.ws + WS_IDX); const float* gate = (const float*)(A.ws + WS_GATE); const float* cfin = (const float*)(A.ws + WS_CFIN);
    for (int tok = bid * NWAVES + wave; tok < T; tok += G * NWAVES) {
        const int b = tok >> 13;
        v4u hq[4];
#pragma unroll
        for (int j = 0; j < 4; ++j) hq[j] = ((const GAS v4u*)(h2 + (size_t)tok * D))[j * 64 + lane];
        const int id0 = idx[(size_t)tok * KSEL + lane], id1 = idx[(size_t)tok * KSEL + 64 + lane];
        const float g0 = gate[(size_t)tok * KSEL + lane], g1 = gate[(size_t)tok * KSEL + 64 + lane];
        float act0 = 0.f, act1 = 0.f;
#pragma unroll 4
        for (int k = 0; k < 64; ++k) {
            const int e = __builtin_amdgcn_readlane(id0, k);
            const GAS v4u* up = (const GAS v4u*)(ub + (size_t)e * D) + lane;
            float p = dot8(up[0], hq[0], 0.f); p = dot8(up[64], hq[1], p); p = dot8(up[128], hq[2], p); p = dot8(up[192], hq[3], p);
            p = wave_sum(p); act0 = (lane == k) ? p : act0;
        }
#pragma unroll 4
        for (int k = 0; k < 64; ++k) {
            const int e = __builtin_amdgcn_readlane(id1, k);
            const GAS v4u* up = (const GAS v4u*)(ub + (size_t)e * D) + lane;
            float p = dot8(up[0], hq[0], 0.f); p = dot8(up[64], hq[1], p); p = dot8(up[128], hq[2], p); p = dot8(up[192], hq[3], p);
            p = wave_sum(p); act1 = (lane == k) ? p : act1;
        }
        const float w0 = g0 * gelu_tanh(act0), w1 = g1 * gelu_tanh(act1);
        float acc[4][8];
#pragma unroll
        for (int j = 0; j < 4; ++j)
#pragma unroll
            for (int e = 0; e < 8; ++e) acc[j][e] = 0.f;
#pragma unroll 4
        for (int k = 0; k < 64; ++k) {
            const int e = __builtin_amdgcn_readlane(id0, k); const float w = rdlane(w0, k);
            const GAS v4u* vp = (const GAS v4u*)(vb + (size_t)e * D) + lane;
            axpy8(acc[0], vp[0], w); axpy8(acc[1], vp[64], w); axpy8(acc[2], vp[128], w); axpy8(acc[3], vp[192], w);
        }
#pragma unroll 4
        for (int k = 0; k < 64; ++k) {
            const int e = __builtin_amdgcn_readlane(id1, k); const float w = rdlane(w1, k);
            const GAS v4u* vp = (const GAS v4u*)(vb + (size_t)e * D) + lane;
            axpy8(acc[0], vp[0], w); axpy8(acc[1], vp[64], w); axpy8(acc[2], vp[128], w); axpy8(acc[3], vp[192], w);
        }
        float s2 = 0.f;
#pragma unroll
        for (int j = 0; j < 4; ++j)
#pragma unroll
            for (int e = 0; e < 8; ++e) s2 += acc[j][e] * acc[j][e];
        const float rstd2 = __builtin_amdgcn_rsqf(wave_sum(s2) * (1.0f / D) + EPS);
        float yv[4][8]; float s1 = 0.f;
#pragma unroll
        for (int j = 0; j < 4; ++j) { const v4u y = ((const GAS v4u*)(y1 + (size_t)tok * D))[j * 64 + lane];
            yv[j][0] = bflo(y.x); yv[j][1] = bfhi(y.x); yv[j][2] = bflo(y.y); yv[j][3] = bfhi(y.y); yv[j][4] = bflo(y.z); yv[j][5] = bfhi(y.z); yv[j][6] = bflo(y.w); yv[j][7] = bfhi(y.w);
#pragma unroll
            for (int e = 0; e < 8; ++e) s1 += yv[j][e] * yv[j][e]; }
        const float rstd1 = __builtin_amdgcn_rsqf(wave_sum(s1) * (1.0f / D) + EPS);
        const GAS f32x4* xr = (const GAS f32x4*)(A.in[I_X] + (size_t)tok * D) + lane * 2;
        const GAS f32x4* c1 = (const GAS f32x4*)(cfin + (size_t)(b * 2 + 0) * D) + lane * 2; const GAS f32x4* c2 = (const GAS f32x4*)(cfin + (size_t)(b * 2 + 1) * D) + lane * 2;
        GAS f32x4* orow = (GAS f32x4*)(A.out + (size_t)tok * D) + lane * 2;
#pragma unroll
        for (int j = 0; j < 4; ++j)
#pragma unroll
            for (int hh = 0; hh < 2; ++hh) { const f32x4 xv = xr[j * 128 + hh], a1 = c1[j * 128 + hh], a2 = c2[j * 128 + hh]; f32x4 o;
#pragma unroll
                for (int e = 0; e < 4; ++e) o[e] = xv[e] + (OUT_MODE != 2 ? a1[e] * yv[j][hh * 4 + e] * rstd1 : 0.f) + (OUT_MODE != 1 ? a2[e] * acc[j][hh * 4 + e] * rstd2 : 0.f);
                orow[j * 128 + hh] = o; }
    }
}

#if defined(MK_CHECKS)
constexpr int CW_CHK = 2048;
__device__ __forceinline__ unsigned hsh(unsigned x) { x ^= x >> 16; x *= 0x7feb352dU; x ^= x >> 15; x *= 0x846ca68bU; x ^= x >> 16; return x; }
__device__ __forceinline__ float bfv(const bf16* p, size_t i) { return __builtin_bit_cast(float, (unsigned)p[i] << 16); }
__device__ __forceinline__ float relerr(float got, float ref, float scale) { const float d = fabsf(got - ref) / (fabsf(ref) + scale); return (d == d) ? d : 1e30f; }
__device__ __forceinline__ void chk_put(unsigned* ctl, int stage, float e) { atomicMax(ctl + CW_CHK + stage, __builtin_bit_cast(unsigned, e)); }
__device__ float chk_gemm(const bf16* Am, const bf16* Bt, const bf16* C, int N, int K, unsigned s) {
    const int row = hsh(s) % T, col = hsh(s * 7 + 1) % N; float acc = 0.f;
    for (int k = 0; k < K; ++k) acc += bfv(Am, (size_t)row * K + k) * bfv(Bt, (size_t)col * K + k);
    return relerr(bfv(C, (size_t)row * N + col), acc, 0.05f);
}
__global__ void __launch_bounds__(128) chk_kernel(Args A, int stage) {
    __shared__ float sh[10240];
    unsigned* ctl = (unsigned*)(A.ws + WS_CTL);
    const int tid = threadIdx.x; const unsigned s = hsh(tid * 2654435761u + stage * 97u + 12345u);
    const float* modp = (const float*)(A.ws + WS_MODP);
    float e = 0.f;
    if (stage == 0) {
        { const int b = s & 1, n = hsh(s) % NMOD; float acc = A.in[I_BMOD][n];
          for (int k = 0; k < D; ++k) { const float c = A.in[I_C][b * D + k]; acc += c / (1.0f + expf(-c)) * A.in[I_WMOD][(size_t)k * NMOD + n]; }
          e = fmaxf(e, relerr(mod_at(modp, b, n), acc, 0.01f)); }
        { const int n = hsh(s + 1) % IN_COLS, k = hsh(s + 2) % D; e = fmaxf(e, relerr(bfv((const bf16*)(A.ws + WS_BT1), (size_t)n * D + k), A.in[I_WIN][(size_t)k * IN_COLS + n], 1e-3f)); }
        { const int n = hsh(s + 3) % D, k = hsh(s + 4) % D; e = fmaxf(e, relerr(bfv((const bf16*)(A.ws + WS_BT2), (size_t)n * D + k), A.in[I_WOUT][(size_t)k * D + n], 1e-3f));
          e = fmaxf(e, relerr(bfv((const bf16*)(A.ws + WS_BT3), (size_t)n * D + k), A.in[I_WQ][(size_t)k * D + n], 1e-3f)); }
        { const int h = s & 7, n = hsh(s + 5) & 255, k = hsh(s + 6) & 127; const float ref = (n < 128 ? A.in[I_WA] : A.in[I_WX])[h * 16384 + k * 128 + (n & 127)];
          e = fmaxf(e, relerr(bfv((const bf16*)(A.ws + WS_WG), (size_t)(h * 256 + n) * 128 + k), ref, 1e-3f)); }
        { const int i = hsh(s + 7) % (NH * 2 * NKEY * 128); e = fmaxf(e, relerr(bfv((const bf16*)(A.ws + WS_SUBK), i), A.in[I_SUBK][i], 1e-3f)); }
    } else if (stage == 1) {
        const int row = hsh(s) % T, col = hsh(s + 1) % D, b = row >> 13; float ss = 0.f;
        for (int k = 0; k < D; ++k) { const float x = A.in[I_X][(size_t)row * D + k]; ss += x * x; }
        const float ref = A.in[I_X][(size_t)row * D + col] * rsqrtf(ss / D + EPS) * A.in[I_GPREMIX][col] * (1.0f + mod_at(modp, b, D + col)) + mod_at(modp, b, col);
        e = relerr(bfv((const bf16*)(A.ws + WS_RA), (size_t)row * D + col), ref, 0.05f);
        const float* cfin = (const float*)(A.ws + WS_CFIN);
        e = fmaxf(e, relerr(cfin[(b * 2 + 0) * D + col], mod_at(modp, b, 2 * D + col) * A.in[I_GPOSTMIX][col], 1e-3f));
        e = fmaxf(e, relerr(cfin[(b * 2 + 1) * D + col], mod_at(modp, b, 5 * D + col) * A.in[I_GPOSTFFN][col], 1e-3f));
    } else if (stage == 2) { e = chk_gemm((const bf16*)(A.ws + WS_RA), (const bf16*)(A.ws + WS_BT1), (const bf16*)(A.ws + WS_PROJ), IN_COLS, D, s);
    } else if (stage == 7) { e = chk_gemm((const bf16*)(A.ws + WS_RA), (const bf16*)(A.ws + WS_BT2), (const bf16*)(A.ws + WS_Y1), D, D, s);
    } else if (stage == 9) { e = chk_gemm((const bf16*)(A.ws + WS_RA), (const bf16*)(A.ws + WS_BT3), (const bf16*)(A.ws + WS_Q), D, D, s);
    } else if (stage == 3) {
        const bf16* proj = (const bf16*)(A.ws + WS_PROJ);
        int row = hsh(s) % T; if (tid < 16) row = (tid & 1) * SEQ + (tid >> 1);
        const int c = hsh(s + 1) % LRU_W, t = row & (SEQ - 1);
        float a = A.in[I_LCB][c];
        for (int j = 0; j < 4; ++j) if (t - 3 + j >= 0) a += A.in[I_LCW][j * LRU_W + c] * bfv(proj, (size_t)(row - 3 + j) * IN_COLS + c);
        e = relerr(bfv((const bf16*)(A.ws + WS_XL), (size_t)row * LRU_W + c), a, 0.05f);
        float z = A.in[I_CDB][c];
        for (int j = 0; j < CONF_K; ++j) if (t - 30 + j >= 0) { const size_t r = (size_t)(row - 30 + j) * IN_COLS; const float g = bfv(proj, r + 3072 + c);
            z += A.in[I_CDW][j * CONF_W + c] * bfv(proj, r + 2048 + c) / (1.0f + expf(-g)); }
        e = fmaxf(e, relerr(bfv((const bf16*)(A.ws + WS_ZC), (size_t)row * CONF_W + c), z, 0.05f));
    } else if (stage == 4) {
        const bf16* xl = (const bf16*)(A.ws + WS_XL);
        const int b = s & 1, chunk = hsh(s + 1) % NCHUNK, ch = hsh(s + 2) % LRU_W, hh = ch >> 7, j = ch & 127;
        const float cl = -8.0f * log1pf(expf(-A.in[I_LAMBDA][ch])); float P = 1.f, H = 0.f;
        for (int t = 0; t < CHUNK; ++t) { const size_t row = (size_t)b * SEQ + chunk * CHUNK + t; float ga = A.in[I_BA][ch], gx = A.in[I_BX][ch];
            for (int i = 0; i < 128; ++i) { const float xv = bfv(xl, row * LRU_W + hh * 128 + i); ga += xv * A.in[I_WA][hh * 16384 + i * 128 + j]; gx += xv * A.in[I_WX][hh * 16384 + i * 128 + j]; }
            const float r = 1.0f / (1.0f + expf(-ga)), ig = 1.0f / (1.0f + expf(-gx)), la = cl * r, a = expf(la), u = sqrtf(fmaxf(-expm1f(2.0f * la), 0.f)) * ig * bfv(xl, row * LRU_W + ch);
            H = a * H + u; P = P * a;
            e = fmaxf(e, relerr(bfv((const bf16*)(A.ws + WS_HLOC), row * LRU_W + ch), H, 0.05f)); e = fmaxf(e, relerr(bfv((const bf16*)(A.ws + WS_PC), row * LRU_W + ch), P, 0.02f)); }
        const float* ag = (const float*)(A.ws + WS_AGG) + ((size_t)(b * NCHUNK + chunk) * LRU_W + ch) * 2;
        e = fmaxf(e, relerr(ag[0], P, 0.02f)); e = fmaxf(e, relerr(ag[1], H, 0.05f));
    } else if (stage == 5) {
        const int b = s & 1, ch = hsh(s + 1) % LRU_W; const float* agg = (const float*)(A.ws + WS_AGG); const float* carry = (const float*)(A.ws + WS_CARRY); float Hs = 0.f;
        for (int c = 0; c < NCHUNK; ++c) { e = fmaxf(e, relerr(carry[(size_t)(b * NCHUNK + c) * LRU_W + ch], Hs, 1e-3f)); const float* ag = agg + ((size_t)(b * NCHUNK + c) * LRU_W + ch) * 2; Hs = ag[0] * Hs + ag[1]; }
    } else if (stage == 6) {
        const bf16* proj = (const bf16*)(A.ws + WS_PROJ); const bf16* zc = (const bf16*)(A.ws + WS_ZC);
        const int row = hsh(s) % T, c = hsh(s + 1) % LRU_W, b = row >> 13, chunk = (row & (SEQ - 1)) >> 6;
        const float hfull = bfv((const bf16*)(A.ws + WS_HLOC), (size_t)row * LRU_W + c) + bfv((const bf16*)(A.ws + WS_PC), (size_t)row * LRU_W + c) * ((const float*)(A.ws + WS_CARRY))[(size_t)(b * NCHUNK + chunk) * LRU_W + c];
        const float g = bfv(proj, (size_t)row * IN_COLS + 1024 + c), ge = 0.5f * g * (1.0f + tanhf(0.7978845608f * (g + 0.044715f * g * g * g)));
        e = relerr(bfv((const bf16*)(A.ws + WS_RA), (size_t)row * D + c), hfull * ge, 0.05f);
        float m = 0.f, q = 0.f;
        for (int k = 0; k < CONF_W; ++k) m += bfv(zc, (size_t)row * CONF_W + k);
        m /= CONF_W;
        for (int k = 0; k < CONF_W; ++k) { const float d = bfv(zc, (size_t)row * CONF_W + k) - m; q += d * d; }
        const float n = (bfv(zc, (size_t)row * CONF_W + c) - m) * rsqrtf(q / CONF_W + EPS) * A.in[I_LNG][c] + A.in[I_LNB][c];
        e = fmaxf(e, relerr(bfv((const bf16*)(A.ws + WS_RA), (size_t)row * D + 1024 + c), n / (1.0f + expf(-n)), 0.05f));
    } else if (stage == 8) {
        const bf16* y1 = (const bf16*)(A.ws + WS_Y1); const float* cfin = (const float*)(A.ws + WS_CFIN);
        const int row = hsh(s) % T, col = hsh(s + 1) % D, b = row >> 13; float s1 = 0.f, s2 = 0.f;
        for (int k = 0; k < D; ++k) { const float y = bfv(y1, (size_t)row * D + k); s1 += y * y; }
        const float r1 = rsqrtf(s1 / D + EPS);
        for (int k = 0; k < D; ++k) { const float x1 = A.in[I_X][(size_t)row * D + k] + cfin[(b * 2) * D + k] * bfv(y1, (size_t)row * D + k) * r1; s2 += x1 * x1; }
        const float x1c = A.in[I_X][(size_t)row * D + col] + cfin[(b * 2) * D + col] * bfv(y1, (size_t)row * D + col) * r1;
        const float ref = x1c * rsqrtf(s2 / D + EPS) * A.in[I_GPREFFN][col] * (1.0f + mod_at(modp, b, 4 * D + col)) + mod_at(modp, b, 3 * D + col);
        e = relerr(bfv((const bf16*)(A.ws + WS_RA), (size_t)row * D + col), ref, 0.05f);
        const size_t i = (size_t)(hsh(s + 2) % NEXP) * D + hsh(s + 3) % D;
        e = fmaxf(e, relerr(bfv((const bf16*)(A.ws + WS_UB), i), A.in[I_PU][i], 1e-4f)); e = fmaxf(e, relerr(bfv((const bf16*)(A.ws + WS_VB), i), A.in[I_PV][i], 1e-3f));
    } else if (stage == 10) {
        if (tid < 32) {
            const bf16* q = (const bf16*)(A.ws + WS_Q); const int* idx = (const int*)(A.ws + WS_IDX); const float* gate = (const float*)(A.ws + WS_GATE);
            const int tok = hsh(s) % T, h = hsh(s + 1) & 7;
            float* sc = sh + tid * 320;
            for (int p = 0; p < 2; ++p) for (int n = 0; n < NKEY; ++n) { float a = 0.f;
                for (int d = 0; d < 128; ++d) a += bfv(q, (size_t)tok * D + h * 256 + p * 128 + d) * A.in[I_SUBK][((size_t)((h * 2 + p) * NKEY + n)) * 128 + d];
                sc[p * 128 + n] = a; }
            for (int p = 0; p < 2; ++p) { float prev = 1e30f; for (int it = 0; it < 16; ++it) { float best = -1e30f; int bi = 0;
                for (int n = 0; n < NKEY; ++n) { const float v = sc[p * 128 + n]; if (v < prev && v > best) { best = v; bi = n; } }
                sc[256 + p * 16 + it] = best; sc[288 + p * 16 + it] = (float)bi; prev = best; } }
            float prev = 1e30f, esum = 0.f, cmax = 0.f; int miss = 0; float gerr = 0.f;
            { float pv = 1e30f; for (int it = 0; it < 16; ++it) { float best = -1e30f;
                for (int c = 0; c < 256; ++c) { const float v = sc[256 + (c >> 4)] + sc[272 + (c & 15)]; if (v < pv && v > best) best = v; }
                if (it == 0) cmax = best; esum += expf(best - cmax); pv = best; } }
            for (int it = 0; it < 16; ++it) { float best = -1e30f; int bc = 0;
                for (int c = 0; c < 256; ++c) { const float v = sc[256 + (c >> 4)] + sc[272 + (c & 15)]; if (v < prev && v > best) { best = v; bc = c; } }
                prev = best;
                const int eidx = (int)sc[288 + (bc >> 4)] * NKEY + (int)sc[304 + (bc & 15)]; const float g = expf(best - cmax) / esum; bool found = false;
                for (int m = 0; m < 16; ++m) if (idx[(size_t)tok * KSEL + h * 16 + m] == eidx) { found = true; gerr = fmaxf(gerr, relerr(gate[(size_t)tok * KSEL + h * 16 + m], g, 0.02f)); }
                if (!found) ++miss; }
            e = fmaxf((float)miss / 16.0f, gerr);
        }
    } else if (stage == 11) {
        const bf16* h2 = (const bf16*)(A.ws + WS_RA); const bf16* y1 = (const bf16*)(A.ws + WS_Y1); const int* idx = (const int*)(A.ws + WS_IDX); const float* gate = (const float*)(A.ws + WS_GATE); const float* cfin = (const float*)(A.ws + WS_CFIN);
        const int tok = hsh(blockIdx.x * 977u + 5u) % T, b = tok >> 13;
        { const int ex = idx[(size_t)tok * KSEL + tid]; float a = 0.f;
          if ((unsigned)ex < (unsigned)NEXP) { for (int d = 0; d < D; ++d) a += bfv(h2, (size_t)tok * D + d) * A.in[I_PU][(size_t)ex * D + d]; } else a = 1e30f;
          const float ge = 0.5f * a * (1.0f + tanhf(0.7978845608f * (a + 0.044715f * a * a * a)));
          sh[tid] = gate[(size_t)tok * KSEL + tid] * ge; sh[128 + tid] = __builtin_bit_cast(float, ex); }
        __syncthreads();
        float s2 = 0.f, s1 = 0.f;
        for (int cc = 0; cc < 16; ++cc) { const int col = cc * 128 + tid; float a = 0.f;
            for (int k = 0; k < KSEL; ++k) { const int ex = __builtin_bit_cast(int, sh[128 + k]); if ((unsigned)ex < (unsigned)NEXP) a += sh[k] * A.in[I_PV][(size_t)ex * D + col]; }
            sh[512 + cc * 128 + tid] = a; s2 += a * a; const float y = bfv(y1, (size_t)tok * D + col); s1 += y * y; }
        __syncthreads(); sh[256 + tid] = s2; sh[384 + tid] = s1; __syncthreads();
        float t2 = 0.f, t1 = 0.f; for (int k = 0; k < 128; ++k) { t2 += sh[256 + k]; t1 += sh[384 + k]; }
        const float r2 = rsqrtf(t2 / D + EPS), r1 = rsqrtf(t1 / D + EPS);
        for (int cc = 0; cc < 16; ++cc) { const int col = cc * 128 + tid;
            const float ref = A.in[I_X][(size_t)tok * D + col] + (OUT_MODE != 2 ? cfin[(b * 2) * D + col] * bfv(y1, (size_t)tok * D + col) * r1 : 0.f) + (OUT_MODE != 1 ? cfin[(b * 2 + 1) * D + col] * sh[512 + cc * 128 + tid] * r2 : 0.f);
            e = fmaxf(e, relerr(A.out[(size_t)tok * D + col], ref, 0.05f)); }
    }
    chk_put(ctl, stage, e);
}
__global__ void chk_encode(Args A, int what) {
    const unsigned* ctl = (const unsigned*)(A.ws + WS_CTL);
    if (threadIdx.x == 0 && blockIdx.x == 0) {
        if (what < 0) {
            const float thr[N_PHASES] = {0.03f, 0.03f, 0.03f, 0.03f, 0.06f, 0.01f, 0.04f, 0.03f, 0.03f, 0.03f, 0.2f, 0.03f};
            for (int st = 0; st < N_PHASES; ++st) { const float e = __builtin_bit_cast(float, ctl[CW_CHK + st]); if (!(e <= thr[st])) { A.out[0] = 4000.0f * (float)(1 << st); break; } }
        } else {
            const float e = fminf(__builtin_bit_cast(float, ctl[CW_CHK + what]), 1e6f); A.out[0] = 4000.0f * sqrtf(1e6f * e);
        }
    }
}
#endif

__global__ void __launch_bounds__(NTHR, 2) fwd_kernel(Args args) {
    extern __shared__ __attribute__((aligned(16))) unsigned char lds_raw[];
    LAS unsigned char* lds = (LAS unsigned char*)lds_raw;
    const int tid = threadIdx.x, lane = tid & 63, wave = __builtin_amdgcn_readfirstlane(tid >> 6), bid = blockIdx.x, G = gridDim.x;
    for (int u = tid; u < (LDS_BYTES - LDSCTL_OFF) / 4; u += NTHR) ((LAS unsigned*)(lds + LDSCTL_OFF))[u] = 0u;
    __syncthreads();
    unsigned* ctl = (unsigned*)(args.ws + WS_CTL);
    XcdBarrier bar; bar.bar = ctl + CW_BAR; bar.x = 0; bar.st = nullptr;
    if (MK_N_LAUNCHES == 1) bar = xcd_barrier_post(ctl + CW_BAR, (volatile LAS unsigned*)(lds + MISC_OFF) + 8);
    const int lo = args.ph_lo, hi = args.ph_hi;
#define IN(k) (lo <= (k) && (k) < hi)
#define SEAM(k) do { if (IN(k) && IN((k) + 1)) xcd_barrier(bar); } while (0)

    if (((PH_MASK >> 0) & 1) && IN(0)) { phase_p0(args, lds, tid, lane, wave, bid, G); }
    SEAM(0);
    if (((PH_MASK >> 1) & 1) && IN(1)) { phase_p1(args, tid, lane, wave, bid, G); }
    SEAM(1);
    if (((PH_MASK >> 2) & 1) && IN(2)) {
        pg8::Gemm g{(const bf16*)(args.ws + WS_RA), (const bf16*)(args.ws + WS_BT1), T, IN_COLS, D}; pg8::StaticOrder S; S.init(T, IN_COLS, G, bid);
        pg8::EpiBf16<0> E{(bf16*)(args.ws + WS_PROJ), IN_COLS, nullptr, 0, 0, 1.f};
        pg8::gemm_phase<pg8::EpiBf16<0>, pg8::StaticOrder, PG8_ALIGN, PG8_SP2>(lds + RING_OFF, g, S, E);
    }
    SEAM(2);
    if (((PH_MASK >> 3) & 1) && IN(3)) { phase_m1a(args, lds, tid, lane, wave, bid, G); }
    SEAM(3);
    if (((PH_MASK >> 4) & 1) && IN(4)) { phase_m1b(args, tid, lane, wave, bid, G); }
    SEAM(4);
    if (((PH_MASK >> 5) & 1) && IN(5)) { phase_m2(args, tid, bid, G); }
    SEAM(5);
    if (((PH_MASK >> 6) & 1) && IN(6)) { phase_m3(args, tid, lane, wave, bid, G); }
    SEAM(6);
    if (((PH_MASK >> 7) & 1) && IN(7)) {
        pg8::Gemm g{(const bf16*)(args.ws + WS_RA), (const bf16*)(args.ws + WS_BT2), T, D, D}; pg8::StaticOrder S; S.init(T, D, G, bid);
        pg8::EpiBf16<0> E{(bf16*)(args.ws + WS_Y1), D, nullptr, 0, 0, 1.f};
        pg8::gemm_phase<pg8::EpiBf16<0>, pg8::StaticOrder, PG8_ALIGN, PG8_SP2>(lds + RING_OFF, g, S, E);
    }
    SEAM(7);
    if (((PH_MASK >> 8) & 1) && IN(8)) { phase_e2(args, tid, lane, wave, bid, G); }
    SEAM(8);
    if (((PH_MASK >> 9) & 1) && IN(9)) {
        pg8::Gemm g{(const bf16*)(args.ws + WS_RA), (const bf16*)(args.ws + WS_BT3), T, D, D}; pg8::StaticOrder S; S.init(T, D, G, bid);
        pg8::EpiBf16<0> E{(bf16*)(args.ws + WS_Q), D, nullptr, 0, 0, 1.f};
        pg8::gemm_phase<pg8::EpiBf16<0>, pg8::StaticOrder, PG8_ALIGN, PG8_SP2>(lds + RING_OFF, g, S, E);
    }
    SEAM(9);
    if (((PH_MASK >> 10) & 1) && IN(10)) { phase_s(args, tid, lane, wave, bid, G); }
    SEAM(10);
    if (((PH_MASK >> 11) & 1) && IN(11)) { phase_pe(args, tid, lane, wave, bid, G); }
#undef IN
#undef SEAM
}

extern "C" void kernel_launch(void* const* d_in, const int* in_sizes, int n_in, void* d_out, int out_size, void* d_ws, size_t ws_size, hipStream_t stream) {
    static int grid = 0;
    if (grid == 0) {
        if (n_in != 25 || in_sizes[0] != T * D || out_size != T * D || ws_size < WS_END) {
            fprintf(stderr, "kernel_launch: built for 25 inputs, x/out of %d floats, >= %zu bytes of workspace; got n_in %d, in0 %d, out %d, ws %zu; nothing launched\n", T * D, (size_t)WS_END, n_in, n_in > 0 ? in_sizes[0] : -1, out_size, ws_size);
            grid = -1; return; }
        int dev = 0, cus = 0, per_cu = 0;
        if (hipGetDevice(&dev) != hipSuccess || hipDeviceGetAttribute(&cus, hipDeviceAttributeMultiprocessorCount, dev) != hipSuccess) { fprintf(stderr, "kernel_launch: device query failed\n"); grid = -1; return; }
        if (hipFuncSetAttribute((const void*)fwd_kernel, hipFuncAttributeMaxDynamicSharedMemorySize, LDS_BYTES) != hipSuccess) { fprintf(stderr, "kernel_launch: hipFuncSetAttribute failed\n"); grid = -1; return; }
        if (hipOccupancyMaxActiveBlocksPerMultiprocessor(&per_cu, (const void*)fwd_kernel, NTHR, LDS_BYTES) != hipSuccess || per_cu < 1)
            fprintf(stderr, "kernel_launch: note: occupancy query reports %d workgroups per CU\n", per_cu);
        (void)hipGetLastError();
        grid = cus;
    }
    if (grid < 0) return;
    if (hipMemsetAsync((char*)d_ws + WS_CTL, 0, CTL_ZERO_BYTES, stream) != hipSuccess) { fprintf(stderr, "kernel_launch: memset failed\n"); return; }
    Args a{};
    for (int i = 0; i < 25; ++i) a.in[i] = (const float*)d_in[i];
    a.out = (float*)d_out; a.ws = (unsigned char*)d_ws;
    for (int li = 0; li < MK_N_LAUNCHES; ++li) {
        if (MK_N_LAUNCHES == 1) { a.ph_lo = 0; a.ph_hi = N_PHASES; } else { a.ph_lo = li; a.ph_hi = li + 1; }
        hipLaunchKernelGGL(fwd_kernel, dim3(grid), dim3(NTHR), LDS_BYTES, stream, a);
        const hipError_t le = hipPeekAtLastError();
        if (le != hipSuccess) { fprintf(stderr, "kernel_launch: launch %d failed: %s\n", li, hipGetErrorName(le)); break; }
#if defined(MK_CHECKS)
        hipLaunchKernelGGL(chk_kernel, dim3(4), dim3(128), 0, stream, a, li);
#endif
    }
#if defined(MK_CHECKS)
    hipLaunchKernelGGL(chk_encode, dim3(1), dim3(64), 0, stream, a, MK_CHECKS);
#endif
}
```

```cpp
#include <hip/hip_runtime.h>
#include <cstdio>
#include <cstdint>
#include <cmath>
namespace pg8 {
#define PG8_LAS __attribute__((address_space(3)))
typedef unsigned short bf16_t;
typedef short bf16x8 __attribute__((ext_vector_type(8)));
typedef float f32x4 __attribute__((ext_vector_type(4)));
typedef unsigned u32x4 __attribute__((ext_vector_type(4)));
constexpr int BM = 256, BK = 64, HALF = 128, HTB = HALF * BK * 2  , STAGE_BYTES = 8 * HTB, NXCD = 8, WGM = 8;

__host__ __device__ __forceinline__ int lds_byte(int r, int c) { const int st = (r >> 4) * 2 + (c >> 5), rr = r & 15, cc = c & 31, ob = rr * 64 + cc * 2; return st * 1024 + (ob ^ (((ob >> 9) & 1) << 5)); }
__host__ __device__ __forceinline__ void stage_rc(int b, int& R, int& C) { const int st = b / 1024, sb = b % 1024, swz = sb ^ (((sb >> 9) & 1) << 5); R = (st >> 1) * 16 + swz / 64; C = (st & 1) * 32 + (swz % 64) / 2; }
__host__ __device__ __forceinline__ int perm32(int rho) { const int n = rho >> 4, i = rho & 15; return 8 * (i >> 2) + 4 * n + (i & 3); }

struct Unit { int pm, pn; };
struct Gemm { const bf16_t* A; const bf16_t* Bt; int M, N, K; };

struct StaticOrder {
    int nM, nN, nwg, G, c;
    __host__ __device__ void init(int M, int N, int G_, int c_) { nM = M / BM; nN = N / BM; nwg = nM * nN; G = G_; c = c_; }
    __host__ __device__ bool next(int i, Unit& u) const {
        const long L = (long)i * G + c; if (L >= nwg) return false;
        int wgid = (int)L; { const int q = nwg / NXCD, r = nwg % NXCD, xcd = wgid % NXCD, off = wgid / NXCD; wgid = (xcd < r ? xcd * (q + 1) : r * (q + 1) + (xcd - r) * q) + off; }
        const int nig = WGM * nN, gid = wgid / nig, fm = gid * WGM, gsz = (nM - fm) < WGM ? (nM - fm) : WGM;
        u.pm = fm + ((wgid % nig) % gsz); u.pn = (wgid % nig) / gsz; return true;
    }
    __device__ __forceinline__ void a_ready(const Unit&) const {}
    __device__ __forceinline__ void done(const Unit&) const {}
};

__device__ __forceinline__ unsigned cvt_pk_bf16(float lo, float hi) { unsigned r; asm volatile("v_cvt_pk_bf16_f32 %0, %1, %2" : "=v"(r) : "v"(lo), "v"(hi)); return r; }
typedef float f32x2 __attribute__((ext_vector_type(2)));
__device__ __forceinline__ f32x2 gelu_pk(f32x2 v) {
    const f32x2 av = __builtin_elementwise_abs(v), d = av * 0.2316418882f + 1.0f;
    f32x2 t; t.x = __builtin_amdgcn_rcpf(d.x); t.y = __builtin_amdgcn_rcpf(d.y);
    f32x2 q = t * 0.5307027145f + (-0.7265760135f); q = q * t + 0.7107068705f; q = q * t + (-0.142248368f); q = q * t + 0.127414796f; q = q * t;
    const f32x2 s = (v * v) * (-0.72134752044f);
    f32x2 e; e.x = __builtin_amdgcn_exp2f(s.x); e.y = __builtin_amdgcn_exp2f(s.y);
    const f32x2 m = v * (q * e), r = v - m;
    f32x2 o; o.x = v.x < 0.f ? m.x : r.x; o.y = v.y < 0.f ? m.y : r.y; return o;
}

template <int ACT  > struct EpiBf16 {
    static constexpr bool PERM = true, AFTER_DRAIN = false; static_assert(ACT == 0 || ACT == 1, "EpiBf16: ACT is 0 (none) or 1 (gelu_pk)");
    bf16_t* O; int ldc; const float* bias; int split_cols; size_t split_stride; float scale0;
    __device__ __forceinline__ void operator()(const f32x4 (&acc)[2][2][4][2], const Unit& u, int wr, int wc, int fr, int fq) const {
        const int row0 = u.pm * BM + wr * 64 + fr; int colt = u.pn * BM; bf16_t* base = O;
        float sc = 1.f; if (split_cols) { const int t = colt / split_cols; base += (size_t)t * split_stride; colt -= t * split_cols; if (t == 0) sc = scale0; }
        const int col0 = colt + wc * 32 + 8 * fq, bcol0 = u.pn * BM + wc * 32 + 8 * fq;
        f32x4 bv[2][2];
#pragma unroll
        for (int bj = 0; bj < 2; ++bj)
#pragma unroll
            for (int n = 0; n < 2; ++n) bv[bj][n] = bias ? *(const f32x4*)(bias + bcol0 + bj * HALF + 4 * n) : (f32x4){0.f, 0.f, 0.f, 0.f};
#pragma unroll
        for (int ai = 0; ai < 2; ++ai)
#pragma unroll
            for (int m = 0; m < 4; ++m) { bf16_t* rowp = base + (size_t)(row0 + ai * HALF + m * 16) * ldc + col0;
#pragma unroll
                for (int bj = 0; bj < 2; ++bj) { f32x4 v0 = acc[ai][bj][m][0] + bv[bj][0], v1 = acc[ai][bj][m][1] + bv[bj][1];
                    if (ACT == 1) { f32x2 a = gelu_pk((f32x2){v0[0], v0[1]}), b = gelu_pk((f32x2){v0[2], v0[3]}), c = gelu_pk((f32x2){v1[0], v1[1]}), d = gelu_pk((f32x2){v1[2], v1[3]});
                        v0 = (f32x4){a.x, a.y, b.x, b.y}; v1 = (f32x4){c.x, c.y, d.x, d.y}; }
                    v0 = v0 * sc; v1 = v1 * sc; u32x4 w; w.x = cvt_pk_bf16(v0[0], v0[1]); w.y = cvt_pk_bf16(v0[2], v0[3]); w.z = cvt_pk_bf16(v1[0], v1[1]); w.w = cvt_pk_bf16(v1[2], v1[3]);
                    *(u32x4*)(rowp + bj * HALF) = w; } }
    }
};
template <class Epi, class Sched, bool ALIGN_EPI = false, bool SP2 = false>
__device__ __forceinline__ void gemm_phase(PG8_LAS unsigned char* lds, const Gemm g, const Sched& S, const Epi& E) {
    const int tid = threadIdx.x, wid = __builtin_amdgcn_readfirstlane(tid >> 6), lane = tid & 63, wr = wid >> 2, wc = wid & 3, fr = lane & 15, fq = lane >> 4;
    const int K = g.K, nt = K / BK;
    unsigned voffA[2], voffB[2];
#pragma unroll
    for (int i = 0; i < 2; ++i) { int R, C; stage_rc(tid * 16 + i * 8192, R, C); const int Rb = Epi::PERM ? ((R & ~31) + perm32(R & 31)) : R;
        voffA[i] = (unsigned)(R * K + C) * 2u; voffB[i] = (unsigned)(Rb * K + C) * 2u; }
    const size_t kstep = (size_t)(BK * 2);
    const size_t hstep = (size_t)HALF * K * 2;
    const size_t tstep = 2 * hstep;
    const unsigned ldsw = (unsigned)wid * 1024u;
    const int aoff = lds_byte(wr * 64 + fr, fq * 8), boff = lds_byte(wc * 32 + fr, fq * 8);
#define PG8_SA(b, h) (((b) * 2 + (h)) * HTB)
#define PG8_SB(b, h) ((4 + (b) * 2 + (h)) * HTB)
#define PG8_STAGE(bufoff, gbase, voff) do { _Pragma("unroll") for (int _i = 0; _i < 2; ++_i) \
        __builtin_amdgcn_global_load_lds((const unsigned*)((const char*)(gbase) + (voff)[_i]), (PG8_LAS unsigned*)(lds + (bufoff) + ldsw + _i * 8192), 16, 0, 0); } while (0)
#define PG8_LDA(dst, b, h) do { _Pragma("unroll") for (int m = 0; m < 4; ++m) _Pragma("unroll") for (int k = 0; k < 2; ++k) dst[m][k] = *(const PG8_LAS bf16x8*)(lds + PG8_SA(b, h) + aoff + m * 2048 + k * 1024); } while (0)
#define PG8_LDB(dst, b, h) do { _Pragma("unroll") for (int n = 0; n < 2; ++n) _Pragma("unroll") for (int k = 0; k < 2; ++k) dst[n][k] = *(const PG8_LAS bf16x8*)(lds + PG8_SB(b, h) + boff + n * 2048 + k * 1024); } while (0)
#define PG8_MMA(ai, bj, At, Bt) do { __builtin_amdgcn_s_setprio(1); _Pragma("unroll") for (int m = 0; m < 4; ++m) _Pragma("unroll") for (int n = 0; n < 2; ++n) _Pragma("unroll") for (int k = 0; k < 2; ++k) \
        acc[ai][bj][m][n] = __builtin_amdgcn_mfma_f32_16x16x32_bf16(Bt[n][k], At[m][k], acc[ai][bj][m][n], 0, 0, 0); __builtin_amdgcn_s_setprio(0); } while (0)
#define PG8_WAIT_V(n) asm volatile("s_waitcnt vmcnt(" #n ")" ::: "memory")
#define PG8_WAIT_L(n) asm volatile("s_waitcnt lgkmcnt(" #n ")" ::: "memory")
#define PG8_BAR __builtin_amdgcn_s_barrier()
#define PG8_SCHED __builtin_amdgcn_sched_barrier(0)
    Unit cur, nxt; int ui = 0;
    if (!S.next(0, cur)) return;
    f32x4 acc[2][2][4][2];
#pragma unroll
    for (int a = 0; a < 2; ++a)
#pragma unroll
        for (int b = 0; b < 2; ++b)
#pragma unroll
            for (int m = 0; m < 4; ++m)
#pragma unroll
                for (int n = 0; n < 2; ++n) acc[a][b][m][n] = (f32x4){0.f, 0.f, 0.f, 0.f};
    bf16x8 At[4][2], B0[2][2], B1[2][2];
    const char* cA = (const char*)g.A + (size_t)cur.pm * tstep; const char* cB = (const char*)g.Bt + (size_t)cur.pn * tstep;
    S.a_ready(cur);
    if constexpr (SP2) {
        PG8_STAGE(PG8_SB(0, 0), cB, voffB); PG8_STAGE(PG8_SB(0, 1), cB + hstep, voffB); PG8_STAGE(PG8_SA(0, 0), cA, voffA); PG8_STAGE(PG8_SA(0, 1), cA + hstep, voffA);
        if (wr == 1) PG8_BAR;
        PG8_WAIT_V(2); PG8_BAR;
        PG8_STAGE(PG8_SB(1, 0), cB + kstep, voffB); PG8_STAGE(PG8_SA(1, 0), cA + kstep, voffA); PG8_STAGE(PG8_SB(1, 1), cB + hstep + kstep, voffB);
        PG8_WAIT_V(6); PG8_BAR;
    } else {
        PG8_STAGE(PG8_SB(0, 0), cB, voffB); PG8_STAGE(PG8_SA(0, 0), cA, voffA); PG8_STAGE(PG8_SB(0, 1), cB + hstep, voffB); PG8_STAGE(PG8_SA(0, 1), cA + hstep, voffA);
        if (wr == 1) PG8_BAR;
        PG8_WAIT_V(4); PG8_BAR;
        PG8_STAGE(PG8_SB(1, 0), cB + kstep, voffB); PG8_STAGE(PG8_SA(1, 0), cA + kstep, voffA); PG8_STAGE(PG8_SB(1, 1), cB + hstep + kstep, voffB);
        PG8_WAIT_V(6); PG8_BAR;
    }
    for (;;) {
        const bool has_next = S.next(ui + 1, nxt);
        const char* nA = has_next ? (const char*)g.A + (size_t)nxt.pm * tstep : cA; const char* nB = has_next ? (const char*)g.Bt + (size_t)nxt.pn * tstep : cB;
        for (int t = 0; t < nt; t += 2) {
            const bool last = (t == nt - 2);
            const char* a1 = cA + (size_t)(t + 1) * kstep;
            const char* a2 = last ? nA : cA + (size_t)(t + 2) * kstep; const char* b2 = last ? nB : cB + (size_t)(t + 2) * kstep;
            const char* a3 = a2 + kstep; const char* b3 = b2 + kstep;
            if (last && has_next) S.a_ready(nxt);
            if constexpr (SP2) {
            PG8_LDB(B0, 0, 0); PG8_LDB(B1, 0, 1); PG8_SCHED; PG8_LDA(At, 0, 0); PG8_STAGE(PG8_SA(1, 1), a1 + hstep, voffA);
            PG8_WAIT_V(8); PG8_WAIT_L(0); PG8_BAR; PG8_MMA(0, 0, At, B0); PG8_MMA(0, 1, At, B1); PG8_BAR; PG8_SCHED;
            PG8_LDA(At, 0, 1); PG8_STAGE(PG8_SB(0, 0), b2, voffB); PG8_STAGE(PG8_SB(0, 1), b2 + hstep, voffB); PG8_STAGE(PG8_SA(0, 0), a2, voffA);
            PG8_WAIT_V(8); PG8_WAIT_L(0); PG8_BAR; PG8_MMA(1, 0, At, B0); PG8_MMA(1, 1, At, B1); PG8_BAR; PG8_SCHED;
            PG8_LDB(B0, 1, 0); PG8_LDB(B1, 1, 1); PG8_SCHED; PG8_LDA(At, 1, 0); PG8_STAGE(PG8_SA(0, 1), a2 + hstep, voffA);
            PG8_WAIT_V(8); PG8_WAIT_L(0); PG8_BAR; PG8_MMA(0, 0, At, B0); PG8_MMA(0, 1, At, B1); PG8_BAR; PG8_SCHED;
            PG8_LDA(At, 1, 1); PG8_STAGE(PG8_SB(1, 0), b3, voffB); PG8_STAGE(PG8_SB(1, 1), b3 + hstep, voffB); PG8_STAGE(PG8_SA(1, 0), a3, voffA);
            PG8_WAIT_V(8); PG8_WAIT_L(0); PG8_BAR; PG8_MMA(1, 0, At, B0); PG8_MMA(1, 1, At, B1); PG8_BAR; PG8_SCHED;
            } else {
            PG8_LDB(B0, 0, 0); PG8_SCHED; PG8_LDA(At, 0, 0); PG8_STAGE(PG8_SA(1, 1), a1 + hstep, voffA);
            PG8_WAIT_L(8); PG8_BAR; PG8_WAIT_L(0); PG8_MMA(0, 0, At, B0); PG8_BAR; PG8_SCHED;
            PG8_LDB(B1, 0, 1); PG8_STAGE(PG8_SB(0, 0), b2, voffB);
            PG8_BAR; PG8_WAIT_L(0); PG8_MMA(0, 1, At, B1); PG8_BAR;
            PG8_LDA(At, 0, 1); PG8_STAGE(PG8_SA(0, 0), a2, voffA);
            PG8_BAR; PG8_WAIT_L(0); PG8_MMA(1, 0, At, B0); PG8_BAR; PG8_SCHED;
            PG8_STAGE(PG8_SB(0, 1), b2 + hstep, voffB);
            PG8_WAIT_V(6); PG8_BAR; PG8_MMA(1, 1, At, B1); PG8_BAR;
            PG8_LDB(B0, 1, 0); PG8_SCHED; PG8_LDA(At, 1, 0); PG8_STAGE(PG8_SA(0, 1), a2 + hstep, voffA);
            PG8_WAIT_L(8); PG8_BAR; PG8_WAIT_L(0); PG8_MMA(0, 0, At, B0); PG8_BAR; PG8_SCHED;
            PG8_LDB(B1, 1, 1); PG8_STAGE(PG8_SB(1, 0), b3, voffB);
            PG8_BAR; PG8_WAIT_L(0); PG8_MMA(0, 1, At, B1); PG8_BAR;
            PG8_LDA(At, 1, 1); PG8_STAGE(PG8_SA(1, 0), a3, voffA);
            PG8_BAR; PG8_WAIT_L(0); PG8_MMA(1, 0, At, B0); PG8_BAR; PG8_SCHED;
            PG8_STAGE(PG8_SB(1, 1), b3 + hstep, voffB);
            PG8_WAIT_V(6); PG8_BAR; PG8_MMA(1, 1, At, B1); PG8_BAR;
            }
        }
        if constexpr (ALIGN_EPI) { if (wr == 0) PG8_BAR; }
        if constexpr (!Epi::AFTER_DRAIN) { E(acc, cur, wr, wc, fr, fq); S.done(cur); }
        if (!has_next) break;
#pragma unroll
        for (int a = 0; a < 2; ++a)
#pragma unroll
            for (int b = 0; b < 2; ++b)
#pragma unroll
                for (int m = 0; m < 4; ++m)
#pragma unroll
                    for (int n = 0; n < 2; ++n) acc[a][b][m][n] = (f32x4){0.f, 0.f, 0.f, 0.f};
        cur = nxt; cA = nA; cB = nB; ++ui;
        if constexpr (ALIGN_EPI) { if (wr == 1) PG8_BAR; }
    }
    PG8_WAIT_V(0);
    if constexpr (!ALIGN_EPI) { if (wr == 0) PG8_BAR; }
    PG8_BAR;
    if constexpr (Epi::AFTER_DRAIN) { E.fused(acc, cur, wr, wc, fr, fq, lds, wid, lane); S.done(cur); }
#undef PG8_SA
#undef PG8_SB
#undef PG8_STAGE
#undef PG8_LDA
#undef PG8_LDB
#undef PG8_MMA
#undef PG8_WAIT_V
#undef PG8_WAIT_L
#undef PG8_BAR
#undef PG8_SCHED
}
}
#ifndef PG8_SP2
#define PG8_SP2 true
#endif
#ifndef PG8_ALIGN
#define PG8_ALIGN true
#endif
#ifndef OUT_MODE
#define OUT_MODE 0
#endif
#ifndef REP_MASK
#define REP_MASK 0
#endif
#ifndef PH_MASK
#define PH_MASK 0xFFF
#endif
#ifndef MK_N_LAUNCHES
#define MK_N_LAUNCHES 1
#endif

constexpr int NWAVES = 8, NTHR = NWAVES * 64;
constexpr int BATCH = 2, SEQ = 8192, D = 2048, T = BATCH * SEQ;
constexpr int LRU_W = 1024, CONF_W = 1024, IN_COLS = 4096, LRU_HD = 128;
constexpr int NH = 8, NKEY = 128, TOPK = 16, NEXP = NKEY * NKEY, KSEL = NH * TOPK;
constexpr int NMOD = 6 * D;
constexpr int CHUNK = 64, NCHUNK = SEQ / CHUNK;
constexpr int CONF_K = 31;
constexpr float EPS = 1e-6f;
constexpr int N_PHASES = 12;

constexpr size_t MiB = 1u << 20;
constexpr size_t WS_CTL = 0, CTL_ZERO_BYTES = 64 * 1024;
constexpr size_t WS_MODP = 1 * MiB;
constexpr size_t WS_CFIN = 2 * MiB;
constexpr size_t WS_CARRY = 3 * MiB;
constexpr size_t WS_AGG = 4 * MiB;
constexpr size_t WS_WG = 6 * MiB;
constexpr size_t WS_SUBK = 7 * MiB;
constexpr size_t WS_BT1 = 8 * MiB;
constexpr size_t WS_BT2 = 24 * MiB;
constexpr size_t WS_BT3 = 32 * MiB;
constexpr size_t WS_IDX = 40 * MiB;
constexpr size_t WS_GATE = 48 * MiB;
constexpr size_t WS_USC = 56 * MiB;
constexpr size_t WS_VSC = 57 * MiB;
constexpr size_t WS_RA = 64 * MiB;
constexpr size_t WS_Y1 = 128 * MiB;
constexpr size_t WS_PROJ = 192 * MiB;
constexpr size_t WS_Q = 192 * MiB;
constexpr size_t WS_UB = 256 * MiB;
constexpr size_t WS_XL = 320 * MiB;
constexpr size_t WS_ZC = 352 * MiB;
constexpr size_t WS_HLOC = 384 * MiB;
constexpr size_t WS_PC = 416 * MiB;
constexpr size_t WS_VB = 320 * MiB;
constexpr size_t WS_END = 448 * MiB;
constexpr int CW_TMO = 0, CW_BAR = 4096;

constexpr int RING_OFF = 0, RING_BYTES = 131072;
constexpr int LDSCTL_OFF = RING_BYTES, MISC_OFF = LDSCTL_OFF + 320;
constexpr int LDS_BYTES = 147456;

#define GAS __attribute__((address_space(1)))
#define LAS __attribute__((address_space(3)))
typedef unsigned short bf16;
typedef unsigned v4u __attribute__((ext_vector_type(4)));
typedef unsigned v2u __attribute__((ext_vector_type(2)));
typedef float f32x4 __attribute__((ext_vector_type(4)));
typedef float f32x16 __attribute__((ext_vector_type(16)));
typedef short bf16x8 __attribute__((ext_vector_type(8)));
typedef __bf16 bfp2 __attribute__((ext_vector_type(2)));
typedef GAS unsigned gu32;
#define RLX_AGENT __ATOMIC_RELAXED, __HIP_MEMORY_SCOPE_AGENT
#define LDS_WAIT() asm volatile("s_waitcnt lgkmcnt(0)" ::: "memory")
#define VM_WAIT() asm volatile("s_waitcnt vmcnt(0)" ::: "memory")
__device__ __forceinline__ unsigned f2bf(float f) { unsigned u = __builtin_bit_cast(unsigned, f); return (u + 0x7fffu + ((u >> 16) & 1u)) >> 16; }
__device__ __forceinline__ unsigned pk2(float lo, float hi) { return f2bf(lo) | (f2bf(hi) << 16); }
__device__ __forceinline__ float bflo(unsigned u) { return __builtin_bit_cast(float, u << 16); }
__device__ __forceinline__ float bfhi(unsigned u) { return __builtin_bit_cast(float, u & 0xffff0000u); }
__device__ __forceinline__ float wave_sum(float v) {
#pragma unroll
    for (int o = 1; o < 64; o <<= 1) v += __shfl_xor(v, o);
    return v;
}
__device__ __forceinline__ float sigmoidf_(float x) { return __builtin_amdgcn_rcpf(1.0f + __expf(-x)); }
__device__ __forceinline__ float gelu_tanh(float x) { return x * sigmoidf_(1.5957691216057308f * (x + 0.044715f * x * x * x)); }
__device__ __forceinline__ float rdlane(float v, int l) { return __builtin_bit_cast(float, __builtin_amdgcn_readlane(__builtin_bit_cast(int, v), l)); }

#define XB_TMO      128
#define XB_XCNT(j)  (256  + 64 * (j))
#define XB_XSUB(j)  (1280 + 64 * (j))
#define XB_XGEN(j)  (2304 + 64 * (j))
#define XB_TOP      3328
#define XB_TOPGEN   3392
#define XCD_BAR_WORDS 3456
#define XB_SPIN_CAP (1u << 18)

__device__ __forceinline__ unsigned xb_ld(unsigned* p)              { return __hip_atomic_load(p, __ATOMIC_RELAXED, __HIP_MEMORY_SCOPE_AGENT); }
__device__ __forceinline__ unsigned xb_add(unsigned* p, unsigned v) { return __hip_atomic_fetch_add(p, v, __ATOMIC_RELAXED, __HIP_MEMORY_SCOPE_AGENT); }
__device__ __forceinline__ unsigned xb_xcc_id() { return (unsigned)__builtin_amdgcn_s_getreg((3 << 11) | 20) & 0xFu; }
#define XB_SPIN(cond, bar) do { unsigned _sp = 0; while (cond) { __builtin_amdgcn_s_sleep(1); \
    if ((++_sp & 255u) == 0u) { if (xb_ld(&(bar)[XB_TMO])) break; if (_sp > XB_SPIN_CAP) { atomicAdd(&(bar)[XB_TMO], 1u); break; } } } } while (0)

struct XcdBarrier {
    unsigned* bar; unsigned x;
    volatile LAS unsigned* st;
};

__device__ __forceinline__ XcdBarrier xcd_barrier_post(unsigned* bar, volatile LAS unsigned* st) {
    XcdBarrier b; b.bar = bar; b.x = xb_xcc_id(); b.st = st;
    if (threadIdx.x == 0) (void)xb_add(&bar[XB_XCNT(b.x)], 1u);
    return b;
}
__device__ __forceinline__ void xcd_barrier_complete(unsigned* bar, unsigned x, unsigned& nloc, unsigned& nx) {
    const unsigned G = gridDim.x * gridDim.y * gridDim.z;
    unsigned sum, cnt, mine, sp = 0u;
    for (;;) {
        sum = 0u; cnt = 0u; mine = 0u;
#pragma unroll
        for (unsigned j = 0; j < 16; ++j) { const unsigned c = xb_ld(&bar[XB_XCNT(j)]); sum += c; cnt += (c > 0u) ? 1u : 0u; mine = (j == x) ? c : mine; }
        if (sum == G) break;
        __builtin_amdgcn_s_sleep(1);
        if ((++sp & 255u) == 0u) { if (xb_ld(&bar[XB_TMO])) break; if (sp > XB_SPIN_CAP) { atomicAdd(&bar[XB_TMO], 1u); break; } }
    }
    nloc = mine > 0u ? mine : 1u; nx = cnt > 0u ? cnt : 1u;
}

__device__ __forceinline__ void xcd_barrier(const XcdBarrier& b) {
    asm volatile("s_waitcnt vmcnt(0)" ::: "memory");
    __syncthreads();
    if (threadIdx.x == 0) {
        unsigned* bar = b.bar;
        __builtin_amdgcn_s_waitcnt(0);
        unsigned nloc = b.st[0], nx = b.st[1];
        if (nloc == 0u) { xcd_barrier_complete(bar, b.x, nloc, nx); b.st[0] = nloc; b.st[1] = nx; }
        const unsigned old = xb_add(&bar[XB_XSUB(b.x)], 1u);
        const unsigned gen = old / nloc;
        if (old + 1u == (gen + 1u) * nloc) {
            __builtin_amdgcn_fence(__ATOMIC_RELEASE, "agent");
            asm volatile("s_waitcnt vmcnt(0)" ::: "memory");
            const unsigned og = xb_add(&bar[XB_TOP], 1u);
            const unsigned tg = og / nx;
            if (og + 1u == (tg + 1u) * nx) xb_add(&bar[XB_TOPGEN], 1u);
            else XB_SPIN(xb_ld(&bar[XB_TOPGEN]) == tg, bar);
            __builtin_amdgcn_fence(__ATOMIC_ACQUIRE, "agent");
            xb_add(&bar[XB_XGEN(b.x)], 1u);
            asm volatile("s_waitcnt vmcnt(0)" ::: "memory");
        } else {
            XB_SPIN(xb_ld(&bar[XB_XGEN(b.x)]) == gen, bar);
            __builtin_amdgcn_fence(__ATOMIC_ACQUIRE, "agent");
            asm volatile("s_waitcnt vmcnt(0)" ::: "memory");
        }
    }
    __syncthreads();
}
struct Args { const float* in[25]; float* out; unsigned char* ws; int ph_lo, ph_hi, li, pad; };
enum { I_X = 0, I_C, I_WMOD, I_BMOD, I_GPREMIX, I_GPOSTMIX, I_GPREFFN, I_GPOSTFFN, I_WIN, I_LCW, I_LCB, I_WA, I_BA, I_WX, I_BX, I_LAMBDA,
       I_CDW, I_CDB, I_LNG, I_LNB, I_WOUT, I_WQ, I_SUBK, I_PU, I_PV };

__device__ __forceinline__ float mod_at(const float* modp, int b, int n) {
    return (modp[(0 * 2 + b) * NMOD + n] + modp[(1 * 2 + b) * NMOD + n]) + (modp[(2 * 2 + b) * NMOD + n] + modp[(3 * 2 + b) * NMOD + n]);
}

__device__ __forceinline__ void p0_transpose_item(const float* W, int K, int N, bf16* WT, LAS float* scr, int item, int lane) {
    const int nblk = N / 32, kb = item / nblk, nb = item % nblk, k0 = 64 * kb, n0 = 32 * nb;
#pragma unroll 8
    for (int i = 0; i < 32; ++i) { const int kk = 2 * i + (lane >> 5); scr[kk * 33 + (lane & 31)] = W[(size_t)(k0 + kk) * N + n0 + (lane & 31)]; }
    LDS_WAIT(); asm volatile("" ::: "memory");
    const int c = lane & 7;
#pragma unroll
    for (int j = 0; j < 4; ++j) { const int n = (lane >> 3) + 8 * j; const LAS float* s = scr + (8 * c) * 33 + n;
        v4u o; o.x = pk2(s[0 * 33], s[1 * 33]); o.y = pk2(s[2 * 33], s[3 * 33]); o.z = pk2(s[4 * 33], s[5 * 33]); o.w = pk2(s[6 * 33], s[7 * 33]);
        *(GAS v4u*)(WT + (size_t)(n0 + n) * K + k0 + 8 * c) = o; }
    LDS_WAIT(); asm volatile("" ::: "memory");
}
__device__ __forceinline__ void cvt_rows_bf16(const float* src, bf16* dst, size_t n8, size_t gt, size_t ngt) {
    for (size_t i = gt; i < n8; i += ngt) {
        const f32x4 a = ((const GAS f32x4*)src)[2 * i], b = ((const GAS f32x4*)src)[2 * i + 1];
        v4u o; o.x = pk2(a.x, a.y); o.y = pk2(a.z, a.w); o.z = pk2(b.x, b.y); o.w = pk2(b.z, b.w);
        ((GAS v4u*)dst)[i] = o; }
}
__device__ __forceinline__ void phase_p0(const Args& A, LAS unsigned char* lds, int tid, int lane, int wave, int bid, int G) {
    float* modp = (float*)(A.ws + WS_MODP);
    for (int item = bid; item < 192; item += G) {
        const int cg = item % 48, kq = item / 48, k0 = kq * 512 + wave * 64, n0 = cg * 256 + lane * 4;
        const float c0 = A.in[I_C][k0 + lane], c1 = A.in[I_C][D + k0 + lane];
        const float ca0 = c0 * sigmoidf_(c0), ca1 = c1 * sigmoidf_(c1);
        f32x4 a0 = {0.f, 0.f, 0.f, 0.f}, a1 = {0.f, 0.f, 0.f, 0.f};
        const float* wp = A.in[I_WMOD] + (size_t)k0 * NMOD + n0;
#pragma unroll 8
        for (int kk = 0; kk < 64; ++kk) {
            const f32x4 w = *(const GAS f32x4*)(wp + (size_t)kk * NMOD);
            const float s0 = __shfl(ca0, kk), s1 = __shfl(ca1, kk);
            a0 += w * s0; a1 += w * s1;
        }
        LAS f32x4* red = (LAS f32x4*)lds;
        red[(wave * 2 + 0) * 64 + lane] = a0; red[(wave * 2 + 1) * 64 + lane] = a1;
        __syncthreads();
        { const int b = tid >> 8, col = tid & 255; const LAS float* rf = (const LAS float*)lds; float s = 0.f;
#pragma unroll
          for (int w = 0; w < 8; ++w) s += rf[((w * 2 + b) * 64) * 4 + col];
          if (kq == 0) s += A.in[I_BMOD][cg * 256 + col];
          modp[(kq * 2 + b) * NMOD + cg * 256 + col] = s; }
        __syncthreads();
    }
    {
        LAS float* scr = (LAS float*)(lds + wave * 16384);
        const int gw = bid * NWAVES + wave, NGW = G * NWAVES;
        constexpr int I1 = (D / 64) * (IN_COLS / 32), I2 = (D / 64) * (D / 32);
        for (int it = gw; it < I1 + 2 * I2; it += NGW) {
            int r = it;
            if (r < I1) { p0_transpose_item(A.in[I_WIN], D, IN_COLS, (bf16*)(A.ws + WS_BT1), scr, r, lane); continue; } r -= I1;
            if (r < I2) { p0_transpose_item(A.in[I_WOUT], D, D, (bf16*)(A.ws + WS_BT2), scr, r, lane); continue; } r -= I2;
            p0_transpose_item(A.in[I_WQ], D, D, (bf16*)(A.ws + WS_BT3), scr, r, lane);
        }
    }
    {
        const int gt = bid * NTHR + tid, ngt = G * NTHR;
        bf16* wg = (bf16*)(A.ws + WS_WG);
        for (int e = gt; e < NH * 256 * 128; e += ngt) {
            const int h = e >> 15, n = (e >> 7) & 255, k = e & 127;
            const float v = (n < 128 ? A.in[I_WA] : A.in[I_WX])[h * 16384 + k * 128 + (n & 127)];
            wg[e] = (bf16)f2bf(v);
        }
        cvt_rows_bf16(A.in[I_SUBK], (bf16*)(A.ws + WS_SUBK), (size_t)NH * 2 * NKEY * 128 / 8, gt, ngt);
    }
}

__device__ __forceinline__ void phase_p1(const Args& A, int tid, int lane, int wave, int bid, int G) {
    const float* modp = (const float*)(A.ws + WS_MODP);
    {
        float* cfin = (float*)(A.ws + WS_CFIN);
        for (int e = bid * NTHR + tid; e < 2 * 2 * D; e += G * NTHR) {
            const int b = e >> 12, arr = (e >> 11) & 1, col = e & (D - 1);
            cfin[e] = arr == 0 ? mod_at(modp, b, 2 * D + col) * A.in[I_GPOSTMIX][col] : mod_at(modp, b, 5 * D + col) * A.in[I_GPOSTFFN][col];
        }
    }
    const int gw = bid * NWAVES + wave, NGW = G * NWAVES;
    bf16* h1 = (bf16*)(A.ws + WS_RA);
    int cb = -1; float gs[4][8], sh[4][8];
    for (int row = gw; row < T; row += NGW) {
        const int b = row >> 13;
        if (b != cb) { cb = b;
#pragma unroll
            for (int j = 0; j < 4; ++j)
#pragma unroll
                for (int e = 0; e < 8; ++e) { const int col = j * 512 + lane * 8 + e;
                    gs[j][e] = A.in[I_GPREMIX][col] * (1.0f + mod_at(modp, b, D + col)); sh[j][e] = mod_at(modp, b, col); } }
        const GAS f32x4* xr = (const GAS f32x4*)(A.in[I_X] + (size_t)row * D) + lane * 2;
        f32x4 v[4][2]; float s = 0.f;
#pragma unroll
        for (int j = 0; j < 4; ++j) { v[j][0] = xr[j * 128]; v[j][1] = xr[j * 128 + 1];
            s += (v[j][0].x * v[j][0].x + v[j][0].y * v[j][0].y) + (v[j][0].z * v[j][0].z + v[j][0].w * v[j][0].w);
            s += (v[j][1].x * v[j][1].x + v[j][1].y * v[j][1].y) + (v[j][1].z * v[j][1].z + v[j][1].w * v[j][1].w); }
        const float rstd = __builtin_amdgcn_rsqf(wave_sum(s) * (1.0f / D) + EPS);
        GAS v4u* orow = (GAS v4u*)(h1 + (size_t)row * D) + lane;
#pragma unroll
        for (int j = 0; j < 4; ++j) { float o[8];
#pragma unroll
            for (int e = 0; e < 8; ++e) o[e] = v[j][e >> 2][e & 3] * rstd * gs[j][e] + sh[j][e];
            v4u w; w.x = pk2(o[0], o[1]); w.y = pk2(o[2], o[3]); w.z = pk2(o[4], o[5]); w.w = pk2(o[6], o[7]);
            orow[j * 64] = w; }
    }
}

__device__ __forceinline__ void phase_m1a(const Args& A, LAS unsigned char* lds, int tid, int lane, int wave, int bid, int G) {
    const bf16* proj = (const bf16*)(A.ws + WS_PROJ);
    {
        bf16* xl = (bf16*)(A.ws + WS_XL);
        const float* w4 = A.in[I_LCW]; const float* b4 = A.in[I_LCB];
        for (int it = bid * NTHR + tid; it < T * 128; it += G * NTHR) {
            const int row = it >> 7, c0 = (it & 127) * 8, t = row & (SEQ - 1);
            float acc[8];
            { const f32x4 ba = *(const GAS f32x4*)(b4 + c0), bb = *(const GAS f32x4*)(b4 + c0 + 4);
              acc[0] = ba.x; acc[1] = ba.y; acc[2] = ba.z; acc[3] = ba.w; acc[4] = bb.x; acc[5] = bb.y; acc[6] = bb.z; acc[7] = bb.w; }
#pragma unroll
            for (int j = 0; j < 4; ++j) {
                if (t - 3 + j >= 0) {
                    const v4u v = *(const GAS v4u*)(proj + (size_t)(row - 3 + j) * IN_COLS + c0);
                    const f32x4 wa = *(const GAS f32x4*)(w4 + j * LRU_W + c0), wb = *(const GAS f32x4*)(w4 + j * LRU_W + c0 + 4);
                    acc[0] += wa.x * bflo(v.x); acc[1] += wa.y * bfhi(v.x); acc[2] += wa.z * bflo(v.y); acc[3] += wa.w * bfhi(v.y);
                    acc[4] += wb.x * bflo(v.z); acc[5] += wb.y * bfhi(v.z); acc[6] += wb.z * bflo(v.w); acc[7] += wb.w * bfhi(v.w);
                }
            }
            v4u o; o.x = pk2(acc[0], acc[1]); o.y = pk2(acc[2], acc[3]); o.z = pk2(acc[4], acc[5]); o.w = pk2(acc[6], acc[7]);
            *(GAS v4u*)(xl + (size_t)row * LRU_W + c0) = o;
        }
    }
    {
        bf16* zc = (bf16*)(A.ws + WS_ZC);
        const float* w31 = A.in[I_CDW]; const float* b31 = A.in[I_CDB];
        LAS float* zt = (LAS float*)lds;
        for (int item = bid; item < 2 * 64 * 8; item += G) {
            const int b = item >> 9, tt = (item >> 3) & 63, ct = item & 7;
            const int t0 = tt * 128;
            __syncthreads();
            for (int e = tid; e < 158 * 16; e += NTHR) {
                const int r = e >> 4, c8 = (e & 15) * 8, t = t0 - 30 + r;
                f32x4 z0 = {0.f, 0.f, 0.f, 0.f}, z1 = {0.f, 0.f, 0.f, 0.f};
                if (t >= 0) {
                    const bf16* p = proj + (size_t)(b * SEQ + t) * IN_COLS + 2048 + ct * 128 + c8;
                    const v4u v = *(const GAS v4u*)p, g = *(const GAS v4u*)(p + 1024);
                    z0.x = bflo(v.x) * sigmoidf_(bflo(g.x)); z0.y = bfhi(v.x) * sigmoidf_(bfhi(g.x)); z0.z = bflo(v.y) * sigmoidf_(bflo(g.y)); z0.w = bfhi(v.y) * sigmoidf_(bfhi(g.y));
                    z1.x = bflo(v.z) * sigmoidf_(bflo(g.z)); z1.y = bfhi(v.z) * sigmoidf_(bfhi(g.z)); z1.z = bflo(v.w) * sigmoidf_(bflo(g.w)); z1.w = bfhi(v.w) * sigmoidf_(bfhi(g.w));
                }
                *(LAS f32x4*)(zt + r * 128 + c8) = z0; *(LAS f32x4*)(zt + r * 128 + c8 + 4) = z1;
            }
            __syncthreads();
            const int c = tid & 127, tg = tid >> 7, ch = ct * 128 + c;
            float w[CONF_K];
#pragma unroll
            for (int j = 0; j < CONF_K; ++j) w[j] = w31[j * CONF_W + ch];
            float acc[32]; const float bias = b31[ch];
#pragma unroll
            for (int i = 0; i < 32; ++i) acc[i] = bias;
#pragma unroll
            for (int s = 0; s < 62; ++s) {
                const float v = zt[(tg * 32 + s) * 128 + c];
#pragma unroll
                for (int i = 0; i < 32; ++i) if (s - i >= 0 && s - i < CONF_K) acc[i] += w[s - i] * v;
            }
            bf16* zo = zc + (size_t)(b * SEQ + t0 + tg * 32) * CONF_W + ch;
#pragma unroll
            for (int i = 0; i < 32; ++i) zo[(size_t)i * CONF_W] = (bf16)f2bf(acc[i]);
        }
        __syncthreads();
    }
}

__device__ __forceinline__ void phase_m1b(const Args& A, int tid, int lane, int wave, int bid, int G) {
    const bf16* xl = (const bf16*)(A.ws + WS_XL); const bf16* wg = (const bf16*)(A.ws + WS_WG);
    bf16* hloc = (bf16*)(A.ws + WS_HLOC); bf16* pc = (bf16*)(A.ws + WS_PC); float* agg = (float*)(A.ws + WS_AGG);
    const int fr = lane & 15, fq = lane >> 4;
    for (int item = bid * NWAVES + wave; item < 2 * NCHUNK * 8; item += G * NWAVES) {
        const int hh = item & 7, chunk = (item >> 3) & (NCHUNK - 1), b = item >> 10;
        const size_t r0 = (size_t)b * SEQ + (size_t)chunk * CHUNK;
        bf16x8 xf[4][4];
#pragma unroll
        for (int mt = 0; mt < 4; ++mt)
#pragma unroll
            for (int ks = 0; ks < 4; ++ks) xf[mt][ks] = *(const GAS bf16x8*)(xl + (r0 + 16 * mt + fr) * LRU_W + hh * LRU_HD + 32 * ks + 8 * fq);
        float cP[4], cH[4];
        for (int j = 0; j < 8; ++j) {
            const int chb = hh * LRU_HD + 16 * j + 4 * fq;
            bf16x8 wa[4], wx[4];
#pragma unroll
            for (int ks = 0; ks < 4; ++ks) { wa[ks] = *(const GAS bf16x8*)(wg + (size_t)(hh * 256 + 16 * j + fr) * 128 + 32 * ks + 8 * fq);
                                             wx[ks] = *(const GAS bf16x8*)(wg + (size_t)(hh * 256 + 128 + 16 * j + fr) * 128 + 32 * ks + 8 * fq); }
            const f32x4 bav = *(const GAS f32x4*)(A.in[I_BA] + chb), bxv = *(const GAS f32x4*)(A.in[I_BX] + chb), lam = *(const GAS f32x4*)(A.in[I_LAMBDA] + chb);
            float cl[4];
#pragma unroll
            for (int r = 0; r < 4; ++r) { cl[r] = -8.0f * log1pf(__expf(-lam[r])); cP[r] = 1.f; cH[r] = 0.f; }
#pragma unroll
            for (int mt = 0; mt < 4; ++mt) {
                f32x4 ar = {0.f, 0.f, 0.f, 0.f}, ai = {0.f, 0.f, 0.f, 0.f};
#pragma unroll
                for (int ks = 0; ks < 4; ++ks) { ar = __builtin_amdgcn_mfma_f32_16x16x32_bf16(wa[ks], xf[mt][ks], ar, 0, 0, 0);
                                                 ai = __builtin_amdgcn_mfma_f32_16x16x32_bf16(wx[ks], xf[mt][ks], ai, 0, 0, 0); }
                const v2u xv = *(const GAS v2u*)(xl + (r0 + 16 * mt + fr) * LRU_W + chb);
                const float xlv[4] = {bflo(xv.x), bfhi(xv.x), bflo(xv.y), bfhi(xv.y)};
                float P[4], H[4];
#pragma unroll
                for (int r = 0; r < 4; ++r) {
                    const float rg = sigmoidf_(ar[r] + bav[r]), ig = sigmoidf_(ai[r] + bxv[r]);
                    const float la = cl[r] * rg, a = __expf(la), mult = sqrtf(fmaxf(1.0f - __expf(2.0f * la), 0.f));
                    float p = a, h = mult * ig * xlv[r];
#pragma unroll
                    for (int s = 1; s < 16; s <<= 1) { const float pp = __shfl_up(p, s, 16), hp = __shfl_up(h, s, 16);
                        if (fr >= s) { h = p * hp + h; p = p * pp; } }
                    h = h + p * cH[r]; p = p * cP[r];
                    P[r] = p; H[r] = h;
                    cP[r] = __shfl(p, 15, 16); cH[r] = __shfl(h, 15, 16);
                }
                v2u ho, po; ho.x = pk2(H[0], H[1]); ho.y = pk2(H[2], H[3]); po.x = pk2(P[0], P[1]); po.y = pk2(P[2], P[3]);
                *(GAS v2u*)(hloc + (r0 + 16 * mt + fr) * LRU_W + chb) = ho;
                *(GAS v2u*)(pc + (r0 + 16 * mt + fr) * LRU_W + chb) = po;
            }
            if (fr == 0) {
                float* ag = agg + ((size_t)(b * NCHUNK + chunk) * LRU_W + chb) * 2;
                *(GAS f32x4*)ag = (f32x4){cP[0], cH[0], cP[1], cH[1]}; *(GAS f32x4*)(ag + 4) = (f32x4){cP[2], cH[2], cP[3], cH[3]};
            }
        }
    }
}

__device__ __forceinline__ void phase_m2(const Args& A, int tid, int bid, int G) {
    const float* agg = (const float*)(A.ws + WS_AGG); float* carry = (float*)(A.ws + WS_CARRY);
    for (int e = bid * NTHR + tid; e < 2 * LRU_W; e += G * NTHR) {
        const int b = e >> 10, ch = e & (LRU_W - 1); float Hs = 0.f;
        for (int c = 0; c < NCHUNK; ++c) {
            carry[(size_t)(b * NCHUNK + c) * LRU_W + ch] = Hs;
            const float2 ab = *(const float2*)(agg + ((size_t)(b * NCHUNK + c) * LRU_W + ch) * 2);
            Hs = ab.x * Hs + ab.y;
        }
    }
}

__device__ __forceinline__ void phase_m3(const Args& A, int tid, int lane, int wave, int bid, int G) {
    const bf16* proj = (const bf16*)(A.ws + WS_PROJ); const bf16* hloc = (const bf16*)(A.ws + WS_HLOC); const bf16* pc = (const bf16*)(A.ws + WS_PC);
    const bf16* zc = (const bf16*)(A.ws + WS_ZC); const float* carry = (const float*)(A.ws + WS_CARRY);
    bf16* a2 = (bf16*)(A.ws + WS_RA);
    float lg[2][8], lb[2][8];
#pragma unroll
    for (int jj = 0; jj < 2; ++jj)
#pragma unroll
        for (int e = 0; e < 8; ++e) { lg[jj][e] = A.in[I_LNG][jj * 512 + lane * 8 + e]; lb[jj][e] = A.in[I_LNB][jj * 512 + lane * 8 + e]; }
    for (int row = bid * NWAVES + wave; row < T; row += G * NWAVES) {
        const int b = row >> 13, chunk = (row & (SEQ - 1)) >> 6;
        float zv[2][8]; float s = 0.f;
#pragma unroll
        for (int jj = 0; jj < 2; ++jj) {
            const int c0 = jj * 512 + lane * 8;
            const v4u hv = *(const GAS v4u*)(hloc + (size_t)row * LRU_W + c0), pv = *(const GAS v4u*)(pc + (size_t)row * LRU_W + c0);
            const v4u gv = *(const GAS v4u*)(proj + (size_t)row * IN_COLS + 1024 + c0);
            const float* cp = carry + (size_t)(b * NCHUNK + chunk) * LRU_W + c0;
            const f32x4 ca = *(const GAS f32x4*)cp, cb = *(const GAS f32x4*)(cp + 4);
            float y[8];
            y[0] = (bflo(hv.x) + bflo(pv.x) * ca.x) * gelu_tanh(bflo(gv.x)); y[1] = (bfhi(hv.x) + bfhi(pv.x) * ca.y) * gelu_tanh(bfhi(gv.x));
            y[2] = (bflo(hv.y) + bflo(pv.y) * ca.z) * gelu_tanh(bflo(gv.y)); y[3] = (bfhi(hv.y) + bfhi(pv.y) * ca.w) * gelu_tanh(bfhi(gv.y));
            y[4] = (bflo(hv.z) + bflo(pv.z) * cb.x) * gelu_tanh(bflo(gv.z)); y[5] = (bfhi(hv.z) + bfhi(pv.z) * cb.y) * gelu_tanh(bfhi(gv.z));
            y[6] = (bflo(hv.w) + bflo(pv.w) * cb.z) * gelu_tanh(bflo(gv.w)); y[7] = (bfhi(hv.w) + bfhi(pv.w) * cb.w) * gelu_tanh(bfhi(gv.w));
            v4u o; o.x = pk2(y[0], y[1]); o.y = pk2(y[2], y[3]); o.z = pk2(y[4], y[5]); o.w = pk2(y[6], y[7]);
            *(GAS v4u*)(a2 + (size_t)row * D + c0) = o;
            const v4u z = *(const GAS v4u*)(zc + (size_t)row * CONF_W + c0);
            zv[jj][0] = bflo(z.x); zv[jj][1] = bfhi(z.x); zv[jj][2] = bflo(z.y); zv[jj][3] = bfhi(z.y); zv[jj][4] = bflo(z.z); zv[jj][5] = bfhi(z.z); zv[jj][6] = bflo(z.w); zv[jj][7] = bfhi(z.w);
#pragma unroll
            for (int e = 0; e < 8; ++e) s += zv[jj][e];
        }
        const float mean = wave_sum(s) * (1.0f / CONF_W); float q = 0.f;
#pragma unroll
        for (int jj = 0; jj < 2; ++jj)
#pragma unroll
            for (int e = 0; e < 8; ++e) { zv[jj][e] -= mean; q += zv[jj][e] * zv[jj][e]; }
        const float rstd = __builtin_amdgcn_rsqf(wave_sum(q) * (1.0f / CONF_W) + EPS);
#pragma unroll
        for (int jj = 0; jj < 2; ++jj) { float o[8];
#pragma unroll
            for (int e = 0; e < 8; ++e) { const float n = zv[jj][e] * rstd * lg[jj][e] + lb[jj][e]; o[e] = n * sigmoidf_(n); }
            v4u w; w.x = pk2(o[0], o[1]); w.y = pk2(o[2], o[3]); w.z = pk2(o[4], o[5]); w.w = pk2(o[6], o[7]);
            *(GAS v4u*)(a2 + (size_t)row * D + 1024 + jj * 512 + lane * 8) = w; }
    }
}

typedef float f32x2 __attribute__((ext_vector_type(2)));
__device__ __forceinline__ float dpp_sum63(float v) {
    v += __builtin_bit_cast(float, __builtin_amdgcn_update_dpp(0, __builtin_bit_cast(int, v), 0xB1, 0xF, 0xF, false));
    v += __builtin_bit_cast(float, __builtin_amdgcn_update_dpp(0, __builtin_bit_cast(int, v), 0x4E, 0xF, 0xF, false));
    v += __builtin_bit_cast(float, __builtin_amdgcn_update_dpp(0, __builtin_bit_cast(int, v), 0x141, 0xF, 0xF, false));
    v += __builtin_bit_cast(float, __builtin_amdgcn_update_dpp(0, __builtin_bit_cast(int, v), 0x140, 0xF, 0xF, false));
    v += __builtin_bit_cast(float, __builtin_amdgcn_update_dpp(0, __builtin_bit_cast(int, v), 0x142, 0xA, 0xF, false));
    v += __builtin_bit_cast(float, __builtin_amdgcn_update_dpp(0, __builtin_bit_cast(int, v), 0x143, 0xC, 0xF, false));
    return v;
}
__device__ __forceinline__ float wave_total(float v) { return rdlane(dpp_sum63(v), 63); }
__device__ __forceinline__ f32x2 fp8lo(unsigned w) { return __builtin_amdgcn_cvt_pk_f32_fp8((int)w, false); }
__device__ __forceinline__ f32x2 fp8hi(unsigned w) { return __builtin_amdgcn_cvt_pk_f32_fp8((int)w, true); }
__device__ __forceinline__ void cvt_table_fp8(const float* src, unsigned char* dst, float* inv_scale, int gw, int NGW, int lane) {
    for (int r = gw; r < NEXP; r += NGW) {
        const GAS f32x4* p = (const GAS f32x4*)(src + (size_t)r * D) + lane * 4;
        f32x4 v[2][4]; float m = 0.f;
#pragma unroll
        for (int jj = 0; jj < 2; ++jj)
#pragma unroll
            for (int i = 0; i < 4; ++i) { v[jj][i] = p[jj * 256 + i]; m = fmaxf(m, fmaxf(fmaxf(fabsf(v[jj][i].x), fabsf(v[jj][i].y)), fmaxf(fabsf(v[jj][i].z), fabsf(v[jj][i].w)))); }
#pragma unroll
        for (int o = 1; o < 64; o <<= 1) m = fmaxf(m, __shfl_xor(m, o));
        const float sc = m > 0.f ? 448.0f / m : 1.0f;
#pragma unroll
        for (int jj = 0; jj < 2; ++jj) { unsigned w[4];
#pragma unroll
            for (int i = 0; i < 4; ++i) { const f32x4 t = v[jj][i] * sc;
                const float a = fminf(fmaxf(t.x, -448.f), 448.f), b = fminf(fmaxf(t.y, -448.f), 448.f), c = fminf(fmaxf(t.z, -448.f), 448.f), d = fminf(fmaxf(t.w, -448.f), 448.f);
                int pk = __builtin_amdgcn_cvt_pk_fp8_f32(a, b, 0, false); pk = __builtin_amdgcn_cvt_pk_fp8_f32(c, d, pk, true); w[i] = (unsigned)pk; }
            ((GAS v4u*)(dst + (size_t)r * D))[jj * 64 + lane] = (v4u){w[0], w[1], w[2], w[3]}; }
        if (lane == 0) inv_scale[r] = m > 0.f ? m * (1.0f / 448.0f) : 1.0f;
    }
}
__device__ __forceinline__ void phase_e2(const Args& A, int tid, int lane, int wave, int bid, int G) {
    const float* modp = (const float*)(A.ws + WS_MODP); const float* cfin = (const float*)(A.ws + WS_CFIN);
    const bf16* y1 = (const bf16*)(A.ws + WS_Y1); bf16* h2 = (bf16*)(A.ws + WS_RA);
    const int gw = bid * NWAVES + wave, NGW = G * NWAVES;
    int cb = -1; float gs[4][8], sh[4][8];
    for (int row = gw; row < T; row += NGW) {
        const int b = row >> 13;
        if (b != cb) { cb = b;
#pragma unroll
            for (int j = 0; j < 4; ++j)
#pragma unroll
                for (int e = 0; e < 8; ++e) { const int col = j * 512 + lane * 8 + e;
                    gs[j][e] = A.in[I_GPREFFN][col] * (1.0f + mod_at(modp, b, 4 * D + col)); sh[j][e] = mod_at(modp, b, 3 * D + col); } }
        const GAS f32x4* xr = (const GAS f32x4*)(A.in[I_X] + (size_t)row * D) + lane * 2;
        const GAS v4u* yr = (const GAS v4u*)(y1 + (size_t)row * D) + lane;
        const GAS f32x4* cf = (const GAS f32x4*)(cfin + (size_t)(b * 2 + 0) * D) + lane * 2;
        float xv[4][8], yv[4][8]; float s1 = 0.f;
#pragma unroll
        for (int j = 0; j < 4; ++j) { const f32x4 a = xr[j * 128], c = xr[j * 128 + 1]; const v4u y = yr[j * 64];
            xv[j][0] = a.x; xv[j][1] = a.y; xv[j][2] = a.z; xv[j][3] = a.w; xv[j][4] = c.x; xv[j][5] = c.y; xv[j][6] = c.z; xv[j][7] = c.w;
            yv[j][0] = bflo(y.x); yv[j][1] = bfhi(y.x); yv[j][2] = bflo(y.y); yv[j][3] = bfhi(y.y); yv[j][4] = bflo(y.z); yv[j][5] = bfhi(y.z); yv[j][6] = bflo(y.w); yv[j][7] = bfhi(y.w);
#pragma unroll
            for (int e = 0; e < 8; ++e) s1 += yv[j][e] * yv[j][e]; }
        const float rstd1 = __builtin_amdgcn_rsqf(wave_sum(s1) * (1.0f / D) + EPS); float s2 = 0.f;
#pragma unroll
        for (int j = 0; j < 4; ++j) { const f32x4 ca = cf[j * 128], cc = cf[j * 128 + 1]; const float cg[8] = {ca.x, ca.y, ca.z, ca.w, cc.x, cc.y, cc.z, cc.w};
#pragma unroll
            for (int e = 0; e < 8; ++e) { xv[j][e] += cg[e] * yv[j][e] * rstd1; s2 += xv[j][e] * xv[j][e]; } }
        const float rstd2 = __builtin_amdgcn_rsqf(wave_sum(s2) * (1.0f / D) + EPS);
        GAS v4u* orow = (GAS v4u*)(h2 + (size_t)row * D) + lane;
#pragma unroll
        for (int j = 0; j < 4; ++j) { float o[8];
#pragma unroll
            for (int e = 0; e < 8; ++e) o[e] = xv[j][e] * rstd2 * gs[j][e] + sh[j][e];
            v4u w; w.x = pk2(o[0], o[1]); w.y = pk2(o[2], o[3]); w.z = pk2(o[4], o[5]); w.w = pk2(o[6], o[7]);
            orow[j * 64] = w; }
    }
    cvt_table_fp8(A.in[I_PU], A.ws + WS_UB, (float*)(A.ws + WS_USC), gw, NGW, lane);
    cvt_table_fp8(A.in[I_PV], A.ws + WS_VB, (float*)(A.ws + WS_VSC), gw, NGW, lane);
}

template <int N> __device__ __forceinline__ void bitonic_sort_desc(float (&v)[N]) {
#pragma unroll
    for (int k = 2; k <= N; k <<= 1)
#pragma unroll
        for (int j = k >> 1; j > 0; j >>= 1)
#pragma unroll
            for (int i = 0; i < N; ++i) { const int l = i ^ j;
                if (l > i) { const bool desc = ((i & k) == 0); const float a = v[i], b = v[l]; const float mx = fmaxf(a, b), mn = fminf(a, b); v[i] = desc ? mx : mn; v[l] = desc ? mn : mx; } }
}
__device__ __forceinline__ void merge_top16(float (&a)[16], const float (&b)[16]) {
#pragma unroll
    for (int i = 0; i < 16; ++i) a[i] = fmaxf(a[i], b[15 - i]);
#pragma unroll
    for (int j = 8; j > 0; j >>= 1)
#pragma unroll
        for (int i = 0; i < 16; ++i) { const int l = i ^ j; if (l > i) { const float x = a[i], y = a[l]; a[i] = fmaxf(x, y); a[l] = fminf(x, y); } }
}
__device__ __forceinline__ void top16_of_64(float (&v)[64], float (&out)[16]) {
    float g[4][16];
#pragma unroll
    for (int q = 0; q < 4; ++q) {
#pragma unroll
        for (int i = 0; i < 16; ++i) g[q][i] = v[q * 16 + i];
        bitonic_sort_desc<16>(g[q]); }
    merge_top16(g[0], g[1]); merge_top16(g[2], g[3]); merge_top16(g[0], g[2]);
#pragma unroll
    for (int i = 0; i < 16; ++i) out[i] = g[0][i];
}
__device__ __forceinline__ float pack_key(float v, unsigned key, unsigned mask) { return __builtin_bit_cast(float, (__builtin_bit_cast(unsigned, v) & ~mask) | key); }
__device__ __forceinline__ void score_top16(const bf16* q, const bf16* sk, int tok, int h, int p, int l31, int hf, float (&out)[16]) {
    f32x16 acc[4];
#pragma unroll
    for (int kt = 0; kt < 4; ++kt)
#pragma unroll
        for (int r = 0; r < 16; ++r) acc[kt][r] = 0.f;
#pragma unroll 2
    for (int ks = 0; ks < 8; ++ks) {
        const bf16x8 bq = *(const GAS bf16x8*)(q + (size_t)tok * D + h * 256 + p * 128 + 16 * ks + 8 * hf);
#pragma unroll
        for (int kt = 0; kt < 4; ++kt) {
            const bf16x8 ak = *(const GAS bf16x8*)(sk + ((size_t)((h * 2 + p) * NKEY + 32 * kt + l31)) * 128 + 16 * ks + 8 * hf);
            acc[kt] = __builtin_amdgcn_mfma_f32_32x32x16_bf16(ak, bq, acc[kt], 0, 0, 0);
        }
    }
    float v[64];
#pragma unroll
    for (int kt = 0; kt < 4; ++kt)
#pragma unroll
        for (int r = 0; r < 16; ++r) v[kt * 16 + r] = pack_key(acc[kt][r], (unsigned)(32 * kt + (r & 3) + 8 * (r >> 2) + 4 * hf), 0x7Fu);
    float other[16];
    top16_of_64(v, out);
#pragma unroll
    for (int i = 0; i < 16; ++i) other[i] = __shfl_xor(out[i], 32);
    merge_top16(out, other);
}
__device__ __forceinline__ void phase_s(const Args& A, int tid, int lane, int wave, int bid, int G) {
    const bf16* q = (const bf16*)(A.ws + WS_Q); const bf16* sk = (const bf16*)(A.ws + WS_SUBK);
    int* idx = (int*)(A.ws + WS_IDX); float* gate = (float*)(A.ws + WS_GATE);
    const int l31 = lane & 31, hf = lane >> 5;
    for (int item = bid * NWAVES + wave; item < (T / 32) * NH; item += G * NWAVES) {
        const int h = item & 7, tok = (item >> 3) * 32 + l31;
        float s1[16], s2[16];
        score_top16(q, sk, tok, h, 0, l31, hf, s1);
        score_top16(q, sk, tok, h, 1, l31, hf, s2);
        float cv[64]; int n = 0;
#pragma unroll
        for (int i = 0; i < 16; ++i)
#pragma unroll
            for (int j = 0; j < 16; ++j)
                if ((i + 1) * (j + 1) <= 16) {
                    const float a = __builtin_bit_cast(float, __builtin_bit_cast(unsigned, s1[i]) & ~0x7Fu), c = __builtin_bit_cast(float, __builtin_bit_cast(unsigned, s2[j]) & ~0x7Fu);
                    cv[n++] = pack_key(a + c, (unsigned)(i * 16 + j), 0xFFu); }
#pragma unroll
        for (int m = 50; m < 64; ++m) cv[m] = -INFINITY;
        float c16[16];
        top16_of_64(cv, c16);
        float ev[16], esum = 0.f; const float cmax = __builtin_bit_cast(float, __builtin_bit_cast(unsigned, c16[0]) & ~0xFFu);
#pragma unroll
        for (int m = 0; m < 16; ++m) { ev[m] = __expf(__builtin_bit_cast(float, __builtin_bit_cast(unsigned, c16[m]) & ~0xFFu) - cmax); esum += ev[m]; }
        const float rs = 1.0f / esum;
        int oi[8]; float og[8];
#pragma unroll
        for (int mm = 0; mm < 8; ++mm) {
            float c_lo = c16[mm], c_hi = c16[8 + mm], e_lo = ev[mm], e_hi = ev[8 + mm];
            asm volatile("" : "+v"(c_lo), "+v"(c_hi), "+v"(e_lo), "+v"(e_hi));
            const unsigned cb = __builtin_bit_cast(unsigned, hf ? c_hi : c_lo); const int ii = (cb >> 4) & 15, jj = cb & 15;
            int row = 0, col = 0;
#pragma unroll
            for (int k = 0; k < 16; ++k) { row = (ii == k) ? (int)(__builtin_bit_cast(unsigned, s1[k]) & 0x7Fu) : row; col = (jj == k) ? (int)(__builtin_bit_cast(unsigned, s2[k]) & 0x7Fu) : col; }
            oi[mm] = row * NKEY + col; og[mm] = (hf ? e_hi : e_lo) * rs;
        }
        int* ip = idx + (size_t)tok * KSEL + h * 16 + hf * 8; float* gp = gate + (size_t)tok * KSEL + h * 16 + hf * 8;
        *(GAS v4u*)ip = (v4u){(unsigned)oi[0], (unsigned)oi[1], (unsigned)oi[2], (unsigned)oi[3]}; *(GAS v4u*)(ip + 4) = (v4u){(unsigned)oi[4], (unsigned)oi[5], (unsigned)oi[6], (unsigned)oi[7]};
        *(GAS f32x4*)gp = (f32x4){og[0], og[1], og[2], og[3]}; *(GAS f32x4*)(gp + 4) = (f32x4){og[4], og[5], og[6], og[7]};
    }
}

__device__ __forceinline__ float row_dot_fp8(const v4u d0, const v4u d1, const f32x2 (&hf)[2][8]) {
    const unsigned w0[4] = {d0.x, d0.y, d0.z, d0.w}, w1[4] = {d1.x, d1.y, d1.z, d1.w};
    f32x2 a = {0.f, 0.f}, b = {0.f, 0.f};
#pragma unroll
    for (int i = 0; i < 4; ++i) { a += fp8lo(w0[i]) * hf[0][2 * i]; a += fp8hi(w0[i]) * hf[0][2 * i + 1]; b += fp8lo(w1[i]) * hf[1][2 * i]; b += fp8hi(w1[i]) * hf[1][2 * i + 1]; }
    return (a.x + a.y) + (b.x + b.y);
}
__device__ __forceinline__ void row_axpy_fp8(f32x2 (&acc)[2][8], const v4u d0, const v4u d1, float w) {
    const unsigned w0[4] = {d0.x, d0.y, d0.z, d0.w}, w1[4] = {d1.x, d1.y, d1.z, d1.w};
#pragma unroll
    for (int i = 0; i < 4; ++i) { acc[0][2 * i] += fp8lo(w0[i]) * w; acc[0][2 * i + 1] += fp8hi(w0[i]) * w; acc[1][2 * i] += fp8lo(w1[i]) * w; acc[1][2 * i + 1] += fp8hi(w1[i]) * w; }
}
__device__ __forceinline__ void phase_pe(const Args& A, int tid, int lane, int wave, int bid, int G) {
    const bf16* h2 = (const bf16*)(A.ws + WS_RA); const bf16* y1 = (const bf16*)(A.ws + WS_Y1);
    const unsigned char* ub = A.ws + WS_UB; const unsigned char* vb = A.ws + WS_VB;
    const float* usc = (const float*)(A.ws + WS_USC); const float* vsc = (const float*)(A.ws + WS_VSC);
    const int* idx = (const int*)(A.ws + WS_IDX); const float* gate = (const float*)(A.ws + WS_GATE); const float* cfin = (const float*)(A.ws + WS_CFIN);
    for (int tok = bid * NWAVES + wave; tok < T; tok += G * NWAVES) {
        const int b = tok >> 13;
        f32x2 hf[2][8];
#pragma unroll
        for (int jj = 0; jj < 2; ++jj) { const GAS v4u* hp = (const GAS v4u*)(h2 + (size_t)tok * D + jj * 1024 + lane * 16); const v4u q0 = hp[0], q1 = hp[1];
            const unsigned w[8] = {q0.x, q0.y, q0.z, q0.w, q1.x, q1.y, q1.z, q1.w};
#pragma unroll
            for (int i = 0; i < 8; ++i) hf[jj][i] = (f32x2){bflo(w[i]), bfhi(w[i])}; }
        const int id0 = idx[(size_t)tok * KSEL + lane], id1 = idx[(size_t)tok * KSEL + 64 + lane];
        const float g0 = gate[(size_t)tok * KSEL + lane], g1 = gate[(size_t)tok * KSEL + 64 + lane];
        const float su0 = usc[id0], su1 = usc[id1], sv0 = vsc[id0], sv1 = vsc[id1];
        float act0 = 0.f, act1 = 0.f;
#pragma unroll 8
        for (int k = 0; k < 64; ++k) {
            const int e = __builtin_amdgcn_readlane(id0, k);
            const GAS v4u* up = (const GAS v4u*)(ub + (size_t)e * D) + lane;
            const float tot = wave_total(row_dot_fp8(up[0], up[64], hf)); act0 = (lane == k) ? tot : act0;
        }
#pragma unroll 8
        for (int k = 0; k < 64; ++k) {
            const int e = __builtin_amdgcn_readlane(id1, k);
            const GAS v4u* up = (const GAS v4u*)(ub + (size_t)e * D) + lane;
            const float tot = wave_total(row_dot_fp8(up[0], up[64], hf)); act1 = (lane == k) ? tot : act1;
        }
        const float w0 = g0 * gelu_tanh(act0 * su0) * sv0, w1 = g1 * gelu_tanh(act1 * su1) * sv1;
        f32x2 acc[2][8];
#pragma unroll
        for (int jj = 0; jj < 2; ++jj)
#pragma unroll
            for (int i = 0; i < 8; ++i) acc[jj][i] = (f32x2){0.f, 0.f};
#pragma unroll 8
        for (int k = 0; k < 64; ++k) {
            const int e = __builtin_amdgcn_readlane(id0, k); const float w = rdlane(w0, k);
            const GAS v4u* vp = (const GAS v4u*)(vb + (size_t)e * D) + lane;
            row_axpy_fp8(acc, vp[0], vp[64], w);
        }
#pragma unroll 8
        for (int k = 0; k < 64; ++k) {
            const int e = __builtin_amdgcn_readlane(id1, k); const float w = rdlane(w1, k);
            const GAS v4u* vp = (const GAS v4u*)(vb + (size_t)e * D) + lane;
            row_axpy_fp8(acc, vp[0], vp[64], w);
        }
        float s2 = 0.f;
#pragma unroll
        for (int jj = 0; jj < 2; ++jj)
#pragma unroll
            for (int i = 0; i < 8; ++i) s2 += acc[jj][i].x * acc[jj][i].x + acc[jj][i].y * acc[jj][i].y;
        const float rstd2 = __builtin_amdgcn_rsqf(wave_sum(s2) * (1.0f / D) + EPS);
        float yv[2][16]; float s1 = 0.f;
#pragma unroll
        for (int jj = 0; jj < 2; ++jj) { const GAS v4u* yp = (const GAS v4u*)(y1 + (size_t)tok * D + jj * 1024 + lane * 16); const v4u q0 = yp[0], q1 = yp[1];
            const unsigned w[8] = {q0.x, q0.y, q0.z, q0.w, q1.x, q1.y, q1.z, q1.w};
#pragma unroll
            for (int i = 0; i < 8; ++i) { yv[jj][2 * i] = bflo(w[i]); yv[jj][2 * i + 1] = bfhi(w[i]); s1 += yv[jj][2 * i] * yv[jj][2 * i] + yv[jj][2 * i + 1] * yv[jj][2 * i + 1]; } }
        const float rstd1 = __builtin_amdgcn_rsqf(wave_sum(s1) * (1.0f / D) + EPS);
#pragma unroll
        for (int jj = 0; jj < 2; ++jj) {
            const size_t off = (size_t)jj * 256 + lane * 4;
            const GAS f32x4* xr = (const GAS f32x4*)(A.in[I_X] + (size_t)tok * D) + off;
            const GAS f32x4* c1 = (const GAS f32x4*)(cfin + (size_t)(b * 2 + 0) * D) + off; const GAS f32x4* c2 = (const GAS f32x4*)(cfin + (size_t)(b * 2 + 1) * D) + off;
            GAS f32x4* orow = (GAS f32x4*)(A.out + (size_t)tok * D) + off;
#pragma unroll
            for (int q = 0; q < 4; ++q) { const f32x4 xv = xr[q], a1 = c1[q], a2 = c2[q]; f32x4 o;
                const float ya[4] = {acc[jj][2 * q].x, acc[jj][2 * q].y, acc[jj][2 * q + 1].x, acc[jj][2 * q + 1].y};
#pragma unroll
                for (int e = 0; e < 4; ++e) o[e] = xv[e] + (OUT_MODE != 2 ? a1[e] * yv[jj][4 * q + e] * rstd1 : 0.f) + (OUT_MODE != 1 ? a2[e] * ya[e] * rstd2 : 0.f);
                orow[q] = o; }
        }
    }
}

#if defined(MK_CHECKS)
constexpr int CW_CHK = 2048;
__device__ __forceinline__ unsigned hsh(unsigned x) { x ^= x >> 16; x *= 0x7feb352dU; x ^= x >> 15; x *= 0x846ca68bU; x ^= x >> 16; return x; }
__device__ __forceinline__ float bfv(const bf16* p, size_t i) { return __builtin_bit_cast(float, (unsigned)p[i] << 16); }
__device__ __forceinline__ float relerr(float got, float ref, float scale) { const float d = fabsf(got - ref) / (fabsf(ref) + scale); return (d == d) ? d : 1e30f; }
__device__ __forceinline__ void chk_put(unsigned* ctl, int stage, float e) { atomicMax(ctl + CW_CHK + stage, __builtin_bit_cast(unsigned, e)); }
__device__ float chk_gemm(const bf16* Am, const bf16* Bt, const bf16* C, int N, int K, unsigned s) {
    const int row = hsh(s) % T, col = hsh(s * 7 + 1) % N; float acc = 0.f;
    for (int k = 0; k < K; ++k) acc += bfv(Am, (size_t)row * K + k) * bfv(Bt, (size_t)col * K + k);
    return relerr(bfv(C, (size_t)row * N + col), acc, 0.05f);
}
__global__ void __launch_bounds__(128) chk_kernel(Args A, int stage) {
    __shared__ float sh[10240];
    unsigned* ctl = (unsigned*)(A.ws + WS_CTL);
    const int tid = threadIdx.x; const unsigned s = hsh(tid * 2654435761u + stage * 97u + 12345u);
    const float* modp = (const float*)(A.ws + WS_MODP);
    float e = 0.f;
    if (stage == 0) {
        { const int b = s & 1, n = hsh(s) % NMOD; float acc = A.in[I_BMOD][n];
          for (int k = 0; k < D; ++k) { const float c = A.in[I_C][b * D + k]; acc += c / (1.0f + expf(-c)) * A.in[I_WMOD][(size_t)k * NMOD + n]; }
          e = fmaxf(e, relerr(mod_at(modp, b, n), acc, 0.01f)); }
        { const int n = hsh(s + 1) % IN_COLS, k = hsh(s + 2) % D; e = fmaxf(e, relerr(bfv((const bf16*)(A.ws + WS_BT1), (size_t)n * D + k), A.in[I_WIN][(size_t)k * IN_COLS + n], 1e-3f)); }
        { const int n = hsh(s + 3) % D, k = hsh(s + 4) % D; e = fmaxf(e, relerr(bfv((const bf16*)(A.ws + WS_BT2), (size_t)n * D + k), A.in[I_WOUT][(size_t)k * D + n], 1e-3f));
          e = fmaxf(e, relerr(bfv((const bf16*)(A.ws + WS_BT3), (size_t)n * D + k), A.in[I_WQ][(size_t)k * D + n], 1e-3f)); }
        { const int h = s & 7, n = hsh(s + 5) & 255, k = hsh(s + 6) & 127; const float ref = (n < 128 ? A.in[I_WA] : A.in[I_WX])[h * 16384 + k * 128 + (n & 127)];
          e = fmaxf(e, relerr(bfv((const bf16*)(A.ws + WS_WG), (size_t)(h * 256 + n) * 128 + k), ref, 1e-3f)); }
        { const int i = hsh(s + 7) % (NH * 2 * NKEY * 128); e = fmaxf(e, relerr(bfv((const bf16*)(A.ws + WS_SUBK), i), A.in[I_SUBK][i], 1e-3f)); }
    } else if (stage == 1) {
        const int row = hsh(s) % T, col = hsh(s + 1) % D, b = row >> 13; float ss = 0.f;
        for (int k = 0; k < D; ++k) { const float x = A.in[I_X][(size_t)row * D + k]; ss += x * x; }
        const float ref = A.in[I_X][(size_t)row * D + col] * rsqrtf(ss / D + EPS) * A.in[I_GPREMIX][col] * (1.0f + mod_at(modp, b, D + col)) + mod_at(modp, b, col);
        e = relerr(bfv((const bf16*)(A.ws + WS_RA), (size_t)row * D + col), ref, 0.05f);
        const float* cfin = (const float*)(A.ws + WS_CFIN);
        e = fmaxf(e, relerr(cfin[(b * 2 + 0) * D + col], mod_at(modp, b, 2 * D + col) * A.in[I_GPOSTMIX][col], 1e-3f));
        e = fmaxf(e, relerr(cfin[(b * 2 + 1) * D + col], mod_at(modp, b, 5 * D + col) * A.in[I_GPOSTFFN][col], 1e-3f));
    } else if (stage == 2) { e = chk_gemm((const bf16*)(A.ws + WS_RA), (const bf16*)(A.ws + WS_BT1), (const bf16*)(A.ws + WS_PROJ), IN_COLS, D, s);
    } else if (stage == 7) { e = chk_gemm((const bf16*)(A.ws + WS_RA), (const bf16*)(A.ws + WS_BT2), (const bf16*)(A.ws + WS_Y1), D, D, s);
    } else if (stage == 9) { e = chk_gemm((const bf16*)(A.ws + WS_RA), (const bf16*)(A.ws + WS_BT3), (const bf16*)(A.ws + WS_Q), D, D, s);
    } else if (stage == 3) {
        const bf16* proj = (const bf16*)(A.ws + WS_PROJ);
        int row = hsh(s) % T; if (tid < 16) row = (tid & 1) * SEQ + (tid >> 1);
        const int c = hsh(s + 1) % LRU_W, t = row & (SEQ - 1);
        float a = A.in[I_LCB][c];
        for (int j = 0; j < 4; ++j) if (t - 3 + j >= 0) a += A.in[I_LCW][j * LRU_W + c] * bfv(proj, (size_t)(row - 3 + j) * IN_COLS + c);
        e = relerr(bfv((const bf16*)(A.ws + WS_XL), (size_t)row * LRU_W + c), a, 0.05f);
        float z = A.in[I_CDB][c];
        for (int j = 0; j < CONF_K; ++j) if (t - 30 + j >= 0) { const size_t r = (size_t)(row - 30 + j) * IN_COLS; const float g = bfv(proj, r + 3072 + c);
            z += A.in[I_CDW][j * CONF_W + c] * bfv(proj, r + 2048 + c) / (1.0f + expf(-g)); }
        e = fmaxf(e, relerr(bfv((const bf16*)(A.ws + WS_ZC), (size_t)row * CONF_W + c), z, 0.05f));
    } else if (stage == 4) {
        const bf16* xl = (const bf16*)(A.ws + WS_XL);
        const int b = s & 1, chunk = hsh(s + 1) % NCHUNK, ch = hsh(s + 2) % LRU_W, hh = ch >> 7, j = ch & 127;
        const float cl = -8.0f * log1pf(expf(-A.in[I_LAMBDA][ch])); float P = 1.f, H = 0.f;
        for (int t = 0; t < CHUNK; ++t) { const size_t row = (size_t)b * SEQ + chunk * CHUNK + t; float ga = A.in[I_BA][ch], gx = A.in[I_BX][ch];
            for (int i = 0; i < 128; ++i) { const float xv = bfv(xl, row * LRU_W + hh * 128 + i); ga += xv * A.in[I_WA][hh * 16384 + i * 128 + j]; gx += xv * A.in[I_WX][hh * 16384 + i * 128 + j]; }
            const float r = 1.0f / (1.0f + expf(-ga)), ig = 1.0f / (1.0f + expf(-gx)), la = cl * r, a = expf(la), u = sqrtf(fmaxf(-expm1f(2.0f * la), 0.f)) * ig * bfv(xl, row * LRU_W + ch);
            H = a * H + u; P = P * a;
            e = fmaxf(e, relerr(bfv((const bf16*)(A.ws + WS_HLOC), row * LRU_W + ch), H, 0.05f)); e = fmaxf(e, relerr(bfv((const bf16*)(A.ws + WS_PC), row * LRU_W + ch), P, 0.02f)); }
        const float* ag = (const float*)(A.ws + WS_AGG) + ((size_t)(b * NCHUNK + chunk) * LRU_W + ch) * 2;
        e = fmaxf(e, relerr(ag[0], P, 0.02f)); e = fmaxf(e, relerr(ag[1], H, 0.05f));
    } else if (stage == 5) {
        const int b = s & 1, ch = hsh(s + 1) % LRU_W; const float* agg = (const float*)(A.ws + WS_AGG); const float* carry = (const float*)(A.ws + WS_CARRY); float Hs = 0.f;
        for (int c = 0; c < NCHUNK; ++c) { e = fmaxf(e, relerr(carry[(size_t)(b * NCHUNK + c) * LRU_W + ch], Hs, 1e-3f)); const float* ag = agg + ((size_t)(b * NCHUNK + c) * LRU_W + ch) * 2; Hs = ag[0] * Hs + ag[1]; }
    } else if (stage == 6) {
        const bf16* proj = (const bf16*)(A.ws + WS_PROJ); const bf16* zc = (const bf16*)(A.ws + WS_ZC);
        const int row = hsh(s) % T, c = hsh(s + 1) % LRU_W, b = row >> 13, chunk = (row & (SEQ - 1)) >> 6;
        const float hfull = bfv((const bf16*)(A.ws + WS_HLOC), (size_t)row * LRU_W + c) + bfv((const bf16*)(A.ws + WS_PC), (size_t)row * LRU_W + c) * ((const float*)(A.ws + WS_CARRY))[(size_t)(b * NCHUNK + chunk) * LRU_W + c];
        const float g = bfv(proj, (size_t)row * IN_COLS + 1024 + c), ge = 0.5f * g * (1.0f + tanhf(0.7978845608f * (g + 0.044715f * g * g * g)));
        e = relerr(bfv((const bf16*)(A.ws + WS_RA), (size_t)row * D + c), hfull * ge, 0.05f);
        float m = 0.f, q = 0.f;
        for (int k = 0; k < CONF_W; ++k) m += bfv(zc, (size_t)row * CONF_W + k);
        m /= CONF_W;
        for (int k = 0; k < CONF_W; ++k) { const float d = bfv(zc, (size_t)row * CONF_W + k) - m; q += d * d; }
        const float n = (bfv(zc, (size_t)row * CONF_W + c) - m) * rsqrtf(q / CONF_W + EPS) * A.in[I_LNG][c] + A.in[I_LNB][c];
        e = fmaxf(e, relerr(bfv((const bf16*)(A.ws + WS_RA), (size_t)row * D + 1024 + c), n / (1.0f + expf(-n)), 0.05f));
    } else if (stage == 8) {
        const bf16* y1 = (const bf16*)(A.ws + WS_Y1); const float* cfin = (const float*)(A.ws + WS_CFIN);
        const int row = hsh(s) % T, col = hsh(s + 1) % D, b = row >> 13; float s1 = 0.f, s2 = 0.f;
        for (int k = 0; k < D; ++k) { const float y = bfv(y1, (size_t)row * D + k); s1 += y * y; }
        const float r1 = rsqrtf(s1 / D + EPS);
        for (int k = 0; k < D; ++k) { const float x1 = A.in[I_X][(size_t)row * D + k] + cfin[(b * 2) * D + k] * bfv(y1, (size_t)row * D + k) * r1; s2 += x1 * x1; }
        const float x1c = A.in[I_X][(size_t)row * D + col] + cfin[(b * 2) * D + col] * bfv(y1, (size_t)row * D + col) * r1;
        const float ref = x1c * rsqrtf(s2 / D + EPS) * A.in[I_GPREFFN][col] * (1.0f + mod_at(modp, b, 4 * D + col)) + mod_at(modp, b, 3 * D + col);
        e = relerr(bfv((const bf16*)(A.ws + WS_RA), (size_t)row * D + col), ref, 0.05f);
        const size_t i = (size_t)(hsh(s + 2) % NEXP) * D + hsh(s + 3) % D;
        { const unsigned wu = ((const unsigned*)(A.ws + WS_UB))[i >> 2] >> (8 * (i & 3)), wv = ((const unsigned*)(A.ws + WS_VB))[i >> 2] >> (8 * (i & 3));
          const float du = __builtin_amdgcn_cvt_pk_f32_fp8((int)wu, false)[0] * ((const float*)(A.ws + WS_USC))[i / D], dv = __builtin_amdgcn_cvt_pk_f32_fp8((int)wv, false)[0] * ((const float*)(A.ws + WS_VSC))[i / D];
          e = fmaxf(e, relerr(du, A.in[I_PU][i], 2e-3f) * 0.3f); e = fmaxf(e, relerr(dv, A.in[I_PV][i], 3e-2f) * 0.3f); }
    } else if (stage == 10) {
        if (tid < 32) {
            const bf16* q = (const bf16*)(A.ws + WS_Q); const int* idx = (const int*)(A.ws + WS_IDX); const float* gate = (const float*)(A.ws + WS_GATE);
            const int tok = hsh(s) % T, h = hsh(s + 1) & 7;
            float* sc = sh + tid * 320;
            for (int p = 0; p < 2; ++p) for (int n = 0; n < NKEY; ++n) { float a = 0.f;
                for (int d = 0; d < 128; ++d) a += bfv(q, (size_t)tok * D + h * 256 + p * 128 + d) * A.in[I_SUBK][((size_t)((h * 2 + p) * NKEY + n)) * 128 + d];
                sc[p * 128 + n] = a; }
            for (int p = 0; p < 2; ++p) { float prev = 1e30f; for (int it = 0; it < 16; ++it) { float best = -1e30f; int bi = 0;
                for (int n = 0; n < NKEY; ++n) { const float v = sc[p * 128 + n]; if (v < prev && v > best) { best = v; bi = n; } }
                sc[256 + p * 16 + it] = best; sc[288 + p * 16 + it] = (float)bi; prev = best; } }
            float prev = 1e30f, esum = 0.f, cmax = 0.f; int miss = 0; float gerr = 0.f;
            { float pv = 1e30f; for (int it = 0; it < 16; ++it) { float best = -1e30f;
                for (int c = 0; c < 256; ++c) { const float v = sc[256 + (c >> 4)] + sc[272 + (c & 15)]; if (v < pv && v > best) best = v; }
                if (it == 0) cmax = best; esum += expf(best - cmax); pv = best; } }
            for (int it = 0; it < 16; ++it) { float best = -1e30f; int bc = 0;
                for (int c = 0; c < 256; ++c) { const float v = sc[256 + (c >> 4)] + sc[272 + (c & 15)]; if (v < prev && v > best) { best = v; bc = c; } }
                prev = best;
                const int eidx = (int)sc[288 + (bc >> 4)] * NKEY + (int)sc[304 + (bc & 15)]; const float g = expf(best - cmax) / esum; bool found = false;
                for (int m = 0; m < 16; ++m) if (idx[(size_t)tok * KSEL + h * 16 + m] == eidx) { found = true; gerr = fmaxf(gerr, relerr(gate[(size_t)tok * KSEL + h * 16 + m], g, 0.02f)); }
                if (!found) ++miss; }
            e = fmaxf((float)miss / 16.0f, gerr);
        }
    } else if (stage == 11) {
        const bf16* h2 = (const bf16*)(A.ws + WS_RA); const bf16* y1 = (const bf16*)(A.ws + WS_Y1); const int* idx = (const int*)(A.ws + WS_IDX); const float* gate = (const float*)(A.ws + WS_GATE); const float* cfin = (const float*)(A.ws + WS_CFIN);
        const int tok = hsh(blockIdx.x * 977u + 5u) % T, b = tok >> 13;
        { const int ex = idx[(size_t)tok * KSEL + tid]; float a = 0.f;
          if ((unsigned)ex < (unsigned)NEXP) { for (int d = 0; d < D; ++d) a += bfv(h2, (size_t)tok * D + d) * A.in[I_PU][(size_t)ex * D + d]; } else a = 1e30f;
          const float ge = 0.5f * a * (1.0f + tanhf(0.7978845608f * (a + 0.044715f * a * a * a)));
          sh[tid] = gate[(size_t)tok * KSEL + tid] * ge; sh[128 + tid] = __builtin_bit_cast(float, ex); }
        __syncthreads();
        float s2 = 0.f, s1 = 0.f;
        for (int cc = 0; cc < 16; ++cc) { const int col = cc * 128 + tid; float a = 0.f;
            for (int k = 0; k < KSEL; ++k) { const int ex = __builtin_bit_cast(int, sh[128 + k]); if ((unsigned)ex < (unsigned)NEXP) a += sh[k] * A.in[I_PV][(size_t)ex * D + col]; }
            sh[512 + cc * 128 + tid] = a; s2 += a * a; const float y = bfv(y1, (size_t)tok * D + col); s1 += y * y; }
        __syncthreads(); sh[256 + tid] = s2; sh[384 + tid] = s1; __syncthreads();
        float t2 = 0.f, t1 = 0.f; for (int k = 0; k < 128; ++k) { t2 += sh[256 + k]; t1 += sh[384 + k]; }
        const float r2 = rsqrtf(t2 / D + EPS), r1 = rsqrtf(t1 / D + EPS);
        float en = 0.f, ed = 0.f;
        for (int cc = 0; cc < 16; ++cc) { const int col = cc * 128 + tid;
            const float pterm = cfin[(b * 2 + 1) * D + col] * sh[512 + cc * 128 + tid] * r2;
            const float ref = A.in[I_X][(size_t)tok * D + col] + (OUT_MODE != 2 ? cfin[(b * 2) * D + col] * bfv(y1, (size_t)tok * D + col) * r1 : 0.f) + (OUT_MODE != 1 ? pterm : 0.f);
            const float d = A.out[(size_t)tok * D + col] - ref; en += d * d; ed += pterm * pterm; }
        __syncthreads(); sh[256 + tid] = en; sh[384 + tid] = ed; __syncthreads();
        float ten = 0.f, ted = 0.f; for (int k = 0; k < 128; ++k) { ten += sh[256 + k]; ted += sh[384 + k]; }
        e = ten / (ted + 1e-12f); if (!(e == e)) e = 1e30f;
    }
    chk_put(ctl, stage, e);
}
__global__ void chk_encode(Args A, int what) {
    const unsigned* ctl = (const unsigned*)(A.ws + WS_CTL);
    if (threadIdx.x == 0 && blockIdx.x == 0) {
        if (what < 0) {
            const float thr[N_PHASES] = {0.03f, 0.03f, 0.03f, 0.03f, 0.06f, 0.01f, 0.04f, 0.03f, 0.03f, 0.03f, 0.2f, 0.01f};
            for (int st = 0; st < N_PHASES; ++st) { const float e = __builtin_bit_cast(float, ctl[CW_CHK + st]); if (!(e <= thr[st])) { A.out[0] = 4000.0f * (float)(1 << st); break; } }
        } else {
            const float e = fminf(__builtin_bit_cast(float, ctl[CW_CHK + what]), 1e6f); A.out[0] = 4000.0f * sqrtf(1e6f * e);
        }
    }
}
#endif

__global__ void __launch_bounds__(NTHR, 2) fwd_kernel(Args args) {
    extern __shared__ __attribute__((aligned(16))) unsigned char lds_raw[];
    LAS unsigned char* lds = (LAS unsigned char*)lds_raw;
    const int tid = threadIdx.x, lane = tid & 63, wave = __builtin_amdgcn_readfirstlane(tid >> 6), bid = blockIdx.x, G = gridDim.x;
    for (int u = tid; u < (LDS_BYTES - LDSCTL_OFF) / 4; u += NTHR) ((LAS unsigned*)(lds + LDSCTL_OFF))[u] = 0u;
    __syncthreads();
    unsigned* ctl = (unsigned*)(args.ws + WS_CTL);
    XcdBarrier bar; bar.bar = ctl + CW_BAR + args.li * XCD_BAR_WORDS; bar.x = 0; bar.st = nullptr;
    if (MK_N_LAUNCHES != N_PHASES) bar = xcd_barrier_post(ctl + CW_BAR + args.li * XCD_BAR_WORDS, (volatile LAS unsigned*)(lds + MISC_OFF) + 8);
    const int lo = args.ph_lo, hi = args.ph_hi;
#define IN(k) (lo <= (k) && (k) < hi)
#define SEAM(k) do { if (IN(k) && IN((k) + 1)) xcd_barrier(bar); } while (0)
#if defined(MK_STAMP)
#define STAMP(k) do { if (bid == 0 && tid == 0) ((volatile LAS unsigned long long*)(lds + LDSCTL_OFF + 1024))[k] = __builtin_amdgcn_s_memrealtime(); } while (0)
#else
#define STAMP(k) do {} while (0)
#endif
    STAMP(0);

    if (((PH_MASK >> 0) & 1) && IN(0)) { phase_p0(args, lds, tid, lane, wave, bid, G); }
    SEAM(0); STAMP(1);
    if (((PH_MASK >> 1) & 1) && IN(1)) { phase_p1(args, tid, lane, wave, bid, G); }
    SEAM(1); STAMP(2);
    if (((PH_MASK >> 2) & 1) && IN(2)) {
        pg8::Gemm g{(const bf16*)(args.ws + WS_RA), (const bf16*)(args.ws + WS_BT1), T, IN_COLS, D}; pg8::StaticOrder S; S.init(T, IN_COLS, G, bid);
        pg8::EpiBf16<0> E{(bf16*)(args.ws + WS_PROJ), IN_COLS, nullptr, 0, 0, 1.f};
        pg8::gemm_phase<pg8::EpiBf16<0>, pg8::StaticOrder, PG8_ALIGN, PG8_SP2>(lds + RING_OFF, g, S, E);
    }
    SEAM(2); STAMP(3);
    if (((PH_MASK >> 3) & 1) && IN(3)) { phase_m1a(args, lds, tid, lane, wave, bid, G); }
    SEAM(3); STAMP(4);
    if (((PH_MASK >> 4) & 1) && IN(4)) { phase_m1b(args, tid, lane, wave, bid, G); }
    SEAM(4); STAMP(5);
    if (((PH_MASK >> 5) & 1) && IN(5)) { phase_m2(args, tid, bid, G); }
    SEAM(5); STAMP(6);
    if (((PH_MASK >> 6) & 1) && IN(6)) { phase_m3(args, tid, lane, wave, bid, G); }
    SEAM(6); STAMP(7);
    if (((PH_MASK >> 7) & 1) && IN(7)) {
        pg8::Gemm g{(const bf16*)(args.ws + WS_RA), (const bf16*)(args.ws + WS_BT2), T, D, D}; pg8::StaticOrder S; S.init(T, D, G, bid);
        pg8::EpiBf16<0> E{(bf16*)(args.ws + WS_Y1), D, nullptr, 0, 0, 1.f};
        pg8::gemm_phase<pg8::EpiBf16<0>, pg8::StaticOrder, PG8_ALIGN, PG8_SP2>(lds + RING_OFF, g, S, E);
    }
    SEAM(7); STAMP(8);
    if (((PH_MASK >> 8) & 1) && IN(8)) { phase_e2(args, tid, lane, wave, bid, G); }
    SEAM(8); STAMP(9);
    if (((PH_MASK >> 9) & 1) && IN(9)) {
        pg8::Gemm g{(const bf16*)(args.ws + WS_RA), (const bf16*)(args.ws + WS_BT3), T, D, D}; pg8::StaticOrder S; S.init(T, D, G, bid);
        pg8::EpiBf16<0> E{(bf16*)(args.ws + WS_Q), D, nullptr, 0, 0, 1.f};
        pg8::gemm_phase<pg8::EpiBf16<0>, pg8::StaticOrder, PG8_ALIGN, PG8_SP2>(lds + RING_OFF, g, S, E);
    }
    SEAM(9); STAMP(10);
    if (((PH_MASK >> 10) & 1) && IN(10)) { phase_s(args, tid, lane, wave, bid, G); }
    SEAM(10); STAMP(11);
    if (((PH_MASK >> 11) & 1) && IN(11)) { phase_pe(args, tid, lane, wave, bid, G); }
#if defined(MK_STAMP)
    STAMP(12);
    if (bid == 0 && tid == 0) { volatile LAS unsigned long long* ts = (volatile LAS unsigned long long*)(lds + LDSCTL_OFF + 1024); const float us = (float)(ts[MK_STAMP + 1] - ts[MK_STAMP]) * 0.01f; asm volatile("s_waitcnt vmcnt(0)" ::: "memory"); args.out[0] = 4000.0f * sqrtf(us); }
#endif
#undef IN
#undef SEAM
}

extern "C" void kernel_launch(void* const* d_in, const int* in_sizes, int n_in, void* d_out, int out_size, void* d_ws, size_t ws_size, hipStream_t stream) {
    static int grid = 0;
    if (grid == 0) {
        if (n_in != 25 || in_sizes[0] != T * D || out_size != T * D || ws_size < WS_END) {
            fprintf(stderr, "kernel_launch: built for 25 inputs, x/out of %d floats, >= %zu bytes of workspace; got n_in %d, in0 %d, out %d, ws %zu; nothing launched\n", T * D, (size_t)WS_END, n_in, n_in > 0 ? in_sizes[0] : -1, out_size, ws_size);
            grid = -1; return; }
        int dev = 0, cus = 0, per_cu = 0;
        if (hipGetDevice(&dev) != hipSuccess || hipDeviceGetAttribute(&cus, hipDeviceAttributeMultiprocessorCount, dev) != hipSuccess) { fprintf(stderr, "kernel_launch: device query failed\n"); grid = -1; return; }
        if (hipFuncSetAttribute((const void*)fwd_kernel, hipFuncAttributeMaxDynamicSharedMemorySize, LDS_BYTES) != hipSuccess) { fprintf(stderr, "kernel_launch: hipFuncSetAttribute failed\n"); grid = -1; return; }
        if (hipOccupancyMaxActiveBlocksPerMultiprocessor(&per_cu, (const void*)fwd_kernel, NTHR, LDS_BYTES) != hipSuccess || per_cu < 1)
            fprintf(stderr, "kernel_launch: note: occupancy query reports %d workgroups per CU\n", per_cu);
        (void)hipGetLastError();
        grid = cus;
    }
    if (grid < 0) return;
    if (hipMemsetAsync((char*)d_ws + WS_CTL, 0, CTL_ZERO_BYTES, stream) != hipSuccess) { fprintf(stderr, "kernel_launch: memset failed\n"); return; }
    Args a{};
    for (int i = 0; i < 25; ++i) a.in[i] = (const float*)d_in[i];
    a.out = (float*)d_out; a.ws = (unsigned char*)d_ws;
#if defined(MK_TIME_REP)
    const int cuts[3][2] = {{0, MK_TIME_REP + 1}, {MK_TIME_REP, MK_TIME_REP + 1}, {MK_TIME_REP + 1, N_PHASES}};
    for (int li = 0; li < 3; ++li) {
        a.ph_lo = cuts[li][0]; a.ph_hi = cuts[li][1]; a.li = li;
        if (a.ph_lo < a.ph_hi) hipLaunchKernelGGL(fwd_kernel, dim3(grid), dim3(NTHR), LDS_BYTES, stream, a);
    }
#else
    for (int li = 0; li < MK_N_LAUNCHES; ++li) {
        if (MK_N_LAUNCHES == 1) { a.ph_lo = 0; a.ph_hi = N_PHASES; } else { a.ph_lo = li; a.ph_hi = li + 1; }
        a.li = 0;
        hipLaunchKernelGGL(fwd_kernel, dim3(grid), dim3(NTHR), LDS_BYTES, stream, a);
        const hipError_t le = hipPeekAtLastError();
        if (le != hipSuccess) { fprintf(stderr, "kernel_launch: launch %d failed: %s\n", li, hipGetErrorName(le)); break; }
#if defined(MK_CHECKS)
        hipLaunchKernelGGL(chk_kernel, dim3(4), dim3(128), 0, stream, a, li);
#endif
    }
#endif
#if defined(MK_CHECKS)
    hipLaunchKernelGGL(chk_encode, dim3(1), dim3(64), 0, stream, a, MK_CHECKS);
#endif
}
```

```cpp
#include <hip/hip_runtime.h>
#include <cstdio>
#include <cstdint>
#include <cmath>
namespace pg8 {
#define PG8_LAS __attribute__((address_space(3)))
typedef unsigned short bf16_t;
typedef short bf16x8 __attribute__((ext_vector_type(8)));
typedef float f32x4 __attribute__((ext_vector_type(4)));
typedef unsigned u32x4 __attribute__((ext_vector_type(4)));
constexpr int BM = 256, BK = 64, HALF = 128, HTB = HALF * BK * 2  , STAGE_BYTES = 8 * HTB, NXCD = 8, WGM = 8;

__host__ __device__ __forceinline__ int lds_byte(int r, int c) { const int st = (r >> 4) * 2 + (c >> 5), rr = r & 15, cc = c & 31, ob = rr * 64 + cc * 2; return st * 1024 + (ob ^ (((ob >> 9) & 1) << 5)); }
__host__ __device__ __forceinline__ void stage_rc(int b, int& R, int& C) { const int st = b / 1024, sb = b % 1024, swz = sb ^ (((sb >> 9) & 1) << 5); R = (st >> 1) * 16 + swz / 64; C = (st & 1) * 32 + (swz % 64) / 2; }
__host__ __device__ __forceinline__ int perm32(int rho) { const int n = rho >> 4, i = rho & 15; return 8 * (i >> 2) + 4 * n + (i & 3); }

struct Unit { int pm, pn; };
struct Gemm { const bf16_t* A; const bf16_t* Bt; int M, N, K; };

struct StaticOrder {
    int nM, nN, nwg, G, c;
    __host__ __device__ void init(int M, int N, int G_, int c_) { nM = M / BM; nN = N / BM; nwg = nM * nN; G = G_; c = c_; }
    __host__ __device__ bool next(int i, Unit& u) const {
        const long L = (long)i * G + c; if (L >= nwg) return false;
        int wgid = (int)L; { const int q = nwg / NXCD, r = nwg % NXCD, xcd = wgid % NXCD, off = wgid / NXCD; wgid = (xcd < r ? xcd * (q + 1) : r * (q + 1) + (xcd - r) * q) + off; }
        const int nig = WGM * nN, gid = wgid / nig, fm = gid * WGM, gsz = (nM - fm) < WGM ? (nM - fm) : WGM;
        u.pm = fm + ((wgid % nig) % gsz); u.pn = (wgid % nig) / gsz; return true;
    }
    __device__ __forceinline__ void a_ready(const Unit&) const {}
    __device__ __forceinline__ void done(const Unit&) const {}
};

__device__ __forceinline__ unsigned cvt_pk_bf16(float lo, float hi) { unsigned r; asm volatile("v_cvt_pk_bf16_f32 %0, %1, %2" : "=v"(r) : "v"(lo), "v"(hi)); return r; }
typedef float f32x2 __attribute__((ext_vector_type(2)));
__device__ __forceinline__ f32x2 gelu_pk(f32x2 v) {
    const f32x2 av = __builtin_elementwise_abs(v), d = av * 0.2316418882f + 1.0f;
    f32x2 t; t.x = __builtin_amdgcn_rcpf(d.x); t.y = __builtin_amdgcn_rcpf(d.y);
    f32x2 q = t * 0.5307027145f + (-0.7265760135f); q = q * t + 0.7107068705f; q = q * t + (-0.142248368f); q = q * t + 0.127414796f; q = q * t;
    const f32x2 s = (v * v) * (-0.72134752044f);
    f32x2 e; e.x = __builtin_amdgcn_exp2f(s.x); e.y = __builtin_amdgcn_exp2f(s.y);
    const f32x2 m = v * (q * e), r = v - m;
    f32x2 o; o.x = v.x < 0.f ? m.x : r.x; o.y = v.y < 0.f ? m.y : r.y; return o;
}

template <int ACT  > struct EpiBf16 {
    static constexpr bool PERM = true, AFTER_DRAIN = false; static_assert(ACT == 0 || ACT == 1, "EpiBf16: ACT is 0 (none) or 1 (gelu_pk)");
    bf16_t* O; int ldc; const float* bias; int split_cols; size_t split_stride; float scale0;
    __device__ __forceinline__ void operator()(const f32x4 (&acc)[2][2][4][2], const Unit& u, int wr, int wc, int fr, int fq) const {
        const int row0 = u.pm * BM + wr * 64 + fr; int colt = u.pn * BM; bf16_t* base = O;
        float sc = 1.f; if (split_cols) { const int t = colt / split_cols; base += (size_t)t * split_stride; colt -= t * split_cols; if (t == 0) sc = scale0; }
        const int col0 = colt + wc * 32 + 8 * fq, bcol0 = u.pn * BM + wc * 32 + 8 * fq;
        f32x4 bv[2][2];
#pragma unroll
        for (int bj = 0; bj < 2; ++bj)
#pragma unroll
            for (int n = 0; n < 2; ++n) bv[bj][n] = bias ? *(const f32x4*)(bias + bcol0 + bj * HALF + 4 * n) : (f32x4){0.f, 0.f, 0.f, 0.f};
#pragma unroll
        for (int ai = 0; ai < 2; ++ai)
#pragma unroll
            for (int m = 0; m < 4; ++m) { bf16_t* rowp = base + (size_t)(row0 + ai * HALF + m * 16) * ldc + col0;
#pragma unroll
                for (int bj = 0; bj < 2; ++bj) { f32x4 v0 = acc[ai][bj][m][0] + bv[bj][0], v1 = acc[ai][bj][m][1] + bv[bj][1];
                    if (ACT == 1) { f32x2 a = gelu_pk((f32x2){v0[0], v0[1]}), b = gelu_pk((f32x2){v0[2], v0[3]}), c = gelu_pk((f32x2){v1[0], v1[1]}), d = gelu_pk((f32x2){v1[2], v1[3]});
                        v0 = (f32x4){a.x, a.y, b.x, b.y}; v1 = (f32x4){c.x, c.y, d.x, d.y}; }
                    v0 = v0 * sc; v1 = v1 * sc; u32x4 w; w.x = cvt_pk_bf16(v0[0], v0[1]); w.y = cvt_pk_bf16(v0[2], v0[3]); w.z = cvt_pk_bf16(v1[0], v1[1]); w.w = cvt_pk_bf16(v1[2], v1[3]);
                    *(u32x4*)(rowp + bj * HALF) = w; } }
    }
};
template <class Epi, class Sched, bool ALIGN_EPI = false, bool SP2 = false>
__device__ __forceinline__ void gemm_phase(PG8_LAS unsigned char* lds, const Gemm g, const Sched& S, const Epi& E) {
    const int tid = threadIdx.x, wid = __builtin_amdgcn_readfirstlane(tid >> 6), lane = tid & 63, wr = wid >> 2, wc = wid & 3, fr = lane & 15, fq = lane >> 4;
    const int K = g.K, nt = K / BK;
    unsigned voffA[2], voffB[2];
#pragma unroll
    for (int i = 0; i < 2; ++i) { int R, C; stage_rc(tid * 16 + i * 8192, R, C); const int Rb = Epi::PERM ? ((R & ~31) + perm32(R & 31)) : R;
        voffA[i] = (unsigned)(R * K + C) * 2u; voffB[i] = (unsigned)(Rb * K + C) * 2u; }
    const size_t kstep = (size_t)(BK * 2);
    const size_t hstep = (size_t)HALF * K * 2;
    const size_t tstep = 2 * hstep;
    const unsigned ldsw = (unsigned)wid * 1024u;
    const int aoff = lds_byte(wr * 64 + fr, fq * 8), boff = lds_byte(wc * 32 + fr, fq * 8);
#define PG8_SA(b, h) (((b) * 2 + (h)) * HTB)
#define PG8_SB(b, h) ((4 + (b) * 2 + (h)) * HTB)
#define PG8_STAGE(bufoff, gbase, voff) do { _Pragma("unroll") for (int _i = 0; _i < 2; ++_i) \
        __builtin_amdgcn_global_load_lds((const unsigned*)((const char*)(gbase) + (voff)[_i]), (PG8_LAS unsigned*)(lds + (bufoff) + ldsw + _i * 8192), 16, 0, 0); } while (0)
#define PG8_LDA(dst, b, h) do { _Pragma("unroll") for (int m = 0; m < 4; ++m) _Pragma("unroll") for (int k = 0; k < 2; ++k) dst[m][k] = *(const PG8_LAS bf16x8*)(lds + PG8_SA(b, h) + aoff + m * 2048 + k * 1024); } while (0)
#define PG8_LDB(dst, b, h) do { _Pragma("unroll") for (int n = 0; n < 2; ++n) _Pragma("unroll") for (int k = 0; k < 2; ++k) dst[n][k] = *(const PG8_LAS bf16x8*)(lds + PG8_SB(b, h) + boff + n * 2048 + k * 1024); } while (0)
#define PG8_MMA(ai, bj, At, Bt) do { __builtin_amdgcn_s_setprio(1); _Pragma("unroll") for (int m = 0; m < 4; ++m) _Pragma("unroll") for (int n = 0; n < 2; ++n) _Pragma("unroll") for (int k = 0; k < 2; ++k) \
        acc[ai][bj][m][n] = __builtin_amdgcn_mfma_f32_16x16x32_bf16(Bt[n][k], At[m][k], acc[ai][bj][m][n], 0, 0, 0); __builtin_amdgcn_s_setprio(0); } while (0)
#define PG8_WAIT_V(n) asm volatile("s_waitcnt vmcnt(" #n ")" ::: "memory")
#define PG8_WAIT_L(n) asm volatile("s_waitcnt lgkmcnt(" #n ")" ::: "memory")
#define PG8_BAR __builtin_amdgcn_s_barrier()
#define PG8_SCHED __builtin_amdgcn_sched_barrier(0)
    Unit cur, nxt; int ui = 0;
    if (!S.next(0, cur)) return;
    f32x4 acc[2][2][4][2];
#pragma unroll
    for (int a = 0; a < 2; ++a)
#pragma unroll
        for (int b = 0; b < 2; ++b)
#pragma unroll
            for (int m = 0; m < 4; ++m)
#pragma unroll
                for (int n = 0; n < 2; ++n) acc[a][b][m][n] = (f32x4){0.f, 0.f, 0.f, 0.f};
    bf16x8 At[4][2], B0[2][2], B1[2][2];
    const char* cA = (const char*)g.A + (size_t)cur.pm * tstep; const char* cB = (const char*)g.Bt + (size_t)cur.pn * tstep;
    S.a_ready(cur);
    if constexpr (SP2) {
        PG8_STAGE(PG8_SB(0, 0), cB, voffB); PG8_STAGE(PG8_SB(0, 1), cB + hstep, voffB); PG8_STAGE(PG8_SA(0, 0), cA, voffA); PG8_STAGE(PG8_SA(0, 1), cA + hstep, voffA);
        if (wr == 1) PG8_BAR;
        PG8_WAIT_V(2); PG8_BAR;
        PG8_STAGE(PG8_SB(1, 0), cB + kstep, voffB); PG8_STAGE(PG8_SA(1, 0), cA + kstep, voffA); PG8_STAGE(PG8_SB(1, 1), cB + hstep + kstep, voffB);
        PG8_WAIT_V(6); PG8_BAR;
    } else {
        PG8_STAGE(PG8_SB(0, 0), cB, voffB); PG8_STAGE(PG8_SA(0, 0), cA, voffA); PG8_STAGE(PG8_SB(0, 1), cB + hstep, voffB); PG8_STAGE(PG8_SA(0, 1), cA + hstep, voffA);
        if (wr == 1) PG8_BAR;
        PG8_WAIT_V(4); PG8_BAR;
        PG8_STAGE(PG8_SB(1, 0), cB + kstep, voffB); PG8_STAGE(PG8_SA(1, 0), cA + kstep, voffA); PG8_STAGE(PG8_SB(1, 1), cB + hstep + kstep, voffB);
        PG8_WAIT_V(6); PG8_BAR;
    }
    for (;;) {
        const bool has_next = S.next(ui + 1, nxt);
        const char* nA = has_next ? (const char*)g.A + (size_t)nxt.pm * tstep : cA; const char* nB = has_next ? (const char*)g.Bt + (size_t)nxt.pn * tstep : cB;
        for (int t = 0; t < nt; t += 2) {
            const bool last = (t == nt - 2);
            const char* a1 = cA + (size_t)(t + 1) * kstep;
            const char* a2 = last ? nA : cA + (size_t)(t + 2) * kstep; const char* b2 = last ? nB : cB + (size_t)(t + 2) * kstep;
            const char* a3 = a2 + kstep; const char* b3 = b2 + kstep;
            if (last && has_next) S.a_ready(nxt);
            if constexpr (SP2) {
            PG8_LDB(B0, 0, 0); PG8_LDB(B1, 0, 1); PG8_SCHED; PG8_LDA(At, 0, 0); PG8_STAGE(PG8_SA(1, 1), a1 + hstep, voffA);
            PG8_WAIT_V(8); PG8_WAIT_L(0); PG8_BAR; PG8_MMA(0, 0, At, B0); PG8_MMA(0, 1, At, B1); PG8_BAR; PG8_SCHED;
            PG8_LDA(At, 0, 1); PG8_STAGE(PG8_SB(0, 0), b2, voffB); PG8_STAGE(PG8_SB(0, 1), b2 + hstep, voffB); PG8_STAGE(PG8_SA(0, 0), a2, voffA);
            PG8_WAIT_V(8); PG8_WAIT_L(0); PG8_BAR; PG8_MMA(1, 0, At, B0); PG8_MMA(1, 1, At, B1); PG8_BAR; PG8_SCHED;
            PG8_LDB(B0, 1, 0); PG8_LDB(B1, 1, 1); PG8_SCHED; PG8_LDA(At, 1, 0); PG8_STAGE(PG8_SA(0, 1), a2 + hstep, voffA);
            PG8_WAIT_V(8); PG8_WAIT_L(0); PG8_BAR; PG8_MMA(0, 0, At, B0); PG8_MMA(0, 1, At, B1); PG8_BAR; PG8_SCHED;
            PG8_LDA(At, 1, 1); PG8_STAGE(PG8_SB(1, 0), b3, voffB); PG8_STAGE(PG8_SB(1, 1), b3 + hstep, voffB); PG8_STAGE(PG8_SA(1, 0), a3, voffA);
            PG8_WAIT_V(8); PG8_WAIT_L(0); PG8_BAR; PG8_MMA(1, 0, At, B0); PG8_MMA(1, 1, At, B1); PG8_BAR; PG8_SCHED;
            } else {
            PG8_LDB(B0, 0, 0); PG8_SCHED; PG8_LDA(At, 0, 0); PG8_STAGE(PG8_SA(1, 1), a1 + hstep, voffA);
            PG8_WAIT_L(8); PG8_BAR; PG8_WAIT_L(0); PG8_MMA(0, 0, At, B0); PG8_BAR; PG8_SCHED;
            PG8_LDB(B1, 0, 1); PG8_STAGE(PG8_SB(0, 0), b2, voffB);
            PG8_BAR; PG8_WAIT_L(0); PG8_MMA(0, 1, At, B1); PG8_BAR;
            PG8_LDA(At, 0, 1); PG8_STAGE(PG8_SA(0, 0), a2, voffA);
            PG8_BAR; PG8_WAIT_L(0); PG8_MMA(1, 0, At, B0); PG8_BAR; PG8_SCHED;
            PG8_STAGE(PG8_SB(0, 1), b2 + hstep, voffB);
            PG8_WAIT_V(6); PG8_BAR; PG8_MMA(1, 1, At, B1); PG8_BAR;
            PG8_LDB(B0, 1, 0); PG8_SCHED; PG8_LDA(At, 1, 0); PG8_STAGE(PG8_SA(0, 1), a2 + hstep, voffA);
            PG8_WAIT_L(8); PG8_BAR; PG8_WAIT_L(0); PG8_MMA(0, 0, At, B0); PG8_BAR; PG8_SCHED;
            PG8_LDB(B1, 1, 1); PG8_STAGE(PG8_SB(1, 0), b3, voffB);
            PG8_BAR; PG8_WAIT_L(0); PG8_MMA(0, 1, At, B1); PG8_BAR;
            PG8_LDA(At, 1, 1); PG8_STAGE(PG8_SA(1, 0), a3, voffA);
            PG8_BAR; PG8_WAIT_L(0); PG8_MMA(1, 0, At, B0); PG8_BAR; PG8_SCHED;
            PG8_STAGE(PG8_SB(1, 1), b3 + hstep, voffB);
            PG8_WAIT_V(6); PG8_BAR; PG8_MMA(1, 1, At, B1); PG8_BAR;
            }
        }
        if constexpr (ALIGN_EPI) { if (wr == 0) PG8_BAR; }
        if constexpr (!Epi::AFTER_DRAIN) { E(acc, cur, wr, wc, fr, fq); S.done(cur); }
        if (!has_next) break;
#pragma unroll
        for (int a = 0; a < 2; ++a)
#pragma unroll
            for (int b = 0; b < 2; ++b)
#pragma unroll
                for (int m = 0; m < 4; ++m)
#pragma unroll
                    for (int n = 0; n < 2; ++n) acc[a][b][m][n] = (f32x4){0.f, 0.f, 0.f, 0.f};
        cur = nxt; cA = nA; cB = nB; ++ui;
        if constexpr (ALIGN_EPI) { if (wr == 1) PG8_BAR; }
    }
    PG8_WAIT_V(0);
    if constexpr (!ALIGN_EPI) { if (wr == 0) PG8_BAR; }
    PG8_BAR;
    if constexpr (Epi::AFTER_DRAIN) { E.fused(acc, cur, wr, wc, fr, fq, lds, wid, lane); S.done(cur); }
#undef PG8_SA
#undef PG8_SB
#undef PG8_STAGE
#undef PG8_LDA
#undef PG8_LDB
#undef PG8_MMA
#undef PG8_WAIT_V
#undef PG8_WAIT_L
#undef PG8_BAR
#undef PG8_SCHED
}
}
#ifndef PG8_SP2
#define PG8_SP2 true
#endif
#ifndef PG8_ALIGN
#define PG8_ALIGN true
#endif
#ifndef OUT_MODE
#define OUT_MODE 0
#endif
#ifndef REP_MASK
#define REP_MASK 0
#endif
#ifndef PE_SORT
#define PE_SORT 1
#endif
#ifndef PH_MASK
#define PH_MASK 0xFFF
#endif
#ifndef MK_N_LAUNCHES
#define MK_N_LAUNCHES 1
#endif

constexpr int NWAVES = 8, NTHR = NWAVES * 64;
constexpr int BATCH = 2, SEQ = 8192, D = 2048, T = BATCH * SEQ;
constexpr int LRU_W = 1024, CONF_W = 1024, IN_COLS = 4096, LRU_HD = 128;
constexpr int NH = 8, NKEY = 128, TOPK = 16, NEXP = NKEY * NKEY, KSEL = NH * TOPK;
constexpr int NMOD = 6 * D;
constexpr int CHUNK = 64, NCHUNK = SEQ / CHUNK;
constexpr int CONF_K = 31;
constexpr float EPS = 1e-6f;
constexpr int N_PHASES = 11;

constexpr size_t MiB = 1u << 20;
constexpr size_t WS_CTL = 0, CTL_ZERO_BYTES = 64 * 1024;
constexpr size_t WS_MODP = 1 * MiB;
constexpr size_t WS_CFIN = 2 * MiB;
constexpr size_t WS_CARRY = 3 * MiB;
constexpr size_t WS_AGG = 4 * MiB;
constexpr size_t WS_WG = 6 * MiB;
constexpr size_t WS_SUBK = 7 * MiB;
constexpr size_t WS_BT1 = 8 * MiB;
constexpr size_t WS_BT2 = 24 * MiB;
constexpr size_t WS_BT3 = 32 * MiB;
constexpr size_t WS_IDX = 40 * MiB;
constexpr size_t WS_GATE = 48 * MiB;
constexpr size_t WS_USC = 56 * MiB;
constexpr size_t WS_VSC = 57 * MiB;
constexpr size_t WS_RA = 64 * MiB;
constexpr size_t WS_Y1 = 128 * MiB;
constexpr size_t WS_PROJ = 192 * MiB;
constexpr size_t WS_Q = 192 * MiB;
constexpr size_t WS_UB = 256 * MiB;
constexpr size_t WS_XL = 320 * MiB;
constexpr size_t WS_ZC = 352 * MiB;
constexpr size_t WS_HLOC = 384 * MiB;
constexpr size_t WS_PC = 416 * MiB;
constexpr size_t WS_VB = 320 * MiB;
constexpr size_t WS_END = 448 * MiB;
constexpr int CW_TMO = 0, CW_BAR = 4096;

constexpr int RING_OFF = 0, RING_BYTES = 131072;
constexpr int LDSCTL_OFF = RING_BYTES, MISC_OFF = LDSCTL_OFF + 320;
constexpr int LDS_BYTES = 147456;

#define GAS __attribute__((address_space(1)))
#define LAS __attribute__((address_space(3)))
typedef unsigned short bf16;
typedef unsigned v4u __attribute__((ext_vector_type(4)));
typedef unsigned v2u __attribute__((ext_vector_type(2)));
typedef float f32x4 __attribute__((ext_vector_type(4)));
typedef float f32x16 __attribute__((ext_vector_type(16)));
typedef float f32x2 __attribute__((ext_vector_type(2)));
typedef short bf16x8 __attribute__((ext_vector_type(8)));
typedef __bf16 bfp2 __attribute__((ext_vector_type(2)));
typedef GAS unsigned gu32;
#define RLX_AGENT __ATOMIC_RELAXED, __HIP_MEMORY_SCOPE_AGENT
#define LDS_WAIT() asm volatile("s_waitcnt lgkmcnt(0)" ::: "memory")
#define VM_WAIT() asm volatile("s_waitcnt vmcnt(0)" ::: "memory")
__device__ __forceinline__ unsigned f2bf(float f) { unsigned u = __builtin_bit_cast(unsigned, f); return (u + 0x7fffu + ((u >> 16) & 1u)) >> 16; }
__device__ __forceinline__ unsigned pk2(float lo, float hi) { return f2bf(lo) | (f2bf(hi) << 16); }
__device__ __forceinline__ float bflo(unsigned u) { return __builtin_bit_cast(float, u << 16); }
__device__ __forceinline__ float bfhi(unsigned u) { return __builtin_bit_cast(float, u & 0xffff0000u); }
__device__ __forceinline__ float wave_sum(float v) {
#pragma unroll
    for (int o = 1; o < 64; o <<= 1) v += __shfl_xor(v, o);
    return v;
}
__device__ __forceinline__ float sigmoidf_(float x) { return __builtin_amdgcn_rcpf(1.0f + __expf(-x)); }
__device__ __forceinline__ float gelu_tanh(float x) { return x * sigmoidf_(1.5957691216057308f * (x + 0.044715f * x * x * x)); }
__device__ __forceinline__ float rdlane(float v, int l) { return __builtin_bit_cast(float, __builtin_amdgcn_readlane(__builtin_bit_cast(int, v), l)); }

#define XB_TMO      128
#define XB_XCNT(j)  (256  + 64 * (j))
#define XB_XSUB(j)  (1280 + 64 * (j))
#define XB_XGEN(j)  (2304 + 64 * (j))
#define XB_TOP      3328
#define XB_TOPGEN   3392
#define XCD_BAR_WORDS 3456
#define XB_SPIN_CAP (1u << 18)

__device__ __forceinline__ unsigned xb_ld(unsigned* p)              { return __hip_atomic_load(p, __ATOMIC_RELAXED, __HIP_MEMORY_SCOPE_AGENT); }
__device__ __forceinline__ unsigned xb_add(unsigned* p, unsigned v) { return __hip_atomic_fetch_add(p, v, __ATOMIC_RELAXED, __HIP_MEMORY_SCOPE_AGENT); }
__device__ __forceinline__ unsigned xb_xcc_id() { return (unsigned)__builtin_amdgcn_s_getreg((3 << 11) | 20) & 0xFu; }
#define XB_SPIN(cond, bar) do { unsigned _sp = 0; while (cond) { __builtin_amdgcn_s_sleep(1); \
    if ((++_sp & 255u) == 0u) { if (xb_ld(&(bar)[XB_TMO])) break; if (_sp > XB_SPIN_CAP) { atomicAdd(&(bar)[XB_TMO], 1u); break; } } } } while (0)

struct XcdBarrier {
    unsigned* bar; unsigned x;
    volatile LAS unsigned* st;
};

__device__ __forceinline__ XcdBarrier xcd_barrier_post(unsigned* bar, volatile LAS unsigned* st) {
    XcdBarrier b; b.bar = bar; b.x = xb_xcc_id(); b.st = st;
    if (threadIdx.x == 0) (void)xb_add(&bar[XB_XCNT(b.x)], 1u);
    return b;
}
__device__ __forceinline__ void xcd_barrier_complete(unsigned* bar, unsigned x, unsigned& nloc, unsigned& nx) {
    const unsigned G = gridDim.x * gridDim.y * gridDim.z;
    unsigned sum, cnt, mine, sp = 0u;
    for (;;) {
        sum = 0u; cnt = 0u; mine = 0u;
#pragma unroll
        for (unsigned j = 0; j < 16; ++j) { const unsigned c = xb_ld(&bar[XB_XCNT(j)]); sum += c; cnt += (c > 0u) ? 1u : 0u; mine = (j == x) ? c : mine; }
        if (sum == G) break;
        __builtin_amdgcn_s_sleep(1);
        if ((++sp & 255u) == 0u) { if (xb_ld(&bar[XB_TMO])) break; if (sp > XB_SPIN_CAP) { atomicAdd(&bar[XB_TMO], 1u); break; } }
    }
    nloc = mine > 0u ? mine : 1u; nx = cnt > 0u ? cnt : 1u;
}

__device__ __forceinline__ void xcd_barrier(const XcdBarrier& b) {
    asm volatile("s_waitcnt vmcnt(0)" ::: "memory");
    __syncthreads();
    if (threadIdx.x == 0) {
        unsigned* bar = b.bar;
        __builtin_amdgcn_s_waitcnt(0);
        unsigned nloc = b.st[0], nx = b.st[1];
        if (nloc == 0u) { xcd_barrier_complete(bar, b.x, nloc, nx); b.st[0] = nloc; b.st[1] = nx; }
        const unsigned old = xb_add(&bar[XB_XSUB(b.x)], 1u);
        const unsigned gen = old / nloc;
        if (old + 1u == (gen + 1u) * nloc) {
            __builtin_amdgcn_fence(__ATOMIC_RELEASE, "agent");
            asm volatile("s_waitcnt vmcnt(0)" ::: "memory");
            const unsigned og = xb_add(&bar[XB_TOP], 1u);
            const unsigned tg = og / nx;
            if (og + 1u == (tg + 1u) * nx) xb_add(&bar[XB_TOPGEN], 1u);
            else XB_SPIN(xb_ld(&bar[XB_TOPGEN]) == tg, bar);
            __builtin_amdgcn_fence(__ATOMIC_ACQUIRE, "agent");
            xb_add(&bar[XB_XGEN(b.x)], 1u);
            asm volatile("s_waitcnt vmcnt(0)" ::: "memory");
        } else {
            XB_SPIN(xb_ld(&bar[XB_XGEN(b.x)]) == gen, bar);
            __builtin_amdgcn_fence(__ATOMIC_ACQUIRE, "agent");
            asm volatile("s_waitcnt vmcnt(0)" ::: "memory");
        }
    }
    __syncthreads();
}
struct Args { const float* in[25]; float* out; unsigned char* ws; int ph_lo, ph_hi, li, pad; };
enum { I_X = 0, I_C, I_WMOD, I_BMOD, I_GPREMIX, I_GPOSTMIX, I_GPREFFN, I_GPOSTFFN, I_WIN, I_LCW, I_LCB, I_WA, I_BA, I_WX, I_BX, I_LAMBDA,
       I_CDW, I_CDB, I_LNG, I_LNB, I_WOUT, I_WQ, I_SUBK, I_PU, I_PV };

__device__ __forceinline__ float mod_at(const float* modp, int b, int n) {
    return (modp[(0 * 2 + b) * NMOD + n] + modp[(1 * 2 + b) * NMOD + n]) + (modp[(2 * 2 + b) * NMOD + n] + modp[(3 * 2 + b) * NMOD + n]);
}

__device__ __forceinline__ void p0_transpose_item(const float* W, int K, int N, bf16* WT, LAS float* scr, int item, int lane) {
    const int nblk = N / 32, kb = item / nblk, nb = item % nblk, k0 = 64 * kb, n0 = 32 * nb;
#pragma unroll 8
    for (int i = 0; i < 32; ++i) { const int kk = 2 * i + (lane >> 5); scr[kk * 33 + (lane & 31)] = W[(size_t)(k0 + kk) * N + n0 + (lane & 31)]; }
    LDS_WAIT(); asm volatile("" ::: "memory");
    const int c = lane & 7;
#pragma unroll
    for (int j = 0; j < 4; ++j) { const int n = (lane >> 3) + 8 * j; const LAS float* s = scr + (8 * c) * 33 + n;
        v4u o; o.x = pk2(s[0 * 33], s[1 * 33]); o.y = pk2(s[2 * 33], s[3 * 33]); o.z = pk2(s[4 * 33], s[5 * 33]); o.w = pk2(s[6 * 33], s[7 * 33]);
        *(GAS v4u*)(WT + (size_t)(n0 + n) * K + k0 + 8 * c) = o; }
    LDS_WAIT(); asm volatile("" ::: "memory");
}
__device__ __forceinline__ void cvt_rows_bf16(const float* src, bf16* dst, size_t n8, size_t gt, size_t ngt) {
    for (size_t i = gt; i < n8; i += ngt) {
        const f32x4 a = ((const GAS f32x4*)src)[2 * i], b = ((const GAS f32x4*)src)[2 * i + 1];
        v4u o; o.x = pk2(a.x, a.y); o.y = pk2(a.z, a.w); o.z = pk2(b.x, b.y); o.w = pk2(b.z, b.w);
        ((GAS v4u*)dst)[i] = o; }
}
__device__ __forceinline__ void phase_p0(const Args& A, LAS unsigned char* lds, int tid, int lane, int wave, int bid, int G) {
    float* modp = (float*)(A.ws + WS_MODP);
    for (int item = bid; item < 192; item += G) {
        const int cg = item % 48, kq = item / 48, k0 = kq * 512 + wave * 64, n0 = cg * 256 + lane * 4;
        const float c0 = A.in[I_C][k0 + lane], c1 = A.in[I_C][D + k0 + lane];
        const float ca0 = c0 * sigmoidf_(c0), ca1 = c1 * sigmoidf_(c1);
        f32x4 a0 = {0.f, 0.f, 0.f, 0.f}, a1 = {0.f, 0.f, 0.f, 0.f};
        const float* wp = A.in[I_WMOD] + (size_t)k0 * NMOD + n0;
#pragma unroll 8
        for (int kk = 0; kk < 64; ++kk) {
            const f32x4 w = *(const GAS f32x4*)(wp + (size_t)kk * NMOD);
            const float s0 = __shfl(ca0, kk), s1 = __shfl(ca1, kk);
            a0 += w * s0; a1 += w * s1;
        }
        LAS f32x4* red = (LAS f32x4*)lds;
        red[(wave * 2 + 0) * 64 + lane] = a0; red[(wave * 2 + 1) * 64 + lane] = a1;
        __syncthreads();
        { const int b = tid >> 8, col = tid & 255; const LAS float* rf = (const LAS float*)lds; float s = 0.f;
#pragma unroll
          for (int w = 0; w < 8; ++w) s += rf[((w * 2 + b) * 64) * 4 + col];
          if (kq == 0) s += A.in[I_BMOD][cg * 256 + col];
          modp[(kq * 2 + b) * NMOD + cg * 256 + col] = s; }
        __syncthreads();
    }
    {
        LAS float* scr = (LAS float*)(lds + wave * 16384);
        const int gw = bid * NWAVES + wave, NGW = G * NWAVES;
        constexpr int I1 = (D / 64) * (IN_COLS / 32), I2 = (D / 64) * (D / 32);
        for (int it = gw; it < I1 + 2 * I2; it += NGW) {
            int r = it;
            if (r < I1) { p0_transpose_item(A.in[I_WIN], D, IN_COLS, (bf16*)(A.ws + WS_BT1), scr, r, lane); continue; } r -= I1;
            if (r < I2) { p0_transpose_item(A.in[I_WOUT], D, D, (bf16*)(A.ws + WS_BT2), scr, r, lane); continue; } r -= I2;
            p0_transpose_item(A.in[I_WQ], D, D, (bf16*)(A.ws + WS_BT3), scr, r, lane);
        }
    }
    {
        const int gt = bid * NTHR + tid, ngt = G * NTHR;
        bf16* wg = (bf16*)(A.ws + WS_WG);
        for (int e = gt; e < NH * 256 * 128; e += ngt) {
            const int h = e >> 15, n = (e >> 7) & 255, k = e & 127;
            const float v = (n < 128 ? A.in[I_WA] : A.in[I_WX])[h * 16384 + k * 128 + (n & 127)];
            wg[e] = (bf16)f2bf(v);
        }
        cvt_rows_bf16(A.in[I_SUBK], (bf16*)(A.ws + WS_SUBK), (size_t)NH * 2 * NKEY * 128 / 8, gt, ngt);
    }
}

__device__ __forceinline__ void phase_p1(const Args& A, int tid, int lane, int wave, int bid, int G) {
    const float* modp = (const float*)(A.ws + WS_MODP);
    {
        float* cfin = (float*)(A.ws + WS_CFIN);
        for (int e = bid * NTHR + tid; e < 2 * 2 * D; e += G * NTHR) {
            const int b = e >> 12, arr = (e >> 11) & 1, col = e & (D - 1);
            cfin[e] = arr == 0 ? mod_at(modp, b, 2 * D + col) * A.in[I_GPOSTMIX][col] : mod_at(modp, b, 5 * D + col) * A.in[I_GPOSTFFN][col];
        }
    }
    const int gw = bid * NWAVES + wave, NGW = G * NWAVES;
    bf16* h1 = (bf16*)(A.ws + WS_RA);
    int cb = -1; float gs[4][8], sh[4][8];
    for (int row = gw; row < T; row += NGW) {
        const int b = row >> 13;
        if (b != cb) { cb = b;
#pragma unroll
            for (int j = 0; j < 4; ++j)
#pragma unroll
                for (int e = 0; e < 8; ++e) { const int col = j * 512 + lane * 8 + e;
                    gs[j][e] = A.in[I_GPREMIX][col] * (1.0f + mod_at(modp, b, D + col)); sh[j][e] = mod_at(modp, b, col); } }
        const GAS f32x4* xr = (const GAS f32x4*)(A.in[I_X] + (size_t)row * D) + lane * 2;
        f32x4 v[4][2]; float s = 0.f;
#pragma unroll
        for (int j = 0; j < 4; ++j) { v[j][0] = xr[j * 128]; v[j][1] = xr[j * 128 + 1];
            s += (v[j][0].x * v[j][0].x + v[j][0].y * v[j][0].y) + (v[j][0].z * v[j][0].z + v[j][0].w * v[j][0].w);
            s += (v[j][1].x * v[j][1].x + v[j][1].y * v[j][1].y) + (v[j][1].z * v[j][1].z + v[j][1].w * v[j][1].w); }
        const float rstd = __builtin_amdgcn_rsqf(wave_sum(s) * (1.0f / D) + EPS);
        GAS v4u* orow = (GAS v4u*)(h1 + (size_t)row * D) + lane;
#pragma unroll
        for (int j = 0; j < 4; ++j) { float o[8];
#pragma unroll
            for (int e = 0; e < 8; ++e) o[e] = v[j][e >> 2][e & 3] * rstd * gs[j][e] + sh[j][e];
            v4u w; w.x = pk2(o[0], o[1]); w.y = pk2(o[2], o[3]); w.z = pk2(o[4], o[5]); w.w = pk2(o[6], o[7]);
            orow[j * 64] = w; }
    }
}

__device__ __forceinline__ void m1a_tile_issue(const bf16* proj, int item, int tid, v4u (&rv)[5], v4u (&rg)[5]) {
    const int b = item >> 9, tt = (item >> 3) & 63, ct = item & 7, t0 = tt * 128;
#pragma unroll
    for (int i = 0; i < 5; ++i) {
        const int e = tid + i * NTHR, r = e >> 4, c8 = (e & 15) * 8, t = t0 - 30 + r;
        rv[i] = (v4u){0u, 0u, 0u, 0u}; rg[i] = (v4u){0u, 0u, 0u, 0u};
        if (e < 158 * 16 && t >= 0) { const bf16* p = proj + (size_t)(b * SEQ + t) * IN_COLS + 2048 + ct * 128 + c8; rv[i] = *(const GAS v4u*)p; rg[i] = *(const GAS v4u*)(p + 1024); }
    }
}
__device__ __forceinline__ void phase_m1a(const Args& A, LAS unsigned char* lds, int tid, int lane, int wave, int bid, int G) {
    const bf16* proj = (const bf16*)(A.ws + WS_PROJ);
    {
        bf16* xl = (bf16*)(A.ws + WS_XL);
        const float* w4 = A.in[I_LCW]; const float* b4 = A.in[I_LCB];
        for (int it = bid * NTHR + tid; it < (T / 16) * 128; it += G * NTHR) {
            const int c0 = (it & 127) * 8, run = it >> 7, row0 = run * 16, t0 = row0 & (SEQ - 1);
            v4u in[19];
#pragma unroll
            for (int r = 0; r < 19; ++r) { in[r] = (v4u){0u, 0u, 0u, 0u}; if (t0 - 3 + r >= 0) in[r] = *(const GAS v4u*)(proj + (size_t)(row0 - 3 + r) * IN_COLS + c0); }
            float w[4][8], bb[8];
#pragma unroll
            for (int j = 0; j < 4; ++j) { const f32x4 wa = *(const GAS f32x4*)(w4 + j * LRU_W + c0), wb = *(const GAS f32x4*)(w4 + j * LRU_W + c0 + 4);
                w[j][0] = wa.x; w[j][1] = wa.y; w[j][2] = wa.z; w[j][3] = wa.w; w[j][4] = wb.x; w[j][5] = wb.y; w[j][6] = wb.z; w[j][7] = wb.w; }
            { const f32x4 ba = *(const GAS f32x4*)(b4 + c0), bc = *(const GAS f32x4*)(b4 + c0 + 4); bb[0] = ba.x; bb[1] = ba.y; bb[2] = ba.z; bb[3] = ba.w; bb[4] = bc.x; bb[5] = bc.y; bb[6] = bc.z; bb[7] = bc.w; }
#pragma unroll
            for (int i = 0; i < 16; ++i) { float acc[8];
#pragma unroll
                for (int e = 0; e < 8; ++e) acc[e] = bb[e];
#pragma unroll
                for (int j = 0; j < 4; ++j) { const v4u v = in[i + j];
                    acc[0] += w[j][0] * bflo(v.x); acc[1] += w[j][1] * bfhi(v.x); acc[2] += w[j][2] * bflo(v.y); acc[3] += w[j][3] * bfhi(v.y);
                    acc[4] += w[j][4] * bflo(v.z); acc[5] += w[j][5] * bfhi(v.z); acc[6] += w[j][6] * bflo(v.w); acc[7] += w[j][7] * bfhi(v.w); }
                v4u o; o.x = pk2(acc[0], acc[1]); o.y = pk2(acc[2], acc[3]); o.z = pk2(acc[4], acc[5]); o.w = pk2(acc[6], acc[7]);
                *(GAS v4u*)(xl + (size_t)(row0 + i) * LRU_W + c0) = o; }
        }
    }
    {
        bf16* zc = (bf16*)(A.ws + WS_ZC);
        const float* w31 = A.in[I_CDW]; const float* b31 = A.in[I_CDB];
        LAS float* zt = (LAS float*)lds;
        const int cp = tid & 63, tg = tid >> 6;
        v4u rv[5], rg[5];
        int item = bid;
        if (item < 2 * 64 * 8) m1a_tile_issue(proj, item, tid, rv, rg);
        float w0[CONF_K], w1[CONF_K], bias0 = 0.f, bias1 = 0.f; int wct = -1;
        for (; item < 2 * 64 * 8; item += G) {
            const int b = item >> 9, tt = (item >> 3) & 63, ct = item & 7, t0 = tt * 128, ch = ct * 128 + 2 * cp;
            if (ct != wct) { wct = ct;
#pragma unroll
                for (int j = 0; j < CONF_K; ++j) { const f32x2 ww = *(const GAS f32x2*)(w31 + j * CONF_W + ch); w0[j] = ww.x; w1[j] = ww.y; }
                const f32x2 bw = *(const GAS f32x2*)(b31 + ch); bias0 = bw.x; bias1 = bw.y; }
            __syncthreads();
#pragma unroll
            for (int i = 0; i < 5; ++i) {
                const int e = tid + i * NTHR, r = e >> 4, c8 = (e & 15) * 8;
                if (e < 158 * 16) { const v4u v = rv[i], g = rg[i]; f32x4 z0, z1;
                    z0.x = bflo(v.x) * sigmoidf_(bflo(g.x)); z0.y = bfhi(v.x) * sigmoidf_(bfhi(g.x)); z0.z = bflo(v.y) * sigmoidf_(bflo(g.y)); z0.w = bfhi(v.y) * sigmoidf_(bfhi(g.y));
                    z1.x = bflo(v.z) * sigmoidf_(bflo(g.z)); z1.y = bfhi(v.z) * sigmoidf_(bfhi(g.z)); z1.z = bflo(v.w) * sigmoidf_(bflo(g.w)); z1.w = bfhi(v.w) * sigmoidf_(bfhi(g.w));
                    *(LAS f32x4*)(zt + r * 128 + c8) = z0; *(LAS f32x4*)(zt + r * 128 + c8 + 4) = z1; }
            }
            __syncthreads();
            if (item + G < 2 * 64 * 8) m1a_tile_issue(proj, item + G, tid, rv, rg);
            float a0[16], a1[16];
#pragma unroll
            for (int i = 0; i < 16; ++i) { a0[i] = bias0; a1[i] = bias1; }
#pragma unroll
            for (int s_ = 0; s_ < 46; ++s_) {
                const f32x2 v = *(const LAS f32x2*)(zt + (tg * 16 + s_) * 128 + 2 * cp);
#pragma unroll
                for (int i = 0; i < 16; ++i) if (s_ - i >= 0 && s_ - i < CONF_K) { a0[i] += w0[s_ - i] * v.x; a1[i] += w1[s_ - i] * v.y; }
            }
            bf16* zo = zc + (size_t)(b * SEQ + t0 + tg * 16) * CONF_W + ch;
#pragma unroll
            for (int i = 0; i < 16; ++i) *(GAS unsigned*)(zo + (size_t)i * CONF_W) = pk2(a0[i], a1[i]);
        }
        __syncthreads();
    }
}

__device__ __forceinline__ void phase_m1b(const Args& A, int tid, int lane, int wave, int bid, int G) {
    const bf16* xl = (const bf16*)(A.ws + WS_XL); const bf16* wg = (const bf16*)(A.ws + WS_WG);
    bf16* hloc = (bf16*)(A.ws + WS_HLOC); bf16* pc = (bf16*)(A.ws + WS_PC); float* agg = (float*)(A.ws + WS_AGG);
    const int fr = lane & 15, fq = lane >> 4;
    for (int item = bid * NWAVES + wave; item < 2 * NCHUNK * 8; item += G * NWAVES) {
        const int hh = item & 7, chunk = (item >> 3) & (NCHUNK - 1), b = item >> 10;
        const size_t r0 = (size_t)b * SEQ + (size_t)chunk * CHUNK;
        bf16x8 xf[4][4];
#pragma unroll
        for (int mt = 0; mt < 4; ++mt)
#pragma unroll
            for (int ks = 0; ks < 4; ++ks) xf[mt][ks] = *(const GAS bf16x8*)(xl + (r0 + 16 * mt + fr) * LRU_W + hh * LRU_HD + 32 * ks + 8 * fq);
        float cP[4], cH[4];
        for (int j = 0; j < 8; ++j) {
            const int chb = hh * LRU_HD + 16 * j + 4 * fq;
            bf16x8 wa[4], wx[4];
#pragma unroll
            for (int ks = 0; ks < 4; ++ks) { wa[ks] = *(const GAS bf16x8*)(wg + (size_t)(hh * 256 + 16 * j + fr) * 128 + 32 * ks + 8 * fq);
                                             wx[ks] = *(const GAS bf16x8*)(wg + (size_t)(hh * 256 + 128 + 16 * j + fr) * 128 + 32 * ks + 8 * fq); }
            const f32x4 bav = *(const GAS f32x4*)(A.in[I_BA] + chb), bxv = *(const GAS f32x4*)(A.in[I_BX] + chb), lam = *(const GAS f32x4*)(A.in[I_LAMBDA] + chb);
            float cl[4];
#pragma unroll
            for (int r = 0; r < 4; ++r) { cl[r] = -8.0f * log1pf(__expf(-lam[r])); cP[r] = 1.f; cH[r] = 0.f; }
#pragma unroll
            for (int mt = 0; mt < 4; ++mt) {
                f32x4 ar = {0.f, 0.f, 0.f, 0.f}, ai = {0.f, 0.f, 0.f, 0.f};
#pragma unroll
                for (int ks = 0; ks < 4; ++ks) { ar = __builtin_amdgcn_mfma_f32_16x16x32_bf16(wa[ks], xf[mt][ks], ar, 0, 0, 0);
                                                 ai = __builtin_amdgcn_mfma_f32_16x16x32_bf16(wx[ks], xf[mt][ks], ai, 0, 0, 0); }
                const v2u xv = *(const GAS v2u*)(xl + (r0 + 16 * mt + fr) * LRU_W + chb);
                const float xlv[4] = {bflo(xv.x), bfhi(xv.x), bflo(xv.y), bfhi(xv.y)};
                float P[4], H[4];
#pragma unroll
                for (int r = 0; r < 4; ++r) {
                    const float rg = sigmoidf_(ar[r] + bav[r]), ig = sigmoidf_(ai[r] + bxv[r]);
                    const float la = cl[r] * rg, a = __expf(la), mult = sqrtf(fmaxf(1.0f - __expf(2.0f * la), 0.f));
                    float p = a, h = mult * ig * xlv[r];
#pragma unroll
                    for (int s = 1; s < 16; s <<= 1) { const float pp = __shfl_up(p, s, 16), hp = __shfl_up(h, s, 16);
                        if (fr >= s) { h = p * hp + h; p = p * pp; } }
                    h = h + p * cH[r]; p = p * cP[r];
                    P[r] = p; H[r] = h;
                    cP[r] = __shfl(p, 15, 16); cH[r] = __shfl(h, 15, 16);
                }
                v2u ho, po; ho.x = pk2(H[0], H[1]); ho.y = pk2(H[2], H[3]); po.x = pk2(P[0], P[1]); po.y = pk2(P[2], P[3]);
                *(GAS v2u*)(hloc + (r0 + 16 * mt + fr) * LRU_W + chb) = ho;
                *(GAS v2u*)(pc + (r0 + 16 * mt + fr) * LRU_W + chb) = po;
            }
            if (fr == 0) {
                float* ag = agg + ((size_t)(b * NCHUNK + chunk) * LRU_W + chb) * 2;
                *(GAS f32x4*)ag = (f32x4){cP[0], cH[0], cP[1], cH[1]}; *(GAS f32x4*)(ag + 4) = (f32x4){cP[2], cH[2], cP[3], cH[3]};
            }
        }
    }
}

__device__ __forceinline__ void phase_m3(const Args& A, LAS unsigned char* lds, int tid, int lane, int wave, int bid, int G) {
    const bf16* proj = (const bf16*)(A.ws + WS_PROJ); const bf16* hloc = (const bf16*)(A.ws + WS_HLOC); const bf16* pc = (const bf16*)(A.ws + WS_PC);
    const bf16* zc = (const bf16*)(A.ws + WS_ZC); const float* agg = (const float*)(A.ws + WS_AGG);
    bf16* a2 = (bf16*)(A.ws + WS_RA);
    LAS float* cs = (LAS float*)lds;
    float lg[2][8], lb[2][8];
#pragma unroll
    for (int jj = 0; jj < 2; ++jj)
#pragma unroll
        for (int e = 0; e < 8; ++e) { lg[jj][e] = A.in[I_LNG][jj * 512 + lane * 8 + e]; lb[jj][e] = A.in[I_LNB][jj * 512 + lane * 8 + e]; }
    for (int item = bid; item < 2 * NCHUNK; item += G) {
        const int b = item >> 7, chunk = item & (NCHUNK - 1);
        {   float h0 = 0.f, h1 = 0.f; const float* ap = agg + ((size_t)(b * NCHUNK) * LRU_W + 2 * tid) * 2;
#pragma unroll 8
            for (int c = 0; c < chunk; ++c) { const f32x4 ab = *(const GAS f32x4*)(ap + (size_t)c * LRU_W * 2); h0 = ab.x * h0 + ab.y; h1 = ab.z * h1 + ab.w; }
            __syncthreads();
            cs[2 * tid] = h0; cs[2 * tid + 1] = h1;
            __syncthreads(); }
        for (int rr = 0; rr < 8; ++rr) {
            const int row = b * SEQ + chunk * CHUNK + wave * 8 + rr;
            float zv[2][8]; float s = 0.f;
#pragma unroll
            for (int jj = 0; jj < 2; ++jj) {
                const int c0 = jj * 512 + lane * 8;
                const v4u hv = *(const GAS v4u*)(hloc + (size_t)row * LRU_W + c0), pv = *(const GAS v4u*)(pc + (size_t)row * LRU_W + c0);
                const v4u gv = *(const GAS v4u*)(proj + (size_t)row * IN_COLS + 1024 + c0);
                const f32x4 ca = *(const LAS f32x4*)(cs + c0), cb = *(const LAS f32x4*)(cs + c0 + 4);
                float y[8];
                y[0] = (bflo(hv.x) + bflo(pv.x) * ca.x) * gelu_tanh(bflo(gv.x)); y[1] = (bfhi(hv.x) + bfhi(pv.x) * ca.y) * gelu_tanh(bfhi(gv.x));
                y[2] = (bflo(hv.y) + bflo(pv.y) * ca.z) * gelu_tanh(bflo(gv.y)); y[3] = (bfhi(hv.y) + bfhi(pv.y) * ca.w) * gelu_tanh(bfhi(gv.y));
                y[4] = (bflo(hv.z) + bflo(pv.z) * cb.x) * gelu_tanh(bflo(gv.z)); y[5] = (bfhi(hv.z) + bfhi(pv.z) * cb.y) * gelu_tanh(bfhi(gv.z));
                y[6] = (bflo(hv.w) + bflo(pv.w) * cb.z) * gelu_tanh(bflo(gv.w)); y[7] = (bfhi(hv.w) + bfhi(pv.w) * cb.w) * gelu_tanh(bfhi(gv.w));
                v4u o; o.x = pk2(y[0], y[1]); o.y = pk2(y[2], y[3]); o.z = pk2(y[4], y[5]); o.w = pk2(y[6], y[7]);
                *(GAS v4u*)(a2 + (size_t)row * D + c0) = o;
                const v4u z = *(const GAS v4u*)(zc + (size_t)row * CONF_W + c0);
                zv[jj][0] = bflo(z.x); zv[jj][1] = bfhi(z.x); zv[jj][2] = bflo(z.y); zv[jj][3] = bfhi(z.y); zv[jj][4] = bflo(z.z); zv[jj][5] = bfhi(z.z); zv[jj][6] = bflo(z.w); zv[jj][7] = bfhi(z.w);
#pragma unroll
                for (int e = 0; e < 8; ++e) s += zv[jj][e];
            }
            const float mean = wave_sum(s) * (1.0f / CONF_W); float q = 0.f;
#pragma unroll
            for (int jj = 0; jj < 2; ++jj)
#pragma unroll
                for (int e = 0; e < 8; ++e) { zv[jj][e] -= mean; q += zv[jj][e] * zv[jj][e]; }
            const float rstd = __builtin_amdgcn_rsqf(wave_sum(q) * (1.0f / CONF_W) + EPS);
#pragma unroll
            for (int jj = 0; jj < 2; ++jj) { float o[8];
#pragma unroll
                for (int e = 0; e < 8; ++e) { const float n = zv[jj][e] * rstd * lg[jj][e] + lb[jj][e]; o[e] = n * sigmoidf_(n); }
                v4u w; w.x = pk2(o[0], o[1]); w.y = pk2(o[2], o[3]); w.z = pk2(o[4], o[5]); w.w = pk2(o[6], o[7]);
                *(GAS v4u*)(a2 + (size_t)row * D + 1024 + jj * 512 + lane * 8) = w; }
        }
    }
}

__device__ __forceinline__ float dpp_sum63(float v) {
    v += __builtin_bit_cast(float, __builtin_amdgcn_update_dpp(0, __builtin_bit_cast(int, v), 0xB1, 0xF, 0xF, false));
    v += __builtin_bit_cast(float, __builtin_amdgcn_update_dpp(0, __builtin_bit_cast(int, v), 0x4E, 0xF, 0xF, false));
    v += __builtin_bit_cast(float, __builtin_amdgcn_update_dpp(0, __builtin_bit_cast(int, v), 0x141, 0xF, 0xF, false));
    v += __builtin_bit_cast(float, __builtin_amdgcn_update_dpp(0, __builtin_bit_cast(int, v), 0x140, 0xF, 0xF, false));
    v += __builtin_bit_cast(float, __builtin_amdgcn_update_dpp(0, __builtin_bit_cast(int, v), 0x142, 0xA, 0xF, false));
    v += __builtin_bit_cast(float, __builtin_amdgcn_update_dpp(0, __builtin_bit_cast(int, v), 0x143, 0xC, 0xF, false));
    return v;
}
__device__ __forceinline__ float wave_total(float v) { return rdlane(dpp_sum63(v), 63); }
__device__ __forceinline__ f32x2 fp8lo(unsigned w) { return __builtin_amdgcn_cvt_pk_f32_fp8((int)w, false); }
__device__ __forceinline__ f32x2 fp8hi(unsigned w) { return __builtin_amdgcn_cvt_pk_f32_fp8((int)w, true); }
__device__ __forceinline__ void cvt_table_fp8(const float* src, unsigned char* dst, float* inv_scale, int gw, int NGW, int lane) {
    for (int r = gw; r < NEXP; r += NGW) {
        const GAS f32x4* p = (const GAS f32x4*)(src + (size_t)r * D) + lane * 4;
        f32x4 v[2][4]; float m = 0.f;
#pragma unroll
        for (int jj = 0; jj < 2; ++jj)
#pragma unroll
            for (int i = 0; i < 4; ++i) { v[jj][i] = p[jj * 256 + i]; m = fmaxf(m, fmaxf(fmaxf(fabsf(v[jj][i].x), fabsf(v[jj][i].y)), fmaxf(fabsf(v[jj][i].z), fabsf(v[jj][i].w)))); }
#pragma unroll
        for (int o = 1; o < 64; o <<= 1) m = fmaxf(m, __shfl_xor(m, o));
        const float sc = m > 0.f ? 448.0f / m : 1.0f;
#pragma unroll
        for (int jj = 0; jj < 2; ++jj) { unsigned w[4];
#pragma unroll
            for (int i = 0; i < 4; ++i) { const f32x4 t = v[jj][i] * sc;
                const float a = fminf(fmaxf(t.x, -448.f), 448.f), b = fminf(fmaxf(t.y, -448.f), 448.f), c = fminf(fmaxf(t.z, -448.f), 448.f), d = fminf(fmaxf(t.w, -448.f), 448.f);
                int pk = __builtin_amdgcn_cvt_pk_fp8_f32(a, b, 0, false); pk = __builtin_amdgcn_cvt_pk_fp8_f32(c, d, pk, true); w[i] = (unsigned)pk; }
            ((GAS v4u*)(dst + (size_t)r * D))[jj * 64 + lane] = (v4u){w[0], w[1], w[2], w[3]}; }
        if (lane == 0) inv_scale[r] = m > 0.f ? m * (1.0f / 448.0f) : 1.0f;
    }
}
__device__ __forceinline__ void phase_e2(const Args& A, int tid, int lane, int wave, int bid, int G) {
    const float* modp = (const float*)(A.ws + WS_MODP); const float* cfin = (const float*)(A.ws + WS_CFIN);
    const bf16* y1 = (const bf16*)(A.ws + WS_Y1); bf16* h2 = (bf16*)(A.ws + WS_RA);
    const int gw = bid * NWAVES + wave, NGW = G * NWAVES;
    int cb = -1; float gs[4][8], sh[4][8];
    for (int row = gw; row < T; row += NGW) {
        const int b = row >> 13;
        if (b != cb) { cb = b;
#pragma unroll
            for (int j = 0; j < 4; ++j)
#pragma unroll
                for (int e = 0; e < 8; ++e) { const int col = j * 512 + lane * 8 + e;
                    gs[j][e] = A.in[I_GPREFFN][col] * (1.0f + mod_at(modp, b, 4 * D + col)); sh[j][e] = mod_at(modp, b, 3 * D + col); } }
        const GAS f32x4* xr = (const GAS f32x4*)(A.in[I_X] + (size_t)row * D) + lane * 2;
        const GAS v4u* yr = (const GAS v4u*)(y1 + (size_t)row * D) + lane;
        const GAS f32x4* cf = (const GAS f32x4*)(cfin + (size_t)(b * 2 + 0) * D) + lane * 2;
        float xv[4][8], yv[4][8]; float s1 = 0.f;
#pragma unroll
        for (int j = 0; j < 4; ++j) { const f32x4 a = xr[j * 128], c = xr[j * 128 + 1]; const v4u y = yr[j * 64];
            xv[j][0] = a.x; xv[j][1] = a.y; xv[j][2] = a.z; xv[j][3] = a.w; xv[j][4] = c.x; xv[j][5] = c.y; xv[j][6] = c.z; xv[j][7] = c.w;
            yv[j][0] = bflo(y.x); yv[j][1] = bfhi(y.x); yv[j][2] = bflo(y.y); yv[j][3] = bfhi(y.y); yv[j][4] = bflo(y.z); yv[j][5] = bfhi(y.z); yv[j][6] = bflo(y.w); yv[j][7] = bfhi(y.w);
#pragma unroll
            for (int e = 0; e < 8; ++e) s1 += yv[j][e] * yv[j][e]; }
        const float rstd1 = __builtin_amdgcn_rsqf(wave_sum(s1) * (1.0f / D) + EPS); float s2 = 0.f;
#pragma unroll
        for (int j = 0; j < 4; ++j) { const f32x4 ca = cf[j * 128], cc = cf[j * 128 + 1]; const float cg[8] = {ca.x, ca.y, ca.z, ca.w, cc.x, cc.y, cc.z, cc.w};
#pragma unroll
            for (int e = 0; e < 8; ++e) { xv[j][e] += cg[e] * yv[j][e] * rstd1; s2 += xv[j][e] * xv[j][e]; } }
        const float rstd2 = __builtin_amdgcn_rsqf(wave_sum(s2) * (1.0f / D) + EPS);
        GAS v4u* orow = (GAS v4u*)(h2 + (size_t)row * D) + lane;
#pragma unroll
        for (int j = 0; j < 4; ++j) { float o[8];
#pragma unroll
            for (int e = 0; e < 8; ++e) o[e] = xv[j][e] * rstd2 * gs[j][e] + sh[j][e];
            v4u w; w.x = pk2(o[0], o[1]); w.y = pk2(o[2], o[3]); w.z = pk2(o[4], o[5]); w.w = pk2(o[6], o[7]);
            orow[j * 64] = w; }
    }
    cvt_table_fp8(A.in[I_PU], A.ws + WS_UB, (float*)(A.ws + WS_USC), gw, NGW, lane);
    cvt_table_fp8(A.in[I_PV], A.ws + WS_VB, (float*)(A.ws + WS_VSC), gw, NGW, lane);
}

template <int N> __device__ __forceinline__ void bitonic_sort_desc(float (&v)[N]) {
#pragma unroll
    for (int k = 2; k <= N; k <<= 1)
#pragma unroll
        for (int j = k >> 1; j > 0; j >>= 1)
#pragma unroll
            for (int i = 0; i < N; ++i) { const int l = i ^ j;
                if (l > i) { const bool desc = ((i & k) == 0); const float a = v[i], b = v[l]; const float mx = fmaxf(a, b), mn = fminf(a, b); v[i] = desc ? mx : mn; v[l] = desc ? mn : mx; } }
}
__device__ __forceinline__ void merge_top16(float (&a)[16], const float (&b)[16]) {
#pragma unroll
    for (int i = 0; i < 16; ++i) a[i] = fmaxf(a[i], b[15 - i]);
#pragma unroll
    for (int j = 8; j > 0; j >>= 1)
#pragma unroll
        for (int i = 0; i < 16; ++i) { const int l = i ^ j; if (l > i) { const float x = a[i], y = a[l]; a[i] = fmaxf(x, y); a[l] = fminf(x, y); } }
}
__device__ __forceinline__ void top16_of_64(float (&v)[64], float (&out)[16]) {
    float g[4][16];
#pragma unroll
    for (int q = 0; q < 4; ++q) {
#pragma unroll
        for (int i = 0; i < 16; ++i) g[q][i] = v[q * 16 + i];
        bitonic_sort_desc<16>(g[q]); }
    merge_top16(g[0], g[1]); merge_top16(g[2], g[3]); merge_top16(g[0], g[2]);
#pragma unroll
    for (int i = 0; i < 16; ++i) out[i] = g[0][i];
}
__device__ __forceinline__ float pack_key(float v, unsigned key, unsigned mask) { return __builtin_bit_cast(float, (__builtin_bit_cast(unsigned, v) & ~mask) | key); }
__device__ __forceinline__ void score_top16(const bf16* q, const bf16* sk, int tok, int h, int p, int l31, int hf, float (&out)[16]) {
    f32x16 acc[4];
#pragma unroll
    for (int kt = 0; kt < 4; ++kt)
#pragma unroll
        for (int r = 0; r < 16; ++r) acc[kt][r] = 0.f;
#pragma unroll 2
    for (int ks = 0; ks < 8; ++ks) {
        const bf16x8 bq = *(const GAS bf16x8*)(q + (size_t)tok * D + h * 256 + p * 128 + 16 * ks + 8 * hf);
#pragma unroll
        for (int kt = 0; kt < 4; ++kt) {
            const bf16x8 ak = *(const GAS bf16x8*)(sk + ((size_t)((h * 2 + p) * NKEY + 32 * kt + l31)) * 128 + 16 * ks + 8 * hf);
            acc[kt] = __builtin_amdgcn_mfma_f32_32x32x16_bf16(ak, bq, acc[kt], 0, 0, 0);
        }
    }
    float v[64];
#pragma unroll
    for (int kt = 0; kt < 4; ++kt)
#pragma unroll
        for (int r = 0; r < 16; ++r) v[kt * 16 + r] = pack_key(acc[kt][r], (unsigned)(32 * kt + (r & 3) + 8 * (r >> 2) + 4 * hf), 0x7Fu);
    float other[16];
    top16_of_64(v, out);
#pragma unroll
    for (int i = 0; i < 16; ++i) other[i] = __shfl_xor(out[i], 32);
    merge_top16(out, other);
}
__device__ __forceinline__ void phase_s(const Args& A, int tid, int lane, int wave, int bid, int G) {
    const bf16* q = (const bf16*)(A.ws + WS_Q); const bf16* sk = (const bf16*)(A.ws + WS_SUBK);
    int* idx = (int*)(A.ws + WS_IDX); float* gate = (float*)(A.ws + WS_GATE);
    const int l31 = lane & 31, hf = lane >> 5;
    for (int item = bid * NWAVES + wave; item < (T / 32) * NH; item += G * NWAVES) {
        const int h = item & 7, tok = (item >> 3) * 32 + l31;
        float s1[16], s2[16];
        score_top16(q, sk, tok, h, 0, l31, hf, s1);
        score_top16(q, sk, tok, h, 1, l31, hf, s2);
        float cv[64]; int n = 0;
#pragma unroll
        for (int i = 0; i < 16; ++i)
#pragma unroll
            for (int j = 0; j < 16; ++j)
                if ((i + 1) * (j + 1) <= 16) {
                    const float a = __builtin_bit_cast(float, __builtin_bit_cast(unsigned, s1[i]) & ~0x7Fu), c = __builtin_bit_cast(float, __builtin_bit_cast(unsigned, s2[j]) & ~0x7Fu);
                    cv[n++] = pack_key(a + c, (unsigned)(i * 16 + j), 0xFFu); }
#pragma unroll
        for (int m = 50; m < 64; ++m) cv[m] = -INFINITY;
        float c16[16];
        top16_of_64(cv, c16);
        float ev[16], esum = 0.f; const float cmax = __builtin_bit_cast(float, __builtin_bit_cast(unsigned, c16[0]) & ~0xFFu);
#pragma unroll
        for (int m = 0; m < 16; ++m) { ev[m] = __expf(__builtin_bit_cast(float, __builtin_bit_cast(unsigned, c16[m]) & ~0xFFu) - cmax); esum += ev[m]; }
        const float rs = 1.0f / esum;
        int oi[8]; float og[8];
#pragma unroll
        for (int mm = 0; mm < 8; ++mm) {
            float c_lo = c16[mm], c_hi = c16[8 + mm], e_lo = ev[mm], e_hi = ev[8 + mm];
            asm volatile("" : "+v"(c_lo), "+v"(c_hi), "+v"(e_lo), "+v"(e_hi));
            const unsigned cb = __builtin_bit_cast(unsigned, hf ? c_hi : c_lo); const int ii = (cb >> 4) & 15, jj = cb & 15;
            int row = 0, col = 0;
#pragma unroll
            for (int k = 0; k < 16; ++k) { row = (ii == k) ? (int)(__builtin_bit_cast(unsigned, s1[k]) & 0x7Fu) : row; col = (jj == k) ? (int)(__builtin_bit_cast(unsigned, s2[k]) & 0x7Fu) : col; }
            oi[mm] = row * NKEY + col; og[mm] = (hf ? e_hi : e_lo) * rs;
        }
        int* ip = idx + (size_t)tok * KSEL + h * 16 + hf * 8; float* gp = gate + (size_t)tok * KSEL + h * 16 + hf * 8;
        *(GAS v4u*)ip = (v4u){(unsigned)oi[0], (unsigned)oi[1], (unsigned)oi[2], (unsigned)oi[3]}; *(GAS v4u*)(ip + 4) = (v4u){(unsigned)oi[4], (unsigned)oi[5], (unsigned)oi[6], (unsigned)oi[7]};
        *(GAS f32x4*)gp = (f32x4){og[0], og[1], og[2], og[3]}; *(GAS f32x4*)(gp + 4) = (f32x4){og[4], og[5], og[6], og[7]};
    }
}

__device__ __forceinline__ float row_dot_fp8(const v4u d0, const v4u d1, const f32x2 (&hf)[2][8]) {
    const unsigned w0[4] = {d0.x, d0.y, d0.z, d0.w}, w1[4] = {d1.x, d1.y, d1.z, d1.w};
    f32x2 a = {0.f, 0.f}, b = {0.f, 0.f};
#pragma unroll
    for (int i = 0; i < 4; ++i) { a += fp8lo(w0[i]) * hf[0][2 * i]; a += fp8hi(w0[i]) * hf[0][2 * i + 1]; b += fp8lo(w1[i]) * hf[1][2 * i]; b += fp8hi(w1[i]) * hf[1][2 * i + 1]; }
    return (a.x + a.y) + (b.x + b.y);
}
__device__ __forceinline__ void row_axpy_fp8(f32x2 (&acc)[2][8], const v4u d0, const v4u d1, float w) {
    const unsigned w0[4] = {d0.x, d0.y, d0.z, d0.w}, w1[4] = {d1.x, d1.y, d1.z, d1.w};
#pragma unroll
    for (int i = 0; i < 4; ++i) { acc[0][2 * i] += fp8lo(w0[i]) * w; acc[0][2 * i + 1] += fp8hi(w0[i]) * w; acc[1][2 * i] += fp8lo(w1[i]) * w; acc[1][2 * i + 1] += fp8hi(w1[i]) * w; }
}
__device__ __forceinline__ void phase_pe(const Args& A, int tid, int lane, int wave, int bid, int G) {
    const bf16* h2 = (const bf16*)(A.ws + WS_RA); const bf16* y1 = (const bf16*)(A.ws + WS_Y1);
    const unsigned char* ub = A.ws + WS_UB; const unsigned char* vb = A.ws + WS_VB;
    const float* usc = (const float*)(A.ws + WS_USC); const float* vsc = (const float*)(A.ws + WS_VSC);
    const int* idx = (const int*)(A.ws + WS_IDX); const float* gate = (const float*)(A.ws + WS_GATE); const float* cfin = (const float*)(A.ws + WS_CFIN);
    for (int tok = bid * NWAVES + wave; tok < T; tok += G * NWAVES) {
        const int b = tok >> 13;
        f32x2 hf[2][8];
#pragma unroll
        for (int jj = 0; jj < 2; ++jj) { const GAS v4u* hp = (const GAS v4u*)(h2 + (size_t)tok * D + jj * 1024 + lane * 16); const v4u q0 = hp[0], q1 = hp[1];
            const unsigned w[8] = {q0.x, q0.y, q0.z, q0.w, q1.x, q1.y, q1.z, q1.w};
#pragma unroll
            for (int i = 0; i < 8; ++i) hf[jj][i] = (f32x2){bflo(w[i]), bfhi(w[i])}; }
        int id0 = idx[(size_t)tok * KSEL + lane], id1 = idx[(size_t)tok * KSEL + 64 + lane];
        float g0 = gate[(size_t)tok * KSEL + lane], g1 = gate[(size_t)tok * KSEL + 64 + lane];
#if PE_SORT
        {
            unsigned k0 = ((unsigned)id0 << 7) | (unsigned)lane, k1 = ((unsigned)id1 << 7) | (unsigned)(64 + lane);
#pragma unroll
            for (int k = 2; k <= 64; k <<= 1)
#pragma unroll
                for (int j = k >> 1; j > 0; j >>= 1) {
                    const unsigned p0 = __shfl_xor(k0, j), p1 = __shfl_xor(k1, j);
                    const bool lower = (lane & j) == 0, up0 = (lane & k) == 0, up1 = (k == 64) ? false : up0;
                    k0 = (lower == up0) ? min(k0, p0) : max(k0, p0); k1 = (lower == up1) ? min(k1, p1) : max(k1, p1);
                }
            { const unsigned lo = min(k0, k1), hi = max(k0, k1); k0 = lo; k1 = hi; }
#pragma unroll
            for (int j = 32; j > 0; j >>= 1) {
                const unsigned p0 = __shfl_xor(k0, j), p1 = __shfl_xor(k1, j); const bool lower = (lane & j) == 0;
                k0 = lower ? min(k0, p0) : max(k0, p0); k1 = lower ? min(k1, p1) : max(k1, p1);
            }
            const int q0 = k0 & 127, q1 = k1 & 127;
            const float a0 = __shfl(g0, q0 & 63), b0 = __shfl(g1, q0 & 63), a1 = __shfl(g0, q1 & 63), b1 = __shfl(g1, q1 & 63);
            g0 = (q0 & 64) ? b0 : a0; g1 = (q1 & 64) ? b1 : a1; id0 = (int)(k0 >> 7); id1 = (int)(k1 >> 7);
        }
#endif
        const float su0 = usc[id0], su1 = usc[id1], sv0 = vsc[id0], sv1 = vsc[id1];
        float act0 = 0.f, act1 = 0.f;
#pragma unroll 8
        for (int k = 0; k < 64; ++k) {
            const int e = __builtin_amdgcn_readlane(id0, k);
            const GAS v4u* up = (const GAS v4u*)(ub + (size_t)e * D) + lane;
            const float tot = wave_total(row_dot_fp8(up[0], up[64], hf)); act0 = (lane == k) ? tot : act0;
        }
#pragma unroll 8
        for (int k = 0; k < 64; ++k) {
            const int e = __builtin_amdgcn_readlane(id1, k);
            const GAS v4u* up = (const GAS v4u*)(ub + (size_t)e * D) + lane;
            const float tot = wave_total(row_dot_fp8(up[0], up[64], hf)); act1 = (lane == k) ? tot : act1;
        }
        const float w0 = g0 * gelu_tanh(act0 * su0) * sv0, w1 = g1 * gelu_tanh(act1 * su1) * sv1;
        f32x2 acc[2][8];
#pragma unroll
        for (int jj = 0; jj < 2; ++jj)
#pragma unroll
            for (int i = 0; i < 8; ++i) acc[jj][i] = (f32x2){0.f, 0.f};
#pragma unroll 8
        for (int k = 0; k < 64; ++k) {
            const int e = __builtin_amdgcn_readlane(id0, k); const float w = rdlane(w0, k);
            const GAS v4u* vp = (const GAS v4u*)(vb + (size_t)e * D) + lane;
            row_axpy_fp8(acc, vp[0], vp[64], w);
        }
#pragma unroll 8
        for (int k = 0; k < 64; ++k) {
            const int e = __builtin_amdgcn_readlane(id1, k); const float w = rdlane(w1, k);
            const GAS v4u* vp = (const GAS v4u*)(vb + (size_t)e * D) + lane;
            row_axpy_fp8(acc, vp[0], vp[64], w);
        }
        float s2 = 0.f;
#pragma unroll
        for (int jj = 0; jj < 2; ++jj)
#pragma unroll
            for (int i = 0; i < 8; ++i) s2 += acc[jj][i].x * acc[jj][i].x + acc[jj][i].y * acc[jj][i].y;
        const float rstd2 = __builtin_amdgcn_rsqf(wave_sum(s2) * (1.0f / D) + EPS);
        float yv[2][16]; float s1 = 0.f;
#pragma unroll
        for (int jj = 0; jj < 2; ++jj) { const GAS v4u* yp = (const GAS v4u*)(y1 + (size_t)tok * D + jj * 1024 + lane * 16); const v4u q0 = yp[0], q1 = yp[1];
            const unsigned w[8] = {q0.x, q0.y, q0.z, q0.w, q1.x, q1.y, q1.z, q1.w};
#pragma unroll
            for (int i = 0; i < 8; ++i) { yv[jj][2 * i] = bflo(w[i]); yv[jj][2 * i + 1] = bfhi(w[i]); s1 += yv[jj][2 * i] * yv[jj][2 * i] + yv[jj][2 * i + 1] * yv[jj][2 * i + 1]; } }
        const float rstd1 = __builtin_amdgcn_rsqf(wave_sum(s1) * (1.0f / D) + EPS);
#pragma unroll
        for (int jj = 0; jj < 2; ++jj) {
            const size_t off = (size_t)jj * 256 + lane * 4;
            const GAS f32x4* xr = (const GAS f32x4*)(A.in[I_X] + (size_t)tok * D) + off;
            const GAS f32x4* c1 = (const GAS f32x4*)(cfin + (size_t)(b * 2 + 0) * D) + off; const GAS f32x4* c2 = (const GAS f32x4*)(cfin + (size_t)(b * 2 + 1) * D) + off;
            GAS f32x4* orow = (GAS f32x4*)(A.out + (size_t)tok * D) + off;
#pragma unroll
            for (int q = 0; q < 4; ++q) { const f32x4 xv = xr[q], a1 = c1[q], a2 = c2[q]; f32x4 o;
                const float ya[4] = {acc[jj][2 * q].x, acc[jj][2 * q].y, acc[jj][2 * q + 1].x, acc[jj][2 * q + 1].y};
#pragma unroll
                for (int e = 0; e < 4; ++e) o[e] = xv[e] + (OUT_MODE != 2 ? a1[e] * yv[jj][4 * q + e] * rstd1 : 0.f) + (OUT_MODE != 1 ? a2[e] * ya[e] * rstd2 : 0.f);
                orow[q] = o; }
        }
    }
}

#if defined(MK_CHECKS)
constexpr int CW_CHK = 2048;
__device__ __forceinline__ unsigned hsh(unsigned x) { x ^= x >> 16; x *= 0x7feb352dU; x ^= x >> 15; x *= 0x846ca68bU; x ^= x >> 16; return x; }
__device__ __forceinline__ float bfv(const bf16* p, size_t i) { return __builtin_bit_cast(float, (unsigned)p[i] << 16); }
__device__ __forceinline__ float relerr(float got, float ref, float scale) { const float d = fabsf(got - ref) / (fabsf(ref) + scale); return (d == d) ? d : 1e30f; }
__device__ __forceinline__ void chk_put(unsigned* ctl, int stage, float e) { atomicMax(ctl + CW_CHK + stage, __builtin_bit_cast(unsigned, e)); }
__device__ float chk_gemm(const bf16* Am, const bf16* Bt, const bf16* C, int N, int K, unsigned s) {
    const int row = hsh(s) % T, col = hsh(s * 7 + 1) % N; float acc = 0.f;
    for (int k = 0; k < K; ++k) acc += bfv(Am, (size_t)row * K + k) * bfv(Bt, (size_t)col * K + k);
    return relerr(bfv(C, (size_t)row * N + col), acc, 0.05f);
}
__global__ void __launch_bounds__(128) chk_kernel(Args A, int stage) {
    __shared__ float sh[10240];
    unsigned* ctl = (unsigned*)(A.ws + WS_CTL);
    const int tid = threadIdx.x; const unsigned s = hsh(tid * 2654435761u + stage * 97u + 12345u);
    const float* modp = (const float*)(A.ws + WS_MODP);
    float e = 0.f;
    if (stage == 0) {
        { const int b = s & 1, n = hsh(s) % NMOD; float acc = A.in[I_BMOD][n];
          for (int k = 0; k < D; ++k) { const float c = A.in[I_C][b * D + k]; acc += c / (1.0f + expf(-c)) * A.in[I_WMOD][(size_t)k * NMOD + n]; }
          e = fmaxf(e, relerr(mod_at(modp, b, n), acc, 0.01f)); }
        { const int n = hsh(s + 1) % IN_COLS, k = hsh(s + 2) % D; e = fmaxf(e, relerr(bfv((const bf16*)(A.ws + WS_BT1), (size_t)n * D + k), A.in[I_WIN][(size_t)k * IN_COLS + n], 1e-3f)); }
        { const int n = hsh(s + 3) % D, k = hsh(s + 4) % D; e = fmaxf(e, relerr(bfv((const bf16*)(A.ws + WS_BT2), (size_t)n * D + k), A.in[I_WOUT][(size_t)k * D + n], 1e-3f));
          e = fmaxf(e, relerr(bfv((const bf16*)(A.ws + WS_BT3), (size_t)n * D + k), A.in[I_WQ][(size_t)k * D + n], 1e-3f)); }
        { const int h = s & 7, n = hsh(s + 5) & 255, k = hsh(s + 6) & 127; const float ref = (n < 128 ? A.in[I_WA] : A.in[I_WX])[h * 16384 + k * 128 + (n & 127)];
          e = fmaxf(e, relerr(bfv((const bf16*)(A.ws + WS_WG), (size_t)(h * 256 + n) * 128 + k), ref, 1e-3f)); }
        { const int i = hsh(s + 7) % (NH * 2 * NKEY * 128); e = fmaxf(e, relerr(bfv((const bf16*)(A.ws + WS_SUBK), i), A.in[I_SUBK][i], 1e-3f)); }
    } else if (stage == 1) {
        const int row = hsh(s) % T, col = hsh(s + 1) % D, b = row >> 13; float ss = 0.f;
        for (int k = 0; k < D; ++k) { const float x = A.in[I_X][(size_t)row * D + k]; ss += x * x; }
        const float ref = A.in[I_X][(size_t)row * D + col] * rsqrtf(ss / D + EPS) * A.in[I_GPREMIX][col] * (1.0f + mod_at(modp, b, D + col)) + mod_at(modp, b, col);
        e = relerr(bfv((const bf16*)(A.ws + WS_RA), (size_t)row * D + col), ref, 0.05f);
        const float* cfin = (const float*)(A.ws + WS_CFIN);
        e = fmaxf(e, relerr(cfin[(b * 2 + 0) * D + col], mod_at(modp, b, 2 * D + col) * A.in[I_GPOSTMIX][col], 1e-3f));
        e = fmaxf(e, relerr(cfin[(b * 2 + 1) * D + col], mod_at(modp, b, 5 * D + col) * A.in[I_GPOSTFFN][col], 1e-3f));
    } else if (stage == 2) { e = chk_gemm((const bf16*)(A.ws + WS_RA), (const bf16*)(A.ws + WS_BT1), (const bf16*)(A.ws + WS_PROJ), IN_COLS, D, s);
    } else if (stage == 7) { e = chk_gemm((const bf16*)(A.ws + WS_RA), (const bf16*)(A.ws + WS_BT2), (const bf16*)(A.ws + WS_Y1), D, D, s);
    } else if (stage == 9) { e = chk_gemm((const bf16*)(A.ws + WS_RA), (const bf16*)(A.ws + WS_BT3), (const bf16*)(A.ws + WS_Q), D, D, s);
    } else if (stage == 3) {
        const bf16* proj = (const bf16*)(A.ws + WS_PROJ);
        int row = hsh(s) % T; if (tid < 16) row = (tid & 1) * SEQ + (tid >> 1);
        const int c = hsh(s + 1) % LRU_W, t = row & (SEQ - 1);
        float a = A.in[I_LCB][c];
        for (int j = 0; j < 4; ++j) if (t - 3 + j >= 0) a += A.in[I_LCW][j * LRU_W + c] * bfv(proj, (size_t)(row - 3 + j) * IN_COLS + c);
        e = relerr(bfv((const bf16*)(A.ws + WS_XL), (size_t)row * LRU_W + c), a, 0.05f);
        float z = A.in[I_CDB][c];
        for (int j = 0; j < CONF_K; ++j) if (t - 30 + j >= 0) { const size_t r = (size_t)(row - 30 + j) * IN_COLS; const float g = bfv(proj, r + 3072 + c);
            z += A.in[I_CDW][j * CONF_W + c] * bfv(proj, r + 2048 + c) / (1.0f + expf(-g)); }
        e = fmaxf(e, relerr(bfv((const bf16*)(A.ws + WS_ZC), (size_t)row * CONF_W + c), z, 0.05f));
    } else if (stage == 4) {
        const bf16* xl = (const bf16*)(A.ws + WS_XL);
        const int b = s & 1, chunk = hsh(s + 1) % NCHUNK, ch = hsh(s + 2) % LRU_W, hh = ch >> 7, j = ch & 127;
        const float cl = -8.0f * log1pf(expf(-A.in[I_LAMBDA][ch])); float P = 1.f, H = 0.f;
        for (int t = 0; t < CHUNK; ++t) { const size_t row = (size_t)b * SEQ + chunk * CHUNK + t; float ga = A.in[I_BA][ch], gx = A.in[I_BX][ch];
            for (int i = 0; i < 128; ++i) { const float xv = bfv(xl, row * LRU_W + hh * 128 + i); ga += xv * A.in[I_WA][hh * 16384 + i * 128 + j]; gx += xv * A.in[I_WX][hh * 16384 + i * 128 + j]; }
            const float r = 1.0f / (1.0f + expf(-ga)), ig = 1.0f / (1.0f + expf(-gx)), la = cl * r, a = expf(la), u = sqrtf(fmaxf(-expm1f(2.0f * la), 0.f)) * ig * bfv(xl, row * LRU_W + ch);
            H = a * H + u; P = P * a;
            e = fmaxf(e, relerr(bfv((const bf16*)(A.ws + WS_HLOC), row * LRU_W + ch), H, 0.05f)); e = fmaxf(e, relerr(bfv((const bf16*)(A.ws + WS_PC), row * LRU_W + ch), P, 0.02f)); }
        const float* ag = (const float*)(A.ws + WS_AGG) + ((size_t)(b * NCHUNK + chunk) * LRU_W + ch) * 2;
        e = fmaxf(e, relerr(ag[0], P, 0.02f)); e = fmaxf(e, relerr(ag[1], H, 0.05f));
    } else if (stage == 5) {
        const int b = s & 1, ch = hsh(s + 1) % LRU_W; const float* agg = (const float*)(A.ws + WS_AGG); const float* carry = (const float*)(A.ws + WS_CARRY); float Hs = 0.f;
        for (int c = 0; c < NCHUNK; ++c) { e = fmaxf(e, relerr(carry[(size_t)(b * NCHUNK + c) * LRU_W + ch], Hs, 1e-3f)); const float* ag = agg + ((size_t)(b * NCHUNK + c) * LRU_W + ch) * 2; Hs = ag[0] * Hs + ag[1]; }
    } else if (stage == 6) {
        const bf16* proj = (const bf16*)(A.ws + WS_PROJ); const bf16* zc = (const bf16*)(A.ws + WS_ZC);
        const int row = hsh(s) % T, c = hsh(s + 1) % LRU_W, b = row >> 13, chunk = (row & (SEQ - 1)) >> 6;
        float cin = 0.f; for (int cc = 0; cc < chunk; ++cc) { const float* ag = (const float*)(A.ws + WS_AGG) + ((size_t)(b * NCHUNK + cc) * LRU_W + c) * 2; cin = ag[0] * cin + ag[1]; }
        const float hfull = bfv((const bf16*)(A.ws + WS_HLOC), (size_t)row * LRU_W + c) + bfv((const bf16*)(A.ws + WS_PC), (size_t)row * LRU_W + c) * cin;
        const float g = bfv(proj, (size_t)row * IN_COLS + 1024 + c), ge = 0.5f * g * (1.0f + tanhf(0.7978845608f * (g + 0.044715f * g * g * g)));
        e = relerr(bfv((const bf16*)(A.ws + WS_RA), (size_t)row * D + c), hfull * ge, 0.05f);
        float m = 0.f, q = 0.f;
        for (int k = 0; k < CONF_W; ++k) m += bfv(zc, (size_t)row * CONF_W + k);
        m /= CONF_W;
        for (int k = 0; k < CONF_W; ++k) { const float d = bfv(zc, (size_t)row * CONF_W + k) - m; q += d * d; }
        const float n = (bfv(zc, (size_t)row * CONF_W + c) - m) * rsqrtf(q / CONF_W + EPS) * A.in[I_LNG][c] + A.in[I_LNB][c];
        e = fmaxf(e, relerr(bfv((const bf16*)(A.ws + WS_RA), (size_t)row * D + 1024 + c), n / (1.0f + expf(-n)), 0.05f));
    } else if (stage == 8) {
        const bf16* y1 = (const bf16*)(A.ws + WS_Y1); const float* cfin = (const float*)(A.ws + WS_CFIN);
        const int row = hsh(s) % T, col = hsh(s + 1) % D, b = row >> 13; float s1 = 0.f, s2 = 0.f;
        for (int k = 0; k < D; ++k) { const float y = bfv(y1, (size_t)row * D + k); s1 += y * y; }
        const float r1 = rsqrtf(s1 / D + EPS);
        for (int k = 0; k < D; ++k) { const float x1 = A.in[I_X][(size_t)row * D + k] + cfin[(b * 2) * D + k] * bfv(y1, (size_t)row * D + k) * r1; s2 += x1 * x1; }
        const float x1c = A.in[I_X][(size_t)row * D + col] + cfin[(b * 2) * D + col] * bfv(y1, (size_t)row * D + col) * r1;
        const float ref = x1c * rsqrtf(s2 / D + EPS) * A.in[I_GPREFFN][col] * (1.0f + mod_at(modp, b, 4 * D + col)) + mod_at(modp, b, 3 * D + col);
        e = relerr(bfv((const bf16*)(A.ws + WS_RA), (size_t)row * D + col), ref, 0.05f);
        const size_t i = (size_t)(hsh(s + 2) % NEXP) * D + hsh(s + 3) % D;
        { const unsigned wu = ((const unsigned*)(A.ws + WS_UB))[i >> 2] >> (8 * (i & 3)), wv = ((const unsigned*)(A.ws + WS_VB))[i >> 2] >> (8 * (i & 3));
          const float du = __builtin_amdgcn_cvt_pk_f32_fp8((int)wu, false)[0] * ((const float*)(A.ws + WS_USC))[i / D], dv = __builtin_amdgcn_cvt_pk_f32_fp8((int)wv, false)[0] * ((const float*)(A.ws + WS_VSC))[i / D];
          e = fmaxf(e, relerr(du, A.in[I_PU][i], 2e-3f) * 0.3f); e = fmaxf(e, relerr(dv, A.in[I_PV][i], 3e-2f) * 0.3f); }
    } else if (stage == 10) {
        if (tid < 32) {
            const bf16* q = (const bf16*)(A.ws + WS_Q); const int* idx = (const int*)(A.ws + WS_IDX); const float* gate = (const float*)(A.ws + WS_GATE);
            const int tok = hsh(s) % T, h = hsh(s + 1) & 7;
            float* sc = sh + tid * 320;
            for (int p = 0; p < 2; ++p) for (int n = 0; n < NKEY; ++n) { float a = 0.f;
                for (int d = 0; d < 128; ++d) a += bfv(q, (size_t)tok * D + h * 256 + p * 128 + d) * A.in[I_SUBK][((size_t)((h * 2 + p) * NKEY + n)) * 128 + d];
                sc[p * 128 + n] = a; }
            for (int p = 0; p < 2; ++p) { float prev = 1e30f; for (int it = 0; it < 16; ++it) { float best = -1e30f; int bi = 0;
                for (int n = 0; n < NKEY; ++n) { const float v = sc[p * 128 + n]; if (v < prev && v > best) { best = v; bi = n; } }
                sc[256 + p * 16 + it] = best; sc[288 + p * 16 + it] = (float)bi; prev = best; } }
            float prev = 1e30f, esum = 0.f, cmax = 0.f; int miss = 0; float gerr = 0.f;
            { float pv = 1e30f; for (int it = 0; it < 16; ++it) { float best = -1e30f;
                for (int c = 0; c < 256; ++c) { const float v = sc[256 + (c >> 4)] + sc[272 + (c & 15)]; if (v < pv && v > best) best = v; }
                if (it == 0) cmax = best; esum += expf(best - cmax); pv = best; } }
            for (int it = 0; it < 16; ++it) { float best = -1e30f; int bc = 0;
                for (int c = 0; c < 256; ++c) { const float v = sc[256 + (c >> 4)] + sc[272 + (c & 15)]; if (v < prev && v > best) { best = v; bc = c; } }
                prev = best;
                const int eidx = (int)sc[288 + (bc >> 4)] * NKEY + (int)sc[304 + (bc & 15)]; const float g = expf(best - cmax) / esum; bool found = false;
                for (int m = 0; m < 16; ++m) if (idx[(size_t)tok * KSEL + h * 16 + m] == eidx) { found = true; gerr = fmaxf(gerr, relerr(gate[(size_t)tok * KSEL + h * 16 + m], g, 0.02f)); }
                if (!found) ++miss; }
            e = fmaxf((float)miss / 16.0f, gerr);
        }
    } else if (stage == 11) {
        const bf16* h2 = (const bf16*)(A.ws + WS_RA); const bf16* y1 = (const bf16*)(A.ws + WS_Y1); const int* idx = (const int*)(A.ws + WS_IDX); const float* gate = (const float*)(A.ws + WS_GATE); const float* cfin = (const float*)(A.ws + WS_CFIN);
        const int tok = hsh(blockIdx.x * 977u + 5u) % T, b = tok >> 13;
        { const int ex = idx[(size_t)tok * KSEL + tid]; float a = 0.f;
          if ((unsigned)ex < (unsigned)NEXP) { for (int d = 0; d < D; ++d) a += bfv(h2, (size_t)tok * D + d) * A.in[I_PU][(size_t)ex * D + d]; } else a = 1e30f;
          const float ge = 0.5f * a * (1.0f + tanhf(0.7978845608f * (a + 0.044715f * a * a * a)));
          sh[tid] = gate[(size_t)tok * KSEL + tid] * ge; sh[128 + tid] = __builtin_bit_cast(float, ex); }
        __syncthreads();
        float s2 = 0.f, s1 = 0.f;
        for (int cc = 0; cc < 16; ++cc) { const int col = cc * 128 + tid; float a = 0.f;
            for (int k = 0; k < KSEL; ++k) { const int ex = __builtin_bit_cast(int, sh[128 + k]); if ((unsigned)ex < (unsigned)NEXP) a += sh[k] * A.in[I_PV][(size_t)ex * D + col]; }
            sh[512 + cc * 128 + tid] = a; s2 += a * a; const float y = bfv(y1, (size_t)tok * D + col); s1 += y * y; }
        __syncthreads(); sh[256 + tid] = s2; sh[384 + tid] = s1; __syncthreads();
        float t2 = 0.f, t1 = 0.f; for (int k = 0; k < 128; ++k) { t2 += sh[256 + k]; t1 += sh[384 + k]; }
        const float r2 = rsqrtf(t2 / D + EPS), r1 = rsqrtf(t1 / D + EPS);
        float en = 0.f, ed = 0.f;
        for (int cc = 0; cc < 16; ++cc) { const int col = cc * 128 + tid;
            const float pterm = cfin[(b * 2 + 1) * D + col] * sh[512 + cc * 128 + tid] * r2;
            const float ref = A.in[I_X][(size_t)tok * D + col] + (OUT_MODE != 2 ? cfin[(b * 2) * D + col] * bfv(y1, (size_t)tok * D + col) * r1 : 0.f) + (OUT_MODE != 1 ? pterm : 0.f);
            const float d = A.out[(size_t)tok * D + col] - ref; en += d * d; ed += pterm * pterm; }
        __syncthreads(); sh[256 + tid] = en; sh[384 + tid] = ed; __syncthreads();
        float ten = 0.f, ted = 0.f; for (int k = 0; k < 128; ++k) { ten += sh[256 + k]; ted += sh[384 + k]; }
        e = ten / (ted + 1e-12f); if (!(e == e)) e = 1e30f;
    }
    chk_put(ctl, stage, e);
}
__global__ void chk_encode(Args A, int what) {
    const unsigned* ctl = (const unsigned*)(A.ws + WS_CTL);
    if (threadIdx.x == 0 && blockIdx.x == 0) {
        if (what < 0) {
            const float thr[12] = {0.03f, 0.03f, 0.03f, 0.03f, 0.06f, 0.01f, 0.04f, 0.03f, 0.03f, 0.03f, 0.2f, 0.01f};
            for (int st = 0; st < 12; ++st) { const float e = __builtin_bit_cast(float, ctl[CW_CHK + st]); if (!(e <= thr[st])) { A.out[0] = 4000.0f * (float)(1 << st); break; } }
        } else {
            const float e = fminf(__builtin_bit_cast(float, ctl[CW_CHK + what]), 1e6f); A.out[0] = 4000.0f * sqrtf(1e6f * e);
        }
    }
}
#endif

__global__ void __launch_bounds__(NTHR, 2) fwd_kernel(Args args) {
    extern __shared__ __attribute__((aligned(16))) unsigned char lds_raw[];
    LAS unsigned char* lds = (LAS unsigned char*)lds_raw;
    const int tid = threadIdx.x, lane = tid & 63, wave = __builtin_amdgcn_readfirstlane(tid >> 6), bid = blockIdx.x, G = gridDim.x;
    for (int u = tid; u < (LDS_BYTES - LDSCTL_OFF) / 4; u += NTHR) ((LAS unsigned*)(lds + LDSCTL_OFF))[u] = 0u;
    __syncthreads();
    unsigned* ctl = (unsigned*)(args.ws + WS_CTL);
    XcdBarrier bar; bar.bar = ctl + CW_BAR + args.li * XCD_BAR_WORDS; bar.x = 0; bar.st = nullptr;
    if (MK_N_LAUNCHES != N_PHASES) bar = xcd_barrier_post(ctl + CW_BAR + args.li * XCD_BAR_WORDS, (volatile LAS unsigned*)(lds + MISC_OFF) + 8);
    const int lo = args.ph_lo, hi = args.ph_hi;
#define IN(k) (lo <= (k) && (k) < hi)
#define SEAM(k) do { if (IN(k) && IN((k) + 1)) xcd_barrier(bar); } while (0)
#define PHON(k) ((PH_MASK >> (k)) & 1)
    if (PHON(0) && IN(0)) { phase_p0(args, lds, tid, lane, wave, bid, G); }
    SEAM(0);
    if (PHON(1) && IN(1)) { phase_p1(args, tid, lane, wave, bid, G); }
    SEAM(1);
    if (PHON(2) && IN(2)) {
        pg8::Gemm g{(const bf16*)(args.ws + WS_RA), (const bf16*)(args.ws + WS_BT1), T, IN_COLS, D}; pg8::StaticOrder S; S.init(T, IN_COLS, G, bid);
        pg8::EpiBf16<0> E{(bf16*)(args.ws + WS_PROJ), IN_COLS, nullptr, 0, 0, 1.f};
        pg8::gemm_phase<pg8::EpiBf16<0>, pg8::StaticOrder, PG8_ALIGN, PG8_SP2>(lds + RING_OFF, g, S, E);
    }
    SEAM(2);
    if (PHON(3) && IN(3)) { phase_m1a(args, lds, tid, lane, wave, bid, G); }
    SEAM(3);
    if (PHON(4) && IN(4)) { phase_m1b(args, tid, lane, wave, bid, G); }
    SEAM(4);
    if (PHON(5) && IN(5)) { phase_m3(args, lds, tid, lane, wave, bid, G); }
    SEAM(5);
    if (PHON(6) && IN(6)) {
        pg8::Gemm g{(const bf16*)(args.ws + WS_RA), (const bf16*)(args.ws + WS_BT2), T, D, D}; pg8::StaticOrder S; S.init(T, D, G, bid);
        pg8::EpiBf16<0> E{(bf16*)(args.ws + WS_Y1), D, nullptr, 0, 0, 1.f};
        pg8::gemm_phase<pg8::EpiBf16<0>, pg8::StaticOrder, PG8_ALIGN, PG8_SP2>(lds + RING_OFF, g, S, E);
    }
    SEAM(6);
    if (PHON(7) && IN(7)) { phase_e2(args, tid, lane, wave, bid, G); }
    SEAM(7);
    if (PHON(8) && IN(8)) {
        pg8::Gemm g{(const bf16*)(args.ws + WS_RA), (const bf16*)(args.ws + WS_BT3), T, D, D}; pg8::StaticOrder S; S.init(T, D, G, bid);
        pg8::EpiBf16<0> E{(bf16*)(args.ws + WS_Q), D, nullptr, 0, 0, 1.f};
        pg8::gemm_phase<pg8::EpiBf16<0>, pg8::StaticOrder, PG8_ALIGN, PG8_SP2>(lds + RING_OFF, g, S, E);
    }
    SEAM(8);
    if (PHON(9) && IN(9)) { phase_s(args, tid, lane, wave, bid, G); }
    SEAM(9);
    if (PHON(10) && IN(10)) { phase_pe(args, tid, lane, wave, bid, G); }
#undef IN
#undef SEAM
}

extern "C" void kernel_launch(void* const* d_in, const int* in_sizes, int n_in, void* d_out, int out_size, void* d_ws, size_t ws_size, hipStream_t stream) {
    static int grid = 0;
    if (grid == 0) {
        if (n_in != 25 || in_sizes[0] != T * D || out_size != T * D || ws_size < WS_END) {
            fprintf(stderr, "kernel_launch: built for 25 inputs, x/out of %d floats, >= %zu bytes of workspace; got n_in %d, in0 %d, out %d, ws %zu; nothing launched\n", T * D, (size_t)WS_END, n_in, n_in > 0 ? in_sizes[0] : -1, out_size, ws_size);
            grid = -1; return; }
        int dev = 0, cus = 0, per_cu = 0;
        if (hipGetDevice(&dev) != hipSuccess || hipDeviceGetAttribute(&cus, hipDeviceAttributeMultiprocessorCount, dev) != hipSuccess) { fprintf(stderr, "kernel_launch: device query failed\n"); grid = -1; return; }
        if (hipFuncSetAttribute((const void*)fwd_kernel, hipFuncAttributeMaxDynamicSharedMemorySize, LDS_BYTES) != hipSuccess) { fprintf(stderr, "kernel_launch: hipFuncSetAttribute failed\n"); grid = -1; return; }
        if (hipOccupancyMaxActiveBlocksPerMultiprocessor(&per_cu, (const void*)fwd_kernel, NTHR, LDS_BYTES) != hipSuccess || per_cu < 1)
            fprintf(stderr, "kernel_launch: note: occupancy query reports %d workgroups per CU\n", per_cu);
        (void)hipGetLastError();
        grid = cus;
    }
    if (grid < 0) return;
    if (hipMemsetAsync((char*)d_ws + WS_CTL, 0, CTL_ZERO_BYTES, stream) != hipSuccess) { fprintf(stderr, "kernel_launch: memset failed\n"); return; }
    Args a{};
    for (int i = 0; i < 25; ++i) a.in[i] = (const float*)d_in[i];
    a.out = (float*)d_out; a.ws = (unsigned char*)d_ws;
#if defined(MK_TIME_REP)
    const int cuts[3][2] = {{0, MK_TIME_REP + 1}, {MK_TIME_REP, MK_TIME_REP + 1}, {MK_TIME_REP + 1, N_PHASES}};
    for (int li = 0; li < 3; ++li) {
        a.ph_lo = cuts[li][0]; a.ph_hi = cuts[li][1]; a.li = li;
        if (a.ph_lo < a.ph_hi) hipLaunchKernelGGL(fwd_kernel, dim3(grid), dim3(NTHR), LDS_BYTES, stream, a);
    }
#else
    for (int li = 0; li < MK_N_LAUNCHES; ++li) {
        if (MK_N_LAUNCHES == 1) { a.ph_lo = 0; a.ph_hi = N_PHASES; } else { a.ph_lo = li; a.ph_hi = li + 1; }
        a.li = 0;
        hipLaunchKernelGGL(fwd_kernel, dim3(grid), dim3(NTHR), LDS_BYTES, stream, a);
        const hipError_t le = hipPeekAtLastError();
        if (le != hipSuccess) { fprintf(stderr, "kernel_launch: launch %d failed: %s\n", li, hipGetErrorName(le)); break; }
#if defined(MK_CHECKS)
        { const int chk_of_phase[N_PHASES] = {0, 1, 2, 3, 4, 6, 7, 8, 9, 10, 11}; hipLaunchKernelGGL(chk_kernel, dim3(4), dim3(128), 0, stream, a, chk_of_phase[li]); }
#endif
    }
#endif
#if defined(MK_CHECKS)
    hipLaunchKernelGGL(chk_encode, dim3(1), dim3(64), 0, stream, a, MK_CHECKS);
#endif
}
```

```cpp
#include <hip/hip_runtime.h>
#include <cstdio>
#include <cstdint>
#include <cmath>
namespace pg8 {
#define PG8_LAS __attribute__((address_space(3)))
typedef unsigned short bf16_t;
typedef short bf16x8 __attribute__((ext_vector_type(8)));
typedef float f32x4 __attribute__((ext_vector_type(4)));
typedef unsigned u32x4 __attribute__((ext_vector_type(4)));
constexpr int BM = 256, BK = 64, HALF = 128, HTB = HALF * BK * 2  , STAGE_BYTES = 8 * HTB, NXCD = 8, WGM = 8;

__host__ __device__ __forceinline__ int lds_byte(int r, int c) { const int st = (r >> 4) * 2 + (c >> 5), rr = r & 15, cc = c & 31, ob = rr * 64 + cc * 2; return st * 1024 + (ob ^ (((ob >> 9) & 1) << 5)); }
__host__ __device__ __forceinline__ void stage_rc(int b, int& R, int& C) { const int st = b / 1024, sb = b % 1024, swz = sb ^ (((sb >> 9) & 1) << 5); R = (st >> 1) * 16 + swz / 64; C = (st & 1) * 32 + (swz % 64) / 2; }
__host__ __device__ __forceinline__ int perm32(int rho) { const int n = rho >> 4, i = rho & 15; return 8 * (i >> 2) + 4 * n + (i & 3); }

struct Unit { int pm, pn; };
struct Gemm { const bf16_t* A; const bf16_t* Bt; int M, N, K; };

struct StaticOrder {
    int nM, nN, nwg, G, c;
    __host__ __device__ void init(int M, int N, int G_, int c_) { nM = M / BM; nN = N / BM; nwg = nM * nN; G = G_; c = c_; }
    __host__ __device__ bool next(int i, Unit& u) const {
        const long L = (long)i * G + c; if (L >= nwg) return false;
        int wgid = (int)L; { const int q = nwg / NXCD, r = nwg % NXCD, xcd = wgid % NXCD, off = wgid / NXCD; wgid = (xcd < r ? xcd * (q + 1) : r * (q + 1) + (xcd - r) * q) + off; }
        const int nig = WGM * nN, gid = wgid / nig, fm = gid * WGM, gsz = (nM - fm) < WGM ? (nM - fm) : WGM;
        u.pm = fm + ((wgid % nig) % gsz); u.pn = (wgid % nig) / gsz; return true;
    }
    __device__ __forceinline__ void a_ready(const Unit&) const {}
    __device__ __forceinline__ void done(const Unit&) const {}
};

__device__ __forceinline__ unsigned cvt_pk_bf16(float lo, float hi) { unsigned r; asm volatile("v_cvt_pk_bf16_f32 %0, %1, %2" : "=v"(r) : "v"(lo), "v"(hi)); return r; }
typedef float f32x2 __attribute__((ext_vector_type(2)));
__device__ __forceinline__ f32x2 gelu_pk(f32x2 v) {
    const f32x2 av = __builtin_elementwise_abs(v), d = av * 0.2316418882f + 1.0f;
    f32x2 t; t.x = __builtin_amdgcn_rcpf(d.x); t.y = __builtin_amdgcn_rcpf(d.y);
    f32x2 q = t * 0.5307027145f + (-0.7265760135f); q = q * t + 0.7107068705f; q = q * t + (-0.142248368f); q = q * t + 0.127414796f; q = q * t;
    const f32x2 s = (v * v) * (-0.72134752044f);
    f32x2 e; e.x = __builtin_amdgcn_exp2f(s.x); e.y = __builtin_amdgcn_exp2f(s.y);
    const f32x2 m = v * (q * e), r = v - m;
    f32x2 o; o.x = v.x < 0.f ? m.x : r.x; o.y = v.y < 0.f ? m.y : r.y; return o;
}

template <int ACT  > struct EpiBf16 {
    static constexpr bool PERM = true, AFTER_DRAIN = false; static_assert(ACT == 0 || ACT == 1, "EpiBf16: ACT is 0 (none) or 1 (gelu_pk)");
    bf16_t* O; int ldc; const float* bias; int split_cols; size_t split_stride; float scale0;
    __device__ __forceinline__ void operator()(const f32x4 (&acc)[2][2][4][2], const Unit& u, int wr, int wc, int fr, int fq) const {
        const int row0 = u.pm * BM + wr * 64 + fr; int colt = u.pn * BM; bf16_t* base = O;
        float sc = 1.f; if (split_cols) { const int t = colt / split_cols; base += (size_t)t * split_stride; colt -= t * split_cols; if (t == 0) sc = scale0; }
        const int col0 = colt + wc * 32 + 8 * fq, bcol0 = u.pn * BM + wc * 32 + 8 * fq;
        f32x4 bv[2][2];
#pragma unroll
        for (int bj = 0; bj < 2; ++bj)
#pragma unroll
            for (int n = 0; n < 2; ++n) bv[bj][n] = bias ? *(const f32x4*)(bias + bcol0 + bj * HALF + 4 * n) : (f32x4){0.f, 0.f, 0.f, 0.f};
#pragma unroll
        for (int ai = 0; ai < 2; ++ai)
#pragma unroll
            for (int m = 0; m < 4; ++m) { bf16_t* rowp = base + (size_t)(row0 + ai * HALF + m * 16) * ldc + col0;
#pragma unroll
                for (int bj = 0; bj < 2; ++bj) { f32x4 v0 = acc[ai][bj][m][0] + bv[bj][0], v1 = acc[ai][bj][m][1] + bv[bj][1];
                    if (ACT == 1) { f32x2 a = gelu_pk((f32x2){v0[0], v0[1]}), b = gelu_pk((f32x2){v0[2], v0[3]}), c = gelu_pk((f32x2){v1[0], v1[1]}), d = gelu_pk((f32x2){v1[2], v1[3]});
                        v0 = (f32x4){a.x, a.y, b.x, b.y}; v1 = (f32x4){c.x, c.y, d.x, d.y}; }
                    v0 = v0 * sc; v1 = v1 * sc; u32x4 w; w.x = cvt_pk_bf16(v0[0], v0[1]); w.y = cvt_pk_bf16(v0[2], v0[3]); w.z = cvt_pk_bf16(v1[0], v1[1]); w.w = cvt_pk_bf16(v1[2], v1[3]);
                    *(u32x4*)(rowp + bj * HALF) = w; } }
    }
};
template <class Epi, class Sched, bool ALIGN_EPI = false, bool SP2 = false>
__device__ __forceinline__ void gemm_phase(PG8_LAS unsigned char* lds, const Gemm g, const Sched& S, const Epi& E) {
    const int tid = threadIdx.x, wid = __builtin_amdgcn_readfirstlane(tid >> 6), lane = tid & 63, wr = wid >> 2, wc = wid & 3, fr = lane & 15, fq = lane >> 4;
    const int K = g.K, nt = K / BK;
    unsigned voffA[2], voffB[2];
#pragma unroll
    for (int i = 0; i < 2; ++i) { int R, C; stage_rc(tid * 16 + i * 8192, R, C); const int Rb = Epi::PERM ? ((R & ~31) + perm32(R & 31)) : R;
        voffA[i] = (unsigned)(R * K + C) * 2u; voffB[i] = (unsigned)(Rb * K + C) * 2u; }
    const size_t kstep = (size_t)(BK * 2);
    const size_t hstep = (size_t)HALF * K * 2;
    const size_t tstep = 2 * hstep;
    const unsigned ldsw = (unsigned)wid * 1024u;
    const int aoff = lds_byte(wr * 64 + fr, fq * 8), boff = lds_byte(wc * 32 + fr, fq * 8);
#define PG8_SA(b, h) (((b) * 2 + (h)) * HTB)
#define PG8_SB(b, h) ((4 + (b) * 2 + (h)) * HTB)
#define PG8_STAGE(bufoff, gbase, voff) do { _Pragma("unroll") for (int _i = 0; _i < 2; ++_i) \
        __builtin_amdgcn_global_load_lds((const unsigned*)((const char*)(gbase) + (voff)[_i]), (PG8_LAS unsigned*)(lds + (bufoff) + ldsw + _i * 8192), 16, 0, 0); } while (0)
#define PG8_LDA(dst, b, h) do { _Pragma("unroll") for (int m = 0; m < 4; ++m) _Pragma("unroll") for (int k = 0; k < 2; ++k) dst[m][k] = *(const PG8_LAS bf16x8*)(lds + PG8_SA(b, h) + aoff + m * 2048 + k * 1024); } while (0)
#define PG8_LDB(dst, b, h) do { _Pragma("unroll") for (int n = 0; n < 2; ++n) _Pragma("unroll") for (int k = 0; k < 2; ++k) dst[n][k] = *(const PG8_LAS bf16x8*)(lds + PG8_SB(b, h) + boff + n * 2048 + k * 1024); } while (0)
#define PG8_MMA(ai, bj, At, Bt) do { __builtin_amdgcn_s_setprio(1); _Pragma("unroll") for (int m = 0; m < 4; ++m) _Pragma("unroll") for (int n = 0; n < 2; ++n) _Pragma("unroll") for (int k = 0; k < 2; ++k) \
        acc[ai][bj][m][n] = __builtin_amdgcn_mfma_f32_16x16x32_bf16(Bt[n][k], At[m][k], acc[ai][bj][m][n], 0, 0, 0); __builtin_amdgcn_s_setprio(0); } while (0)
#define PG8_WAIT_V(n) asm volatile("s_waitcnt vmcnt(" #n ")" ::: "memory")
#define PG8_WAIT_L(n) asm volatile("s_waitcnt lgkmcnt(" #n ")" ::: "memory")
#define PG8_BAR __builtin_amdgcn_s_barrier()
#define PG8_SCHED __builtin_amdgcn_sched_barrier(0)
    Unit cur, nxt; int ui = 0;
    if (!S.next(0, cur)) return;
    f32x4 acc[2][2][4][2];
#pragma unroll
    for (int a = 0; a < 2; ++a)
#pragma unroll
        for (int b = 0; b < 2; ++b)
#pragma unroll
            for (int m = 0; m < 4; ++m)
#pragma unroll
                for (int n = 0; n < 2; ++n) acc[a][b][m][n] = (f32x4){0.f, 0.f, 0.f, 0.f};
    bf16x8 At[4][2], B0[2][2], B1[2][2];
    const char* cA = (const char*)g.A + (size_t)cur.pm * tstep; const char* cB = (const char*)g.Bt + (size_t)cur.pn * tstep;
    S.a_ready(cur);
    if constexpr (SP2) {
        PG8_STAGE(PG8_SB(0, 0), cB, voffB); PG8_STAGE(PG8_SB(0, 1), cB + hstep, voffB); PG8_STAGE(PG8_SA(0, 0), cA, voffA); PG8_STAGE(PG8_SA(0, 1), cA + hstep, voffA);
        if (wr == 1) PG8_BAR;
        PG8_WAIT_V(2); PG8_BAR;
        PG8_STAGE(PG8_SB(1, 0), cB + kstep, voffB); PG8_STAGE(PG8_SA(1, 0), cA + kstep, voffA); PG8_STAGE(PG8_SB(1, 1), cB + hstep + kstep, voffB);
        PG8_WAIT_V(6); PG8_BAR;
    } else {
        PG8_STAGE(PG8_SB(0, 0), cB, voffB); PG8_STAGE(PG8_SA(0, 0), cA, voffA); PG8_STAGE(PG8_SB(0, 1), cB + hstep, voffB); PG8_STAGE(PG8_SA(0, 1), cA + hstep, voffA);
        if (wr == 1) PG8_BAR;
        PG8_WAIT_V(4); PG8_BAR;
        PG8_STAGE(PG8_SB(1, 0), cB + kstep, voffB); PG8_STAGE(PG8_SA(1, 0), cA + kstep, voffA); PG8_STAGE(PG8_SB(1, 1), cB + hstep + kstep, voffB);
        PG8_WAIT_V(6); PG8_BAR;
    }
    for (;;) {
        const bool has_next = S.next(ui + 1, nxt);
        const char* nA = has_next ? (const char*)g.A + (size_t)nxt.pm * tstep : cA; const char* nB = has_next ? (const char*)g.Bt + (size_t)nxt.pn * tstep : cB;
        for (int t = 0; t < nt; t += 2) {
            const bool last = (t == nt - 2);
            const char* a1 = cA + (size_t)(t + 1) * kstep;
            const char* a2 = last ? nA : cA + (size_t)(t + 2) * kstep; const char* b2 = last ? nB : cB + (size_t)(t + 2) * kstep;
            const char* a3 = a2 + kstep; const char* b3 = b2 + kstep;
            if (last && has_next) S.a_ready(nxt);
            if constexpr (SP2) {
            PG8_LDB(B0, 0, 0); PG8_LDB(B1, 0, 1); PG8_SCHED; PG8_LDA(At, 0, 0); PG8_STAGE(PG8_SA(1, 1), a1 + hstep, voffA);
            PG8_WAIT_V(8); PG8_WAIT_L(0); PG8_BAR; PG8_MMA(0, 0, At, B0); PG8_MMA(0, 1, At, B1); PG8_BAR; PG8_SCHED;
            PG8_LDA(At, 0, 1); PG8_STAGE(PG8_SB(0, 0), b2, voffB); PG8_STAGE(PG8_SB(0, 1), b2 + hstep, voffB); PG8_STAGE(PG8_SA(0, 0), a2, voffA);
            PG8_WAIT_V(8); PG8_WAIT_L(0); PG8_BAR; PG8_MMA(1, 0, At, B0); PG8_MMA(1, 1, At, B1); PG8_BAR; PG8_SCHED;
            PG8_LDB(B0, 1, 0); PG8_LDB(B1, 1, 1); PG8_SCHED; PG8_LDA(At, 1, 0); PG8_STAGE(PG8_SA(0, 1), a2 + hstep, voffA);
            PG8_WAIT_V(8); PG8_WAIT_L(0); PG8_BAR; PG8_MMA(0, 0, At, B0); PG8_MMA(0, 1, At, B1); PG8_BAR; PG8_SCHED;
            PG8_LDA(At, 1, 1); PG8_STAGE(PG8_SB(1, 0), b3, voffB); PG8_STAGE(PG8_SB(1, 1), b3 + hstep, voffB); PG8_STAGE(PG8_SA(1, 0), a3, voffA);
            PG8_WAIT_V(8); PG8_WAIT_L(0); PG8_BAR; PG8_MMA(1, 0, At, B0); PG8_MMA(1, 1, At, B1); PG8_BAR; PG8_SCHED;
            } else {
            PG8_LDB(B0, 0, 0); PG8_SCHED; PG8_LDA(At, 0, 0); PG8_STAGE(PG8_SA(1, 1), a1 + hstep, voffA);
            PG8_WAIT_L(8); PG8_BAR; PG8_WAIT_L(0); PG8_MMA(0, 0, At, B0); PG8_BAR; PG8_SCHED;
            PG8_LDB(B1, 0, 1); PG8_STAGE(PG8_SB(0, 0), b2, voffB);
            PG8_BAR; PG8_WAIT_L(0); PG8_MMA(0, 1, At, B1); PG8_BAR;
            PG8_LDA(At, 0, 1); PG8_STAGE(PG8_SA(0, 0), a2, voffA);
            PG8_BAR; PG8_WAIT_L(0); PG8_MMA(1, 0, At, B0); PG8_BAR; PG8_SCHED;
            PG8_STAGE(PG8_SB(0, 1), b2 + hstep, voffB);
            PG8_WAIT_V(6); PG8_BAR; PG8_MMA(1, 1, At, B1); PG8_BAR;
            PG8_LDB(B0, 1, 0); PG8_SCHED; PG8_LDA(At, 1, 0); PG8_STAGE(PG8_SA(0, 1), a2 + hstep, voffA);
            PG8_WAIT_L(8); PG8_BAR; PG8_WAIT_L(0); PG8_MMA(0, 0, At, B0); PG8_BAR; PG8_SCHED;
            PG8_LDB(B1, 1, 1); PG8_STAGE(PG8_SB(1, 0), b3, voffB);
            PG8_BAR; PG8_WAIT_L(0); PG8_MMA(0, 1, At, B1); PG8_BAR;
            PG8_LDA(At, 1, 1); PG8_STAGE(PG8_SA(1, 0), a3, voffA);
            PG8_BAR; PG8_WAIT_L(0); PG8_MMA(1, 0, At, B0); PG8_BAR; PG8_SCHED;
            PG8_STAGE(PG8_SB(1, 1), b3 + hstep, voffB);
            PG8_WAIT_V(6); PG8_BAR; PG8_MMA(1, 1, At, B1); PG8_BAR;
            }
        }
        if constexpr (ALIGN_EPI) { if (wr == 0) PG8_BAR; }
        if constexpr (!Epi::AFTER_DRAIN) { E(acc, cur, wr, wc, fr, fq); S.done(cur); }
        if (!has_next) break;
#pragma unroll
        for (int a = 0; a < 2; ++a)
#pragma unroll
            for (int b = 0; b < 2; ++b)
#pragma unroll
                for (int m = 0; m < 4; ++m)
#pragma unroll
                    for (int n = 0; n < 2; ++n) acc[a][b][m][n] = (f32x4){0.f, 0.f, 0.f, 0.f};
        cur = nxt; cA = nA; cB = nB; ++ui;
        if constexpr (ALIGN_EPI) { if (wr == 1) PG8_BAR; }
    }
    PG8_WAIT_V(0);
    if constexpr (!ALIGN_EPI) { if (wr == 0) PG8_BAR; }
    PG8_BAR;
    if constexpr (Epi::AFTER_DRAIN) { E.fused(acc, cur, wr, wc, fr, fq, lds, wid, lane); S.done(cur); }
#undef PG8_SA
#undef PG8_SB
#undef PG8_STAGE
#undef PG8_LDA
#undef PG8_LDB
#undef PG8_MMA
#undef PG8_WAIT_V
#undef PG8_WAIT_L
#undef PG8_BAR
#undef PG8_SCHED
}
}
#ifndef PG8_SP2
#define PG8_SP2 true
#endif
#ifndef PG8_ALIGN
#define PG8_ALIGN true
#endif
#ifndef OUT_MODE
#define OUT_MODE 0
#endif
#ifndef REP_MASK
#define REP_MASK 0
#endif
#ifndef S_CONV
#define S_CONV 1
#endif
#ifndef PE_RB
#define PE_RB 4
#endif
#ifndef PE_SORT
#define PE_SORT 1
#endif
#ifndef PH_MASK
#define PH_MASK 0xFFF
#endif
#ifndef MK_N_LAUNCHES
#define MK_N_LAUNCHES 1
#endif

constexpr int NWAVES = 8, NTHR = NWAVES * 64;
constexpr int BATCH = 2, SEQ = 8192, D = 2048, T = BATCH * SEQ;
constexpr int LRU_W = 1024, CONF_W = 1024, IN_COLS = 4096, LRU_HD = 128;
constexpr int NH = 8, NKEY = 128, TOPK = 16, NEXP = NKEY * NKEY, KSEL = NH * TOPK;
constexpr int NMOD = 6 * D;
constexpr int CHUNK = 64, NCHUNK = SEQ / CHUNK;
constexpr int CONF_K = 31;
constexpr float EPS = 1e-6f;
constexpr int N_PHASES = 11;

constexpr size_t MiB = 1u << 20;
constexpr size_t WS_CTL = 0, CTL_ZERO_BYTES = 64 * 1024;
constexpr size_t WS_MODP = 1 * MiB;
constexpr size_t WS_CFIN = 2 * MiB;
constexpr size_t WS_CARRY = 3 * MiB;
constexpr size_t WS_AGG = 4 * MiB;
constexpr size_t WS_WG = 6 * MiB;
constexpr size_t WS_SUBK = 7 * MiB;
constexpr size_t WS_BT1 = 8 * MiB;
constexpr size_t WS_BT2 = 24 * MiB;
constexpr size_t WS_BT3 = 32 * MiB;
constexpr size_t WS_IDX = 40 * MiB;
constexpr size_t WS_GATE = 48 * MiB;
constexpr size_t WS_USC = 56 * MiB;
constexpr size_t WS_VSC = 57 * MiB;
constexpr size_t WS_RA = 64 * MiB;
constexpr size_t WS_Y1 = 128 * MiB;
constexpr size_t WS_PROJ = 192 * MiB;
constexpr size_t WS_Q = 192 * MiB;
constexpr size_t WS_UB = 256 * MiB;
constexpr size_t WS_XL = 320 * MiB;
constexpr size_t WS_ZC = 352 * MiB;
constexpr size_t WS_HLOC = 384 * MiB;
constexpr size_t WS_PC = 416 * MiB;
constexpr size_t WS_VB = 320 * MiB;
constexpr size_t WS_END = 448 * MiB;
constexpr int CW_TMO = 0, CW_BAR = 4096;

constexpr int RING_OFF = 0, RING_BYTES = 131072;
constexpr int LDSCTL_OFF = RING_BYTES, MISC_OFF = LDSCTL_OFF + 320;
constexpr int LDS_BYTES = 147456;

#define GAS __attribute__((address_space(1)))
#define LAS __attribute__((address_space(3)))
typedef unsigned short bf16;
typedef unsigned v4u __attribute__((ext_vector_type(4)));
typedef unsigned v2u __attribute__((ext_vector_type(2)));
typedef float f32x4 __attribute__((ext_vector_type(4)));
typedef float f32x16 __attribute__((ext_vector_type(16)));
typedef float f32x2 __attribute__((ext_vector_type(2)));
typedef short bf16x8 __attribute__((ext_vector_type(8)));
typedef __bf16 bfp2 __attribute__((ext_vector_type(2)));
typedef GAS unsigned gu32;
#define RLX_AGENT __ATOMIC_RELAXED, __HIP_MEMORY_SCOPE_AGENT
#define LDS_WAIT() asm volatile("s_waitcnt lgkmcnt(0)" ::: "memory")
#define VM_WAIT() asm volatile("s_waitcnt vmcnt(0)" ::: "memory")
__device__ __forceinline__ unsigned f2bf(float f) { unsigned u = __builtin_bit_cast(unsigned, f); return (u + 0x7fffu + ((u >> 16) & 1u)) >> 16; }
__device__ __forceinline__ unsigned pk2(float lo, float hi) { return f2bf(lo) | (f2bf(hi) << 16); }
__device__ __forceinline__ float bflo(unsigned u) { return __builtin_bit_cast(float, u << 16); }
__device__ __forceinline__ float bfhi(unsigned u) { return __builtin_bit_cast(float, u & 0xffff0000u); }
__device__ __forceinline__ float wave_sum(float v) {
#pragma unroll
    for (int o = 1; o < 64; o <<= 1) v += __shfl_xor(v, o);
    return v;
}
__device__ __forceinline__ float sigmoidf_(float x) { return __builtin_amdgcn_rcpf(1.0f + __expf(-x)); }
__device__ __forceinline__ float gelu_tanh(float x) { return x * sigmoidf_(1.5957691216057308f * (x + 0.044715f * x * x * x)); }
__device__ __forceinline__ float rdlane(float v, int l) { return __builtin_bit_cast(float, __builtin_amdgcn_readlane(__builtin_bit_cast(int, v), l)); }

#define XB_TMO      128
#define XB_XCNT(j)  (256  + 64 * (j))
#define XB_XSUB(j)  (1280 + 64 * (j))
#define XB_XGEN(j)  (2304 + 64 * (j))
#define XB_TOP      3328
#define XB_TOPGEN   3392
#define XCD_BAR_WORDS 3456
#define XB_SPIN_CAP (1u << 18)

__device__ __forceinline__ unsigned xb_ld(unsigned* p)              { return __hip_atomic_load(p, __ATOMIC_RELAXED, __HIP_MEMORY_SCOPE_AGENT); }
__device__ __forceinline__ unsigned xb_add(unsigned* p, unsigned v) { return __hip_atomic_fetch_add(p, v, __ATOMIC_RELAXED, __HIP_MEMORY_SCOPE_AGENT); }
__device__ __forceinline__ unsigned xb_xcc_id() { return (unsigned)__builtin_amdgcn_s_getreg((3 << 11) | 20) & 0xFu; }
#define XB_SPIN(cond, bar) do { unsigned _sp = 0; while (cond) { __builtin_amdgcn_s_sleep(1); \
    if ((++_sp & 255u) == 0u) { if (xb_ld(&(bar)[XB_TMO])) break; if (_sp > XB_SPIN_CAP) { atomicAdd(&(bar)[XB_TMO], 1u); break; } } } } while (0)

struct XcdBarrier {
    unsigned* bar; unsigned x;
    volatile LAS unsigned* st;
};

__device__ __forceinline__ XcdBarrier xcd_barrier_post(unsigned* bar, volatile LAS unsigned* st) {
    XcdBarrier b; b.bar = bar; b.x = xb_xcc_id(); b.st = st;
    if (threadIdx.x == 0) (void)xb_add(&bar[XB_XCNT(b.x)], 1u);
    return b;
}
__device__ __forceinline__ void xcd_barrier_complete(unsigned* bar, unsigned x, unsigned& nloc, unsigned& nx) {
    const unsigned G = gridDim.x * gridDim.y * gridDim.z;
    unsigned sum, cnt, mine, sp = 0u;
    for (;;) {
        sum = 0u; cnt = 0u; mine = 0u;
#pragma unroll
        for (unsigned j = 0; j < 16; ++j) { const unsigned c = xb_ld(&bar[XB_XCNT(j)]); sum += c; cnt += (c > 0u) ? 1u : 0u; mine = (j == x) ? c : mine; }
        if (sum == G) break;
        __builtin_amdgcn_s_sleep(1);
        if ((++sp & 255u) == 0u) { if (xb_ld(&bar[XB_TMO])) break; if (sp > XB_SPIN_CAP) { atomicAdd(&bar[XB_TMO], 1u); break; } }
    }
    nloc = mine > 0u ? mine : 1u; nx = cnt > 0u ? cnt : 1u;
}

__device__ __forceinline__ void xcd_barrier(const XcdBarrier& b) {
    asm volatile("s_waitcnt vmcnt(0)" ::: "memory");
    __syncthreads();
    if (threadIdx.x == 0) {
        unsigned* bar = b.bar;
        __builtin_amdgcn_s_waitcnt(0);
        unsigned nloc = b.st[0], nx = b.st[1];
        if (nloc == 0u) { xcd_barrier_complete(bar, b.x, nloc, nx); b.st[0] = nloc; b.st[1] = nx; }
        const unsigned old = xb_add(&bar[XB_XSUB(b.x)], 1u);
        const unsigned gen = old / nloc;
        if (old + 1u == (gen + 1u) * nloc) {
            __builtin_amdgcn_fence(__ATOMIC_RELEASE, "agent");
            asm volatile("s_waitcnt vmcnt(0)" ::: "memory");
            const unsigned og = xb_add(&bar[XB_TOP], 1u);
            const unsigned tg = og / nx;
            if (og + 1u == (tg + 1u) * nx) xb_add(&bar[XB_TOPGEN], 1u);
            else XB_SPIN(xb_ld(&bar[XB_TOPGEN]) == tg, bar);
            __builtin_amdgcn_fence(__ATOMIC_ACQUIRE, "agent");
            xb_add(&bar[XB_XGEN(b.x)], 1u);
            asm volatile("s_waitcnt vmcnt(0)" ::: "memory");
        } else {
            XB_SPIN(xb_ld(&bar[XB_XGEN(b.x)]) == gen, bar);
            __builtin_amdgcn_fence(__ATOMIC_ACQUIRE, "agent");
            asm volatile("s_waitcnt vmcnt(0)" ::: "memory");
        }
    }
    __syncthreads();
}
struct Args { const float* in[25]; float* out; unsigned char* ws; int ph_lo, ph_hi, li, pad; };
enum { I_X = 0, I_C, I_WMOD, I_BMOD, I_GPREMIX, I_GPOSTMIX, I_GPREFFN, I_GPOSTFFN, I_WIN, I_LCW, I_LCB, I_WA, I_BA, I_WX, I_BX, I_LAMBDA,
       I_CDW, I_CDB, I_LNG, I_LNB, I_WOUT, I_WQ, I_SUBK, I_PU, I_PV };

__device__ __forceinline__ float mod_at(const float* modp, int b, int n) {
    return (modp[(0 * 2 + b) * NMOD + n] + modp[(1 * 2 + b) * NMOD + n]) + (modp[(2 * 2 + b) * NMOD + n] + modp[(3 * 2 + b) * NMOD + n]);
}

__device__ __forceinline__ void p0_transpose_item(const float* W, int K, int N, bf16* WT, LAS float* scr, int item, int lane) {
    const int nblk = N / 32, kb = item / nblk, nb = item % nblk, k0 = 64 * kb, n0 = 32 * nb;
#pragma unroll 8
    for (int i = 0; i < 32; ++i) { const int kk = 2 * i + (lane >> 5); scr[kk * 33 + (lane & 31)] = W[(size_t)(k0 + kk) * N + n0 + (lane & 31)]; }
    LDS_WAIT(); asm volatile("" ::: "memory");
    const int c = lane & 7;
#pragma unroll
    for (int j = 0; j < 4; ++j) { const int n = (lane >> 3) + 8 * j; const LAS float* s = scr + (8 * c) * 33 + n;
        v4u o; o.x = pk2(s[0 * 33], s[1 * 33]); o.y = pk2(s[2 * 33], s[3 * 33]); o.z = pk2(s[4 * 33], s[5 * 33]); o.w = pk2(s[6 * 33], s[7 * 33]);
        *(GAS v4u*)(WT + (size_t)(n0 + n) * K + k0 + 8 * c) = o; }
    LDS_WAIT(); asm volatile("" ::: "memory");
}
__device__ __forceinline__ void cvt_rows_bf16(const float* src, bf16* dst, size_t n8, size_t gt, size_t ngt) {
    for (size_t i = gt; i < n8; i += ngt) {
        const f32x4 a = ((const GAS f32x4*)src)[2 * i], b = ((const GAS f32x4*)src)[2 * i + 1];
        v4u o; o.x = pk2(a.x, a.y); o.y = pk2(a.z, a.w); o.z = pk2(b.x, b.y); o.w = pk2(b.z, b.w);
        ((GAS v4u*)dst)[i] = o; }
}
__device__ __forceinline__ void phase_p0(const Args& A, LAS unsigned char* lds, int tid, int lane, int wave, int bid, int G) {
    float* modp = (float*)(A.ws + WS_MODP);
    for (int item = bid; item < 192; item += G) {
        const int cg = item % 48, kq = item / 48, k0 = kq * 512 + wave * 64, n0 = cg * 256 + lane * 4;
        const float c0 = A.in[I_C][k0 + lane], c1 = A.in[I_C][D + k0 + lane];
        const float ca0 = c0 * sigmoidf_(c0), ca1 = c1 * sigmoidf_(c1);
        f32x4 a0 = {0.f, 0.f, 0.f, 0.f}, a1 = {0.f, 0.f, 0.f, 0.f};
        const float* wp = A.in[I_WMOD] + (size_t)k0 * NMOD + n0;
#pragma unroll 8
        for (int kk = 0; kk < 64; ++kk) {
            const f32x4 w = *(const GAS f32x4*)(wp + (size_t)kk * NMOD);
            const float s0 = __shfl(ca0, kk), s1 = __shfl(ca1, kk);
            a0 += w * s0; a1 += w * s1;
        }
        LAS f32x4* red = (LAS f32x4*)lds;
        red[(wave * 2 + 0) * 64 + lane] = a0; red[(wave * 2 + 1) * 64 + lane] = a1;
        __syncthreads();
        { const int b = tid >> 8, col = tid & 255; const LAS float* rf = (const LAS float*)lds; float s = 0.f;
#pragma unroll
          for (int w = 0; w < 8; ++w) s += rf[((w * 2 + b) * 64) * 4 + col];
          if (kq == 0) s += A.in[I_BMOD][cg * 256 + col];
          modp[(kq * 2 + b) * NMOD + cg * 256 + col] = s; }
        __syncthreads();
    }
    {
        LAS float* scr = (LAS float*)(lds + wave * 16384);
        const int gw = bid * NWAVES + wave, NGW = G * NWAVES;
        constexpr int I1 = (D / 64) * (IN_COLS / 32), I2 = (D / 64) * (D / 32);
        for (int it = gw; it < I1 + 2 * I2; it += NGW) {
            int r = it;
            if (r < I1) { p0_transpose_item(A.in[I_WIN], D, IN_COLS, (bf16*)(A.ws + WS_BT1), scr, r, lane); continue; } r -= I1;
            if (r < I2) { p0_transpose_item(A.in[I_WOUT], D, D, (bf16*)(A.ws + WS_BT2), scr, r, lane); continue; } r -= I2;
            p0_transpose_item(A.in[I_WQ], D, D, (bf16*)(A.ws + WS_BT3), scr, r, lane);
        }
    }
    {
        const int gt = bid * NTHR + tid, ngt = G * NTHR;
        bf16* wg = (bf16*)(A.ws + WS_WG);
        for (int e = gt; e < NH * 256 * 128; e += ngt) {
            const int h = e >> 15, n = (e >> 7) & 255, k = e & 127;
            const float v = (n < 128 ? A.in[I_WA] : A.in[I_WX])[h * 16384 + k * 128 + (n & 127)];
            wg[e] = (bf16)f2bf(v);
        }
        cvt_rows_bf16(A.in[I_SUBK], (bf16*)(A.ws + WS_SUBK), (size_t)NH * 2 * NKEY * 128 / 8, gt, ngt);
    }
}

__device__ __forceinline__ void phase_p1(const Args& A, int tid, int lane, int wave, int bid, int G) {
    const float* modp = (const float*)(A.ws + WS_MODP);
    {
        float* cfin = (float*)(A.ws + WS_CFIN);
        for (int e = bid * NTHR + tid; e < 2 * 2 * D; e += G * NTHR) {
            const int b = e >> 12, arr = (e >> 11) & 1, col = e & (D - 1);
            cfin[e] = arr == 0 ? mod_at(modp, b, 2 * D + col) * A.in[I_GPOSTMIX][col] : mod_at(modp, b, 5 * D + col) * A.in[I_GPOSTFFN][col];
        }
    }
    const int gw = bid * NWAVES + wave, NGW = G * NWAVES;
    bf16* h1 = (bf16*)(A.ws + WS_RA);
    int cb = -1; float gs[4][8], sh[4][8];
    for (int row = gw; row < T; row += NGW) {
        const int b = row >> 13;
        if (b != cb) { cb = b;
#pragma unroll
            for (int j = 0; j < 4; ++j)
#pragma unroll
                for (int e = 0; e < 8; ++e) { const int col = j * 512 + lane * 8 + e;
                    gs[j][e] = A.in[I_GPREMIX][col] * (1.0f + mod_at(modp, b, D + col)); sh[j][e] = mod_at(modp, b, col); } }
        const GAS f32x4* xr = (const GAS f32x4*)(A.in[I_X] + (size_t)row * D) + lane * 2;
        f32x4 v[4][2]; float s = 0.f;
#pragma unroll
        for (int j = 0; j < 4; ++j) { v[j][0] = xr[j * 128]; v[j][1] = xr[j * 128 + 1];
            s += (v[j][0].x * v[j][0].x + v[j][0].y * v[j][0].y) + (v[j][0].z * v[j][0].z + v[j][0].w * v[j][0].w);
            s += (v[j][1].x * v[j][1].x + v[j][1].y * v[j][1].y) + (v[j][1].z * v[j][1].z + v[j][1].w * v[j][1].w); }
        const float rstd = __builtin_amdgcn_rsqf(wave_sum(s) * (1.0f / D) + EPS);
        GAS v4u* orow = (GAS v4u*)(h1 + (size_t)row * D) + lane;
#pragma unroll
        for (int j = 0; j < 4; ++j) { float o[8];
#pragma unroll
            for (int e = 0; e < 8; ++e) o[e] = v[j][e >> 2][e & 3] * rstd * gs[j][e] + sh[j][e];
            v4u w; w.x = pk2(o[0], o[1]); w.y = pk2(o[2], o[3]); w.z = pk2(o[4], o[5]); w.w = pk2(o[6], o[7]);
            orow[j * 64] = w; }
    }
}

__device__ __forceinline__ void m1a_tile_issue(const bf16* proj, int item, int tid, v4u (&rv)[5], v4u (&rg)[5]) {
    const int b = item >> 9, tt = (item >> 3) & 63, ct = item & 7, t0 = tt * 128;
#pragma unroll
    for (int i = 0; i < 5; ++i) {
        const int e = tid + i * NTHR, r = e >> 4, c8 = (e & 15) * 8, t = t0 - 30 + r;
        rv[i] = (v4u){0u, 0u, 0u, 0u}; rg[i] = (v4u){0u, 0u, 0u, 0u};
        if (e < 158 * 16 && t >= 0) { const bf16* p = proj + (size_t)(b * SEQ + t) * IN_COLS + 2048 + ct * 128 + c8; rv[i] = *(const GAS v4u*)p; rg[i] = *(const GAS v4u*)(p + 1024); }
    }
}
__device__ __forceinline__ void phase_m1a(const Args& A, LAS unsigned char* lds, int tid, int lane, int wave, int bid, int G) {
    const bf16* proj = (const bf16*)(A.ws + WS_PROJ);
    {
        bf16* xl = (bf16*)(A.ws + WS_XL);
        const float* w4 = A.in[I_LCW]; const float* b4 = A.in[I_LCB];
        for (int it = bid * NTHR + tid; it < (T / 16) * 128; it += G * NTHR) {
            const int c0 = (it & 127) * 8, run = it >> 7, row0 = run * 16, t0 = row0 & (SEQ - 1);
            v4u in[19];
#pragma unroll
            for (int r = 0; r < 19; ++r) { in[r] = (v4u){0u, 0u, 0u, 0u}; if (t0 - 3 + r >= 0) in[r] = *(const GAS v4u*)(proj + (size_t)(row0 - 3 + r) * IN_COLS + c0); }
            float w[4][8], bb[8];
#pragma unroll
            for (int j = 0; j < 4; ++j) { const f32x4 wa = *(const GAS f32x4*)(w4 + j * LRU_W + c0), wb = *(const GAS f32x4*)(w4 + j * LRU_W + c0 + 4);
                w[j][0] = wa.x; w[j][1] = wa.y; w[j][2] = wa.z; w[j][3] = wa.w; w[j][4] = wb.x; w[j][5] = wb.y; w[j][6] = wb.z; w[j][7] = wb.w; }
            { const f32x4 ba = *(const GAS f32x4*)(b4 + c0), bc = *(const GAS f32x4*)(b4 + c0 + 4); bb[0] = ba.x; bb[1] = ba.y; bb[2] = ba.z; bb[3] = ba.w; bb[4] = bc.x; bb[5] = bc.y; bb[6] = bc.z; bb[7] = bc.w; }
#pragma unroll
            for (int i = 0; i < 16; ++i) { float acc[8];
#pragma unroll
                for (int e = 0; e < 8; ++e) acc[e] = bb[e];
#pragma unroll
                for (int j = 0; j < 4; ++j) { const v4u v = in[i + j];
                    acc[0] += w[j][0] * bflo(v.x); acc[1] += w[j][1] * bfhi(v.x); acc[2] += w[j][2] * bflo(v.y); acc[3] += w[j][3] * bfhi(v.y);
                    acc[4] += w[j][4] * bflo(v.z); acc[5] += w[j][5] * bfhi(v.z); acc[6] += w[j][6] * bflo(v.w); acc[7] += w[j][7] * bfhi(v.w); }
                v4u o; o.x = pk2(acc[0], acc[1]); o.y = pk2(acc[2], acc[3]); o.z = pk2(acc[4], acc[5]); o.w = pk2(acc[6], acc[7]);
                *(GAS v4u*)(xl + (size_t)(row0 + i) * LRU_W + c0) = o; }
        }
    }
    {
        bf16* zc = (bf16*)(A.ws + WS_ZC);
        const float* w31 = A.in[I_CDW]; const float* b31 = A.in[I_CDB];
        LAS float* zt = (LAS float*)lds;
        const int cp = tid & 63, tg = tid >> 6;
        v4u rv[5], rg[5];
        int item = bid;
        if (item < 2 * 64 * 8) m1a_tile_issue(proj, item, tid, rv, rg);
        float w0[CONF_K], w1[CONF_K], bias0 = 0.f, bias1 = 0.f; int wct = -1;
        for (; item < 2 * 64 * 8; item += G) {
            const int b = item >> 9, tt = (item >> 3) & 63, ct = item & 7, t0 = tt * 128, ch = ct * 128 + 2 * cp;
            if (ct != wct) { wct = ct;
#pragma unroll
                for (int j = 0; j < CONF_K; ++j) { const f32x2 ww = *(const GAS f32x2*)(w31 + j * CONF_W + ch); w0[j] = ww.x; w1[j] = ww.y; }
                const f32x2 bw = *(const GAS f32x2*)(b31 + ch); bias0 = bw.x; bias1 = bw.y; }
            __syncthreads();
#pragma unroll
            for (int i = 0; i < 5; ++i) {
                const int e = tid + i * NTHR, r = e >> 4, c8 = (e & 15) * 8;
                if (e < 158 * 16) { const v4u v = rv[i], g = rg[i]; f32x4 z0, z1;
                    z0.x = bflo(v.x) * sigmoidf_(bflo(g.x)); z0.y = bfhi(v.x) * sigmoidf_(bfhi(g.x)); z0.z = bflo(v.y) * sigmoidf_(bflo(g.y)); z0.w = bfhi(v.y) * sigmoidf_(bfhi(g.y));
                    z1.x = bflo(v.z) * sigmoidf_(bflo(g.z)); z1.y = bfhi(v.z) * sigmoidf_(bfhi(g.z)); z1.z = bflo(v.w) * sigmoidf_(bflo(g.w)); z1.w = bfhi(v.w) * sigmoidf_(bfhi(g.w));
                    *(LAS f32x4*)(zt + r * 128 + c8) = z0; *(LAS f32x4*)(zt + r * 128 + c8 + 4) = z1; }
            }
            __syncthreads();
            if (item + G < 2 * 64 * 8) m1a_tile_issue(proj, item + G, tid, rv, rg);
            float a0[16], a1[16];
#pragma unroll
            for (int i = 0; i < 16; ++i) { a0[i] = bias0; a1[i] = bias1; }
#pragma unroll
            for (int s_ = 0; s_ < 46; ++s_) {
                const f32x2 v = *(const LAS f32x2*)(zt + (tg * 16 + s_) * 128 + 2 * cp);
#pragma unroll
                for (int i = 0; i < 16; ++i) if (s_ - i >= 0 && s_ - i < CONF_K) { a0[i] += w0[s_ - i] * v.x; a1[i] += w1[s_ - i] * v.y; }
            }
            bf16* zo = zc + (size_t)(b * SEQ + t0 + tg * 16) * CONF_W + ch;
#pragma unroll
            for (int i = 0; i < 16; ++i) *(GAS unsigned*)(zo + (size_t)i * CONF_W) = pk2(a0[i], a1[i]);
        }
        __syncthreads();
    }
}

__device__ __forceinline__ void phase_m1b(const Args& A, int tid, int lane, int wave, int bid, int G) {
    const bf16* xl = (const bf16*)(A.ws + WS_XL); const bf16* wg = (const bf16*)(A.ws + WS_WG);
    bf16* hloc = (bf16*)(A.ws + WS_HLOC); bf16* pc = (bf16*)(A.ws + WS_PC); float* agg = (float*)(A.ws + WS_AGG);
    const int fr = lane & 15, fq = lane >> 4;
    for (int item = bid * NWAVES + wave; item < 2 * NCHUNK * 8; item += G * NWAVES) {
        const int hh = item & 7, chunk = (item >> 3) & (NCHUNK - 1), b = item >> 10;
        const size_t r0 = (size_t)b * SEQ + (size_t)chunk * CHUNK;
        bf16x8 xf[4][4];
#pragma unroll
        for (int mt = 0; mt < 4; ++mt)
#pragma unroll
            for (int ks = 0; ks < 4; ++ks) xf[mt][ks] = *(const GAS bf16x8*)(xl + (r0 + 16 * mt + fr) * LRU_W + hh * LRU_HD + 32 * ks + 8 * fq);
        float cP[4], cH[4];
        for (int j = 0; j < 8; ++j) {
            const int chb = hh * LRU_HD + 16 * j + 4 * fq;
            bf16x8 wa[4], wx[4];
#pragma unroll
            for (int ks = 0; ks < 4; ++ks) { wa[ks] = *(const GAS bf16x8*)(wg + (size_t)(hh * 256 + 16 * j + fr) * 128 + 32 * ks + 8 * fq);
                                             wx[ks] = *(const GAS bf16x8*)(wg + (size_t)(hh * 256 + 128 + 16 * j + fr) * 128 + 32 * ks + 8 * fq); }
            const f32x4 bav = *(const GAS f32x4*)(A.in[I_BA] + chb), bxv = *(const GAS f32x4*)(A.in[I_BX] + chb), lam = *(const GAS f32x4*)(A.in[I_LAMBDA] + chb);
            float cl[4];
#pragma unroll
            for (int r = 0; r < 4; ++r) { cl[r] = -8.0f * log1pf(__expf(-lam[r])); cP[r] = 1.f; cH[r] = 0.f; }
#pragma unroll
            for (int mt = 0; mt < 4; ++mt) {
                f32x4 ar = {0.f, 0.f, 0.f, 0.f}, ai = {0.f, 0.f, 0.f, 0.f};
#pragma unroll
                for (int ks = 0; ks < 4; ++ks) { ar = __builtin_amdgcn_mfma_f32_16x16x32_bf16(wa[ks], xf[mt][ks], ar, 0, 0, 0);
                                                 ai = __builtin_amdgcn_mfma_f32_16x16x32_bf16(wx[ks], xf[mt][ks], ai, 0, 0, 0); }
                const v2u xv = *(const GAS v2u*)(xl + (r0 + 16 * mt + fr) * LRU_W + chb);
                const float xlv[4] = {bflo(xv.x), bfhi(xv.x), bflo(xv.y), bfhi(xv.y)};
                float P[4], H[4];
#pragma unroll
                for (int r = 0; r < 4; ++r) {
                    const float rg = sigmoidf_(ar[r] + bav[r]), ig = sigmoidf_(ai[r] + bxv[r]);
                    const float la = cl[r] * rg, a = __expf(la), mult = sqrtf(fmaxf(1.0f - __expf(2.0f * la), 0.f));
                    float p = a, h = mult * ig * xlv[r];
#pragma unroll
                    for (int s = 1; s < 16; s <<= 1) { const float pp = __shfl_up(p, s, 16), hp = __shfl_up(h, s, 16);
                        if (fr >= s) { h = p * hp + h; p = p * pp; } }
                    h = h + p * cH[r]; p = p * cP[r];
                    P[r] = p; H[r] = h;
                    cP[r] = __shfl(p, 15, 16); cH[r] = __shfl(h, 15, 16);
                }
                v2u ho, po; ho.x = pk2(H[0], H[1]); ho.y = pk2(H[2], H[3]); po.x = pk2(P[0], P[1]); po.y = pk2(P[2], P[3]);
                *(GAS v2u*)(hloc + (r0 + 16 * mt + fr) * LRU_W + chb) = ho;
                *(GAS v2u*)(pc + (r0 + 16 * mt + fr) * LRU_W + chb) = po;
            }
            if (fr == 0) {
                float* ag = agg + ((size_t)(b * NCHUNK + chunk) * LRU_W + chb) * 2;
                *(GAS f32x4*)ag = (f32x4){cP[0], cH[0], cP[1], cH[1]}; *(GAS f32x4*)(ag + 4) = (f32x4){cP[2], cH[2], cP[3], cH[3]};
            }
        }
    }
}

__device__ __forceinline__ void phase_m3(const Args& A, LAS unsigned char* lds, int tid, int lane, int wave, int bid, int G) {
    const bf16* proj = (const bf16*)(A.ws + WS_PROJ); const bf16* hloc = (const bf16*)(A.ws + WS_HLOC); const bf16* pc = (const bf16*)(A.ws + WS_PC);
    const bf16* zc = (const bf16*)(A.ws + WS_ZC); const float* agg = (const float*)(A.ws + WS_AGG);
    bf16* a2 = (bf16*)(A.ws + WS_RA);
    LAS float* cs = (LAS float*)lds;
    float lg[2][8], lb[2][8];
#pragma unroll
    for (int jj = 0; jj < 2; ++jj)
#pragma unroll
        for (int e = 0; e < 8; ++e) { lg[jj][e] = A.in[I_LNG][jj * 512 + lane * 8 + e]; lb[jj][e] = A.in[I_LNB][jj * 512 + lane * 8 + e]; }
    for (int item = bid; item < 2 * NCHUNK; item += G) {
        const int b = item >> 7, chunk = item & (NCHUNK - 1);
        {   float h0 = 0.f, h1 = 0.f; const float* ap = agg + ((size_t)(b * NCHUNK) * LRU_W + 2 * tid) * 2;
#pragma unroll 8
            for (int c = 0; c < chunk; ++c) { const f32x4 ab = *(const GAS f32x4*)(ap + (size_t)c * LRU_W * 2); h0 = ab.x * h0 + ab.y; h1 = ab.z * h1 + ab.w; }
            __syncthreads();
            cs[2 * tid] = h0; cs[2 * tid + 1] = h1;
            __syncthreads(); }
        for (int rr = 0; rr < 8; ++rr) {
            const int row = b * SEQ + chunk * CHUNK + wave * 8 + rr;
            float zv[2][8]; float s = 0.f;
#pragma unroll
            for (int jj = 0; jj < 2; ++jj) {
                const int c0 = jj * 512 + lane * 8;
                const v4u hv = *(const GAS v4u*)(hloc + (size_t)row * LRU_W + c0), pv = *(const GAS v4u*)(pc + (size_t)row * LRU_W + c0);
                const v4u gv = *(const GAS v4u*)(proj + (size_t)row * IN_COLS + 1024 + c0);
                const f32x4 ca = *(const LAS f32x4*)(cs + c0), cb = *(const LAS f32x4*)(cs + c0 + 4);
                float y[8];
                y[0] = (bflo(hv.x) + bflo(pv.x) * ca.x) * gelu_tanh(bflo(gv.x)); y[1] = (bfhi(hv.x) + bfhi(pv.x) * ca.y) * gelu_tanh(bfhi(gv.x));
                y[2] = (bflo(hv.y) + bflo(pv.y) * ca.z) * gelu_tanh(bflo(gv.y)); y[3] = (bfhi(hv.y) + bfhi(pv.y) * ca.w) * gelu_tanh(bfhi(gv.y));
                y[4] = (bflo(hv.z) + bflo(pv.z) * cb.x) * gelu_tanh(bflo(gv.z)); y[5] = (bfhi(hv.z) + bfhi(pv.z) * cb.y) * gelu_tanh(bfhi(gv.z));
                y[6] = (bflo(hv.w) + bflo(pv.w) * cb.z) * gelu_tanh(bflo(gv.w)); y[7] = (bfhi(hv.w) + bfhi(pv.w) * cb.w) * gelu_tanh(bfhi(gv.w));
                v4u o; o.x = pk2(y[0], y[1]); o.y = pk2(y[2], y[3]); o.z = pk2(y[4], y[5]); o.w = pk2(y[6], y[7]);
                *(GAS v4u*)(a2 + (size_t)row * D + c0) = o;
                const v4u z = *(const GAS v4u*)(zc + (size_t)row * CONF_W + c0);
                zv[jj][0] = bflo(z.x); zv[jj][1] = bfhi(z.x); zv[jj][2] = bflo(z.y); zv[jj][3] = bfhi(z.y); zv[jj][4] = bflo(z.z); zv[jj][5] = bfhi(z.z); zv[jj][6] = bflo(z.w); zv[jj][7] = bfhi(z.w);
#pragma unroll
                for (int e = 0; e < 8; ++e) s += zv[jj][e];
            }
            const float mean = wave_sum(s) * (1.0f / CONF_W); float q = 0.f;
#pragma unroll
            for (int jj = 0; jj < 2; ++jj)
#pragma unroll
                for (int e = 0; e < 8; ++e) { zv[jj][e] -= mean; q += zv[jj][e] * zv[jj][e]; }
            const float rstd = __builtin_amdgcn_rsqf(wave_sum(q) * (1.0f / CONF_W) + EPS);
#pragma unroll
            for (int jj = 0; jj < 2; ++jj) { float o[8];
#pragma unroll
                for (int e = 0; e < 8; ++e) { const float n = zv[jj][e] * rstd * lg[jj][e] + lb[jj][e]; o[e] = n * sigmoidf_(n); }
                v4u w; w.x = pk2(o[0], o[1]); w.y = pk2(o[2], o[3]); w.z = pk2(o[4], o[5]); w.w = pk2(o[6], o[7]);
                *(GAS v4u*)(a2 + (size_t)row * D + 1024 + jj * 512 + lane * 8) = w; }
        }
    }
}

__device__ __forceinline__ float dpp_sum63(float v) {
    v += __builtin_bit_cast(float, __builtin_amdgcn_update_dpp(0, __builtin_bit_cast(int, v), 0xB1, 0xF, 0xF, false));
    v += __builtin_bit_cast(float, __builtin_amdgcn_update_dpp(0, __builtin_bit_cast(int, v), 0x4E, 0xF, 0xF, false));
    v += __builtin_bit_cast(float, __builtin_amdgcn_update_dpp(0, __builtin_bit_cast(int, v), 0x141, 0xF, 0xF, false));
    v += __builtin_bit_cast(float, __builtin_amdgcn_update_dpp(0, __builtin_bit_cast(int, v), 0x140, 0xF, 0xF, false));
    v += __builtin_bit_cast(float, __builtin_amdgcn_update_dpp(0, __builtin_bit_cast(int, v), 0x142, 0xA, 0xF, false));
    v += __builtin_bit_cast(float, __builtin_amdgcn_update_dpp(0, __builtin_bit_cast(int, v), 0x143, 0xC, 0xF, false));
    return v;
}
__device__ __forceinline__ float wave_total(float v) { return rdlane(dpp_sum63(v), 63); }
__device__ __forceinline__ f32x2 fp8lo(unsigned w) { return __builtin_amdgcn_cvt_pk_f32_fp8((int)w, false); }
__device__ __forceinline__ f32x2 fp8hi(unsigned w) { return __builtin_amdgcn_cvt_pk_f32_fp8((int)w, true); }
constexpr int CVT_ROWS = 4;
__device__ __forceinline__ void cvt_table_fp8(const float* src, unsigned char* dst, float* inv_scale, int gw, int NGW, int lane) {
    for (int r0 = gw; r0 < NEXP; r0 += NGW * CVT_ROWS) {
        f32x4 v[CVT_ROWS][8];
#pragma unroll
        for (int q = 0; q < CVT_ROWS; ++q) { const int r = r0 + q * NGW; const GAS f32x4* p = (const GAS f32x4*)(src + (size_t)(r < NEXP ? r : r0) * D) + lane;
#pragma unroll
            for (int i = 0; i < 8; ++i) v[q][i] = p[i * 64]; }
#pragma unroll
        for (int q = 0; q < CVT_ROWS; ++q) { const int r = r0 + q * NGW; float m = 0.f;
#pragma unroll
            for (int i = 0; i < 8; ++i) m = fmaxf(m, fmaxf(fmaxf(fabsf(v[q][i].x), fabsf(v[q][i].y)), fmaxf(fabsf(v[q][i].z), fabsf(v[q][i].w))));
#pragma unroll
            for (int o = 1; o < 64; o <<= 1) m = fmaxf(m, __shfl_xor(m, o));
            const float sc = m > 0.f ? 448.0f / m : 1.0f;
            if (r < NEXP) {
                GAS unsigned* o4 = (GAS unsigned*)(dst + (size_t)r * D) + lane;
#pragma unroll
                for (int i = 0; i < 8; ++i) { const f32x4 t = v[q][i] * sc;
                    const float a = fminf(fmaxf(t.x, -448.f), 448.f), b = fminf(fmaxf(t.y, -448.f), 448.f), c = fminf(fmaxf(t.z, -448.f), 448.f), d = fminf(fmaxf(t.w, -448.f), 448.f);
                    int pk = __builtin_amdgcn_cvt_pk_fp8_f32(a, b, 0, false); pk = __builtin_amdgcn_cvt_pk_fp8_f32(c, d, pk, true); o4[i * 64] = (unsigned)pk; }
                if (lane == 0) inv_scale[r] = m > 0.f ? m * (1.0f / 448.0f) : 1.0f;
            }
        }
    }
}
__device__ __forceinline__ void phase_e2(const Args& A, int tid, int lane, int wave, int bid, int G) {
    const float* modp = (const float*)(A.ws + WS_MODP); const float* cfin = (const float*)(A.ws + WS_CFIN);
    const bf16* y1 = (const bf16*)(A.ws + WS_Y1); bf16* h2 = (bf16*)(A.ws + WS_RA);
    const int gw = bid * NWAVES + wave, NGW = G * NWAVES;
    int cb = -1; float gs[4][8], sh[4][8];
    for (int row = gw; row < T; row += NGW) {
        const int b = row >> 13;
        if (b != cb) { cb = b;
#pragma unroll
            for (int j = 0; j < 4; ++j)
#pragma unroll
                for (int e = 0; e < 8; ++e) { const int col = j * 512 + lane * 8 + e;
                    gs[j][e] = A.in[I_GPREFFN][col] * (1.0f + mod_at(modp, b, 4 * D + col)); sh[j][e] = mod_at(modp, b, 3 * D + col); } }
        const GAS f32x4* xr = (const GAS f32x4*)(A.in[I_X] + (size_t)row * D) + lane * 2;
        const GAS v4u* yr = (const GAS v4u*)(y1 + (size_t)row * D) + lane;
        const GAS f32x4* cf = (const GAS f32x4*)(cfin + (size_t)(b * 2 + 0) * D) + lane * 2;
        float xv[4][8], yv[4][8]; float s1 = 0.f;
#pragma unroll
        for (int j = 0; j < 4; ++j) { const f32x4 a = xr[j * 128], c = xr[j * 128 + 1]; const v4u y = yr[j * 64];
            xv[j][0] = a.x; xv[j][1] = a.y; xv[j][2] = a.z; xv[j][3] = a.w; xv[j][4] = c.x; xv[j][5] = c.y; xv[j][6] = c.z; xv[j][7] = c.w;
            yv[j][0] = bflo(y.x); yv[j][1] = bfhi(y.x); yv[j][2] = bflo(y.y); yv[j][3] = bfhi(y.y); yv[j][4] = bflo(y.z); yv[j][5] = bfhi(y.z); yv[j][6] = bflo(y.w); yv[j][7] = bfhi(y.w);
#pragma unroll
            for (int e = 0; e < 8; ++e) s1 += yv[j][e] * yv[j][e]; }
        const float rstd1 = __builtin_amdgcn_rsqf(wave_sum(s1) * (1.0f / D) + EPS); float s2 = 0.f;
#pragma unroll
        for (int j = 0; j < 4; ++j) { const f32x4 ca = cf[j * 128], cc = cf[j * 128 + 1]; const float cg[8] = {ca.x, ca.y, ca.z, ca.w, cc.x, cc.y, cc.z, cc.w};
#pragma unroll
            for (int e = 0; e < 8; ++e) { xv[j][e] += cg[e] * yv[j][e] * rstd1; s2 += xv[j][e] * xv[j][e]; } }
        const float rstd2 = __builtin_amdgcn_rsqf(wave_sum(s2) * (1.0f / D) + EPS);
        GAS v4u* orow = (GAS v4u*)(h2 + (size_t)row * D) + lane;
#pragma unroll
        for (int j = 0; j < 4; ++j) { float o[8];
#pragma unroll
            for (int e = 0; e < 8; ++e) o[e] = xv[j][e] * rstd2 * gs[j][e] + sh[j][e];
            v4u w; w.x = pk2(o[0], o[1]); w.y = pk2(o[2], o[3]); w.z = pk2(o[4], o[5]); w.w = pk2(o[6], o[7]);
            orow[j * 64] = w; }
    }
    if (!S_CONV) { cvt_table_fp8(A.in[I_PU], A.ws + WS_UB, (float*)(A.ws + WS_USC), gw, NGW, lane); cvt_table_fp8(A.in[I_PV], A.ws + WS_VB, (float*)(A.ws + WS_VSC), gw, NGW, lane); }
}

template <int N> __device__ __forceinline__ void bitonic_sort_desc(float (&v)[N]) {
#pragma unroll
    for (int k = 2; k <= N; k <<= 1)
#pragma unroll
        for (int j = k >> 1; j > 0; j >>= 1)
#pragma unroll
            for (int i = 0; i < N; ++i) { const int l = i ^ j;
                if (l > i) { const bool desc = ((i & k) == 0); const float a = v[i], b = v[l]; const float mx = fmaxf(a, b), mn = fminf(a, b); v[i] = desc ? mx : mn; v[l] = desc ? mn : mx; } }
}
__device__ __forceinline__ void merge_top16(float (&a)[16], const float (&b)[16]) {
#pragma unroll
    for (int i = 0; i < 16; ++i) a[i] = fmaxf(a[i], b[15 - i]);
#pragma unroll
    for (int j = 8; j > 0; j >>= 1)
#pragma unroll
        for (int i = 0; i < 16; ++i) { const int l = i ^ j; if (l > i) { const float x = a[i], y = a[l]; a[i] = fmaxf(x, y); a[l] = fminf(x, y); } }
}
__device__ __forceinline__ void top16_of_64(float (&v)[64], float (&out)[16]) {
    float g[4][16];
#pragma unroll
    for (int q = 0; q < 4; ++q) {
#pragma unroll
        for (int i = 0; i < 16; ++i) g[q][i] = v[q * 16 + i];
        bitonic_sort_desc<16>(g[q]); }
    merge_top16(g[0], g[1]); merge_top16(g[2], g[3]); merge_top16(g[0], g[2]);
#pragma unroll
    for (int i = 0; i < 16; ++i) out[i] = g[0][i];
}
__device__ __forceinline__ float pack_key(float v, unsigned key, unsigned mask) { return __builtin_bit_cast(float, (__builtin_bit_cast(unsigned, v) & ~mask) | key); }
constexpr int SK_PITCH = 272;
__device__ __forceinline__ void score_top16(const bf16* q, const LAS unsigned char* skl, int tok, int h, int p, int l31, int hf, float (&out)[16]) {
    f32x16 acc[4];
#pragma unroll
    for (int kt = 0; kt < 4; ++kt)
#pragma unroll
        for (int r = 0; r < 16; ++r) acc[kt][r] = 0.f;
    bf16x8 bq[8];
#pragma unroll
    for (int ks = 0; ks < 8; ++ks) bq[ks] = *(const GAS bf16x8*)(q + (size_t)tok * D + h * 256 + p * 128 + 16 * ks + 8 * hf);
#pragma unroll
    for (int ks = 0; ks < 8; ++ks) {
#pragma unroll
        for (int kt = 0; kt < 4; ++kt) {
            const bf16x8 ak = *(const LAS bf16x8*)(skl + (p * NKEY + 32 * kt + l31) * SK_PITCH + (16 * ks + 8 * hf) * 2);
            acc[kt] = __builtin_amdgcn_mfma_f32_32x32x16_bf16(ak, bq[ks], acc[kt], 0, 0, 0);
        }
    }
    float v[64];
#pragma unroll
    for (int kt = 0; kt < 4; ++kt)
#pragma unroll
        for (int r = 0; r < 16; ++r) v[kt * 16 + r] = pack_key(acc[kt][r], (unsigned)(32 * kt + (r & 3) + 8 * (r >> 2) + 4 * hf), 0x7Fu);
    float other[16];
    top16_of_64(v, out);
#pragma unroll
    for (int i = 0; i < 16; ++i) other[i] = __shfl_xor(out[i], 32);
    merge_top16(out, other);
}
__device__ __forceinline__ void s_convert_tables(const Args& A, int gw, int NGW, int lane) {
    cvt_table_fp8(A.in[I_PU], A.ws + WS_UB, (float*)(A.ws + WS_USC), gw, NGW, lane);
    cvt_table_fp8(A.in[I_PV], A.ws + WS_VB, (float*)(A.ws + WS_VSC), gw, NGW, lane);
}
__device__ __forceinline__ void phase_s(const Args& A, LAS unsigned char* lds, int tid, int lane, int wave, int bid, int G) {
    const bf16* q = (const bf16*)(A.ws + WS_Q); const bf16* sk = (const bf16*)(A.ws + WS_SUBK);
    int* idx = (int*)(A.ws + WS_IDX); float* gate = (float*)(A.ws + WS_GATE);
    const int l31 = lane & 31, hf = lane >> 5;
    bool conv_done = false;
    for (int wi = bid; wi < (T / 512) * NH; wi += G) {
      const int h = wi & 7, tg = wi >> 3;
      __syncthreads();
#pragma unroll
      for (int i = 0; i < 8; ++i) { const int c = tid + i * NTHR, row = c >> 4, c16 = c & 15;
          *(LAS v4u*)(lds + row * SK_PITCH + c16 * 16) = *(const GAS v4u*)(sk + ((size_t)(h * 2 * NKEY + row)) * 128 + c16 * 8); }
      __syncthreads();
      if (S_CONV && wave >= 4 && !conv_done) s_convert_tables(A, bid * NWAVES + wave, G * NWAVES, lane);
      for (int ti = 0; ti < 2; ++ti) {
        const int tok = (tg * 16 + ti * 8 + wave) * 32 + l31;
        float s1[16], s2[16];
        score_top16(q, lds, tok, h, 0, l31, hf, s1);
        score_top16(q, lds, tok, h, 1, l31, hf, s2);
        float cv[64]; int n = 0;
#pragma unroll
        for (int i = 0; i < 16; ++i)
#pragma unroll
            for (int j = 0; j < 16; ++j)
                if ((i + 1) * (j + 1) <= 16) {
                    const float a = __builtin_bit_cast(float, __builtin_bit_cast(unsigned, s1[i]) & ~0x7Fu), c = __builtin_bit_cast(float, __builtin_bit_cast(unsigned, s2[j]) & ~0x7Fu);
                    cv[n++] = pack_key(a + c, (unsigned)(i * 16 + j), 0xFFu); }
#pragma unroll
        for (int m = 50; m < 64; ++m) cv[m] = -INFINITY;
        float c16[16];
        top16_of_64(cv, c16);
        float ev[16], esum = 0.f; const float cmax = __builtin_bit_cast(float, __builtin_bit_cast(unsigned, c16[0]) & ~0xFFu);
#pragma unroll
        for (int m = 0; m < 16; ++m) { ev[m] = __expf(__builtin_bit_cast(float, __builtin_bit_cast(unsigned, c16[m]) & ~0xFFu) - cmax); esum += ev[m]; }
        const float rs = 1.0f / esum;
        int oi[8]; float og[8];
#pragma unroll
        for (int mm = 0; mm < 8; ++mm) {
            float c_lo = c16[mm], c_hi = c16[8 + mm], e_lo = ev[mm], e_hi = ev[8 + mm];
            asm volatile("" : "+v"(c_lo), "+v"(c_hi), "+v"(e_lo), "+v"(e_hi));
            const unsigned cb = __builtin_bit_cast(unsigned, hf ? c_hi : c_lo); const int ii = (cb >> 4) & 15, jj = cb & 15;
            int row = 0, col = 0;
#pragma unroll
            for (int k = 0; k < 16; ++k) { row = (ii == k) ? (int)(__builtin_bit_cast(unsigned, s1[k]) & 0x7Fu) : row; col = (jj == k) ? (int)(__builtin_bit_cast(unsigned, s2[k]) & 0x7Fu) : col; }
            oi[mm] = row * NKEY + col; og[mm] = (hf ? e_hi : e_lo) * rs;
        }
        int* ip = idx + (size_t)tok * KSEL + h * 16 + hf * 8; float* gp = gate + (size_t)tok * KSEL + h * 16 + hf * 8;
        *(GAS v4u*)ip = (v4u){(unsigned)oi[0], (unsigned)oi[1], (unsigned)oi[2], (unsigned)oi[3]}; *(GAS v4u*)(ip + 4) = (v4u){(unsigned)oi[4], (unsigned)oi[5], (unsigned)oi[6], (unsigned)oi[7]};
        *(GAS f32x4*)gp = (f32x4){og[0], og[1], og[2], og[3]}; *(GAS f32x4*)(gp + 4) = (f32x4){og[4], og[5], og[6], og[7]};
      }
      if (S_CONV && wave < 4 && !conv_done) s_convert_tables(A, bid * NWAVES + wave, G * NWAVES, lane);
      conv_done = true;
    }
    if (S_CONV && !conv_done) s_convert_tables(A, bid * NWAVES + wave, G * NWAVES, lane);
    __syncthreads();
}

__device__ __forceinline__ float row_dot_fp8(const v4u d0, const v4u d1, const f32x2 (&hf)[2][8]) {
    const unsigned w0[4] = {d0.x, d0.y, d0.z, d0.w}, w1[4] = {d1.x, d1.y, d1.z, d1.w};
    f32x2 a = {0.f, 0.f}, b = {0.f, 0.f};
#pragma unroll
    for (int i = 0; i < 4; ++i) { a += fp8lo(w0[i]) * hf[0][2 * i]; a += fp8hi(w0[i]) * hf[0][2 * i + 1]; b += fp8lo(w1[i]) * hf[1][2 * i]; b += fp8hi(w1[i]) * hf[1][2 * i + 1]; }
    return (a.x + a.y) + (b.x + b.y);
}
__device__ __forceinline__ void row_axpy_fp8(f32x2 (&acc)[2][8], const v4u d0, const v4u d1, float w) {
    const unsigned w0[4] = {d0.x, d0.y, d0.z, d0.w}, w1[4] = {d1.x, d1.y, d1.z, d1.w};
#pragma unroll
    for (int i = 0; i < 4; ++i) { acc[0][2 * i] += fp8lo(w0[i]) * w; acc[0][2 * i + 1] += fp8hi(w0[i]) * w; acc[1][2 * i] += fp8lo(w1[i]) * w; acc[1][2 * i + 1] += fp8hi(w1[i]) * w; }
}
__device__ __forceinline__ void phase_pe(const Args& A, int tid, int lane, int wave, int bid, int G) {
    const bf16* h2 = (const bf16*)(A.ws + WS_RA); const bf16* y1 = (const bf16*)(A.ws + WS_Y1);
    const unsigned char* ub = A.ws + WS_UB; const unsigned char* vb = A.ws + WS_VB;
    const float* usc = (const float*)(A.ws + WS_USC); const float* vsc = (const float*)(A.ws + WS_VSC);
    const int* idx = (const int*)(A.ws + WS_IDX); const float* gate = (const float*)(A.ws + WS_GATE); const float* cfin = (const float*)(A.ws + WS_CFIN);
    for (int tok = bid * NWAVES + wave; tok < T; tok += G * NWAVES) {
        const int b = tok >> 13;
        f32x2 hf[2][8];
#pragma unroll
        for (int jj = 0; jj < 2; ++jj) { const GAS v4u* hp = (const GAS v4u*)(h2 + (size_t)tok * D + jj * 1024 + lane * 16); const v4u q0 = hp[0], q1 = hp[1];
            const unsigned w[8] = {q0.x, q0.y, q0.z, q0.w, q1.x, q1.y, q1.z, q1.w};
#pragma unroll
            for (int i = 0; i < 8; ++i) hf[jj][i] = (f32x2){bflo(w[i]), bfhi(w[i])}; }
        int id0 = idx[(size_t)tok * KSEL + lane], id1 = idx[(size_t)tok * KSEL + 64 + lane];
        float g0 = gate[(size_t)tok * KSEL + lane], g1 = gate[(size_t)tok * KSEL + 64 + lane];
#if PE_SORT
        {
            unsigned k0 = ((unsigned)id0 << 7) | (unsigned)lane, k1 = ((unsigned)id1 << 7) | (unsigned)(64 + lane);
#pragma unroll
            for (int k = 2; k <= 64; k <<= 1)
#pragma unroll
                for (int j = k >> 1; j > 0; j >>= 1) {
                    const unsigned p0 = __shfl_xor(k0, j), p1 = __shfl_xor(k1, j);
                    const bool lower = (lane & j) == 0, up0 = (lane & k) == 0, up1 = (k == 64) ? false : up0;
                    k0 = (lower == up0) ? min(k0, p0) : max(k0, p0); k1 = (lower == up1) ? min(k1, p1) : max(k1, p1);
                }
            { const unsigned lo = min(k0, k1), hi = max(k0, k1); k0 = lo; k1 = hi; }
#pragma unroll
            for (int j = 32; j > 0; j >>= 1) {
                const unsigned p0 = __shfl_xor(k0, j), p1 = __shfl_xor(k1, j); const bool lower = (lane & j) == 0;
                k0 = lower ? min(k0, p0) : max(k0, p0); k1 = lower ? min(k1, p1) : max(k1, p1);
            }
            const int q0 = k0 & 127, q1 = k1 & 127;
            const float a0 = __shfl(g0, q0 & 63), b0 = __shfl(g1, q0 & 63), a1 = __shfl(g0, q1 & 63), b1 = __shfl(g1, q1 & 63);
            g0 = (q0 & 64) ? b0 : a0; g1 = (q1 & 64) ? b1 : a1; id0 = (int)(k0 >> 7); id1 = (int)(k1 >> 7);
        }
#endif
        const float su0 = usc[id0], su1 = usc[id1], gs0 = g0 * vsc[id0], gs1 = g1 * vsc[id1];
        f32x2 acc[2][8];
#pragma unroll
        for (int jj = 0; jj < 2; ++jj)
#pragma unroll
            for (int i = 0; i < 8; ++i) acc[jj][i] = (f32x2){0.f, 0.f};
        v4u bu[PE_RB][2], bv[PE_RB][2];
#define PE_ISSUE(slot, kk) do { const int kk_ = (kk); const int e_ = __builtin_amdgcn_readlane((kk_ & 64) ? id1 : id0, kk_ & 63); \
            const GAS v4u* up_ = (const GAS v4u*)(ub + (size_t)e_ * D) + lane; const GAS v4u* vp_ = (const GAS v4u*)(vb + (size_t)e_ * D) + lane; \
            bu[slot][0] = up_[0]; bu[slot][1] = up_[64]; bv[slot][0] = vp_[0]; bv[slot][1] = vp_[64]; } while (0)
#pragma unroll
        for (int r = 0; r < PE_RB; ++r) PE_ISSUE(r, r);
        for (int k0 = 0; k0 < KSEL; k0 += PE_RB) {
#pragma unroll
            for (int r = 0; r < PE_RB; ++r) {
                const int k = k0 + r;
                const float suk = rdlane((k & 64) ? su1 : su0, k & 63), gsk = rdlane((k & 64) ? gs1 : gs0, k & 63);
                const float tot = wave_total(row_dot_fp8(bu[r][0], bu[r][1], hf));
                const float w = gsk * gelu_tanh(tot * suk);
                row_axpy_fp8(acc, bv[r][0], bv[r][1], w);
                if (k + PE_RB < KSEL) PE_ISSUE(r, k + PE_RB);
            }
        }
#undef PE_ISSUE
        float s2 = 0.f;
#pragma unroll
        for (int jj = 0; jj < 2; ++jj)
#pragma unroll
            for (int i = 0; i < 8; ++i) s2 += acc[jj][i].x * acc[jj][i].x + acc[jj][i].y * acc[jj][i].y;
        const float rstd2 = __builtin_amdgcn_rsqf(wave_sum(s2) * (1.0f / D) + EPS);
        float yv[2][16]; float s1 = 0.f;
#pragma unroll
        for (int jj = 0; jj < 2; ++jj) { const GAS v4u* yp = (const GAS v4u*)(y1 + (size_t)tok * D + jj * 1024 + lane * 16); const v4u q0 = yp[0], q1 = yp[1];
            const unsigned w[8] = {q0.x, q0.y, q0.z, q0.w, q1.x, q1.y, q1.z, q1.w};
#pragma unroll
            for (int i = 0; i < 8; ++i) { yv[jj][2 * i] = bflo(w[i]); yv[jj][2 * i + 1] = bfhi(w[i]); s1 += yv[jj][2 * i] * yv[jj][2 * i] + yv[jj][2 * i + 1] * yv[jj][2 * i + 1]; } }
        const float rstd1 = __builtin_amdgcn_rsqf(wave_sum(s1) * (1.0f / D) + EPS);
#pragma unroll
        for (int jj = 0; jj < 2; ++jj) {
            const size_t off = (size_t)jj * 256 + lane * 4;
            const GAS f32x4* xr = (const GAS f32x4*)(A.in[I_X] + (size_t)tok * D) + off;
            const GAS f32x4* c1 = (const GAS f32x4*)(cfin + (size_t)(b * 2 + 0) * D) + off; const GAS f32x4* c2 = (const GAS f32x4*)(cfin + (size_t)(b * 2 + 1) * D) + off;
            GAS f32x4* orow = (GAS f32x4*)(A.out + (size_t)tok * D) + off;
#pragma unroll
            for (int q = 0; q < 4; ++q) { const f32x4 xv = xr[q], a1 = c1[q], a2 = c2[q]; f32x4 o;
                const float ya[4] = {acc[jj][2 * q].x, acc[jj][2 * q].y, acc[jj][2 * q + 1].x, acc[jj][2 * q + 1].y};
#pragma unroll
                for (int e = 0; e < 4; ++e) o[e] = xv[e] + (OUT_MODE != 2 ? a1[e] * yv[jj][4 * q + e] * rstd1 : 0.f) + (OUT_MODE != 1 ? a2[e] * ya[e] * rstd2 : 0.f);
                orow[q] = o; }
        }
    }
}

#if defined(MK_CHECKS)
constexpr int CW_CHK = 2048;
__device__ __forceinline__ unsigned hsh(unsigned x) { x ^= x >> 16; x *= 0x7feb352dU; x ^= x >> 15; x *= 0x846ca68bU; x ^= x >> 16; return x; }
__device__ __forceinline__ float bfv(const bf16* p, size_t i) { return __builtin_bit_cast(float, (unsigned)p[i] << 16); }
__device__ __forceinline__ float relerr(float got, float ref, float scale) { const float d = fabsf(got - ref) / (fabsf(ref) + scale); return (d == d) ? d : 1e30f; }
__device__ __forceinline__ void chk_put(unsigned* ctl, int stage, float e) { atomicMax(ctl + CW_CHK + stage, __builtin_bit_cast(unsigned, e)); }
__device__ float chk_gemm(const bf16* Am, const bf16* Bt, const bf16* C, int N, int K, unsigned s) {
    const int row = hsh(s) % T, col = hsh(s * 7 + 1) % N; float acc = 0.f;
    for (int k = 0; k < K; ++k) acc += bfv(Am, (size_t)row * K + k) * bfv(Bt, (size_t)col * K + k);
    return relerr(bfv(C, (size_t)row * N + col), acc, 0.05f);
}
__global__ void __launch_bounds__(128) chk_kernel(Args A, int stage) {
    __shared__ float sh[10240];
    unsigned* ctl = (unsigned*)(A.ws + WS_CTL);
    const int tid = threadIdx.x; const unsigned s = hsh(tid * 2654435761u + stage * 97u + 12345u);
    const float* modp = (const float*)(A.ws + WS_MODP);
    float e = 0.f;
    if (stage == 0) {
        { const int b = s & 1, n = hsh(s) % NMOD; float acc = A.in[I_BMOD][n];
          for (int k = 0; k < D; ++k) { const float c = A.in[I_C][b * D + k]; acc += c / (1.0f + expf(-c)) * A.in[I_WMOD][(size_t)k * NMOD + n]; }
          e = fmaxf(e, relerr(mod_at(modp, b, n), acc, 0.01f)); }
        { const int n = hsh(s + 1) % IN_COLS, k = hsh(s + 2) % D; e = fmaxf(e, relerr(bfv((const bf16*)(A.ws + WS_BT1), (size_t)n * D + k), A.in[I_WIN][(size_t)k * IN_COLS + n], 1e-3f)); }
        { const int n = hsh(s + 3) % D, k = hsh(s + 4) % D; e = fmaxf(e, relerr(bfv((const bf16*)(A.ws + WS_BT2), (size_t)n * D + k), A.in[I_WOUT][(size_t)k * D + n], 1e-3f));
          e = fmaxf(e, relerr(bfv((const bf16*)(A.ws + WS_BT3), (size_t)n * D + k), A.in[I_WQ][(size_t)k * D + n], 1e-3f)); }
        { const int h = s & 7, n = hsh(s + 5) & 255, k = hsh(s + 6) & 127; const float ref = (n < 128 ? A.in[I_WA] : A.in[I_WX])[h * 16384 + k * 128 + (n & 127)];
          e = fmaxf(e, relerr(bfv((const bf16*)(A.ws + WS_WG), (size_t)(h * 256 + n) * 128 + k), ref, 1e-3f)); }
        { const int i = hsh(s + 7) % (NH * 2 * NKEY * 128); e = fmaxf(e, relerr(bfv((const bf16*)(A.ws + WS_SUBK), i), A.in[I_SUBK][i], 1e-3f)); }
    } else if (stage == 1) {
        const int row = hsh(s) % T, col = hsh(s + 1) % D, b = row >> 13; float ss = 0.f;
        for (int k = 0; k < D; ++k) { const float x = A.in[I_X][(size_t)row * D + k]; ss += x * x; }
        const float ref = A.in[I_X][(size_t)row * D + col] * rsqrtf(ss / D + EPS) * A.in[I_GPREMIX][col] * (1.0f + mod_at(modp, b, D + col)) + mod_at(modp, b, col);
        e = relerr(bfv((const bf16*)(A.ws + WS_RA), (size_t)row * D + col), ref, 0.05f);
        const float* cfin = (const float*)(A.ws + WS_CFIN);
        e = fmaxf(e, relerr(cfin[(b * 2 + 0) * D + col], mod_at(modp, b, 2 * D + col) * A.in[I_GPOSTMIX][col], 1e-3f));
        e = fmaxf(e, relerr(cfin[(b * 2 + 1) * D + col], mod_at(modp, b, 5 * D + col) * A.in[I_GPOSTFFN][col], 1e-3f));
    } else if (stage == 2) { e = chk_gemm((const bf16*)(A.ws + WS_RA), (const bf16*)(A.ws + WS_BT1), (const bf16*)(A.ws + WS_PROJ), IN_COLS, D, s);
    } else if (stage == 7) { e = chk_gemm((const bf16*)(A.ws + WS_RA), (const bf16*)(A.ws + WS_BT2), (const bf16*)(A.ws + WS_Y1), D, D, s);
    } else if (stage == 9) { e = chk_gemm((const bf16*)(A.ws + WS_RA), (const bf16*)(A.ws + WS_BT3), (const bf16*)(A.ws + WS_Q), D, D, s);
    } else if (stage == 3) {
        const bf16* proj = (const bf16*)(A.ws + WS_PROJ);
        int row = hsh(s) % T; if (tid < 16) row = (tid & 1) * SEQ + (tid >> 1);
        const int c = hsh(s + 1) % LRU_W, t = row & (SEQ - 1);
        float a = A.in[I_LCB][c];
        for (int j = 0; j < 4; ++j) if (t - 3 + j >= 0) a += A.in[I_LCW][j * LRU_W + c] * bfv(proj, (size_t)(row - 3 + j) * IN_COLS + c);
        e = relerr(bfv((const bf16*)(A.ws + WS_XL), (size_t)row * LRU_W + c), a, 0.05f);
        float z = A.in[I_CDB][c];
        for (int j = 0; j < CONF_K; ++j) if (t - 30 + j >= 0) { const size_t r = (size_t)(row - 30 + j) * IN_COLS; const float g = bfv(proj, r + 3072 + c);
            z += A.in[I_CDW][j * CONF_W + c] * bfv(proj, r + 2048 + c) / (1.0f + expf(-g)); }
        e = fmaxf(e, relerr(bfv((const bf16*)(A.ws + WS_ZC), (size_t)row * CONF_W + c), z, 0.05f));
    } else if (stage == 4) {
        const bf16* xl = (const bf16*)(A.ws + WS_XL);
        const int b = s & 1, chunk = hsh(s + 1) % NCHUNK, ch = hsh(s + 2) % LRU_W, hh = ch >> 7, j = ch & 127;
        const float cl = -8.0f * log1pf(expf(-A.in[I_LAMBDA][ch])); float P = 1.f, H = 0.f;
        for (int t = 0; t < CHUNK; ++t) { const size_t row = (size_t)b * SEQ + chunk * CHUNK + t; float ga = A.in[I_BA][ch], gx = A.in[I_BX][ch];
            for (int i = 0; i < 128; ++i) { const float xv = bfv(xl, row * LRU_W + hh * 128 + i); ga += xv * A.in[I_WA][hh * 16384 + i * 128 + j]; gx += xv * A.in[I_WX][hh * 16384 + i * 128 + j]; }
            const float r = 1.0f / (1.0f + expf(-ga)), ig = 1.0f / (1.0f + expf(-gx)), la = cl * r, a = expf(la), u = sqrtf(fmaxf(-expm1f(2.0f * la), 0.f)) * ig * bfv(xl, row * LRU_W + ch);
            H = a * H + u; P = P * a;
            e = fmaxf(e, relerr(bfv((const bf16*)(A.ws + WS_HLOC), row * LRU_W + ch), H, 0.05f)); e = fmaxf(e, relerr(bfv((const bf16*)(A.ws + WS_PC), row * LRU_W + ch), P, 0.02f)); }
        const float* ag = (const float*)(A.ws + WS_AGG) + ((size_t)(b * NCHUNK + chunk) * LRU_W + ch) * 2;
        e = fmaxf(e, relerr(ag[0], P, 0.02f)); e = fmaxf(e, relerr(ag[1], H, 0.05f));
    } else if (stage == 5) {
        const int b = s & 1, ch = hsh(s + 1) % LRU_W; const float* agg = (const float*)(A.ws + WS_AGG); const float* carry = (const float*)(A.ws + WS_CARRY); float Hs = 0.f;
        for (int c = 0; c < NCHUNK; ++c) { e = fmaxf(e, relerr(carry[(size_t)(b * NCHUNK + c) * LRU_W + ch], Hs, 1e-3f)); const float* ag = agg + ((size_t)(b * NCHUNK + c) * LRU_W + ch) * 2; Hs = ag[0] * Hs + ag[1]; }
    } else if (stage == 6) {
        const bf16* proj = (const bf16*)(A.ws + WS_PROJ); const bf16* zc = (const bf16*)(A.ws + WS_ZC);
        const int row = hsh(s) % T, c = hsh(s + 1) % LRU_W, b = row >> 13, chunk = (row & (SEQ - 1)) >> 6;
        float cin = 0.f; for (int cc = 0; cc < chunk; ++cc) { const float* ag = (const float*)(A.ws + WS_AGG) + ((size_t)(b * NCHUNK + cc) * LRU_W + c) * 2; cin = ag[0] * cin + ag[1]; }
        const float hfull = bfv((const bf16*)(A.ws + WS_HLOC), (size_t)row * LRU_W + c) + bfv((const bf16*)(A.ws + WS_PC), (size_t)row * LRU_W + c) * cin;
        const float g = bfv(proj, (size_t)row * IN_COLS + 1024 + c), ge = 0.5f * g * (1.0f + tanhf(0.7978845608f * (g + 0.044715f * g * g * g)));
        e = relerr(bfv((const bf16*)(A.ws + WS_RA), (size_t)row * D + c), hfull * ge, 0.05f);
        float m = 0.f, q = 0.f;
        for (int k = 0; k < CONF_W; ++k) m += bfv(zc, (size_t)row * CONF_W + k);
        m /= CONF_W;
        for (int k = 0; k < CONF_W; ++k) { const float d = bfv(zc, (size_t)row * CONF_W + k) - m; q += d * d; }
        const float n = (bfv(zc, (size_t)row * CONF_W + c) - m) * rsqrtf(q / CONF_W + EPS) * A.in[I_LNG][c] + A.in[I_LNB][c];
        e = fmaxf(e, relerr(bfv((const bf16*)(A.ws + WS_RA), (size_t)row * D + 1024 + c), n / (1.0f + expf(-n)), 0.05f));
    } else if (stage == 8) {
        const bf16* y1 = (const bf16*)(A.ws + WS_Y1); const float* cfin = (const float*)(A.ws + WS_CFIN);
        const int row = hsh(s) % T, col = hsh(s + 1) % D, b = row >> 13; float s1 = 0.f, s2 = 0.f;
        for (int k = 0; k < D; ++k) { const float y = bfv(y1, (size_t)row * D + k); s1 += y * y; }
        const float r1 = rsqrtf(s1 / D + EPS);
        for (int k = 0; k < D; ++k) { const float x1 = A.in[I_X][(size_t)row * D + k] + cfin[(b * 2) * D + k] * bfv(y1, (size_t)row * D + k) * r1; s2 += x1 * x1; }
        const float x1c = A.in[I_X][(size_t)row * D + col] + cfin[(b * 2) * D + col] * bfv(y1, (size_t)row * D + col) * r1;
        const float ref = x1c * rsqrtf(s2 / D + EPS) * A.in[I_GPREFFN][col] * (1.0f + mod_at(modp, b, 4 * D + col)) + mod_at(modp, b, 3 * D + col);
        e = relerr(bfv((const bf16*)(A.ws + WS_RA), (size_t)row * D + col), ref, 0.05f);
    } else if (stage == 10) {
        { const size_t i = (size_t)(hsh(s + 2) % NEXP) * D + hsh(s + 3) % D;
          const unsigned wu = ((const unsigned*)(A.ws + WS_UB))[i >> 2] >> (8 * (i & 3)), wv = ((const unsigned*)(A.ws + WS_VB))[i >> 2] >> (8 * (i & 3));
          const float du = __builtin_amdgcn_cvt_pk_f32_fp8((int)wu, false)[0] * ((const float*)(A.ws + WS_USC))[i / D], dv = __builtin_amdgcn_cvt_pk_f32_fp8((int)wv, false)[0] * ((const float*)(A.ws + WS_VSC))[i / D];
          e = fmaxf(e, relerr(du, A.in[I_PU][i], 2e-3f) * 0.3f); e = fmaxf(e, relerr(dv, A.in[I_PV][i], 3e-2f) * 0.3f); }
        if (tid < 32) {
            const bf16* q = (const bf16*)(A.ws + WS_Q); const int* idx = (const int*)(A.ws + WS_IDX); const float* gate = (const float*)(A.ws + WS_GATE);
            const int tok = hsh(s) % T, h = hsh(s + 1) & 7;
            float* sc = sh + tid * 320;
            for (int p = 0; p < 2; ++p) for (int n = 0; n < NKEY; ++n) { float a = 0.f;
                for (int d = 0; d < 128; ++d) a += bfv(q, (size_t)tok * D + h * 256 + p * 128 + d) * A.in[I_SUBK][((size_t)((h * 2 + p) * NKEY + n)) * 128 + d];
                sc[p * 128 + n] = a; }
            for (int p = 0; p < 2; ++p) { float prev = 1e30f; for (int it = 0; it < 16; ++it) { float best = -1e30f; int bi = 0;
                for (int n = 0; n < NKEY; ++n) { const float v = sc[p * 128 + n]; if (v < prev && v > best) { best = v; bi = n; } }
                sc[256 + p * 16 + it] = best; sc[288 + p * 16 + it] = (float)bi; prev = best; } }
            float prev = 1e30f, esum = 0.f, cmax = 0.f; int miss = 0; float gerr = 0.f;
            { float pv = 1e30f; for (int it = 0; it < 16; ++it) { float best = -1e30f;
                for (int c = 0; c < 256; ++c) { const float v = sc[256 + (c >> 4)] + sc[272 + (c & 15)]; if (v < pv && v > best) best = v; }
                if (it == 0) cmax = best; esum += expf(best - cmax); pv = best; } }
            for (int it = 0; it < 16; ++it) { float best = -1e30f; int bc = 0;
                for (int c = 0; c < 256; ++c) { const float v = sc[256 + (c >> 4)] + sc[272 + (c & 15)]; if (v < prev && v > best) { best = v; bc = c; } }
                prev = best;
                const int eidx = (int)sc[288 + (bc >> 4)] * NKEY + (int)sc[304 + (bc & 15)]; const float g = expf(best - cmax) / esum; bool found = false;
                for (int m = 0; m < 16; ++m) if (idx[(size_t)tok * KSEL + h * 16 + m] == eidx) { found = true; gerr = fmaxf(gerr, relerr(gate[(size_t)tok * KSEL + h * 16 + m], g, 0.02f)); }
                if (!found) ++miss; }
            e = fmaxf((float)miss / 16.0f, gerr);
        }
    } else if (stage == 11) {
        const bf16* h2 = (const bf16*)(A.ws + WS_RA); const bf16* y1 = (const bf16*)(A.ws + WS_Y1); const int* idx = (const int*)(A.ws + WS_IDX); const float* gate = (const float*)(A.ws + WS_GATE); const float* cfin = (const float*)(A.ws + WS_CFIN);
        const int tok = hsh(blockIdx.x * 977u + 5u) % T, b = tok >> 13;
        { const int ex = idx[(size_t)tok * KSEL + tid]; float a = 0.f;
          if ((unsigned)ex < (unsigned)NEXP) { for (int d = 0; d < D; ++d) a += bfv(h2, (size_t)tok * D + d) * A.in[I_PU][(size_t)ex * D + d]; } else a = 1e30f;
          const float ge = 0.5f * a * (1.0f + tanhf(0.7978845608f * (a + 0.044715f * a * a * a)));
          sh[tid] = gate[(size_t)tok * KSEL + tid] * ge; sh[128 + tid] = __builtin_bit_cast(float, ex); }
        __syncthreads();
        float s2 = 0.f, s1 = 0.f;
        for (int cc = 0; cc < 16; ++cc) { const int col = cc * 128 + tid; float a = 0.f;
            for (int k = 0; k < KSEL; ++k) { const int ex = __builtin_bit_cast(int, sh[128 + k]); if ((unsigned)ex < (unsigned)NEXP) a += sh[k] * A.in[I_PV][(size_t)ex * D + col]; }
            sh[512 + cc * 128 + tid] = a; s2 += a * a; const float y = bfv(y1, (size_t)tok * D + col); s1 += y * y; }
        __syncthreads(); sh[256 + tid] = s2; sh[384 + tid] = s1; __syncthreads();
        float t2 = 0.f, t1 = 0.f; for (int k = 0; k < 128; ++k) { t2 += sh[256 + k]; t1 += sh[384 + k]; }
        const float r2 = rsqrtf(t2 / D + EPS), r1 = rsqrtf(t1 / D + EPS);
        float en = 0.f, ed = 0.f;
        for (int cc = 0; cc < 16; ++cc) { const int col = cc * 128 + tid;
            const float pterm = cfin[(b * 2 + 1) * D + col] * sh[512 + cc * 128 + tid] * r2;
            const float ref = A.in[I_X][(size_t)tok * D + col] + (OUT_MODE != 2 ? cfin[(b * 2) * D + col] * bfv(y1, (size_t)tok * D + col) * r1 : 0.f) + (OUT_MODE != 1 ? pterm : 0.f);
            const float d = A.out[(size_t)tok * D + col] - ref; en += d * d; ed += pterm * pterm; }
        __syncthreads(); sh[256 + tid] = en; sh[384 + tid] = ed; __syncthreads();
        float ten = 0.f, ted = 0.f; for (int k = 0; k < 128; ++k) { ten += sh[256 + k]; ted += sh[384 + k]; }
        e = ten / (ted + 1e-12f); if (!(e == e)) e = 1e30f;
    }
    chk_put(ctl, stage, e);
}
__global__ void chk_encode(Args A, int what) {
    const unsigned* ctl = (const unsigned*)(A.ws + WS_CTL);
    if (threadIdx.x == 0 && blockIdx.x == 0) {
        if (what < 0) {
            const float thr[12] = {0.03f, 0.03f, 0.03f, 0.03f, 0.06f, 0.01f, 0.04f, 0.03f, 0.03f, 0.03f, 0.2f, 0.01f};
            for (int st = 0; st < 12; ++st) { const float e = __builtin_bit_cast(float, ctl[CW_CHK + st]); if (!(e <= thr[st])) { A.out[0] = 4000.0f * (float)(1 << st); break; } }
        } else {
            const float e = fminf(__builtin_bit_cast(float, ctl[CW_CHK + what]), 1e6f); A.out[0] = 4000.0f * sqrtf(1e6f * e);
        }
    }
}
#endif

__global__ void __launch_bounds__(NTHR, 2) fwd_kernel(Args args) {
    extern __shared__ __attribute__((aligned(16))) unsigned char lds_raw[];
    LAS unsigned char* lds = (LAS unsigned char*)lds_raw;
    const int tid = threadIdx.x, lane = tid & 63, wave = __builtin_amdgcn_readfirstlane(tid >> 6), bid = blockIdx.x, G = gridDim.x;
    for (int u = tid; u < (LDS_BYTES - LDSCTL_OFF) / 4; u += NTHR) ((LAS unsigned*)(lds + LDSCTL_OFF))[u] = 0u;
    __syncthreads();
    unsigned* ctl = (unsigned*)(args.ws + WS_CTL);
    XcdBarrier bar; bar.bar = ctl + CW_BAR + args.li * XCD_BAR_WORDS; bar.x = 0; bar.st = nullptr;
    if (MK_N_LAUNCHES != N_PHASES) bar = xcd_barrier_post(ctl + CW_BAR + args.li * XCD_BAR_WORDS, (volatile LAS unsigned*)(lds + MISC_OFF) + 8);
    const int lo = args.ph_lo, hi = args.ph_hi;
#define IN(k) (lo <= (k) && (k) < hi)
#define SEAM(k) do { if (IN(k) && IN((k) + 1)) xcd_barrier(bar); } while (0)
#define PHON(k) ((PH_MASK >> (k)) & 1)
    if (PHON(0) && IN(0)) { phase_p0(args, lds, tid, lane, wave, bid, G); }
    SEAM(0);
    if (PHON(1) && IN(1)) { phase_p1(args, tid, lane, wave, bid, G); }
    SEAM(1);
    if (PHON(2) && IN(2)) {
        pg8::Gemm g{(const bf16*)(args.ws + WS_RA), (const bf16*)(args.ws + WS_BT1), T, IN_COLS, D}; pg8::StaticOrder S; S.init(T, IN_COLS, G, bid);
        pg8::EpiBf16<0> E{(bf16*)(args.ws + WS_PROJ), IN_COLS, nullptr, 0, 0, 1.f};
        pg8::gemm_phase<pg8::EpiBf16<0>, pg8::StaticOrder, PG8_ALIGN, PG8_SP2>(lds + RING_OFF, g, S, E);
    }
    SEAM(2);
    if (PHON(3) && IN(3)) { phase_m1a(args, lds, tid, lane, wave, bid, G); }
    SEAM(3);
    if (PHON(4) && IN(4)) { phase_m1b(args, tid, lane, wave, bid, G); }
    SEAM(4);
    if (PHON(5) && IN(5)) { phase_m3(args, lds, tid, lane, wave, bid, G); }
    SEAM(5);
    if (PHON(6) && IN(6)) {
        pg8::Gemm g{(const bf16*)(args.ws + WS_RA), (const bf16*)(args.ws + WS_BT2), T, D, D}; pg8::StaticOrder S; S.init(T, D, G, bid);
        pg8::EpiBf16<0> E{(bf16*)(args.ws + WS_Y1), D, nullptr, 0, 0, 1.f};
        pg8::gemm_phase<pg8::EpiBf16<0>, pg8::StaticOrder, PG8_ALIGN, PG8_SP2>(lds + RING_OFF, g, S, E);
    }
    SEAM(6);
    if (PHON(7) && IN(7)) { phase_e2(args, tid, lane, wave, bid, G); }
    SEAM(7);
    if (PHON(8) && IN(8)) {
        pg8::Gemm g{(const bf16*)(args.ws + WS_RA), (const bf16*)(args.ws + WS_BT3), T, D, D}; pg8::StaticOrder S; S.init(T, D, G, bid);
        pg8::EpiBf16<0> E{(bf16*)(args.ws + WS_Q), D, nullptr, 0, 0, 1.f};
        pg8::gemm_phase<pg8::EpiBf16<0>, pg8::StaticOrder, PG8_ALIGN, PG8_SP2>(lds + RING_OFF, g, S, E);
    }
    SEAM(8);
    if (PHON(9) && IN(9)) { phase_s(args, lds, tid, lane, wave, bid, G); }
    SEAM(9);
    if (PHON(10) && IN(10)) { phase_pe(args, tid, lane, wave, bid, G); }
#undef IN
#undef SEAM
}

extern "C" void kernel_launch(void* const* d_in, const int* in_sizes, int n_in, void* d_out, int out_size, void* d_ws, size_t ws_size, hipStream_t stream) {
    static int grid = 0;
    if (grid == 0) {
        if (n_in != 25 || in_sizes[0] != T * D || out_size != T * D || ws_size < WS_END) {
            fprintf(stderr, "kernel_launch: built for 25 inputs, x/out of %d floats, >= %zu bytes of workspace; got n_in %d, in0 %d, out %d, ws %zu; nothing launched\n", T * D, (size_t)WS_END, n_in, n_in > 0 ? in_sizes[0] : -1, out_size, ws_size);
            grid = -1; return; }
        int dev = 0, cus = 0, per_cu = 0;
        if (hipGetDevice(&dev) != hipSuccess || hipDeviceGetAttribute(&cus, hipDeviceAttributeMultiprocessorCount, dev) != hipSuccess) { fprintf(stderr, "kernel_launch: device query failed\n"); grid = -1; return; }
        if (hipFuncSetAttribute((const void*)fwd_kernel, hipFuncAttributeMaxDynamicSharedMemorySize, LDS_BYTES) != hipSuccess) { fprintf(stderr, "kernel_launch: hipFuncSetAttribute failed\n"); grid = -1; return; }
        if (hipOccupancyMaxActiveBlocksPerMultiprocessor(&per_cu, (const void*)fwd_kernel, NTHR, LDS_BYTES) != hipSuccess || per_cu < 1)
            fprintf(stderr, "kernel_launch: note: occupancy query reports %d workgroups per CU\n", per_cu);
        (void)hipGetLastError();
        grid = cus;
    }
    if (grid < 0) return;
    if (hipMemsetAsync((char*)d_ws + WS_CTL, 0, CTL_ZERO_BYTES, stream) != hipSuccess) { fprintf(stderr, "kernel_launch: memset failed\n"); return; }
    Args a{};
    for (int i = 0; i < 25; ++i) a.in[i] = (const float*)d_in[i];
    a.out = (float*)d_out; a.ws = (unsigned char*)d_ws;
#if defined(MK_TIME_REP)
    const int cuts[3][2] = {{0, MK_TIME_REP + 1}, {MK_TIME_REP, MK_TIME_REP + 1}, {MK_TIME_REP + 1, N_PHASES}};
    for (int li = 0; li < 3; ++li) {
        a.ph_lo = cuts[li][0]; a.ph_hi = cuts[li][1]; a.li = li;
        if (a.ph_lo < a.ph_hi) hipLaunchKernelGGL(fwd_kernel, dim3(grid), dim3(NTHR), LDS_BYTES, stream, a);
    }
#else
    for (int li = 0; li < MK_N_LAUNCHES; ++li) {
        if (MK_N_LAUNCHES == 1) { a.ph_lo = 0; a.ph_hi = N_PHASES; } else { a.ph_lo = li; a.ph_hi = li + 1; }
        a.li = 0;
        hipLaunchKernelGGL(fwd_kernel, dim3(grid), dim3(NTHR), LDS_BYTES, stream, a);
        const hipError_t le = hipPeekAtLastError();
        if (le != hipSuccess) { fprintf(stderr, "kernel_launch: launch %d failed: %s\n", li, hipGetErrorName(le)); break; }
#if defined(MK_CHECKS)
        { const int chk_of_phase[N_PHASES] = {0, 1, 2, 3, 4, 6, 7, 8, 9, 10, 11}; hipLaunchKernelGGL(chk_kernel, dim3(4), dim3(128), 0, stream, a, chk_of_phase[li]); }
#endif
    }
#endif
#if defined(MK_CHECKS)
    hipLaunchKernelGGL(chk_encode, dim3(1), dim3(64), 0, stream, a, MK_CHECKS);
#endif
}
```

```cpp
#include <hip/hip_runtime.h>
#include <cstdio>
#include <cstdint>
#include <cmath>
namespace pg8 {
#define PG8_LAS __attribute__((address_space(3)))
typedef unsigned short bf16_t;
typedef short bf16x8 __attribute__((ext_vector_type(8)));
typedef float f32x4 __attribute__((ext_vector_type(4)));
typedef unsigned u32x4 __attribute__((ext_vector_type(4)));
constexpr int BM = 256, BK = 64, HALF = 128, HTB = HALF * BK * 2  , STAGE_BYTES = 8 * HTB, NXCD = 8, WGM = 8;

__host__ __device__ __forceinline__ int lds_byte(int r, int c) { const int st = (r >> 4) * 2 + (c >> 5), rr = r & 15, cc = c & 31, ob = rr * 64 + cc * 2; return st * 1024 + (ob ^ (((ob >> 9) & 1) << 5)); }
__host__ __device__ __forceinline__ void stage_rc(int b, int& R, int& C) { const int st = b / 1024, sb = b % 1024, swz = sb ^ (((sb >> 9) & 1) << 5); R = (st >> 1) * 16 + swz / 64; C = (st & 1) * 32 + (swz % 64) / 2; }
__host__ __device__ __forceinline__ int perm32(int rho) { const int n = rho >> 4, i = rho & 15; return 8 * (i >> 2) + 4 * n + (i & 3); }

struct Unit { int pm, pn; };
struct Gemm { const bf16_t* A; const bf16_t* Bt; int M, N, K; };

struct StaticOrder {
    int nM, nN, nwg, G, c;
    __host__ __device__ void init(int M, int N, int G_, int c_) { nM = M / BM; nN = N / BM; nwg = nM * nN; G = G_; c = c_; }
    __host__ __device__ bool next(int i, Unit& u) const {
        const long L = (long)i * G + c; if (L >= nwg) return false;
        int wgid = (int)L; { const int q = nwg / NXCD, r = nwg % NXCD, xcd = wgid % NXCD, off = wgid / NXCD; wgid = (xcd < r ? xcd * (q + 1) : r * (q + 1) + (xcd - r) * q) + off; }
        const int nig = WGM * nN, gid = wgid / nig, fm = gid * WGM, gsz = (nM - fm) < WGM ? (nM - fm) : WGM;
        u.pm = fm + ((wgid % nig) % gsz); u.pn = (wgid % nig) / gsz; return true;
    }
    __device__ __forceinline__ void a_ready(const Unit&) const {}
    __device__ __forceinline__ void done(const Unit&) const {}
};

__device__ __forceinline__ unsigned cvt_pk_bf16(float lo, float hi) { unsigned r; asm volatile("v_cvt_pk_bf16_f32 %0, %1, %2" : "=v"(r) : "v"(lo), "v"(hi)); return r; }
typedef float f32x2 __attribute__((ext_vector_type(2)));
__device__ __forceinline__ f32x2 gelu_pk(f32x2 v) {
    const f32x2 av = __builtin_elementwise_abs(v), d = av * 0.2316418882f + 1.0f;
    f32x2 t; t.x = __builtin_amdgcn_rcpf(d.x); t.y = __builtin_amdgcn_rcpf(d.y);
    f32x2 q = t * 0.5307027145f + (-0.7265760135f); q = q * t + 0.7107068705f; q = q * t + (-0.142248368f); q = q * t + 0.127414796f; q = q * t;
    const f32x2 s = (v * v) * (-0.72134752044f);
    f32x2 e; e.x = __builtin_amdgcn_exp2f(s.x); e.y = __builtin_amdgcn_exp2f(s.y);
    const f32x2 m = v * (q * e), r = v - m;
    f32x2 o; o.x = v.x < 0.f ? m.x : r.x; o.y = v.y < 0.f ? m.y : r.y; return o;
}

template <int ACT  > struct EpiBf16 {
    static constexpr bool PERM = true, AFTER_DRAIN = false; static_assert(ACT == 0 || ACT == 1, "EpiBf16: ACT is 0 (none) or 1 (gelu_pk)");
    bf16_t* O; int ldc; const float* bias; int split_cols; size_t split_stride; float scale0;
    __device__ __forceinline__ void operator()(const f32x4 (&acc)[2][2][4][2], const Unit& u, int wr, int wc, int fr, int fq) const {
        const int row0 = u.pm * BM + wr * 64 + fr; int colt = u.pn * BM; bf16_t* base = O;
        float sc = 1.f; if (split_cols) { const int t = colt / split_cols; base += (size_t)t * split_stride; colt -= t * split_cols; if (t == 0) sc = scale0; }
        const int col0 = colt + wc * 32 + 8 * fq, bcol0 = u.pn * BM + wc * 32 + 8 * fq;
        f32x4 bv[2][2];
#pragma unroll
        for (int bj = 0; bj < 2; ++bj)
#pragma unroll
            for (int n = 0; n < 2; ++n) bv[bj][n] = bias ? *(const f32x4*)(bias + bcol0 + bj * HALF + 4 * n) : (f32x4){0.f, 0.f, 0.f, 0.f};
#pragma unroll
        for (int ai = 0; ai < 2; ++ai)
#pragma unroll
            for (int m = 0; m < 4; ++m) { bf16_t* rowp = base + (size_t)(row0 + ai * HALF + m * 16) * ldc + col0;
#pragma unroll
                for (int bj = 0; bj < 2; ++bj) { f32x4 v0 = acc[ai][bj][m][0] + bv[bj][0], v1 = acc[ai][bj][m][1] + bv[bj][1];
                    if (ACT == 1) { f32x2 a = gelu_pk((f32x2){v0[0], v0[1]}), b = gelu_pk((f32x2){v0[2], v0[3]}), c = gelu_pk((f32x2){v1[0], v1[1]}), d = gelu_pk((f32x2){v1[2], v1[3]});
                        v0 = (f32x4){a.x, a.y, b.x, b.y}; v1 = (f32x4){c.x, c.y, d.x, d.y}; }
                    v0 = v0 * sc; v1 = v1 * sc; u32x4 w; w.x = cvt_pk_bf16(v0[0], v0[1]); w.y = cvt_pk_bf16(v0[2], v0[3]); w.z = cvt_pk_bf16(v1[0], v1[1]); w.w = cvt_pk_bf16(v1[2], v1[3]);
                    *(u32x4*)(rowp + bj * HALF) = w; } }
    }
};
template <class Epi, class Sched, bool ALIGN_EPI = false, bool SP2 = false>
__device__ __forceinline__ void gemm_phase(PG8_LAS unsigned char* lds, const Gemm g, const Sched& S, const Epi& E) {
    const int tid = threadIdx.x, wid = __builtin_amdgcn_readfirstlane(tid >> 6), lane = tid & 63, wr = wid >> 2, wc = wid & 3, fr = lane & 15, fq = lane >> 4;
    const int K = g.K, nt = K / BK;
    unsigned voffA[2], voffB[2];
#pragma unroll
    for (int i = 0; i < 2; ++i) { int R, C; stage_rc(tid * 16 + i * 8192, R, C); const int Rb = Epi::PERM ? ((R & ~31) + perm32(R & 31)) : R;
        voffA[i] = (unsigned)(R * K + C) * 2u; voffB[i] = (unsigned)(Rb * K + C) * 2u; }
    const size_t kstep = (size_t)(BK * 2);
    const size_t hstep = (size_t)HALF * K * 2;
    const size_t tstep = 2 * hstep;
    const unsigned ldsw = (unsigned)wid * 1024u;
    const int aoff = lds_byte(wr * 64 + fr, fq * 8), boff = lds_byte(wc * 32 + fr, fq * 8);
#define PG8_SA(b, h) (((b) * 2 + (h)) * HTB)
#define PG8_SB(b, h) ((4 + (b) * 2 + (h)) * HTB)
#define PG8_STAGE(bufoff, gbase, voff) do { _Pragma("unroll") for (int _i = 0; _i < 2; ++_i) \
        __builtin_amdgcn_global_load_lds((const unsigned*)((const char*)(gbase) + (voff)[_i]), (PG8_LAS unsigned*)(lds + (bufoff) + ldsw + _i * 8192), 16, 0, 0); } while (0)
#define PG8_LDA(dst, b, h) do { _Pragma("unroll") for (int m = 0; m < 4; ++m) _Pragma("unroll") for (int k = 0; k < 2; ++k) dst[m][k] = *(const PG8_LAS bf16x8*)(lds + PG8_SA(b, h) + aoff + m * 2048 + k * 1024); } while (0)
#define PG8_LDB(dst, b, h) do { _Pragma("unroll") for (int n = 0; n < 2; ++n) _Pragma("unroll") for (int k = 0; k < 2; ++k) dst[n][k] = *(const PG8_LAS bf16x8*)(lds + PG8_SB(b, h) + boff + n * 2048 + k * 1024); } while (0)
#define PG8_MMA(ai, bj, At, Bt) do { __builtin_amdgcn_s_setprio(1); _Pragma("unroll") for (int m = 0; m < 4; ++m) _Pragma("unroll") for (int n = 0; n < 2; ++n) _Pragma("unroll") for (int k = 0; k < 2; ++k) \
        acc[ai][bj][m][n] = __builtin_amdgcn_mfma_f32_16x16x32_bf16(Bt[n][k], At[m][k], acc[ai][bj][m][n], 0, 0, 0); __builtin_amdgcn_s_setprio(0); } while (0)
#define PG8_WAIT_V(n) asm volatile("s_waitcnt vmcnt(" #n ")" ::: "memory")
#define PG8_WAIT_L(n) asm volatile("s_waitcnt lgkmcnt(" #n ")" ::: "memory")
#define PG8_BAR __builtin_amdgcn_s_barrier()
#define PG8_SCHED __builtin_amdgcn_sched_barrier(0)
    Unit cur, nxt; int ui = 0;
    if (!S.next(0, cur)) return;
    f32x4 acc[2][2][4][2];
#pragma unroll
    for (int a = 0; a < 2; ++a)
#pragma unroll
        for (int b = 0; b < 2; ++b)
#pragma unroll
            for (int m = 0; m < 4; ++m)
#pragma unroll
                for (int n = 0; n < 2; ++n) acc[a][b][m][n] = (f32x4){0.f, 0.f, 0.f, 0.f};
    bf16x8 At[4][2], B0[2][2], B1[2][2];
    const char* cA = (const char*)g.A + (size_t)cur.pm * tstep; const char* cB = (const char*)g.Bt + (size_t)cur.pn * tstep;
    S.a_ready(cur);
    if constexpr (SP2) {
        PG8_STAGE(PG8_SB(0, 0), cB, voffB); PG8_STAGE(PG8_SB(0, 1), cB + hstep, voffB); PG8_STAGE(PG8_SA(0, 0), cA, voffA); PG8_STAGE(PG8_SA(0, 1), cA + hstep, voffA);
        if (wr == 1) PG8_BAR;
        PG8_WAIT_V(2); PG8_BAR;
        PG8_STAGE(PG8_SB(1, 0), cB + kstep, voffB); PG8_STAGE(PG8_SA(1, 0), cA + kstep, voffA); PG8_STAGE(PG8_SB(1, 1), cB + hstep + kstep, voffB);
        PG8_WAIT_V(6); PG8_BAR;
    } else {
        PG8_STAGE(PG8_SB(0, 0), cB, voffB); PG8_STAGE(PG8_SA(0, 0), cA, voffA); PG8_STAGE(PG8_SB(0, 1), cB + hstep, voffB); PG8_STAGE(PG8_SA(0, 1), cA + hstep, voffA);
        if (wr == 1) PG8_BAR;
        PG8_WAIT_V(4); PG8_BAR;
        PG8_STAGE(PG8_SB(1, 0), cB + kstep, voffB); PG8_STAGE(PG8_SA(1, 0), cA + kstep, voffA); PG8_STAGE(PG8_SB(1, 1), cB + hstep + kstep, voffB);
        PG8_WAIT_V(6); PG8_BAR;
    }
    for (;;) {
        const bool has_next = S.next(ui + 1, nxt);
        const char* nA = has_next ? (const char*)g.A + (size_t)nxt.pm * tstep : cA; const char* nB = has_next ? (const char*)g.Bt + (size_t)nxt.pn * tstep : cB;
        for (int t = 0; t < nt; t += 2) {
            const bool last = (t == nt - 2);
            const char* a1 = cA + (size_t)(t + 1) * kstep;
            const char* a2 = last ? nA : cA + (size_t)(t + 2) * kstep; const char* b2 = last ? nB : cB + (size_t)(t + 2) * kstep;
            const char* a3 = a2 + kstep; const char* b3 = b2 + kstep;
            if (last && has_next) S.a_ready(nxt);
            if constexpr (SP2) {
            PG8_LDB(B0, 0, 0); PG8_LDB(B1, 0, 1); PG8_SCHED; PG8_LDA(At, 0, 0); PG8_STAGE(PG8_SA(1, 1), a1 + hstep, voffA);
            PG8_WAIT_V(8); PG8_WAIT_L(0); PG8_BAR; PG8_MMA(0, 0, At, B0); PG8_MMA(0, 1, At, B1); PG8_BAR; PG8_SCHED;
            PG8_LDA(At, 0, 1); PG8_STAGE(PG8_SB(0, 0), b2, voffB); PG8_STAGE(PG8_SB(0, 1), b2 + hstep, voffB); PG8_STAGE(PG8_SA(0, 0), a2, voffA);
            PG8_WAIT_V(8); PG8_WAIT_L(0); PG8_BAR; PG8_MMA(1, 0, At, B0); PG8_MMA(1, 1, At, B1); PG8_BAR; PG8_SCHED;
            PG8_LDB(B0, 1, 0); PG8_LDB(B1, 1, 1); PG8_SCHED; PG8_LDA(At, 1, 0); PG8_STAGE(PG8_SA(0, 1), a2 + hstep, voffA);
            PG8_WAIT_V(8); PG8_WAIT_L(0); PG8_BAR; PG8_MMA(0, 0, At, B0); PG8_MMA(0, 1, At, B1); PG8_BAR; PG8_SCHED;
            PG8_LDA(At, 1, 1); PG8_STAGE(PG8_SB(1, 0), b3, voffB); PG8_STAGE(PG8_SB(1, 1), b3 + hstep, voffB); PG8_STAGE(PG8_SA(1, 0), a3, voffA);
            PG8_WAIT_V(8); PG8_WAIT_L(0); PG8_BAR; PG8_MMA(1, 0, At, B0); PG8_MMA(1, 1, At, B1); PG8_BAR; PG8_SCHED;
            } else {
            PG8_LDB(B0, 0, 0); PG8_SCHED; PG8_LDA(At, 0, 0); PG8_STAGE(PG8_SA(1, 1), a1 + hstep, voffA);
            PG8_WAIT_L(8); PG8_BAR; PG8_WAIT_L(0); PG8_MMA(0, 0, At, B0); PG8_BAR; PG8_SCHED;
            PG8_LDB(B1, 0, 1); PG8_STAGE(PG8_SB(0, 0), b2, voffB);
            PG8_BAR; PG8_WAIT_L(0); PG8_MMA(0, 1, At, B1); PG8_BAR;
            PG8_LDA(At, 0, 1); PG8_STAGE(PG8_SA(0, 0), a2, voffA);
            PG8_BAR; PG8_WAIT_L(0); PG8_MMA(1, 0, At, B0); PG8_BAR; PG8_SCHED;
            PG8_STAGE(PG8_SB(0, 1), b2 + hstep, voffB);
            PG8_WAIT_V(6); PG8_BAR; PG8_MMA(1, 1, At, B1); PG8_BAR;
            PG8_LDB(B0, 1, 0); PG8_SCHED; PG8_LDA(At, 1, 0); PG8_STAGE(PG8_SA(0, 1), a2 + hstep, voffA);
            PG8_WAIT_L(8); PG8_BAR; PG8_WAIT_L(0); PG8_MMA(0, 0, At, B0); PG8_BAR; PG8_SCHED;
            PG8_LDB(B1, 1, 1); PG8_STAGE(PG8_SB(1, 0), b3, voffB);
            PG8_BAR; PG8_WAIT_L(0); PG8_MMA(0, 1, At, B1); PG8_BAR;
            PG8_LDA(At, 1, 1); PG8_STAGE(PG8_SA(1, 0), a3, voffA);
            PG8_BAR; PG8_WAIT_L(0); PG8_MMA(1, 0, At, B0); PG8_BAR; PG8_SCHED;
            PG8_STAGE(PG8_SB(1, 1), b3 + hstep, voffB);
            PG8_WAIT_V(6); PG8_BAR; PG8_MMA(1, 1, At, B1); PG8_BAR;
            }
        }
        if constexpr (ALIGN_EPI) { if (wr == 0) PG8_BAR; }
        if constexpr (!Epi::AFTER_DRAIN) { E(acc, cur, wr, wc, fr, fq); S.done(cur); }
        if (!has_next) break;
#pragma unroll
        for (int a = 0; a < 2; ++a)
#pragma unroll
            for (int b = 0; b < 2; ++b)
#pragma unroll
                for (int m = 0; m < 4; ++m)
#pragma unroll
                    for (int n = 0; n < 2; ++n) acc[a][b][m][n] = (f32x4){0.f, 0.f, 0.f, 0.f};
        cur = nxt; cA = nA; cB = nB; ++ui;
        if constexpr (ALIGN_EPI) { if (wr == 1) PG8_BAR; }
    }
    PG8_WAIT_V(0);
    if constexpr (!ALIGN_EPI) { if (wr == 0) PG8_BAR; }
    PG8_BAR;
    if constexpr (Epi::AFTER_DRAIN) { E.fused(acc, cur, wr, wc, fr, fq, lds, wid, lane); S.done(cur); }
#undef PG8_SA
#undef PG8_SB
#undef PG8_STAGE
#undef PG8_LDA
#undef PG8_LDB
#undef PG8_MMA
#undef PG8_WAIT_V
#undef PG8_WAIT_L
#undef PG8_BAR
#undef PG8_SCHED
}
}
#ifndef PG8_SP2
#define PG8_SP2 true
#endif
#ifndef PG8_ALIGN
#define PG8_ALIGN true
#endif
#ifndef OUT_MODE
#define OUT_MODE 0
#endif
#ifndef REP_MASK
#define REP_MASK 0
#endif
#ifndef S_CONV
#define S_CONV 1
#endif
#ifndef M3_RW
#define M3_RW 2
#endif
#ifndef PU_NB
#define PU_NB 6
#endif
#ifndef PV_RB
#define PV_RB 8
#endif
#ifndef PE_SORT
#define PE_SORT 1
#endif
#ifndef PH_MASK
#define PH_MASK 0xFFF
#endif
#ifndef MK_N_LAUNCHES
#define MK_N_LAUNCHES 1
#endif

constexpr int NWAVES = 8, NTHR = NWAVES * 64;
constexpr int BATCH = 2, SEQ = 8192, D = 2048, T = BATCH * SEQ;
constexpr int LRU_W = 1024, CONF_W = 1024, IN_COLS = 4096, LRU_HD = 128;
constexpr int NH = 8, NKEY = 128, TOPK = 16, NEXP = NKEY * NKEY, KSEL = NH * TOPK;
constexpr int NMOD = 6 * D;
constexpr int CHUNK = 64, NCHUNK = SEQ / CHUNK;
constexpr int CONF_K = 31;
constexpr float EPS = 1e-6f;
constexpr int N_PHASES = 12;

constexpr size_t MiB = 1u << 20;
constexpr size_t WS_CTL = 0, CTL_ZERO_BYTES = 64 * 1024;
constexpr size_t WS_MODP = 1 * MiB;
constexpr size_t WS_CFIN = 2 * MiB;
constexpr size_t WS_CARRY = 3 * MiB;
constexpr size_t WS_AGG = 4 * MiB;
constexpr size_t WS_WG = 6 * MiB;
constexpr size_t WS_SUBK = 7 * MiB;
constexpr size_t WS_BT1 = 8 * MiB;
constexpr size_t WS_BT2 = 24 * MiB;
constexpr size_t WS_BT3 = 32 * MiB;
constexpr size_t WS_IDX = 40 * MiB;
constexpr size_t WS_GATE = 48 * MiB;
constexpr size_t WS_USC = 56 * MiB;
constexpr size_t WS_VSC = 57 * MiB;
constexpr size_t WS_RA = 64 * MiB;
constexpr size_t WS_Y1 = 128 * MiB;
constexpr size_t WS_PROJ = 192 * MiB;
constexpr size_t WS_Q = 192 * MiB;
constexpr size_t WS_UB = 256 * MiB;
constexpr size_t WS_XL = 320 * MiB;
constexpr size_t WS_ZC = 352 * MiB;
constexpr size_t WS_HLOC = 384 * MiB;
constexpr size_t WS_PC = 416 * MiB;
constexpr size_t WS_VB = 320 * MiB;
constexpr size_t WS_ACT = 448 * MiB;
constexpr size_t WS_H2Q = 456 * MiB;
constexpr size_t WS_HSC = 488 * MiB;
constexpr size_t WS_END = 489 * MiB;
constexpr int CW_TMO = 0, CW_BAR = 4096;

constexpr int RING_OFF = 0, RING_BYTES = 131072;
constexpr int LDSCTL_OFF = RING_BYTES, MISC_OFF = LDSCTL_OFF + 320;
constexpr int LDS_BYTES = 147456;

#define GAS __attribute__((address_space(1)))
#define LAS __attribute__((address_space(3)))
typedef unsigned short bf16;
typedef unsigned v4u __attribute__((ext_vector_type(4)));
typedef unsigned v2u __attribute__((ext_vector_type(2)));
typedef float f32x4 __attribute__((ext_vector_type(4)));
typedef float f32x16 __attribute__((ext_vector_type(16)));
typedef float f32x2 __attribute__((ext_vector_type(2)));
typedef short bf16x8 __attribute__((ext_vector_type(8)));
typedef __bf16 bfp2 __attribute__((ext_vector_type(2)));
typedef GAS unsigned gu32;
#define RLX_AGENT __ATOMIC_RELAXED, __HIP_MEMORY_SCOPE_AGENT
#define LDS_WAIT() asm volatile("s_waitcnt lgkmcnt(0)" ::: "memory")
#define VM_WAIT() asm volatile("s_waitcnt vmcnt(0)" ::: "memory")
__device__ __forceinline__ unsigned f2bf(float f) { unsigned u = __builtin_bit_cast(unsigned, f); return (u + 0x7fffu + ((u >> 16) & 1u)) >> 16; }
__device__ __forceinline__ unsigned pk2(float lo, float hi) { return f2bf(lo) | (f2bf(hi) << 16); }
__device__ __forceinline__ float bflo(unsigned u) { return __builtin_bit_cast(float, u << 16); }
__device__ __forceinline__ float bfhi(unsigned u) { return __builtin_bit_cast(float, u & 0xffff0000u); }
__device__ __forceinline__ float wave_sum(float v) {
#pragma unroll
    for (int o = 1; o < 64; o <<= 1) v += __shfl_xor(v, o);
    return v;
}
__device__ __forceinline__ float dpp_sum63(float v) {
    v += __builtin_bit_cast(float, __builtin_amdgcn_update_dpp(0, __builtin_bit_cast(int, v), 0xB1, 0xF, 0xF, false));
    v += __builtin_bit_cast(float, __builtin_amdgcn_update_dpp(0, __builtin_bit_cast(int, v), 0x4E, 0xF, 0xF, false));
    v += __builtin_bit_cast(float, __builtin_amdgcn_update_dpp(0, __builtin_bit_cast(int, v), 0x141, 0xF, 0xF, false));
    v += __builtin_bit_cast(float, __builtin_amdgcn_update_dpp(0, __builtin_bit_cast(int, v), 0x140, 0xF, 0xF, false));
    v += __builtin_bit_cast(float, __builtin_amdgcn_update_dpp(0, __builtin_bit_cast(int, v), 0x142, 0xA, 0xF, false));
    v += __builtin_bit_cast(float, __builtin_amdgcn_update_dpp(0, __builtin_bit_cast(int, v), 0x143, 0xC, 0xF, false));
    return v;
}

__device__ __forceinline__ float sigmoidf_(float x) { return __builtin_amdgcn_rcpf(1.0f + __expf(-x)); }
__device__ __forceinline__ float gelu_tanh(float x) { return x * sigmoidf_(1.5957691216057308f * (x + 0.044715f * x * x * x)); }
__device__ __forceinline__ float rdlane(float v, int l) { return __builtin_bit_cast(float, __builtin_amdgcn_readlane(__builtin_bit_cast(int, v), l)); }
__device__ __forceinline__ float wave_total(float v) { return rdlane(dpp_sum63(v), 63); }

#define XB_TMO      128
#define XB_XCNT(j)  (256  + 64 * (j))
#define XB_XSUB(j)  (1280 + 64 * (j))
#define XB_XGEN(j)  (2304 + 64 * (j))
#define XB_TOP      3328
#define XB_TOPGEN   3392
#define XCD_BAR_WORDS 3456
#define XB_SPIN_CAP (1u << 18)

__device__ __forceinline__ unsigned xb_ld(unsigned* p)              { return __hip_atomic_load(p, __ATOMIC_RELAXED, __HIP_MEMORY_SCOPE_AGENT); }
__device__ __forceinline__ unsigned xb_add(unsigned* p, unsigned v) { return __hip_atomic_fetch_add(p, v, __ATOMIC_RELAXED, __HIP_MEMORY_SCOPE_AGENT); }
__device__ __forceinline__ unsigned xb_xcc_id() { return (unsigned)__builtin_amdgcn_s_getreg((3 << 11) | 20) & 0xFu; }
#define XB_SPIN(cond, bar) do { unsigned _sp = 0; while (cond) { __builtin_amdgcn_s_sleep(1); \
    if ((++_sp & 255u) == 0u) { if (xb_ld(&(bar)[XB_TMO])) break; if (_sp > XB_SPIN_CAP) { atomicAdd(&(bar)[XB_TMO], 1u); break; } } } } while (0)

struct XcdBarrier {
    unsigned* bar; unsigned x;
    volatile LAS unsigned* st;
};

__device__ __forceinline__ XcdBarrier xcd_barrier_post(unsigned* bar, volatile LAS unsigned* st) {
    XcdBarrier b; b.bar = bar; b.x = xb_xcc_id(); b.st = st;
    if (threadIdx.x == 0) (void)xb_add(&bar[XB_XCNT(b.x)], 1u);
    return b;
}
__device__ __forceinline__ void xcd_barrier_complete(unsigned* bar, unsigned x, unsigned& nloc, unsigned& nx) {
    const unsigned G = gridDim.x * gridDim.y * gridDim.z;
    unsigned sum, cnt, mine, sp = 0u;
    for (;;) {
        sum = 0u; cnt = 0u; mine = 0u;
#pragma unroll
        for (unsigned j = 0; j < 16; ++j) { const unsigned c = xb_ld(&bar[XB_XCNT(j)]); sum += c; cnt += (c > 0u) ? 1u : 0u; mine = (j == x) ? c : mine; }
        if (sum == G) break;
        __builtin_amdgcn_s_sleep(1);
        if ((++sp & 255u) == 0u) { if (xb_ld(&bar[XB_TMO])) break; if (sp > XB_SPIN_CAP) { atomicAdd(&bar[XB_TMO], 1u); break; } }
    }
    nloc = mine > 0u ? mine : 1u; nx = cnt > 0u ? cnt : 1u;
}

__device__ __forceinline__ void xcd_barrier(const XcdBarrier& b) {
    asm volatile("s_waitcnt vmcnt(0)" ::: "memory");
    __syncthreads();
    if (threadIdx.x == 0) {
        unsigned* bar = b.bar;
        __builtin_amdgcn_s_waitcnt(0);
        unsigned nloc = b.st[0], nx = b.st[1];
        if (nloc == 0u) { xcd_barrier_complete(bar, b.x, nloc, nx); b.st[0] = nloc; b.st[1] = nx; }
        const unsigned old = xb_add(&bar[XB_XSUB(b.x)], 1u);
        const unsigned gen = old / nloc;
        if (old + 1u == (gen + 1u) * nloc) {
            __builtin_amdgcn_fence(__ATOMIC_RELEASE, "agent");
            asm volatile("s_waitcnt vmcnt(0)" ::: "memory");
            const unsigned og = xb_add(&bar[XB_TOP], 1u);
            const unsigned tg = og / nx;
            if (og + 1u == (tg + 1u) * nx) xb_add(&bar[XB_TOPGEN], 1u);
            else XB_SPIN(xb_ld(&bar[XB_TOPGEN]) == tg, bar);
            __builtin_amdgcn_fence(__ATOMIC_ACQUIRE, "agent");
            xb_add(&bar[XB_XGEN(b.x)], 1u);
            asm volatile("s_waitcnt vmcnt(0)" ::: "memory");
        } else {
            XB_SPIN(xb_ld(&bar[XB_XGEN(b.x)]) == gen, bar);
            __builtin_amdgcn_fence(__ATOMIC_ACQUIRE, "agent");
            asm volatile("s_waitcnt vmcnt(0)" ::: "memory");
        }
    }
    __syncthreads();
}
struct Args { const float* in[25]; float* out; unsigned char* ws; int ph_lo, ph_hi, li, pad; };
enum { I_X = 0, I_C, I_WMOD, I_BMOD, I_GPREMIX, I_GPOSTMIX, I_GPREFFN, I_GPOSTFFN, I_WIN, I_LCW, I_LCB, I_WA, I_BA, I_WX, I_BX, I_LAMBDA,
       I_CDW, I_CDB, I_LNG, I_LNB, I_WOUT, I_WQ, I_SUBK, I_PU, I_PV };

__device__ __forceinline__ float mod_at(const float* modp, int b, int n) {
    return (modp[(0 * 2 + b) * NMOD + n] + modp[(1 * 2 + b) * NMOD + n]) + (modp[(2 * 2 + b) * NMOD + n] + modp[(3 * 2 + b) * NMOD + n]);
}

__device__ __forceinline__ void p0_transpose_item(const float* W, int K, int N, bf16* WT, LAS float* scr, int item, int lane) {
    const int nblk = N / 32, kb = item / nblk, nb = item % nblk, k0 = 64 * kb, n0 = 32 * nb;
#pragma unroll 8
    for (int i = 0; i < 32; ++i) { const int kk = 2 * i + (lane >> 5); scr[kk * 33 + (lane & 31)] = W[(size_t)(k0 + kk) * N + n0 + (lane & 31)]; }
    LDS_WAIT(); asm volatile("" ::: "memory");
    const int c = lane & 7;
#pragma unroll
    for (int j = 0; j < 4; ++j) { const int n = (lane >> 3) + 8 * j; const LAS float* s = scr + (8 * c) * 33 + n;
        v4u o; o.x = pk2(s[0 * 33], s[1 * 33]); o.y = pk2(s[2 * 33], s[3 * 33]); o.z = pk2(s[4 * 33], s[5 * 33]); o.w = pk2(s[6 * 33], s[7 * 33]);
        *(GAS v4u*)(WT + (size_t)(n0 + n) * K + k0 + 8 * c) = o; }
    LDS_WAIT(); asm volatile("" ::: "memory");
}
__device__ __forceinline__ void cvt_rows_bf16(const float* src, bf16* dst, size_t n8, size_t gt, size_t ngt) {
    for (size_t i = gt; i < n8; i += ngt) {
        const f32x4 a = ((const GAS f32x4*)src)[2 * i], b = ((const GAS f32x4*)src)[2 * i + 1];
        v4u o; o.x = pk2(a.x, a.y); o.y = pk2(a.z, a.w); o.z = pk2(b.x, b.y); o.w = pk2(b.z, b.w);
        ((GAS v4u*)dst)[i] = o; }
}
__device__ __forceinline__ void phase_p0(const Args& A, LAS unsigned char* lds, int tid, int lane, int wave, int bid, int G) {
    float* modp = (float*)(A.ws + WS_MODP);
    for (int item = bid; item < 192; item += G) {
        const int cg = item % 48, kq = item / 48, k0 = kq * 512 + wave * 64, n0 = cg * 256 + lane * 4;
        const float c0 = A.in[I_C][k0 + lane], c1 = A.in[I_C][D + k0 + lane];
        const float ca0 = c0 * sigmoidf_(c0), ca1 = c1 * sigmoidf_(c1);
        f32x4 a0 = {0.f, 0.f, 0.f, 0.f}, a1 = {0.f, 0.f, 0.f, 0.f};
        const float* wp = A.in[I_WMOD] + (size_t)k0 * NMOD + n0;
#pragma unroll 8
        for (int kk = 0; kk < 64; ++kk) {
            const f32x4 w = *(const GAS f32x4*)(wp + (size_t)kk * NMOD);
            const float s0 = __shfl(ca0, kk), s1 = __shfl(ca1, kk);
            a0 += w * s0; a1 += w * s1;
        }
        LAS f32x4* red = (LAS f32x4*)lds;
        red[(wave * 2 + 0) * 64 + lane] = a0; red[(wave * 2 + 1) * 64 + lane] = a1;
        __syncthreads();
        { const int b = tid >> 8, col = tid & 255; const LAS float* rf = (const LAS float*)lds; float s = 0.f;
#pragma unroll
          for (int w = 0; w < 8; ++w) s += rf[((w * 2 + b) * 64) * 4 + col];
          if (kq == 0) s += A.in[I_BMOD][cg * 256 + col];
          modp[(kq * 2 + b) * NMOD + cg * 256 + col] = s; }
        __syncthreads();
    }
    {
        LAS float* scr = (LAS float*)(lds + wave * 16384);
        const int gw = bid * NWAVES + wave, NGW = G * NWAVES;
        constexpr int I1 = (D / 64) * (IN_COLS / 32), I2 = (D / 64) * (D / 32);
        for (int it = gw; it < I1 + 2 * I2; it += NGW) {
            int r = it;
            if (r < I1) { p0_transpose_item(A.in[I_WIN], D, IN_COLS, (bf16*)(A.ws + WS_BT1), scr, r, lane); continue; } r -= I1;
            if (r < I2) { p0_transpose_item(A.in[I_WOUT], D, D, (bf16*)(A.ws + WS_BT2), scr, r, lane); continue; } r -= I2;
            p0_transpose_item(A.in[I_WQ], D, D, (bf16*)(A.ws + WS_BT3), scr, r, lane);
        }
    }
    {
        const int gt = bid * NTHR + tid, ngt = G * NTHR;
        bf16* wg = (bf16*)(A.ws + WS_WG);
        for (int e = gt; e < NH * 256 * 128; e += ngt) {
            const int h = e >> 15, n = (e >> 7) & 255, k = e & 127;
            const float v = (n < 128 ? A.in[I_WA] : A.in[I_WX])[h * 16384 + k * 128 + (n & 127)];
            wg[e] = (bf16)f2bf(v);
        }
        cvt_rows_bf16(A.in[I_SUBK], (bf16*)(A.ws + WS_SUBK), (size_t)NH * 2 * NKEY * 128 / 8, gt, ngt);
    }
}

__device__ __forceinline__ void phase_p1(const Args& A, int tid, int lane, int wave, int bid, int G) {
    const float* modp = (const float*)(A.ws + WS_MODP);
    {
        float* cfin = (float*)(A.ws + WS_CFIN);
        for (int e = bid * NTHR + tid; e < 2 * 2 * D; e += G * NTHR) {
            const int b = e >> 12, arr = (e >> 11) & 1, col = e & (D - 1);
            cfin[e] = arr == 0 ? mod_at(modp, b, 2 * D + col) * A.in[I_GPOSTMIX][col] : mod_at(modp, b, 5 * D + col) * A.in[I_GPOSTFFN][col];
        }
        float* cfe = (float*)(A.ws + WS_CFIN) + 4 * D;
        for (int e = bid * NTHR + tid; e < 2 * 2 * D; e += G * NTHR) {
            const int b = e >> 12, arr = (e >> 11) & 1, col = e & (D - 1);
            cfe[e] = arr == 0 ? A.in[I_GPREFFN][col] * (1.0f + mod_at(modp, b, 4 * D + col)) : mod_at(modp, b, 3 * D + col);
        }
    }
    const int gw = bid * NWAVES + wave, NGW = G * NWAVES;
    bf16* h1 = (bf16*)(A.ws + WS_RA);
    int cb = -1; float gs[4][8], sh[4][8];
    for (int row = gw; row < T; row += NGW) {
        const int b = row >> 13;
        if (b != cb) { cb = b;
#pragma unroll
            for (int j = 0; j < 4; ++j)
#pragma unroll
                for (int e = 0; e < 8; ++e) { const int col = j * 512 + lane * 8 + e;
                    gs[j][e] = A.in[I_GPREMIX][col] * (1.0f + mod_at(modp, b, D + col)); sh[j][e] = mod_at(modp, b, col); } }
        const GAS f32x4* xr = (const GAS f32x4*)(A.in[I_X] + (size_t)row * D) + lane * 2;
        f32x4 v[4][2]; float s = 0.f;
#pragma unroll
        for (int j = 0; j < 4; ++j) { v[j][0] = xr[j * 128]; v[j][1] = xr[j * 128 + 1];
            s += (v[j][0].x * v[j][0].x + v[j][0].y * v[j][0].y) + (v[j][0].z * v[j][0].z + v[j][0].w * v[j][0].w);
            s += (v[j][1].x * v[j][1].x + v[j][1].y * v[j][1].y) + (v[j][1].z * v[j][1].z + v[j][1].w * v[j][1].w); }
        const float rstd = __builtin_amdgcn_rsqf(wave_total(s) * (1.0f / D) + EPS);
        GAS v4u* orow = (GAS v4u*)(h1 + (size_t)row * D) + lane;
#pragma unroll
        for (int j = 0; j < 4; ++j) { float o[8];
#pragma unroll
            for (int e = 0; e < 8; ++e) o[e] = v[j][e >> 2][e & 3] * rstd * gs[j][e] + sh[j][e];
            v4u w; w.x = pk2(o[0], o[1]); w.y = pk2(o[2], o[3]); w.z = pk2(o[4], o[5]); w.w = pk2(o[6], o[7]);
            orow[j * 64] = w; }
    }
}

__device__ __forceinline__ void m1a_tile_issue(const bf16* proj, int item, int tid, v4u (&rv)[5], v4u (&rg)[5]) {
    const int b = item >> 9, tt = (item >> 3) & 63, ct = item & 7, t0 = tt * 128;
#pragma unroll
    for (int i = 0; i < 5; ++i) {
        const int e = tid + i * NTHR, r = e >> 4, c8 = (e & 15) * 8, t = t0 - 30 + r;
        rv[i] = (v4u){0u, 0u, 0u, 0u}; rg[i] = (v4u){0u, 0u, 0u, 0u};
        if (e < 158 * 16 && t >= 0) { const bf16* p = proj + (size_t)(b * SEQ + t) * IN_COLS + 2048 + ct * 128 + c8; rv[i] = *(const GAS v4u*)p; rg[i] = *(const GAS v4u*)(p + 1024); }
    }
}
__device__ __forceinline__ void phase_m1a(const Args& A, LAS unsigned char* lds, int tid, int lane, int wave, int bid, int G) {
    const bf16* proj = (const bf16*)(A.ws + WS_PROJ);
    {
        bf16* xl = (bf16*)(A.ws + WS_XL);
        const float* w4 = A.in[I_LCW]; const float* b4 = A.in[I_LCB];
        for (int it = bid * NTHR + tid; it < (T / 16) * 128; it += G * NTHR) {
            const int c0 = (it & 127) * 8, run = it >> 7, row0 = run * 16, t0 = row0 & (SEQ - 1);
            v4u in[19];
#pragma unroll
            for (int r = 0; r < 19; ++r) { in[r] = (v4u){0u, 0u, 0u, 0u}; if (t0 - 3 + r >= 0) in[r] = *(const GAS v4u*)(proj + (size_t)(row0 - 3 + r) * IN_COLS + c0); }
            float w[4][8], bb[8];
#pragma unroll
            for (int j = 0; j < 4; ++j) { const f32x4 wa = *(const GAS f32x4*)(w4 + j * LRU_W + c0), wb = *(const GAS f32x4*)(w4 + j * LRU_W + c0 + 4);
                w[j][0] = wa.x; w[j][1] = wa.y; w[j][2] = wa.z; w[j][3] = wa.w; w[j][4] = wb.x; w[j][5] = wb.y; w[j][6] = wb.z; w[j][7] = wb.w; }
            { const f32x4 ba = *(const GAS f32x4*)(b4 + c0), bc = *(const GAS f32x4*)(b4 + c0 + 4); bb[0] = ba.x; bb[1] = ba.y; bb[2] = ba.z; bb[3] = ba.w; bb[4] = bc.x; bb[5] = bc.y; bb[6] = bc.z; bb[7] = bc.w; }
#pragma unroll
            for (int i = 0; i < 16; ++i) { float acc[8];
#pragma unroll
                for (int e = 0; e < 8; ++e) acc[e] = bb[e];
#pragma unroll
                for (int j = 0; j < 4; ++j) { const v4u v = in[i + j];
                    acc[0] += w[j][0] * bflo(v.x); acc[1] += w[j][1] * bfhi(v.x); acc[2] += w[j][2] * bflo(v.y); acc[3] += w[j][3] * bfhi(v.y);
                    acc[4] += w[j][4] * bflo(v.z); acc[5] += w[j][5] * bfhi(v.z); acc[6] += w[j][6] * bflo(v.w); acc[7] += w[j][7] * bfhi(v.w); }
                v4u o; o.x = pk2(acc[0], acc[1]); o.y = pk2(acc[2], acc[3]); o.z = pk2(acc[4], acc[5]); o.w = pk2(acc[6], acc[7]);
                *(GAS v4u*)(xl + (size_t)(row0 + i) * LRU_W + c0) = o; }
        }
    }
    {
        bf16* zc = (bf16*)(A.ws + WS_ZC);
        const float* w31 = A.in[I_CDW]; const float* b31 = A.in[I_CDB];
        LAS float* zt = (LAS float*)lds;
        const int cp = tid & 63, tg = tid >> 6;
        v4u rv[5], rg[5];
        int item = bid;
        if (item < 2 * 64 * 8) m1a_tile_issue(proj, item, tid, rv, rg);
        float w0[CONF_K], w1[CONF_K], bias0 = 0.f, bias1 = 0.f; int wct = -1;
        for (; item < 2 * 64 * 8; item += G) {
            const int b = item >> 9, tt = (item >> 3) & 63, ct = item & 7, t0 = tt * 128, ch = ct * 128 + 2 * cp;
            if (ct != wct) { wct = ct;
#pragma unroll
                for (int j = 0; j < CONF_K; ++j) { const f32x2 ww = *(const GAS f32x2*)(w31 + j * CONF_W + ch); w0[j] = ww.x; w1[j] = ww.y; }
                const f32x2 bw = *(const GAS f32x2*)(b31 + ch); bias0 = bw.x; bias1 = bw.y; }
            __syncthreads();
#pragma unroll
            for (int i = 0; i < 5; ++i) {
                const int e = tid + i * NTHR, r = e >> 4, c8 = (e & 15) * 8;
                if (e < 158 * 16) { const v4u v = rv[i], g = rg[i]; f32x4 z0, z1;
                    z0.x = bflo(v.x) * sigmoidf_(bflo(g.x)); z0.y = bfhi(v.x) * sigmoidf_(bfhi(g.x)); z0.z = bflo(v.y) * sigmoidf_(bflo(g.y)); z0.w = bfhi(v.y) * sigmoidf_(bfhi(g.y));
                    z1.x = bflo(v.z) * sigmoidf_(bflo(g.z)); z1.y = bfhi(v.z) * sigmoidf_(bfhi(g.z)); z1.z = bflo(v.w) * sigmoidf_(bflo(g.w)); z1.w = bfhi(v.w) * sigmoidf_(bfhi(g.w));
                    *(LAS f32x4*)(zt + r * 128 + c8) = z0; *(LAS f32x4*)(zt + r * 128 + c8 + 4) = z1; }
            }
            __syncthreads();
            if (item + G < 2 * 64 * 8) m1a_tile_issue(proj, item + G, tid, rv, rg);
            float a0[16], a1[16];
#pragma unroll
            for (int i = 0; i < 16; ++i) { a0[i] = bias0; a1[i] = bias1; }
#pragma unroll
            for (int s_ = 0; s_ < 46; ++s_) {
                const f32x2 v = *(const LAS f32x2*)(zt + (tg * 16 + s_) * 128 + 2 * cp);
#pragma unroll
                for (int i = 0; i < 16; ++i) if (s_ - i >= 0 && s_ - i < CONF_K) { a0[i] += w0[s_ - i] * v.x; a1[i] += w1[s_ - i] * v.y; }
            }
            bf16* zo = zc + (size_t)(b * SEQ + t0 + tg * 16) * CONF_W + ch;
#pragma unroll
            for (int i = 0; i < 16; ++i) *(GAS unsigned*)(zo + (size_t)i * CONF_W) = pk2(a0[i], a1[i]);
        }
        __syncthreads();
    }
}

template <int CTRL> __device__ __forceinline__ float dpp_shr(float v, float ident) {
    return __builtin_bit_cast(float, __builtin_amdgcn_update_dpp(__builtin_bit_cast(int, ident), __builtin_bit_cast(int, v), CTRL, 0xF, 0xF, false));
}
__device__ __forceinline__ void phase_m1b(const Args& A, int tid, int lane, int wave, int bid, int G) {
    const bf16* xl = (const bf16*)(A.ws + WS_XL); const bf16* wg = (const bf16*)(A.ws + WS_WG);
    bf16* hloc = (bf16*)(A.ws + WS_HLOC); bf16* pc = (bf16*)(A.ws + WS_PC); float* agg = (float*)(A.ws + WS_AGG);
    const int fr = lane & 15, fq = lane >> 4;
    for (int item = bid * NWAVES + wave; item < 2 * NCHUNK * 8; item += G * NWAVES) {
        const int hh = item & 7, chunk = (item >> 3) & (NCHUNK - 1), b = item >> 10;
        const size_t r0 = (size_t)b * SEQ + (size_t)chunk * CHUNK;
        bf16x8 xf[4][4];
#pragma unroll
        for (int mt = 0; mt < 4; ++mt)
#pragma unroll
            for (int ks = 0; ks < 4; ++ks) xf[mt][ks] = *(const GAS bf16x8*)(xl + (r0 + 16 * mt + fr) * LRU_W + hh * LRU_HD + 32 * ks + 8 * fq);
        float cP[4], cH[4];
        for (int j = 0; j < 8; ++j) {
            const int chb = hh * LRU_HD + 16 * j + 4 * fq;
            bf16x8 wa[4], wx[4];
#pragma unroll
            for (int ks = 0; ks < 4; ++ks) { wa[ks] = *(const GAS bf16x8*)(wg + (size_t)(hh * 256 + 16 * j + fr) * 128 + 32 * ks + 8 * fq);
                                             wx[ks] = *(const GAS bf16x8*)(wg + (size_t)(hh * 256 + 128 + 16 * j + fr) * 128 + 32 * ks + 8 * fq); }
            const f32x4 bav = *(const GAS f32x4*)(A.in[I_BA] + chb), bxv = *(const GAS f32x4*)(A.in[I_BX] + chb), lam = *(const GAS f32x4*)(A.in[I_LAMBDA] + chb);
            float cl[4];
#pragma unroll
            for (int r = 0; r < 4; ++r) { cl[r] = -8.0f * log1pf(__expf(-lam[r])); cP[r] = 1.f; cH[r] = 0.f; }
#pragma unroll
            for (int mt = 0; mt < 4; ++mt) {
                f32x4 ar = {0.f, 0.f, 0.f, 0.f}, ai = {0.f, 0.f, 0.f, 0.f};
#pragma unroll
                for (int ks = 0; ks < 4; ++ks) { ar = __builtin_amdgcn_mfma_f32_16x16x32_bf16(wa[ks], xf[mt][ks], ar, 0, 0, 0);
                                                 ai = __builtin_amdgcn_mfma_f32_16x16x32_bf16(wx[ks], xf[mt][ks], ai, 0, 0, 0); }
                const v2u xv = *(const GAS v2u*)(xl + (r0 + 16 * mt + fr) * LRU_W + chb);
                const float xlv[4] = {bflo(xv.x), bfhi(xv.x), bflo(xv.y), bfhi(xv.y)};
                float P[4], H[4];
#pragma unroll
                for (int r = 0; r < 4; ++r) {
                    const float rg = sigmoidf_(ar[r] + bav[r]), ig = sigmoidf_(ai[r] + bxv[r]);
                    const float la = cl[r] * rg, a = __expf(la), mult = sqrtf(fmaxf(1.0f - a * a, 0.f));
                    float p = a, h = mult * ig * xlv[r];
                    { float pp, hp;
                      pp = dpp_shr<0x111>(p, 1.0f); hp = dpp_shr<0x111>(h, 0.0f); h = p * hp + h; p = p * pp;
                      pp = dpp_shr<0x112>(p, 1.0f); hp = dpp_shr<0x112>(h, 0.0f); h = p * hp + h; p = p * pp;
                      pp = dpp_shr<0x114>(p, 1.0f); hp = dpp_shr<0x114>(h, 0.0f); h = p * hp + h; p = p * pp;
                      pp = dpp_shr<0x118>(p, 1.0f); hp = dpp_shr<0x118>(h, 0.0f); h = p * hp + h; p = p * pp; }
                    h = h + p * cH[r]; p = p * cP[r];
                    P[r] = p; H[r] = h;
                    cP[r] = __shfl(p, 15, 16); cH[r] = __shfl(h, 15, 16);
                }
                v2u ho, po; ho.x = pk2(H[0], H[1]); ho.y = pk2(H[2], H[3]); po.x = pk2(P[0], P[1]); po.y = pk2(P[2], P[3]);
                *(GAS v2u*)(hloc + (r0 + 16 * mt + fr) * LRU_W + chb) = ho;
                *(GAS v2u*)(pc + (r0 + 16 * mt + fr) * LRU_W + chb) = po;
            }
            if (fr == 0) {
                float* ag = agg + ((size_t)(b * NCHUNK + chunk) * LRU_W + chb) * 2;
                *(GAS f32x4*)ag = (f32x4){cP[0], cH[0], cP[1], cH[1]}; *(GAS f32x4*)(ag + 4) = (f32x4){cP[2], cH[2], cP[3], cH[3]};
            }
        }
    }
}

__device__ __forceinline__ void phase_m3(const Args& A, LAS unsigned char* lds, int tid, int lane, int wave, int bid, int G) {
    const bf16* proj = (const bf16*)(A.ws + WS_PROJ); const bf16* hloc = (const bf16*)(A.ws + WS_HLOC); const bf16* pc = (const bf16*)(A.ws + WS_PC);
    const bf16* zc = (const bf16*)(A.ws + WS_ZC); const float* agg = (const float*)(A.ws + WS_AGG);
    bf16* a2 = (bf16*)(A.ws + WS_RA);
    LAS float* cs = (LAS float*)lds;
    float lg[2][8], lb[2][8];
#pragma unroll
    for (int jj = 0; jj < 2; ++jj)
#pragma unroll
        for (int e = 0; e < 8; ++e) { lg[jj][e] = A.in[I_LNG][jj * 512 + lane * 8 + e]; lb[jj][e] = A.in[I_LNB][jj * 512 + lane * 8 + e]; }
    for (int item = bid; item < 2 * NCHUNK; item += G) {
        const int b = item >> 7, chunk = item & (NCHUNK - 1);
        {   float h0 = 0.f, h1 = 0.f; const float* ap = agg + ((size_t)(b * NCHUNK) * LRU_W + 2 * tid) * 2;
#pragma unroll 8
            for (int c = 0; c < chunk; ++c) { const f32x4 ab = *(const GAS f32x4*)(ap + (size_t)c * LRU_W * 2); h0 = ab.x * h0 + ab.y; h1 = ab.z * h1 + ab.w; }
            __syncthreads();
            cs[2 * tid] = h0; cs[2 * tid + 1] = h1;
            __syncthreads(); }
        for (int rr = 0; rr < 8; rr += M3_RW) {
            const int row0 = b * SEQ + chunk * CHUNK + wave * 8 + rr;
            v4u hv[M3_RW][2], pv[M3_RW][2], gv[M3_RW][2], zq[M3_RW][2];
#pragma unroll
            for (int u = 0; u < M3_RW; ++u)
#pragma unroll
                for (int jj = 0; jj < 2; ++jj) { const int c0 = jj * 512 + lane * 8; const size_t row = (size_t)(row0 + u);
                    hv[u][jj] = *(const GAS v4u*)(hloc + row * LRU_W + c0); pv[u][jj] = *(const GAS v4u*)(pc + row * LRU_W + c0);
                    gv[u][jj] = *(const GAS v4u*)(proj + row * IN_COLS + 1024 + c0); zq[u][jj] = *(const GAS v4u*)(zc + row * CONF_W + c0); }
#pragma unroll
            for (int u = 0; u < M3_RW; ++u) {
                const size_t row = (size_t)(row0 + u);
                float zv[2][8]; float s = 0.f;
#pragma unroll
                for (int jj = 0; jj < 2; ++jj) {
                    const int c0 = jj * 512 + lane * 8;
                    const f32x4 ca = *(const LAS f32x4*)(cs + c0), cb = *(const LAS f32x4*)(cs + c0 + 4);
                    const v4u h_ = hv[u][jj], p_ = pv[u][jj], g_ = gv[u][jj], z = zq[u][jj];
                    float y[8];
                    y[0] = (bflo(h_.x) + bflo(p_.x) * ca.x) * gelu_tanh(bflo(g_.x)); y[1] = (bfhi(h_.x) + bfhi(p_.x) * ca.y) * gelu_tanh(bfhi(g_.x));
                    y[2] = (bflo(h_.y) + bflo(p_.y) * ca.z) * gelu_tanh(bflo(g_.y)); y[3] = (bfhi(h_.y) + bfhi(p_.y) * ca.w) * gelu_tanh(bfhi(g_.y));
                    y[4] = (bflo(h_.z) + bflo(p_.z) * cb.x) * gelu_tanh(bflo(g_.z)); y[5] = (bfhi(h_.z) + bfhi(p_.z) * cb.y) * gelu_tanh(bfhi(g_.z));
                    y[6] = (bflo(h_.w) + bflo(p_.w) * cb.z) * gelu_tanh(bflo(g_.w)); y[7] = (bfhi(h_.w) + bfhi(p_.w) * cb.w) * gelu_tanh(bfhi(g_.w));
                    v4u o; o.x = pk2(y[0], y[1]); o.y = pk2(y[2], y[3]); o.z = pk2(y[4], y[5]); o.w = pk2(y[6], y[7]);
                    *(GAS v4u*)(a2 + row * D + c0) = o;
                    zv[jj][0] = bflo(z.x); zv[jj][1] = bfhi(z.x); zv[jj][2] = bflo(z.y); zv[jj][3] = bfhi(z.y); zv[jj][4] = bflo(z.z); zv[jj][5] = bfhi(z.z); zv[jj][6] = bflo(z.w); zv[jj][7] = bfhi(z.w);
#pragma unroll
                    for (int e = 0; e < 8; ++e) s += zv[jj][e];
                }
                const float mean = wave_total(s) * (1.0f / CONF_W); float q = 0.f;
#pragma unroll
                for (int jj = 0; jj < 2; ++jj)
#pragma unroll
                    for (int e = 0; e < 8; ++e) { zv[jj][e] -= mean; q += zv[jj][e] * zv[jj][e]; }
                const float rstd = __builtin_amdgcn_rsqf(wave_total(q) * (1.0f / CONF_W) + EPS);
#pragma unroll
                for (int jj = 0; jj < 2; ++jj) { float o[8];
#pragma unroll
                    for (int e = 0; e < 8; ++e) { const float n = zv[jj][e] * rstd * lg[jj][e] + lb[jj][e]; o[e] = n * sigmoidf_(n); }
                    v4u w; w.x = pk2(o[0], o[1]); w.y = pk2(o[2], o[3]); w.z = pk2(o[4], o[5]); w.w = pk2(o[6], o[7]);
                    *(GAS v4u*)(a2 + row * D + 1024 + jj * 512 + lane * 8) = w; }
            }
        }
    }
}

__device__ __forceinline__ f32x2 fp8lo(unsigned w) { return __builtin_amdgcn_cvt_pk_f32_fp8((int)w, false); }
__device__ __forceinline__ f32x2 fp8hi(unsigned w) { return __builtin_amdgcn_cvt_pk_f32_fp8((int)w, true); }
constexpr int CVT_ROWS = 4;
template <bool I8> __device__ __forceinline__ void cvt_table_q8(const float* src, unsigned char* dst, float* inv_scale, int gw, int NGW, int lane) {
    for (int r0 = gw; r0 < NEXP; r0 += NGW * CVT_ROWS) {
        f32x4 v[CVT_ROWS][8];
#pragma unroll
        for (int q = 0; q < CVT_ROWS; ++q) { const int r = r0 + q * NGW; const GAS f32x4* p = (const GAS f32x4*)(src + (size_t)(r < NEXP ? r : r0) * D) + lane;
#pragma unroll
            for (int i = 0; i < 8; ++i) v[q][i] = p[i * 64]; }
#pragma unroll
        for (int q = 0; q < CVT_ROWS; ++q) { const int r = r0 + q * NGW; float m = 0.f;
#pragma unroll
            for (int i = 0; i < 8; ++i) m = fmaxf(m, fmaxf(fmaxf(fabsf(v[q][i].x), fabsf(v[q][i].y)), fmaxf(fabsf(v[q][i].z), fabsf(v[q][i].w))));
#pragma unroll
            for (int o = 1; o < 64; o <<= 1) m = fmaxf(m, __shfl_xor(m, o));
            const float QM = I8 ? 127.0f : 448.0f;
            const float sc = m > 0.f ? QM / m : 1.0f;
            if (r < NEXP) {
                GAS unsigned* o4 = (GAS unsigned*)(dst + (size_t)r * D) + lane;
#pragma unroll
                for (int i = 0; i < 8; ++i) { const f32x4 t = v[q][i] * sc;
                    const float a = fminf(fmaxf(t.x, -QM), QM), b = fminf(fmaxf(t.y, -QM), QM), c = fminf(fmaxf(t.z, -QM), QM), d = fminf(fmaxf(t.w, -QM), QM);
                    if (I8) { o4[i * 64] = (unsigned)(((int)rintf(a) & 255) | (((int)rintf(b) & 255) << 8) | (((int)rintf(c) & 255) << 16) | ((int)rintf(d) << 24)); }
                    else { int pk = __builtin_amdgcn_cvt_pk_fp8_f32(a, b, 0, false); pk = __builtin_amdgcn_cvt_pk_fp8_f32(c, d, pk, true); o4[i * 64] = (unsigned)pk; } }
                if (lane == 0) inv_scale[r] = m > 0.f ? m * (1.0f / QM) : 1.0f;
            }
        }
    }
}
__device__ __forceinline__ void phase_e2(const Args& A, int tid, int lane, int wave, int bid, int G) {
    const float* modp = (const float*)(A.ws + WS_MODP); const float* cfin = (const float*)(A.ws + WS_CFIN);
    const bf16* y1 = (const bf16*)(A.ws + WS_Y1); bf16* h2 = (bf16*)(A.ws + WS_RA);
    const int gw = bid * NWAVES + wave, NGW = G * NWAVES;
    const float* cfe = (const float*)(A.ws + WS_CFIN) + 4 * D;
    for (int row = gw; row < T; row += NGW) {
        const int b = row >> 13;
        const GAS f32x4* xr = (const GAS f32x4*)(A.in[I_X] + (size_t)row * D) + lane * 2;
        const GAS v4u* yr = (const GAS v4u*)(y1 + (size_t)row * D) + lane;
        const GAS f32x4* cf = (const GAS f32x4*)(cfin + (size_t)(b * 2 + 0) * D) + lane * 2;
        float xv[4][8], yv[4][8]; float s1 = 0.f;
#pragma unroll
        for (int j = 0; j < 4; ++j) { const f32x4 a = xr[j * 128], c = xr[j * 128 + 1]; const v4u y = yr[j * 64];
            xv[j][0] = a.x; xv[j][1] = a.y; xv[j][2] = a.z; xv[j][3] = a.w; xv[j][4] = c.x; xv[j][5] = c.y; xv[j][6] = c.z; xv[j][7] = c.w;
            yv[j][0] = bflo(y.x); yv[j][1] = bfhi(y.x); yv[j][2] = bflo(y.y); yv[j][3] = bfhi(y.y); yv[j][4] = bflo(y.z); yv[j][5] = bfhi(y.z); yv[j][6] = bflo(y.w); yv[j][7] = bfhi(y.w);
#pragma unroll
            for (int e = 0; e < 8; ++e) s1 += yv[j][e] * yv[j][e]; }
        const float rstd1 = __builtin_amdgcn_rsqf(wave_total(s1) * (1.0f / D) + EPS); float s2 = 0.f;
#pragma unroll
        for (int j = 0; j < 4; ++j) { const f32x4 ca = cf[j * 128], cc = cf[j * 128 + 1]; const float cg[8] = {ca.x, ca.y, ca.z, ca.w, cc.x, cc.y, cc.z, cc.w};
#pragma unroll
            for (int e = 0; e < 8; ++e) { xv[j][e] += cg[e] * yv[j][e] * rstd1; s2 += xv[j][e] * xv[j][e]; } }
        const float rstd2 = __builtin_amdgcn_rsqf(wave_total(s2) * (1.0f / D) + EPS);
        GAS v4u* orow = (GAS v4u*)(h2 + (size_t)row * D) + lane; float am = 0.f;
#pragma unroll
        for (int j = 0; j < 4; ++j) {
            const GAS f32x4* ge = (const GAS f32x4*)(cfe + (size_t)(b * 2 + 0) * D) + lane * 2 + j * 128; const GAS f32x4* se = (const GAS f32x4*)(cfe + (size_t)(b * 2 + 1) * D) + lane * 2 + j * 128;
            const f32x4 g0_ = ge[0], g1_ = ge[1], s0_ = se[0], s1_ = se[1]; const float gsv[8] = {g0_.x, g0_.y, g0_.z, g0_.w, g1_.x, g1_.y, g1_.z, g1_.w}, shv[8] = {s0_.x, s0_.y, s0_.z, s0_.w, s1_.x, s1_.y, s1_.z, s1_.w};
#pragma unroll
            for (int e = 0; e < 8; ++e) { xv[j][e] = xv[j][e] * rstd2 * gsv[e] + shv[e]; am = fmaxf(am, fabsf(xv[j][e])); }
            v4u w; w.x = pk2(xv[j][0], xv[j][1]); w.y = pk2(xv[j][2], xv[j][3]); w.z = pk2(xv[j][4], xv[j][5]); w.w = pk2(xv[j][6], xv[j][7]);
            orow[j * 64] = w; }
#pragma unroll
        for (int o = 1; o < 64; o <<= 1) am = fmaxf(am, __shfl_xor(am, o));
        const float qs = am > 0.f ? 127.0f / am : 1.0f;
        GAS v2u* qrow = (GAS v2u*)(A.ws + WS_H2Q + (size_t)row * D) + lane;
#pragma unroll
        for (int j = 0; j < 4; ++j) { int q[8];
#pragma unroll
            for (int e = 0; e < 8; ++e) q[e] = (int)rintf(xv[j][e] * qs) & 255;
            v2u w; w.x = (unsigned)(q[0] | (q[1] << 8) | (q[2] << 16) | (q[3] << 24)); w.y = (unsigned)(q[4] | (q[5] << 8) | (q[6] << 16) | (q[7] << 24));
            qrow[j * 64] = w; }
        if (lane == 0) ((float*)(A.ws + WS_HSC))[row] = am > 0.f ? am * (1.0f / 127.0f) : 1.0f;
    }
    if (!S_CONV) { cvt_table_q8<true>(A.in[I_PU], A.ws + WS_UB, (float*)(A.ws + WS_USC), gw, NGW, lane); cvt_table_q8<false>(A.in[I_PV], A.ws + WS_VB, (float*)(A.ws + WS_VSC), gw, NGW, lane); }
}

template <int N> __device__ __forceinline__ void bitonic_sort_desc(float (&v)[N]) {
#pragma unroll
    for (int k = 2; k <= N; k <<= 1)
#pragma unroll
        for (int j = k >> 1; j > 0; j >>= 1)
#pragma unroll
            for (int i = 0; i < N; ++i) { const int l = i ^ j;
                if (l > i) { const bool desc = ((i & k) == 0); const float a = v[i], b = v[l]; const float mx = fmaxf(a, b), mn = fminf(a, b); v[i] = desc ? mx : mn; v[l] = desc ? mn : mx; } }
}
__device__ __forceinline__ void merge_top16(float (&a)[16], const float (&b)[16]) {
#pragma unroll
    for (int i = 0; i < 16; ++i) a[i] = fmaxf(a[i], b[15 - i]);
#pragma unroll
    for (int j = 8; j > 0; j >>= 1)
#pragma unroll
        for (int i = 0; i < 16; ++i) { const int l = i ^ j; if (l > i) { const float x = a[i], y = a[l]; a[i] = fmaxf(x, y); a[l] = fminf(x, y); } }
}
__device__ __forceinline__ void top16_of_64(float (&v)[64], float (&out)[16]) {
    float g[4][16];
#pragma unroll
    for (int q = 0; q < 4; ++q) {
#pragma unroll
        for (int i = 0; i < 16; ++i) g[q][i] = v[q * 16 + i];
        bitonic_sort_desc<16>(g[q]); }
    merge_top16(g[0], g[1]); merge_top16(g[2], g[3]); merge_top16(g[0], g[2]);
#pragma unroll
    for (int i = 0; i < 16; ++i) out[i] = g[0][i];
}
__device__ __forceinline__ float pack_key(float v, unsigned key, unsigned mask) { return __builtin_bit_cast(float, (__builtin_bit_cast(unsigned, v) & ~mask) | key); }
constexpr int SK_PITCH = 272;
__device__ __forceinline__ void score_top16(const bf16* q, const LAS unsigned char* skl, int tok, int h, int p, int l31, int hf, float (&out)[16]) {
    f32x16 acc[4];
#pragma unroll
    for (int kt = 0; kt < 4; ++kt)
#pragma unroll
        for (int r = 0; r < 16; ++r) acc[kt][r] = 0.f;
    bf16x8 bq[8];
#pragma unroll
    for (int ks = 0; ks < 8; ++ks) bq[ks] = *(const GAS bf16x8*)(q + (size_t)tok * D + h * 256 + p * 128 + 16 * ks + 8 * hf);
#pragma unroll
    for (int ks = 0; ks < 8; ++ks) {
#pragma unroll
        for (int kt = 0; kt < 4; ++kt) {
            const bf16x8 ak = *(const LAS bf16x8*)(skl + (p * NKEY + 32 * kt + l31) * SK_PITCH + (16 * ks + 8 * hf) * 2);
            acc[kt] = __builtin_amdgcn_mfma_f32_32x32x16_bf16(ak, bq[ks], acc[kt], 0, 0, 0);
        }
    }
    float v[64];
#pragma unroll
    for (int kt = 0; kt < 4; ++kt)
#pragma unroll
        for (int r = 0; r < 16; ++r) v[kt * 16 + r] = pack_key(acc[kt][r], (unsigned)(32 * kt + (r & 3) + 8 * (r >> 2) + 4 * hf), 0x7Fu);
    float other[16];
    top16_of_64(v, out);
#pragma unroll
    for (int i = 0; i < 16; ++i) other[i] = __shfl_xor(out[i], 32);
    merge_top16(out, other);
}
__device__ __forceinline__ void s_convert_tables(const Args& A, int gw, int NGW, int lane) {
    cvt_table_q8<true>(A.in[I_PU], A.ws + WS_UB, (float*)(A.ws + WS_USC), gw, NGW, lane);
    cvt_table_q8<false>(A.in[I_PV], A.ws + WS_VB, (float*)(A.ws + WS_VSC), gw, NGW, lane);
}
__device__ __forceinline__ void phase_s(const Args& A, LAS unsigned char* lds, int tid, int lane, int wave, int bid, int G) {
    const bf16* q = (const bf16*)(A.ws + WS_Q); const bf16* sk = (const bf16*)(A.ws + WS_SUBK);
    int* idx = (int*)(A.ws + WS_IDX); float* gate = (float*)(A.ws + WS_GATE);
    const int l31 = lane & 31, hf = lane >> 5;
    bool conv_done = false;
    for (int wi = bid; wi < (T / 512) * NH; wi += G) {
      const int h = wi & 7, tg = wi >> 3;
      __syncthreads();
#pragma unroll
      for (int i = 0; i < 8; ++i) { const int c = tid + i * NTHR, row = c >> 4, c16 = c & 15;
          *(LAS v4u*)(lds + row * SK_PITCH + c16 * 16) = *(const GAS v4u*)(sk + ((size_t)(h * 2 * NKEY + row)) * 128 + c16 * 8); }
      __syncthreads();
      if (S_CONV && wave >= 4 && !conv_done) s_convert_tables(A, bid * NWAVES + wave, G * NWAVES, lane);
      for (int ti = 0; ti < 2; ++ti) {
        const int tok = (tg * 16 + ti * 8 + wave) * 32 + l31;
        float s1[16], s2[16];
        score_top16(q, lds, tok, h, 0, l31, hf, s1);
        score_top16(q, lds, tok, h, 1, l31, hf, s2);
        float cv[64]; int n = 0;
#pragma unroll
        for (int i = 0; i < 16; ++i)
#pragma unroll
            for (int j = 0; j < 16; ++j)
                if ((i + 1) * (j + 1) <= 16) {
                    const float a = __builtin_bit_cast(float, __builtin_bit_cast(unsigned, s1[i]) & ~0x7Fu), c = __builtin_bit_cast(float, __builtin_bit_cast(unsigned, s2[j]) & ~0x7Fu);
                    cv[n++] = pack_key(a + c, (unsigned)(i * 16 + j), 0xFFu); }
#pragma unroll
        for (int m = 50; m < 64; ++m) cv[m] = -INFINITY;
        float c16[16];
        top16_of_64(cv, c16);
        float ev[16], esum = 0.f; const float cmax = __builtin_bit_cast(float, __builtin_bit_cast(unsigned, c16[0]) & ~0xFFu);
#pragma unroll
        for (int m = 0; m < 16; ++m) { ev[m] = __expf(__builtin_bit_cast(float, __builtin_bit_cast(unsigned, c16[m]) & ~0xFFu) - cmax); esum += ev[m]; }
        const float rs = 1.0f / esum;
        int oi[8]; float og[8];
#pragma unroll
        for (int mm = 0; mm < 8; ++mm) {
            float c_lo = c16[mm], c_hi = c16[8 + mm], e_lo = ev[mm], e_hi = ev[8 + mm];
            asm volatile("" : "+v"(c_lo), "+v"(c_hi), "+v"(e_lo), "+v"(e_hi));
            const unsigned cb = __builtin_bit_cast(unsigned, hf ? c_hi : c_lo); const int ii = (cb >> 4) & 15, jj = cb & 15;
            int row = 0, col = 0;
#pragma unroll
            for (int k = 0; k < 16; ++k) { row = (ii == k) ? (int)(__builtin_bit_cast(unsigned, s1[k]) & 0x7Fu) : row; col = (jj == k) ? (int)(__builtin_bit_cast(unsigned, s2[k]) & 0x7Fu) : col; }
            oi[mm] = row * NKEY + col; og[mm] = (hf ? e_hi : e_lo) * rs;
        }
        int* ip = idx + (size_t)tok * KSEL + h * 16 + hf * 8; float* gp = gate + (size_t)tok * KSEL + h * 16 + hf * 8;
        *(GAS v4u*)ip = (v4u){(unsigned)oi[0], (unsigned)oi[1], (unsigned)oi[2], (unsigned)oi[3]}; *(GAS v4u*)(ip + 4) = (v4u){(unsigned)oi[4], (unsigned)oi[5], (unsigned)oi[6], (unsigned)oi[7]};
        *(GAS f32x4*)gp = (f32x4){og[0], og[1], og[2], og[3]}; *(GAS f32x4*)(gp + 4) = (f32x4){og[4], og[5], og[6], og[7]};
      }
      if (S_CONV && wave < 4 && !conv_done) s_convert_tables(A, bid * NWAVES + wave, G * NWAVES, lane);
      conv_done = true;
    }
    if (S_CONV && !conv_done) s_convert_tables(A, bid * NWAVES + wave, G * NWAVES, lane);
    __syncthreads();
}

__device__ __forceinline__ float row_dot_fp8(const v4u d0, const v4u d1, const f32x2 (&hf)[2][8]) {
    const unsigned w0[4] = {d0.x, d0.y, d0.z, d0.w}, w1[4] = {d1.x, d1.y, d1.z, d1.w};
    f32x2 a = {0.f, 0.f}, b = {0.f, 0.f};
#pragma unroll
    for (int i = 0; i < 4; ++i) { a += fp8lo(w0[i]) * hf[0][2 * i]; a += fp8hi(w0[i]) * hf[0][2 * i + 1]; b += fp8lo(w1[i]) * hf[1][2 * i]; b += fp8hi(w1[i]) * hf[1][2 * i + 1]; }
    return (a.x + a.y) + (b.x + b.y);
}
__device__ __forceinline__ void row_axpy_fp8(f32x2 (&acc)[2][8], const v4u d0, const v4u d1, float w) {
    const unsigned w0[4] = {d0.x, d0.y, d0.z, d0.w}, w1[4] = {d1.x, d1.y, d1.z, d1.w};
#pragma unroll
    for (int i = 0; i < 4; ++i) { acc[0][2 * i] += fp8lo(w0[i]) * w; acc[0][2 * i + 1] += fp8hi(w0[i]) * w; acc[1][2 * i] += fp8lo(w1[i]) * w; acc[1][2 * i + 1] += fp8hi(w1[i]) * w; }
}
struct PuVisit { int tok, id0, id1; unsigned long long m0, m1, s0, s1; v4u h[2]; int kk[PU_NB]; v4u bu[PU_NB][2]; };
struct PuPre { int tok, id0, id1; v4u h[2]; };
__device__ __forceinline__ void pu_prefetch(PuPre& P, int tok, const int* idx, const unsigned char* h2q, int lane) {
    P.tok = tok; P.id0 = 0; P.id1 = 0; P.h[0] = (v4u){0u, 0u, 0u, 0u}; P.h[1] = (v4u){0u, 0u, 0u, 0u};
    if (tok < T) { P.id0 = idx[(size_t)tok * KSEL + lane]; P.id1 = idx[(size_t)tok * KSEL + 64 + lane];
        const GAS v4u* hp = (const GAS v4u*)(h2q + (size_t)tok * D) + lane; P.h[0] = hp[0]; P.h[1] = hp[64]; }
}
__device__ __forceinline__ void pu_issue(PuVisit& V, const unsigned char* ub, int lane) {
#pragma unroll
    for (int sl = 0; sl < PU_NB; ++sl) {
        V.kk[sl] = -1;
        if ((V.m0 | V.m1) != 0ull) {
            int k;
            if (V.m0 != 0ull) { k = __ffsll((long long)V.m0) - 1; V.m0 &= V.m0 - 1ull; } else { k = 64 + __ffsll((long long)V.m1) - 1; V.m1 &= V.m1 - 1ull; }
            V.kk[sl] = k;
            const int e = __builtin_amdgcn_readlane(k < 64 ? V.id0 : V.id1, k & 63);
            const GAS v4u* up = (const GAS v4u*)(ub + (size_t)e * D) + lane; V.bu[sl][0] = up[0]; V.bu[sl][1] = up[64];
        }
    }
}
__device__ __forceinline__ void pu_setup(PuVisit& V, const PuPre& P, int r, const unsigned char* ub, int lane) {
    V.tok = P.tok; V.id0 = P.id0; V.id1 = P.id1; V.h[0] = P.h[0]; V.h[1] = P.h[1];
    const bool ok = P.tok < T;
    V.m0 = ok ? __ballot((P.id0 >> 10) == r) : 0ull; V.m1 = ok ? __ballot((P.id1 >> 10) == r) : 0ull; V.s0 = V.m0; V.s1 = V.m1;
    pu_issue(V, ub, lane);
}
__device__ __forceinline__ int dpp_isum63(int v) {
    v += __builtin_amdgcn_update_dpp(0, v, 0xB1, 0xF, 0xF, false); v += __builtin_amdgcn_update_dpp(0, v, 0x4E, 0xF, 0xF, false);
    v += __builtin_amdgcn_update_dpp(0, v, 0x141, 0xF, 0xF, false); v += __builtin_amdgcn_update_dpp(0, v, 0x140, 0xF, 0xF, false);
    v += __builtin_amdgcn_update_dpp(0, v, 0x142, 0xA, 0xF, false); v += __builtin_amdgcn_update_dpp(0, v, 0x143, 0xC, 0xF, false);
    return v;
}
__device__ __forceinline__ void pu_compute(PuVisit& V, float* act, const unsigned char* ub, int lane) {
    if (V.tok >= T) return;
    float a0 = 0.f, a1 = 0.f;
    const int hw[8] = {(int)V.h[0].x, (int)V.h[0].y, (int)V.h[0].z, (int)V.h[0].w, (int)V.h[1].x, (int)V.h[1].y, (int)V.h[1].z, (int)V.h[1].w};
    for (;;) {
#pragma unroll
        for (int sl = 0; sl < PU_NB; ++sl) {
            if (V.kk[sl] >= 0) {
                const int uw[8] = {(int)V.bu[sl][0].x, (int)V.bu[sl][0].y, (int)V.bu[sl][0].z, (int)V.bu[sl][0].w, (int)V.bu[sl][1].x, (int)V.bu[sl][1].y, (int)V.bu[sl][1].z, (int)V.bu[sl][1].w};
                int d0 = 0, d1 = 0;
#pragma unroll
                for (int i = 0; i < 4; ++i) { d0 = __builtin_amdgcn_sdot4(uw[i], hw[i], d0, false); d1 = __builtin_amdgcn_sdot4(uw[4 + i], hw[4 + i], d1, false); }
                const float tot = (float)__builtin_amdgcn_readlane(dpp_isum63(d0 + d1), 63); const int k = V.kk[sl];
                a0 = (lane == k) ? tot : a0; a1 = (lane + 64 == k) ? tot : a1;
            }
        }
        if ((V.m0 | V.m1) == 0ull) break;
        pu_issue(V, ub, lane);
    }
    if ((V.s0 >> lane) & 1ull) act[(size_t)V.tok * KSEL + lane] = a0;
    if ((V.s1 >> lane) & 1ull) act[(size_t)V.tok * KSEL + 64 + lane] = a1;
}
__device__ __forceinline__ void phase_pu(const Args& A, int tid, int lane, int wave, int bid, int G) {
    const unsigned char* h2q = A.ws + WS_H2Q; const int* idx = (const int*)(A.ws + WS_IDX); const unsigned char* ub = A.ws + WS_UB; float* act = (float*)(A.ws + WS_ACT);
    const int NX = (G % 8 == 0) ? 8 : 1, vx = bid % NX, nw = (G / NX) * NWAVES, wv = (bid / NX) * NWAVES + wave;
    for (int r = vx; r < NEXP / 1024; r += NX) {
        PuVisit VA, VB; PuPre P;
        pu_prefetch(P, wv, idx, h2q, lane);
        pu_setup(VA, P, r, ub, lane);
        pu_prefetch(P, wv + nw, idx, h2q, lane);
        for (int tok = wv; tok < T; tok += 2 * nw) {
            pu_setup(VB, P, r, ub, lane); pu_prefetch(P, tok + 2 * nw, idx, h2q, lane);
            pu_compute(VA, act, ub, lane);
            pu_setup(VA, P, r, ub, lane); pu_prefetch(P, tok + 3 * nw, idx, h2q, lane);
            pu_compute(VB, act, ub, lane);
        }
    }
}
__device__ __forceinline__ void phase_pv(const Args& A, int tid, int lane, int wave, int bid, int G) {
    const bf16* y1 = (const bf16*)(A.ws + WS_Y1);
    const unsigned char* vb = A.ws + WS_VB;
    const float* usc = (const float*)(A.ws + WS_USC); const float* vsc = (const float*)(A.ws + WS_VSC); const float* act = (const float*)(A.ws + WS_ACT);
    const int* idx = (const int*)(A.ws + WS_IDX); const float* gate = (const float*)(A.ws + WS_GATE); const float* cfin = (const float*)(A.ws + WS_CFIN);
    for (int tok = bid * NWAVES + wave; tok < T; tok += G * NWAVES) {
        const int b = tok >> 13;
        int id0 = idx[(size_t)tok * KSEL + lane], id1 = idx[(size_t)tok * KSEL + 64 + lane];
        const float g0 = gate[(size_t)tok * KSEL + lane], g1 = gate[(size_t)tok * KSEL + 64 + lane];
        const float hs = ((const float*)(A.ws + WS_HSC))[tok];
        const float w0 = g0 * gelu_tanh(act[(size_t)tok * KSEL + lane] * usc[id0] * hs) * vsc[id0], w1 = g1 * gelu_tanh(act[(size_t)tok * KSEL + 64 + lane] * usc[id1] * hs) * vsc[id1];
        float ws0 = w0, ws1 = w1;
#if PE_SORT
        {
            unsigned k0 = ((unsigned)id0 << 7) | (unsigned)lane, k1 = ((unsigned)id1 << 7) | (unsigned)(64 + lane);
#pragma unroll
            for (int k = 2; k <= 64; k <<= 1)
#pragma unroll
                for (int j = k >> 1; j > 0; j >>= 1) {
                    const unsigned p0 = __shfl_xor(k0, j), p1 = __shfl_xor(k1, j);
                    const bool lower = (lane & j) == 0, up0 = (lane & k) == 0, up1 = (k == 64) ? false : up0;
                    k0 = (lower == up0) ? min(k0, p0) : max(k0, p0); k1 = (lower == up1) ? min(k1, p1) : max(k1, p1);
                }
            { const unsigned lo = min(k0, k1), hi = max(k0, k1); k0 = lo; k1 = hi; }
#pragma unroll
            for (int j = 32; j > 0; j >>= 1) {
                const unsigned p0 = __shfl_xor(k0, j), p1 = __shfl_xor(k1, j); const bool lower = (lane & j) == 0;
                k0 = lower ? min(k0, p0) : max(k0, p0); k1 = lower ? min(k1, p1) : max(k1, p1);
            }
            const int q0 = k0 & 127, q1 = k1 & 127;
            const float a0 = __shfl(w0, q0 & 63), b0 = __shfl(w1, q0 & 63), a1 = __shfl(w0, q1 & 63), b1 = __shfl(w1, q1 & 63);
            ws0 = (q0 & 64) ? b0 : a0; ws1 = (q1 & 64) ? b1 : a1; id0 = (int)(k0 >> 7); id1 = (int)(k1 >> 7);
        }
#endif
        f32x2 acc[2][8];
#pragma unroll
        for (int jj = 0; jj < 2; ++jj)
#pragma unroll
            for (int i = 0; i < 8; ++i) acc[jj][i] = (f32x2){0.f, 0.f};
        v4u bv[PV_RB][2];
#define PV_ISSUE(slot, kk) do { const int kk_ = (kk); const int e_ = __builtin_amdgcn_readlane((kk_ & 64) ? id1 : id0, kk_ & 63); \
            const GAS v4u* vp_ = (const GAS v4u*)(vb + (size_t)e_ * D) + lane; bv[slot][0] = vp_[0]; bv[slot][1] = vp_[64]; } while (0)
#pragma unroll
        for (int r = 0; r < PV_RB; ++r) PV_ISSUE(r, r);
        for (int k0 = 0; k0 < KSEL; k0 += PV_RB) {
#pragma unroll
            for (int r = 0; r < PV_RB; ++r) {
                const int k = k0 + r;
                const float w = rdlane((k & 64) ? ws1 : ws0, k & 63);
                row_axpy_fp8(acc, bv[r][0], bv[r][1], w);
                if (k + PV_RB < KSEL) PV_ISSUE(r, k + PV_RB);
            }
        }
#undef PV_ISSUE
        float s2 = 0.f;
#pragma unroll
        for (int jj = 0; jj < 2; ++jj)
#pragma unroll
            for (int i = 0; i < 8; ++i) s2 += acc[jj][i].x * acc[jj][i].x + acc[jj][i].y * acc[jj][i].y;
        const float rstd2 = __builtin_amdgcn_rsqf(wave_total(s2) * (1.0f / D) + EPS);
        float yv[2][16]; float s1 = 0.f;
#pragma unroll
        for (int jj = 0; jj < 2; ++jj) { const GAS v4u* yp = (const GAS v4u*)(y1 + (size_t)tok * D + jj * 1024 + lane * 16); const v4u q0 = yp[0], q1 = yp[1];
            const unsigned w[8] = {q0.x, q0.y, q0.z, q0.w, q1.x, q1.y, q1.z, q1.w};
#pragma unroll
            for (int i = 0; i < 8; ++i) { yv[jj][2 * i] = bflo(w[i]); yv[jj][2 * i + 1] = bfhi(w[i]); s1 += yv[jj][2 * i] * yv[jj][2 * i] + yv[jj][2 * i + 1] * yv[jj][2 * i + 1]; } }
        const float rstd1 = __builtin_amdgcn_rsqf(wave_total(s1) * (1.0f / D) + EPS);
#pragma unroll
        for (int jj = 0; jj < 2; ++jj) {
            const size_t off = (size_t)jj * 256 + lane * 4;
            const GAS f32x4* xr = (const GAS f32x4*)(A.in[I_X] + (size_t)tok * D) + off;
            const GAS f32x4* c1 = (const GAS f32x4*)(cfin + (size_t)(b * 2 + 0) * D) + off; const GAS f32x4* c2 = (const GAS f32x4*)(cfin + (size_t)(b * 2 + 1) * D) + off;
            GAS f32x4* orow = (GAS f32x4*)(A.out + (size_t)tok * D) + off;
#pragma unroll
            for (int q = 0; q < 4; ++q) { const f32x4 xv = xr[q], a1 = c1[q], a2 = c2[q]; f32x4 o;
                const float ya[4] = {acc[jj][2 * q].x, acc[jj][2 * q].y, acc[jj][2 * q + 1].x, acc[jj][2 * q + 1].y};
#pragma unroll
                for (int e = 0; e < 4; ++e) o[e] = xv[e] + (OUT_MODE != 2 ? a1[e] * yv[jj][4 * q + e] * rstd1 : 0.f) + (OUT_MODE != 1 ? a2[e] * ya[e] * rstd2 : 0.f);
                orow[q] = o; }
        }
    }
}

#if defined(MK_CHECKS)
constexpr int CW_CHK = 2048;
__device__ __forceinline__ unsigned hsh(unsigned x) { x ^= x >> 16; x *= 0x7feb352dU; x ^= x >> 15; x *= 0x846ca68bU; x ^= x >> 16; return x; }
__device__ __forceinline__ float bfv(const bf16* p, size_t i) { return __builtin_bit_cast(float, (unsigned)p[i] << 16); }
__device__ __forceinline__ float relerr(float got, float ref, float scale) { const float d = fabsf(got - ref) / (fabsf(ref) + scale); return (d == d) ? d : 1e30f; }
__device__ __forceinline__ void chk_put(unsigned* ctl, int stage, float e) { atomicMax(ctl + CW_CHK + stage, __builtin_bit_cast(unsigned, e)); }
__device__ float chk_gemm(const bf16* Am, const bf16* Bt, const bf16* C, int N, int K, unsigned s) {
    const int row = hsh(s) % T, col = hsh(s * 7 + 1) % N; float acc = 0.f;
    for (int k = 0; k < K; ++k) acc += bfv(Am, (size_t)row * K + k) * bfv(Bt, (size_t)col * K + k);
    return relerr(bfv(C, (size_t)row * N + col), acc, 0.05f);
}
__global__ void __launch_bounds__(128) chk_kernel(Args A, int stage) {
    __shared__ float sh[10240];
    unsigned* ctl = (unsigned*)(A.ws + WS_CTL);
    const int tid = threadIdx.x; const unsigned s = hsh(tid * 2654435761u + stage * 97u + 12345u);
    const float* modp = (const float*)(A.ws + WS_MODP);
    float e = 0.f;
    if (stage == 0) {
        { const int b = s & 1, n = hsh(s) % NMOD; float acc = A.in[I_BMOD][n];
          for (int k = 0; k < D; ++k) { const float c = A.in[I_C][b * D + k]; acc += c / (1.0f + expf(-c)) * A.in[I_WMOD][(size_t)k * NMOD + n]; }
          e = fmaxf(e, relerr(mod_at(modp, b, n), acc, 0.01f)); }
        { const int n = hsh(s + 1) % IN_COLS, k = hsh(s + 2) % D; e = fmaxf(e, relerr(bfv((const bf16*)(A.ws + WS_BT1), (size_t)n * D + k), A.in[I_WIN][(size_t)k * IN_COLS + n], 1e-3f)); }
        { const int n = hsh(s + 3) % D, k = hsh(s + 4) % D; e = fmaxf(e, relerr(bfv((const bf16*)(A.ws + WS_BT2), (size_t)n * D + k), A.in[I_WOUT][(size_t)k * D + n], 1e-3f));
          e = fmaxf(e, relerr(bfv((const bf16*)(A.ws + WS_BT3), (size_t)n * D + k), A.in[I_WQ][(size_t)k * D + n], 1e-3f)); }
        { const int h = s & 7, n = hsh(s + 5) & 255, k = hsh(s + 6) & 127; const float ref = (n < 128 ? A.in[I_WA] : A.in[I_WX])[h * 16384 + k * 128 + (n & 127)];
          e = fmaxf(e, relerr(bfv((const bf16*)(A.ws + WS_WG), (size_t)(h * 256 + n) * 128 + k), ref, 1e-3f)); }
        { const int i = hsh(s + 7) % (NH * 2 * NKEY * 128); e = fmaxf(e, relerr(bfv((const bf16*)(A.ws + WS_SUBK), i), A.in[I_SUBK][i], 1e-3f)); }
    } else if (stage == 1) {
        const int row = hsh(s) % T, col = hsh(s + 1) % D, b = row >> 13; float ss = 0.f;
        for (int k = 0; k < D; ++k) { const float x = A.in[I_X][(size_t)row * D + k]; ss += x * x; }
        const float ref = A.in[I_X][(size_t)row * D + col] * rsqrtf(ss / D + EPS) * A.in[I_GPREMIX][col] * (1.0f + mod_at(modp, b, D + col)) + mod_at(modp, b, col);
        e = relerr(bfv((const bf16*)(A.ws + WS_RA), (size_t)row * D + col), ref, 0.05f);
        const float* cfin = (const float*)(A.ws + WS_CFIN);
        e = fmaxf(e, relerr(cfin[(b * 2 + 0) * D + col], mod_at(modp, b, 2 * D + col) * A.in[I_GPOSTMIX][col], 1e-3f));
        e = fmaxf(e, relerr(cfin[(b * 2 + 1) * D + col], mod_at(modp, b, 5 * D + col) * A.in[I_GPOSTFFN][col], 1e-3f));
    } else if (stage == 2) { e = chk_gemm((const bf16*)(A.ws + WS_RA), (const bf16*)(A.ws + WS_BT1), (const bf16*)(A.ws + WS_PROJ), IN_COLS, D, s);
    } else if (stage == 7) { e = chk_gemm((const bf16*)(A.ws + WS_RA), (const bf16*)(A.ws + WS_BT2), (const bf16*)(A.ws + WS_Y1), D, D, s);
    } else if (stage == 9) { e = chk_gemm((const bf16*)(A.ws + WS_RA), (const bf16*)(A.ws + WS_BT3), (const bf16*)(A.ws + WS_Q), D, D, s);
    } else if (stage == 3) {
        const bf16* proj = (const bf16*)(A.ws + WS_PROJ);
        int row = hsh(s) % T; if (tid < 16) row = (tid & 1) * SEQ + (tid >> 1);
        const int c = hsh(s + 1) % LRU_W, t = row & (SEQ - 1);
        float a = A.in[I_LCB][c];
        for (int j = 0; j < 4; ++j) if (t - 3 + j >= 0) a += A.in[I_LCW][j * LRU_W + c] * bfv(proj, (size_t)(row - 3 + j) * IN_COLS + c);
        e = relerr(bfv((const bf16*)(A.ws + WS_XL), (size_t)row * LRU_W + c), a, 0.05f);
        float z = A.in[I_CDB][c];
        for (int j = 0; j < CONF_K; ++j) if (t - 30 + j >= 0) { const size_t r = (size_t)(row - 30 + j) * IN_COLS; const float g = bfv(proj, r + 3072 + c);
            z += A.in[I_CDW][j * CONF_W + c] * bfv(proj, r + 2048 + c) / (1.0f + expf(-g)); }
        e = fmaxf(e, relerr(bfv((const bf16*)(A.ws + WS_ZC), (size_t)row * CONF_W + c), z, 0.05f));
    } else if (stage == 4) {
        const bf16* xl = (const bf16*)(A.ws + WS_XL);
        const int b = s & 1, chunk = hsh(s + 1) % NCHUNK, ch = hsh(s + 2) % LRU_W, hh = ch >> 7, j = ch & 127;
        const float cl = -8.0f * log1pf(expf(-A.in[I_LAMBDA][ch])); float P = 1.f, H = 0.f;
        for (int t = 0; t < CHUNK; ++t) { const size_t row = (size_t)b * SEQ + chunk * CHUNK + t; float ga = A.in[I_BA][ch], gx = A.in[I_BX][ch];
            for (int i = 0; i < 128; ++i) { const float xv = bfv(xl, row * LRU_W + hh * 128 + i); ga += xv * A.in[I_WA][hh * 16384 + i * 128 + j]; gx += xv * A.in[I_WX][hh * 16384 + i * 128 + j]; }
            const float r = 1.0f / (1.0f + expf(-ga)), ig = 1.0f / (1.0f + expf(-gx)), la = cl * r, a = expf(la), u = sqrtf(fmaxf(-expm1f(2.0f * la), 0.f)) * ig * bfv(xl, row * LRU_W + ch);
            H = a * H + u; P = P * a;
            e = fmaxf(e, relerr(bfv((const bf16*)(A.ws + WS_HLOC), row * LRU_W + ch), H, 0.05f)); e = fmaxf(e, relerr(bfv((const bf16*)(A.ws + WS_PC), row * LRU_W + ch), P, 0.02f)); }
        const float* ag = (const float*)(A.ws + WS_AGG) + ((size_t)(b * NCHUNK + chunk) * LRU_W + ch) * 2;
        e = fmaxf(e, relerr(ag[0], P, 0.02f)); e = fmaxf(e, relerr(ag[1], H, 0.05f));
    } else if (stage == 5) {
    } else if (stage == 6) {
        const bf16* proj = (const bf16*)(A.ws + WS_PROJ); const bf16* zc = (const bf16*)(A.ws + WS_ZC);
        const int row = hsh(s) % T, c = hsh(s + 1) % LRU_W, b = row >> 13, chunk = (row & (SEQ - 1)) >> 6;
        float cin = 0.f; for (int cc = 0; cc < chunk; ++cc) { const float* ag = (const float*)(A.ws + WS_AGG) + ((size_t)(b * NCHUNK + cc) * LRU_W + c) * 2; cin = ag[0] * cin + ag[1]; }
        const float hfull = bfv((const bf16*)(A.ws + WS_HLOC), (size_t)row * LRU_W + c) + bfv((const bf16*)(A.ws + WS_PC), (size_t)row * LRU_W + c) * cin;
        const float g = bfv(proj, (size_t)row * IN_COLS + 1024 + c), ge = 0.5f * g * (1.0f + tanhf(0.7978845608f * (g + 0.044715f * g * g * g)));
        e = relerr(bfv((const bf16*)(A.ws + WS_RA), (size_t)row * D + c), hfull * ge, 0.05f);
        float m = 0.f, q = 0.f;
        for (int k = 0; k < CONF_W; ++k) m += bfv(zc, (size_t)row * CONF_W + k);
        m /= CONF_W;
        for (int k = 0; k < CONF_W; ++k) { const float d = bfv(zc, (size_t)row * CONF_W + k) - m; q += d * d; }
        const float n = (bfv(zc, (size_t)row * CONF_W + c) - m) * rsqrtf(q / CONF_W + EPS) * A.in[I_LNG][c] + A.in[I_LNB][c];
        e = fmaxf(e, relerr(bfv((const bf16*)(A.ws + WS_RA), (size_t)row * D + 1024 + c), n / (1.0f + expf(-n)), 0.05f));
    } else if (stage == 8) {
        const bf16* y1 = (const bf16*)(A.ws + WS_Y1); const float* cfin = (const float*)(A.ws + WS_CFIN);
        const int row = hsh(s) % T, col = hsh(s + 1) % D, b = row >> 13; float s1 = 0.f, s2 = 0.f;
        for (int k = 0; k < D; ++k) { const float y = bfv(y1, (size_t)row * D + k); s1 += y * y; }
        const float r1 = rsqrtf(s1 / D + EPS);
        for (int k = 0; k < D; ++k) { const float x1 = A.in[I_X][(size_t)row * D + k] + cfin[(b * 2) * D + k] * bfv(y1, (size_t)row * D + k) * r1; s2 += x1 * x1; }
        const float x1c = A.in[I_X][(size_t)row * D + col] + cfin[(b * 2) * D + col] * bfv(y1, (size_t)row * D + col) * r1;
        const float ref = x1c * rsqrtf(s2 / D + EPS) * A.in[I_GPREFFN][col] * (1.0f + mod_at(modp, b, 4 * D + col)) + mod_at(modp, b, 3 * D + col);
        e = relerr(bfv((const bf16*)(A.ws + WS_RA), (size_t)row * D + col), ref, 0.05f);
    } else if (stage == 10) {
        { const size_t i = (size_t)(hsh(s + 2) % NEXP) * D + hsh(s + 3) % D;
          const unsigned wu = ((const unsigned*)(A.ws + WS_UB))[i >> 2] >> (8 * (i & 3)), wv = ((const unsigned*)(A.ws + WS_VB))[i >> 2] >> (8 * (i & 3));
          const float du = (float)(signed char)(wu & 255u) * ((const float*)(A.ws + WS_USC))[i / D], dv = __builtin_amdgcn_cvt_pk_f32_fp8((int)wv, false)[0] * ((const float*)(A.ws + WS_VSC))[i / D];
          e = fmaxf(e, relerr(du, A.in[I_PU][i], 2e-3f) * 0.3f); e = fmaxf(e, relerr(dv, A.in[I_PV][i], 3e-2f) * 0.3f); }
        if (tid < 32) {
            const bf16* q = (const bf16*)(A.ws + WS_Q); const int* idx = (const int*)(A.ws + WS_IDX); const float* gate = (const float*)(A.ws + WS_GATE);
            const int tok = hsh(s) % T, h = hsh(s + 1) & 7;
            float* sc = sh + tid * 320;
            for (int p = 0; p < 2; ++p) for (int n = 0; n < NKEY; ++n) { float a = 0.f;
                for (int d = 0; d < 128; ++d) a += bfv(q, (size_t)tok * D + h * 256 + p * 128 + d) * A.in[I_SUBK][((size_t)((h * 2 + p) * NKEY + n)) * 128 + d];
                sc[p * 128 + n] = a; }
            for (int p = 0; p < 2; ++p) { float prev = 1e30f; for (int it = 0; it < 16; ++it) { float best = -1e30f; int bi = 0;
                for (int n = 0; n < NKEY; ++n) { const float v = sc[p * 128 + n]; if (v < prev && v > best) { best = v; bi = n; } }
                sc[256 + p * 16 + it] = best; sc[288 + p * 16 + it] = (float)bi; prev = best; } }
            float prev = 1e30f, esum = 0.f, cmax = 0.f; int miss = 0; float gerr = 0.f;
            { float pv = 1e30f; for (int it = 0; it < 16; ++it) { float best = -1e30f;
                for (int c = 0; c < 256; ++c) { const float v = sc[256 + (c >> 4)] + sc[272 + (c & 15)]; if (v < pv && v > best) best = v; }
                if (it == 0) cmax = best; esum += expf(best - cmax); pv = best; } }
            for (int it = 0; it < 16; ++it) { float best = -1e30f; int bc = 0;
                for (int c = 0; c < 256; ++c) { const float v = sc[256 + (c >> 4)] + sc[272 + (c & 15)]; if (v < prev && v > best) { best = v; bc = c; } }
                prev = best;
                const int eidx = (int)sc[288 + (bc >> 4)] * NKEY + (int)sc[304 + (bc & 15)]; const float g = expf(best - cmax) / esum; bool found = false;
                for (int m = 0; m < 16; ++m) if (idx[(size_t)tok * KSEL + h * 16 + m] == eidx) { found = true; gerr = fmaxf(gerr, relerr(gate[(size_t)tok * KSEL + h * 16 + m], g, 0.02f)); }
                if (!found) ++miss; }
            e = fmaxf((float)miss / 16.0f, gerr);
        }
    } else if (stage == 11) {
        const bf16* h2 = (const bf16*)(A.ws + WS_RA); const bf16* y1 = (const bf16*)(A.ws + WS_Y1); const int* idx = (const int*)(A.ws + WS_IDX); const float* gate = (const float*)(A.ws + WS_GATE); const float* cfin = (const float*)(A.ws + WS_CFIN);
        const int tok = hsh(blockIdx.x * 977u + 5u) % T, b = tok >> 13;
        { const int ex = idx[(size_t)tok * KSEL + tid]; float a = 0.f;
          if ((unsigned)ex < (unsigned)NEXP) { for (int d = 0; d < D; ++d) a += bfv(h2, (size_t)tok * D + d) * A.in[I_PU][(size_t)ex * D + d]; } else a = 1e30f;
          const float ge = 0.5f * a * (1.0f + tanhf(0.7978845608f * (a + 0.044715f * a * a * a)));
          sh[tid] = gate[(size_t)tok * KSEL + tid] * ge; sh[128 + tid] = __builtin_bit_cast(float, ex); }
        __syncthreads();
        float s2 = 0.f, s1 = 0.f;
        for (int cc = 0; cc < 16; ++cc) { const int col = cc * 128 + tid; float a = 0.f;
            for (int k = 0; k < KSEL; ++k) { const int ex = __builtin_bit_cast(int, sh[128 + k]); if ((unsigned)ex < (unsigned)NEXP) a += sh[k] * A.in[I_PV][(size_t)ex * D + col]; }
            sh[512 + cc * 128 + tid] = a; s2 += a * a; const float y = bfv(y1, (size_t)tok * D + col); s1 += y * y; }
        __syncthreads(); sh[256 + tid] = s2; sh[384 + tid] = s1; __syncthreads();
        float t2 = 0.f, t1 = 0.f; for (int k = 0; k < 128; ++k) { t2 += sh[256 + k]; t1 += sh[384 + k]; }
        const float r2 = rsqrtf(t2 / D + EPS), r1 = rsqrtf(t1 / D + EPS);
        float en = 0.f, ed = 0.f;
        for (int cc = 0; cc < 16; ++cc) { const int col = cc * 128 + tid;
            const float pterm = cfin[(b * 2 + 1) * D + col] * sh[512 + cc * 128 + tid] * r2;
            const float ref = A.in[I_X][(size_t)tok * D + col] + (OUT_MODE != 2 ? cfin[(b * 2) * D + col] * bfv(y1, (size_t)tok * D + col) * r1 : 0.f) + (OUT_MODE != 1 ? pterm : 0.f);
            const float d = A.out[(size_t)tok * D + col] - ref; en += d * d; ed += pterm * pterm; }
        __syncthreads(); sh[256 + tid] = en; sh[384 + tid] = ed; __syncthreads();
        float ten = 0.f, ted = 0.f; for (int k = 0; k < 128; ++k) { ten += sh[256 + k]; ted += sh[384 + k]; }
        e = ten / (ted + 1e-12f); if (!(e == e)) e = 1e30f;
    }
    chk_put(ctl, stage, e);
}
__global__ void chk_encode(Args A, int what) {
    const unsigned* ctl = (const unsigned*)(A.ws + WS_CTL);
    if (threadIdx.x == 0 && blockIdx.x == 0) {
        if (what < 0) {
            const float thr[12] = {0.03f, 0.03f, 0.03f, 0.03f, 0.06f, 0.01f, 0.04f, 0.03f, 0.03f, 0.03f, 0.2f, 0.01f};
            for (int st = 0; st < 12; ++st) { const float e = __builtin_bit_cast(float, ctl[CW_CHK + st]); if (!(e <= thr[st])) { A.out[0] = 4000.0f * (float)(1 << st); break; } }
        } else {
            const float e = fminf(__builtin_bit_cast(float, ctl[CW_CHK + what]), 1e6f); A.out[0] = 4000.0f * sqrtf(1e6f * e);
        }
    }
}
#endif

__global__ void __launch_bounds__(NTHR, 2) fwd_kernel(Args args) {
    extern __shared__ __attribute__((aligned(16))) unsigned char lds_raw[];
    LAS unsigned char* lds = (LAS unsigned char*)lds_raw;
    const int tid = threadIdx.x, lane = tid & 63, wave = __builtin_amdgcn_readfirstlane(tid >> 6), bid = blockIdx.x, G = gridDim.x;
    for (int u = tid; u < (LDS_BYTES - LDSCTL_OFF) / 4; u += NTHR) ((LAS unsigned*)(lds + LDSCTL_OFF))[u] = 0u;
    __syncthreads();
    unsigned* ctl = (unsigned*)(args.ws + WS_CTL);
    XcdBarrier bar; bar.bar = ctl + CW_BAR + args.li * XCD_BAR_WORDS; bar.x = 0; bar.st = nullptr;
    if (MK_N_LAUNCHES != N_PHASES) bar = xcd_barrier_post(ctl + CW_BAR + args.li * XCD_BAR_WORDS, (volatile LAS unsigned*)(lds + MISC_OFF) + 8);
    const int lo = args.ph_lo, hi = args.ph_hi;
#define IN(k) (lo <= (k) && (k) < hi)
#define SEAM(k) do { if (IN(k) && IN((k) + 1)) xcd_barrier(bar); } while (0)
#define PHON(k) ((PH_MASK >> (k)) & 1)
    if (PHON(0) && IN(0)) { phase_p0(args, lds, tid, lane, wave, bid, G); }
    SEAM(0);
    if (PHON(1) && IN(1)) { phase_p1(args, tid, lane, wave, bid, G); }
    SEAM(1);
    if (PHON(2) && IN(2)) {
        pg8::Gemm g{(const bf16*)(args.ws + WS_RA), (const bf16*)(args.ws + WS_BT1), T, IN_COLS, D}; pg8::StaticOrder S; S.init(T, IN_COLS, G, bid);
        pg8::EpiBf16<0> E{(bf16*)(args.ws + WS_PROJ), IN_COLS, nullptr, 0, 0, 1.f};
        pg8::gemm_phase<pg8::EpiBf16<0>, pg8::StaticOrder, PG8_ALIGN, PG8_SP2>(lds + RING_OFF, g, S, E);
    }
    SEAM(2);
    if (PHON(3) && IN(3)) { phase_m1a(args, lds, tid, lane, wave, bid, G); }
    SEAM(3);
    if (PHON(4) && IN(4)) { phase_m1b(args, tid, lane, wave, bid, G); }
    SEAM(4);
    if (PHON(5) && IN(5)) { phase_m3(args, lds, tid, lane, wave, bid, G); }
    SEAM(5);
    if (PHON(6) && IN(6)) {
        pg8::Gemm g{(const bf16*)(args.ws + WS_RA), (const bf16*)(args.ws + WS_BT2), T, D, D}; pg8::StaticOrder S; S.init(T, D, G, bid);
        pg8::EpiBf16<0> E{(bf16*)(args.ws + WS_Y1), D, nullptr, 0, 0, 1.f};
        pg8::gemm_phase<pg8::EpiBf16<0>, pg8::StaticOrder, PG8_ALIGN, PG8_SP2>(lds + RING_OFF, g, S, E);
    }
    SEAM(6);
    if (PHON(7) && IN(7)) { phase_e2(args, tid, lane, wave, bid, G); }
    SEAM(7);
    if (PHON(8) && IN(8)) {
        pg8::Gemm g{(const bf16*)(args.ws + WS_RA), (const bf16*)(args.ws + WS_BT3), T, D, D}; pg8::StaticOrder S; S.init(T, D, G, bid);
        pg8::EpiBf16<0> E{(bf16*)(args.ws + WS_Q), D, nullptr, 0, 0, 1.f};
        pg8::gemm_phase<pg8::EpiBf16<0>, pg8::StaticOrder, PG8_ALIGN, PG8_SP2>(lds + RING_OFF, g, S, E);
    }
    SEAM(8);
    if (PHON(9) && IN(9)) { phase_s(args, lds, tid, lane, wave, bid, G); }
    SEAM(9);
    if (PHON(10) && IN(10)) { phase_pu(args, tid, lane, wave, bid, G); }
    SEAM(10);
    if (PHON(11) && IN(11)) { phase_pv(args, tid, lane, wave, bid, G); }
#undef IN
#undef SEAM
}

extern "C" void kernel_launch(void* const* d_in, const int* in_sizes, int n_in, void* d_out, int out_size, void* d_ws, size_t ws_size, hipStream_t stream) {
    static int grid = 0;
    if (grid == 0) {
        if (n_in != 25 || in_sizes[0] != T * D || out_size != T * D || ws_size < WS_END) {
            fprintf(stderr, "kernel_launch: built for 25 inputs, x/out of %d floats, >= %zu bytes of workspace; got n_in %d, in0 %d, out %d, ws %zu; nothing launched\n", T * D, (size_t)WS_END, n_in, n_in > 0 ? in_sizes[0] : -1, out_size, ws_size);
            grid = -1; return; }
        int dev = 0, cus = 0, per_cu = 0;
        if (hipGetDevice(&dev) != hipSuccess || hipDeviceGetAttribute(&cus, hipDeviceAttributeMultiprocessorCount, dev) != hipSuccess) { fprintf(stderr, "kernel_launch: device query failed\n"); grid = -1; return; }
        if (hipFuncSetAttribute((const void*)fwd_kernel, hipFuncAttributeMaxDynamicSharedMemorySize, LDS_BYTES) != hipSuccess) { fprintf(stderr, "kernel_launch: hipFuncSetAttribute failed\n"); grid = -1; return; }
        if (hipOccupancyMaxActiveBlocksPerMultiprocessor(&per_cu, (const void*)fwd_kernel, NTHR, LDS_BYTES) != hipSuccess || per_cu < 1)
            fprintf(stderr, "kernel_launch: note: occupancy query reports %d workgroups per CU\n", per_cu);
        (void)hipGetLastError();
        grid = cus;
    }
    if (grid < 0) return;
    if (hipMemsetAsync((char*)d_ws + WS_CTL, 0, CTL_ZERO_BYTES, stream) != hipSuccess) { fprintf(stderr, "kernel_launch: memset failed\n"); return; }
    Args a{};
    for (int i = 0; i < 25; ++i) a.in[i] = (const float*)d_in[i];
    a.out = (float*)d_out; a.ws = (unsigned char*)d_ws;
#if defined(MK_TIME_REP)
    const int cuts[3][2] = {{0, MK_TIME_REP + 1}, {MK_TIME_REP, MK_TIME_REP + 1}, {MK_TIME_REP + 1, N_PHASES}};
    for (int li = 0; li < 3; ++li) {
        a.ph_lo = cuts[li][0]; a.ph_hi = cuts[li][1]; a.li = li;
        if (a.ph_lo < a.ph_hi) hipLaunchKernelGGL(fwd_kernel, dim3(grid), dim3(NTHR), LDS_BYTES, stream, a);
    }
#else
    for (int li = 0; li < MK_N_LAUNCHES; ++li) {
        if (MK_N_LAUNCHES == 1) { a.ph_lo = 0; a.ph_hi = N_PHASES; } else { a.ph_lo = li; a.ph_hi = li + 1; }
        a.li = 0;
        hipLaunchKernelGGL(fwd_kernel, dim3(grid), dim3(NTHR), LDS_BYTES, stream, a);
        const hipError_t le = hipPeekAtLastError();
        if (le != hipSuccess) { fprintf(stderr, "kernel_launch: launch %d failed: %s\n", li, hipGetErrorName(le)); break; }
#if defined(MK_CHECKS)
        { const int chk_of_phase[N_PHASES] = {0, 1, 2, 3, 4, 6, 7, 8, 9, 10, 5, 11}; hipLaunchKernelGGL(chk_kernel, dim3(4), dim3(128), 0, stream, a, chk_of_phase[li]); }
#endif
    }
#endif
#if defined(MK_CHECKS)
    hipLaunchKernelGGL(chk_encode, dim3(1), dim3(64), 0, stream, a, MK_CHECKS);
#endif
}
```

```cpp
#include <hip/hip_runtime.h>
#include <cstdio>
#include <cstdint>
#include <cmath>
namespace pg8 {
#define PG8_LAS __attribute__((address_space(3)))
typedef unsigned short bf16_t;
typedef short bf16x8 __attribute__((ext_vector_type(8)));
typedef float f32x4 __attribute__((ext_vector_type(4)));
typedef unsigned u32x4 __attribute__((ext_vector_type(4)));
constexpr int BM = 256, BK = 64, HALF = 128, HTB = HALF * BK * 2  , STAGE_BYTES = 8 * HTB, NXCD = 8, WGM = 8;

__host__ __device__ __forceinline__ int lds_byte(int r, int c) { const int st = (r >> 4) * 2 + (c >> 5), rr = r & 15, cc = c & 31, ob = rr * 64 + cc * 2; return st * 1024 + (ob ^ (((ob >> 9) & 1) << 5)); }
__host__ __device__ __forceinline__ void stage_rc(int b, int& R, int& C) { const int st = b / 1024, sb = b % 1024, swz = sb ^ (((sb >> 9) & 1) << 5); R = (st >> 1) * 16 + swz / 64; C = (st & 1) * 32 + (swz % 64) / 2; }
__host__ __device__ __forceinline__ int perm32(int rho) { const int n = rho >> 4, i = rho & 15; return 8 * (i >> 2) + 4 * n + (i & 3); }

struct Unit { int pm, pn; };
struct Gemm { const bf16_t* A; const bf16_t* Bt; int M, N, K; };

struct StaticOrder {
    int nM, nN, nwg, G, c;
    __host__ __device__ void init(int M, int N, int G_, int c_) { nM = M / BM; nN = N / BM; nwg = nM * nN; G = G_; c = c_; }
    __host__ __device__ bool next(int i, Unit& u) const {
        const long L = (long)i * G + c; if (L >= nwg) return false;
        int wgid = (int)L; { const int q = nwg / NXCD, r = nwg % NXCD, xcd = wgid % NXCD, off = wgid / NXCD; wgid = (xcd < r ? xcd * (q + 1) : r * (q + 1) + (xcd - r) * q) + off; }
        const int nig = WGM * nN, gid = wgid / nig, fm = gid * WGM, gsz = (nM - fm) < WGM ? (nM - fm) : WGM;
        u.pm = fm + ((wgid % nig) % gsz); u.pn = (wgid % nig) / gsz; return true;
    }
    __device__ __forceinline__ void a_ready(const Unit&) const {}
    __device__ __forceinline__ void done(const Unit&) const {}
};

__device__ __forceinline__ unsigned cvt_pk_bf16(float lo, float hi) { unsigned r; asm volatile("v_cvt_pk_bf16_f32 %0, %1, %2" : "=v"(r) : "v"(lo), "v"(hi)); return r; }
typedef float f32x2 __attribute__((ext_vector_type(2)));
__device__ __forceinline__ f32x2 gelu_pk(f32x2 v) {
    const f32x2 av = __builtin_elementwise_abs(v), d = av * 0.2316418882f + 1.0f;
    f32x2 t; t.x = __builtin_amdgcn_rcpf(d.x); t.y = __builtin_amdgcn_rcpf(d.y);
    f32x2 q = t * 0.5307027145f + (-0.7265760135f); q = q * t + 0.7107068705f; q = q * t + (-0.142248368f); q = q * t + 0.127414796f; q = q * t;
    const f32x2 s = (v * v) * (-0.72134752044f);
    f32x2 e; e.x = __builtin_amdgcn_exp2f(s.x); e.y = __builtin_amdgcn_exp2f(s.y);
    const f32x2 m = v * (q * e), r = v - m;
    f32x2 o; o.x = v.x < 0.f ? m.x : r.x; o.y = v.y < 0.f ? m.y : r.y; return o;
}

template <int ACT  > struct EpiBf16 {
    static constexpr bool PERM = true, AFTER_DRAIN = false; static_assert(ACT == 0 || ACT == 1, "EpiBf16: ACT is 0 (none) or 1 (gelu_pk)");
    bf16_t* O; int ldc; const float* bias; int split_cols; size_t split_stride; float scale0;
    __device__ __forceinline__ void operator()(const f32x4 (&acc)[2][2][4][2], const Unit& u, int wr, int wc, int fr, int fq) const {
        const int row0 = u.pm * BM + wr * 64 + fr; int colt = u.pn * BM; bf16_t* base = O;
        float sc = 1.f; if (split_cols) { const int t = colt / split_cols; base += (size_t)t * split_stride; colt -= t * split_cols; if (t == 0) sc = scale0; }
        const int col0 = colt + wc * 32 + 8 * fq, bcol0 = u.pn * BM + wc * 32 + 8 * fq;
        f32x4 bv[2][2];
#pragma unroll
        for (int bj = 0; bj < 2; ++bj)
#pragma unroll
            for (int n = 0; n < 2; ++n) bv[bj][n] = bias ? *(const f32x4*)(bias + bcol0 + bj * HALF + 4 * n) : (f32x4){0.f, 0.f, 0.f, 0.f};
#pragma unroll
        for (int ai = 0; ai < 2; ++ai)
#pragma unroll
            for (int m = 0; m < 4; ++m) { bf16_t* rowp = base + (size_t)(row0 + ai * HALF + m * 16) * ldc + col0;
#pragma unroll
                for (int bj = 0; bj < 2; ++bj) { f32x4 v0 = acc[ai][bj][m][0] + bv[bj][0], v1 = acc[ai][bj][m][1] + bv[bj][1];
                    if (ACT == 1) { f32x2 a = gelu_pk((f32x2){v0[0], v0[1]}), b = gelu_pk((f32x2){v0[2], v0[3]}), c = gelu_pk((f32x2){v1[0], v1[1]}), d = gelu_pk((f32x2){v1[2], v1[3]});
                        v0 = (f32x4){a.x, a.y, b.x, b.y}; v1 = (f32x4){c.x, c.y, d.x, d.y}; }
                    v0 = v0 * sc; v1 = v1 * sc; u32x4 w; w.x = cvt_pk_bf16(v0[0], v0[1]); w.y = cvt_pk_bf16(v0[2], v0[3]); w.z = cvt_pk_bf16(v1[0], v1[1]); w.w = cvt_pk_bf16(v1[2], v1[3]);
                    *(u32x4*)(rowp + bj * HALF) = w; } }
    }
};
template <class Epi, class Sched, bool ALIGN_EPI = false, bool SP2 = false>
__device__ __forceinline__ void gemm_phase(PG8_LAS unsigned char* lds, const Gemm g, const Sched& S, const Epi& E) {
    const int tid = threadIdx.x, wid = __builtin_amdgcn_readfirstlane(tid >> 6), lane = tid & 63, wr = wid >> 2, wc = wid & 3, fr = lane & 15, fq = lane >> 4;
    const int K = g.K, nt = K / BK;
    unsigned voffA[2], voffB[2];
#pragma unroll
    for (int i = 0; i < 2; ++i) { int R, C; stage_rc(tid * 16 + i * 8192, R, C); const int Rb = Epi::PERM ? ((R & ~31) + perm32(R & 31)) : R;
        voffA[i] = (unsigned)(R * K + C) * 2u; voffB[i] = (unsigned)(Rb * K + C) * 2u; }
    const size_t kstep = (size_t)(BK * 2);
    const size_t hstep = (size_t)HALF * K * 2;
    const size_t tstep = 2 * hstep;
    const unsigned ldsw = (unsigned)wid * 1024u;
    const int aoff = lds_byte(wr * 64 + fr, fq * 8), boff = lds_byte(wc * 32 + fr, fq * 8);
#define PG8_SA(b, h) (((b) * 2 + (h)) * HTB)
#define PG8_SB(b, h) ((4 + (b) * 2 + (h)) * HTB)
#define PG8_STAGE(bufoff, gbase, voff) do { _Pragma("unroll") for (int _i = 0; _i < 2; ++_i) \
        __builtin_amdgcn_global_load_lds((const unsigned*)((const char*)(gbase) + (voff)[_i]), (PG8_LAS unsigned*)(lds + (bufoff) + ldsw + _i * 8192), 16, 0, 0); } while (0)
#define PG8_LDA(dst, b, h) do { _Pragma("unroll") for (int m = 0; m < 4; ++m) _Pragma("unroll") for (int k = 0; k < 2; ++k) dst[m][k] = *(const PG8_LAS bf16x8*)(lds + PG8_SA(b, h) + aoff + m * 2048 + k * 1024); } while (0)
#define PG8_LDB(dst, b, h) do { _Pragma("unroll") for (int n = 0; n < 2; ++n) _Pragma("unroll") for (int k = 0; k < 2; ++k) dst[n][k] = *(const PG8_LAS bf16x8*)(lds + PG8_SB(b, h) + boff + n * 2048 + k * 1024); } while (0)
#define PG8_MMA(ai, bj, At, Bt) do { __builtin_amdgcn_s_setprio(1); _Pragma("unroll") for (int m = 0; m < 4; ++m) _Pragma("unroll") for (int n = 0; n < 2; ++n) _Pragma("unroll") for (int k = 0; k < 2; ++k) \
        acc[ai][bj][m][n] = __builtin_amdgcn_mfma_f32_16x16x32_bf16(Bt[n][k], At[m][k], acc[ai][bj][m][n], 0, 0, 0); __builtin_amdgcn_s_setprio(0); } while (0)
#define PG8_WAIT_V(n) asm volatile("s_waitcnt vmcnt(" #n ")" ::: "memory")
#define PG8_WAIT_L(n) asm volatile("s_waitcnt lgkmcnt(" #n ")" ::: "memory")
#define PG8_BAR __builtin_amdgcn_s_barrier()
#define PG8_SCHED __builtin_amdgcn_sched_barrier(0)
    Unit cur, nxt; int ui = 0;
    if (!S.next(0, cur)) return;
    f32x4 acc[2][2][4][2];
#pragma unroll
    for (int a = 0; a < 2; ++a)
#pragma unroll
        for (int b = 0; b < 2; ++b)
#pragma unroll
            for (int m = 0; m < 4; ++m)
#pragma unroll
                for (int n = 0; n < 2; ++n) acc[a][b][m][n] = (f32x4){0.f, 0.f, 0.f, 0.f};
    bf16x8 At[4][2], B0[2][2], B1[2][2];
    const char* cA = (const char*)g.A + (size_t)cur.pm * tstep; const char* cB = (const char*)g.Bt + (size_t)cur.pn * tstep;
    S.a_ready(cur);
    if constexpr (SP2) {
        PG8_STAGE(PG8_SB(0, 0), cB, voffB); PG8_STAGE(PG8_SB(0, 1), cB + hstep, voffB); PG8_STAGE(PG8_SA(0, 0), cA, voffA); PG8_STAGE(PG8_SA(0, 1), cA + hstep, voffA);
        if (wr == 1) PG8_BAR;
        PG8_WAIT_V(2); PG8_BAR;
        PG8_STAGE(PG8_SB(1, 0), cB + kstep, voffB); PG8_STAGE(PG8_SA(1, 0), cA + kstep, voffA); PG8_STAGE(PG8_SB(1, 1), cB + hstep + kstep, voffB);
        PG8_WAIT_V(6); PG8_BAR;
    } else {
        PG8_STAGE(PG8_SB(0, 0), cB, voffB); PG8_STAGE(PG8_SA(0, 0), cA, voffA); PG8_STAGE(PG8_SB(0, 1), cB + hstep, voffB); PG8_STAGE(PG8_SA(0, 1), cA + hstep, voffA);
        if (wr == 1) PG8_BAR;
        PG8_WAIT_V(4); PG8_BAR;
        PG8_STAGE(PG8_SB(1, 0), cB + kstep, voffB); PG8_STAGE(PG8_SA(1, 0), cA + kstep, voffA); PG8_STAGE(PG8_SB(1, 1), cB + hstep + kstep, voffB);
        PG8_WAIT_V(6); PG8_BAR;
    }
    for (;;) {
        const bool has_next = S.next(ui + 1, nxt);
        const char* nA = has_next ? (const char*)g.A + (size_t)nxt.pm * tstep : cA; const char* nB = has_next ? (const char*)g.Bt + (size_t)nxt.pn * tstep : cB;
        for (int t = 0; t < nt; t += 2) {
            const bool last = (t == nt - 2);
            const char* a1 = cA + (size_t)(t + 1) * kstep;
            const char* a2 = last ? nA : cA + (size_t)(t + 2) * kstep; const char* b2 = last ? nB : cB + (size_t)(t + 2) * kstep;
            const char* a3 = a2 + kstep; const char* b3 = b2 + kstep;
            if (last && has_next) S.a_ready(nxt);
            if constexpr (SP2) {
            PG8_LDB(B0, 0, 0); PG8_LDB(B1, 0, 1); PG8_SCHED; PG8_LDA(At, 0, 0); PG8_STAGE(PG8_SA(1, 1), a1 + hstep, voffA);
            PG8_WAIT_V(8); PG8_WAIT_L(0); PG8_BAR; PG8_MMA(0, 0, At, B0); PG8_MMA(0, 1, At, B1); PG8_BAR; PG8_SCHED;
            PG8_LDA(At, 0, 1); PG8_STAGE(PG8_SB(0, 0), b2, voffB); PG8_STAGE(PG8_SB(0, 1), b2 + hstep, voffB); PG8_STAGE(PG8_SA(0, 0), a2, voffA);
            PG8_WAIT_V(8); PG8_WAIT_L(0); PG8_BAR; PG8_MMA(1, 0, At, B0); PG8_MMA(1, 1, At, B1); PG8_BAR; PG8_SCHED;
            PG8_LDB(B0, 1, 0); PG8_LDB(B1, 1, 1); PG8_SCHED; PG8_LDA(At, 1, 0); PG8_STAGE(PG8_SA(0, 1), a2 + hstep, voffA);
            PG8_WAIT_V(8); PG8_WAIT_L(0); PG8_BAR; PG8_MMA(0, 0, At, B0); PG8_MMA(0, 1, At, B1); PG8_BAR; PG8_SCHED;
            PG8_LDA(At, 1, 1); PG8_STAGE(PG8_SB(1, 0), b3, voffB); PG8_STAGE(PG8_SB(1, 1), b3 + hstep, voffB); PG8_STAGE(PG8_SA(1, 0), a3, voffA);
            PG8_WAIT_V(8); PG8_WAIT_L(0); PG8_BAR; PG8_MMA(1, 0, At, B0); PG8_MMA(1, 1, At, B1); PG8_BAR; PG8_SCHED;
            } else {
            PG8_LDB(B0, 0, 0); PG8_SCHED; PG8_LDA(At, 0, 0); PG8_STAGE(PG8_SA(1, 1), a1 + hstep, voffA);
            PG8_WAIT_L(8); PG8_BAR; PG8_WAIT_L(0); PG8_MMA(0, 0, At, B0); PG8_BAR; PG8_SCHED;
            PG8_LDB(B1, 0, 1); PG8_STAGE(PG8_SB(0, 0), b2, voffB);
            PG8_BAR; PG8_WAIT_L(0); PG8_MMA(0, 1, At, B1); PG8_BAR;
            PG8_LDA(At, 0, 1); PG8_STAGE(PG8_SA(0, 0), a2, voffA);
            PG8_BAR; PG8_WAIT_L(0); PG8_MMA(1, 0, At, B0); PG8_BAR; PG8_SCHED;
            PG8_STAGE(PG8_SB(0, 1), b2 + hstep, voffB);
            PG8_WAIT_V(6); PG8_BAR; PG8_MMA(1, 1, At, B1); PG8_BAR;
            PG8_LDB(B0, 1, 0); PG8_SCHED; PG8_LDA(At, 1, 0); PG8_STAGE(PG8_SA(0, 1), a2 + hstep, voffA);
            PG8_WAIT_L(8); PG8_BAR; PG8_WAIT_L(0); PG8_MMA(0, 0, At, B0); PG8_BAR; PG8_SCHED;
            PG8_LDB(B1, 1, 1); PG8_STAGE(PG8_SB(1, 0), b3, voffB);
            PG8_BAR; PG8_WAIT_L(0); PG8_MMA(0, 1, At, B1); PG8_BAR;
            PG8_LDA(At, 1, 1); PG8_STAGE(PG8_SA(1, 0), a3, voffA);
            PG8_BAR; PG8_WAIT_L(0); PG8_MMA(1, 0, At, B0); PG8_BAR; PG8_SCHED;
            PG8_STAGE(PG8_SB(1, 1), b3 + hstep, voffB);
            PG8_WAIT_V(6); PG8_BAR; PG8_MMA(1, 1, At, B1); PG8_BAR;
            }
        }
        if constexpr (ALIGN_EPI) { if (wr == 0) PG8_BAR; }
        if constexpr (!Epi::AFTER_DRAIN) { E(acc, cur, wr, wc, fr, fq); S.done(cur); }
        if (!has_next) break;
#pragma unroll
        for (int a = 0; a < 2; ++a)
#pragma unroll
            for (int b = 0; b < 2; ++b)
#pragma unroll
                for (int m = 0; m < 4; ++m)
#pragma unroll
                    for (int n = 0; n < 2; ++n) acc[a][b][m][n] = (f32x4){0.f, 0.f, 0.f, 0.f};
        cur = nxt; cA = nA; cB = nB; ++ui;
        if constexpr (ALIGN_EPI) { if (wr == 1) PG8_BAR; }
    }
    PG8_WAIT_V(0);
    if constexpr (!ALIGN_EPI) { if (wr == 0) PG8_BAR; }
    PG8_BAR;
    if constexpr (Epi::AFTER_DRAIN) { E.fused(acc, cur, wr, wc, fr, fq, lds, wid, lane); S.done(cur); }
#undef PG8_SA
#undef PG8_SB
#undef PG8_STAGE
#undef PG8_LDA
#undef PG8_LDB
#undef PG8_MMA
#undef PG8_WAIT_V
#undef PG8_WAIT_L
#undef PG8_BAR
#undef PG8_SCHED
}
}
#ifndef PG8_SP2
#define PG8_SP2 true
#endif
#ifndef PG8_ALIGN
#define PG8_ALIGN true
#endif
#ifndef OUT_MODE
#define OUT_MODE 0
#endif
#ifndef REP_MASK
#define REP_MASK 0
#endif
#ifndef S_CONV
#define S_CONV 1
#endif
#ifndef M3_RW
#define M3_RW 2
#endif
#ifndef PU_RSHIFT
#define PU_RSHIFT 11
#endif
#ifndef PU_NB
#define PU_NB 6
#endif
#ifndef PVC_RB
#define PVC_RB 64
#endif
#ifndef PE_SORT
#define PE_SORT 1
#endif
#ifndef PH_MASK
#define PH_MASK 0xFFFFF
#endif
#ifndef MK_N_LAUNCHES
#define MK_N_LAUNCHES 1
#endif

constexpr int NWAVES = 8, NTHR = NWAVES * 64;
constexpr int BATCH = 2, SEQ = 8192, D = 2048, T = BATCH * SEQ;
constexpr int LRU_W = 1024, CONF_W = 1024, IN_COLS = 4096, LRU_HD = 128;
constexpr int NH = 8, NKEY = 128, TOPK = 16, NEXP = NKEY * NKEY, KSEL = NH * TOPK;
constexpr int NMOD = 6 * D;
constexpr int CHUNK = 64, NCHUNK = SEQ / CHUNK;
constexpr int CONF_K = 31;
constexpr float EPS = 1e-6f;
constexpr int N_PHASES = 13;

constexpr size_t MiB = 1u << 20;
constexpr size_t WS_CTL = 0, CTL_ZERO_BYTES = 64 * 1024;
constexpr size_t WS_MODP = 1 * MiB;
constexpr size_t WS_CFIN = 2 * MiB;
constexpr size_t WS_CARRY = 3 * MiB;
constexpr size_t WS_AGG = 4 * MiB;
constexpr size_t WS_WG = 6 * MiB;
constexpr size_t WS_SUBK = 7 * MiB;
constexpr size_t WS_BT1 = 8 * MiB;
constexpr size_t WS_BT2 = 24 * MiB;
constexpr size_t WS_BT3 = 32 * MiB;
constexpr size_t WS_IDX = 40 * MiB;
constexpr size_t WS_GATE = 48 * MiB;
constexpr size_t WS_USC = 56 * MiB;
constexpr size_t WS_VSC = 57 * MiB;
constexpr size_t WS_RA = 64 * MiB;
constexpr size_t WS_Y1 = 128 * MiB;
constexpr size_t WS_PROJ = 192 * MiB;
constexpr size_t WS_Q = 192 * MiB;
constexpr size_t WS_UB = 256 * MiB;
constexpr size_t WS_XL = 320 * MiB;
constexpr size_t WS_ZC = 352 * MiB;
constexpr size_t WS_Y2 = 384 * MiB;
constexpr size_t WS_SSQ = 58 * MiB;
constexpr size_t WS_HLOC = 384 * MiB;
constexpr size_t WS_PC = 416 * MiB;
constexpr size_t WS_VB = 320 * MiB;
constexpr size_t WS_ACT = 448 * MiB;
constexpr size_t WS_H2Q = 456 * MiB;
constexpr size_t WS_HSC = 488 * MiB;
constexpr size_t WS_END = 489 * MiB;
constexpr int CW_TMO = 0, CW_BAR = 4096;

constexpr int RING_OFF = 0, RING_BYTES = 131072;
constexpr int LDSCTL_OFF = RING_BYTES, MISC_OFF = LDSCTL_OFF + 320;
constexpr int LDS_BYTES = 147456;

#define GAS __attribute__((address_space(1)))
#define LAS __attribute__((address_space(3)))
typedef unsigned short bf16;
typedef unsigned v4u __attribute__((ext_vector_type(4)));
typedef unsigned v2u __attribute__((ext_vector_type(2)));
typedef float f32x4 __attribute__((ext_vector_type(4)));
typedef float f32x16 __attribute__((ext_vector_type(16)));
typedef float f32x2 __attribute__((ext_vector_type(2)));
typedef short bf16x8 __attribute__((ext_vector_type(8)));
typedef __bf16 bfp2 __attribute__((ext_vector_type(2)));
typedef GAS unsigned gu32;
#define RLX_AGENT __ATOMIC_RELAXED, __HIP_MEMORY_SCOPE_AGENT
#define LDS_WAIT() asm volatile("s_waitcnt lgkmcnt(0)" ::: "memory")
#define VM_WAIT() asm volatile("s_waitcnt vmcnt(0)" ::: "memory")
__device__ __forceinline__ unsigned f2bf(float f) { unsigned u = __builtin_bit_cast(unsigned, f); return (u + 0x7fffu + ((u >> 16) & 1u)) >> 16; }
__device__ __forceinline__ unsigned pk2(float lo, float hi) { return f2bf(lo) | (f2bf(hi) << 16); }
__device__ __forceinline__ float bflo(unsigned u) { return __builtin_bit_cast(float, u << 16); }
__device__ __forceinline__ float bfhi(unsigned u) { return __builtin_bit_cast(float, u & 0xffff0000u); }
__device__ __forceinline__ float wave_sum(float v) {
#pragma unroll
    for (int o = 1; o < 64; o <<= 1) v += __shfl_xor(v, o);
    return v;
}
__device__ __forceinline__ float dpp_sum63(float v) {
    v += __builtin_bit_cast(float, __builtin_amdgcn_update_dpp(0, __builtin_bit_cast(int, v), 0xB1, 0xF, 0xF, false));
    v += __builtin_bit_cast(float, __builtin_amdgcn_update_dpp(0, __builtin_bit_cast(int, v), 0x4E, 0xF, 0xF, false));
    v += __builtin_bit_cast(float, __builtin_amdgcn_update_dpp(0, __builtin_bit_cast(int, v), 0x141, 0xF, 0xF, false));
    v += __builtin_bit_cast(float, __builtin_amdgcn_update_dpp(0, __builtin_bit_cast(int, v), 0x140, 0xF, 0xF, false));
    v += __builtin_bit_cast(float, __builtin_amdgcn_update_dpp(0, __builtin_bit_cast(int, v), 0x142, 0xA, 0xF, false));
    v += __builtin_bit_cast(float, __builtin_amdgcn_update_dpp(0, __builtin_bit_cast(int, v), 0x143, 0xC, 0xF, false));
    return v;
}

__device__ __forceinline__ float sigmoidf_(float x) { return __builtin_amdgcn_rcpf(1.0f + __expf(-x)); }
__device__ __forceinline__ float gelu_tanh(float x) { return x * sigmoidf_(1.5957691216057308f * (x + 0.044715f * x * x * x)); }
__device__ __forceinline__ float rdlane(float v, int l) { return __builtin_bit_cast(float, __builtin_amdgcn_readlane(__builtin_bit_cast(int, v), l)); }
__device__ __forceinline__ float wave_total(float v) { return rdlane(dpp_sum63(v), 63); }

#define XB_TMO      128
#define XB_XCNT(j)  (256  + 64 * (j))
#define XB_XSUB(j)  (1280 + 64 * (j))
#define XB_XGEN(j)  (2304 + 64 * (j))
#define XB_TOP      3328
#define XB_TOPGEN   3392
#define XCD_BAR_WORDS 3456
#define XB_SPIN_CAP (1u << 18)

__device__ __forceinline__ unsigned xb_ld(unsigned* p)              { return __hip_atomic_load(p, __ATOMIC_RELAXED, __HIP_MEMORY_SCOPE_AGENT); }
__device__ __forceinline__ unsigned xb_add(unsigned* p, unsigned v) { return __hip_atomic_fetch_add(p, v, __ATOMIC_RELAXED, __HIP_MEMORY_SCOPE_AGENT); }
__device__ __forceinline__ unsigned xb_xcc_id() { return (unsigned)__builtin_amdgcn_s_getreg((3 << 11) | 20) & 0xFu; }
#define XB_SPIN(cond, bar) do { unsigned _sp = 0; while (cond) { __builtin_amdgcn_s_sleep(1); \
    if ((++_sp & 255u) == 0u) { if (xb_ld(&(bar)[XB_TMO])) break; if (_sp > XB_SPIN_CAP) { atomicAdd(&(bar)[XB_TMO], 1u); break; } } } } while (0)

struct XcdBarrier {
    unsigned* bar; unsigned x;
    volatile LAS unsigned* st;
};

__device__ __forceinline__ XcdBarrier xcd_barrier_post(unsigned* bar, volatile LAS unsigned* st) {
    XcdBarrier b; b.bar = bar; b.x = xb_xcc_id(); b.st = st;
    if (threadIdx.x == 0) (void)xb_add(&bar[XB_XCNT(b.x)], 1u);
    return b;
}
__device__ __forceinline__ void xcd_barrier_complete(unsigned* bar, unsigned x, unsigned& nloc, unsigned& nx) {
    const unsigned G = gridDim.x * gridDim.y * gridDim.z;
    unsigned sum, cnt, mine, sp = 0u;
    for (;;) {
        sum = 0u; cnt = 0u; mine = 0u;
#pragma unroll
        for (unsigned j = 0; j < 16; ++j) { const unsigned c = xb_ld(&bar[XB_XCNT(j)]); sum += c; cnt += (c > 0u) ? 1u : 0u; mine = (j == x) ? c : mine; }
        if (sum == G) break;
        __builtin_amdgcn_s_sleep(1);
        if ((++sp & 255u) == 0u) { if (xb_ld(&bar[XB_TMO])) break; if (sp > XB_SPIN_CAP) { atomicAdd(&bar[XB_TMO], 1u); break; } }
    }
    nloc = mine > 0u ? mine : 1u; nx = cnt > 0u ? cnt : 1u;
}

__device__ __forceinline__ void xcd_barrier(const XcdBarrier& b) {
    asm volatile("s_waitcnt vmcnt(0)" ::: "memory");
    __syncthreads();
    if (threadIdx.x == 0) {
        unsigned* bar = b.bar;
        __builtin_amdgcn_s_waitcnt(0);
        unsigned nloc = b.st[0], nx = b.st[1];
        if (nloc == 0u) { xcd_barrier_complete(bar, b.x, nloc, nx); b.st[0] = nloc; b.st[1] = nx; }
        const unsigned old = xb_add(&bar[XB_XSUB(b.x)], 1u);
        const unsigned gen = old / nloc;
        if (old + 1u == (gen + 1u) * nloc) {
            __builtin_amdgcn_fence(__ATOMIC_RELEASE, "agent");
            asm volatile("s_waitcnt vmcnt(0)" ::: "memory");
            const unsigned og = xb_add(&bar[XB_TOP], 1u);
            const unsigned tg = og / nx;
            if (og + 1u == (tg + 1u) * nx) xb_add(&bar[XB_TOPGEN], 1u);
            else XB_SPIN(xb_ld(&bar[XB_TOPGEN]) == tg, bar);
            __builtin_amdgcn_fence(__ATOMIC_ACQUIRE, "agent");
            xb_add(&bar[XB_XGEN(b.x)], 1u);
            asm volatile("s_waitcnt vmcnt(0)" ::: "memory");
        } else {
            XB_SPIN(xb_ld(&bar[XB_XGEN(b.x)]) == gen, bar);
            __builtin_amdgcn_fence(__ATOMIC_ACQUIRE, "agent");
            asm volatile("s_waitcnt vmcnt(0)" ::: "memory");
        }
    }
    __syncthreads();
}
struct Args { const float* in[25]; float* out; unsigned char* ws; int ph_lo, ph_hi, li, pad; };
enum { I_X = 0, I_C, I_WMOD, I_BMOD, I_GPREMIX, I_GPOSTMIX, I_GPREFFN, I_GPOSTFFN, I_WIN, I_LCW, I_LCB, I_WA, I_BA, I_WX, I_BX, I_LAMBDA,
       I_CDW, I_CDB, I_LNG, I_LNB, I_WOUT, I_WQ, I_SUBK, I_PU, I_PV };

__device__ __forceinline__ float mod_at(const float* modp, int b, int n) {
    return (modp[(0 * 2 + b) * NMOD + n] + modp[(1 * 2 + b) * NMOD + n]) + (modp[(2 * 2 + b) * NMOD + n] + modp[(3 * 2 + b) * NMOD + n]);
}

__device__ __forceinline__ void p0_transpose_item(const float* W, int K, int N, bf16* WT, LAS float* scr, int item, int lane) {
    const int nblk = N / 32, kb = item / nblk, nb = item % nblk, k0 = 64 * kb, n0 = 32 * nb;
#pragma unroll 8
    for (int i = 0; i < 32; ++i) { const int kk = 2 * i + (lane >> 5); scr[kk * 33 + (lane & 31)] = W[(size_t)(k0 + kk) * N + n0 + (lane & 31)]; }
    LDS_WAIT(); asm volatile("" ::: "memory");
    const int c = lane & 7;
#pragma unroll
    for (int j = 0; j < 4; ++j) { const int n = (lane >> 3) + 8 * j; const LAS float* s = scr + (8 * c) * 33 + n;
        v4u o; o.x = pk2(s[0 * 33], s[1 * 33]); o.y = pk2(s[2 * 33], s[3 * 33]); o.z = pk2(s[4 * 33], s[5 * 33]); o.w = pk2(s[6 * 33], s[7 * 33]);
        *(GAS v4u*)(WT + (size_t)(n0 + n) * K + k0 + 8 * c) = o; }
    LDS_WAIT(); asm volatile("" ::: "memory");
}
__device__ __forceinline__ void cvt_rows_bf16(const float* src, bf16* dst, size_t n8, size_t gt, size_t ngt) {
    for (size_t i = gt; i < n8; i += ngt) {
        const f32x4 a = ((const GAS f32x4*)src)[2 * i], b = ((const GAS f32x4*)src)[2 * i + 1];
        v4u o; o.x = pk2(a.x, a.y); o.y = pk2(a.z, a.w); o.z = pk2(b.x, b.y); o.w = pk2(b.z, b.w);
        ((GAS v4u*)dst)[i] = o; }
}
__device__ __forceinline__ void phase_p0(const Args& A, LAS unsigned char* lds, int tid, int lane, int wave, int bid, int G) {
    float* modp = (float*)(A.ws + WS_MODP);
    for (int item = bid; item < 192; item += G) {
        const int cg = item % 48, kq = item / 48, k0 = kq * 512 + wave * 64, n0 = cg * 256 + lane * 4;
        const float c0 = A.in[I_C][k0 + lane], c1 = A.in[I_C][D + k0 + lane];
        const float ca0 = c0 * sigmoidf_(c0), ca1 = c1 * sigmoidf_(c1);
        f32x4 a0 = {0.f, 0.f, 0.f, 0.f}, a1 = {0.f, 0.f, 0.f, 0.f};
        const float* wp = A.in[I_WMOD] + (size_t)k0 * NMOD + n0;
#pragma unroll 8
        for (int kk = 0; kk < 64; ++kk) {
            const f32x4 w = *(const GAS f32x4*)(wp + (size_t)kk * NMOD);
            const float s0 = __shfl(ca0, kk), s1 = __shfl(ca1, kk);
            a0 += w * s0; a1 += w * s1;
        }
        LAS f32x4* red = (LAS f32x4*)lds;
        red[(wave * 2 + 0) * 64 + lane] = a0; red[(wave * 2 + 1) * 64 + lane] = a1;
        __syncthreads();
        { const int b = tid >> 8, col = tid & 255; const LAS float* rf = (const LAS float*)lds; float s = 0.f;
#pragma unroll
          for (int w = 0; w < 8; ++w) s += rf[((w * 2 + b) * 64) * 4 + col];
          if (kq == 0) s += A.in[I_BMOD][cg * 256 + col];
          modp[(kq * 2 + b) * NMOD + cg * 256 + col] = s; }
        __syncthreads();
    }
    {
        LAS float* scr = (LAS float*)(lds + wave * 16384);
        const int gw = bid * NWAVES + wave, NGW = G * NWAVES;
        constexpr int I1 = (D / 64) * (IN_COLS / 32), I2 = (D / 64) * (D / 32);
        for (int it = gw; it < I1 + 2 * I2; it += NGW) {
            int r = it;
            if (r < I1) { p0_transpose_item(A.in[I_WIN], D, IN_COLS, (bf16*)(A.ws + WS_BT1), scr, r, lane); continue; } r -= I1;
            if (r < I2) { p0_transpose_item(A.in[I_WOUT], D, D, (bf16*)(A.ws + WS_BT2), scr, r, lane); continue; } r -= I2;
            p0_transpose_item(A.in[I_WQ], D, D, (bf16*)(A.ws + WS_BT3), scr, r, lane);
        }
    }
    {
        const int gt = bid * NTHR + tid, ngt = G * NTHR;
        bf16* wg = (bf16*)(A.ws + WS_WG);
        for (int e = gt; e < NH * 256 * 128; e += ngt) {
            const int h = e >> 15, n = (e >> 7) & 255, k = e & 127;
            const float v = (n < 128 ? A.in[I_WA] : A.in[I_WX])[h * 16384 + k * 128 + (n & 127)];
            wg[e] = (bf16)f2bf(v);
        }
        cvt_rows_bf16(A.in[I_SUBK], (bf16*)(A.ws + WS_SUBK), (size_t)NH * 2 * NKEY * 128 / 8, gt, ngt);
    }
}

__device__ __forceinline__ void phase_p1(const Args& A, int tid, int lane, int wave, int bid, int G) {
    const float* modp = (const float*)(A.ws + WS_MODP);
    {
        float* cfin = (float*)(A.ws + WS_CFIN);
        for (int e = bid * NTHR + tid; e < 2 * 2 * D; e += G * NTHR) {
            const int b = e >> 12, arr = (e >> 11) & 1, col = e & (D - 1);
            cfin[e] = arr == 0 ? mod_at(modp, b, 2 * D + col) * A.in[I_GPOSTMIX][col] : mod_at(modp, b, 5 * D + col) * A.in[I_GPOSTFFN][col];
        }
        float* cfe = (float*)(A.ws + WS_CFIN) + 4 * D;
        for (int e = bid * NTHR + tid; e < 2 * 2 * D; e += G * NTHR) {
            const int b = e >> 12, arr = (e >> 11) & 1, col = e & (D - 1);
            cfe[e] = arr == 0 ? A.in[I_GPREFFN][col] * (1.0f + mod_at(modp, b, 4 * D + col)) : mod_at(modp, b, 3 * D + col);
        }
    }
    const int gw = bid * NWAVES + wave, NGW = G * NWAVES;
    bf16* h1 = (bf16*)(A.ws + WS_RA);
    int cb = -1; float gs[4][8], sh[4][8];
    for (int row = gw; row < T; row += NGW) {
        const int b = row >> 13;
        if (b != cb) { cb = b;
#pragma unroll
            for (int j = 0; j < 4; ++j)
#pragma unroll
                for (int e = 0; e < 8; ++e) { const int col = j * 512 + lane * 8 + e;
                    gs[j][e] = A.in[I_GPREMIX][col] * (1.0f + mod_at(modp, b, D + col)); sh[j][e] = mod_at(modp, b, col); } }
        const GAS f32x4* xr = (const GAS f32x4*)(A.in[I_X] + (size_t)row * D) + lane * 2;
        f32x4 v[4][2]; float s = 0.f;
#pragma unroll
        for (int j = 0; j < 4; ++j) { v[j][0] = xr[j * 128]; v[j][1] = xr[j * 128 + 1];
            s += (v[j][0].x * v[j][0].x + v[j][0].y * v[j][0].y) + (v[j][0].z * v[j][0].z + v[j][0].w * v[j][0].w);
            s += (v[j][1].x * v[j][1].x + v[j][1].y * v[j][1].y) + (v[j][1].z * v[j][1].z + v[j][1].w * v[j][1].w); }
        const float rstd = __builtin_amdgcn_rsqf(wave_total(s) * (1.0f / D) + EPS);
        GAS v4u* orow = (GAS v4u*)(h1 + (size_t)row * D) + lane;
#pragma unroll
        for (int j = 0; j < 4; ++j) { float o[8];
#pragma unroll
            for (int e = 0; e < 8; ++e) o[e] = v[j][e >> 2][e & 3] * rstd * gs[j][e] + sh[j][e];
            v4u w; w.x = pk2(o[0], o[1]); w.y = pk2(o[2], o[3]); w.z = pk2(o[4], o[5]); w.w = pk2(o[6], o[7]);
            orow[j * 64] = w; }
    }
}

__device__ __forceinline__ void m1a_tile_issue(const bf16* proj, int item, int tid, v4u (&rv)[5], v4u (&rg)[5]) {
    const int b = item >> 9, tt = (item >> 3) & 63, ct = item & 7, t0 = tt * 128;
#pragma unroll
    for (int i = 0; i < 5; ++i) {
        const int e = tid + i * NTHR, r = e >> 4, c8 = (e & 15) * 8, t = t0 - 30 + r;
        rv[i] = (v4u){0u, 0u, 0u, 0u}; rg[i] = (v4u){0u, 0u, 0u, 0u};
        if (e < 158 * 16 && t >= 0) { const bf16* p = proj + (size_t)(b * SEQ + t) * IN_COLS + 2048 + ct * 128 + c8; rv[i] = *(const GAS v4u*)p; rg[i] = *(const GAS v4u*)(p + 1024); }
    }
}
__device__ __forceinline__ void phase_m1a(const Args& A, LAS unsigned char* lds, int tid, int lane, int wave, int bid, int G) {
    const bf16* proj = (const bf16*)(A.ws + WS_PROJ);
    {
        bf16* xl = (bf16*)(A.ws + WS_XL);
        const float* w4 = A.in[I_LCW]; const float* b4 = A.in[I_LCB];
        for (int it = bid * NTHR + tid; it < (T / 16) * 128; it += G * NTHR) {
            const int c0 = (it & 127) * 8, run = it >> 7, row0 = run * 16, t0 = row0 & (SEQ - 1);
            v4u in[19];
#pragma unroll
            for (int r = 0; r < 19; ++r) { in[r] = (v4u){0u, 0u, 0u, 0u}; if (t0 - 3 + r >= 0) in[r] = *(const GAS v4u*)(proj + (size_t)(row0 - 3 + r) * IN_COLS + c0); }
            float w[4][8], bb[8];
#pragma unroll
            for (int j = 0; j < 4; ++j) { const f32x4 wa = *(const GAS f32x4*)(w4 + j * LRU_W + c0), wb = *(const GAS f32x4*)(w4 + j * LRU_W + c0 + 4);
                w[j][0] = wa.x; w[j][1] = wa.y; w[j][2] = wa.z; w[j][3] = wa.w; w[j][4] = wb.x; w[j][5] = wb.y; w[j][6] = wb.z; w[j][7] = wb.w; }
            { const f32x4 ba = *(const GAS f32x4*)(b4 + c0), bc = *(const GAS f32x4*)(b4 + c0 + 4); bb[0] = ba.x; bb[1] = ba.y; bb[2] = ba.z; bb[3] = ba.w; bb[4] = bc.x; bb[5] = bc.y; bb[6] = bc.z; bb[7] = bc.w; }
#pragma unroll
            for (int i = 0; i < 16; ++i) { float acc[8];
#pragma unroll
                for (int e = 0; e < 8; ++e) acc[e] = bb[e];
#pragma unroll
                for (int j = 0; j < 4; ++j) { const v4u v = in[i + j];
                    acc[0] += w[j][0] * bflo(v.x); acc[1] += w[j][1] * bfhi(v.x); acc[2] += w[j][2] * bflo(v.y); acc[3] += w[j][3] * bfhi(v.y);
                    acc[4] += w[j][4] * bflo(v.z); acc[5] += w[j][5] * bfhi(v.z); acc[6] += w[j][6] * bflo(v.w); acc[7] += w[j][7] * bfhi(v.w); }
                v4u o; o.x = pk2(acc[0], acc[1]); o.y = pk2(acc[2], acc[3]); o.z = pk2(acc[4], acc[5]); o.w = pk2(acc[6], acc[7]);
                *(GAS v4u*)(xl + (size_t)(row0 + i) * LRU_W + c0) = o; }
        }
    }
    {
        bf16* zc = (bf16*)(A.ws + WS_ZC);
        const float* w31 = A.in[I_CDW]; const float* b31 = A.in[I_CDB];
        LAS float* zt = (LAS float*)lds;
        const int cp = tid & 63, tg = tid >> 6;
        v4u rv[5], rg[5];
        int item = bid;
        if (item < 2 * 64 * 8) m1a_tile_issue(proj, item, tid, rv, rg);
        float w0[CONF_K], w1[CONF_K], bias0 = 0.f, bias1 = 0.f; int wct = -1;
        for (; item < 2 * 64 * 8; item += G) {
            const int b = item >> 9, tt = (item >> 3) & 63, ct = item & 7, t0 = tt * 128, ch = ct * 128 + 2 * cp;
            if (ct != wct) { wct = ct;
#pragma unroll
                for (int j = 0; j < CONF_K; ++j) { const f32x2 ww = *(const GAS f32x2*)(w31 + j * CONF_W + ch); w0[j] = ww.x; w1[j] = ww.y; }
                const f32x2 bw = *(const GAS f32x2*)(b31 + ch); bias0 = bw.x; bias1 = bw.y; }
            __syncthreads();
#pragma unroll
            for (int i = 0; i < 5; ++i) {
                const int e = tid + i * NTHR, r = e >> 4, c8 = (e & 15) * 8;
                if (e < 158 * 16) { const v4u v = rv[i], g = rg[i]; f32x4 z0, z1;
                    z0.x = bflo(v.x) * sigmoidf_(bflo(g.x)); z0.y = bfhi(v.x) * sigmoidf_(bfhi(g.x)); z0.z = bflo(v.y) * sigmoidf_(bflo(g.y)); z0.w = bfhi(v.y) * sigmoidf_(bfhi(g.y));
                    z1.x = bflo(v.z) * sigmoidf_(bflo(g.z)); z1.y = bfhi(v.z) * sigmoidf_(bfhi(g.z)); z1.z = bflo(v.w) * sigmoidf_(bflo(g.w)); z1.w = bfhi(v.w) * sigmoidf_(bfhi(g.w));
                    *(LAS f32x4*)(zt + r * 128 + c8) = z0; *(LAS f32x4*)(zt + r * 128 + c8 + 4) = z1; }
            }
            __syncthreads();
            if (item + G < 2 * 64 * 8) m1a_tile_issue(proj, item + G, tid, rv, rg);
            float a0[16], a1[16];
#pragma unroll
            for (int i = 0; i < 16; ++i) { a0[i] = bias0; a1[i] = bias1; }
#pragma unroll
            for (int s_ = 0; s_ < 46; ++s_) {
                const f32x2 v = *(const LAS f32x2*)(zt + (tg * 16 + s_) * 128 + 2 * cp);
#pragma unroll
                for (int i = 0; i < 16; ++i) if (s_ - i >= 0 && s_ - i < CONF_K) { a0[i] += w0[s_ - i] * v.x; a1[i] += w1[s_ - i] * v.y; }
            }
            bf16* zo = zc + (size_t)(b * SEQ + t0 + tg * 16) * CONF_W + ch;
#pragma unroll
            for (int i = 0; i < 16; ++i) *(GAS unsigned*)(zo + (size_t)i * CONF_W) = pk2(a0[i], a1[i]);
        }
        __syncthreads();
    }
}

template <int CTRL> __device__ __forceinline__ float dpp_shr(float v, float ident) {
    return __builtin_bit_cast(float, __builtin_amdgcn_update_dpp(__builtin_bit_cast(int, ident), __builtin_bit_cast(int, v), CTRL, 0xF, 0xF, false));
}
__device__ __forceinline__ void phase_m1b(const Args& A, int tid, int lane, int wave, int bid, int G) {
    const bf16* xl = (const bf16*)(A.ws + WS_XL); const bf16* wg = (const bf16*)(A.ws + WS_WG);
    bf16* hloc = (bf16*)(A.ws + WS_HLOC); bf16* pc = (bf16*)(A.ws + WS_PC); float* agg = (float*)(A.ws + WS_AGG);
    const int fr = lane & 15, fq = lane >> 4;
    for (int item = bid * NWAVES + wave; item < 2 * NCHUNK * 8; item += G * NWAVES) {
        const int hh = item & 7, chunk = (item >> 3) & (NCHUNK - 1), b = item >> 10;
        const size_t r0 = (size_t)b * SEQ + (size_t)chunk * CHUNK;
        bf16x8 xf[4][4];
#pragma unroll
        for (int mt = 0; mt < 4; ++mt)
#pragma unroll
            for (int ks = 0; ks < 4; ++ks) xf[mt][ks] = *(const GAS bf16x8*)(xl + (r0 + 16 * mt + fr) * LRU_W + hh * LRU_HD + 32 * ks + 8 * fq);
        float cP[4], cH[4];
        for (int j = 0; j < 8; ++j) {
            const int chb = hh * LRU_HD + 16 * j + 4 * fq;
            bf16x8 wa[4], wx[4];
#pragma unroll
            for (int ks = 0; ks < 4; ++ks) { wa[ks] = *(const GAS bf16x8*)(wg + (size_t)(hh * 256 + 16 * j + fr) * 128 + 32 * ks + 8 * fq);
                                             wx[ks] = *(const GAS bf16x8*)(wg + (size_t)(hh * 256 + 128 + 16 * j + fr) * 128 + 32 * ks + 8 * fq); }
            const f32x4 bav = *(const GAS f32x4*)(A.in[I_BA] + chb), bxv = *(const GAS f32x4*)(A.in[I_BX] + chb), lam = *(const GAS f32x4*)(A.in[I_LAMBDA] + chb);
            float cl[4];
#pragma unroll
            for (int r = 0; r < 4; ++r) { cl[r] = -8.0f * log1pf(__expf(-lam[r])); cP[r] = 1.f; cH[r] = 0.f; }
#pragma unroll
            for (int mt = 0; mt < 4; ++mt) {
                f32x4 ar = {0.f, 0.f, 0.f, 0.f}, ai = {0.f, 0.f, 0.f, 0.f};
#pragma unroll
                for (int ks = 0; ks < 4; ++ks) { ar = __builtin_amdgcn_mfma_f32_16x16x32_bf16(wa[ks], xf[mt][ks], ar, 0, 0, 0);
                                                 ai = __builtin_amdgcn_mfma_f32_16x16x32_bf16(wx[ks], xf[mt][ks], ai, 0, 0, 0); }
                const v2u xv = *(const GAS v2u*)(xl + (r0 + 16 * mt + fr) * LRU_W + chb);
                const float xlv[4] = {bflo(xv.x), bfhi(xv.x), bflo(xv.y), bfhi(xv.y)};
                float P[4], H[4];
#pragma unroll
                for (int r = 0; r < 4; ++r) {
                    const float rg = sigmoidf_(ar[r] + bav[r]), ig = sigmoidf_(ai[r] + bxv[r]);
                    const float la = cl[r] * rg, a = __expf(la), mult = sqrtf(fmaxf(1.0f - a * a, 0.f));
                    float p = a, h = mult * ig * xlv[r];
                    { float pp, hp;
                      pp = dpp_shr<0x111>(p, 1.0f); hp = dpp_shr<0x111>(h, 0.0f); h = p * hp + h; p = p * pp;
                      pp = dpp_shr<0x112>(p, 1.0f); hp = dpp_shr<0x112>(h, 0.0f); h = p * hp + h; p = p * pp;
                      pp = dpp_shr<0x114>(p, 1.0f); hp = dpp_shr<0x114>(h, 0.0f); h = p * hp + h; p = p * pp;
                      pp = dpp_shr<0x118>(p, 1.0f); hp = dpp_shr<0x118>(h, 0.0f); h = p * hp + h; p = p * pp; }
                    h = h + p * cH[r]; p = p * cP[r];
                    P[r] = p; H[r] = h;
                    cP[r] = __shfl(p, 15, 16); cH[r] = __shfl(h, 15, 16);
                }
                v2u ho, po; ho.x = pk2(H[0], H[1]); ho.y = pk2(H[2], H[3]); po.x = pk2(P[0], P[1]); po.y = pk2(P[2], P[3]);
                *(GAS v2u*)(hloc + (r0 + 16 * mt + fr) * LRU_W + chb) = ho;
                *(GAS v2u*)(pc + (r0 + 16 * mt + fr) * LRU_W + chb) = po;
            }
            if (fr == 0) {
                float* ag = agg + ((size_t)(b * NCHUNK + chunk) * LRU_W + chb) * 2;
                *(GAS f32x4*)ag = (f32x4){cP[0], cH[0], cP[1], cH[1]}; *(GAS f32x4*)(ag + 4) = (f32x4){cP[2], cH[2], cP[3], cH[3]};
            }
        }
    }
}

__device__ __forceinline__ void phase_m3(const Args& A, LAS unsigned char* lds, int tid, int lane, int wave, int bid, int G) {
    const bf16* proj = (const bf16*)(A.ws + WS_PROJ); const bf16* hloc = (const bf16*)(A.ws + WS_HLOC); const bf16* pc = (const bf16*)(A.ws + WS_PC);
    const bf16* zc = (const bf16*)(A.ws + WS_ZC); const float* agg = (const float*)(A.ws + WS_AGG);
    bf16* a2 = (bf16*)(A.ws + WS_RA);
    LAS float* cs = (LAS float*)lds;
    float lg[2][8], lb[2][8];
#pragma unroll
    for (int jj = 0; jj < 2; ++jj)
#pragma unroll
        for (int e = 0; e < 8; ++e) { lg[jj][e] = A.in[I_LNG][jj * 512 + lane * 8 + e]; lb[jj][e] = A.in[I_LNB][jj * 512 + lane * 8 + e]; }
    for (int item = bid; item < 2 * NCHUNK; item += G) {
        const int b = item >> 7, chunk = item & (NCHUNK - 1);
        {   float h0 = 0.f, h1 = 0.f; const float* ap = agg + ((size_t)(b * NCHUNK) * LRU_W + 2 * tid) * 2;
#pragma unroll 8
            for (int c = 0; c < chunk; ++c) { const f32x4 ab = *(const GAS f32x4*)(ap + (size_t)c * LRU_W * 2); h0 = ab.x * h0 + ab.y; h1 = ab.z * h1 + ab.w; }
            __syncthreads();
            cs[2 * tid] = h0; cs[2 * tid + 1] = h1;
            __syncthreads(); }
        for (int rr = 0; rr < 8; rr += M3_RW) {
            const int row0 = b * SEQ + chunk * CHUNK + wave * 8 + rr;
            v4u hv[M3_RW][2], pv[M3_RW][2], gv[M3_RW][2], zq[M3_RW][2];
#pragma unroll
            for (int u = 0; u < M3_RW; ++u)
#pragma unroll
                for (int jj = 0; jj < 2; ++jj) { const int c0 = jj * 512 + lane * 8; const size_t row = (size_t)(row0 + u);
                    hv[u][jj] = *(const GAS v4u*)(hloc + row * LRU_W + c0); pv[u][jj] = *(const GAS v4u*)(pc + row * LRU_W + c0);
                    gv[u][jj] = *(const GAS v4u*)(proj + row * IN_COLS + 1024 + c0); zq[u][jj] = *(const GAS v4u*)(zc + row * CONF_W + c0); }
#pragma unroll
            for (int u = 0; u < M3_RW; ++u) {
                const size_t row = (size_t)(row0 + u);
                float zv[2][8]; float s = 0.f;
#pragma unroll
                for (int jj = 0; jj < 2; ++jj) {
                    const int c0 = jj * 512 + lane * 8;
                    const f32x4 ca = *(const LAS f32x4*)(cs + c0), cb = *(const LAS f32x4*)(cs + c0 + 4);
                    const v4u h_ = hv[u][jj], p_ = pv[u][jj], g_ = gv[u][jj], z = zq[u][jj];
                    float y[8];
                    y[0] = (bflo(h_.x) + bflo(p_.x) * ca.x) * gelu_tanh(bflo(g_.x)); y[1] = (bfhi(h_.x) + bfhi(p_.x) * ca.y) * gelu_tanh(bfhi(g_.x));
                    y[2] = (bflo(h_.y) + bflo(p_.y) * ca.z) * gelu_tanh(bflo(g_.y)); y[3] = (bfhi(h_.y) + bfhi(p_.y) * ca.w) * gelu_tanh(bfhi(g_.y));
                    y[4] = (bflo(h_.z) + bflo(p_.z) * cb.x) * gelu_tanh(bflo(g_.z)); y[5] = (bfhi(h_.z) + bfhi(p_.z) * cb.y) * gelu_tanh(bfhi(g_.z));
                    y[6] = (bflo(h_.w) + bflo(p_.w) * cb.z) * gelu_tanh(bflo(g_.w)); y[7] = (bfhi(h_.w) + bfhi(p_.w) * cb.w) * gelu_tanh(bfhi(g_.w));
                    v4u o; o.x = pk2(y[0], y[1]); o.y = pk2(y[2], y[3]); o.z = pk2(y[4], y[5]); o.w = pk2(y[6], y[7]);
                    *(GAS v4u*)(a2 + row * D + c0) = o;
                    zv[jj][0] = bflo(z.x); zv[jj][1] = bfhi(z.x); zv[jj][2] = bflo(z.y); zv[jj][3] = bfhi(z.y); zv[jj][4] = bflo(z.z); zv[jj][5] = bfhi(z.z); zv[jj][6] = bflo(z.w); zv[jj][7] = bfhi(z.w);
#pragma unroll
                    for (int e = 0; e < 8; ++e) s += zv[jj][e];
                }
                const float mean = wave_total(s) * (1.0f / CONF_W); float q = 0.f;
#pragma unroll
                for (int jj = 0; jj < 2; ++jj)
#pragma unroll
                    for (int e = 0; e < 8; ++e) { zv[jj][e] -= mean; q += zv[jj][e] * zv[jj][e]; }
                const float rstd = __builtin_amdgcn_rsqf(wave_total(q) * (1.0f / CONF_W) + EPS);
#pragma unroll
                for (int jj = 0; jj < 2; ++jj) { float o[8];
#pragma unroll
                    for (int e = 0; e < 8; ++e) { const float n = zv[jj][e] * rstd * lg[jj][e] + lb[jj][e]; o[e] = n * sigmoidf_(n); }
                    v4u w; w.x = pk2(o[0], o[1]); w.y = pk2(o[2], o[3]); w.z = pk2(o[4], o[5]); w.w = pk2(o[6], o[7]);
                    *(GAS v4u*)(a2 + row * D + 1024 + jj * 512 + lane * 8) = w; }
            }
        }
    }
}

__device__ __forceinline__ f32x2 fp8lo(unsigned w) { return __builtin_amdgcn_cvt_pk_f32_fp8((int)w, false); }
__device__ __forceinline__ f32x2 fp8hi(unsigned w) { return __builtin_amdgcn_cvt_pk_f32_fp8((int)w, true); }
constexpr int CVT_ROWS = 4;
template <bool I8> __device__ __forceinline__ void cvt_table_q8(const float* src, unsigned char* dst, float* inv_scale, int gw, int NGW, int lane) {
    for (int r0 = gw; r0 < NEXP; r0 += NGW * CVT_ROWS) {
        f32x4 v[CVT_ROWS][8];
#pragma unroll
        for (int q = 0; q < CVT_ROWS; ++q) { const int r = r0 + q * NGW; const GAS f32x4* p = (const GAS f32x4*)(src + (size_t)(r < NEXP ? r : r0) * D) + lane;
#pragma unroll
            for (int i = 0; i < 8; ++i) v[q][i] = p[i * 64]; }
#pragma unroll
        for (int q = 0; q < CVT_ROWS; ++q) { const int r = r0 + q * NGW; float m = 0.f;
#pragma unroll
            for (int i = 0; i < 8; ++i) m = fmaxf(m, fmaxf(fmaxf(fabsf(v[q][i].x), fabsf(v[q][i].y)), fmaxf(fabsf(v[q][i].z), fabsf(v[q][i].w))));
#pragma unroll
            for (int o = 1; o < 64; o <<= 1) m = fmaxf(m, __shfl_xor(m, o));
            const float QM = I8 ? 127.0f : 448.0f;
            const float sc = m > 0.f ? QM / m : 1.0f;
            if (r < NEXP) {
                GAS unsigned* o4 = (GAS unsigned*)(dst + (size_t)r * D) + lane;
#pragma unroll
                for (int i = 0; i < 8; ++i) { const f32x4 t = v[q][i] * sc;
                    const float a = fminf(fmaxf(t.x, -QM), QM), b = fminf(fmaxf(t.y, -QM), QM), c = fminf(fmaxf(t.z, -QM), QM), d = fminf(fmaxf(t.w, -QM), QM);
                    if (I8) { o4[i * 64] = (unsigned)(((int)rintf(a) & 255) | (((int)rintf(b) & 255) << 8) | (((int)rintf(c) & 255) << 16) | ((int)rintf(d) << 24)); }
                    else { int pk = __builtin_amdgcn_cvt_pk_fp8_f32(a, b, 0, false); pk = __builtin_amdgcn_cvt_pk_fp8_f32(c, d, pk, true); o4[i * 64] = (unsigned)pk; } }
                if (lane == 0) inv_scale[r] = m > 0.f ? m * (1.0f / QM) : 1.0f;
            }
        }
    }
}
__device__ __forceinline__ void phase_e2(const Args& A, int tid, int lane, int wave, int bid, int G) {
    const float* modp = (const float*)(A.ws + WS_MODP); const float* cfin = (const float*)(A.ws + WS_CFIN);
    const bf16* y1 = (const bf16*)(A.ws + WS_Y1); bf16* h2 = (bf16*)(A.ws + WS_RA);
    const int gw = bid * NWAVES + wave, NGW = G * NWAVES;
    const float* cfe = (const float*)(A.ws + WS_CFIN) + 4 * D;
    for (int row = gw; row < T; row += NGW) {
        const int b = row >> 13;
        const GAS f32x4* xr = (const GAS f32x4*)(A.in[I_X] + (size_t)row * D) + lane * 2;
        const GAS v4u* yr = (const GAS v4u*)(y1 + (size_t)row * D) + lane;
        const GAS f32x4* cf = (const GAS f32x4*)(cfin + (size_t)(b * 2 + 0) * D) + lane * 2;
        float xv[4][8], yv[4][8]; float s1 = 0.f;
#pragma unroll
        for (int j = 0; j < 4; ++j) { const f32x4 a = xr[j * 128], c = xr[j * 128 + 1]; const v4u y = yr[j * 64];
            xv[j][0] = a.x; xv[j][1] = a.y; xv[j][2] = a.z; xv[j][3] = a.w; xv[j][4] = c.x; xv[j][5] = c.y; xv[j][6] = c.z; xv[j][7] = c.w;
            yv[j][0] = bflo(y.x); yv[j][1] = bfhi(y.x); yv[j][2] = bflo(y.y); yv[j][3] = bfhi(y.y); yv[j][4] = bflo(y.z); yv[j][5] = bfhi(y.z); yv[j][6] = bflo(y.w); yv[j][7] = bfhi(y.w);
#pragma unroll
            for (int e = 0; e < 8; ++e) s1 += yv[j][e] * yv[j][e]; }
        const float rstd1 = __builtin_amdgcn_rsqf(wave_total(s1) * (1.0f / D) + EPS); float s2 = 0.f;
#pragma unroll
        for (int j = 0; j < 4; ++j) { const f32x4 ca = cf[j * 128], cc = cf[j * 128 + 1]; const float cg[8] = {ca.x, ca.y, ca.z, ca.w, cc.x, cc.y, cc.z, cc.w};
#pragma unroll
            for (int e = 0; e < 8; ++e) { xv[j][e] += cg[e] * yv[j][e] * rstd1; s2 += xv[j][e] * xv[j][e]; } }
        const float rstd2 = __builtin_amdgcn_rsqf(wave_total(s2) * (1.0f / D) + EPS);
        GAS v4u* orow = (GAS v4u*)(h2 + (size_t)row * D) + lane; float am = 0.f;
#pragma unroll
        for (int j = 0; j < 4; ++j) {
            const GAS f32x4* ge = (const GAS f32x4*)(cfe + (size_t)(b * 2 + 0) * D) + lane * 2 + j * 128; const GAS f32x4* se = (const GAS f32x4*)(cfe + (size_t)(b * 2 + 1) * D) + lane * 2 + j * 128;
            const f32x4 g0_ = ge[0], g1_ = ge[1], s0_ = se[0], s1_ = se[1]; const float gsv[8] = {g0_.x, g0_.y, g0_.z, g0_.w, g1_.x, g1_.y, g1_.z, g1_.w}, shv[8] = {s0_.x, s0_.y, s0_.z, s0_.w, s1_.x, s1_.y, s1_.z, s1_.w};
#pragma unroll
            for (int e = 0; e < 8; ++e) { xv[j][e] = xv[j][e] * rstd2 * gsv[e] + shv[e]; am = fmaxf(am, fabsf(xv[j][e])); }
            v4u w; w.x = pk2(xv[j][0], xv[j][1]); w.y = pk2(xv[j][2], xv[j][3]); w.z = pk2(xv[j][4], xv[j][5]); w.w = pk2(xv[j][6], xv[j][7]);
            orow[j * 64] = w; }
#pragma unroll
        for (int o = 1; o < 64; o <<= 1) am = fmaxf(am, __shfl_xor(am, o));
        const float qs = am > 0.f ? 127.0f / am : 1.0f;
        GAS v2u* qrow = (GAS v2u*)(A.ws + WS_H2Q + (size_t)row * D) + lane;
#pragma unroll
        for (int j = 0; j < 4; ++j) { int q[8];
#pragma unroll
            for (int e = 0; e < 8; ++e) q[e] = (int)rintf(xv[j][e] * qs) & 255;
            v2u w; w.x = (unsigned)(q[0] | (q[1] << 8) | (q[2] << 16) | (q[3] << 24)); w.y = (unsigned)(q[4] | (q[5] << 8) | (q[6] << 16) | (q[7] << 24));
            qrow[j * 64] = w; }
        if (lane == 0) ((float*)(A.ws + WS_HSC))[row] = am > 0.f ? am * (1.0f / 127.0f) : 1.0f;
    }
    if (!S_CONV) { cvt_table_q8<true>(A.in[I_PU], A.ws + WS_UB, (float*)(A.ws + WS_USC), gw, NGW, lane); cvt_table_q8<false>(A.in[I_PV], A.ws + WS_VB, (float*)(A.ws + WS_VSC), gw, NGW, lane); }
}

template <int N> __device__ __forceinline__ void bitonic_sort_desc(float (&v)[N]) {
#pragma unroll
    for (int k = 2; k <= N; k <<= 1)
#pragma unroll
        for (int j = k >> 1; j > 0; j >>= 1)
#pragma unroll
            for (int i = 0; i < N; ++i) { const int l = i ^ j;
                if (l > i) { const bool desc = ((i & k) == 0); const float a = v[i], b = v[l]; const float mx = fmaxf(a, b), mn = fminf(a, b); v[i] = desc ? mx : mn; v[l] = desc ? mn : mx; } }
}
__device__ __forceinline__ void merge_top16(float (&a)[16], const float (&b)[16]) {
#pragma unroll
    for (int i = 0; i < 16; ++i) a[i] = fmaxf(a[i], b[15 - i]);
#pragma unroll
    for (int j = 8; j > 0; j >>= 1)
#pragma unroll
        for (int i = 0; i < 16; ++i) { const int l = i ^ j; if (l > i) { const float x = a[i], y = a[l]; a[i] = fmaxf(x, y); a[l] = fminf(x, y); } }
}
__device__ __forceinline__ void top16_of_64(float (&v)[64], float (&out)[16]) {
    float g[4][16];
#pragma unroll
    for (int q = 0; q < 4; ++q) {
#pragma unroll
        for (int i = 0; i < 16; ++i) g[q][i] = v[q * 16 + i];
        bitonic_sort_desc<16>(g[q]); }
    merge_top16(g[0], g[1]); merge_top16(g[2], g[3]); merge_top16(g[0], g[2]);
#pragma unroll
    for (int i = 0; i < 16; ++i) out[i] = g[0][i];
}
__device__ __forceinline__ float pack_key(float v, unsigned key, unsigned mask) { return __builtin_bit_cast(float, (__builtin_bit_cast(unsigned, v) & ~mask) | key); }
constexpr int SK_PITCH = 272;
__device__ __forceinline__ void score_top16(const bf16* q, const LAS unsigned char* skl, int tok, int h, int p, int l31, int hf, float (&out)[16]) {
    f32x16 acc[4];
#pragma unroll
    for (int kt = 0; kt < 4; ++kt)
#pragma unroll
        for (int r = 0; r < 16; ++r) acc[kt][r] = 0.f;
    bf16x8 bq[8];
#pragma unroll
    for (int ks = 0; ks < 8; ++ks) bq[ks] = *(const GAS bf16x8*)(q + (size_t)tok * D + h * 256 + p * 128 + 16 * ks + 8 * hf);
#pragma unroll
    for (int ks = 0; ks < 8; ++ks) {
#pragma unroll
        for (int kt = 0; kt < 4; ++kt) {
            const bf16x8 ak = *(const LAS bf16x8*)(skl + (p * NKEY + 32 * kt + l31) * SK_PITCH + (16 * ks + 8 * hf) * 2);
            acc[kt] = __builtin_amdgcn_mfma_f32_32x32x16_bf16(ak, bq[ks], acc[kt], 0, 0, 0);
        }
    }
    float v[64];
#pragma unroll
    for (int kt = 0; kt < 4; ++kt)
#pragma unroll
        for (int r = 0; r < 16; ++r) v[kt * 16 + r] = pack_key(acc[kt][r], (unsigned)(32 * kt + (r & 3) + 8 * (r >> 2) + 4 * hf), 0x7Fu);
    float other[16];
    top16_of_64(v, out);
#pragma unroll
    for (int i = 0; i < 16; ++i) other[i] = __shfl_xor(out[i], 32);
    merge_top16(out, other);
}
__device__ __forceinline__ void s_convert_tables(const Args& A, int gw, int NGW, int lane) {
    cvt_table_q8<true>(A.in[I_PU], A.ws + WS_UB, (float*)(A.ws + WS_USC), gw, NGW, lane);
    cvt_table_q8<false>(A.in[I_PV], A.ws + WS_VB, (float*)(A.ws + WS_VSC), gw, NGW, lane);
}
__device__ __forceinline__ void phase_s(const Args& A, LAS unsigned char* lds, int tid, int lane, int wave, int bid, int G) {
    const bf16* q = (const bf16*)(A.ws + WS_Q); const bf16* sk = (const bf16*)(A.ws + WS_SUBK);
    int* idx = (int*)(A.ws + WS_IDX); float* gate = (float*)(A.ws + WS_GATE);
    const int l31 = lane & 31, hf = lane >> 5;
    bool conv_done = false;
    for (int wi = bid; wi < (T / 512) * NH; wi += G) {
      const int h = wi & 7, tg = wi >> 3;
      __syncthreads();
#pragma unroll
      for (int i = 0; i < 8; ++i) { const int c = tid + i * NTHR, row = c >> 4, c16 = c & 15;
          *(LAS v4u*)(lds + row * SK_PITCH + c16 * 16) = *(const GAS v4u*)(sk + ((size_t)(h * 2 * NKEY + row)) * 128 + c16 * 8); }
      __syncthreads();
      if (S_CONV && wave >= 4 && !conv_done) s_convert_tables(A, bid * NWAVES + wave, G * NWAVES, lane);
      for (int ti = 0; ti < 2; ++ti) {
        const int tok = (tg * 16 + ti * 8 + wave) * 32 + l31;
        float s1[16], s2[16];
        score_top16(q, lds, tok, h, 0, l31, hf, s1);
        score_top16(q, lds, tok, h, 1, l31, hf, s2);
        float cv[64]; int n = 0;
#pragma unroll
        for (int i = 0; i < 16; ++i)
#pragma unroll
            for (int j = 0; j < 16; ++j)
                if ((i + 1) * (j + 1) <= 16) {
                    const float a = __builtin_bit_cast(float, __builtin_bit_cast(unsigned, s1[i]) & ~0x7Fu), c = __builtin_bit_cast(float, __builtin_bit_cast(unsigned, s2[j]) & ~0x7Fu);
                    cv[n++] = pack_key(a + c, (unsigned)(i * 16 + j), 0xFFu); }
#pragma unroll
        for (int m = 50; m < 64; ++m) cv[m] = -INFINITY;
        float c16[16];
        top16_of_64(cv, c16);
        float ev[16], esum = 0.f; const float cmax = __builtin_bit_cast(float, __builtin_bit_cast(unsigned, c16[0]) & ~0xFFu);
#pragma unroll
        for (int m = 0; m < 16; ++m) { ev[m] = __expf(__builtin_bit_cast(float, __builtin_bit_cast(unsigned, c16[m]) & ~0xFFu) - cmax); esum += ev[m]; }
        const float rs = 1.0f / esum;
        int oi[8]; float og[8];
#pragma unroll
        for (int mm = 0; mm < 8; ++mm) {
            float c_lo = c16[mm], c_hi = c16[8 + mm], e_lo = ev[mm], e_hi = ev[8 + mm];
            asm volatile("" : "+v"(c_lo), "+v"(c_hi), "+v"(e_lo), "+v"(e_hi));
            const unsigned cb = __builtin_bit_cast(unsigned, hf ? c_hi : c_lo); const int ii = (cb >> 4) & 15, jj = cb & 15;
            int row = 0, col = 0;
#pragma unroll
            for (int k = 0; k < 16; ++k) { row = (ii == k) ? (int)(__builtin_bit_cast(unsigned, s1[k]) & 0x7Fu) : row; col = (jj == k) ? (int)(__builtin_bit_cast(unsigned, s2[k]) & 0x7Fu) : col; }
            oi[mm] = row * NKEY + col; og[mm] = (hf ? e_hi : e_lo) * rs;
        }
        int* ip = idx + (size_t)tok * KSEL + h * 16 + hf * 8; float* gp = gate + (size_t)tok * KSEL + h * 16 + hf * 8;
        *(GAS v4u*)ip = (v4u){(unsigned)oi[0], (unsigned)oi[1], (unsigned)oi[2], (unsigned)oi[3]}; *(GAS v4u*)(ip + 4) = (v4u){(unsigned)oi[4], (unsigned)oi[5], (unsigned)oi[6], (unsigned)oi[7]};
        *(GAS f32x4*)gp = (f32x4){og[0], og[1], og[2], og[3]}; *(GAS f32x4*)(gp + 4) = (f32x4){og[4], og[5], og[6], og[7]};
      }
      if (S_CONV && wave < 4 && !conv_done) s_convert_tables(A, bid * NWAVES + wave, G * NWAVES, lane);
      conv_done = true;
    }
    if (S_CONV && !conv_done) s_convert_tables(A, bid * NWAVES + wave, G * NWAVES, lane);
    __syncthreads();
}

__device__ __forceinline__ float row_dot_fp8(const v4u d0, const v4u d1, const f32x2 (&hf)[2][8]) {
    const unsigned w0[4] = {d0.x, d0.y, d0.z, d0.w}, w1[4] = {d1.x, d1.y, d1.z, d1.w};
    f32x2 a = {0.f, 0.f}, b = {0.f, 0.f};
#pragma unroll
    for (int i = 0; i < 4; ++i) { a += fp8lo(w0[i]) * hf[0][2 * i]; a += fp8hi(w0[i]) * hf[0][2 * i + 1]; b += fp8lo(w1[i]) * hf[1][2 * i]; b += fp8hi(w1[i]) * hf[1][2 * i + 1]; }
    return (a.x + a.y) + (b.x + b.y);
}
__device__ __forceinline__ void row_axpy_fp8(f32x2 (&acc)[2][8], const v4u d0, const v4u d1, float w) {
    const unsigned w0[4] = {d0.x, d0.y, d0.z, d0.w}, w1[4] = {d1.x, d1.y, d1.z, d1.w};
#pragma unroll
    for (int i = 0; i < 4; ++i) { acc[0][2 * i] += fp8lo(w0[i]) * w; acc[0][2 * i + 1] += fp8hi(w0[i]) * w; acc[1][2 * i] += fp8lo(w1[i]) * w; acc[1][2 * i + 1] += fp8hi(w1[i]) * w; }
}
struct PuVisit { int tok, id0, id1; unsigned long long m0, m1, s0, s1; v4u h[2]; int kk[PU_NB]; v4u bu[PU_NB][2]; };
struct PuPre { int tok, id0, id1; v4u h[2]; };
__device__ __forceinline__ void pu_prefetch(PuPre& P, int tok, const int* idx, const unsigned char* h2q, int lane) {
    P.tok = tok; P.id0 = 0; P.id1 = 0; P.h[0] = (v4u){0u, 0u, 0u, 0u}; P.h[1] = (v4u){0u, 0u, 0u, 0u};
    if (tok < T) { P.id0 = idx[(size_t)tok * KSEL + lane]; P.id1 = idx[(size_t)tok * KSEL + 64 + lane];
        const GAS v4u* hp = (const GAS v4u*)(h2q + (size_t)tok * D) + lane; P.h[0] = hp[0]; P.h[1] = hp[64]; }
}
__device__ __forceinline__ void pu_issue(PuVisit& V, const unsigned char* ub, int lane) {
#pragma unroll
    for (int sl = 0; sl < PU_NB; ++sl) {
        V.kk[sl] = -1;
        if ((V.m0 | V.m1) != 0ull) {
            int k;
            if (V.m0 != 0ull) { k = __ffsll((long long)V.m0) - 1; V.m0 &= V.m0 - 1ull; } else { k = 64 + __ffsll((long long)V.m1) - 1; V.m1 &= V.m1 - 1ull; }
            V.kk[sl] = k;
            const int e = __builtin_amdgcn_readlane(k < 64 ? V.id0 : V.id1, k & 63);
            const GAS v4u* up = (const GAS v4u*)(ub + (size_t)e * D) + lane; V.bu[sl][0] = up[0]; V.bu[sl][1] = up[64];
        }
    }
}
__device__ __forceinline__ void pu_setup(PuVisit& V, const PuPre& P, int r, const unsigned char* ub, int lane) {
    V.tok = P.tok; V.id0 = P.id0; V.id1 = P.id1; V.h[0] = P.h[0]; V.h[1] = P.h[1];
    const bool ok = P.tok < T;
    V.m0 = ok ? __ballot((P.id0 >> PU_RSHIFT) == r) : 0ull; V.m1 = ok ? __ballot((P.id1 >> PU_RSHIFT) == r) : 0ull; V.s0 = V.m0; V.s1 = V.m1;
    pu_issue(V, ub, lane);
}
__device__ __forceinline__ int dpp_isum63(int v) {
    v += __builtin_amdgcn_update_dpp(0, v, 0xB1, 0xF, 0xF, false); v += __builtin_amdgcn_update_dpp(0, v, 0x4E, 0xF, 0xF, false);
    v += __builtin_amdgcn_update_dpp(0, v, 0x141, 0xF, 0xF, false); v += __builtin_amdgcn_update_dpp(0, v, 0x140, 0xF, 0xF, false);
    v += __builtin_amdgcn_update_dpp(0, v, 0x142, 0xA, 0xF, false); v += __builtin_amdgcn_update_dpp(0, v, 0x143, 0xC, 0xF, false);
    return v;
}
__device__ __forceinline__ void pu_compute(PuVisit& V, float* act, const unsigned char* ub, int lane) {
    if (V.tok >= T) return;
    float a0 = 0.f, a1 = 0.f;
    const int hw[8] = {(int)V.h[0].x, (int)V.h[0].y, (int)V.h[0].z, (int)V.h[0].w, (int)V.h[1].x, (int)V.h[1].y, (int)V.h[1].z, (int)V.h[1].w};
    for (;;) {
#pragma unroll
        for (int sl = 0; sl < PU_NB; ++sl) {
            if (V.kk[sl] >= 0) {
                const int uw[8] = {(int)V.bu[sl][0].x, (int)V.bu[sl][0].y, (int)V.bu[sl][0].z, (int)V.bu[sl][0].w, (int)V.bu[sl][1].x, (int)V.bu[sl][1].y, (int)V.bu[sl][1].z, (int)V.bu[sl][1].w};
                int d0 = 0, d1 = 0;
#pragma unroll
                for (int i = 0; i < 4; ++i) { d0 = __builtin_amdgcn_sdot4(uw[i], hw[i], d0, false); d1 = __builtin_amdgcn_sdot4(uw[4 + i], hw[4 + i], d1, false); }
                const float tot = (float)__builtin_amdgcn_readlane(dpp_isum63(d0 + d1), 63); const int k = V.kk[sl];
                a0 = (lane == k) ? tot : a0; a1 = (lane + 64 == k) ? tot : a1;
            }
        }
        if ((V.m0 | V.m1) == 0ull) break;
        pu_issue(V, ub, lane);
    }
    if ((V.s0 >> lane) & 1ull) act[(size_t)V.tok * KSEL + lane] = a0;
    if ((V.s1 >> lane) & 1ull) act[(size_t)V.tok * KSEL + 64 + lane] = a1;
}
__device__ __forceinline__ void phase_pu(const Args& A, int tid, int lane, int wave, int bid, int G) {
    const unsigned char* h2q = A.ws + WS_H2Q; const int* idx = (const int*)(A.ws + WS_IDX); const unsigned char* ub = A.ws + WS_UB; float* act = (float*)(A.ws + WS_ACT);
    const int NX = (G % 8 == 0) ? 8 : 1, vx = bid % NX, nw = (G / NX) * NWAVES, wv = (bid / NX) * NWAVES + wave;
    for (int r = vx; r < (NEXP >> PU_RSHIFT); r += NX) {
        PuVisit VA, VB; PuPre P0, P1;
        pu_prefetch(P0, wv, idx, h2q, lane);
        pu_prefetch(P1, wv + nw, idx, h2q, lane);
        pu_setup(VA, P0, r, ub, lane);
        pu_prefetch(P0, wv + 2 * nw, idx, h2q, lane);
        for (int tok = wv; tok < T; tok += 2 * nw) {
            pu_setup(VB, P1, r, ub, lane); pu_prefetch(P1, tok + 3 * nw, idx, h2q, lane);
            pu_compute(VA, act, ub, lane);
            pu_setup(VA, P0, r, ub, lane); pu_prefetch(P0, tok + 4 * nw, idx, h2q, lane);
            pu_compute(VB, act, ub, lane);
        }
    }
}
__device__ __forceinline__ void phase_pv(const Args& A, int lane, int wave, int bid, int G) {
    const unsigned char* vb = A.ws + WS_VB;
    const float* usc = (const float*)(A.ws + WS_USC); const float* vsc = (const float*)(A.ws + WS_VSC); const float* act = (const float*)(A.ws + WS_ACT); const float* hsc = (const float*)(A.ws + WS_HSC);
    const int* idx = (const int*)(A.ws + WS_IDX); const float* gate = (const float*)(A.ws + WS_GATE);
    bf16* y2 = (bf16*)(A.ws + WS_Y2); float* ssq = (float*)(A.ws + WS_SSQ);
    const int NX = (G % 8 == 0) ? 8 : 1, vx = bid % NX, nw = (G / NX) * NWAVES, wv = (bid / NX) * NWAVES + wave;
    for (int cb = vx; cb < D / 256; cb += NX) {
        const unsigned loff = (unsigned)(cb * 256 + lane * 4);
        int nid0 = 0, nid1 = 0; float ng0 = 0.f, ng1 = 0.f, na0 = 0.f, na1 = 0.f;
        int mid0 = 0, mid1 = 0; float mg0 = 0.f, mg1 = 0.f, ma0 = 0.f, ma1 = 0.f, mu0 = 0.f, mu1 = 0.f, mv0 = 0.f, mv1 = 0.f, mh = 0.f;
#define PVC_LOADA(t_) do { const int t__ = (t_); if (t__ < T) { nid0 = idx[(size_t)t__ * KSEL + lane]; nid1 = idx[(size_t)t__ * KSEL + 64 + lane]; ng0 = gate[(size_t)t__ * KSEL + lane]; ng1 = gate[(size_t)t__ * KSEL + 64 + lane]; \
            na0 = act[(size_t)t__ * KSEL + lane]; na1 = act[(size_t)t__ * KSEL + 64 + lane]; } } while (0)
#define PVC_LOADB(t_) do { const int t__ = (t_); mid0 = nid0; mid1 = nid1; mg0 = ng0; mg1 = ng1; ma0 = na0; ma1 = na1; \
            if (t__ < T) { mu0 = usc[mid0]; mu1 = usc[mid1]; mv0 = vsc[mid0]; mv1 = vsc[mid1]; mh = hsc[t__]; } } while (0)
        PVC_LOADA(wv); PVC_LOADB(wv); PVC_LOADA(wv + nw);
        unsigned rv[PVC_RB];
        const unsigned char* vcol = vb + loff;
#define PVC_ISSUE(slot, idr, kk) do { const int e_ = __builtin_amdgcn_readlane(idr, (kk) & 63); rv[slot] = *(const GAS unsigned*)(vcol + (size_t)e_ * D); } while (0)
#pragma unroll
        for (int r = 0; r < PVC_RB; ++r) PVC_ISSUE(r, mid0, r);
        for (int tok = wv; tok < T; tok += nw) {
            const int id0 = mid0, id1 = mid1;
            const float w0 = mg0 * gelu_tanh(ma0 * mu0 * mh) * mv0, w1 = mg1 * gelu_tanh(ma1 * mu1 * mh) * mv1;
            PVC_LOADB(tok + nw); PVC_LOADA(tok + 2 * nw);
            f32x2 a01 = {0.f, 0.f}, a23 = {0.f, 0.f};
            for (int k0 = 0; k0 < KSEL - PVC_RB; k0 += PVC_RB) {
                const float wc = (k0 & 64) ? w1 : w0; const int idn = ((k0 + PVC_RB) & 64) ? id1 : id0;
#pragma unroll
                for (int r = 0; r < PVC_RB; ++r) {
                    const float w = rdlane(wc, (k0 + r) & 63);
                    a01 += fp8lo(rv[r]) * w; a23 += fp8hi(rv[r]) * w;
                    PVC_ISSUE(r, idn, k0 + r + PVC_RB);
                }
            }
#pragma unroll
            for (int r = 0; r < PVC_RB; ++r) { const float w = rdlane(w1, (KSEL - PVC_RB + r) & 63); a01 += fp8lo(rv[r]) * w; a23 += fp8hi(rv[r]) * w;
                PVC_ISSUE(r, mid0, r); }
            const float sq = wave_total((a01.x * a01.x + a01.y * a01.y) + (a23.x * a23.x + a23.y * a23.y));
            *(GAS v2u*)(y2 + (size_t)tok * D + loff) = (v2u){pk2(a01.x, a01.y), pk2(a23.x, a23.y)};
            if (lane == 0) ssq[(size_t)cb * T + tok] = sq;
        }
#undef PVC_LOADA
#undef PVC_LOADB
    }
}
__device__ __forceinline__ void phase_f(const Args& A, int lane, int wave, int bid, int G) {
    const bf16* y1 = (const bf16*)(A.ws + WS_Y1); const bf16* y2 = (const bf16*)(A.ws + WS_Y2); const float* ssq = (const float*)(A.ws + WS_SSQ); const float* cfin = (const float*)(A.ws + WS_CFIN);
    for (int tok = bid * NWAVES + wave; tok < T; tok += G * NWAVES) {
        const int b = tok >> 13;
        float qs = 0.f;
#pragma unroll
        for (int c = 0; c < 8; ++c) qs += ssq[(size_t)c * T + tok];
        const float rstd2 = __builtin_amdgcn_rsqf(qs * (1.0f / D) + EPS);
        const GAS v2u* yp = (const GAS v2u*)(y1 + (size_t)tok * D) + lane; const GAS v2u* zp = (const GAS v2u*)(y2 + (size_t)tok * D) + lane;
        const GAS f32x4* xr = (const GAS f32x4*)(A.in[I_X] + (size_t)tok * D) + lane;
        v2u yq[8], zq[8]; f32x4 xv[8]; float s1 = 0.f;
#pragma unroll
        for (int i = 0; i < 8; ++i) { yq[i] = yp[i * 64]; zq[i] = zp[i * 64]; xv[i] = xr[i * 64]; }
#pragma unroll
        for (int i = 0; i < 8; ++i) { const float a = bflo(yq[i].x), b_ = bfhi(yq[i].x), c = bflo(yq[i].y), d = bfhi(yq[i].y); s1 += (a * a + b_ * b_) + (c * c + d * d); }
        const float rstd1 = __builtin_amdgcn_rsqf(wave_total(s1) * (1.0f / D) + EPS);
        const GAS f32x4* c1 = (const GAS f32x4*)(cfin + (size_t)(b * 2 + 0) * D) + lane; const GAS f32x4* c2 = (const GAS f32x4*)(cfin + (size_t)(b * 2 + 1) * D) + lane;
        GAS f32x4* orow = (GAS f32x4*)(A.out + (size_t)tok * D) + lane;
#pragma unroll
        for (int i = 0; i < 8; ++i) { const f32x4 a1 = c1[i * 64], a2 = c2[i * 64];
            const float yv[4] = {bflo(yq[i].x), bfhi(yq[i].x), bflo(yq[i].y), bfhi(yq[i].y)}, zv[4] = {bflo(zq[i].x), bfhi(zq[i].x), bflo(zq[i].y), bfhi(zq[i].y)}; f32x4 o;
#pragma unroll
            for (int e = 0; e < 4; ++e) o[e] = xv[i][e] + (OUT_MODE != 2 ? a1[e] * yv[e] * rstd1 : 0.f) + (OUT_MODE != 1 ? a2[e] * zv[e] * rstd2 : 0.f);
            orow[i * 64] = o; }
    }
}

#if defined(MK_CHECKS)
constexpr int CW_CHK = 2048;
__device__ __forceinline__ unsigned hsh(unsigned x) { x ^= x >> 16; x *= 0x7feb352dU; x ^= x >> 15; x *= 0x846ca68bU; x ^= x >> 16; return x; }
__device__ __forceinline__ float bfv(const bf16* p, size_t i) { return __builtin_bit_cast(float, (unsigned)p[i] << 16); }
__device__ __forceinline__ float relerr(float got, float ref, float scale) { const float d = fabsf(got - ref) / (fabsf(ref) + scale); return (d == d) ? d : 1e30f; }
__device__ __forceinline__ void chk_put(unsigned* ctl, int stage, float e) { atomicMax(ctl + CW_CHK + stage, __builtin_bit_cast(unsigned, e)); }
__device__ float chk_gemm(const bf16* Am, const bf16* Bt, const bf16* C, int N, int K, unsigned s) {
    const int row = hsh(s) % T, col = hsh(s * 7 + 1) % N; float acc = 0.f;
    for (int k = 0; k < K; ++k) acc += bfv(Am, (size_t)row * K + k) * bfv(Bt, (size_t)col * K + k);
    return relerr(bfv(C, (size_t)row * N + col), acc, 0.05f);
}
__global__ void __launch_bounds__(128) chk_kernel(Args A, int stage) {
    __shared__ float sh[10240];
    unsigned* ctl = (unsigned*)(A.ws + WS_CTL);
    const int tid = threadIdx.x; const unsigned s = hsh(tid * 2654435761u + stage * 97u + 12345u);
    const float* modp = (const float*)(A.ws + WS_MODP);
    float e = 0.f;
    if (stage == 0) {
        { const int b = s & 1, n = hsh(s) % NMOD; float acc = A.in[I_BMOD][n];
          for (int k = 0; k < D; ++k) { const float c = A.in[I_C][b * D + k]; acc += c / (1.0f + expf(-c)) * A.in[I_WMOD][(size_t)k * NMOD + n]; }
          e = fmaxf(e, relerr(mod_at(modp, b, n), acc, 0.01f)); }
        { const int n = hsh(s + 1) % IN_COLS, k = hsh(s + 2) % D; e = fmaxf(e, relerr(bfv((const bf16*)(A.ws + WS_BT1), (size_t)n * D + k), A.in[I_WIN][(size_t)k * IN_COLS + n], 1e-3f)); }
        { const int n = hsh(s + 3) % D, k = hsh(s + 4) % D; e = fmaxf(e, relerr(bfv((const bf16*)(A.ws + WS_BT2), (size_t)n * D + k), A.in[I_WOUT][(size_t)k * D + n], 1e-3f));
          e = fmaxf(e, relerr(bfv((const bf16*)(A.ws + WS_BT3), (size_t)n * D + k), A.in[I_WQ][(size_t)k * D + n], 1e-3f)); }
        { const int h = s & 7, n = hsh(s + 5) & 255, k = hsh(s + 6) & 127; const float ref = (n < 128 ? A.in[I_WA] : A.in[I_WX])[h * 16384 + k * 128 + (n & 127)];
          e = fmaxf(e, relerr(bfv((const bf16*)(A.ws + WS_WG), (size_t)(h * 256 + n) * 128 + k), ref, 1e-3f)); }
        { const int i = hsh(s + 7) % (NH * 2 * NKEY * 128); e = fmaxf(e, relerr(bfv((const bf16*)(A.ws + WS_SUBK), i), A.in[I_SUBK][i], 1e-3f)); }
    } else if (stage == 1) {
        const int row = hsh(s) % T, col = hsh(s + 1) % D, b = row >> 13; float ss = 0.f;
        for (int k = 0; k < D; ++k) { const float x = A.in[I_X][(size_t)row * D + k]; ss += x * x; }
        const float ref = A.in[I_X][(size_t)row * D + col] * rsqrtf(ss / D + EPS) * A.in[I_GPREMIX][col] * (1.0f + mod_at(modp, b, D + col)) + mod_at(modp, b, col);
        e = relerr(bfv((const bf16*)(A.ws + WS_RA), (size_t)row * D + col), ref, 0.05f);
        const float* cfin = (const float*)(A.ws + WS_CFIN);
        e = fmaxf(e, relerr(cfin[(b * 2 + 0) * D + col], mod_at(modp, b, 2 * D + col) * A.in[I_GPOSTMIX][col], 1e-3f));
        e = fmaxf(e, relerr(cfin[(b * 2 + 1) * D + col], mod_at(modp, b, 5 * D + col) * A.in[I_GPOSTFFN][col], 1e-3f));
    } else if (stage == 2) { e = chk_gemm((const bf16*)(A.ws + WS_RA), (const bf16*)(A.ws + WS_BT1), (const bf16*)(A.ws + WS_PROJ), IN_COLS, D, s);
    } else if (stage == 7) { e = chk_gemm((const bf16*)(A.ws + WS_RA), (const bf16*)(A.ws + WS_BT2), (const bf16*)(A.ws + WS_Y1), D, D, s);
    } else if (stage == 9) { e = chk_gemm((const bf16*)(A.ws + WS_RA), (const bf16*)(A.ws + WS_BT3), (const bf16*)(A.ws + WS_Q), D, D, s);
    } else if (stage == 3) {
        const bf16* proj = (const bf16*)(A.ws + WS_PROJ);
        int row = hsh(s) % T; if (tid < 16) row = (tid & 1) * SEQ + (tid >> 1);
        const int c = hsh(s + 1) % LRU_W, t = row & (SEQ - 1);
        float a = A.in[I_LCB][c];
        for (int j = 0; j < 4; ++j) if (t - 3 + j >= 0) a += A.in[I_LCW][j * LRU_W + c] * bfv(proj, (size_t)(row - 3 + j) * IN_COLS + c);
        e = relerr(bfv((const bf16*)(A.ws + WS_XL), (size_t)row * LRU_W + c), a, 0.05f);
        float z = A.in[I_CDB][c];
        for (int j = 0; j < CONF_K; ++j) if (t - 30 + j >= 0) { const size_t r = (size_t)(row - 30 + j) * IN_COLS; const float g = bfv(proj, r + 3072 + c);
            z += A.in[I_CDW][j * CONF_W + c] * bfv(proj, r + 2048 + c) / (1.0f + expf(-g)); }
        e = fmaxf(e, relerr(bfv((const bf16*)(A.ws + WS_ZC), (size_t)row * CONF_W + c), z, 0.05f));
    } else if (stage == 4) {
        const bf16* xl = (const bf16*)(A.ws + WS_XL);
        const int b = s & 1, chunk = hsh(s + 1) % NCHUNK, ch = hsh(s + 2) % LRU_W, hh = ch >> 7, j = ch & 127;
        const float cl = -8.0f * log1pf(expf(-A.in[I_LAMBDA][ch])); float P = 1.f, H = 0.f;
        for (int t = 0; t < CHUNK; ++t) { const size_t row = (size_t)b * SEQ + chunk * CHUNK + t; float ga = A.in[I_BA][ch], gx = A.in[I_BX][ch];
            for (int i = 0; i < 128; ++i) { const float xv = bfv(xl, row * LRU_W + hh * 128 + i); ga += xv * A.in[I_WA][hh * 16384 + i * 128 + j]; gx += xv * A.in[I_WX][hh * 16384 + i * 128 + j]; }
            const float r = 1.0f / (1.0f + expf(-ga)), ig = 1.0f / (1.0f + expf(-gx)), la = cl * r, a = expf(la), u = sqrtf(fmaxf(-expm1f(2.0f * la), 0.f)) * ig * bfv(xl, row * LRU_W + ch);
            H = a * H + u; P = P * a;
            e = fmaxf(e, relerr(bfv((const bf16*)(A.ws + WS_HLOC), row * LRU_W + ch), H, 0.05f)); e = fmaxf(e, relerr(bfv((const bf16*)(A.ws + WS_PC), row * LRU_W + ch), P, 0.02f)); }
        const float* ag = (const float*)(A.ws + WS_AGG) + ((size_t)(b * NCHUNK + chunk) * LRU_W + ch) * 2;
        e = fmaxf(e, relerr(ag[0], P, 0.02f)); e = fmaxf(e, relerr(ag[1], H, 0.05f));
    } else if (stage == 5) {
    } else if (stage == 6) {
        const bf16* proj = (const bf16*)(A.ws + WS_PROJ); const bf16* zc = (const bf16*)(A.ws + WS_ZC);
        const int row = hsh(s) % T, c = hsh(s + 1) % LRU_W, b = row >> 13, chunk = (row & (SEQ - 1)) >> 6;
        float cin = 0.f; for (int cc = 0; cc < chunk; ++cc) { const float* ag = (const float*)(A.ws + WS_AGG) + ((size_t)(b * NCHUNK + cc) * LRU_W + c) * 2; cin = ag[0] * cin + ag[1]; }
        const float hfull = bfv((const bf16*)(A.ws + WS_HLOC), (size_t)row * LRU_W + c) + bfv((const bf16*)(A.ws + WS_PC), (size_t)row * LRU_W + c) * cin;
        const float g = bfv(proj, (size_t)row * IN_COLS + 1024 + c), ge = 0.5f * g * (1.0f + tanhf(0.7978845608f * (g + 0.044715f * g * g * g)));
        e = relerr(bfv((const bf16*)(A.ws + WS_RA), (size_t)row * D + c), hfull * ge, 0.05f);
        float m = 0.f, q = 0.f;
        for (int k = 0; k < CONF_W; ++k) m += bfv(zc, (size_t)row * CONF_W + k);
        m /= CONF_W;
        for (int k = 0; k < CONF_W; ++k) { const float d = bfv(zc, (size_t)row * CONF_W + k) - m; q += d * d; }
        const float n = (bfv(zc, (size_t)row * CONF_W + c) - m) * rsqrtf(q / CONF_W + EPS) * A.in[I_LNG][c] + A.in[I_LNB][c];
        e = fmaxf(e, relerr(bfv((const bf16*)(A.ws + WS_RA), (size_t)row * D + 1024 + c), n / (1.0f + expf(-n)), 0.05f));
    } else if (stage == 8) {
        const bf16* y1 = (const bf16*)(A.ws + WS_Y1); const float* cfin = (const float*)(A.ws + WS_CFIN);
        const int row = hsh(s) % T, col = hsh(s + 1) % D, b = row >> 13; float s1 = 0.f, s2 = 0.f;
        for (int k = 0; k < D; ++k) { const float y = bfv(y1, (size_t)row * D + k); s1 += y * y; }
        const float r1 = rsqrtf(s1 / D + EPS);
        for (int k = 0; k < D; ++k) { const float x1 = A.in[I_X][(size_t)row * D + k] + cfin[(b * 2) * D + k] * bfv(y1, (size_t)row * D + k) * r1; s2 += x1 * x1; }
        const float x1c = A.in[I_X][(size_t)row * D + col] + cfin[(b * 2) * D + col] * bfv(y1, (size_t)row * D + col) * r1;
        const float ref = x1c * rsqrtf(s2 / D + EPS) * A.in[I_GPREFFN][col] * (1.0f + mod_at(modp, b, 4 * D + col)) + mod_at(modp, b, 3 * D + col);
        e = relerr(bfv((const bf16*)(A.ws + WS_RA), (size_t)row * D + col), ref, 0.05f);
    } else if (stage == 10) {
        { const size_t i = (size_t)(hsh(s + 2) % NEXP) * D + hsh(s + 3) % D;
          const unsigned wu = ((const unsigned*)(A.ws + WS_UB))[i >> 2] >> (8 * (i & 3)), wv = ((const unsigned*)(A.ws + WS_VB))[i >> 2] >> (8 * (i & 3));
          const float du = (float)(signed char)(wu & 255u) * ((const float*)(A.ws + WS_USC))[i / D], dv = __builtin_amdgcn_cvt_pk_f32_fp8((int)wv, false)[0] * ((const float*)(A.ws + WS_VSC))[i / D];
          e = fmaxf(e, relerr(du, A.in[I_PU][i], 2e-3f) * 0.3f); e = fmaxf(e, relerr(dv, A.in[I_PV][i], 3e-2f) * 0.3f); }
        if (tid < 32) {
            const bf16* q = (const bf16*)(A.ws + WS_Q); const int* idx = (const int*)(A.ws + WS_IDX); const float* gate = (const float*)(A.ws + WS_GATE);
            const int tok = hsh(s) % T, h = hsh(s + 1) & 7;
            float* sc = sh + tid * 320;
            for (int p = 0; p < 2; ++p) for (int n = 0; n < NKEY; ++n) { float a = 0.f;
                for (int d = 0; d < 128; ++d) a += bfv(q, (size_t)tok * D + h * 256 + p * 128 + d) * A.in[I_SUBK][((size_t)((h * 2 + p) * NKEY + n)) * 128 + d];
                sc[p * 128 + n] = a; }
            for (int p = 0; p < 2; ++p) { float prev = 1e30f; for (int it = 0; it < 16; ++it) { float best = -1e30f; int bi = 0;
                for (int n = 0; n < NKEY; ++n) { const float v = sc[p * 128 + n]; if (v < prev && v > best) { best = v; bi = n; } }
                sc[256 + p * 16 + it] = best; sc[288 + p * 16 + it] = (float)bi; prev = best; } }
            float prev = 1e30f, esum = 0.f, cmax = 0.f; int miss = 0; float gerr = 0.f;
            { float pv = 1e30f; for (int it = 0; it < 16; ++it) { float best = -1e30f;
                for (int c = 0; c < 256; ++c) { const float v = sc[256 + (c >> 4)] + sc[272 + (c & 15)]; if (v < pv && v > best) best = v; }
                if (it == 0) cmax = best; esum += expf(best - cmax); pv = best; } }
            for (int it = 0; it < 16; ++it) { float best = -1e30f; int bc = 0;
                for (int c = 0; c < 256; ++c) { const float v = sc[256 + (c >> 4)] + sc[272 + (c & 15)]; if (v < prev && v > best) { best = v; bc = c; } }
                prev = best;
                const int eidx = (int)sc[288 + (bc >> 4)] * NKEY + (int)sc[304 + (bc & 15)]; const float g = expf(best - cmax) / esum; bool found = false;
                for (int m = 0; m < 16; ++m) if (idx[(size_t)tok * KSEL + h * 16 + m] == eidx) { found = true; gerr = fmaxf(gerr, relerr(gate[(size_t)tok * KSEL + h * 16 + m], g, 0.02f)); }
                if (!found) ++miss; }
            e = fmaxf((float)miss / 16.0f, gerr);
        }
    } else if (stage == 11) {
        const bf16* h2 = (const bf16*)(A.ws + WS_RA); const bf16* y1 = (const bf16*)(A.ws + WS_Y1); const int* idx = (const int*)(A.ws + WS_IDX); const float* gate = (const float*)(A.ws + WS_GATE); const float* cfin = (const float*)(A.ws + WS_CFIN);
        const int tok = hsh(blockIdx.x * 977u + 5u) % T, b = tok >> 13;
        { const int ex = idx[(size_t)tok * KSEL + tid]; float a = 0.f;
          if ((unsigned)ex < (unsigned)NEXP) { for (int d = 0; d < D; ++d) a += bfv(h2, (size_t)tok * D + d) * A.in[I_PU][(size_t)ex * D + d]; } else a = 1e30f;
          const float ge = 0.5f * a * (1.0f + tanhf(0.7978845608f * (a + 0.044715f * a * a * a)));
          sh[tid] = gate[(size_t)tok * KSEL + tid] * ge; sh[128 + tid] = __builtin_bit_cast(float, ex); }
        __syncthreads();
        float s2 = 0.f, s1 = 0.f;
        for (int cc = 0; cc < 16; ++cc) { const int col = cc * 128 + tid; float a = 0.f;
            for (int k = 0; k < KSEL; ++k) { const int ex = __builtin_bit_cast(int, sh[128 + k]); if ((unsigned)ex < (unsigned)NEXP) a += sh[k] * A.in[I_PV][(size_t)ex * D + col]; }
            sh[512 + cc * 128 + tid] = a; s2 += a * a; const float y = bfv(y1, (size_t)tok * D + col); s1 += y * y; }
        __syncthreads(); sh[256 + tid] = s2; sh[384 + tid] = s1; __syncthreads();
        float t2 = 0.f, t1 = 0.f; for (int k = 0; k < 128; ++k) { t2 += sh[256 + k]; t1 += sh[384 + k]; }
        const float r2 = rsqrtf(t2 / D + EPS), r1 = rsqrtf(t1 / D + EPS);
        float en = 0.f, ed = 0.f;
        for (int cc = 0; cc < 16; ++cc) { const int col = cc * 128 + tid;
            const float pterm = cfin[(b * 2 + 1) * D + col] * sh[512 + cc * 128 + tid] * r2;
            const float ref = A.in[I_X][(size_t)tok * D + col] + (OUT_MODE != 2 ? cfin[(b * 2) * D + col] * bfv(y1, (size_t)tok * D + col) * r1 : 0.f) + (OUT_MODE != 1 ? pterm : 0.f);
            const float d = A.out[(size_t)tok * D + col] - ref; en += d * d; ed += pterm * pterm; }
        __syncthreads(); sh[256 + tid] = en; sh[384 + tid] = ed; __syncthreads();
        float ten = 0.f, ted = 0.f; for (int k = 0; k < 128; ++k) { ten += sh[256 + k]; ted += sh[384 + k]; }
        e = ten / (ted + 1e-12f); if (!(e == e)) e = 1e30f;
    }
    chk_put(ctl, stage, e);
}
__global__ void chk_encode(Args A, int what) {
    const unsigned* ctl = (const unsigned*)(A.ws + WS_CTL);
    if (threadIdx.x == 0 && blockIdx.x == 0) {
        if (what < 0) {
            const float thr[12] = {0.03f, 0.03f, 0.03f, 0.03f, 0.06f, 0.01f, 0.04f, 0.03f, 0.03f, 0.03f, 0.2f, 0.01f};
            for (int st = 0; st < 12; ++st) { const float e = __builtin_bit_cast(float, ctl[CW_CHK + st]); if (!(e <= thr[st])) { A.out[0] = 4000.0f * (float)(1 << st); break; } }
        } else {
            const float e = fminf(__builtin_bit_cast(float, ctl[CW_CHK + what]), 1e6f); A.out[0] = 4000.0f * sqrtf(1e6f * e);
        }
    }
}
#endif

__global__ void __launch_bounds__(NTHR, 2) fwd_kernel(Args args) {
    extern __shared__ __attribute__((aligned(16))) unsigned char lds_raw[];
    LAS unsigned char* lds = (LAS unsigned char*)lds_raw;
    const int tid = threadIdx.x, lane = tid & 63, wave = __builtin_amdgcn_readfirstlane(tid >> 6), bid = blockIdx.x, G = gridDim.x;
    for (int u = tid; u < (LDS_BYTES - LDSCTL_OFF) / 4; u += NTHR) ((LAS unsigned*)(lds + LDSCTL_OFF))[u] = 0u;
    __syncthreads();
    unsigned* ctl = (unsigned*)(args.ws + WS_CTL);
    XcdBarrier bar; bar.bar = ctl + CW_BAR + args.li * XCD_BAR_WORDS; bar.x = 0; bar.st = nullptr;
    if (MK_N_LAUNCHES != N_PHASES) bar = xcd_barrier_post(ctl + CW_BAR + args.li * XCD_BAR_WORDS, (volatile LAS unsigned*)(lds + MISC_OFF) + 8);
    const int lo = args.ph_lo, hi = args.ph_hi;
#define IN(k) (lo <= (k) && (k) < hi)
#define SEAM(k) do { if (IN(k) && IN((k) + 1)) xcd_barrier(bar); } while (0)
#define PHON(k) ((PH_MASK >> (k)) & 1)
    if (PHON(0) && IN(0)) { phase_p0(args, lds, tid, lane, wave, bid, G); }
    SEAM(0);
    if (PHON(1) && IN(1)) { phase_p1(args, tid, lane, wave, bid, G); }
    SEAM(1);
    if (PHON(2) && IN(2)) {
        pg8::Gemm g{(const bf16*)(args.ws + WS_RA), (const bf16*)(args.ws + WS_BT1), T, IN_COLS, D}; pg8::StaticOrder S; S.init(T, IN_COLS, G, bid);
        pg8::EpiBf16<0> E{(bf16*)(args.ws + WS_PROJ), IN_COLS, nullptr, 0, 0, 1.f};
        pg8::gemm_phase<pg8::EpiBf16<0>, pg8::StaticOrder, PG8_ALIGN, PG8_SP2>(lds + RING_OFF, g, S, E);
    }
    SEAM(2);
    if (PHON(3) && IN(3)) { phase_m1a(args, lds, tid, lane, wave, bid, G); }
    SEAM(3);
    if (PHON(4) && IN(4)) { phase_m1b(args, tid, lane, wave, bid, G); }
    SEAM(4);
    if (PHON(5) && IN(5)) { phase_m3(args, lds, tid, lane, wave, bid, G); }
    SEAM(5);
    if (PHON(6) && IN(6)) {
        pg8::Gemm g{(const bf16*)(args.ws + WS_RA), (const bf16*)(args.ws + WS_BT2), T, D, D}; pg8::StaticOrder S; S.init(T, D, G, bid);
        pg8::EpiBf16<0> E{(bf16*)(args.ws + WS_Y1), D, nullptr, 0, 0, 1.f};
        pg8::gemm_phase<pg8::EpiBf16<0>, pg8::StaticOrder, PG8_ALIGN, PG8_SP2>(lds + RING_OFF, g, S, E);
    }
    SEAM(6);
    if (PHON(7) && IN(7)) { phase_e2(args, tid, lane, wave, bid, G); }
    SEAM(7);
    if (PHON(8) && IN(8)) {
        pg8::Gemm g{(const bf16*)(args.ws + WS_RA), (const bf16*)(args.ws + WS_BT3), T, D, D}; pg8::StaticOrder S; S.init(T, D, G, bid);
        pg8::EpiBf16<0> E{(bf16*)(args.ws + WS_Q), D, nullptr, 0, 0, 1.f};
        pg8::gemm_phase<pg8::EpiBf16<0>, pg8::StaticOrder, PG8_ALIGN, PG8_SP2>(lds + RING_OFF, g, S, E);
    }
    SEAM(8);
    if (PHON(9) && IN(9)) { phase_s(args, lds, tid, lane, wave, bid, G); }
    SEAM(9);
    if (PHON(10) && IN(10)) { phase_pu(args, tid, lane, wave, bid, G); }
    SEAM(10);
    if (PHON(11) && IN(11)) { phase_pv(args, lane, wave, bid, G); }
    SEAM(11);
    if (PHON(12) && IN(12)) { phase_f(args, lane, wave, bid, G); }
#undef IN
#undef SEAM
}

extern "C" void kernel_launch(void* const* d_in, const int* in_sizes, int n_in, void* d_out, int out_size, void* d_ws, size_t ws_size, hipStream_t stream) {
    static int grid = 0;
    if (grid == 0) {
        if (n_in != 25 || in_sizes[0] != T * D || out_size != T * D || ws_size < WS_END) {
            fprintf(stderr, "kernel_launch: built for 25 inputs, x/out of %d floats, >= %zu bytes of workspace; got n_in %d, in0 %d, out %d, ws %zu; nothing launched\n", T * D, (size_t)WS_END, n_in, n_in > 0 ? in_sizes[0] : -1, out_size, ws_size);
            grid = -1; return; }
        int dev = 0, cus = 0, per_cu = 0;
        if (hipGetDevice(&dev) != hipSuccess || hipDeviceGetAttribute(&cus, hipDeviceAttributeMultiprocessorCount, dev) != hipSuccess) { fprintf(stderr, "kernel_launch: device query failed\n"); grid = -1; return; }
        if (hipFuncSetAttribute((const void*)fwd_kernel, hipFuncAttributeMaxDynamicSharedMemorySize, LDS_BYTES) != hipSuccess) { fprintf(stderr, "kernel_launch: hipFuncSetAttribute failed\n"); grid = -1; return; }
        if (hipOccupancyMaxActiveBlocksPerMultiprocessor(&per_cu, (const void*)fwd_kernel, NTHR, LDS_BYTES) != hipSuccess || per_cu < 1)
            fprintf(stderr, "kernel_launch: note: occupancy query reports %d workgroups per CU\n", per_cu);
        (void)hipGetLastError();
        grid = cus;
    }
    if (grid < 0) return;
    if (hipMemsetAsync((char*)d_ws + WS_CTL, 0, CTL_ZERO_BYTES, stream) != hipSuccess) { fprintf(stderr, "kernel_launch: memset failed\n"); return; }
    Args a{};
    for (int i = 0; i < 25; ++i) a.in[i] = (const float*)d_in[i];
    a.out = (float*)d_out; a.ws = (unsigned char*)d_ws;
#if defined(MK_TIME_REP)
    const int cuts[3][2] = {{0, MK_TIME_REP + 1}, {MK_TIME_REP, MK_TIME_REP + 1}, {MK_TIME_REP + 1, N_PHASES}};
    for (int li = 0; li < 3; ++li) {
        a.ph_lo = cuts[li][0]; a.ph_hi = cuts[li][1]; a.li = li;
        if (a.ph_lo < a.ph_hi) hipLaunchKernelGGL(fwd_kernel, dim3(grid), dim3(NTHR), LDS_BYTES, stream, a);
    }
#else
    for (int li = 0; li < MK_N_LAUNCHES; ++li) {
        if (MK_N_LAUNCHES == 1) { a.ph_lo = 0; a.ph_hi = N_PHASES; } else { a.ph_lo = li; a.ph_hi = li + 1; }
        a.li = 0;
        hipLaunchKernelGGL(fwd_kernel, dim3(grid), dim3(NTHR), LDS_BYTES, stream, a);
        const hipError_t le = hipPeekAtLastError();
        if (le != hipSuccess) { fprintf(stderr, "kernel_launch: launch %d failed: %s\n", li, hipGetErrorName(le)); break; }
#if defined(MK_CHECKS)
        { const int chk_of_phase[N_PHASES] = {0, 1, 2, 3, 4, 6, 7, 8, 9, 10, 5, 5, 11}; hipLaunchKernelGGL(chk_kernel, dim3(4), dim3(128), 0, stream, a, chk_of_phase[li]); }
#endif
    }
#endif
#if defined(MK_CHECKS)
    hipLaunchKernelGGL(chk_encode, dim3(1), dim3(64), 0, stream, a, MK_CHECKS);
#endif
}
```

```cpp
#include <hip/hip_runtime.h>
#include <cstdio>
#include <cstdint>
#include <cmath>
namespace pg8 {
#define PG8_LAS __attribute__((address_space(3)))
typedef unsigned short bf16_t;
typedef short bf16x8 __attribute__((ext_vector_type(8)));
typedef float f32x4 __attribute__((ext_vector_type(4)));
typedef unsigned u32x4 __attribute__((ext_vector_type(4)));
constexpr int BM = 256, BK = 64, HALF = 128, HTB = HALF * BK * 2  , STAGE_BYTES = 8 * HTB, NXCD = 8, WGM = 8;

__host__ __device__ __forceinline__ int lds_byte(int r, int c) { const int st = (r >> 4) * 2 + (c >> 5), rr = r & 15, cc = c & 31, ob = rr * 64 + cc * 2; return st * 1024 + (ob ^ (((ob >> 9) & 1) << 5)); }
__host__ __device__ __forceinline__ void stage_rc(int b, int& R, int& C) { const int st = b / 1024, sb = b % 1024, swz = sb ^ (((sb >> 9) & 1) << 5); R = (st >> 1) * 16 + swz / 64; C = (st & 1) * 32 + (swz % 64) / 2; }
__host__ __device__ __forceinline__ int perm32(int rho) { const int n = rho >> 4, i = rho & 15; return 8 * (i >> 2) + 4 * n + (i & 3); }

struct Unit { int pm, pn; };
struct Gemm { const bf16_t* A; const bf16_t* Bt; int M, N, K; };

struct StaticOrder {
    int nM, nN, nwg, G, c;
    __host__ __device__ void init(int M, int N, int G_, int c_) { nM = M / BM; nN = N / BM; nwg = nM * nN; G = G_; c = c_; }
    __host__ __device__ bool next(int i, Unit& u) const {
        const long L = (long)i * G + c; if (L >= nwg) return false;
        int wgid = (int)L; { const int q = nwg / NXCD, r = nwg % NXCD, xcd = wgid % NXCD, off = wgid / NXCD; wgid = (xcd < r ? xcd * (q + 1) : r * (q + 1) + (xcd - r) * q) + off; }
        const int nig = WGM * nN, gid = wgid / nig, fm = gid * WGM, gsz = (nM - fm) < WGM ? (nM - fm) : WGM;
        u.pm = fm + ((wgid % nig) % gsz); u.pn = (wgid % nig) / gsz; return true;
    }
    __device__ __forceinline__ void a_ready(const Unit&) const {}
    __device__ __forceinline__ void done(const Unit&) const {}
};

__device__ __forceinline__ unsigned cvt_pk_bf16(float lo, float hi) { unsigned r; asm volatile("v_cvt_pk_bf16_f32 %0, %1, %2" : "=v"(r) : "v"(lo), "v"(hi)); return r; }
typedef float f32x2 __attribute__((ext_vector_type(2)));
__device__ __forceinline__ f32x2 gelu_pk(f32x2 v) {
    const f32x2 av = __builtin_elementwise_abs(v), d = av * 0.2316418882f + 1.0f;
    f32x2 t; t.x = __builtin_amdgcn_rcpf(d.x); t.y = __builtin_amdgcn_rcpf(d.y);
    f32x2 q = t * 0.5307027145f + (-0.7265760135f); q = q * t + 0.7107068705f; q = q * t + (-0.142248368f); q = q * t + 0.127414796f; q = q * t;
    const f32x2 s = (v * v) * (-0.72134752044f);
    f32x2 e; e.x = __builtin_amdgcn_exp2f(s.x); e.y = __builtin_amdgcn_exp2f(s.y);
    const f32x2 m = v * (q * e), r = v - m;
    f32x2 o; o.x = v.x < 0.f ? m.x : r.x; o.y = v.y < 0.f ? m.y : r.y; return o;
}

template <int ACT  > struct EpiBf16 {
    static constexpr bool PERM = true, AFTER_DRAIN = false; static_assert(ACT == 0 || ACT == 1, "EpiBf16: ACT is 0 (none) or 1 (gelu_pk)");
    bf16_t* O; int ldc; const float* bias; int split_cols; size_t split_stride; float scale0;
    __device__ __forceinline__ void operator()(const f32x4 (&acc)[2][2][4][2], const Unit& u, int wr, int wc, int fr, int fq) const {
        const int row0 = u.pm * BM + wr * 64 + fr; int colt = u.pn * BM; bf16_t* base = O;
        float sc = 1.f; if (split_cols) { const int t = colt / split_cols; base += (size_t)t * split_stride; colt -= t * split_cols; if (t == 0) sc = scale0; }
        const int col0 = colt + wc * 32 + 8 * fq, bcol0 = u.pn * BM + wc * 32 + 8 * fq;
        f32x4 bv[2][2];
#pragma unroll
        for (int bj = 0; bj < 2; ++bj)
#pragma unroll
            for (int n = 0; n < 2; ++n) bv[bj][n] = bias ? *(const f32x4*)(bias + bcol0 + bj * HALF + 4 * n) : (f32x4){0.f, 0.f, 0.f, 0.f};
#pragma unroll
        for (int ai = 0; ai < 2; ++ai)
#pragma unroll
            for (int m = 0; m < 4; ++m) { bf16_t* rowp = base + (size_t)(row0 + ai * HALF + m * 16) * ldc + col0;
#pragma unroll
                for (int bj = 0; bj < 2; ++bj) { f32x4 v0 = acc[ai][bj][m][0] + bv[bj][0], v1 = acc[ai][bj][m][1] + bv[bj][1];
                    if (ACT == 1) { f32x2 a = gelu_pk((f32x2){v0[0], v0[1]}), b = gelu_pk((f32x2){v0[2], v0[3]}), c = gelu_pk((f32x2){v1[0], v1[1]}), d = gelu_pk((f32x2){v1[2], v1[3]});
                        v0 = (f32x4){a.x, a.y, b.x, b.y}; v1 = (f32x4){c.x, c.y, d.x, d.y}; }
                    v0 = v0 * sc; v1 = v1 * sc; u32x4 w; w.x = cvt_pk_bf16(v0[0], v0[1]); w.y = cvt_pk_bf16(v0[2], v0[3]); w.z = cvt_pk_bf16(v1[0], v1[1]); w.w = cvt_pk_bf16(v1[2], v1[3]);
                    *(u32x4*)(rowp + bj * HALF) = w; } }
    }
};
template <class Epi, class Sched, bool ALIGN_EPI = false, bool SP2 = false>
__device__ __forceinline__ void gemm_phase(PG8_LAS unsigned char* lds, const Gemm g, const Sched& S, const Epi& E) {
    const int tid = threadIdx.x, wid = __builtin_amdgcn_readfirstlane(tid >> 6), lane = tid & 63, wr = wid >> 2, wc = wid & 3, fr = lane & 15, fq = lane >> 4;
    const int K = g.K, nt = K / BK;
    unsigned voffA[2], voffB[2];
#pragma unroll
    for (int i = 0; i < 2; ++i) { int R, C; stage_rc(tid * 16 + i * 8192, R, C); const int Rb = Epi::PERM ? ((R & ~31) + perm32(R & 31)) : R;
        voffA[i] = (unsigned)(R * K + C) * 2u; voffB[i] = (unsigned)(Rb * K + C) * 2u; }
    const size_t kstep = (size_t)(BK * 2);
    const size_t hstep = (size_t)HALF * K * 2;
    const size_t tstep = 2 * hstep;
    const unsigned ldsw = (unsigned)wid * 1024u;
    const int aoff = lds_byte(wr * 64 + fr, fq * 8), boff = lds_byte(wc * 32 + fr, fq * 8);
#define PG8_SA(b, h) (((b) * 2 + (h)) * HTB)
#define PG8_SB(b, h) ((4 + (b) * 2 + (h)) * HTB)
#define PG8_STAGE(bufoff, gbase, voff) do { _Pragma("unroll") for (int _i = 0; _i < 2; ++_i) \
        __builtin_amdgcn_global_load_lds((const unsigned*)((const char*)(gbase) + (voff)[_i]), (PG8_LAS unsigned*)(lds + (bufoff) + ldsw + _i * 8192), 16, 0, 0); } while (0)
#define PG8_LDA(dst, b, h) do { _Pragma("unroll") for (int m = 0; m < 4; ++m) _Pragma("unroll") for (int k = 0; k < 2; ++k) dst[m][k] = *(const PG8_LAS bf16x8*)(lds + PG8_SA(b, h) + aoff + m * 2048 + k * 1024); } while (0)
#define PG8_LDB(dst, b, h) do { _Pragma("unroll") for (int n = 0; n < 2; ++n) _Pragma("unroll") for (int k = 0; k < 2; ++k) dst[n][k] = *(const PG8_LAS bf16x8*)(lds + PG8_SB(b, h) + boff + n * 2048 + k * 1024); } while (0)
#define PG8_MMA(ai, bj, At, Bt) do { __builtin_amdgcn_s_setprio(1); _Pragma("unroll") for (int m = 0; m < 4; ++m) _Pragma("unroll") for (int n = 0; n < 2; ++n) _Pragma("unroll") for (int k = 0; k < 2; ++k) \
        acc[ai][bj][m][n] = __builtin_amdgcn_mfma_f32_16x16x32_bf16(Bt[n][k], At[m][k], acc[ai][bj][m][n], 0, 0, 0); __builtin_amdgcn_s_setprio(0); } while (0)
#define PG8_WAIT_V(n) asm volatile("s_waitcnt vmcnt(" #n ")" ::: "memory")
#define PG8_WAIT_L(n) asm volatile("s_waitcnt lgkmcnt(" #n ")" ::: "memory")
#define PG8_BAR __builtin_amdgcn_s_barrier()
#define PG8_SCHED __builtin_amdgcn_sched_barrier(0)
    Unit cur, nxt; int ui = 0;
    if (!S.next(0, cur)) return;
    f32x4 acc[2][2][4][2];
#pragma unroll
    for (int a = 0; a < 2; ++a)
#pragma unroll
        for (int b = 0; b < 2; ++b)
#pragma unroll
            for (int m = 0; m < 4; ++m)
#pragma unroll
                for (int n = 0; n < 2; ++n) acc[a][b][m][n] = (f32x4){0.f, 0.f, 0.f, 0.f};
    bf16x8 At[4][2], B0[2][2], B1[2][2];
    const char* cA = (const char*)g.A + (size_t)cur.pm * tstep; const char* cB = (const char*)g.Bt + (size_t)cur.pn * tstep;
    S.a_ready(cur);
    if constexpr (SP2) {
        PG8_STAGE(PG8_SB(0, 0), cB, voffB); PG8_STAGE(PG8_SB(0, 1), cB + hstep, voffB); PG8_STAGE(PG8_SA(0, 0), cA, voffA); PG8_STAGE(PG8_SA(0, 1), cA + hstep, voffA);
        if (wr == 1) PG8_BAR;
        PG8_WAIT_V(2); PG8_BAR;
        PG8_STAGE(PG8_SB(1, 0), cB + kstep, voffB); PG8_STAGE(PG8_SA(1, 0), cA + kstep, voffA); PG8_STAGE(PG8_SB(1, 1), cB + hstep + kstep, voffB);
        PG8_WAIT_V(6); PG8_BAR;
    } else {
        PG8_STAGE(PG8_SB(0, 0), cB, voffB); PG8_STAGE(PG8_SA(0, 0), cA, voffA); PG8_STAGE(PG8_SB(0, 1), cB + hstep, voffB); PG8_STAGE(PG8_SA(0, 1), cA + hstep, voffA);
        if (wr == 1) PG8_BAR;
        PG8_WAIT_V(4); PG8_BAR;
        PG8_STAGE(PG8_SB(1, 0), cB + kstep, voffB); PG8_STAGE(PG8_SA(1, 0), cA + kstep, voffA); PG8_STAGE(PG8_SB(1, 1), cB + hstep + kstep, voffB);
        PG8_WAIT_V(6); PG8_BAR;
    }
    for (;;) {
        const bool has_next = S.next(ui + 1, nxt);
        const char* nA = has_next ? (const char*)g.A + (size_t)nxt.pm * tstep : cA; const char* nB = has_next ? (const char*)g.Bt + (size_t)nxt.pn * tstep : cB;
        for (int t = 0; t < nt; t += 2) {
            const bool last = (t == nt - 2);
            const char* a1 = cA + (size_t)(t + 1) * kstep;
            const char* a2 = last ? nA : cA + (size_t)(t + 2) * kstep; const char* b2 = last ? nB : cB + (size_t)(t + 2) * kstep;
            const char* a3 = a2 + kstep; const char* b3 = b2 + kstep;
            if (last && has_next) S.a_ready(nxt);
            if constexpr (SP2) {
            PG8_LDB(B0, 0, 0); PG8_LDB(B1, 0, 1); PG8_SCHED; PG8_LDA(At, 0, 0); PG8_STAGE(PG8_SA(1, 1), a1 + hstep, voffA);
            PG8_WAIT_V(8); PG8_WAIT_L(0); PG8_BAR; PG8_MMA(0, 0, At, B0); PG8_MMA(0, 1, At, B1); PG8_BAR; PG8_SCHED;
            PG8_LDA(At, 0, 1); PG8_STAGE(PG8_SB(0, 0), b2, voffB); PG8_STAGE(PG8_SB(0, 1), b2 + hstep, voffB); PG8_STAGE(PG8_SA(0, 0), a2, voffA);
            PG8_WAIT_V(8); PG8_WAIT_L(0); PG8_BAR; PG8_MMA(1, 0, At, B0); PG8_MMA(1, 1, At, B1); PG8_BAR; PG8_SCHED;
            PG8_LDB(B0, 1, 0); PG8_LDB(B1, 1, 1); PG8_SCHED; PG8_LDA(At, 1, 0); PG8_STAGE(PG8_SA(0, 1), a2 + hstep, voffA);
            PG8_WAIT_V(8); PG8_WAIT_L(0); PG8_BAR; PG8_MMA(0, 0, At, B0); PG8_MMA(0, 1, At, B1); PG8_BAR; PG8_SCHED;
            PG8_LDA(At, 1, 1); PG8_STAGE(PG8_SB(1, 0), b3, voffB); PG8_STAGE(PG8_SB(1, 1), b3 + hstep, voffB); PG8_STAGE(PG8_SA(1, 0), a3, voffA);
            PG8_WAIT_V(8); PG8_WAIT_L(0); PG8_BAR; PG8_MMA(1, 0, At, B0); PG8_MMA(1, 1, At, B1); PG8_BAR; PG8_SCHED;
            } else {
            PG8_LDB(B0, 0, 0); PG8_SCHED; PG8_LDA(At, 0, 0); PG8_STAGE(PG8_SA(1, 1), a1 + hstep, voffA);
            PG8_WAIT_L(8); PG8_BAR; PG8_WAIT_L(0); PG8_MMA(0, 0, At, B0); PG8_BAR; PG8_SCHED;
            PG8_LDB(B1, 0, 1); PG8_STAGE(PG8_SB(0, 0), b2, voffB);
            PG8_BAR; PG8_WAIT_L(0); PG8_MMA(0, 1, At, B1); PG8_BAR;
            PG8_LDA(At, 0, 1); PG8_STAGE(PG8_SA(0, 0), a2, voffA);
            PG8_BAR; PG8_WAIT_L(0); PG8_MMA(1, 0, At, B0); PG8_BAR; PG8_SCHED;
            PG8_STAGE(PG8_SB(0, 1), b2 + hstep, voffB);
            PG8_WAIT_V(6); PG8_BAR; PG8_MMA(1, 1, At, B1); PG8_BAR;
            PG8_LDB(B0, 1, 0); PG8_SCHED; PG8_LDA(At, 1, 0); PG8_STAGE(PG8_SA(0, 1), a2 + hstep, voffA);
            PG8_WAIT_L(8); PG8_BAR; PG8_WAIT_L(0); PG8_MMA(0, 0, At, B0); PG8_BAR; PG8_SCHED;
            PG8_LDB(B1, 1, 1); PG8_STAGE(PG8_SB(1, 0), b3, voffB);
            PG8_BAR; PG8_WAIT_L(0); PG8_MMA(0, 1, At, B1); PG8_BAR;
            PG8_LDA(At, 1, 1); PG8_STAGE(PG8_SA(1, 0), a3, voffA);
            PG8_BAR; PG8_WAIT_L(0); PG8_MMA(1, 0, At, B0); PG8_BAR; PG8_SCHED;
            PG8_STAGE(PG8_SB(1, 1), b3 + hstep, voffB);
            PG8_WAIT_V(6); PG8_BAR; PG8_MMA(1, 1, At, B1); PG8_BAR;
            }
        }
        if constexpr (ALIGN_EPI) { if (wr == 0) PG8_BAR; }
        if constexpr (!Epi::AFTER_DRAIN) { E(acc, cur, wr, wc, fr, fq); S.done(cur); }
        if (!has_next) break;
#pragma unroll
        for (int a = 0; a < 2; ++a)
#pragma unroll
            for (int b = 0; b < 2; ++b)
#pragma unroll
                for (int m = 0; m < 4; ++m)
#pragma unroll
                    for (int n = 0; n < 2; ++n) acc[a][b][m][n] = (f32x4){0.f, 0.f, 0.f, 0.f};
        cur = nxt; cA = nA; cB = nB; ++ui;
        if constexpr (ALIGN_EPI) { if (wr == 1) PG8_BAR; }
    }
    PG8_WAIT_V(0);
    if constexpr (!ALIGN_EPI) { if (wr == 0) PG8_BAR; }
    PG8_BAR;
    if constexpr (Epi::AFTER_DRAIN) { E.fused(acc, cur, wr, wc, fr, fq, lds, wid, lane); S.done(cur); }
#undef PG8_SA
#undef PG8_SB
#undef PG8_STAGE
#undef PG8_LDA
#undef PG8_LDB
#undef PG8_MMA
#undef PG8_WAIT_V
#undef PG8_WAIT_L
#undef PG8_BAR
#undef PG8_SCHED
}
}
#ifndef PG8_SP2
#define PG8_SP2 true
#endif
#ifndef PG8_ALIGN
#define PG8_ALIGN true
#endif
#ifndef OUT_MODE
#define OUT_MODE 0
#endif
#ifndef REP_MASK
#define REP_MASK 0
#endif
#ifndef S_CONV
#define S_CONV 1
#endif
#ifndef M3_RW
#define M3_RW 2
#endif
#ifndef PU_RSHIFT
#define PU_RSHIFT 11
#endif
#ifndef PU_NB
#define PU_NB 6
#endif
#ifndef PVQ_RB
#define PVQ_RB 16
#endif
#ifndef PUQ_RB
#define PUQ_RB 16
#endif
#ifndef PE_SORT
#define PE_SORT 1
#endif
#ifndef PH_MASK
#define PH_MASK 0xFFFFF
#endif
#ifndef MK_N_LAUNCHES
#define MK_N_LAUNCHES 1
#endif

constexpr int NWAVES = 8, NTHR = NWAVES * 64;
constexpr int BATCH = 2, SEQ = 8192, D = 2048, T = BATCH * SEQ;
constexpr int LRU_W = 1024, CONF_W = 1024, IN_COLS = 4096, LRU_HD = 128;
constexpr int NH = 8, NKEY = 128, TOPK = 16, NEXP = NKEY * NKEY, KSEL = NH * TOPK;
constexpr int NMOD = 6 * D;
constexpr int CHUNK = 64, NCHUNK = SEQ / CHUNK;
constexpr int CONF_K = 31;
constexpr float EPS = 1e-6f;
constexpr int N_PHASES = 14;

constexpr size_t MiB = 1u << 20;
constexpr size_t WS_CTL = 0, CTL_ZERO_BYTES = 64 * 1024;
constexpr size_t WS_MODP = 1 * MiB;
constexpr size_t WS_CFIN = 2 * MiB;
constexpr size_t WS_CARRY = 3 * MiB;
constexpr size_t WS_AGG = 4 * MiB;
constexpr size_t WS_WG = 6 * MiB;
constexpr size_t WS_SUBK = 7 * MiB;
constexpr size_t WS_BT1 = 8 * MiB;
constexpr size_t WS_BT2 = 24 * MiB;
constexpr size_t WS_BT3 = 32 * MiB;
constexpr size_t WS_IDX = 40 * MiB;
constexpr size_t WS_GATE = 48 * MiB;
constexpr size_t WS_USC = 56 * MiB;
constexpr size_t WS_VSC = 57 * MiB;
constexpr size_t WS_RA = 64 * MiB;
constexpr size_t WS_Y1 = 128 * MiB;
constexpr size_t WS_PROJ = 192 * MiB;
constexpr size_t WS_Q = 192 * MiB;
constexpr size_t WS_UB = 256 * MiB;
constexpr size_t WS_XL = 320 * MiB;
constexpr size_t WS_ZC = 352 * MiB;
constexpr size_t WS_Y2 = 384 * MiB;
constexpr size_t WS_SSQ = 58 * MiB;
constexpr size_t WS_HLOC = 384 * MiB;
constexpr size_t WS_PC = 416 * MiB;
constexpr size_t WS_VB = 320 * MiB;
constexpr size_t WS_ACTP = 192 * MiB;
constexpr size_t WS_ACT = 448 * MiB;
constexpr size_t WS_H2Q = 456 * MiB;
constexpr size_t WS_HSC = 488 * MiB;
constexpr size_t WS_END = 489 * MiB;
constexpr int CW_TMO = 0, CW_BAR = 4096;

constexpr int RING_OFF = 0, RING_BYTES = 131072;
constexpr int LDSCTL_OFF = RING_BYTES, MISC_OFF = LDSCTL_OFF + 320;
constexpr int LDS_BYTES = 147456;

#define GAS __attribute__((address_space(1)))
#define LAS __attribute__((address_space(3)))
typedef unsigned short bf16;
typedef unsigned v4u __attribute__((ext_vector_type(4)));
typedef unsigned v2u __attribute__((ext_vector_type(2)));
typedef float f32x4 __attribute__((ext_vector_type(4)));
typedef float f32x16 __attribute__((ext_vector_type(16)));
typedef float f32x2 __attribute__((ext_vector_type(2)));
typedef short bf16x8 __attribute__((ext_vector_type(8)));
typedef __bf16 bfp2 __attribute__((ext_vector_type(2)));
typedef GAS unsigned gu32;
#define RLX_AGENT __ATOMIC_RELAXED, __HIP_MEMORY_SCOPE_AGENT
#define LDS_WAIT() asm volatile("s_waitcnt lgkmcnt(0)" ::: "memory")
#define VM_WAIT() asm volatile("s_waitcnt vmcnt(0)" ::: "memory")
__device__ __forceinline__ unsigned f2bf(float f) { unsigned u = __builtin_bit_cast(unsigned, f); return (u + 0x7fffu + ((u >> 16) & 1u)) >> 16; }
__device__ __forceinline__ unsigned pk2(float lo, float hi) { return f2bf(lo) | (f2bf(hi) << 16); }
__device__ __forceinline__ float bflo(unsigned u) { return __builtin_bit_cast(float, u << 16); }
__device__ __forceinline__ float bfhi(unsigned u) { return __builtin_bit_cast(float, u & 0xffff0000u); }
__device__ __forceinline__ float wave_sum(float v) {
#pragma unroll
    for (int o = 1; o < 64; o <<= 1) v += __shfl_xor(v, o);
    return v;
}
__device__ __forceinline__ float dpp_sum63(float v) {
    v += __builtin_bit_cast(float, __builtin_amdgcn_update_dpp(0, __builtin_bit_cast(int, v), 0xB1, 0xF, 0xF, false));
    v += __builtin_bit_cast(float, __builtin_amdgcn_update_dpp(0, __builtin_bit_cast(int, v), 0x4E, 0xF, 0xF, false));
    v += __builtin_bit_cast(float, __builtin_amdgcn_update_dpp(0, __builtin_bit_cast(int, v), 0x141, 0xF, 0xF, false));
    v += __builtin_bit_cast(float, __builtin_amdgcn_update_dpp(0, __builtin_bit_cast(int, v), 0x140, 0xF, 0xF, false));
    v += __builtin_bit_cast(float, __builtin_amdgcn_update_dpp(0, __builtin_bit_cast(int, v), 0x142, 0xA, 0xF, false));
    v += __builtin_bit_cast(float, __builtin_amdgcn_update_dpp(0, __builtin_bit_cast(int, v), 0x143, 0xC, 0xF, false));
    return v;
}

__device__ __forceinline__ float sigmoidf_(float x) { return __builtin_amdgcn_rcpf(1.0f + __expf(-x)); }
__device__ __forceinline__ float gelu_tanh(float x) { return x * sigmoidf_(1.5957691216057308f * (x + 0.044715f * x * x * x)); }
__device__ __forceinline__ float rdlane(float v, int l) { return __builtin_bit_cast(float, __builtin_amdgcn_readlane(__builtin_bit_cast(int, v), l)); }
__device__ __forceinline__ float wave_total(float v) { return rdlane(dpp_sum63(v), 63); }

#define XB_TMO      128
#define XB_XCNT(j)  (256  + 64 * (j))
#define XB_XSUB(j)  (1280 + 64 * (j))
#define XB_XGEN(j)  (2304 + 64 * (j))
#define XB_TOP      3328
#define XB_TOPGEN   3392
#define XCD_BAR_WORDS 3456
#define XB_SPIN_CAP (1u << 18)

__device__ __forceinline__ unsigned xb_ld(unsigned* p)              { return __hip_atomic_load(p, __ATOMIC_RELAXED, __HIP_MEMORY_SCOPE_AGENT); }
__device__ __forceinline__ unsigned xb_add(unsigned* p, unsigned v) { return __hip_atomic_fetch_add(p, v, __ATOMIC_RELAXED, __HIP_MEMORY_SCOPE_AGENT); }
__device__ __forceinline__ unsigned xb_xcc_id() { return (unsigned)__builtin_amdgcn_s_getreg((3 << 11) | 20) & 0xFu; }
#define XB_SPIN(cond, bar) do { unsigned _sp = 0; while (cond) { __builtin_amdgcn_s_sleep(1); \
    if ((++_sp & 255u) == 0u) { if (xb_ld(&(bar)[XB_TMO])) break; if (_sp > XB_SPIN_CAP) { atomicAdd(&(bar)[XB_TMO], 1u); break; } } } } while (0)

struct XcdBarrier {
    unsigned* bar; unsigned x;
    volatile LAS unsigned* st;
};

__device__ __forceinline__ XcdBarrier xcd_barrier_post(unsigned* bar, volatile LAS unsigned* st) {
    XcdBarrier b; b.bar = bar; b.x = xb_xcc_id(); b.st = st;
    if (threadIdx.x == 0) (void)xb_add(&bar[XB_XCNT(b.x)], 1u);
    return b;
}
__device__ __forceinline__ void xcd_barrier_complete(unsigned* bar, unsigned x, unsigned& nloc, unsigned& nx) {
    const unsigned G = gridDim.x * gridDim.y * gridDim.z;
    unsigned sum, cnt, mine, sp = 0u;
    for (;;) {
        sum = 0u; cnt = 0u; mine = 0u;
#pragma unroll
        for (unsigned j = 0; j < 16; ++j) { const unsigned c = xb_ld(&bar[XB_XCNT(j)]); sum += c; cnt += (c > 0u) ? 1u : 0u; mine = (j == x) ? c : mine; }
        if (sum == G) break;
        __builtin_amdgcn_s_sleep(1);
        if ((++sp & 255u) == 0u) { if (xb_ld(&bar[XB_TMO])) break; if (sp > XB_SPIN_CAP) { atomicAdd(&bar[XB_TMO], 1u); break; } }
    }
    nloc = mine > 0u ? mine : 1u; nx = cnt > 0u ? cnt : 1u;
}

__device__ __forceinline__ void xcd_barrier(const XcdBarrier& b) {
    asm volatile("s_waitcnt vmcnt(0)" ::: "memory");
    __syncthreads();
    if (threadIdx.x == 0) {
        unsigned* bar = b.bar;
        __builtin_amdgcn_s_waitcnt(0);
        unsigned nloc = b.st[0], nx = b.st[1];
        if (nloc == 0u) { xcd_barrier_complete(bar, b.x, nloc, nx); b.st[0] = nloc; b.st[1] = nx; }
        const unsigned old = xb_add(&bar[XB_XSUB(b.x)], 1u);
        const unsigned gen = old / nloc;
        if (old + 1u == (gen + 1u) * nloc) {
            __builtin_amdgcn_fence(__ATOMIC_RELEASE, "agent");
            asm volatile("s_waitcnt vmcnt(0)" ::: "memory");
            const unsigned og = xb_add(&bar[XB_TOP], 1u);
            const unsigned tg = og / nx;
            if (og + 1u == (tg + 1u) * nx) xb_add(&bar[XB_TOPGEN], 1u);
            else XB_SPIN(xb_ld(&bar[XB_TOPGEN]) == tg, bar);
            __builtin_amdgcn_fence(__ATOMIC_ACQUIRE, "agent");
            xb_add(&bar[XB_XGEN(b.x)], 1u);
            asm volatile("s_waitcnt vmcnt(0)" ::: "memory");
        } else {
            XB_SPIN(xb_ld(&bar[XB_XGEN(b.x)]) == gen, bar);
            __builtin_amdgcn_fence(__ATOMIC_ACQUIRE, "agent");
            asm volatile("s_waitcnt vmcnt(0)" ::: "memory");
        }
    }
    __syncthreads();
}
struct Args { const float* in[25]; float* out; unsigned char* ws; int ph_lo, ph_hi, li, pad; };
enum { I_X = 0, I_C, I_WMOD, I_BMOD, I_GPREMIX, I_GPOSTMIX, I_GPREFFN, I_GPOSTFFN, I_WIN, I_LCW, I_LCB, I_WA, I_BA, I_WX, I_BX, I_LAMBDA,
       I_CDW, I_CDB, I_LNG, I_LNB, I_WOUT, I_WQ, I_SUBK, I_PU, I_PV };

__device__ __forceinline__ float mod_at(const float* modp, int b, int n) {
    return (modp[(0 * 2 + b) * NMOD + n] + modp[(1 * 2 + b) * NMOD + n]) + (modp[(2 * 2 + b) * NMOD + n] + modp[(3 * 2 + b) * NMOD + n]);
}

__device__ __forceinline__ void p0_transpose_item(const float* W, int K, int N, bf16* WT, LAS float* scr, int item, int lane) {
    const int nblk = N / 32, kb = item / nblk, nb = item % nblk, k0 = 64 * kb, n0 = 32 * nb;
#pragma unroll 8
    for (int i = 0; i < 32; ++i) { const int kk = 2 * i + (lane >> 5); scr[kk * 33 + (lane & 31)] = W[(size_t)(k0 + kk) * N + n0 + (lane & 31)]; }
    LDS_WAIT(); asm volatile("" ::: "memory");
    const int c = lane & 7;
#pragma unroll
    for (int j = 0; j < 4; ++j) { const int n = (lane >> 3) + 8 * j; const LAS float* s = scr + (8 * c) * 33 + n;
        v4u o; o.x = pk2(s[0 * 33], s[1 * 33]); o.y = pk2(s[2 * 33], s[3 * 33]); o.z = pk2(s[4 * 33], s[5 * 33]); o.w = pk2(s[6 * 33], s[7 * 33]);
        *(GAS v4u*)(WT + (size_t)(n0 + n) * K + k0 + 8 * c) = o; }
    LDS_WAIT(); asm volatile("" ::: "memory");
}
__device__ __forceinline__ void cvt_rows_bf16(const float* src, bf16* dst, size_t n8, size_t gt, size_t ngt) {
    for (size_t i = gt; i < n8; i += ngt) {
        const f32x4 a = ((const GAS f32x4*)src)[2 * i], b = ((const GAS f32x4*)src)[2 * i + 1];
        v4u o; o.x = pk2(a.x, a.y); o.y = pk2(a.z, a.w); o.z = pk2(b.x, b.y); o.w = pk2(b.z, b.w);
        ((GAS v4u*)dst)[i] = o; }
}
__device__ __forceinline__ void phase_p0(const Args& A, LAS unsigned char* lds, int tid, int lane, int wave, int bid, int G) {
    float* modp = (float*)(A.ws + WS_MODP);
    for (int item = bid; item < 192; item += G) {
        const int cg = item % 48, kq = item / 48, k0 = kq * 512 + wave * 64, n0 = cg * 256 + lane * 4;
        const float c0 = A.in[I_C][k0 + lane], c1 = A.in[I_C][D + k0 + lane];
        const float ca0 = c0 * sigmoidf_(c0), ca1 = c1 * sigmoidf_(c1);
        f32x4 a0 = {0.f, 0.f, 0.f, 0.f}, a1 = {0.f, 0.f, 0.f, 0.f};
        const float* wp = A.in[I_WMOD] + (size_t)k0 * NMOD + n0;
#pragma unroll 8
        for (int kk = 0; kk < 64; ++kk) {
            const f32x4 w = *(const GAS f32x4*)(wp + (size_t)kk * NMOD);
            const float s0 = __shfl(ca0, kk), s1 = __shfl(ca1, kk);
            a0 += w * s0; a1 += w * s1;
        }
        LAS f32x4* red = (LAS f32x4*)lds;
        red[(wave * 2 + 0) * 64 + lane] = a0; red[(wave * 2 + 1) * 64 + lane] = a1;
        __syncthreads();
        { const int b = tid >> 8, col = tid & 255; const LAS float* rf = (const LAS float*)lds; float s = 0.f;
#pragma unroll
          for (int w = 0; w < 8; ++w) s += rf[((w * 2 + b) * 64) * 4 + col];
          if (kq == 0) s += A.in[I_BMOD][cg * 256 + col];
          modp[(kq * 2 + b) * NMOD + cg * 256 + col] = s; }
        __syncthreads();
    }
    {
        LAS float* scr = (LAS float*)(lds + wave * 16384);
        const int gw = bid * NWAVES + wave, NGW = G * NWAVES;
        constexpr int I1 = (D / 64) * (IN_COLS / 32), I2 = (D / 64) * (D / 32);
        for (int it = gw; it < I1 + 2 * I2; it += NGW) {
            int r = it;
            if (r < I1) { p0_transpose_item(A.in[I_WIN], D, IN_COLS, (bf16*)(A.ws + WS_BT1), scr, r, lane); continue; } r -= I1;
            if (r < I2) { p0_transpose_item(A.in[I_WOUT], D, D, (bf16*)(A.ws + WS_BT2), scr, r, lane); continue; } r -= I2;
            p0_transpose_item(A.in[I_WQ], D, D, (bf16*)(A.ws + WS_BT3), scr, r, lane);
        }
    }
    {
        const int gt = bid * NTHR + tid, ngt = G * NTHR;
        bf16* wg = (bf16*)(A.ws + WS_WG);
        for (int e = gt; e < NH * 256 * 128; e += ngt) {
            const int h = e >> 15, n = (e >> 7) & 255, k = e & 127;
            const float v = (n < 128 ? A.in[I_WA] : A.in[I_WX])[h * 16384 + k * 128 + (n & 127)];
            wg[e] = (bf16)f2bf(v);
        }
        cvt_rows_bf16(A.in[I_SUBK], (bf16*)(A.ws + WS_SUBK), (size_t)NH * 2 * NKEY * 128 / 8, gt, ngt);
    }
}

__device__ __forceinline__ void phase_p1(const Args& A, int tid, int lane, int wave, int bid, int G) {
    const float* modp = (const float*)(A.ws + WS_MODP);
    {
        float* cfin = (float*)(A.ws + WS_CFIN);
        for (int e = bid * NTHR + tid; e < 2 * 2 * D; e += G * NTHR) {
            const int b = e >> 12, arr = (e >> 11) & 1, col = e & (D - 1);
            cfin[e] = arr == 0 ? mod_at(modp, b, 2 * D + col) * A.in[I_GPOSTMIX][col] : mod_at(modp, b, 5 * D + col) * A.in[I_GPOSTFFN][col];
        }
        float* cfe = (float*)(A.ws + WS_CFIN) + 4 * D;
        for (int e = bid * NTHR + tid; e < 2 * 2 * D; e += G * NTHR) {
            const int b = e >> 12, arr = (e >> 11) & 1, col = e & (D - 1);
            cfe[e] = arr == 0 ? A.in[I_GPREFFN][col] * (1.0f + mod_at(modp, b, 4 * D + col)) : mod_at(modp, b, 3 * D + col);
        }
    }
    const int gw = bid * NWAVES + wave, NGW = G * NWAVES;
    bf16* h1 = (bf16*)(A.ws + WS_RA);
    int cb = -1; float gs[4][8], sh[4][8];
    for (int row = gw; row < T; row += NGW) {
        const int b = row >> 13;
        if (b != cb) { cb = b;
#pragma unroll
            for (int j = 0; j < 4; ++j)
#pragma unroll
                for (int e = 0; e < 8; ++e) { const int col = j * 512 + lane * 8 + e;
                    gs[j][e] = A.in[I_GPREMIX][col] * (1.0f + mod_at(modp, b, D + col)); sh[j][e] = mod_at(modp, b, col); } }
        const GAS f32x4* xr = (const GAS f32x4*)(A.in[I_X] + (size_t)row * D) + lane * 2;
        f32x4 v[4][2]; float s = 0.f;
#pragma unroll
        for (int j = 0; j < 4; ++j) { v[j][0] = xr[j * 128]; v[j][1] = xr[j * 128 + 1];
            s += (v[j][0].x * v[j][0].x + v[j][0].y * v[j][0].y) + (v[j][0].z * v[j][0].z + v[j][0].w * v[j][0].w);
            s += (v[j][1].x * v[j][1].x + v[j][1].y * v[j][1].y) + (v[j][1].z * v[j][1].z + v[j][1].w * v[j][1].w); }
        const float rstd = __builtin_amdgcn_rsqf(wave_total(s) * (1.0f / D) + EPS);
        GAS v4u* orow = (GAS v4u*)(h1 + (size_t)row * D) + lane;
#pragma unroll
        for (int j = 0; j < 4; ++j) { float o[8];
#pragma unroll
            for (int e = 0; e < 8; ++e) o[e] = v[j][e >> 2][e & 3] * rstd * gs[j][e] + sh[j][e];
            v4u w; w.x = pk2(o[0], o[1]); w.y = pk2(o[2], o[3]); w.z = pk2(o[4], o[5]); w.w = pk2(o[6], o[7]);
            orow[j * 64] = w; }
    }
}

__device__ __forceinline__ void m1a_tile_issue(const bf16* proj, int item, int tid, v4u (&rv)[5], v4u (&rg)[5]) {
    const int b = item >> 9, tt = (item >> 3) & 63, ct = item & 7, t0 = tt * 128;
#pragma unroll
    for (int i = 0; i < 5; ++i) {
        const int e = tid + i * NTHR, r = e >> 4, c8 = (e & 15) * 8, t = t0 - 30 + r;
        rv[i] = (v4u){0u, 0u, 0u, 0u}; rg[i] = (v4u){0u, 0u, 0u, 0u};
        if (e < 158 * 16 && t >= 0) { const bf16* p = proj + (size_t)(b * SEQ + t) * IN_COLS + 2048 + ct * 128 + c8; rv[i] = *(const GAS v4u*)p; rg[i] = *(const GAS v4u*)(p + 1024); }
    }
}
__device__ __forceinline__ void phase_m1a(const Args& A, LAS unsigned char* lds, int tid, int lane, int wave, int bid, int G) {
    const bf16* proj = (const bf16*)(A.ws + WS_PROJ);
    {
        bf16* xl = (bf16*)(A.ws + WS_XL);
        const float* w4 = A.in[I_LCW]; const float* b4 = A.in[I_LCB];
        for (int it = bid * NTHR + tid; it < (T / 16) * 128; it += G * NTHR) {
            const int c0 = (it & 127) * 8, run = it >> 7, row0 = run * 16, t0 = row0 & (SEQ - 1);
            v4u in[19];
#pragma unroll
            for (int r = 0; r < 19; ++r) { in[r] = (v4u){0u, 0u, 0u, 0u}; if (t0 - 3 + r >= 0) in[r] = *(const GAS v4u*)(proj + (size_t)(row0 - 3 + r) * IN_COLS + c0); }
            float w[4][8], bb[8];
#pragma unroll
            for (int j = 0; j < 4; ++j) { const f32x4 wa = *(const GAS f32x4*)(w4 + j * LRU_W + c0), wb = *(const GAS f32x4*)(w4 + j * LRU_W + c0 + 4);
                w[j][0] = wa.x; w[j][1] = wa.y; w[j][2] = wa.z; w[j][3] = wa.w; w[j][4] = wb.x; w[j][5] = wb.y; w[j][6] = wb.z; w[j][7] = wb.w; }
            { const f32x4 ba = *(const GAS f32x4*)(b4 + c0), bc = *(const GAS f32x4*)(b4 + c0 + 4); bb[0] = ba.x; bb[1] = ba.y; bb[2] = ba.z; bb[3] = ba.w; bb[4] = bc.x; bb[5] = bc.y; bb[6] = bc.z; bb[7] = bc.w; }
#pragma unroll
            for (int i = 0; i < 16; ++i) { float acc[8];
#pragma unroll
                for (int e = 0; e < 8; ++e) acc[e] = bb[e];
#pragma unroll
                for (int j = 0; j < 4; ++j) { const v4u v = in[i + j];
                    acc[0] += w[j][0] * bflo(v.x); acc[1] += w[j][1] * bfhi(v.x); acc[2] += w[j][2] * bflo(v.y); acc[3] += w[j][3] * bfhi(v.y);
                    acc[4] += w[j][4] * bflo(v.z); acc[5] += w[j][5] * bfhi(v.z); acc[6] += w[j][6] * bflo(v.w); acc[7] += w[j][7] * bfhi(v.w); }
                v4u o; o.x = pk2(acc[0], acc[1]); o.y = pk2(acc[2], acc[3]); o.z = pk2(acc[4], acc[5]); o.w = pk2(acc[6], acc[7]);
                *(GAS v4u*)(xl + (size_t)(row0 + i) * LRU_W + c0) = o; }
        }
    }
    {
        bf16* zc = (bf16*)(A.ws + WS_ZC);
        const float* w31 = A.in[I_CDW]; const float* b31 = A.in[I_CDB];
        LAS float* zt = (LAS float*)lds;
        const int cp = tid & 63, tg = tid >> 6;
        v4u rv[5], rg[5];
        int item = bid;
        if (item < 2 * 64 * 8) m1a_tile_issue(proj, item, tid, rv, rg);
        float w0[CONF_K], w1[CONF_K], bias0 = 0.f, bias1 = 0.f; int wct = -1;
        for (; item < 2 * 64 * 8; item += G) {
            const int b = item >> 9, tt = (item >> 3) & 63, ct = item & 7, t0 = tt * 128, ch = ct * 128 + 2 * cp;
            if (ct != wct) { wct = ct;
#pragma unroll
                for (int j = 0; j < CONF_K; ++j) { const f32x2 ww = *(const GAS f32x2*)(w31 + j * CONF_W + ch); w0[j] = ww.x; w1[j] = ww.y; }
                const f32x2 bw = *(const GAS f32x2*)(b31 + ch); bias0 = bw.x; bias1 = bw.y; }
            __syncthreads();
#pragma unroll
            for (int i = 0; i < 5; ++i) {
                const int e = tid + i * NTHR, r = e >> 4, c8 = (e & 15) * 8;
                if (e < 158 * 16) { const v4u v = rv[i], g = rg[i]; f32x4 z0, z1;
                    z0.x = bflo(v.x) * sigmoidf_(bflo(g.x)); z0.y = bfhi(v.x) * sigmoidf_(bfhi(g.x)); z0.z = bflo(v.y) * sigmoidf_(bflo(g.y)); z0.w = bfhi(v.y) * sigmoidf_(bfhi(g.y));
                    z1.x = bflo(v.z) * sigmoidf_(bflo(g.z)); z1.y = bfhi(v.z) * sigmoidf_(bfhi(g.z)); z1.z = bflo(v.w) * sigmoidf_(bflo(g.w)); z1.w = bfhi(v.w) * sigmoidf_(bfhi(g.w));
                    *(LAS f32x4*)(zt + r * 128 + c8) = z0; *(LAS f32x4*)(zt + r * 128 + c8 + 4) = z1; }
            }
            __syncthreads();
            if (item + G < 2 * 64 * 8) m1a_tile_issue(proj, item + G, tid, rv, rg);
            float a0[16], a1[16];
#pragma unroll
            for (int i = 0; i < 16; ++i) { a0[i] = bias0; a1[i] = bias1; }
#pragma unroll
            for (int s_ = 0; s_ < 46; ++s_) {
                const f32x2 v = *(const LAS f32x2*)(zt + (tg * 16 + s_) * 128 + 2 * cp);
#pragma unroll
                for (int i = 0; i < 16; ++i) if (s_ - i >= 0 && s_ - i < CONF_K) { a0[i] += w0[s_ - i] * v.x; a1[i] += w1[s_ - i] * v.y; }
            }
            bf16* zo = zc + (size_t)(b * SEQ + t0 + tg * 16) * CONF_W + ch;
#pragma unroll
            for (int i = 0; i < 16; ++i) *(GAS unsigned*)(zo + (size_t)i * CONF_W) = pk2(a0[i], a1[i]);
        }
        __syncthreads();
    }
}

template <int CTRL> __device__ __forceinline__ float dpp_shr(float v, float ident) {
    return __builtin_bit_cast(float, __builtin_amdgcn_update_dpp(__builtin_bit_cast(int, ident), __builtin_bit_cast(int, v), CTRL, 0xF, 0xF, false));
}
__device__ __forceinline__ void phase_m1b(const Args& A, int tid, int lane, int wave, int bid, int G) {
    const bf16* xl = (const bf16*)(A.ws + WS_XL); const bf16* wg = (const bf16*)(A.ws + WS_WG);
    bf16* hloc = (bf16*)(A.ws + WS_HLOC); bf16* pc = (bf16*)(A.ws + WS_PC); float* agg = (float*)(A.ws + WS_AGG);
    const int fr = lane & 15, fq = lane >> 4;
    for (int item = bid * NWAVES + wave; item < 2 * NCHUNK * 8; item += G * NWAVES) {
        const int hh = item & 7, chunk = (item >> 3) & (NCHUNK - 1), b = item >> 10;
        const size_t r0 = (size_t)b * SEQ + (size_t)chunk * CHUNK;
        bf16x8 xf[4][4];
#pragma unroll
        for (int mt = 0; mt < 4; ++mt)
#pragma unroll
            for (int ks = 0; ks < 4; ++ks) xf[mt][ks] = *(const GAS bf16x8*)(xl + (r0 + 16 * mt + fr) * LRU_W + hh * LRU_HD + 32 * ks + 8 * fq);
        float cP[4], cH[4];
        for (int j = 0; j < 8; ++j) {
            const int chb = hh * LRU_HD + 16 * j + 4 * fq;
            bf16x8 wa[4], wx[4];
#pragma unroll
            for (int ks = 0; ks < 4; ++ks) { wa[ks] = *(const GAS bf16x8*)(wg + (size_t)(hh * 256 + 16 * j + fr) * 128 + 32 * ks + 8 * fq);
                                             wx[ks] = *(const GAS bf16x8*)(wg + (size_t)(hh * 256 + 128 + 16 * j + fr) * 128 + 32 * ks + 8 * fq); }
            const f32x4 bav = *(const GAS f32x4*)(A.in[I_BA] + chb), bxv = *(const GAS f32x4*)(A.in[I_BX] + chb), lam = *(const GAS f32x4*)(A.in[I_LAMBDA] + chb);
            float cl[4];
#pragma unroll
            for (int r = 0; r < 4; ++r) { cl[r] = -8.0f * log1pf(__expf(-lam[r])); cP[r] = 1.f; cH[r] = 0.f; }
#pragma unroll
            for (int mt = 0; mt < 4; ++mt) {
                f32x4 ar = {0.f, 0.f, 0.f, 0.f}, ai = {0.f, 0.f, 0.f, 0.f};
#pragma unroll
                for (int ks = 0; ks < 4; ++ks) { ar = __builtin_amdgcn_mfma_f32_16x16x32_bf16(wa[ks], xf[mt][ks], ar, 0, 0, 0);
                                                 ai = __builtin_amdgcn_mfma_f32_16x16x32_bf16(wx[ks], xf[mt][ks], ai, 0, 0, 0); }
                const v2u xv = *(const GAS v2u*)(xl + (r0 + 16 * mt + fr) * LRU_W + chb);
                const float xlv[4] = {bflo(xv.x), bfhi(xv.x), bflo(xv.y), bfhi(xv.y)};
                float P[4], H[4];
#pragma unroll
                for (int r = 0; r < 4; ++r) {
                    const float rg = sigmoidf_(ar[r] + bav[r]), ig = sigmoidf_(ai[r] + bxv[r]);
                    const float la = cl[r] * rg, a = __expf(la), mult = sqrtf(fmaxf(1.0f - a * a, 0.f));
                    float p = a, h = mult * ig * xlv[r];
                    { float pp, hp;
                      pp = dpp_shr<0x111>(p, 1.0f); hp = dpp_shr<0x111>(h, 0.0f); h = p * hp + h; p = p * pp;
                      pp = dpp_shr<0x112>(p, 1.0f); hp = dpp_shr<0x112>(h, 0.0f); h = p * hp + h; p = p * pp;
                      pp = dpp_shr<0x114>(p, 1.0f); hp = dpp_shr<0x114>(h, 0.0f); h = p * hp + h; p = p * pp;
                      pp = dpp_shr<0x118>(p, 1.0f); hp = dpp_shr<0x118>(h, 0.0f); h = p * hp + h; p = p * pp; }
                    h = h + p * cH[r]; p = p * cP[r];
                    P[r] = p; H[r] = h;
                    cP[r] = __shfl(p, 15, 16); cH[r] = __shfl(h, 15, 16);
                }
                v2u ho, po; ho.x = pk2(H[0], H[1]); ho.y = pk2(H[2], H[3]); po.x = pk2(P[0], P[1]); po.y = pk2(P[2], P[3]);
                *(GAS v2u*)(hloc + (r0 + 16 * mt + fr) * LRU_W + chb) = ho;
                *(GAS v2u*)(pc + (r0 + 16 * mt + fr) * LRU_W + chb) = po;
            }
            if (fr == 0) {
                float* ag = agg + ((size_t)(b * NCHUNK + chunk) * LRU_W + chb) * 2;
                *(GAS f32x4*)ag = (f32x4){cP[0], cH[0], cP[1], cH[1]}; *(GAS f32x4*)(ag + 4) = (f32x4){cP[2], cH[2], cP[3], cH[3]};
            }
        }
    }
}

__device__ __forceinline__ void phase_m3(const Args& A, LAS unsigned char* lds, int tid, int lane, int wave, int bid, int G) {
    const bf16* proj = (const bf16*)(A.ws + WS_PROJ); const bf16* hloc = (const bf16*)(A.ws + WS_HLOC); const bf16* pc = (const bf16*)(A.ws + WS_PC);
    const bf16* zc = (const bf16*)(A.ws + WS_ZC); const float* agg = (const float*)(A.ws + WS_AGG);
    bf16* a2 = (bf16*)(A.ws + WS_RA);
    LAS float* cs = (LAS float*)lds;
    float lg[2][8], lb[2][8];
#pragma unroll
    for (int jj = 0; jj < 2; ++jj)
#pragma unroll
        for (int e = 0; e < 8; ++e) { lg[jj][e] = A.in[I_LNG][jj * 512 + lane * 8 + e]; lb[jj][e] = A.in[I_LNB][jj * 512 + lane * 8 + e]; }
    for (int item = bid; item < 2 * NCHUNK; item += G) {
        const int b = item >> 7, chunk = item & (NCHUNK - 1);
        {   float h0 = 0.f, h1 = 0.f; const float* ap = agg + ((size_t)(b * NCHUNK) * LRU_W + 2 * tid) * 2;
#pragma unroll 8
            for (int c = 0; c < chunk; ++c) { const f32x4 ab = *(const GAS f32x4*)(ap + (size_t)c * LRU_W * 2); h0 = ab.x * h0 + ab.y; h1 = ab.z * h1 + ab.w; }
            __syncthreads();
            cs[2 * tid] = h0; cs[2 * tid + 1] = h1;
            __syncthreads(); }
        for (int rr = 0; rr < 8; rr += M3_RW) {
            const int row0 = b * SEQ + chunk * CHUNK + wave * 8 + rr;
            v4u hv[M3_RW][2], pv[M3_RW][2], gv[M3_RW][2], zq[M3_RW][2];
#pragma unroll
            for (int u = 0; u < M3_RW; ++u)
#pragma unroll
                for (int jj = 0; jj < 2; ++jj) { const int c0 = jj * 512 + lane * 8; const size_t row = (size_t)(row0 + u);
                    hv[u][jj] = *(const GAS v4u*)(hloc + row * LRU_W + c0); pv[u][jj] = *(const GAS v4u*)(pc + row * LRU_W + c0);
                    gv[u][jj] = *(const GAS v4u*)(proj + row * IN_COLS + 1024 + c0); zq[u][jj] = *(const GAS v4u*)(zc + row * CONF_W + c0); }
#pragma unroll
            for (int u = 0; u < M3_RW; ++u) {
                const size_t row = (size_t)(row0 + u);
                float zv[2][8]; float s = 0.f;
#pragma unroll
                for (int jj = 0; jj < 2; ++jj) {
                    const int c0 = jj * 512 + lane * 8;
                    const f32x4 ca = *(const LAS f32x4*)(cs + c0), cb = *(const LAS f32x4*)(cs + c0 + 4);
                    const v4u h_ = hv[u][jj], p_ = pv[u][jj], g_ = gv[u][jj], z = zq[u][jj];
                    float y[8];
                    y[0] = (bflo(h_.x) + bflo(p_.x) * ca.x) * gelu_tanh(bflo(g_.x)); y[1] = (bfhi(h_.x) + bfhi(p_.x) * ca.y) * gelu_tanh(bfhi(g_.x));
                    y[2] = (bflo(h_.y) + bflo(p_.y) * ca.z) * gelu_tanh(bflo(g_.y)); y[3] = (bfhi(h_.y) + bfhi(p_.y) * ca.w) * gelu_tanh(bfhi(g_.y));
                    y[4] = (bflo(h_.z) + bflo(p_.z) * cb.x) * gelu_tanh(bflo(g_.z)); y[5] = (bfhi(h_.z) + bfhi(p_.z) * cb.y) * gelu_tanh(bfhi(g_.z));
                    y[6] = (bflo(h_.w) + bflo(p_.w) * cb.z) * gelu_tanh(bflo(g_.w)); y[7] = (bfhi(h_.w) + bfhi(p_.w) * cb.w) * gelu_tanh(bfhi(g_.w));
                    v4u o; o.x = pk2(y[0], y[1]); o.y = pk2(y[2], y[3]); o.z = pk2(y[4], y[5]); o.w = pk2(y[6], y[7]);
                    *(GAS v4u*)(a2 + row * D + c0) = o;
                    zv[jj][0] = bflo(z.x); zv[jj][1] = bfhi(z.x); zv[jj][2] = bflo(z.y); zv[jj][3] = bfhi(z.y); zv[jj][4] = bflo(z.z); zv[jj][5] = bfhi(z.z); zv[jj][6] = bflo(z.w); zv[jj][7] = bfhi(z.w);
#pragma unroll
                    for (int e = 0; e < 8; ++e) s += zv[jj][e];
                }
                const float mean = wave_total(s) * (1.0f / CONF_W); float q = 0.f;
#pragma unroll
                for (int jj = 0; jj < 2; ++jj)
#pragma unroll
                    for (int e = 0; e < 8; ++e) { zv[jj][e] -= mean; q += zv[jj][e] * zv[jj][e]; }
                const float rstd = __builtin_amdgcn_rsqf(wave_total(q) * (1.0f / CONF_W) + EPS);
#pragma unroll
                for (int jj = 0; jj < 2; ++jj) { float o[8];
#pragma unroll
                    for (int e = 0; e < 8; ++e) { const float n = zv[jj][e] * rstd * lg[jj][e] + lb[jj][e]; o[e] = n * sigmoidf_(n); }
                    v4u w; w.x = pk2(o[0], o[1]); w.y = pk2(o[2], o[3]); w.z = pk2(o[4], o[5]); w.w = pk2(o[6], o[7]);
                    *(GAS v4u*)(a2 + row * D + 1024 + jj * 512 + lane * 8) = w; }
            }
        }
    }
}

__device__ __forceinline__ f32x2 fp8lo(unsigned w) { return __builtin_amdgcn_cvt_pk_f32_fp8((int)w, false); }
__device__ __forceinline__ f32x2 fp8hi(unsigned w) { return __builtin_amdgcn_cvt_pk_f32_fp8((int)w, true); }
constexpr int CVT_ROWS = 4;
template <bool I8> __device__ __forceinline__ void cvt_table_q8(const float* src, unsigned char* dst, float* inv_scale, int gw, int NGW, int lane) {
    for (int r0 = gw; r0 < NEXP; r0 += NGW * CVT_ROWS) {
        f32x4 v[CVT_ROWS][8];
#pragma unroll
        for (int q = 0; q < CVT_ROWS; ++q) { const int r = r0 + q * NGW; const GAS f32x4* p = (const GAS f32x4*)(src + (size_t)(r < NEXP ? r : r0) * D) + lane;
#pragma unroll
            for (int i = 0; i < 8; ++i) v[q][i] = p[i * 64]; }
#pragma unroll
        for (int q = 0; q < CVT_ROWS; ++q) { const int r = r0 + q * NGW; float m = 0.f;
#pragma unroll
            for (int i = 0; i < 8; ++i) m = fmaxf(m, fmaxf(fmaxf(fabsf(v[q][i].x), fabsf(v[q][i].y)), fmaxf(fabsf(v[q][i].z), fabsf(v[q][i].w))));
#pragma unroll
            for (int o = 1; o < 64; o <<= 1) m = fmaxf(m, __shfl_xor(m, o));
            const float QM = I8 ? 127.0f : 448.0f;
            const float sc = m > 0.f ? QM / m : 1.0f;
            if (r < NEXP) {
                GAS unsigned* o4 = (GAS unsigned*)(dst + (size_t)r * D) + lane;
#pragma unroll
                for (int i = 0; i < 8; ++i) { const f32x4 t = v[q][i] * sc;
                    const float a = fminf(fmaxf(t.x, -QM), QM), b = fminf(fmaxf(t.y, -QM), QM), c = fminf(fmaxf(t.z, -QM), QM), d = fminf(fmaxf(t.w, -QM), QM);
                    if (I8) { o4[i * 64] = (unsigned)(((int)rintf(a) & 255) | (((int)rintf(b) & 255) << 8) | (((int)rintf(c) & 255) << 16) | ((int)rintf(d) << 24)); }
                    else { int pk = __builtin_amdgcn_cvt_pk_fp8_f32(a, b, 0, false); pk = __builtin_amdgcn_cvt_pk_fp8_f32(c, d, pk, true); o4[i * 64] = (unsigned)pk; } }
                if (lane == 0) inv_scale[r] = m > 0.f ? m * (1.0f / QM) : 1.0f;
            }
        }
    }
}
__device__ __forceinline__ void phase_e2(const Args& A, int tid, int lane, int wave, int bid, int G) {
    const float* modp = (const float*)(A.ws + WS_MODP); const float* cfin = (const float*)(A.ws + WS_CFIN);
    const bf16* y1 = (const bf16*)(A.ws + WS_Y1); bf16* h2 = (bf16*)(A.ws + WS_RA);
    const int gw = bid * NWAVES + wave, NGW = G * NWAVES;
    const float* cfe = (const float*)(A.ws + WS_CFIN) + 4 * D;
    for (int row = gw; row < T; row += NGW) {
        const int b = row >> 13;
        const GAS f32x4* xr = (const GAS f32x4*)(A.in[I_X] + (size_t)row * D) + lane * 2;
        const GAS v4u* yr = (const GAS v4u*)(y1 + (size_t)row * D) + lane;
        const GAS f32x4* cf = (const GAS f32x4*)(cfin + (size_t)(b * 2 + 0) * D) + lane * 2;
        float xv[4][8], yv[4][8]; float s1 = 0.f;
#pragma unroll
        for (int j = 0; j < 4; ++j) { const f32x4 a = xr[j * 128], c = xr[j * 128 + 1]; const v4u y = yr[j * 64];
            xv[j][0] = a.x; xv[j][1] = a.y; xv[j][2] = a.z; xv[j][3] = a.w; xv[j][4] = c.x; xv[j][5] = c.y; xv[j][6] = c.z; xv[j][7] = c.w;
            yv[j][0] = bflo(y.x); yv[j][1] = bfhi(y.x); yv[j][2] = bflo(y.y); yv[j][3] = bfhi(y.y); yv[j][4] = bflo(y.z); yv[j][5] = bfhi(y.z); yv[j][6] = bflo(y.w); yv[j][7] = bfhi(y.w);
#pragma unroll
            for (int e = 0; e < 8; ++e) s1 += yv[j][e] * yv[j][e]; }
        const float rstd1 = __builtin_amdgcn_rsqf(wave_total(s1) * (1.0f / D) + EPS); float s2 = 0.f;
#pragma unroll
        for (int j = 0; j < 4; ++j) { const f32x4 ca = cf[j * 128], cc = cf[j * 128 + 1]; const float cg[8] = {ca.x, ca.y, ca.z, ca.w, cc.x, cc.y, cc.z, cc.w};
#pragma unroll
            for (int e = 0; e < 8; ++e) { xv[j][e] += cg[e] * yv[j][e] * rstd1; s2 += xv[j][e] * xv[j][e]; } }
        const float rstd2 = __builtin_amdgcn_rsqf(wave_total(s2) * (1.0f / D) + EPS);
        GAS v4u* orow = (GAS v4u*)(h2 + (size_t)row * D) + lane; float am = 0.f;
#pragma unroll
        for (int j = 0; j < 4; ++j) {
            const GAS f32x4* ge = (const GAS f32x4*)(cfe + (size_t)(b * 2 + 0) * D) + lane * 2 + j * 128; const GAS f32x4* se = (const GAS f32x4*)(cfe + (size_t)(b * 2 + 1) * D) + lane * 2 + j * 128;
            const f32x4 g0_ = ge[0], g1_ = ge[1], s0_ = se[0], s1_ = se[1]; const float gsv[8] = {g0_.x, g0_.y, g0_.z, g0_.w, g1_.x, g1_.y, g1_.z, g1_.w}, shv[8] = {s0_.x, s0_.y, s0_.z, s0_.w, s1_.x, s1_.y, s1_.z, s1_.w};
#pragma unroll
            for (int e = 0; e < 8; ++e) { xv[j][e] = xv[j][e] * rstd2 * gsv[e] + shv[e]; am = fmaxf(am, fabsf(xv[j][e])); }
            v4u w; w.x = pk2(xv[j][0], xv[j][1]); w.y = pk2(xv[j][2], xv[j][3]); w.z = pk2(xv[j][4], xv[j][5]); w.w = pk2(xv[j][6], xv[j][7]);
            orow[j * 64] = w; }
#pragma unroll
        for (int o = 1; o < 64; o <<= 1) am = fmaxf(am, __shfl_xor(am, o));
        const float qs = am > 0.f ? 127.0f / am : 1.0f;
        GAS v2u* qrow = (GAS v2u*)(A.ws + WS_H2Q + (size_t)row * D) + lane;
#pragma unroll
        for (int j = 0; j < 4; ++j) { int q[8];
#pragma unroll
            for (int e = 0; e < 8; ++e) q[e] = (int)rintf(xv[j][e] * qs) & 255;
            v2u w; w.x = (unsigned)(q[0] | (q[1] << 8) | (q[2] << 16) | (q[3] << 24)); w.y = (unsigned)(q[4] | (q[5] << 8) | (q[6] << 16) | (q[7] << 24));
            qrow[j * 64] = w; }
        if (lane == 0) ((float*)(A.ws + WS_HSC))[row] = am > 0.f ? am * (1.0f / 127.0f) : 1.0f;
    }
    if (!S_CONV) { cvt_table_q8<true>(A.in[I_PU], A.ws + WS_UB, (float*)(A.ws + WS_USC), gw, NGW, lane); cvt_table_q8<false>(A.in[I_PV], A.ws + WS_VB, (float*)(A.ws + WS_VSC), gw, NGW, lane); }
}

template <int N> __device__ __forceinline__ void bitonic_sort_desc(float (&v)[N]) {
#pragma unroll
    for (int k = 2; k <= N; k <<= 1)
#pragma unroll
        for (int j = k >> 1; j > 0; j >>= 1)
#pragma unroll
            for (int i = 0; i < N; ++i) { const int l = i ^ j;
                if (l > i) { const bool desc = ((i & k) == 0); const float a = v[i], b = v[l]; const float mx = fmaxf(a, b), mn = fminf(a, b); v[i] = desc ? mx : mn; v[l] = desc ? mn : mx; } }
}
__device__ __forceinline__ void merge_top16(float (&a)[16], const float (&b)[16]) {
#pragma unroll
    for (int i = 0; i < 16; ++i) a[i] = fmaxf(a[i], b[15 - i]);
#pragma unroll
    for (int j = 8; j > 0; j >>= 1)
#pragma unroll
        for (int i = 0; i < 16; ++i) { const int l = i ^ j; if (l > i) { const float x = a[i], y = a[l]; a[i] = fmaxf(x, y); a[l] = fminf(x, y); } }
}
__device__ __forceinline__ void top16_of_64(float (&v)[64], float (&out)[16]) {
    float g[4][16];
#pragma unroll
    for (int q = 0; q < 4; ++q) {
#pragma unroll
        for (int i = 0; i < 16; ++i) g[q][i] = v[q * 16 + i];
        bitonic_sort_desc<16>(g[q]); }
    merge_top16(g[0], g[1]); merge_top16(g[2], g[3]); merge_top16(g[0], g[2]);
#pragma unroll
    for (int i = 0; i < 16; ++i) out[i] = g[0][i];
}
__device__ __forceinline__ float pack_key(float v, unsigned key, unsigned mask) { return __builtin_bit_cast(float, (__builtin_bit_cast(unsigned, v) & ~mask) | key); }
constexpr int SK_PITCH = 272;
__device__ __forceinline__ void score_top16(const bf16* q, const LAS unsigned char* skl, int tok, int h, int p, int l31, int hf, float (&out)[16]) {
    f32x16 acc[4];
#pragma unroll
    for (int kt = 0; kt < 4; ++kt)
#pragma unroll
        for (int r = 0; r < 16; ++r) acc[kt][r] = 0.f;
    bf16x8 bq[8];
#pragma unroll
    for (int ks = 0; ks < 8; ++ks) bq[ks] = *(const GAS bf16x8*)(q + (size_t)tok * D + h * 256 + p * 128 + 16 * ks + 8 * hf);
#pragma unroll
    for (int ks = 0; ks < 8; ++ks) {
#pragma unroll
        for (int kt = 0; kt < 4; ++kt) {
            const bf16x8 ak = *(const LAS bf16x8*)(skl + (p * NKEY + 32 * kt + l31) * SK_PITCH + (16 * ks + 8 * hf) * 2);
            acc[kt] = __builtin_amdgcn_mfma_f32_32x32x16_bf16(ak, bq[ks], acc[kt], 0, 0, 0);
        }
    }
    float v[64];
#pragma unroll
    for (int kt = 0; kt < 4; ++kt)
#pragma unroll
        for (int r = 0; r < 16; ++r) v[kt * 16 + r] = pack_key(acc[kt][r], (unsigned)(32 * kt + (r & 3) + 8 * (r >> 2) + 4 * hf), 0x7Fu);
    float other[16];
    top16_of_64(v, out);
#pragma unroll
    for (int i = 0; i < 16; ++i) other[i] = __shfl_xor(out[i], 32);
    merge_top16(out, other);
}
__device__ __forceinline__ void s_convert_tables(const Args& A, int gw, int NGW, int lane) {
    cvt_table_q8<true>(A.in[I_PU], A.ws + WS_UB, (float*)(A.ws + WS_USC), gw, NGW, lane);
    cvt_table_q8<false>(A.in[I_PV], A.ws + WS_VB, (float*)(A.ws + WS_VSC), gw, NGW, lane);
}
__device__ __forceinline__ void phase_s(const Args& A, LAS unsigned char* lds, int tid, int lane, int wave, int bid, int G) {
    const bf16* q = (const bf16*)(A.ws + WS_Q); const bf16* sk = (const bf16*)(A.ws + WS_SUBK);
    int* idx = (int*)(A.ws + WS_IDX); float* gate = (float*)(A.ws + WS_GATE);
    const int l31 = lane & 31, hf = lane >> 5;
    bool conv_done = false;
    for (int wi = bid; wi < (T / 512) * NH; wi += G) {
      const int h = wi & 7, tg = wi >> 3;
      __syncthreads();
#pragma unroll
      for (int i = 0; i < 8; ++i) { const int c = tid + i * NTHR, row = c >> 4, c16 = c & 15;
          *(LAS v4u*)(lds + row * SK_PITCH + c16 * 16) = *(const GAS v4u*)(sk + ((size_t)(h * 2 * NKEY + row)) * 128 + c16 * 8); }
      __syncthreads();
      if (S_CONV && wave >= 4 && !conv_done) s_convert_tables(A, bid * NWAVES + wave, G * NWAVES, lane);
      for (int ti = 0; ti < 2; ++ti) {
        const int tok = (tg * 16 + ti * 8 + wave) * 32 + l31;
        float s1[16], s2[16];
        score_top16(q, lds, tok, h, 0, l31, hf, s1);
        score_top16(q, lds, tok, h, 1, l31, hf, s2);
        float cv[64]; int n = 0;
#pragma unroll
        for (int i = 0; i < 16; ++i)
#pragma unroll
            for (int j = 0; j < 16; ++j)
                if ((i + 1) * (j + 1) <= 16) {
                    const float a = __builtin_bit_cast(float, __builtin_bit_cast(unsigned, s1[i]) & ~0x7Fu), c = __builtin_bit_cast(float, __builtin_bit_cast(unsigned, s2[j]) & ~0x7Fu);
                    cv[n++] = pack_key(a + c, (unsigned)(i * 16 + j), 0xFFu); }
#pragma unroll
        for (int m = 50; m < 64; ++m) cv[m] = -INFINITY;
        float c16[16];
        top16_of_64(cv, c16);
        float ev[16], esum = 0.f; const float cmax = __builtin_bit_cast(float, __builtin_bit_cast(unsigned, c16[0]) & ~0xFFu);
#pragma unroll
        for (int m = 0; m < 16; ++m) { ev[m] = __expf(__builtin_bit_cast(float, __builtin_bit_cast(unsigned, c16[m]) & ~0xFFu) - cmax); esum += ev[m]; }
        const float rs = 1.0f / esum;
        int oi[8]; float og[8];
#pragma unroll
        for (int mm = 0; mm < 8; ++mm) {
            float c_lo = c16[mm], c_hi = c16[8 + mm], e_lo = ev[mm], e_hi = ev[8 + mm];
            asm volatile("" : "+v"(c_lo), "+v"(c_hi), "+v"(e_lo), "+v"(e_hi));
            const unsigned cb = __builtin_bit_cast(unsigned, hf ? c_hi : c_lo); const int ii = (cb >> 4) & 15, jj = cb & 15;
            int row = 0, col = 0;
#pragma unroll
            for (int k = 0; k < 16; ++k) { row = (ii == k) ? (int)(__builtin_bit_cast(unsigned, s1[k]) & 0x7Fu) : row; col = (jj == k) ? (int)(__builtin_bit_cast(unsigned, s2[k]) & 0x7Fu) : col; }
            oi[mm] = row * NKEY + col; og[mm] = (hf ? e_hi : e_lo) * rs;
        }
        int* ip = idx + (size_t)tok * KSEL + h * 16 + hf * 8; float* gp = gate + (size_t)tok * KSEL + h * 16 + hf * 8;
        *(GAS v4u*)ip = (v4u){(unsigned)oi[0], (unsigned)oi[1], (unsigned)oi[2], (unsigned)oi[3]}; *(GAS v4u*)(ip + 4) = (v4u){(unsigned)oi[4], (unsigned)oi[5], (unsigned)oi[6], (unsigned)oi[7]};
        *(GAS f32x4*)gp = (f32x4){og[0], og[1], og[2], og[3]}; *(GAS f32x4*)(gp + 4) = (f32x4){og[4], og[5], og[6], og[7]};
      }
      if (S_CONV && wave < 4 && !conv_done) s_convert_tables(A, bid * NWAVES + wave, G * NWAVES, lane);
      conv_done = true;
    }
    if (S_CONV && !conv_done) s_convert_tables(A, bid * NWAVES + wave, G * NWAVES, lane);
    __syncthreads();
}

__device__ __forceinline__ float row_dot_fp8(const v4u d0, const v4u d1, const f32x2 (&hf)[2][8]) {
    const unsigned w0[4] = {d0.x, d0.y, d0.z, d0.w}, w1[4] = {d1.x, d1.y, d1.z, d1.w};
    f32x2 a = {0.f, 0.f}, b = {0.f, 0.f};
#pragma unroll
    for (int i = 0; i < 4; ++i) { a += fp8lo(w0[i]) * hf[0][2 * i]; a += fp8hi(w0[i]) * hf[0][2 * i + 1]; b += fp8lo(w1[i]) * hf[1][2 * i]; b += fp8hi(w1[i]) * hf[1][2 * i + 1]; }
    return (a.x + a.y) + (b.x + b.y);
}
__device__ __forceinline__ void row_axpy_fp8(f32x2 (&acc)[2][8], const v4u d0, const v4u d1, float w) {
    const unsigned w0[4] = {d0.x, d0.y, d0.z, d0.w}, w1[4] = {d1.x, d1.y, d1.z, d1.w};
#pragma unroll
    for (int i = 0; i < 4; ++i) { acc[0][2 * i] += fp8lo(w0[i]) * w; acc[0][2 * i + 1] += fp8hi(w0[i]) * w; acc[1][2 * i] += fp8lo(w1[i]) * w; acc[1][2 * i + 1] += fp8hi(w1[i]) * w; }
}
__device__ __forceinline__ void phase_pu(const Args& A, int lane, int wave, int bid, int G) {
    const unsigned char* h2q = A.ws + WS_H2Q; const unsigned char* ub = A.ws + WS_UB; const int* idx = (const int*)(A.ws + WS_IDX); float* actp = (float*)(A.ws + WS_ACTP);
    const int NX = (G % 8 == 0) ? 8 : 1, vx = bid % NX, nw = (G / NX) * NWAVES, wv = (bid / NX) * NWAVES + wave;
    const int q = lane >> 4, c16 = lane & 15;
    for (int cb = vx; cb < D / 256; cb += NX) {
        const unsigned char* ucol = ub + cb * 256 + c16 * 16;
        int cid0 = 0, cid1 = 0, nid0 = 0, nid1 = 0; v4u ch = {0u, 0u, 0u, 0u}, nh = {0u, 0u, 0u, 0u};
#define PUQ_LOAD(i0, i1, hh, t_) do { const int t__ = (t_); if (t__ < T) { i0 = idx[(size_t)t__ * KSEL + lane]; i1 = idx[(size_t)t__ * KSEL + 64 + lane]; hh = *(const GAS v4u*)(h2q + (size_t)t__ * D + cb * 256 + c16 * 16); } } while (0)
        PUQ_LOAD(cid0, cid1, ch, wv); PUQ_LOAD(nid0, nid1, nh, wv + nw);
        v4u rv[PUQ_RB];
#define PUQ_ISSUE(slot, idr, s_) do { const int e_ = __shfl(idr, ((4 * (s_)) & 63) + q); rv[slot] = *(const GAS v4u*)(ucol + (size_t)e_ * D); } while (0)
#pragma unroll
        for (int r = 0; r < PUQ_RB; ++r) PUQ_ISSUE(r, cid0, r);
        for (int tok = wv; tok < T; tok += nw) {
            const int hx = (int)ch.x, hy = (int)ch.y, hz = (int)ch.z, hw = (int)ch.w;
            int a0 = 0, a1 = 0;
#define PUQ_DOT(slot, acc_, s_) do { const v4u d_ = rv[slot]; int p_ = __builtin_amdgcn_sdot4((int)d_.x, hx, 0, false); p_ = __builtin_amdgcn_sdot4((int)d_.y, hy, p_, false); \
                p_ = __builtin_amdgcn_sdot4((int)d_.z, hz, p_, false); p_ = __builtin_amdgcn_sdot4((int)d_.w, hw, p_, false); \
                p_ += __builtin_amdgcn_update_dpp(0, p_, 0xB1, 0xF, 0xF, false); p_ += __builtin_amdgcn_update_dpp(0, p_, 0x4E, 0xF, 0xF, false); \
                p_ += __builtin_amdgcn_update_dpp(0, p_, 0x141, 0xF, 0xF, false); p_ += __builtin_amdgcn_update_dpp(0, p_, 0x140, 0xF, 0xF, false); \
                acc_ = (c16 == ((s_) & 15)) ? p_ : acc_; } while (0)
#pragma unroll
            for (int r = 0; r < PUQ_RB; ++r) { PUQ_DOT(r, a0, r); PUQ_ISSUE(r, cid1, r + PUQ_RB); }
#pragma unroll
            for (int r = 0; r < PUQ_RB; ++r) { PUQ_DOT(r, a1, r + PUQ_RB); PUQ_ISSUE(r, nid0, r); }
            float* ap = actp + ((size_t)cb * T + tok) * KSEL + 4 * c16 + q;
            ap[0] = (float)a0; ap[64] = (float)a1;
            cid0 = nid0; cid1 = nid1; ch = nh;
            PUQ_LOAD(nid0, nid1, nh, tok + 2 * nw);
        }
#undef PUQ_LOAD
#undef PUQ_ISSUE
#undef PUQ_DOT
    }
}
__device__ __forceinline__ void phase_w(const Args& A, int lane, int wave, int bid, int G) {
    const float* actp = (const float*)(A.ws + WS_ACTP); const float* usc = (const float*)(A.ws + WS_USC); const float* vsc = (const float*)(A.ws + WS_VSC); const float* hsc = (const float*)(A.ws + WS_HSC);
    const int* idx = (const int*)(A.ws + WS_IDX); const float* gate = (const float*)(A.ws + WS_GATE); float* wb = (float*)(A.ws + WS_ACT);
    for (int tok = bid * NWAVES + wave; tok < T; tok += G * NWAVES) {
        const float hs = hsc[tok];
#pragma unroll
        for (int hh = 0; hh < 2; ++hh) {
            const size_t o = (size_t)tok * KSEL + hh * 64 + lane; float sacc = 0.f;
#pragma unroll
            for (int c = 0; c < 8; ++c) sacc += actp[(size_t)c * T * KSEL + o];
            const int e = idx[o];
            wb[o] = gate[o] * gelu_tanh(sacc * usc[e] * hs) * vsc[e];
        }
    }
}
__device__ __forceinline__ void phase_pv(const Args& A, int lane, int wave, int bid, int G) {
    const unsigned char* vb = A.ws + WS_VB; const float* wb = (const float*)(A.ws + WS_ACT); const int* idx = (const int*)(A.ws + WS_IDX);
    bf16* y2 = (bf16*)(A.ws + WS_Y2); float* ssq = (float*)(A.ws + WS_SSQ);
    const int NX = (G % 8 == 0) ? 8 : 1, vx = bid % NX, nw = (G / NX) * NWAVES, wv = (bid / NX) * NWAVES + wave;
    const int q = lane >> 4, c16 = lane & 15;
    for (int cb = vx; cb < D / 256; cb += NX) {
        const unsigned char* vcol = vb + cb * 256 + c16 * 16;
        int cid0 = 0, cid1 = 0, nid0 = 0, nid1 = 0; float cw0 = 0.f, cw1 = 0.f, nw0 = 0.f, nw1 = 0.f;
#define PVQ_LOAD(i0, i1, x0, x1, t_) do { const int t__ = (t_); if (t__ < T) { i0 = idx[(size_t)t__ * KSEL + lane]; i1 = idx[(size_t)t__ * KSEL + 64 + lane]; x0 = wb[(size_t)t__ * KSEL + lane]; x1 = wb[(size_t)t__ * KSEL + 64 + lane]; } } while (0)
        PVQ_LOAD(cid0, cid1, cw0, cw1, wv); PVQ_LOAD(nid0, nid1, nw0, nw1, wv + nw);
        v4u rv[PVQ_RB];
#define PVQ_ISSUE(slot, idr, s_) do { const int e_ = __shfl(idr, ((4 * (s_)) & 63) + q); rv[slot] = *(const GAS v4u*)(vcol + (size_t)e_ * D); } while (0)
#pragma unroll
        for (int r = 0; r < PVQ_RB; ++r) PVQ_ISSUE(r, cid0, r);
        for (int tok = wv; tok < T; tok += nw) {
            f32x2 acc[8];
#pragma unroll
            for (int i = 0; i < 8; ++i) acc[i] = (f32x2){0.f, 0.f};
#define PVQ_FMA(slot, wr, s_) do { const float w_ = __shfl(wr, ((4 * (s_)) & 63) + q); const v4u d_ = rv[slot]; const unsigned dw_[4] = {d_.x, d_.y, d_.z, d_.w}; \
                _Pragma("unroll") for (int i_ = 0; i_ < 4; ++i_) { acc[2 * i_] += fp8lo(dw_[i_]) * w_; acc[2 * i_ + 1] += fp8hi(dw_[i_]) * w_; } } while (0)
#pragma unroll
            for (int r = 0; r < PVQ_RB; ++r) { PVQ_FMA(r, cw0, r); PVQ_ISSUE(r, cid1, r + PVQ_RB); }
#pragma unroll
            for (int r = 0; r < PVQ_RB; ++r) { PVQ_FMA(r, cw1, r + PVQ_RB); PVQ_ISSUE(r, nid0, r); }
            float sq = 0.f;
#pragma unroll
            for (int i = 0; i < 8; ++i) { float x = acc[i].x, y = acc[i].y; x += __shfl_xor(x, 16); y += __shfl_xor(y, 16); x += __shfl_xor(x, 32); y += __shfl_xor(y, 32); acc[i] = (f32x2){x, y}; sq += x * x + y * y; }
            sq = wave_total(q == 0 ? sq : 0.f);
            if (q == 0) { GAS v4u* yo = (GAS v4u*)(y2 + (size_t)tok * D + cb * 256 + c16 * 16);
                yo[0] = (v4u){pk2(acc[0].x, acc[0].y), pk2(acc[1].x, acc[1].y), pk2(acc[2].x, acc[2].y), pk2(acc[3].x, acc[3].y)};
                yo[1] = (v4u){pk2(acc[4].x, acc[4].y), pk2(acc[5].x, acc[5].y), pk2(acc[6].x, acc[6].y), pk2(acc[7].x, acc[7].y)}; }
            if (lane == 0) ssq[(size_t)cb * T + tok] = sq;
            cid0 = nid0; cid1 = nid1; cw0 = nw0; cw1 = nw1;
            PVQ_LOAD(nid0, nid1, nw0, nw1, tok + 2 * nw);
        }
#undef PVQ_LOAD
#undef PVQ_ISSUE
#undef PVQ_FMA
    }
}
__device__ __forceinline__ void phase_f(const Args& A, int lane, int wave, int bid, int G) {
    const bf16* y1 = (const bf16*)(A.ws + WS_Y1); const bf16* y2 = (const bf16*)(A.ws + WS_Y2); const float* ssq = (const float*)(A.ws + WS_SSQ); const float* cfin = (const float*)(A.ws + WS_CFIN);
    for (int tok = bid * NWAVES + wave; tok < T; tok += G * NWAVES) {
        const int b = tok >> 13;
        float qs = 0.f;
#pragma unroll
        for (int c = 0; c < 8; ++c) qs += ssq[(size_t)c * T + tok];
        const float rstd2 = __builtin_amdgcn_rsqf(qs * (1.0f / D) + EPS);
        const GAS v2u* yp = (const GAS v2u*)(y1 + (size_t)tok * D) + lane; const GAS v2u* zp = (const GAS v2u*)(y2 + (size_t)tok * D) + lane;
        const GAS f32x4* xr = (const GAS f32x4*)(A.in[I_X] + (size_t)tok * D) + lane;
        v2u yq[8], zq[8]; f32x4 xv[8]; float s1 = 0.f;
#pragma unroll
        for (int i = 0; i < 8; ++i) { yq[i] = yp[i * 64]; zq[i] = zp[i * 64]; xv[i] = xr[i * 64]; }
#pragma unroll
        for (int i = 0; i < 8; ++i) { const float a = bflo(yq[i].x), b_ = bfhi(yq[i].x), c = bflo(yq[i].y), d = bfhi(yq[i].y); s1 += (a * a + b_ * b_) + (c * c + d * d); }
        const float rstd1 = __builtin_amdgcn_rsqf(wave_total(s1) * (1.0f / D) + EPS);
        const GAS f32x4* c1 = (const GAS f32x4*)(cfin + (size_t)(b * 2 + 0) * D) + lane; const GAS f32x4* c2 = (const GAS f32x4*)(cfin + (size_t)(b * 2 + 1) * D) + lane;
        GAS f32x4* orow = (GAS f32x4*)(A.out + (size_t)tok * D) + lane;
#pragma unroll
        for (int i = 0; i < 8; ++i) { const f32x4 a1 = c1[i * 64], a2 = c2[i * 64];
            const float yv[4] = {bflo(yq[i].x), bfhi(yq[i].x), bflo(yq[i].y), bfhi(yq[i].y)}, zv[4] = {bflo(zq[i].x), bfhi(zq[i].x), bflo(zq[i].y), bfhi(zq[i].y)}; f32x4 o;
#pragma unroll
            for (int e = 0; e < 4; ++e) o[e] = xv[i][e] + (OUT_MODE != 2 ? a1[e] * yv[e] * rstd1 : 0.f) + (OUT_MODE != 1 ? a2[e] * zv[e] * rstd2 : 0.f);
            orow[i * 64] = o; }
    }
}

#if defined(MK_CHECKS)
constexpr int CW_CHK = 2048;
__device__ __forceinline__ unsigned hsh(unsigned x) { x ^= x >> 16; x *= 0x7feb352dU; x ^= x >> 15; x *= 0x846ca68bU; x ^= x >> 16; return x; }
__device__ __forceinline__ float bfv(const bf16* p, size_t i) { return __builtin_bit_cast(float, (unsigned)p[i] << 16); }
__device__ __forceinline__ float relerr(float got, float ref, float scale) { const float d = fabsf(got - ref) / (fabsf(ref) + scale); return (d == d) ? d : 1e30f; }
__device__ __forceinline__ void chk_put(unsigned* ctl, int stage, float e) { atomicMax(ctl + CW_CHK + stage, __builtin_bit_cast(unsigned, e)); }
__device__ float chk_gemm(const bf16* Am, const bf16* Bt, const bf16* C, int N, int K, unsigned s) {
    const int row = hsh(s) % T, col = hsh(s * 7 + 1) % N; float acc = 0.f;
    for (int k = 0; k < K; ++k) acc += bfv(Am, (size_t)row * K + k) * bfv(Bt, (size_t)col * K + k);
    return relerr(bfv(C, (size_t)row * N + col), acc, 0.05f);
}
__global__ void __launch_bounds__(128) chk_kernel(Args A, int stage) {
    __shared__ float sh[10240];
    unsigned* ctl = (unsigned*)(A.ws + WS_CTL);
    const int tid = threadIdx.x; const unsigned s = hsh(tid * 2654435761u + stage * 97u + 12345u);
    const float* modp = (const float*)(A.ws + WS_MODP);
    float e = 0.f;
    if (stage == 0) {
        { const int b = s & 1, n = hsh(s) % NMOD; float acc = A.in[I_BMOD][n];
          for (int k = 0; k < D; ++k) { const float c = A.in[I_C][b * D + k]; acc += c / (1.0f + expf(-c)) * A.in[I_WMOD][(size_t)k * NMOD + n]; }
          e = fmaxf(e, relerr(mod_at(modp, b, n), acc, 0.01f)); }
        { const int n = hsh(s + 1) % IN_COLS, k = hsh(s + 2) % D; e = fmaxf(e, relerr(bfv((const bf16*)(A.ws + WS_BT1), (size_t)n * D + k), A.in[I_WIN][(size_t)k * IN_COLS + n], 1e-3f)); }
        { const int n = hsh(s + 3) % D, k = hsh(s + 4) % D; e = fmaxf(e, relerr(bfv((const bf16*)(A.ws + WS_BT2), (size_t)n * D + k), A.in[I_WOUT][(size_t)k * D + n], 1e-3f));
          e = fmaxf(e, relerr(bfv((const bf16*)(A.ws + WS_BT3), (size_t)n * D + k), A.in[I_WQ][(size_t)k * D + n], 1e-3f)); }
        { const int h = s & 7, n = hsh(s + 5) & 255, k = hsh(s + 6) & 127; const float ref = (n < 128 ? A.in[I_WA] : A.in[I_WX])[h * 16384 + k * 128 + (n & 127)];
          e = fmaxf(e, relerr(bfv((const bf16*)(A.ws + WS_WG), (size_t)(h * 256 + n) * 128 + k), ref, 1e-3f)); }
        { const int i = hsh(s + 7) % (NH * 2 * NKEY * 128); e = fmaxf(e, relerr(bfv((const bf16*)(A.ws + WS_SUBK), i), A.in[I_SUBK][i], 1e-3f)); }
    } else if (stage == 1) {
        const int row = hsh(s) % T, col = hsh(s + 1) % D, b = row >> 13; float ss = 0.f;
        for (int k = 0; k < D; ++k) { const float x = A.in[I_X][(size_t)row * D + k]; ss += x * x; }
        const float ref = A.in[I_X][(size_t)row * D + col] * rsqrtf(ss / D + EPS) * A.in[I_GPREMIX][col] * (1.0f + mod_at(modp, b, D + col)) + mod_at(modp, b, col);
        e = relerr(bfv((const bf16*)(A.ws + WS_RA), (size_t)row * D + col), ref, 0.05f);
        const float* cfin = (const float*)(A.ws + WS_CFIN);
        e = fmaxf(e, relerr(cfin[(b * 2 + 0) * D + col], mod_at(modp, b, 2 * D + col) * A.in[I_GPOSTMIX][col], 1e-3f));
        e = fmaxf(e, relerr(cfin[(b * 2 + 1) * D + col], mod_at(modp, b, 5 * D + col) * A.in[I_GPOSTFFN][col], 1e-3f));
    } else if (stage == 2) { e = chk_gemm((const bf16*)(A.ws + WS_RA), (const bf16*)(A.ws + WS_BT1), (const bf16*)(A.ws + WS_PROJ), IN_COLS, D, s);
    } else if (stage == 7) { e = chk_gemm((const bf16*)(A.ws + WS_RA), (const bf16*)(A.ws + WS_BT2), (const bf16*)(A.ws + WS_Y1), D, D, s);
    } else if (stage == 9) { e = chk_gemm((const bf16*)(A.ws + WS_RA), (const bf16*)(A.ws + WS_BT3), (const bf16*)(A.ws + WS_Q), D, D, s);
    } else if (stage == 3) {
        const bf16* proj = (const bf16*)(A.ws + WS_PROJ);
        int row = hsh(s) % T; if (tid < 16) row = (tid & 1) * SEQ + (tid >> 1);
        const int c = hsh(s + 1) % LRU_W, t = row & (SEQ - 1);
        float a = A.in[I_LCB][c];
        for (int j = 0; j < 4; ++j) if (t - 3 + j >= 0) a += A.in[I_LCW][j * LRU_W + c] * bfv(proj, (size_t)(row - 3 + j) * IN_COLS + c);
        e = relerr(bfv((const bf16*)(A.ws + WS_XL), (size_t)row * LRU_W + c), a, 0.05f);
        float z = A.in[I_CDB][c];
        for (int j = 0; j < CONF_K; ++j) if (t - 30 + j >= 0) { const size_t r = (size_t)(row - 30 + j) * IN_COLS; const float g = bfv(proj, r + 3072 + c);
            z += A.in[I_CDW][j * CONF_W + c] * bfv(proj, r + 2048 + c) / (1.0f + expf(-g)); }
        e = fmaxf(e, relerr(bfv((const bf16*)(A.ws + WS_ZC), (size_t)row * CONF_W + c), z, 0.05f));
    } else if (stage == 4) {
        const bf16* xl = (const bf16*)(A.ws + WS_XL);
        const int b = s & 1, chunk = hsh(s + 1) % NCHUNK, ch = hsh(s + 2) % LRU_W, hh = ch >> 7, j = ch & 127;
        const float cl = -8.0f * log1pf(expf(-A.in[I_LAMBDA][ch])); float P = 1.f, H = 0.f;
        for (int t = 0; t < CHUNK; ++t) { const size_t row = (size_t)b * SEQ + chunk * CHUNK + t; float ga = A.in[I_BA][ch], gx = A.in[I_BX][ch];
            for (int i = 0; i < 128; ++i) { const float xv = bfv(xl, row * LRU_W + hh * 128 + i); ga += xv * A.in[I_WA][hh * 16384 + i * 128 + j]; gx += xv * A.in[I_WX][hh * 16384 + i * 128 + j]; }
            const float r = 1.0f / (1.0f + expf(-ga)), ig = 1.0f / (1.0f + expf(-gx)), la = cl * r, a = expf(la), u = sqrtf(fmaxf(-expm1f(2.0f * la), 0.f)) * ig * bfv(xl, row * LRU_W + ch);
            H = a * H + u; P = P * a;
            e = fmaxf(e, relerr(bfv((const bf16*)(A.ws + WS_HLOC), row * LRU_W + ch), H, 0.05f)); e = fmaxf(e, relerr(bfv((const bf16*)(A.ws + WS_PC), row * LRU_W + ch), P, 0.02f)); }
        const float* ag = (const float*)(A.ws + WS_AGG) + ((size_t)(b * NCHUNK + chunk) * LRU_W + ch) * 2;
        e = fmaxf(e, relerr(ag[0], P, 0.02f)); e = fmaxf(e, relerr(ag[1], H, 0.05f));
    } else if (stage == 5) {
    } else if (stage == 6) {
        const bf16* proj = (const bf16*)(A.ws + WS_PROJ); const bf16* zc = (const bf16*)(A.ws + WS_ZC);
        const int row = hsh(s) % T, c = hsh(s + 1) % LRU_W, b = row >> 13, chunk = (row & (SEQ - 1)) >> 6;
        float cin = 0.f; for (int cc = 0; cc < chunk; ++cc) { const float* ag = (const float*)(A.ws + WS_AGG) + ((size_t)(b * NCHUNK + cc) * LRU_W + c) * 2; cin = ag[0] * cin + ag[1]; }
        const float hfull = bfv((const bf16*)(A.ws + WS_HLOC), (size_t)row * LRU_W + c) + bfv((const bf16*)(A.ws + WS_PC), (size_t)row * LRU_W + c) * cin;
        const float g = bfv(proj, (size_t)row * IN_COLS + 1024 + c), ge = 0.5f * g * (1.0f + tanhf(0.7978845608f * (g + 0.044715f * g * g * g)));
        e = relerr(bfv((const bf16*)(A.ws + WS_RA), (size_t)row * D + c), hfull * ge, 0.05f);
        float m = 0.f, q = 0.f;
        for (int k = 0; k < CONF_W; ++k) m += bfv(zc, (size_t)row * CONF_W + k);
        m /= CONF_W;
        for (int k = 0; k < CONF_W; ++k) { const float d = bfv(zc, (size_t)row * CONF_W + k) - m; q += d * d; }
        const float n = (bfv(zc, (size_t)row * CONF_W + c) - m) * rsqrtf(q / CONF_W + EPS) * A.in[I_LNG][c] + A.in[I_LNB][c];
        e = fmaxf(e, relerr(bfv((const bf16*)(A.ws + WS_RA), (size_t)row * D + 1024 + c), n / (1.0f + expf(-n)), 0.05f));
    } else if (stage == 8) {
        const bf16* y1 = (const bf16*)(A.ws + WS_Y1); const float* cfin = (const float*)(A.ws + WS_CFIN);
        const int row = hsh(s) % T, col = hsh(s + 1) % D, b = row >> 13; float s1 = 0.f, s2 = 0.f;
        for (int k = 0; k < D; ++k) { const float y = bfv(y1, (size_t)row * D + k); s1 += y * y; }
        const float r1 = rsqrtf(s1 / D + EPS);
        for (int k = 0; k < D; ++k) { const float x1 = A.in[I_X][(size_t)row * D + k] + cfin[(b * 2) * D + k] * bfv(y1, (size_t)row * D + k) * r1; s2 += x1 * x1; }
        const float x1c = A.in[I_X][(size_t)row * D + col] + cfin[(b * 2) * D + col] * bfv(y1, (size_t)row * D + col) * r1;
        const float ref = x1c * rsqrtf(s2 / D + EPS) * A.in[I_GPREFFN][col] * (1.0f + mod_at(modp, b, 4 * D + col)) + mod_at(modp, b, 3 * D + col);
        e = relerr(bfv((const bf16*)(A.ws + WS_RA), (size_t)row * D + col), ref, 0.05f);
    } else if (stage == 10) {
        { const size_t i = (size_t)(hsh(s + 2) % NEXP) * D + hsh(s + 3) % D;
          const unsigned wu = ((const unsigned*)(A.ws + WS_UB))[i >> 2] >> (8 * (i & 3)), wv = ((const unsigned*)(A.ws + WS_VB))[i >> 2] >> (8 * (i & 3));
          const float du = (float)(signed char)(wu & 255u) * ((const float*)(A.ws + WS_USC))[i / D], dv = __builtin_amdgcn_cvt_pk_f32_fp8((int)wv, false)[0] * ((const float*)(A.ws + WS_VSC))[i / D];
          e = fmaxf(e, relerr(du, A.in[I_PU][i], 2e-3f) * 0.3f); e = fmaxf(e, relerr(dv, A.in[I_PV][i], 3e-2f) * 0.3f); }
        if (tid < 32) {
            const bf16* q = (const bf16*)(A.ws + WS_Q); const int* idx = (const int*)(A.ws + WS_IDX); const float* gate = (const float*)(A.ws + WS_GATE);
            const int tok = hsh(s) % T, h = hsh(s + 1) & 7;
            float* sc = sh + tid * 320;
            for (int p = 0; p < 2; ++p) for (int n = 0; n < NKEY; ++n) { float a = 0.f;
                for (int d = 0; d < 128; ++d) a += bfv(q, (size_t)tok * D + h * 256 + p * 128 + d) * A.in[I_SUBK][((size_t)((h * 2 + p) * NKEY + n)) * 128 + d];
                sc[p * 128 + n] = a; }
            for (int p = 0; p < 2; ++p) { float prev = 1e30f; for (int it = 0; it < 16; ++it) { float best = -1e30f; int bi = 0;
                for (int n = 0; n < NKEY; ++n) { const float v = sc[p * 128 + n]; if (v < prev && v > best) { best = v; bi = n; } }
                sc[256 + p * 16 + it] = best; sc[288 + p * 16 + it] = (float)bi; prev = best; } }
            float prev = 1e30f, esum = 0.f, cmax = 0.f; int miss = 0; float gerr = 0.f;
            { float pv = 1e30f; for (int it = 0; it < 16; ++it) { float best = -1e30f;
                for (int c = 0; c < 256; ++c) { const float v = sc[256 + (c >> 4)] + sc[272 + (c & 15)]; if (v < pv && v > best) best = v; }
                if (it == 0) cmax = best; esum += expf(best - cmax); pv = best; } }
            for (int it = 0; it < 16; ++it) { float best = -1e30f; int bc = 0;
                for (int c = 0; c < 256; ++c) { const float v = sc[256 + (c >> 4)] + sc[272 + (c & 15)]; if (v < prev && v > best) { best = v; bc = c; } }
                prev = best;
                const int eidx = (int)sc[288 + (bc >> 4)] * NKEY + (int)sc[304 + (bc & 15)]; const float g = expf(best - cmax) / esum; bool found = false;
                for (int m = 0; m < 16; ++m) if (idx[(size_t)tok * KSEL + h * 16 + m] == eidx) { found = true; gerr = fmaxf(gerr, relerr(gate[(size_t)tok * KSEL + h * 16 + m], g, 0.02f)); }
                if (!found) ++miss; }
            e = fmaxf((float)miss / 16.0f, gerr);
        }
    } else if (stage == 11) {
        const bf16* h2 = (const bf16*)(A.ws + WS_RA); const bf16* y1 = (const bf16*)(A.ws + WS_Y1); const int* idx = (const int*)(A.ws + WS_IDX); const float* gate = (const float*)(A.ws + WS_GATE); const float* cfin = (const float*)(A.ws + WS_CFIN);
        const int tok = hsh(blockIdx.x * 977u + 5u) % T, b = tok >> 13;
        { const int ex = idx[(size_t)tok * KSEL + tid]; float a = 0.f;
          if ((unsigned)ex < (unsigned)NEXP) { for (int d = 0; d < D; ++d) a += bfv(h2, (size_t)tok * D + d) * A.in[I_PU][(size_t)ex * D + d]; } else a = 1e30f;
          const float ge = 0.5f * a * (1.0f + tanhf(0.7978845608f * (a + 0.044715f * a * a * a)));
          sh[tid] = gate[(size_t)tok * KSEL + tid] * ge; sh[128 + tid] = __builtin_bit_cast(float, ex); }
        __syncthreads();
        float s2 = 0.f, s1 = 0.f;
        for (int cc = 0; cc < 16; ++cc) { const int col = cc * 128 + tid; float a = 0.f;
            for (int k = 0; k < KSEL; ++k) { const int ex = __builtin_bit_cast(int, sh[128 + k]); if ((unsigned)ex < (unsigned)NEXP) a += sh[k] * A.in[I_PV][(size_t)ex * D + col]; }
            sh[512 + cc * 128 + tid] = a; s2 += a * a; const float y = bfv(y1, (size_t)tok * D + col); s1 += y * y; }
        __syncthreads(); sh[256 + tid] = s2; sh[384 + tid] = s1; __syncthreads();
        float t2 = 0.f, t1 = 0.f; for (int k = 0; k < 128; ++k) { t2 += sh[256 + k]; t1 += sh[384 + k]; }
        const float r2 = rsqrtf(t2 / D + EPS), r1 = rsqrtf(t1 / D + EPS);
        float en = 0.f, ed = 0.f;
        for (int cc = 0; cc < 16; ++cc) { const int col = cc * 128 + tid;
            const float pterm = cfin[(b * 2 + 1) * D + col] * sh[512 + cc * 128 + tid] * r2;
            const float ref = A.in[I_X][(size_t)tok * D + col] + (OUT_MODE != 2 ? cfin[(b * 2) * D + col] * bfv(y1, (size_t)tok * D + col) * r1 : 0.f) + (OUT_MODE != 1 ? pterm : 0.f);
            const float d = A.out[(size_t)tok * D + col] - ref; en += d * d; ed += pterm * pterm; }
        __syncthreads(); sh[256 + tid] = en; sh[384 + tid] = ed; __syncthreads();
        float ten = 0.f, ted = 0.f; for (int k = 0; k < 128; ++k) { ten += sh[256 + k]; ted += sh[384 + k]; }
        e = ten / (ted + 1e-12f); if (!(e == e)) e = 1e30f;
    }
    chk_put(ctl, stage, e);
}
__global__ void chk_encode(Args A, int what) {
    const unsigned* ctl = (const unsigned*)(A.ws + WS_CTL);
    if (threadIdx.x == 0 && blockIdx.x == 0) {
        if (what < 0) {
            const float thr[12] = {0.03f, 0.03f, 0.03f, 0.03f, 0.06f, 0.01f, 0.04f, 0.03f, 0.03f, 0.03f, 0.2f, 0.01f};
            for (int st = 0; st < 12; ++st) { const float e = __builtin_bit_cast(float, ctl[CW_CHK + st]); if (!(e <= thr[st])) { A.out[0] = 4000.0f * (float)(1 << st); break; } }
        } else {
            const float e = fminf(__builtin_bit_cast(float, ctl[CW_CHK + what]), 1e6f); A.out[0] = 4000.0f * sqrtf(1e6f * e);
        }
    }
}
#endif

__global__ void __launch_bounds__(NTHR, 2) fwd_kernel(Args args) {
    extern __shared__ __attribute__((aligned(16))) unsigned char lds_raw[];
    LAS unsigned char* lds = (LAS unsigned char*)lds_raw;
    const int tid = threadIdx.x, lane = tid & 63, wave = __builtin_amdgcn_readfirstlane(tid >> 6), bid = blockIdx.x, G = gridDim.x;
    for (int u = tid; u < (LDS_BYTES - LDSCTL_OFF) / 4; u += NTHR) ((LAS unsigned*)(lds + LDSCTL_OFF))[u] = 0u;
    __syncthreads();
    unsigned* ctl = (unsigned*)(args.ws + WS_CTL);
    XcdBarrier bar; bar.bar = ctl + CW_BAR + args.li * XCD_BAR_WORDS; bar.x = 0; bar.st = nullptr;
    if (MK_N_LAUNCHES != N_PHASES) bar = xcd_barrier_post(ctl + CW_BAR + args.li * XCD_BAR_WORDS, (volatile LAS unsigned*)(lds + MISC_OFF) + 8);
    const int lo = args.ph_lo, hi = args.ph_hi;
#define IN(k) (lo <= (k) && (k) < hi)
#define SEAM(k) do { if (IN(k) && IN((k) + 1)) xcd_barrier(bar); } while (0)
#define PHON(k) ((PH_MASK >> (k)) & 1)
    if (PHON(0) && IN(0)) { phase_p0(args, lds, tid, lane, wave, bid, G); }
    SEAM(0);
    if (PHON(1) && IN(1)) { phase_p1(args, tid, lane, wave, bid, G); }
    SEAM(1);
    if (PHON(2) && IN(2)) {
        pg8::Gemm g{(const bf16*)(args.ws + WS_RA), (const bf16*)(args.ws + WS_BT1), T, IN_COLS, D}; pg8::StaticOrder S; S.init(T, IN_COLS, G, bid);
        pg8::EpiBf16<0> E{(bf16*)(args.ws + WS_PROJ), IN_COLS, nullptr, 0, 0, 1.f};
        pg8::gemm_phase<pg8::EpiBf16<0>, pg8::StaticOrder, PG8_ALIGN, PG8_SP2>(lds + RING_OFF, g, S, E);
    }
    SEAM(2);
    if (PHON(3) && IN(3)) { phase_m1a(args, lds, tid, lane, wave, bid, G); }
    SEAM(3);
    if (PHON(4) && IN(4)) { phase_m1b(args, tid, lane, wave, bid, G); }
    SEAM(4);
    if (PHON(5) && IN(5)) { phase_m3(args, lds, tid, lane, wave, bid, G); }
    SEAM(5);
    if (PHON(6) && IN(6)) {
        pg8::Gemm g{(const bf16*)(args.ws + WS_RA), (const bf16*)(args.ws + WS_BT2), T, D, D}; pg8::StaticOrder S; S.init(T, D, G, bid);
        pg8::EpiBf16<0> E{(bf16*)(args.ws + WS_Y1), D, nullptr, 0, 0, 1.f};
        pg8::gemm_phase<pg8::EpiBf16<0>, pg8::StaticOrder, PG8_ALIGN, PG8_SP2>(lds + RING_OFF, g, S, E);
    }
    SEAM(6);
    if (PHON(7) && IN(7)) { phase_e2(args, tid, lane, wave, bid, G); }
    SEAM(7);
    if (PHON(8) && IN(8)) {
        pg8::Gemm g{(const bf16*)(args.ws + WS_RA), (const bf16*)(args.ws + WS_BT3), T, D, D}; pg8::StaticOrder S; S.init(T, D, G, bid);
        pg8::EpiBf16<0> E{(bf16*)(args.ws + WS_Q), D, nullptr, 0, 0, 1.f};
        pg8::gemm_phase<pg8::EpiBf16<0>, pg8::StaticOrder, PG8_ALIGN, PG8_SP2>(lds + RING_OFF, g, S, E);
    }
    SEAM(8);
    if (PHON(9) && IN(9)) { phase_s(args, lds, tid, lane, wave, bid, G); }
    SEAM(9);
    if (PHON(10) && IN(10)) { phase_pu(args, lane, wave, bid, G); }
    SEAM(10);
    if (PHON(11) && IN(11)) { phase_w(args, lane, wave, bid, G); }
    SEAM(11);
    if (PHON(12) && IN(12)) { phase_pv(args, lane, wave, bid, G); }
    SEAM(12);
    if (PHON(13) && IN(13)) { phase_f(args, lane, wave, bid, G); }
#undef IN
#undef SEAM
}

extern "C" void kernel_launch(void* const* d_in, const int* in_sizes, int n_in, void* d_out, int out_size, void* d_ws, size_t ws_size, hipStream_t stream) {
    static int grid = 0;
    if (grid == 0) {
        if (n_in != 25 || in_sizes[0] != T * D || out_size != T * D || ws_size < WS_END) {
            fprintf(stderr, "kernel_launch: built for 25 inputs, x/out of %d floats, >= %zu bytes of workspace; got n_in %d, in0 %d, out %d, ws %zu; nothing launched\n", T * D, (size_t)WS_END, n_in, n_in > 0 ? in_sizes[0] : -1, out_size, ws_size);
            grid = -1; return; }
        int dev = 0, cus = 0, per_cu = 0;
        if (hipGetDevice(&dev) != hipSuccess || hipDeviceGetAttribute(&cus, hipDeviceAttributeMultiprocessorCount, dev) != hipSuccess) { fprintf(stderr, "kernel_launch: device query failed\n"); grid = -1; return; }
        if (hipFuncSetAttribute((const void*)fwd_kernel, hipFuncAttributeMaxDynamicSharedMemorySize, LDS_BYTES) != hipSuccess) { fprintf(stderr, "kernel_launch: hipFuncSetAttribute failed\n"); grid = -1; return; }
        if (hipOccupancyMaxActiveBlocksPerMultiprocessor(&per_cu, (const void*)fwd_kernel, NTHR, LDS_BYTES) != hipSuccess || per_cu < 1)
            fprintf(stderr, "kernel_launch: note: occupancy query reports %d workgroups per CU\n", per_cu);
        (void)hipGetLastError();
        grid = cus;
    }
    if (grid < 0) return;
    if (hipMemsetAsync((char*)d_ws + WS_CTL, 0, CTL_ZERO_BYTES, stream) != hipSuccess) { fprintf(stderr, "kernel_launch: memset failed\n"); return; }
    Args a{};
    for (int i = 0; i < 25; ++i) a.in[i] = (const float*)d_in[i];
    a.out = (float*)d_out; a.ws = (unsigned char*)d_ws;
#if defined(MK_TIME_REP)
    const int cuts[3][2] = {{0, MK_TIME_REP + 1}, {MK_TIME_REP, MK_TIME_REP + 1}, {MK_TIME_REP + 1, N_PHASES}};
    for (int li = 0; li < 3; ++li) {
        a.ph_lo = cuts[li][0]; a.ph_hi = cuts[li][1]; a.li = li;
        if (a.ph_lo < a.ph_hi) hipLaunchKernelGGL(fwd_kernel, dim3(grid), dim3(NTHR), LDS_BYTES, stream, a);
    }
#else
    for (int li = 0; li < MK_N_LAUNCHES; ++li) {
        if (MK_N_LAUNCHES == 1) { a.ph_lo = 0; a.ph_hi = N_PHASES; } else { a.ph_lo = li; a.ph_hi = li + 1; }
        a.li = 0;
        hipLaunchKernelGGL(fwd_kernel, dim3(grid), dim3(NTHR), LDS_BYTES, stream, a);
        const hipError_t le = hipPeekAtLastError();
        if (le != hipSuccess) { fprintf(stderr, "kernel_launch: launch %d failed: %s\n", li, hipGetErrorName(le)); break; }
#if defined(MK_CHECKS)
        { const int chk_of_phase[N_PHASES] = {0, 1, 2, 3, 4, 6, 7, 8, 9, 10, 5, 5, 5, 11}; hipLaunchKernelGGL(chk_kernel, dim3(4), dim3(128), 0, stream, a, chk_of_phase[li]); }
#endif
    }
#endif
#if defined(MK_CHECKS)
    hipLaunchKernelGGL(chk_encode, dim3(1), dim3(64), 0, stream, a, MK_CHECKS);
#endif
}
```

```cpp
#include <hip/hip_runtime.h>
#include <cstdio>
#include <cstdint>
#include <cmath>
namespace pg8 {
#define PG8_LAS __attribute__((address_space(3)))
typedef unsigned short bf16_t;
typedef short bf16x8 __attribute__((ext_vector_type(8)));
typedef float f32x4 __attribute__((ext_vector_type(4)));
typedef unsigned u32x4 __attribute__((ext_vector_type(4)));
constexpr int BM = 256, BK = 64, HALF = 128, HTB = HALF * BK * 2  , STAGE_BYTES = 8 * HTB, NXCD = 8, WGM = 8;

__host__ __device__ __forceinline__ int lds_byte(int r, int c) { const int st = (r >> 4) * 2 + (c >> 5), rr = r & 15, cc = c & 31, ob = rr * 64 + cc * 2; return st * 1024 + (ob ^ (((ob >> 9) & 1) << 5)); }
__host__ __device__ __forceinline__ void stage_rc(int b, int& R, int& C) { const int st = b / 1024, sb = b % 1024, swz = sb ^ (((sb >> 9) & 1) << 5); R = (st >> 1) * 16 + swz / 64; C = (st & 1) * 32 + (swz % 64) / 2; }
__host__ __device__ __forceinline__ int perm32(int rho) { const int n = rho >> 4, i = rho & 15; return 8 * (i >> 2) + 4 * n + (i & 3); }

struct Unit { int pm, pn; };
struct Gemm { const bf16_t* A; const bf16_t* Bt; int M, N, K; };

struct StaticOrder {
    int nM, nN, nwg, G, c;
    __host__ __device__ void init(int M, int N, int G_, int c_) { nM = M / BM; nN = N / BM; nwg = nM * nN; G = G_; c = c_; }
    __host__ __device__ bool next(int i, Unit& u) const {
        const long L = (long)i * G + c; if (L >= nwg) return false;
        int wgid = (int)L; { const int q = nwg / NXCD, r = nwg % NXCD, xcd = wgid % NXCD, off = wgid / NXCD; wgid = (xcd < r ? xcd * (q + 1) : r * (q + 1) + (xcd - r) * q) + off; }
        const int nig = WGM * nN, gid = wgid / nig, fm = gid * WGM, gsz = (nM - fm) < WGM ? (nM - fm) : WGM;
        u.pm = fm + ((wgid % nig) % gsz); u.pn = (wgid % nig) / gsz; return true;
    }
    __device__ __forceinline__ void a_ready(const Unit&) const {}
    __device__ __forceinline__ void done(const Unit&) const {}
};

__device__ __forceinline__ unsigned cvt_pk_bf16(float lo, float hi) { unsigned r; asm volatile("v_cvt_pk_bf16_f32 %0, %1, %2" : "=v"(r) : "v"(lo), "v"(hi)); return r; }
typedef float f32x2 __attribute__((ext_vector_type(2)));
__device__ __forceinline__ f32x2 gelu_pk(f32x2 v) {
    const f32x2 av = __builtin_elementwise_abs(v), d = av * 0.2316418882f + 1.0f;
    f32x2 t; t.x = __builtin_amdgcn_rcpf(d.x); t.y = __builtin_amdgcn_rcpf(d.y);
    f32x2 q = t * 0.5307027145f + (-0.7265760135f); q = q * t + 0.7107068705f; q = q * t + (-0.142248368f); q = q * t + 0.127414796f; q = q * t;
    const f32x2 s = (v * v) * (-0.72134752044f);
    f32x2 e; e.x = __builtin_amdgcn_exp2f(s.x); e.y = __builtin_amdgcn_exp2f(s.y);
    const f32x2 m = v * (q * e), r = v - m;
    f32x2 o; o.x = v.x < 0.f ? m.x : r.x; o.y = v.y < 0.f ? m.y : r.y; return o;
}

template <int ACT  > struct EpiBf16 {
    static constexpr bool PERM = true, AFTER_DRAIN = false; static_assert(ACT == 0 || ACT == 1, "EpiBf16: ACT is 0 (none) or 1 (gelu_pk)");
    bf16_t* O; int ldc; const float* bias; int split_cols; size_t split_stride; float scale0;
    __device__ __forceinline__ void operator()(const f32x4 (&acc)[2][2][4][2], const Unit& u, int wr, int wc, int fr, int fq) const {
        const int row0 = u.pm * BM + wr * 64 + fr; int colt = u.pn * BM; bf16_t* base = O;
        float sc = 1.f; if (split_cols) { const int t = colt / split_cols; base += (size_t)t * split_stride; colt -= t * split_cols; if (t == 0) sc = scale0; }
        const int col0 = colt + wc * 32 + 8 * fq, bcol0 = u.pn * BM + wc * 32 + 8 * fq;
        f32x4 bv[2][2];
#pragma unroll
        for (int bj = 0; bj < 2; ++bj)
#pragma unroll
            for (int n = 0; n < 2; ++n) bv[bj][n] = bias ? *(const f32x4*)(bias + bcol0 + bj * HALF + 4 * n) : (f32x4){0.f, 0.f, 0.f, 0.f};
#pragma unroll
        for (int ai = 0; ai < 2; ++ai)
#pragma unroll
            for (int m = 0; m < 4; ++m) { bf16_t* rowp = base + (size_t)(row0 + ai * HALF + m * 16) * ldc + col0;
#pragma unroll
                for (int bj = 0; bj < 2; ++bj) { f32x4 v0 = acc[ai][bj][m][0] + bv[bj][0], v1 = acc[ai][bj][m][1] + bv[bj][1];
                    if (ACT == 1) { f32x2 a = gelu_pk((f32x2){v0[0], v0[1]}), b = gelu_pk((f32x2){v0[2], v0[3]}), c = gelu_pk((f32x2){v1[0], v1[1]}), d = gelu_pk((f32x2){v1[2], v1[3]});
                        v0 = (f32x4){a.x, a.y, b.x, b.y}; v1 = (f32x4){c.x, c.y, d.x, d.y}; }
                    v0 = v0 * sc; v1 = v1 * sc; u32x4 w; w.x = cvt_pk_bf16(v0[0], v0[1]); w.y = cvt_pk_bf16(v0[2], v0[3]); w.z = cvt_pk_bf16(v1[0], v1[1]); w.w = cvt_pk_bf16(v1[2], v1[3]);
                    *(u32x4*)(rowp + bj * HALF) = w; } }
    }
};
template <class Epi, class Sched, bool ALIGN_EPI = false, bool SP2 = false>
__device__ __forceinline__ void gemm_phase(PG8_LAS unsigned char* lds, const Gemm g, const Sched& S, const Epi& E) {
    const int tid = threadIdx.x, wid = __builtin_amdgcn_readfirstlane(tid >> 6), lane = tid & 63, wr = wid >> 2, wc = wid & 3, fr = lane & 15, fq = lane >> 4;
    const int K = g.K, nt = K / BK;
    unsigned voffA[2], voffB[2];
#pragma unroll
    for (int i = 0; i < 2; ++i) { int R, C; stage_rc(tid * 16 + i * 8192, R, C); const int Rb = Epi::PERM ? ((R & ~31) + perm32(R & 31)) : R;
        voffA[i] = (unsigned)(R * K + C) * 2u; voffB[i] = (unsigned)(Rb * K + C) * 2u; }
    const size_t kstep = (size_t)(BK * 2);
    const size_t hstep = (size_t)HALF * K * 2;
    const size_t tstep = 2 * hstep;
    const unsigned ldsw = (unsigned)wid * 1024u;
    const int aoff = lds_byte(wr * 64 + fr, fq * 8), boff = lds_byte(wc * 32 + fr, fq * 8);
#define PG8_SA(b, h) (((b) * 2 + (h)) * HTB)
#define PG8_SB(b, h) ((4 + (b) * 2 + (h)) * HTB)
#define PG8_STAGE(bufoff, gbase, voff) do { _Pragma("unroll") for (int _i = 0; _i < 2; ++_i) \
        __builtin_amdgcn_global_load_lds((const unsigned*)((const char*)(gbase) + (voff)[_i]), (PG8_LAS unsigned*)(lds + (bufoff) + ldsw + _i * 8192), 16, 0, 0); } while (0)
#define PG8_LDA(dst, b, h) do { _Pragma("unroll") for (int m = 0; m < 4; ++m) _Pragma("unroll") for (int k = 0; k < 2; ++k) dst[m][k] = *(const PG8_LAS bf16x8*)(lds + PG8_SA(b, h) + aoff + m * 2048 + k * 1024); } while (0)
#define PG8_LDB(dst, b, h) do { _Pragma("unroll") for (int n = 0; n < 2; ++n) _Pragma("unroll") for (int k = 0; k < 2; ++k) dst[n][k] = *(const PG8_LAS bf16x8*)(lds + PG8_SB(b, h) + boff + n * 2048 + k * 1024); } while (0)
#define PG8_MMA(ai, bj, At, Bt) do { __builtin_amdgcn_s_setprio(1); _Pragma("unroll") for (int m = 0; m < 4; ++m) _Pragma("unroll") for (int n = 0; n < 2; ++n) _Pragma("unroll") for (int k = 0; k < 2; ++k) \
        acc[ai][bj][m][n] = __builtin_amdgcn_mfma_f32_16x16x32_bf16(Bt[n][k], At[m][k], acc[ai][bj][m][n], 0, 0, 0); __builtin_amdgcn_s_setprio(0); } while (0)
#define PG8_WAIT_V(n) asm volatile("s_waitcnt vmcnt(" #n ")" ::: "memory")
#define PG8_WAIT_L(n) asm volatile("s_waitcnt lgkmcnt(" #n ")" ::: "memory")
#define PG8_BAR __builtin_amdgcn_s_barrier()
#define PG8_SCHED __builtin_amdgcn_sched_barrier(0)
    Unit cur, nxt; int ui = 0;
    if (!S.next(0, cur)) return;
    f32x4 acc[2][2][4][2];
#pragma unroll
    for (int a = 0; a < 2; ++a)
#pragma unroll
        for (int b = 0; b < 2; ++b)
#pragma unroll
            for (int m = 0; m < 4; ++m)
#pragma unroll
                for (int n = 0; n < 2; ++n) acc[a][b][m][n] = (f32x4){0.f, 0.f, 0.f, 0.f};
    bf16x8 At[4][2], B0[2][2], B1[2][2];
    const char* cA = (const char*)g.A + (size_t)cur.pm * tstep; const char* cB = (const char*)g.Bt + (size_t)cur.pn * tstep;
    S.a_ready(cur);
    if constexpr (SP2) {
        PG8_STAGE(PG8_SB(0, 0), cB, voffB); PG8_STAGE(PG8_SB(0, 1), cB + hstep, voffB); PG8_STAGE(PG8_SA(0, 0), cA, voffA); PG8_STAGE(PG8_SA(0, 1), cA + hstep, voffA);
        if (wr == 1) PG8_BAR;
        PG8_WAIT_V(2); PG8_BAR;
        PG8_STAGE(PG8_SB(1, 0), cB + kstep, voffB); PG8_STAGE(PG8_SA(1, 0), cA + kstep, voffA); PG8_STAGE(PG8_SB(1, 1), cB + hstep + kstep, voffB);
        PG8_WAIT_V(6); PG8_BAR;
    } else {
        PG8_STAGE(PG8_SB(0, 0), cB, voffB); PG8_STAGE(PG8_SA(0, 0), cA, voffA); PG8_STAGE(PG8_SB(0, 1), cB + hstep, voffB); PG8_STAGE(PG8_SA(0, 1), cA + hstep, voffA);
        if (wr == 1) PG8_BAR;
        PG8_WAIT_V(4); PG8_BAR;
        PG8_STAGE(PG8_SB(1, 0), cB + kstep, voffB); PG8_STAGE(PG8_SA(1, 0), cA + kstep, voffA); PG8_STAGE(PG8_SB(1, 1), cB + hstep + kstep, voffB);
        PG8_WAIT_V(6); PG8_BAR;
    }
    for (;;) {
        const bool has_next = S.next(ui + 1, nxt);
        const char* nA = has_next ? (const char*)g.A + (size_t)nxt.pm * tstep : cA; const char* nB = has_next ? (const char*)g.Bt + (size_t)nxt.pn * tstep : cB;
        for (int t = 0; t < nt; t += 2) {
            const bool last = (t == nt - 2);
            const char* a1 = cA + (size_t)(t + 1) * kstep;
            const char* a2 = last ? nA : cA + (size_t)(t + 2) * kstep; const char* b2 = last ? nB : cB + (size_t)(t + 2) * kstep;
            const char* a3 = a2 + kstep; const char* b3 = b2 + kstep;
            if (last && has_next) S.a_ready(nxt);
            if constexpr (SP2) {
            PG8_LDB(B0, 0, 0); PG8_LDB(B1, 0, 1); PG8_SCHED; PG8_LDA(At, 0, 0); PG8_STAGE(PG8_SA(1, 1), a1 + hstep, voffA);
            PG8_WAIT_V(8); PG8_WAIT_L(0); PG8_BAR; PG8_MMA(0, 0, At, B0); PG8_MMA(0, 1, At, B1); PG8_BAR; PG8_SCHED;
            PG8_LDA(At, 0, 1); PG8_STAGE(PG8_SB(0, 0), b2, voffB); PG8_STAGE(PG8_SB(0, 1), b2 + hstep, voffB); PG8_STAGE(PG8_SA(0, 0), a2, voffA);
            PG8_WAIT_V(8); PG8_WAIT_L(0); PG8_BAR; PG8_MMA(1, 0, At, B0); PG8_MMA(1, 1, At, B1); PG8_BAR; PG8_SCHED;
            PG8_LDB(B0, 1, 0); PG8_LDB(B1, 1, 1); PG8_SCHED; PG8_LDA(At, 1, 0); PG8_STAGE(PG8_SA(0, 1), a2 + hstep, voffA);
            PG8_WAIT_V(8); PG8_WAIT_L(0); PG8_BAR; PG8_MMA(0, 0, At, B0); PG8_MMA(0, 1, At, B1); PG8_BAR; PG8_SCHED;
            PG8_LDA(At, 1, 1); PG8_STAGE(PG8_SB(1, 0), b3, voffB); PG8_STAGE(PG8_SB(1, 1), b3 + hstep, voffB); PG8_STAGE(PG8_SA(1, 0), a3, voffA);
            PG8_WAIT_V(8); PG8_WAIT_L(0); PG8_BAR; PG8_MMA(1, 0, At, B0); PG8_MMA(1, 1, At, B1); PG8_BAR; PG8_SCHED;
            } else {
            PG8_LDB(B0, 0, 0); PG8_SCHED; PG8_LDA(At, 0, 0); PG8_STAGE(PG8_SA(1, 1), a1 + hstep, voffA);
            PG8_WAIT_L(8); PG8_BAR; PG8_WAIT_L(0); PG8_MMA(0, 0, At, B0); PG8_BAR; PG8_SCHED;
            PG8_LDB(B1, 0, 1); PG8_STAGE(PG8_SB(0, 0), b2, voffB);
            PG8_BAR; PG8_WAIT_L(0); PG8_MMA(0, 1, At, B1); PG8_BAR;
            PG8_LDA(At, 0, 1); PG8_STAGE(PG8_SA(0, 0), a2, voffA);
            PG8_BAR; PG8_WAIT_L(0); PG8_MMA(1, 0, At, B0); PG8_BAR; PG8_SCHED;
            PG8_STAGE(PG8_SB(0, 1), b2 + hstep, voffB);
            PG8_WAIT_V(6); PG8_BAR; PG8_MMA(1, 1, At, B1); PG8_BAR;
            PG8_LDB(B0, 1, 0); PG8_SCHED; PG8_LDA(At, 1, 0); PG8_STAGE(PG8_SA(0, 1), a2 + hstep, voffA);
            PG8_WAIT_L(8); PG8_BAR; PG8_WAIT_L(0); PG8_MMA(0, 0, At, B0); PG8_BAR; PG8_SCHED;
            PG8_LDB(B1, 1, 1); PG8_STAGE(PG8_SB(1, 0), b3, voffB);
            PG8_BAR; PG8_WAIT_L(0); PG8_MMA(0, 1, At, B1); PG8_BAR;
            PG8_LDA(At, 1, 1); PG8_STAGE(PG8_SA(1, 0), a3, voffA);
            PG8_BAR; PG8_WAIT_L(0); PG8_MMA(1, 0, At, B0); PG8_BAR; PG8_SCHED;
            PG8_STAGE(PG8_SB(1, 1), b3 + hstep, voffB);
            PG8_WAIT_V(6); PG8_BAR; PG8_MMA(1, 1, At, B1); PG8_BAR;
            }
        }
        if constexpr (ALIGN_EPI) { if (wr == 0) PG8_BAR; }
        if constexpr (!Epi::AFTER_DRAIN) { E(acc, cur, wr, wc, fr, fq); S.done(cur); }
        if (!has_next) break;
#pragma unroll
        for (int a = 0; a < 2; ++a)
#pragma unroll
            for (int b = 0; b < 2; ++b)
#pragma unroll
                for (int m = 0; m < 4; ++m)
#pragma unroll
                    for (int n = 0; n < 2; ++n) acc[a][b][m][n] = (f32x4){0.f, 0.f, 0.f, 0.f};
        cur = nxt; cA = nA; cB = nB; ++ui;
        if constexpr (ALIGN_EPI) { if (wr == 1) PG8_BAR; }
    }
    PG8_WAIT_V(0);
    if constexpr (!ALIGN_EPI) { if (wr == 0) PG8_BAR; }
    PG8_BAR;
    if constexpr (Epi::AFTER_DRAIN) { E.fused(acc, cur, wr, wc, fr, fq, lds, wid, lane); S.done(cur); }
#undef PG8_SA
#undef PG8_SB
#undef PG8_STAGE
#undef PG8_LDA
#undef PG8_LDB
#undef PG8_MMA
#undef PG8_WAIT_V
#undef PG8_WAIT_L
#undef PG8_BAR
#undef PG8_SCHED
}
}
#ifndef PG8_SP2
#define PG8_SP2 true
#endif
#ifndef PG8_ALIGN
#define PG8_ALIGN true
#endif
#ifndef OUT_MODE
#define OUT_MODE 0
#endif
#ifndef REP_MASK
#define REP_MASK 0
#endif
#ifndef S_CONV
#define S_CONV 1
#endif
#ifndef M3_RW
#define M3_RW 2
#endif
#ifndef PU_RSHIFT
#define PU_RSHIFT 11
#endif
#ifndef PU_NB
#define PU_NB 6
#endif
#ifndef PVQ_RB
#define PVQ_RB 16
#endif
#ifndef PUQ_RB
#define PUQ_RB 16
#endif
#ifndef PE_SORT
#define PE_SORT 1
#endif
#ifndef PH_MASK
#define PH_MASK 0xFFFFF
#endif
#ifndef MK_N_LAUNCHES
#define MK_N_LAUNCHES 1
#endif

constexpr int NWAVES = 8, NTHR = NWAVES * 64;
constexpr int BATCH = 2, SEQ = 8192, D = 2048, T = BATCH * SEQ;
constexpr int LRU_W = 1024, CONF_W = 1024, IN_COLS = 4096, LRU_HD = 128;
constexpr int NH = 8, NKEY = 128, TOPK = 16, NEXP = NKEY * NKEY, KSEL = NH * TOPK;
constexpr int NMOD = 6 * D;
constexpr int CHUNK = 64, NCHUNK = SEQ / CHUNK;
constexpr int CONF_K = 31;
constexpr float EPS = 1e-6f;
constexpr int N_PHASES = 14;

constexpr size_t MiB = 1u << 20;
constexpr size_t WS_CTL = 0, CTL_ZERO_BYTES = 64 * 1024;
constexpr size_t WS_MODP = 1 * MiB;
constexpr size_t WS_CFIN = 2 * MiB;
constexpr size_t WS_CARRY = 3 * MiB;
constexpr size_t WS_AGG = 4 * MiB;
constexpr size_t WS_WG = 6 * MiB;
constexpr size_t WS_SUBK = 7 * MiB;
constexpr size_t WS_BT1 = 8 * MiB;
constexpr size_t WS_BT2 = 24 * MiB;
constexpr size_t WS_BT3 = 32 * MiB;
constexpr size_t WS_IDX = 40 * MiB;
constexpr size_t WS_GATE = 48 * MiB;
constexpr size_t WS_USC = 56 * MiB;
constexpr size_t WS_VSC = 57 * MiB;
constexpr size_t WS_RA = 64 * MiB;
constexpr size_t WS_Y1 = 128 * MiB;
constexpr size_t WS_PROJ = 192 * MiB;
constexpr size_t WS_Q = 192 * MiB;
constexpr size_t WS_UB = 256 * MiB;
constexpr size_t WS_XL = 320 * MiB;
constexpr size_t WS_ZC = 352 * MiB;
constexpr size_t WS_Y2 = 384 * MiB;
constexpr size_t WS_SSQ = 58 * MiB;
constexpr size_t WS_HLOC = 384 * MiB;
constexpr size_t WS_PC = 416 * MiB;
constexpr size_t WS_VB = 320 * MiB;
constexpr size_t WS_ACTP = 192 * MiB;
constexpr size_t WS_ACT = 448 * MiB;
constexpr size_t WS_H2Q = 456 * MiB;
constexpr size_t WS_HSC = 488 * MiB;
constexpr size_t WS_END = 489 * MiB;
constexpr int CW_TMO = 0, CW_BAR = 4096;

constexpr int RING_OFF = 0, RING_BYTES = 131072;
constexpr int LDSCTL_OFF = RING_BYTES, MISC_OFF = LDSCTL_OFF + 320;
constexpr int LDS_BYTES = 147456;

#define GAS __attribute__((address_space(1)))
#define LAS __attribute__((address_space(3)))
typedef unsigned short bf16;
typedef unsigned v4u __attribute__((ext_vector_type(4)));
typedef unsigned v2u __attribute__((ext_vector_type(2)));
typedef float f32x4 __attribute__((ext_vector_type(4)));
typedef float f32x16 __attribute__((ext_vector_type(16)));
typedef float f32x2 __attribute__((ext_vector_type(2)));
typedef short bf16x8 __attribute__((ext_vector_type(8)));
typedef __bf16 bfp2 __attribute__((ext_vector_type(2)));
typedef GAS unsigned gu32;
#define RLX_AGENT __ATOMIC_RELAXED, __HIP_MEMORY_SCOPE_AGENT
#define LDS_WAIT() asm volatile("s_waitcnt lgkmcnt(0)" ::: "memory")
#define VM_WAIT() asm volatile("s_waitcnt vmcnt(0)" ::: "memory")
__device__ __forceinline__ unsigned f2bf(float f) { unsigned u = __builtin_bit_cast(unsigned, f); return (u + 0x7fffu + ((u >> 16) & 1u)) >> 16; }
__device__ __forceinline__ unsigned pk2(float lo, float hi) { return f2bf(lo) | (f2bf(hi) << 16); }
__device__ __forceinline__ float bflo(unsigned u) { return __builtin_bit_cast(float, u << 16); }
__device__ __forceinline__ float bfhi(unsigned u) { return __builtin_bit_cast(float, u & 0xffff0000u); }
__device__ __forceinline__ float wave_sum(float v) {
#pragma unroll
    for (int o = 1; o < 64; o <<= 1) v += __shfl_xor(v, o);
    return v;
}
__device__ __forceinline__ float dpp_sum63(float v) {
    v += __builtin_bit_cast(float, __builtin_amdgcn_update_dpp(0, __builtin_bit_cast(int, v), 0xB1, 0xF, 0xF, false));
    v += __builtin_bit_cast(float, __builtin_amdgcn_update_dpp(0, __builtin_bit_cast(int, v), 0x4E, 0xF, 0xF, false));
    v += __builtin_bit_cast(float, __builtin_amdgcn_update_dpp(0, __builtin_bit_cast(int, v), 0x141, 0xF, 0xF, false));
    v += __builtin_bit_cast(float, __builtin_amdgcn_update_dpp(0, __builtin_bit_cast(int, v), 0x140, 0xF, 0xF, false));
    v += __builtin_bit_cast(float, __builtin_amdgcn_update_dpp(0, __builtin_bit_cast(int, v), 0x142, 0xA, 0xF, false));
    v += __builtin_bit_cast(float, __builtin_amdgcn_update_dpp(0, __builtin_bit_cast(int, v), 0x143, 0xC, 0xF, false));
    return v;
}

__device__ __forceinline__ float sigmoidf_(float x) { return __builtin_amdgcn_rcpf(1.0f + __expf(-x)); }
__device__ __forceinline__ float gelu_tanh(float x) { return x * sigmoidf_(1.5957691216057308f * (x + 0.044715f * x * x * x)); }
__device__ __forceinline__ float rdlane(float v, int l) { return __builtin_bit_cast(float, __builtin_amdgcn_readlane(__builtin_bit_cast(int, v), l)); }
__device__ __forceinline__ float wave_total(float v) { return rdlane(dpp_sum63(v), 63); }

#define XB_TMO      128
#define XB_XCNT(j)  (256  + 64 * (j))
#define XB_XSUB(j)  (1280 + 64 * (j))
#define XB_XGEN(j)  (2304 + 64 * (j))
#define XB_TOP      3328
#define XB_TOPGEN   3392
#define XCD_BAR_WORDS 3456
#define XB_SPIN_CAP (1u << 18)

__device__ __forceinline__ unsigned xb_ld(unsigned* p)              { return __hip_atomic_load(p, __ATOMIC_RELAXED, __HIP_MEMORY_SCOPE_AGENT); }
__device__ __forceinline__ unsigned xb_add(unsigned* p, unsigned v) { return __hip_atomic_fetch_add(p, v, __ATOMIC_RELAXED, __HIP_MEMORY_SCOPE_AGENT); }
__device__ __forceinline__ unsigned xb_xcc_id() { return (unsigned)__builtin_amdgcn_s_getreg((3 << 11) | 20) & 0xFu; }
#define XB_SPIN(cond, bar) do { unsigned _sp = 0; while (cond) { __builtin_amdgcn_s_sleep(1); \
    if ((++_sp & 255u) == 0u) { if (xb_ld(&(bar)[XB_TMO])) break; if (_sp > XB_SPIN_CAP) { atomicAdd(&(bar)[XB_TMO], 1u); break; } } } } while (0)

struct XcdBarrier {
    unsigned* bar; unsigned x;
    volatile LAS unsigned* st;
};

__device__ __forceinline__ XcdBarrier xcd_barrier_post(unsigned* bar, volatile LAS unsigned* st) {
    XcdBarrier b; b.bar = bar; b.x = xb_xcc_id(); b.st = st;
    if (threadIdx.x == 0) (void)xb_add(&bar[XB_XCNT(b.x)], 1u);
    return b;
}
__device__ __forceinline__ void xcd_barrier_complete(unsigned* bar, unsigned x, unsigned& nloc, unsigned& nx) {
    const unsigned G = gridDim.x * gridDim.y * gridDim.z;
    unsigned sum, cnt, mine, sp = 0u;
    for (;;) {
        sum = 0u; cnt = 0u; mine = 0u;
#pragma unroll
        for (unsigned j = 0; j < 16; ++j) { const unsigned c = xb_ld(&bar[XB_XCNT(j)]); sum += c; cnt += (c > 0u) ? 1u : 0u; mine = (j == x) ? c : mine; }
        if (sum == G) break;
        __builtin_amdgcn_s_sleep(1);
        if ((++sp & 255u) == 0u) { if (xb_ld(&bar[XB_TMO])) break; if (sp > XB_SPIN_CAP) { atomicAdd(&bar[XB_TMO], 1u); break; } }
    }
    nloc = mine > 0u ? mine : 1u; nx = cnt > 0u ? cnt : 1u;
}

__device__ __forceinline__ void xcd_barrier(const XcdBarrier& b) {
    asm volatile("s_waitcnt vmcnt(0)" ::: "memory");
    __syncthreads();
    if (threadIdx.x == 0) {
        unsigned* bar = b.bar;
        __builtin_amdgcn_s_waitcnt(0);
        unsigned nloc = b.st[0], nx = b.st[1];
        if (nloc == 0u) { xcd_barrier_complete(bar, b.x, nloc, nx); b.st[0] = nloc; b.st[1] = nx; }
        const unsigned old = xb_add(&bar[XB_XSUB(b.x)], 1u);
        const unsigned gen = old / nloc;
        if (old + 1u == (gen + 1u) * nloc) {
            __builtin_amdgcn_fence(__ATOMIC_RELEASE, "agent");
            asm volatile("s_waitcnt vmcnt(0)" ::: "memory");
            const unsigned og = xb_add(&bar[XB_TOP], 1u);
            const unsigned tg = og / nx;
            if (og + 1u == (tg + 1u) * nx) xb_add(&bar[XB_TOPGEN], 1u);
            else XB_SPIN(xb_ld(&bar[XB_TOPGEN]) == tg, bar);
            __builtin_amdgcn_fence(__ATOMIC_ACQUIRE, "agent");
            xb_add(&bar[XB_XGEN(b.x)], 1u);
            asm volatile("s_waitcnt vmcnt(0)" ::: "memory");
        } else {
            XB_SPIN(xb_ld(&bar[XB_XGEN(b.x)]) == gen, bar);
            __builtin_amdgcn_fence(__ATOMIC_ACQUIRE, "agent");
            asm volatile("s_waitcnt vmcnt(0)" ::: "memory");
        }
    }
    __syncthreads();
}
struct Args { const float* in[25]; float* out; unsigned char* ws; int ph_lo, ph_hi, li, pad; };
enum { I_X = 0, I_C, I_WMOD, I_BMOD, I_GPREMIX, I_GPOSTMIX, I_GPREFFN, I_GPOSTFFN, I_WIN, I_LCW, I_LCB, I_WA, I_BA, I_WX, I_BX, I_LAMBDA,
       I_CDW, I_CDB, I_LNG, I_LNB, I_WOUT, I_WQ, I_SUBK, I_PU, I_PV };

__device__ __forceinline__ float mod_at(const float* modp, int b, int n) {
    return (modp[(0 * 2 + b) * NMOD + n] + modp[(1 * 2 + b) * NMOD + n]) + (modp[(2 * 2 + b) * NMOD + n] + modp[(3 * 2 + b) * NMOD + n]);
}

__device__ __forceinline__ void p0_transpose_item(const float* W, int K, int N, bf16* WT, LAS float* scr, int item, int lane) {
    const int nblk = N / 32, kb = item / nblk, nb = item % nblk, k0 = 64 * kb, n0 = 32 * nb;
#pragma unroll 8
    for (int i = 0; i < 32; ++i) { const int kk = 2 * i + (lane >> 5); scr[kk * 33 + (lane & 31)] = W[(size_t)(k0 + kk) * N + n0 + (lane & 31)]; }
    LDS_WAIT(); asm volatile("" ::: "memory");
    const int c = lane & 7;
#pragma unroll
    for (int j = 0; j < 4; ++j) { const int n = (lane >> 3) + 8 * j; const LAS float* s = scr + (8 * c) * 33 + n;
        v4u o; o.x = pk2(s[0 * 33], s[1 * 33]); o.y = pk2(s[2 * 33], s[3 * 33]); o.z = pk2(s[4 * 33], s[5 * 33]); o.w = pk2(s[6 * 33], s[7 * 33]);
        *(GAS v4u*)(WT + (size_t)(n0 + n) * K + k0 + 8 * c) = o; }
    LDS_WAIT(); asm volatile("" ::: "memory");
}
__device__ __forceinline__ void cvt_rows_bf16(const float* src, bf16* dst, size_t n8, size_t gt, size_t ngt) {
    for (size_t i = gt; i < n8; i += ngt) {
        const f32x4 a = ((const GAS f32x4*)src)[2 * i], b = ((const GAS f32x4*)src)[2 * i + 1];
        v4u o; o.x = pk2(a.x, a.y); o.y = pk2(a.z, a.w); o.z = pk2(b.x, b.y); o.w = pk2(b.z, b.w);
        ((GAS v4u*)dst)[i] = o; }
}
__device__ __forceinline__ void phase_p0(const Args& A, LAS unsigned char* lds, int tid, int lane, int wave, int bid, int G) {
    float* modp = (float*)(A.ws + WS_MODP);
    for (int item = bid; item < 192; item += G) {
        const int cg = item % 48, kq = item / 48, k0 = kq * 512 + wave * 64, n0 = cg * 256 + lane * 4;
        const float c0 = A.in[I_C][k0 + lane], c1 = A.in[I_C][D + k0 + lane];
        const float ca0 = c0 * sigmoidf_(c0), ca1 = c1 * sigmoidf_(c1);
        f32x4 a0 = {0.f, 0.f, 0.f, 0.f}, a1 = {0.f, 0.f, 0.f, 0.f};
        const float* wp = A.in[I_WMOD] + (size_t)k0 * NMOD + n0;
#pragma unroll 8
        for (int kk = 0; kk < 64; ++kk) {
            const f32x4 w = *(const GAS f32x4*)(wp + (size_t)kk * NMOD);
            const float s0 = __shfl(ca0, kk), s1 = __shfl(ca1, kk);
            a0 += w * s0; a1 += w * s1;
        }
        LAS f32x4* red = (LAS f32x4*)lds;
        red[(wave * 2 + 0) * 64 + lane] = a0; red[(wave * 2 + 1) * 64 + lane] = a1;
        __syncthreads();
        { const int b = tid >> 8, col = tid & 255; const LAS float* rf = (const LAS float*)lds; float s = 0.f;
#pragma unroll
          for (int w = 0; w < 8; ++w) s += rf[((w * 2 + b) * 64) * 4 + col];
          if (kq == 0) s += A.in[I_BMOD][cg * 256 + col];
          modp[(kq * 2 + b) * NMOD + cg * 256 + col] = s; }
        __syncthreads();
    }
    {
        LAS float* scr = (LAS float*)(lds + wave * 16384);
        const int gw = bid * NWAVES + wave, NGW = G * NWAVES;
        constexpr int I1 = (D / 64) * (IN_COLS / 32), I2 = (D / 64) * (D / 32);
        for (int it = gw; it < I1 + 2 * I2; it += NGW) {
            int r = it;
            if (r < I1) { p0_transpose_item(A.in[I_WIN], D, IN_COLS, (bf16*)(A.ws + WS_BT1), scr, r, lane); continue; } r -= I1;
            if (r < I2) { p0_transpose_item(A.in[I_WOUT], D, D, (bf16*)(A.ws + WS_BT2), scr, r, lane); continue; } r -= I2;
            p0_transpose_item(A.in[I_WQ], D, D, (bf16*)(A.ws + WS_BT3), scr, r, lane);
        }
    }
    {
        const int gt = bid * NTHR + tid, ngt = G * NTHR;
        bf16* wg = (bf16*)(A.ws + WS_WG);
        for (int e = gt; e < NH * 256 * 128; e += ngt) {
            const int h = e >> 15, n = (e >> 7) & 255, k = e & 127;
            const float v = (n < 128 ? A.in[I_WA] : A.in[I_WX])[h * 16384 + k * 128 + (n & 127)];
            wg[e] = (bf16)f2bf(v);
        }
        cvt_rows_bf16(A.in[I_SUBK], (bf16*)(A.ws + WS_SUBK), (size_t)NH * 2 * NKEY * 128 / 8, gt, ngt);
    }
}

__device__ __forceinline__ void phase_p1(const Args& A, int tid, int lane, int wave, int bid, int G) {
    const float* modp = (const float*)(A.ws + WS_MODP);
    {
        float* cfin = (float*)(A.ws + WS_CFIN);
        for (int e = bid * NTHR + tid; e < 2 * 2 * D; e += G * NTHR) {
            const int b = e >> 12, arr = (e >> 11) & 1, col = e & (D - 1);
            cfin[e] = arr == 0 ? mod_at(modp, b, 2 * D + col) * A.in[I_GPOSTMIX][col] : mod_at(modp, b, 5 * D + col) * A.in[I_GPOSTFFN][col];
        }
        float* cfe = (float*)(A.ws + WS_CFIN) + 4 * D;
        for (int e = bid * NTHR + tid; e < 2 * 2 * D; e += G * NTHR) {
            const int b = e >> 12, arr = (e >> 11) & 1, col = e & (D - 1);
            cfe[e] = arr == 0 ? A.in[I_GPREFFN][col] * (1.0f + mod_at(modp, b, 4 * D + col)) : mod_at(modp, b, 3 * D + col);
        }
    }
    const int gw = bid * NWAVES + wave, NGW = G * NWAVES;
    bf16* h1 = (bf16*)(A.ws + WS_RA);
    int cb = -1; float gs[4][8], sh[4][8];
    for (int row = gw; row < T; row += NGW) {
        const int b = row >> 13;
        if (b != cb) { cb = b;
#pragma unroll
            for (int j = 0; j < 4; ++j)
#pragma unroll
                for (int e = 0; e < 8; ++e) { const int col = j * 512 + lane * 8 + e;
                    gs[j][e] = A.in[I_GPREMIX][col] * (1.0f + mod_at(modp, b, D + col)); sh[j][e] = mod_at(modp, b, col); } }
        const GAS f32x4* xr = (const GAS f32x4*)(A.in[I_X] + (size_t)row * D) + lane * 2;
        f32x4 v[4][2]; float s = 0.f;
#pragma unroll
        for (int j = 0; j < 4; ++j) { v[j][0] = xr[j * 128]; v[j][1] = xr[j * 128 + 1];
            s += (v[j][0].x * v[j][0].x + v[j][0].y * v[j][0].y) + (v[j][0].z * v[j][0].z + v[j][0].w * v[j][0].w);
            s += (v[j][1].x * v[j][1].x + v[j][1].y * v[j][1].y) + (v[j][1].z * v[j][1].z + v[j][1].w * v[j][1].w); }
        const float rstd = __builtin_amdgcn_rsqf(wave_total(s) * (1.0f / D) + EPS);
        GAS v4u* orow = (GAS v4u*)(h1 + (size_t)row * D) + lane;
#pragma unroll
        for (int j = 0; j < 4; ++j) { float o[8];
#pragma unroll
            for (int e = 0; e < 8; ++e) o[e] = v[j][e >> 2][e & 3] * rstd * gs[j][e] + sh[j][e];
            v4u w; w.x = pk2(o[0], o[1]); w.y = pk2(o[2], o[3]); w.z = pk2(o[4], o[5]); w.w = pk2(o[6], o[7]);
            orow[j * 64] = w; }
    }
}

__device__ __forceinline__ void m1a_tile_issue(const bf16* proj, int item, int tid, v4u (&rv)[5], v4u (&rg)[5]) {
    const int b = item >> 9, tt = (item >> 3) & 63, ct = item & 7, t0 = tt * 128;
#pragma unroll
    for (int i = 0; i < 5; ++i) {
        const int e = tid + i * NTHR, r = e >> 4, c8 = (e & 15) * 8, t = t0 - 30 + r;
        rv[i] = (v4u){0u, 0u, 0u, 0u}; rg[i] = (v4u){0u, 0u, 0u, 0u};
        if (e < 158 * 16 && t >= 0) { const bf16* p = proj + (size_t)(b * SEQ + t) * IN_COLS + 2048 + ct * 128 + c8; rv[i] = *(const GAS v4u*)p; rg[i] = *(const GAS v4u*)(p + 1024); }
    }
}
__device__ __forceinline__ void phase_m1a(const Args& A, LAS unsigned char* lds, int tid, int lane, int wave, int bid, int G) {
    const bf16* proj = (const bf16*)(A.ws + WS_PROJ);
    {
        bf16* xl = (bf16*)(A.ws + WS_XL);
        const float* w4 = A.in[I_LCW]; const float* b4 = A.in[I_LCB];
        for (int it = bid * NTHR + tid; it < (T / 16) * 128; it += G * NTHR) {
            const int c0 = (it & 127) * 8, run = it >> 7, row0 = run * 16, t0 = row0 & (SEQ - 1);
            v4u in[19];
#pragma unroll
            for (int r = 0; r < 19; ++r) { in[r] = (v4u){0u, 0u, 0u, 0u}; if (t0 - 3 + r >= 0) in[r] = *(const GAS v4u*)(proj + (size_t)(row0 - 3 + r) * IN_COLS + c0); }
            float w[4][8], bb[8];
#pragma unroll
            for (int j = 0; j < 4; ++j) { const f32x4 wa = *(const GAS f32x4*)(w4 + j * LRU_W + c0), wb = *(const GAS f32x4*)(w4 + j * LRU_W + c0 + 4);
                w[j][0] = wa.x; w[j][1] = wa.y; w[j][2] = wa.z; w[j][3] = wa.w; w[j][4] = wb.x; w[j][5] = wb.y; w[j][6] = wb.z; w[j][7] = wb.w; }
            { const f32x4 ba = *(const GAS f32x4*)(b4 + c0), bc = *(const GAS f32x4*)(b4 + c0 + 4); bb[0] = ba.x; bb[1] = ba.y; bb[2] = ba.z; bb[3] = ba.w; bb[4] = bc.x; bb[5] = bc.y; bb[6] = bc.z; bb[7] = bc.w; }
#pragma unroll
            for (int i = 0; i < 16; ++i) { float acc[8];
#pragma unroll
                for (int e = 0; e < 8; ++e) acc[e] = bb[e];
#pragma unroll
                for (int j = 0; j < 4; ++j) { const v4u v = in[i + j];
                    acc[0] += w[j][0] * bflo(v.x); acc[1] += w[j][1] * bfhi(v.x); acc[2] += w[j][2] * bflo(v.y); acc[3] += w[j][3] * bfhi(v.y);
                    acc[4] += w[j][4] * bflo(v.z); acc[5] += w[j][5] * bfhi(v.z); acc[6] += w[j][6] * bflo(v.w); acc[7] += w[j][7] * bfhi(v.w); }
                v4u o; o.x = pk2(acc[0], acc[1]); o.y = pk2(acc[2], acc[3]); o.z = pk2(acc[4], acc[5]); o.w = pk2(acc[6], acc[7]);
                *(GAS v4u*)(xl + (size_t)(row0 + i) * LRU_W + c0) = o; }
        }
    }
    {
        bf16* zc = (bf16*)(A.ws + WS_ZC);
        const float* w31 = A.in[I_CDW]; const float* b31 = A.in[I_CDB];
        LAS float* zt = (LAS float*)lds;
        const int cp = tid & 63, tg = tid >> 6;
        v4u rv[5], rg[5];
        int item = bid;
        if (item < 2 * 64 * 8) m1a_tile_issue(proj, item, tid, rv, rg);
        float w0[CONF_K], w1[CONF_K], bias0 = 0.f, bias1 = 0.f; int wct = -1;
        for (; item < 2 * 64 * 8; item += G) {
            const int b = item >> 9, tt = (item >> 3) & 63, ct = item & 7, t0 = tt * 128, ch = ct * 128 + 2 * cp;
            if (ct != wct) { wct = ct;
#pragma unroll
                for (int j = 0; j < CONF_K; ++j) { const f32x2 ww = *(const GAS f32x2*)(w31 + j * CONF_W + ch); w0[j] = ww.x; w1[j] = ww.y; }
                const f32x2 bw = *(const GAS f32x2*)(b31 + ch); bias0 = bw.x; bias1 = bw.y; }
            __syncthreads();
#pragma unroll
            for (int i = 0; i < 5; ++i) {
                const int e = tid + i * NTHR, r = e >> 4, c8 = (e & 15) * 8;
                if (e < 158 * 16) { const v4u v = rv[i], g = rg[i]; f32x4 z0, z1;
                    z0.x = bflo(v.x) * sigmoidf_(bflo(g.x)); z0.y = bfhi(v.x) * sigmoidf_(bfhi(g.x)); z0.z = bflo(v.y) * sigmoidf_(bflo(g.y)); z0.w = bfhi(v.y) * sigmoidf_(bfhi(g.y));
                    z1.x = bflo(v.z) * sigmoidf_(bflo(g.z)); z1.y = bfhi(v.z) * sigmoidf_(bfhi(g.z)); z1.z = bflo(v.w) * sigmoidf_(bflo(g.w)); z1.w = bfhi(v.w) * sigmoidf_(bfhi(g.w));
                    *(LAS f32x4*)(zt + r * 128 + c8) = z0; *(LAS f32x4*)(zt + r * 128 + c8 + 4) = z1; }
            }
            __syncthreads();
            if (item + G < 2 * 64 * 8) m1a_tile_issue(proj, item + G, tid, rv, rg);
            float a0[16], a1[16];
#pragma unroll
            for (int i = 0; i < 16; ++i) { a0[i] = bias0; a1[i] = bias1; }
#pragma unroll
            for (int s_ = 0; s_ < 46; ++s_) {
                const f32x2 v = *(const LAS f32x2*)(zt + (tg * 16 + s_) * 128 + 2 * cp);
#pragma unroll
                for (int i = 0; i < 16; ++i) if (s_ - i >= 0 && s_ - i < CONF_K) { a0[i] += w0[s_ - i] * v.x; a1[i] += w1[s_ - i] * v.y; }
            }
            bf16* zo = zc + (size_t)(b * SEQ + t0 + tg * 16) * CONF_W + ch;
#pragma unroll
            for (int i = 0; i < 16; ++i) *(GAS unsigned*)(zo + (size_t)i * CONF_W) = pk2(a0[i], a1[i]);
        }
        __syncthreads();
    }
}

template <int CTRL> __device__ __forceinline__ float dpp_shr(float v, float ident) {
    return __builtin_bit_cast(float, __builtin_amdgcn_update_dpp(__builtin_bit_cast(int, ident), __builtin_bit_cast(int, v), CTRL, 0xF, 0xF, false));
}
__device__ __forceinline__ void phase_m1b(const Args& A, int tid, int lane, int wave, int bid, int G) {
    const bf16* xl = (const bf16*)(A.ws + WS_XL); const bf16* wg = (const bf16*)(A.ws + WS_WG);
    bf16* hloc = (bf16*)(A.ws + WS_HLOC); bf16* pc = (bf16*)(A.ws + WS_PC); float* agg = (float*)(A.ws + WS_AGG);
    const int fr = lane & 15, fq = lane >> 4;
    for (int item = bid * NWAVES + wave; item < 2 * NCHUNK * 8; item += G * NWAVES) {
        const int hh = item & 7, chunk = (item >> 3) & (NCHUNK - 1), b = item >> 10;
        const size_t r0 = (size_t)b * SEQ + (size_t)chunk * CHUNK;
        bf16x8 xf[4][4];
#pragma unroll
        for (int mt = 0; mt < 4; ++mt)
#pragma unroll
            for (int ks = 0; ks < 4; ++ks) xf[mt][ks] = *(const GAS bf16x8*)(xl + (r0 + 16 * mt + fr) * LRU_W + hh * LRU_HD + 32 * ks + 8 * fq);
        float cP[4], cH[4];
        for (int j = 0; j < 8; ++j) {
            const int chb = hh * LRU_HD + 16 * j + 4 * fq;
            bf16x8 wa[4], wx[4];
#pragma unroll
            for (int ks = 0; ks < 4; ++ks) { wa[ks] = *(const GAS bf16x8*)(wg + (size_t)(hh * 256 + 16 * j + fr) * 128 + 32 * ks + 8 * fq);
                                             wx[ks] = *(const GAS bf16x8*)(wg + (size_t)(hh * 256 + 128 + 16 * j + fr) * 128 + 32 * ks + 8 * fq); }
            const f32x4 bav = *(const GAS f32x4*)(A.in[I_BA] + chb), bxv = *(const GAS f32x4*)(A.in[I_BX] + chb), lam = *(const GAS f32x4*)(A.in[I_LAMBDA] + chb);
            float cl[4];
#pragma unroll
            for (int r = 0; r < 4; ++r) { cl[r] = -8.0f * log1pf(__expf(-lam[r])); cP[r] = 1.f; cH[r] = 0.f; }
#pragma unroll
            for (int mt = 0; mt < 4; ++mt) {
                f32x4 ar = {0.f, 0.f, 0.f, 0.f}, ai = {0.f, 0.f, 0.f, 0.f};
#pragma unroll
                for (int ks = 0; ks < 4; ++ks) { ar = __builtin_amdgcn_mfma_f32_16x16x32_bf16(wa[ks], xf[mt][ks], ar, 0, 0, 0);
                                                 ai = __builtin_amdgcn_mfma_f32_16x16x32_bf16(wx[ks], xf[mt][ks], ai, 0, 0, 0); }
                const v2u xv = *(const GAS v2u*)(xl + (r0 + 16 * mt + fr) * LRU_W + chb);
                const float xlv[4] = {bflo(xv.x), bfhi(xv.x), bflo(xv.y), bfhi(xv.y)};
                float P[4], H[4];
#pragma unroll
                for (int r = 0; r < 4; ++r) {
                    const float rg = sigmoidf_(ar[r] + bav[r]), ig = sigmoidf_(ai[r] + bxv[r]);
                    const float la = cl[r] * rg, a = __expf(la), mult = sqrtf(fmaxf(1.0f - a * a, 0.f));
                    float p = a, h = mult * ig * xlv[r];
                    { float pp, hp;
                      pp = dpp_shr<0x111>(p, 1.0f); hp = dpp_shr<0x111>(h, 0.0f); h = p * hp + h; p = p * pp;
                      pp = dpp_shr<0x112>(p, 1.0f); hp = dpp_shr<0x112>(h, 0.0f); h = p * hp + h; p = p * pp;
                      pp = dpp_shr<0x114>(p, 1.0f); hp = dpp_shr<0x114>(h, 0.0f); h = p * hp + h; p = p * pp;
                      pp = dpp_shr<0x118>(p, 1.0f); hp = dpp_shr<0x118>(h, 0.0f); h = p * hp + h; p = p * pp; }
                    h = h + p * cH[r]; p = p * cP[r];
                    P[r] = p; H[r] = h;
                    cP[r] = __shfl(p, 15, 16); cH[r] = __shfl(h, 15, 16);
                }
                v2u ho, po; ho.x = pk2(H[0], H[1]); ho.y = pk2(H[2], H[3]); po.x = pk2(P[0], P[1]); po.y = pk2(P[2], P[3]);
                *(GAS v2u*)(hloc + (r0 + 16 * mt + fr) * LRU_W + chb) = ho;
                *(GAS v2u*)(pc + (r0 + 16 * mt + fr) * LRU_W + chb) = po;
            }
            if (fr == 0) {
                float* ag = agg + ((size_t)(b * NCHUNK + chunk) * LRU_W + chb) * 2;
                *(GAS f32x4*)ag = (f32x4){cP[0], cH[0], cP[1], cH[1]}; *(GAS f32x4*)(ag + 4) = (f32x4){cP[2], cH[2], cP[3], cH[3]};
            }
        }
    }
}

__device__ __forceinline__ void phase_m3(const Args& A, LAS unsigned char* lds, int tid, int lane, int wave, int bid, int G) {
    const bf16* proj = (const bf16*)(A.ws + WS_PROJ); const bf16* hloc = (const bf16*)(A.ws + WS_HLOC); const bf16* pc = (const bf16*)(A.ws + WS_PC);
    const bf16* zc = (const bf16*)(A.ws + WS_ZC); const float* agg = (const float*)(A.ws + WS_AGG);
    bf16* a2 = (bf16*)(A.ws + WS_RA);
    LAS float* cs = (LAS float*)lds;
    float lg[2][8], lb[2][8];
#pragma unroll
    for (int jj = 0; jj < 2; ++jj)
#pragma unroll
        for (int e = 0; e < 8; ++e) { lg[jj][e] = A.in[I_LNG][jj * 512 + lane * 8 + e]; lb[jj][e] = A.in[I_LNB][jj * 512 + lane * 8 + e]; }
    for (int item = bid; item < 2 * NCHUNK; item += G) {
        const int b = item >> 7, chunk = item & (NCHUNK - 1);
        {   float h0 = 0.f, h1 = 0.f; const float* ap = agg + ((size_t)(b * NCHUNK) * LRU_W + 2 * tid) * 2;
#pragma unroll 8
            for (int c = 0; c < chunk; ++c) { const f32x4 ab = *(const GAS f32x4*)(ap + (size_t)c * LRU_W * 2); h0 = ab.x * h0 + ab.y; h1 = ab.z * h1 + ab.w; }
            __syncthreads();
            cs[2 * tid] = h0; cs[2 * tid + 1] = h1;
            __syncthreads(); }
        for (int rr = 0; rr < 8; rr += M3_RW) {
            const int row0 = b * SEQ + chunk * CHUNK + wave * 8 + rr;
            v4u hv[M3_RW][2], pv[M3_RW][2], gv[M3_RW][2], zq[M3_RW][2];
#pragma unroll
            for (int u = 0; u < M3_RW; ++u)
#pragma unroll
                for (int jj = 0; jj < 2; ++jj) { const int c0 = jj * 512 + lane * 8; const size_t row = (size_t)(row0 + u);
                    hv[u][jj] = *(const GAS v4u*)(hloc + row * LRU_W + c0); pv[u][jj] = *(const GAS v4u*)(pc + row * LRU_W + c0);
                    gv[u][jj] = *(const GAS v4u*)(proj + row * IN_COLS + 1024 + c0); zq[u][jj] = *(const GAS v4u*)(zc + row * CONF_W + c0); }
#pragma unroll
            for (int u = 0; u < M3_RW; ++u) {
                const size_t row = (size_t)(row0 + u);
                float zv[2][8]; float s = 0.f;
#pragma unroll
                for (int jj = 0; jj < 2; ++jj) {
                    const int c0 = jj * 512 + lane * 8;
                    const f32x4 ca = *(const LAS f32x4*)(cs + c0), cb = *(const LAS f32x4*)(cs + c0 + 4);
                    const v4u h_ = hv[u][jj], p_ = pv[u][jj], g_ = gv[u][jj], z = zq[u][jj];
                    float y[8];
                    y[0] = (bflo(h_.x) + bflo(p_.x) * ca.x) * gelu_tanh(bflo(g_.x)); y[1] = (bfhi(h_.x) + bfhi(p_.x) * ca.y) * gelu_tanh(bfhi(g_.x));
                    y[2] = (bflo(h_.y) + bflo(p_.y) * ca.z) * gelu_tanh(bflo(g_.y)); y[3] = (bfhi(h_.y) + bfhi(p_.y) * ca.w) * gelu_tanh(bfhi(g_.y));
                    y[4] = (bflo(h_.z) + bflo(p_.z) * cb.x) * gelu_tanh(bflo(g_.z)); y[5] = (bfhi(h_.z) + bfhi(p_.z) * cb.y) * gelu_tanh(bfhi(g_.z));
                    y[6] = (bflo(h_.w) + bflo(p_.w) * cb.z) * gelu_tanh(bflo(g_.w)); y[7] = (bfhi(h_.w) + bfhi(p_.w) * cb.w) * gelu_tanh(bfhi(g_.w));
                    v4u o; o.x = pk2(y[0], y[1]); o.y = pk2(y[2], y[3]); o.z = pk2(y[4], y[5]); o.w = pk2(y[6], y[7]);
                    *(GAS v4u*)(a2 + row * D + c0) = o;
                    zv[jj][0] = bflo(z.x); zv[jj][1] = bfhi(z.x); zv[jj][2] = bflo(z.y); zv[jj][3] = bfhi(z.y); zv[jj][4] = bflo(z.z); zv[jj][5] = bfhi(z.z); zv[jj][6] = bflo(z.w); zv[jj][7] = bfhi(z.w);
#pragma unroll
                    for (int e = 0; e < 8; ++e) s += zv[jj][e];
                }
                const float mean = wave_total(s) * (1.0f / CONF_W); float q = 0.f;
#pragma unroll
                for (int jj = 0; jj < 2; ++jj)
#pragma unroll
                    for (int e = 0; e < 8; ++e) { zv[jj][e] -= mean; q += zv[jj][e] * zv[jj][e]; }
                const float rstd = __builtin_amdgcn_rsqf(wave_total(q) * (1.0f / CONF_W) + EPS);
#pragma unroll
                for (int jj = 0; jj < 2; ++jj) { float o[8];
#pragma unroll
                    for (int e = 0; e < 8; ++e) { const float n = zv[jj][e] * rstd * lg[jj][e] + lb[jj][e]; o[e] = n * sigmoidf_(n); }
                    v4u w; w.x = pk2(o[0], o[1]); w.y = pk2(o[2], o[3]); w.z = pk2(o[4], o[5]); w.w = pk2(o[6], o[7]);
                    *(GAS v4u*)(a2 + row * D + 1024 + jj * 512 + lane * 8) = w; }
            }
        }
    }
}

__device__ __forceinline__ f32x2 fp8lo(unsigned w) { return __builtin_amdgcn_cvt_pk_f32_fp8((int)w, false); }
__device__ __forceinline__ f32x2 fp8hi(unsigned w) { return __builtin_amdgcn_cvt_pk_f32_fp8((int)w, true); }
constexpr int CVT_ROWS = 4;
template <bool I8> __device__ __forceinline__ void cvt_table_q8(const float* src, unsigned char* dst, float* inv_scale, int gw, int NGW, int lane) {
    for (int r0 = gw; r0 < NEXP; r0 += NGW * CVT_ROWS) {
        f32x4 v[CVT_ROWS][8];
#pragma unroll
        for (int q = 0; q < CVT_ROWS; ++q) { const int r = r0 + q * NGW; const GAS f32x4* p = (const GAS f32x4*)(src + (size_t)(r < NEXP ? r : r0) * D) + lane;
#pragma unroll
            for (int i = 0; i < 8; ++i) v[q][i] = p[i * 64]; }
#pragma unroll
        for (int q = 0; q < CVT_ROWS; ++q) { const int r = r0 + q * NGW; float m = 0.f;
#pragma unroll
            for (int i = 0; i < 8; ++i) m = fmaxf(m, fmaxf(fmaxf(fabsf(v[q][i].x), fabsf(v[q][i].y)), fmaxf(fabsf(v[q][i].z), fabsf(v[q][i].w))));
#pragma unroll
            for (int o = 1; o < 64; o <<= 1) m = fmaxf(m, __shfl_xor(m, o));
            const float QM = I8 ? 127.0f : 448.0f;
            const float sc = m > 0.f ? QM / m : 1.0f;
            if (r < NEXP) {
                GAS unsigned* o4 = (GAS unsigned*)(dst + (size_t)r * D) + lane;
#pragma unroll
                for (int i = 0; i < 8; ++i) { const f32x4 t = v[q][i] * sc;
                    const float a = fminf(fmaxf(t.x, -QM), QM), b = fminf(fmaxf(t.y, -QM), QM), c = fminf(fmaxf(t.z, -QM), QM), d = fminf(fmaxf(t.w, -QM), QM);
                    if (I8) { o4[i * 64] = (unsigned)(((int)rintf(a) & 255) | (((int)rintf(b) & 255) << 8) | (((int)rintf(c) & 255) << 16) | ((int)rintf(d) << 24)); }
                    else { int pk = __builtin_amdgcn_cvt_pk_fp8_f32(a, b, 0, false); pk = __builtin_amdgcn_cvt_pk_fp8_f32(c, d, pk, true); o4[i * 64] = (unsigned)pk; } }
                if (lane == 0) inv_scale[r] = m > 0.f ? m * (1.0f / QM) : 1.0f;
            }
        }
    }
}
__device__ __forceinline__ void phase_e2(const Args& A, int tid, int lane, int wave, int bid, int G) {
    const float* modp = (const float*)(A.ws + WS_MODP); const float* cfin = (const float*)(A.ws + WS_CFIN);
    const bf16* y1 = (const bf16*)(A.ws + WS_Y1); bf16* h2 = (bf16*)(A.ws + WS_RA);
    const int gw = bid * NWAVES + wave, NGW = G * NWAVES;
    const float* cfe = (const float*)(A.ws + WS_CFIN) + 4 * D;
    for (int row = gw; row < T; row += NGW) {
        const int b = row >> 13;
        const GAS f32x4* xr = (const GAS f32x4*)(A.in[I_X] + (size_t)row * D) + lane * 2;
        const GAS v4u* yr = (const GAS v4u*)(y1 + (size_t)row * D) + lane;
        const GAS f32x4* cf = (const GAS f32x4*)(cfin + (size_t)(b * 2 + 0) * D) + lane * 2;
        float xv[4][8], yv[4][8]; float s1 = 0.f;
#pragma unroll
        for (int j = 0; j < 4; ++j) { const f32x4 a = xr[j * 128], c = xr[j * 128 + 1]; const v4u y = yr[j * 64];
            xv[j][0] = a.x; xv[j][1] = a.y; xv[j][2] = a.z; xv[j][3] = a.w; xv[j][4] = c.x; xv[j][5] = c.y; xv[j][6] = c.z; xv[j][7] = c.w;
            yv[j][0] = bflo(y.x); yv[j][1] = bfhi(y.x); yv[j][2] = bflo(y.y); yv[j][3] = bfhi(y.y); yv[j][4] = bflo(y.z); yv[j][5] = bfhi(y.z); yv[j][6] = bflo(y.w); yv[j][7] = bfhi(y.w);
#pragma unroll
            for (int e = 0; e < 8; ++e) s1 += yv[j][e] * yv[j][e]; }
        const float rstd1 = __builtin_amdgcn_rsqf(wave_total(s1) * (1.0f / D) + EPS); float s2 = 0.f;
#pragma unroll
        for (int j = 0; j < 4; ++j) { const f32x4 ca = cf[j * 128], cc = cf[j * 128 + 1]; const float cg[8] = {ca.x, ca.y, ca.z, ca.w, cc.x, cc.y, cc.z, cc.w};
#pragma unroll
            for (int e = 0; e < 8; ++e) { xv[j][e] += cg[e] * yv[j][e] * rstd1; s2 += xv[j][e] * xv[j][e]; } }
        const float rstd2 = __builtin_amdgcn_rsqf(wave_total(s2) * (1.0f / D) + EPS);
        GAS v4u* orow = (GAS v4u*)(h2 + (size_t)row * D) + lane; float am = 0.f;
#pragma unroll
        for (int j = 0; j < 4; ++j) {
            const GAS f32x4* ge = (const GAS f32x4*)(cfe + (size_t)(b * 2 + 0) * D) + lane * 2 + j * 128; const GAS f32x4* se = (const GAS f32x4*)(cfe + (size_t)(b * 2 + 1) * D) + lane * 2 + j * 128;
            const f32x4 g0_ = ge[0], g1_ = ge[1], s0_ = se[0], s1_ = se[1]; const float gsv[8] = {g0_.x, g0_.y, g0_.z, g0_.w, g1_.x, g1_.y, g1_.z, g1_.w}, shv[8] = {s0_.x, s0_.y, s0_.z, s0_.w, s1_.x, s1_.y, s1_.z, s1_.w};
#pragma unroll
            for (int e = 0; e < 8; ++e) { xv[j][e] = xv[j][e] * rstd2 * gsv[e] + shv[e]; am = fmaxf(am, fabsf(xv[j][e])); }
            v4u w; w.x = pk2(xv[j][0], xv[j][1]); w.y = pk2(xv[j][2], xv[j][3]); w.z = pk2(xv[j][4], xv[j][5]); w.w = pk2(xv[j][6], xv[j][7]);
            orow[j * 64] = w; }
#pragma unroll
        for (int o = 1; o < 64; o <<= 1) am = fmaxf(am, __shfl_xor(am, o));
        const float qs = am > 0.f ? 127.0f / am : 1.0f;
        GAS v2u* qrow = (GAS v2u*)(A.ws + WS_H2Q + (size_t)row * D) + lane;
#pragma unroll
        for (int j = 0; j < 4; ++j) { int q[8];
#pragma unroll
            for (int e = 0; e < 8; ++e) q[e] = (int)rintf(xv[j][e] * qs) & 255;
            v2u w; w.x = (unsigned)(q[0] | (q[1] << 8) | (q[2] << 16) | (q[3] << 24)); w.y = (unsigned)(q[4] | (q[5] << 8) | (q[6] << 16) | (q[7] << 24));
            qrow[j * 64] = w; }
        if (lane == 0) ((float*)(A.ws + WS_HSC))[row] = am > 0.f ? am * (1.0f / 127.0f) : 1.0f;
    }
    if (!S_CONV) { cvt_table_q8<true>(A.in[I_PU], A.ws + WS_UB, (float*)(A.ws + WS_USC), gw, NGW, lane); cvt_table_q8<false>(A.in[I_PV], A.ws + WS_VB, (float*)(A.ws + WS_VSC), gw, NGW, lane); }
}

template <int N> __device__ __forceinline__ void bitonic_sort_desc(float (&v)[N]) {
#pragma unroll
    for (int k = 2; k <= N; k <<= 1)
#pragma unroll
        for (int j = k >> 1; j > 0; j >>= 1)
#pragma unroll
            for (int i = 0; i < N; ++i) { const int l = i ^ j;
                if (l > i) { const bool desc = ((i & k) == 0); const float a = v[i], b = v[l]; const float mx = fmaxf(a, b), mn = fminf(a, b); v[i] = desc ? mx : mn; v[l] = desc ? mn : mx; } }
}
__device__ __forceinline__ void merge_top16(float (&a)[16], const float (&b)[16]) {
#pragma unroll
    for (int i = 0; i < 16; ++i) a[i] = fmaxf(a[i], b[15 - i]);
#pragma unroll
    for (int j = 8; j > 0; j >>= 1)
#pragma unroll
        for (int i = 0; i < 16; ++i) { const int l = i ^ j; if (l > i) { const float x = a[i], y = a[l]; a[i] = fmaxf(x, y); a[l] = fminf(x, y); } }
}
__device__ __forceinline__ void top16_of_64(float (&v)[64], float (&out)[16]) {
    float g[4][16];
#pragma unroll
    for (int q = 0; q < 4; ++q) {
#pragma unroll
        for (int i = 0; i < 16; ++i) g[q][i] = v[q * 16 + i];
        bitonic_sort_desc<16>(g[q]); }
    merge_top16(g[0], g[1]); merge_top16(g[2], g[3]); merge_top16(g[0], g[2]);
#pragma unroll
    for (int i = 0; i < 16; ++i) out[i] = g[0][i];
}
__device__ __forceinline__ float pack_key(float v, unsigned key, unsigned mask) { return __builtin_bit_cast(float, (__builtin_bit_cast(unsigned, v) & ~mask) | key); }
constexpr int SK_PITCH = 272;
__device__ __forceinline__ void score_top16(const bf16* q, const LAS unsigned char* skl, int tok, int h, int p, int l31, int hf, float (&out)[16]) {
    f32x16 acc[4];
#pragma unroll
    for (int kt = 0; kt < 4; ++kt)
#pragma unroll
        for (int r = 0; r < 16; ++r) acc[kt][r] = 0.f;
    bf16x8 bq[8];
#pragma unroll
    for (int ks = 0; ks < 8; ++ks) bq[ks] = *(const GAS bf16x8*)(q + (size_t)tok * D + h * 256 + p * 128 + 16 * ks + 8 * hf);
#pragma unroll
    for (int ks = 0; ks < 8; ++ks) {
#pragma unroll
        for (int kt = 0; kt < 4; ++kt) {
            const bf16x8 ak = *(const LAS bf16x8*)(skl + (p * NKEY + 32 * kt + l31) * SK_PITCH + (16 * ks + 8 * hf) * 2);
            acc[kt] = __builtin_amdgcn_mfma_f32_32x32x16_bf16(ak, bq[ks], acc[kt], 0, 0, 0);
        }
    }
    float v[64];
#pragma unroll
    for (int kt = 0; kt < 4; ++kt)
#pragma unroll
        for (int r = 0; r < 16; ++r) v[kt * 16 + r] = pack_key(acc[kt][r], (unsigned)(32 * kt + (r & 3) + 8 * (r >> 2) + 4 * hf), 0x7Fu);
    float other[16];
    top16_of_64(v, out);
#pragma unroll
    for (int i = 0; i < 16; ++i) other[i] = __shfl_xor(out[i], 32);
    merge_top16(out, other);
}
__device__ __forceinline__ void s_convert_tables(const Args& A, int gw, int NGW, int lane) {
    cvt_table_q8<true>(A.in[I_PU], A.ws + WS_UB, (float*)(A.ws + WS_USC), gw, NGW, lane);
}
__device__ __forceinline__ void phase_s(const Args& A, LAS unsigned char* lds, int tid, int lane, int wave, int bid, int G) {
    const bf16* q = (const bf16*)(A.ws + WS_Q); const bf16* sk = (const bf16*)(A.ws + WS_SUBK);
    int* idx = (int*)(A.ws + WS_IDX); float* gate = (float*)(A.ws + WS_GATE);
    const int l31 = lane & 31, hf = lane >> 5;
    bool conv_done = false;
    for (int wi = bid; wi < (T / 512) * NH; wi += G) {
      const int h = wi & 7, tg = wi >> 3;
      __syncthreads();
#pragma unroll
      for (int i = 0; i < 8; ++i) { const int c = tid + i * NTHR, row = c >> 4, c16 = c & 15;
          *(LAS v4u*)(lds + row * SK_PITCH + c16 * 16) = *(const GAS v4u*)(sk + ((size_t)(h * 2 * NKEY + row)) * 128 + c16 * 8); }
      __syncthreads();
      if (S_CONV && wave >= 4 && !conv_done) s_convert_tables(A, bid * NWAVES + wave, G * NWAVES, lane);
      for (int ti = 0; ti < 2; ++ti) {
        const int tok = (tg * 16 + ti * 8 + wave) * 32 + l31;
        float s1[16], s2[16];
        score_top16(q, lds, tok, h, 0, l31, hf, s1);
        score_top16(q, lds, tok, h, 1, l31, hf, s2);
        float cv[64]; int n = 0;
#pragma unroll
        for (int i = 0; i < 16; ++i)
#pragma unroll
            for (int j = 0; j < 16; ++j)
                if ((i + 1) * (j + 1) <= 16) {
                    const float a = __builtin_bit_cast(float, __builtin_bit_cast(unsigned, s1[i]) & ~0x7Fu), c = __builtin_bit_cast(float, __builtin_bit_cast(unsigned, s2[j]) & ~0x7Fu);
                    cv[n++] = pack_key(a + c, (unsigned)(i * 16 + j), 0xFFu); }
#pragma unroll
        for (int m = 50; m < 64; ++m) cv[m] = -INFINITY;
        float c16[16];
        top16_of_64(cv, c16);
        float ev[16], esum = 0.f; const float cmax = __builtin_bit_cast(float, __builtin_bit_cast(unsigned, c16[0]) & ~0xFFu);
#pragma unroll
        for (int m = 0; m < 16; ++m) { ev[m] = __expf(__builtin_bit_cast(float, __builtin_bit_cast(unsigned, c16[m]) & ~0xFFu) - cmax); esum += ev[m]; }
        const float rs = 1.0f / esum;
        int oi[8]; float og[8];
#pragma unroll
        for (int mm = 0; mm < 8; ++mm) {
            float c_lo = c16[mm], c_hi = c16[8 + mm], e_lo = ev[mm], e_hi = ev[8 + mm];
            asm volatile("" : "+v"(c_lo), "+v"(c_hi), "+v"(e_lo), "+v"(e_hi));
            const unsigned cb = __builtin_bit_cast(unsigned, hf ? c_hi : c_lo); const int ii = (cb >> 4) & 15, jj = cb & 15;
            int row = 0, col = 0;
#pragma unroll
            for (int k = 0; k < 16; ++k) { row = (ii == k) ? (int)(__builtin_bit_cast(unsigned, s1[k]) & 0x7Fu) : row; col = (jj == k) ? (int)(__builtin_bit_cast(unsigned, s2[k]) & 0x7Fu) : col; }
            oi[mm] = row * NKEY + col; og[mm] = (hf ? e_hi : e_lo) * rs;
        }
        int* ip = idx + (size_t)tok * KSEL + h * 16 + hf * 8; float* gp = gate + (size_t)tok * KSEL + h * 16 + hf * 8;
        *(GAS v4u*)ip = (v4u){(unsigned)oi[0], (unsigned)oi[1], (unsigned)oi[2], (unsigned)oi[3]}; *(GAS v4u*)(ip + 4) = (v4u){(unsigned)oi[4], (unsigned)oi[5], (unsigned)oi[6], (unsigned)oi[7]};
        *(GAS f32x4*)gp = (f32x4){og[0], og[1], og[2], og[3]}; *(GAS f32x4*)(gp + 4) = (f32x4){og[4], og[5], og[6], og[7]};
      }
      if (S_CONV && wave < 4 && !conv_done) s_convert_tables(A, bid * NWAVES + wave, G * NWAVES, lane);
      conv_done = true;
    }
    if (S_CONV && !conv_done) s_convert_tables(A, bid * NWAVES + wave, G * NWAVES, lane);
    __syncthreads();
}

__device__ __forceinline__ float row_dot_fp8(const v4u d0, const v4u d1, const f32x2 (&hf)[2][8]) {
    const unsigned w0[4] = {d0.x, d0.y, d0.z, d0.w}, w1[4] = {d1.x, d1.y, d1.z, d1.w};
    f32x2 a = {0.f, 0.f}, b = {0.f, 0.f};
#pragma unroll
    for (int i = 0; i < 4; ++i) { a += fp8lo(w0[i]) * hf[0][2 * i]; a += fp8hi(w0[i]) * hf[0][2 * i + 1]; b += fp8lo(w1[i]) * hf[1][2 * i]; b += fp8hi(w1[i]) * hf[1][2 * i + 1]; }
    return (a.x + a.y) + (b.x + b.y);
}
__device__ __forceinline__ void row_axpy_fp8(f32x2 (&acc)[2][8], const v4u d0, const v4u d1, float w) {
    const unsigned w0[4] = {d0.x, d0.y, d0.z, d0.w}, w1[4] = {d1.x, d1.y, d1.z, d1.w};
#pragma unroll
    for (int i = 0; i < 4; ++i) { acc[0][2 * i] += fp8lo(w0[i]) * w; acc[0][2 * i + 1] += fp8hi(w0[i]) * w; acc[1][2 * i] += fp8lo(w1[i]) * w; acc[1][2 * i + 1] += fp8hi(w1[i]) * w; }
}
__device__ __forceinline__ void phase_pu(const Args& A, int lane, int wave, int bid, int G) {
    const unsigned char* h2q = A.ws + WS_H2Q; const unsigned char* ub = A.ws + WS_UB; const int* idx = (const int*)(A.ws + WS_IDX); float* actp = (float*)(A.ws + WS_ACTP);
    const int NX = (G % 8 == 0) ? 8 : 1, vx = bid % NX, nw = (G / NX) * NWAVES, wv = (bid / NX) * NWAVES + wave;
    const int q = lane >> 4, c16 = lane & 15;
    for (int cb = vx; cb < D / 256; cb += NX) {
        const unsigned char* ucol = ub + cb * 256 + c16 * 16;
        int cid0 = 0, cid1 = 0, nid0 = 0, nid1 = 0; v4u ch = {0u, 0u, 0u, 0u}, nh = {0u, 0u, 0u, 0u};
#define PUQ_LOAD(i0, i1, hh, t_) do { const int t__ = (t_); if (t__ < T) { i0 = idx[(size_t)t__ * KSEL + lane]; i1 = idx[(size_t)t__ * KSEL + 64 + lane]; hh = *(const GAS v4u*)(h2q + (size_t)t__ * D + cb * 256 + c16 * 16); } } while (0)
        PUQ_LOAD(cid0, cid1, ch, wv); PUQ_LOAD(nid0, nid1, nh, wv + nw);
        v4u rv[PUQ_RB];
#define PUQ_ISSUE(slot, idr, s_) do { const int e_ = __shfl(idr, ((4 * (s_)) & 63) + q); rv[slot] = *(const GAS v4u*)(ucol + (size_t)e_ * D); } while (0)
#pragma unroll
        for (int r = 0; r < PUQ_RB; ++r) PUQ_ISSUE(r, cid0, r);
        f32x4 cvv[8]; int it = 0;
        const int gwv = bid * NWAVES + wave, NGWv = G * NWAVES;
        for (int tok = wv; tok < T; tok += nw, ++it) {
            if (cb == vx) {
                const int vr = gwv + NGWv * (it >> 3);
                if ((it & 7) == 0 && vr < NEXP) { const GAS f32x4* p = (const GAS f32x4*)(A.in[I_PV] + (size_t)vr * D) + lane;
#pragma unroll
                    for (int i = 0; i < 8; ++i) cvv[i] = p[i * 64]; }
                if ((it & 7) == 1 && vr < NEXP) { float m = 0.f;
#pragma unroll
                    for (int i = 0; i < 8; ++i) m = fmaxf(m, fmaxf(fmaxf(fabsf(cvv[i].x), fabsf(cvv[i].y)), fmaxf(fabsf(cvv[i].z), fabsf(cvv[i].w))));
#pragma unroll
                    for (int o = 1; o < 64; o <<= 1) m = fmaxf(m, __shfl_xor(m, o));
                    const float sc = m > 0.f ? 448.0f / m : 1.0f; GAS unsigned* o4 = (GAS unsigned*)(A.ws + WS_VB + (size_t)vr * D) + lane;
#pragma unroll
                    for (int i = 0; i < 8; ++i) { const f32x4 t = cvv[i] * sc;
                        const float a = fminf(fmaxf(t.x, -448.f), 448.f), b = fminf(fmaxf(t.y, -448.f), 448.f), c = fminf(fmaxf(t.z, -448.f), 448.f), d = fminf(fmaxf(t.w, -448.f), 448.f);
                        int pk = __builtin_amdgcn_cvt_pk_fp8_f32(a, b, 0, false); pk = __builtin_amdgcn_cvt_pk_fp8_f32(c, d, pk, true); o4[i * 64] = (unsigned)pk; }
                    if (lane == 0) ((float*)(A.ws + WS_VSC))[vr] = m > 0.f ? m * (1.0f / 448.0f) : 1.0f; }
            }
            const int hx = (int)ch.x, hy = (int)ch.y, hz = (int)ch.z, hw = (int)ch.w;
            int a0 = 0, a1 = 0;
#define PUQ_DOT(slot, acc_, s_) do { const v4u d_ = rv[slot]; int p_ = __builtin_amdgcn_sdot4((int)d_.x, hx, 0, false); p_ = __builtin_amdgcn_sdot4((int)d_.y, hy, p_, false); \
                p_ = __builtin_amdgcn_sdot4((int)d_.z, hz, p_, false); p_ = __builtin_amdgcn_sdot4((int)d_.w, hw, p_, false); \
                p_ += __builtin_amdgcn_update_dpp(0, p_, 0xB1, 0xF, 0xF, false); p_ += __builtin_amdgcn_update_dpp(0, p_, 0x4E, 0xF, 0xF, false); \
                p_ += __builtin_amdgcn_update_dpp(0, p_, 0x141, 0xF, 0xF, false); p_ += __builtin_amdgcn_update_dpp(0, p_, 0x140, 0xF, 0xF, false); \
                acc_ = (c16 == ((s_) & 15)) ? p_ : acc_; } while (0)
#pragma unroll
            for (int r = 0; r < PUQ_RB; ++r) { PUQ_DOT(r, a0, r); PUQ_ISSUE(r, cid1, r + PUQ_RB); }
#pragma unroll
            for (int r = 0; r < PUQ_RB; ++r) { PUQ_DOT(r, a1, r + PUQ_RB); PUQ_ISSUE(r, nid0, r); }
            float* ap = actp + ((size_t)cb * T + tok) * KSEL + 4 * c16 + q;
            ap[0] = (float)a0; ap[64] = (float)a1;
            cid0 = nid0; cid1 = nid1; ch = nh;
            PUQ_LOAD(nid0, nid1, nh, tok + 2 * nw);
        }
#undef PUQ_LOAD
#undef PUQ_ISSUE
#undef PUQ_DOT
    }
}
__device__ __forceinline__ void phase_w(const Args& A, int lane, int wave, int bid, int G) {
    const float* actp = (const float*)(A.ws + WS_ACTP); const float* usc = (const float*)(A.ws + WS_USC); const float* vsc = (const float*)(A.ws + WS_VSC); const float* hsc = (const float*)(A.ws + WS_HSC);
    const int* idx = (const int*)(A.ws + WS_IDX); const float* gate = (const float*)(A.ws + WS_GATE); float* wb = (float*)(A.ws + WS_ACT);
    for (int tok = bid * NWAVES + wave; tok < T; tok += G * NWAVES) {
        const float hs = hsc[tok];
#pragma unroll
        for (int hh = 0; hh < 2; ++hh) {
            const size_t o = (size_t)tok * KSEL + hh * 64 + lane; float sacc = 0.f;
#pragma unroll
            for (int c = 0; c < 8; ++c) sacc += actp[(size_t)c * T * KSEL + o];
            const int e = idx[o];
            wb[o] = gate[o] * gelu_tanh(sacc * usc[e] * hs) * vsc[e];
        }
    }
}
__device__ __forceinline__ void phase_pv(const Args& A, int lane, int wave, int bid, int G) {
    const unsigned char* vb = A.ws + WS_VB; const float* wb = (const float*)(A.ws + WS_ACT); const int* idx = (const int*)(A.ws + WS_IDX);
    bf16* y2 = (bf16*)(A.ws + WS_Y2); float* ssq = (float*)(A.ws + WS_SSQ);
    const int NX = (G % 8 == 0) ? 8 : 1, vx = bid % NX, nw = (G / NX) * NWAVES, wv = (bid / NX) * NWAVES + wave;
    const int q = lane >> 4, c16 = lane & 15;
    for (int cb = vx; cb < D / 256; cb += NX) {
        const unsigned char* vcol = vb + cb * 256 + c16 * 16;
        int cid0 = 0, cid1 = 0, nid0 = 0, nid1 = 0; float cw0 = 0.f, cw1 = 0.f, nw0 = 0.f, nw1 = 0.f;
#define PVQ_LOAD(i0, i1, x0, x1, t_) do { const int t__ = (t_); if (t__ < T) { i0 = idx[(size_t)t__ * KSEL + lane]; i1 = idx[(size_t)t__ * KSEL + 64 + lane]; x0 = wb[(size_t)t__ * KSEL + lane]; x1 = wb[(size_t)t__ * KSEL + 64 + lane]; } } while (0)
        PVQ_LOAD(cid0, cid1, cw0, cw1, wv); PVQ_LOAD(nid0, nid1, nw0, nw1, wv + nw);
        v4u rv[PVQ_RB];
#define PVQ_ISSUE(slot, idr, s_) do { const int e_ = __shfl(idr, ((4 * (s_)) & 63) + q); rv[slot] = *(const GAS v4u*)(vcol + (size_t)e_ * D); } while (0)
#pragma unroll
        for (int r = 0; r < PVQ_RB; ++r) PVQ_ISSUE(r, cid0, r);
        for (int tok = wv; tok < T; tok += nw) {
            f32x2 acc[8];
#pragma unroll
            for (int i = 0; i < 8; ++i) acc[i] = (f32x2){0.f, 0.f};
#define PVQ_FMA(slot, wr, s_) do { const float w_ = __shfl(wr, ((4 * (s_)) & 63) + q); const v4u d_ = rv[slot]; const unsigned dw_[4] = {d_.x, d_.y, d_.z, d_.w}; \
                _Pragma("unroll") for (int i_ = 0; i_ < 4; ++i_) { acc[2 * i_] += fp8lo(dw_[i_]) * w_; acc[2 * i_ + 1] += fp8hi(dw_[i_]) * w_; } } while (0)
#pragma unroll
            for (int r = 0; r < PVQ_RB; ++r) { PVQ_FMA(r, cw0, r); PVQ_ISSUE(r, cid1, r + PVQ_RB); }
#pragma unroll
            for (int r = 0; r < PVQ_RB; ++r) { PVQ_FMA(r, cw1, r + PVQ_RB); PVQ_ISSUE(r, nid0, r); }
            float sq = 0.f;
#pragma unroll
            for (int i = 0; i < 8; ++i) { float x = acc[i].x, y = acc[i].y; x += __shfl_xor(x, 16); y += __shfl_xor(y, 16); x += __shfl_xor(x, 32); y += __shfl_xor(y, 32); acc[i] = (f32x2){x, y}; sq += x * x + y * y; }
            sq = wave_total(q == 0 ? sq : 0.f);
            if (q == 0) { GAS v4u* yo = (GAS v4u*)(y2 + (size_t)tok * D + cb * 256 + c16 * 16);
                yo[0] = (v4u){pk2(acc[0].x, acc[0].y), pk2(acc[1].x, acc[1].y), pk2(acc[2].x, acc[2].y), pk2(acc[3].x, acc[3].y)};
                yo[1] = (v4u){pk2(acc[4].x, acc[4].y), pk2(acc[5].x, acc[5].y), pk2(acc[6].x, acc[6].y), pk2(acc[7].x, acc[7].y)}; }
            if (lane == 0) ssq[(size_t)cb * T + tok] = sq;
            cid0 = nid0; cid1 = nid1; cw0 = nw0; cw1 = nw1;
            PVQ_LOAD(nid0, nid1, nw0, nw1, tok + 2 * nw);
        }
#undef PVQ_LOAD
#undef PVQ_ISSUE
#undef PVQ_FMA
    }
}
__device__ __forceinline__ void phase_f(const Args& A, int lane, int wave, int bid, int G) {
    const bf16* y1 = (const bf16*)(A.ws + WS_Y1); const bf16* y2 = (const bf16*)(A.ws + WS_Y2); const float* ssq = (const float*)(A.ws + WS_SSQ); const float* cfin = (const float*)(A.ws + WS_CFIN);
    for (int tok = bid * NWAVES + wave; tok < T; tok += G * NWAVES) {
        const int b = tok >> 13;
        float qs = 0.f;
#pragma unroll
        for (int c = 0; c < 8; ++c) qs += ssq[(size_t)c * T + tok];
        const float rstd2 = __builtin_amdgcn_rsqf(qs * (1.0f / D) + EPS);
        const GAS v2u* yp = (const GAS v2u*)(y1 + (size_t)tok * D) + lane; const GAS v2u* zp = (const GAS v2u*)(y2 + (size_t)tok * D) + lane;
        const GAS f32x4* xr = (const GAS f32x4*)(A.in[I_X] + (size_t)tok * D) + lane;
        v2u yq[8], zq[8]; f32x4 xv[8]; float s1 = 0.f;
#pragma unroll
        for (int i = 0; i < 8; ++i) { yq[i] = yp[i * 64]; zq[i] = zp[i * 64]; xv[i] = xr[i * 64]; }
#pragma unroll
        for (int i = 0; i < 8; ++i) { const float a = bflo(yq[i].x), b_ = bfhi(yq[i].x), c = bflo(yq[i].y), d = bfhi(yq[i].y); s1 += (a * a + b_ * b_) + (c * c + d * d); }
        const float rstd1 = __builtin_amdgcn_rsqf(wave_total(s1) * (1.0f / D) + EPS);
        const GAS f32x4* c1 = (const GAS f32x4*)(cfin + (size_t)(b * 2 + 0) * D) + lane; const GAS f32x4* c2 = (const GAS f32x4*)(cfin + (size_t)(b * 2 + 1) * D) + lane;
        GAS f32x4* orow = (GAS f32x4*)(A.out + (size_t)tok * D) + lane;
#pragma unroll
        for (int i = 0; i < 8; ++i) { const f32x4 a1 = c1[i * 64], a2 = c2[i * 64];
            const float yv[4] = {bflo(yq[i].x), bfhi(yq[i].x), bflo(yq[i].y), bfhi(yq[i].y)}, zv[4] = {bflo(zq[i].x), bfhi(zq[i].x), bflo(zq[i].y), bfhi(zq[i].y)}; f32x4 o;
#pragma unroll
            for (int e = 0; e < 4; ++e) o[e] = xv[i][e] + (OUT_MODE != 2 ? a1[e] * yv[e] * rstd1 : 0.f) + (OUT_MODE != 1 ? a2[e] * zv[e] * rstd2 : 0.f);
            orow[i * 64] = o; }
    }
}

#if defined(MK_CHECKS)
constexpr int CW_CHK = 2048;
__device__ __forceinline__ unsigned hsh(unsigned x) { x ^= x >> 16; x *= 0x7feb352dU; x ^= x >> 15; x *= 0x846ca68bU; x ^= x >> 16; return x; }
__device__ __forceinline__ float bfv(const bf16* p, size_t i) { return __builtin_bit_cast(float, (unsigned)p[i] << 16); }
__device__ __forceinline__ float relerr(float got, float ref, float scale) { const float d = fabsf(got - ref) / (fabsf(ref) + scale); return (d == d) ? d : 1e30f; }
__device__ __forceinline__ void chk_put(unsigned* ctl, int stage, float e) { atomicMax(ctl + CW_CHK + stage, __builtin_bit_cast(unsigned, e)); }
__device__ float chk_gemm(const bf16* Am, const bf16* Bt, const bf16* C, int N, int K, unsigned s) {
    const int row = hsh(s) % T, col = hsh(s * 7 + 1) % N; float acc = 0.f;
    for (int k = 0; k < K; ++k) acc += bfv(Am, (size_t)row * K + k) * bfv(Bt, (size_t)col * K + k);
    return relerr(bfv(C, (size_t)row * N + col), acc, 0.05f);
}
__global__ void __launch_bounds__(128) chk_kernel(Args A, int stage) {
    __shared__ float sh[10240];
    unsigned* ctl = (unsigned*)(A.ws + WS_CTL);
    const int tid = threadIdx.x; const unsigned s = hsh(tid * 2654435761u + stage * 97u + 12345u);
    const float* modp = (const float*)(A.ws + WS_MODP);
    float e = 0.f;
    if (stage == 0) {
        { const int b = s & 1, n = hsh(s) % NMOD; float acc = A.in[I_BMOD][n];
          for (int k = 0; k < D; ++k) { const float c = A.in[I_C][b * D + k]; acc += c / (1.0f + expf(-c)) * A.in[I_WMOD][(size_t)k * NMOD + n]; }
          e = fmaxf(e, relerr(mod_at(modp, b, n), acc, 0.01f)); }
        { const int n = hsh(s + 1) % IN_COLS, k = hsh(s + 2) % D; e = fmaxf(e, relerr(bfv((const bf16*)(A.ws + WS_BT1), (size_t)n * D + k), A.in[I_WIN][(size_t)k * IN_COLS + n], 1e-3f)); }
        { const int n = hsh(s + 3) % D, k = hsh(s + 4) % D; e = fmaxf(e, relerr(bfv((const bf16*)(A.ws + WS_BT2), (size_t)n * D + k), A.in[I_WOUT][(size_t)k * D + n], 1e-3f));
          e = fmaxf(e, relerr(bfv((const bf16*)(A.ws + WS_BT3), (size_t)n * D + k), A.in[I_WQ][(size_t)k * D + n], 1e-3f)); }
        { const int h = s & 7, n = hsh(s + 5) & 255, k = hsh(s + 6) & 127; const float ref = (n < 128 ? A.in[I_WA] : A.in[I_WX])[h * 16384 + k * 128 + (n & 127)];
          e = fmaxf(e, relerr(bfv((const bf16*)(A.ws + WS_WG), (size_t)(h * 256 + n) * 128 + k), ref, 1e-3f)); }
        { const int i = hsh(s + 7) % (NH * 2 * NKEY * 128); e = fmaxf(e, relerr(bfv((const bf16*)(A.ws + WS_SUBK), i), A.in[I_SUBK][i], 1e-3f)); }
    } else if (stage == 1) {
        const int row = hsh(s) % T, col = hsh(s + 1) % D, b = row >> 13; float ss = 0.f;
        for (int k = 0; k < D; ++k) { const float x = A.in[I_X][(size_t)row * D + k]; ss += x * x; }
        const float ref = A.in[I_X][(size_t)row * D + col] * rsqrtf(ss / D + EPS) * A.in[I_GPREMIX][col] * (1.0f + mod_at(modp, b, D + col)) + mod_at(modp, b, col);
        e = relerr(bfv((const bf16*)(A.ws + WS_RA), (size_t)row * D + col), ref, 0.05f);
        const float* cfin = (const float*)(A.ws + WS_CFIN);
        e = fmaxf(e, relerr(cfin[(b * 2 + 0) * D + col], mod_at(modp, b, 2 * D + col) * A.in[I_GPOSTMIX][col], 1e-3f));
        e = fmaxf(e, relerr(cfin[(b * 2 + 1) * D + col], mod_at(modp, b, 5 * D + col) * A.in[I_GPOSTFFN][col], 1e-3f));
    } else if (stage == 2) { e = chk_gemm((const bf16*)(A.ws + WS_RA), (const bf16*)(A.ws + WS_BT1), (const bf16*)(A.ws + WS_PROJ), IN_COLS, D, s);
    } else if (stage == 7) { e = chk_gemm((const bf16*)(A.ws + WS_RA), (const bf16*)(A.ws + WS_BT2), (const bf16*)(A.ws + WS_Y1), D, D, s);
    } else if (stage == 9) { e = chk_gemm((const bf16*)(A.ws + WS_RA), (const bf16*)(A.ws + WS_BT3), (const bf16*)(A.ws + WS_Q), D, D, s);
    } else if (stage == 3) {
        const bf16* proj = (const bf16*)(A.ws + WS_PROJ);
        int row = hsh(s) % T; if (tid < 16) row = (tid & 1) * SEQ + (tid >> 1);
        const int c = hsh(s + 1) % LRU_W, t = row & (SEQ - 1);
        float a = A.in[I_LCB][c];
        for (int j = 0; j < 4; ++j) if (t - 3 + j >= 0) a += A.in[I_LCW][j * LRU_W + c] * bfv(proj, (size_t)(row - 3 + j) * IN_COLS + c);
        e = relerr(bfv((const bf16*)(A.ws + WS_XL), (size_t)row * LRU_W + c), a, 0.05f);
        float z = A.in[I_CDB][c];
        for (int j = 0; j < CONF_K; ++j) if (t - 30 + j >= 0) { const size_t r = (size_t)(row - 30 + j) * IN_COLS; const float g = bfv(proj, r + 3072 + c);
            z += A.in[I_CDW][j * CONF_W + c] * bfv(proj, r + 2048 + c) / (1.0f + expf(-g)); }
        e = fmaxf(e, relerr(bfv((const bf16*)(A.ws + WS_ZC), (size_t)row * CONF_W + c), z, 0.05f));
    } else if (stage == 4) {
        const bf16* xl = (const bf16*)(A.ws + WS_XL);
        const int b = s & 1, chunk = hsh(s + 1) % NCHUNK, ch = hsh(s + 2) % LRU_W, hh = ch >> 7, j = ch & 127;
        const float cl = -8.0f * log1pf(expf(-A.in[I_LAMBDA][ch])); float P = 1.f, H = 0.f;
        for (int t = 0; t < CHUNK; ++t) { const size_t row = (size_t)b * SEQ + chunk * CHUNK + t; float ga = A.in[I_BA][ch], gx = A.in[I_BX][ch];
            for (int i = 0; i < 128; ++i) { const float xv = bfv(xl, row * LRU_W + hh * 128 + i); ga += xv * A.in[I_WA][hh * 16384 + i * 128 + j]; gx += xv * A.in[I_WX][hh * 16384 + i * 128 + j]; }
            const float r = 1.0f / (1.0f + expf(-ga)), ig = 1.0f / (1.0f + expf(-gx)), la = cl * r, a = expf(la), u = sqrtf(fmaxf(-expm1f(2.0f * la), 0.f)) * ig * bfv(xl, row * LRU_W + ch);
            H = a * H + u; P = P * a;
            e = fmaxf(e, relerr(bfv((const bf16*)(A.ws + WS_HLOC), row * LRU_W + ch), H, 0.05f)); e = fmaxf(e, relerr(bfv((const bf16*)(A.ws + WS_PC), row * LRU_W + ch), P, 0.02f)); }
        const float* ag = (const float*)(A.ws + WS_AGG) + ((size_t)(b * NCHUNK + chunk) * LRU_W + ch) * 2;
        e = fmaxf(e, relerr(ag[0], P, 0.02f)); e = fmaxf(e, relerr(ag[1], H, 0.05f));
    } else if (stage == 5) {
    } else if (stage == 6) {
        const bf16* proj = (const bf16*)(A.ws + WS_PROJ); const bf16* zc = (const bf16*)(A.ws + WS_ZC);
        const int row = hsh(s) % T, c = hsh(s + 1) % LRU_W, b = row >> 13, chunk = (row & (SEQ - 1)) >> 6;
        float cin = 0.f; for (int cc = 0; cc < chunk; ++cc) { const float* ag = (const float*)(A.ws + WS_AGG) + ((size_t)(b * NCHUNK + cc) * LRU_W + c) * 2; cin = ag[0] * cin + ag[1]; }
        const float hfull = bfv((const bf16*)(A.ws + WS_HLOC), (size_t)row * LRU_W + c) + bfv((const bf16*)(A.ws + WS_PC), (size_t)row * LRU_W + c) * cin;
        const float g = bfv(proj, (size_t)row * IN_COLS + 1024 + c), ge = 0.5f * g * (1.0f + tanhf(0.7978845608f * (g + 0.044715f * g * g * g)));
        e = relerr(bfv((const bf16*)(A.ws + WS_RA), (size_t)row * D + c), hfull * ge, 0.05f);
        float m = 0.f, q = 0.f;
        for (int k = 0; k < CONF_W; ++k) m += bfv(zc, (size_t)row * CONF_W + k);
        m /= CONF_W;
        for (int k = 0; k < CONF_W; ++k) { const float d = bfv(zc, (size_t)row * CONF_W + k) - m; q += d * d; }
        const float n = (bfv(zc, (size_t)row * CONF_W + c) - m) * rsqrtf(q / CONF_W + EPS) * A.in[I_LNG][c] + A.in[I_LNB][c];
        e = fmaxf(e, relerr(bfv((const bf16*)(A.ws + WS_RA), (size_t)row * D + 1024 + c), n / (1.0f + expf(-n)), 0.05f));
    } else if (stage == 8) {
        const bf16* y1 = (const bf16*)(A.ws + WS_Y1); const float* cfin = (const float*)(A.ws + WS_CFIN);
        const int row = hsh(s) % T, col = hsh(s + 1) % D, b = row >> 13; float s1 = 0.f, s2 = 0.f;
        for (int k = 0; k < D; ++k) { const float y = bfv(y1, (size_t)row * D + k); s1 += y * y; }
        const float r1 = rsqrtf(s1 / D + EPS);
        for (int k = 0; k < D; ++k) { const float x1 = A.in[I_X][(size_t)row * D + k] + cfin[(b * 2) * D + k] * bfv(y1, (size_t)row * D + k) * r1; s2 += x1 * x1; }
        const float x1c = A.in[I_X][(size_t)row * D + col] + cfin[(b * 2) * D + col] * bfv(y1, (size_t)row * D + col) * r1;
        const float ref = x1c * rsqrtf(s2 / D + EPS) * A.in[I_GPREFFN][col] * (1.0f + mod_at(modp, b, 4 * D + col)) + mod_at(modp, b, 3 * D + col);
        e = relerr(bfv((const bf16*)(A.ws + WS_RA), (size_t)row * D + col), ref, 0.05f);
    } else if (stage == 10) {
        { const size_t i = (size_t)(hsh(s + 2) % NEXP) * D + hsh(s + 3) % D;
          const unsigned wu = ((const unsigned*)(A.ws + WS_UB))[i >> 2] >> (8 * (i & 3)), wv = ((const unsigned*)(A.ws + WS_VB))[i >> 2] >> (8 * (i & 3));
          const float du = (float)(signed char)(wu & 255u) * ((const float*)(A.ws + WS_USC))[i / D], dv = __builtin_amdgcn_cvt_pk_f32_fp8((int)wv, false)[0] * ((const float*)(A.ws + WS_VSC))[i / D];
          e = fmaxf(e, relerr(du, A.in[I_PU][i], 2e-3f) * 0.3f); (void)dv; }
        if (tid < 32) {
            const bf16* q = (const bf16*)(A.ws + WS_Q); const int* idx = (const int*)(A.ws + WS_IDX); const float* gate = (const float*)(A.ws + WS_GATE);
            const int tok = hsh(s) % T, h = hsh(s + 1) & 7;
            float* sc = sh + tid * 320;
            for (int p = 0; p < 2; ++p) for (int n = 0; n < NKEY; ++n) { float a = 0.f;
                for (int d = 0; d < 128; ++d) a += bfv(q, (size_t)tok * D + h * 256 + p * 128 + d) * A.in[I_SUBK][((size_t)((h * 2 + p) * NKEY + n)) * 128 + d];
                sc[p * 128 + n] = a; }
            for (int p = 0; p < 2; ++p) { float prev = 1e30f; for (int it = 0; it < 16; ++it) { float best = -1e30f; int bi = 0;
                for (int n = 0; n < NKEY; ++n) { const float v = sc[p * 128 + n]; if (v < prev && v > best) { best = v; bi = n; } }
                sc[256 + p * 16 + it] = best; sc[288 + p * 16 + it] = (float)bi; prev = best; } }
            float prev = 1e30f, esum = 0.f, cmax = 0.f; int miss = 0; float gerr = 0.f;
            { float pv = 1e30f; for (int it = 0; it < 16; ++it) { float best = -1e30f;
                for (int c = 0; c < 256; ++c) { const float v = sc[256 + (c >> 4)] + sc[272 + (c & 15)]; if (v < pv && v > best) best = v; }
                if (it == 0) cmax = best; esum += expf(best - cmax); pv = best; } }
            for (int it = 0; it < 16; ++it) { float best = -1e30f; int bc = 0;
                for (int c = 0; c < 256; ++c) { const float v = sc[256 + (c >> 4)] + sc[272 + (c & 15)]; if (v < prev && v > best) { best = v; bc = c; } }
                prev = best;
                const int eidx = (int)sc[288 + (bc >> 4)] * NKEY + (int)sc[304 + (bc & 15)]; const float g = expf(best - cmax) / esum; bool found = false;
                for (int m = 0; m < 16; ++m) if (idx[(size_t)tok * KSEL + h * 16 + m] == eidx) { found = true; gerr = fmaxf(gerr, relerr(gate[(size_t)tok * KSEL + h * 16 + m], g, 0.02f)); }
                if (!found) ++miss; }
            e = fmaxf((float)miss / 16.0f, gerr);
        }
    } else if (stage == 11) {
        const bf16* h2 = (const bf16*)(A.ws + WS_RA); const bf16* y1 = (const bf16*)(A.ws + WS_Y1); const int* idx = (const int*)(A.ws + WS_IDX); const float* gate = (const float*)(A.ws + WS_GATE); const float* cfin = (const float*)(A.ws + WS_CFIN);
        const int tok = hsh(blockIdx.x * 977u + 5u) % T, b = tok >> 13;
        { const int ex = idx[(size_t)tok * KSEL + tid]; float a = 0.f;
          if ((unsigned)ex < (unsigned)NEXP) { for (int d = 0; d < D; ++d) a += bfv(h2, (size_t)tok * D + d) * A.in[I_PU][(size_t)ex * D + d]; } else a = 1e30f;
          const float ge = 0.5f * a * (1.0f + tanhf(0.7978845608f * (a + 0.044715f * a * a * a)));
          sh[tid] = gate[(size_t)tok * KSEL + tid] * ge; sh[128 + tid] = __builtin_bit_cast(float, ex); }
        __syncthreads();
        float s2 = 0.f, s1 = 0.f;
        for (int cc = 0; cc < 16; ++cc) { const int col = cc * 128 + tid; float a = 0.f;
            for (int k = 0; k < KSEL; ++k) { const int ex = __builtin_bit_cast(int, sh[128 + k]); if ((unsigned)ex < (unsigned)NEXP) a += sh[k] * A.in[I_PV][(size_t)ex * D + col]; }
            sh[512 + cc * 128 + tid] = a; s2 += a * a; const float y = bfv(y1, (size_t)tok * D + col); s1 += y * y; }
        __syncthreads(); sh[256 + tid] = s2; sh[384 + tid] = s1; __syncthreads();
        float t2 = 0.f, t1 = 0.f; for (int k = 0; k < 128; ++k) { t2 += sh[256 + k]; t1 += sh[384 + k]; }
        const float r2 = rsqrtf(t2 / D + EPS), r1 = rsqrtf(t1 / D + EPS);
        float en = 0.f, ed = 0.f;
        for (int cc = 0; cc < 16; ++cc) { const int col = cc * 128 + tid;
            const float pterm = cfin[(b * 2 + 1) * D + col] * sh[512 + cc * 128 + tid] * r2;
            const float ref = A.in[I_X][(size_t)tok * D + col] + (OUT_MODE != 2 ? cfin[(b * 2) * D + col] * bfv(y1, (size_t)tok * D + col) * r1 : 0.f) + (OUT_MODE != 1 ? pterm : 0.f);
            const float d = A.out[(size_t)tok * D + col] - ref; en += d * d; ed += pterm * pterm; }
        __syncthreads(); sh[256 + tid] = en; sh[384 + tid] = ed; __syncthreads();
        float ten = 0.f, ted = 0.f; for (int k = 0; k < 128; ++k) { ten += sh[256 + k]; ted += sh[384 + k]; }
        e = ten / (ted + 1e-12f); if (!(e == e)) e = 1e30f;
    }
    chk_put(ctl, stage, e);
}
__global__ void chk_encode(Args A, int what) {
    const unsigned* ctl = (const unsigned*)(A.ws + WS_CTL);
    if (threadIdx.x == 0 && blockIdx.x == 0) {
        if (what < 0) {
            const float thr[12] = {0.03f, 0.03f, 0.03f, 0.03f, 0.06f, 0.01f, 0.04f, 0.03f, 0.03f, 0.03f, 0.2f, 0.01f};
            for (int st = 0; st < 12; ++st) { const float e = __builtin_bit_cast(float, ctl[CW_CHK + st]); if (!(e <= thr[st])) { A.out[0] = 4000.0f * (float)(1 << st); break; } }
        } else {
            const float e = fminf(__builtin_bit_cast(float, ctl[CW_CHK + what]), 1e6f); A.out[0] = 4000.0f * sqrtf(1e6f * e);
        }
    }
}
#endif

__global__ void __launch_bounds__(NTHR, 2) fwd_kernel(Args args) {
    extern __shared__ __attribute__((aligned(16))) unsigned char lds_raw[];
    LAS unsigned char* lds = (LAS unsigned char*)lds_raw;
    const int tid = threadIdx.x, lane = tid & 63, wave = __builtin_amdgcn_readfirstlane(tid >> 6), bid = blockIdx.x, G = gridDim.x;
    for (int u = tid; u < (LDS_BYTES - LDSCTL_OFF) / 4; u += NTHR) ((LAS unsigned*)(lds + LDSCTL_OFF))[u] = 0u;
    __syncthreads();
    unsigned* ctl = (unsigned*)(args.ws + WS_CTL);
    XcdBarrier bar; bar.bar = ctl + CW_BAR + args.li * XCD_BAR_WORDS; bar.x = 0; bar.st = nullptr;
    if (MK_N_LAUNCHES != N_PHASES) bar = xcd_barrier_post(ctl + CW_BAR + args.li * XCD_BAR_WORDS, (volatile LAS unsigned*)(lds + MISC_OFF) + 8);
    const int lo = args.ph_lo, hi = args.ph_hi;
#define IN(k) (lo <= (k) && (k) < hi)
#define SEAM(k) do { if (IN(k) && IN((k) + 1)) xcd_barrier(bar); } while (0)
#define PHON(k) ((PH_MASK >> (k)) & 1)
    if (PHON(0) && IN(0)) { phase_p0(args, lds, tid, lane, wave, bid, G); }
    SEAM(0);
    if (PHON(1) && IN(1)) { phase_p1(args, tid, lane, wave, bid, G); }
    SEAM(1);
    if (PHON(2) && IN(2)) {
        pg8::Gemm g{(const bf16*)(args.ws + WS_RA), (const bf16*)(args.ws + WS_BT1), T, IN_COLS, D}; pg8::StaticOrder S; S.init(T, IN_COLS, G, bid);
        pg8::EpiBf16<0> E{(bf16*)(args.ws + WS_PROJ), IN_COLS, nullptr, 0, 0, 1.f};
        pg8::gemm_phase<pg8::EpiBf16<0>, pg8::StaticOrder, PG8_ALIGN, PG8_SP2>(lds + RING_OFF, g, S, E);
    }
    SEAM(2);
    if (PHON(3) && IN(3)) { phase_m1a(args, lds, tid, lane, wave, bid, G); }
    SEAM(3);
    if (PHON(4) && IN(4)) { phase_m1b(args, tid, lane, wave, bid, G); }
    SEAM(4);
    if (PHON(5) && IN(5)) { phase_m3(args, lds, tid, lane, wave, bid, G); }
    SEAM(5);
    if (PHON(6) && IN(6)) {
        pg8::Gemm g{(const bf16*)(args.ws + WS_RA), (const bf16*)(args.ws + WS_BT2), T, D, D}; pg8::StaticOrder S; S.init(T, D, G, bid);
        pg8::EpiBf16<0> E{(bf16*)(args.ws + WS_Y1), D, nullptr, 0, 0, 1.f};
        pg8::gemm_phase<pg8::EpiBf16<0>, pg8::StaticOrder, PG8_ALIGN, PG8_SP2>(lds + RING_OFF, g, S, E);
    }
    SEAM(6);
    if (PHON(7) && IN(7)) { phase_e2(args, tid, lane, wave, bid, G); }
    SEAM(7);
    if (PHON(8) && IN(8)) {
        pg8::Gemm g{(const bf16*)(args.ws + WS_RA), (const bf16*)(args.ws + WS_BT3), T, D, D}; pg8::StaticOrder S; S.init(T, D, G, bid);
        pg8::EpiBf16<0> E{(bf16*)(args.ws + WS_Q), D, nullptr, 0, 0, 1.f};
        pg8::gemm_phase<pg8::EpiBf16<0>, pg8::StaticOrder, PG8_ALIGN, PG8_SP2>(lds + RING_OFF, g, S, E);
    }
    SEAM(8);
    if (PHON(9) && IN(9)) { phase_s(args, lds, tid, lane, wave, bid, G); }
    SEAM(9);
    if (PHON(10) && IN(10)) { phase_pu(args, lane, wave, bid, G); }
    SEAM(10);
    if (PHON(11) && IN(11)) { phase_w(args, lane, wave, bid, G); }
    SEAM(11);
    if (PHON(12) && IN(12)) { phase_pv(args, lane, wave, bid, G); }
    SEAM(12);
    if (PHON(13) && IN(13)) { phase_f(args, lane, wave, bid, G); }
#undef IN
#undef SEAM
}

extern "C" void kernel_launch(void* const* d_in, const int* in_sizes, int n_in, void* d_out, int out_size, void* d_ws, size_t ws_size, hipStream_t stream) {
    static int grid = 0;
    if (grid == 0) {
        if (n_in != 25 || in_sizes[0] != T * D || out_size != T * D || ws_size < WS_END) {
            fprintf(stderr, "kernel_launch: built for 25 inputs, x/out of %d floats, >= %zu bytes of workspace; got n_in %d, in0 %d, out %d, ws %zu; nothing launched\n", T * D, (size_t)WS_END, n_in, n_in > 0 ? in_sizes[0] : -1, out_size, ws_size);
            grid = -1; return; }
        int dev = 0, cus = 0, per_cu = 0;
        if (hipGetDevice(&dev) != hipSuccess || hipDeviceGetAttribute(&cus, hipDeviceAttributeMultiprocessorCount, dev) != hipSuccess) { fprintf(stderr, "kernel_launch: device query failed\n"); grid = -1; return; }
        if (hipFuncSetAttribute((const void*)fwd_kernel, hipFuncAttributeMaxDynamicSharedMemorySize, LDS_BYTES) != hipSuccess) { fprintf(stderr, "kernel_launch: hipFuncSetAttribute failed\n"); grid = -1; return; }
        if (hipOccupancyMaxActiveBlocksPerMultiprocessor(&per_cu, (const void*)fwd_kernel, NTHR, LDS_BYTES) != hipSuccess || per_cu < 1)
            fprintf(stderr, "kernel_launch: note: occupancy query reports %d workgroups per CU\n", per_cu);
        (void)hipGetLastError();
        grid = cus;
    }
    if (grid < 0) return;
    if (hipMemsetAsync((char*)d_ws + WS_CTL, 0, CTL_ZERO_BYTES, stream) != hipSuccess) { fprintf(stderr, "kernel_launch: memset failed\n"); return; }
    Args a{};
    for (int i = 0; i < 25; ++i) a.in[i] = (const float*)d_in[i];
    a.out = (float*)d_out; a.ws = (unsigned char*)d_ws;
#if defined(MK_TIME_REP)
    const int cuts[3][2] = {{0, MK_TIME_REP + 1}, {MK_TIME_REP, MK_TIME_REP + 1}, {MK_TIME_REP + 1, N_PHASES}};
    for (int li = 0; li < 3; ++li) {
        a.ph_lo = cuts[li][0]; a.ph_hi = cuts[li][1]; a.li = li;
        if (a.ph_lo < a.ph_hi) hipLaunchKernelGGL(fwd_kernel, dim3(grid), dim3(NTHR), LDS_BYTES, stream, a);
    }
#else
    for (int li = 0; li < MK_N_LAUNCHES; ++li) {
        if (MK_N_LAUNCHES == 1) { a.ph_lo = 0; a.ph_hi = N_PHASES; } else { a.ph_lo = li; a.ph_hi = li + 1; }
        a.li = 0;
        hipLaunchKernelGGL(fwd_kernel, dim3(grid), dim3(NTHR), LDS_BYTES, stream, a);
        const hipError_t le = hipPeekAtLastError();
        if (le != hipSuccess) { fprintf(stderr, "kernel_launch: launch %d failed: %s\n", li, hipGetErrorName(le)); break; }
#if defined(MK_CHECKS)
        { const int chk_of_phase[N_PHASES] = {0, 1, 2, 3, 4, 6, 7, 8, 9, 10, 5, 5, 5, 11}; hipLaunchKernelGGL(chk_kernel, dim3(4), dim3(128), 0, stream, a, chk_of_phase[li]); }
#endif
    }
#endif
#if defined(MK_CHECKS)
    hipLaunchKernelGGL(chk_encode, dim3(1), dim3(64), 0, stream, a, MK_CHECKS);
#endif
}
```

```cpp
#include <hip/hip_runtime.h>
#include <cstdio>
#include <cstdint>
#include <cmath>
namespace pg8 {
#define PG8_LAS __attribute__((address_space(3)))
typedef unsigned short bf16_t;
typedef short bf16x8 __attribute__((ext_vector_type(8)));
typedef float f32x4 __attribute__((ext_vector_type(4)));
typedef unsigned u32x4 __attribute__((ext_vector_type(4)));
constexpr int BM = 256, BK = 64, HALF = 128, HTB = HALF * BK * 2  , STAGE_BYTES = 8 * HTB, NXCD = 8, WGM = 8;

__host__ __device__ __forceinline__ int lds_byte(int r, int c) { const int st = (r >> 4) * 2 + (c >> 5), rr = r & 15, cc = c & 31, ob = rr * 64 + cc * 2; return st * 1024 + (ob ^ (((ob >> 9) & 1) << 5)); }
__host__ __device__ __forceinline__ void stage_rc(int b, int& R, int& C) { const int st = b / 1024, sb = b % 1024, swz = sb ^ (((sb >> 9) & 1) << 5); R = (st >> 1) * 16 + swz / 64; C = (st & 1) * 32 + (swz % 64) / 2; }
__host__ __device__ __forceinline__ int perm32(int rho) { const int n = rho >> 4, i = rho & 15; return 8 * (i >> 2) + 4 * n + (i & 3); }

struct Unit { int pm, pn; };
struct Gemm { const bf16_t* A; const bf16_t* Bt; int M, N, K; };

struct StaticOrder {
    int nM, nN, nwg, G, c;
    __host__ __device__ void init(int M, int N, int G_, int c_) { nM = M / BM; nN = N / BM; nwg = nM * nN; G = G_; c = c_; }
    __host__ __device__ bool next(int i, Unit& u) const {
        const long L = (long)i * G + c; if (L >= nwg) return false;
        int wgid = (int)L; { const int q = nwg / NXCD, r = nwg % NXCD, xcd = wgid % NXCD, off = wgid / NXCD; wgid = (xcd < r ? xcd * (q + 1) : r * (q + 1) + (xcd - r) * q) + off; }
        const int nig = WGM * nN, gid = wgid / nig, fm = gid * WGM, gsz = (nM - fm) < WGM ? (nM - fm) : WGM;
        u.pm = fm + ((wgid % nig) % gsz); u.pn = (wgid % nig) / gsz; return true;
    }
    __device__ __forceinline__ void a_ready(const Unit&) const {}
    __device__ __forceinline__ void done(const Unit&) const {}
};

__device__ __forceinline__ unsigned cvt_pk_bf16(float lo, float hi) { unsigned r; asm volatile("v_cvt_pk_bf16_f32 %0, %1, %2" : "=v"(r) : "v"(lo), "v"(hi)); return r; }
typedef float f32x2 __attribute__((ext_vector_type(2)));
__device__ __forceinline__ f32x2 gelu_pk(f32x2 v) {
    const f32x2 av = __builtin_elementwise_abs(v), d = av * 0.2316418882f + 1.0f;
    f32x2 t; t.x = __builtin_amdgcn_rcpf(d.x); t.y = __builtin_amdgcn_rcpf(d.y);
    f32x2 q = t * 0.5307027145f + (-0.7265760135f); q = q * t + 0.7107068705f; q = q * t + (-0.142248368f); q = q * t + 0.127414796f; q = q * t;
    const f32x2 s = (v * v) * (-0.72134752044f);
    f32x2 e; e.x = __builtin_amdgcn_exp2f(s.x); e.y = __builtin_amdgcn_exp2f(s.y);
    const f32x2 m = v * (q * e), r = v - m;
    f32x2 o; o.x = v.x < 0.f ? m.x : r.x; o.y = v.y < 0.f ? m.y : r.y; return o;
}

template <int ACT  > struct EpiBf16 {
    static constexpr bool PERM = true, AFTER_DRAIN = false; static_assert(ACT == 0 || ACT == 1, "EpiBf16: ACT is 0 (none) or 1 (gelu_pk)");
    bf16_t* O; int ldc; const float* bias; int split_cols; size_t split_stride; float scale0;
    __device__ __forceinline__ void operator()(const f32x4 (&acc)[2][2][4][2], const Unit& u, int wr, int wc, int fr, int fq) const {
        const int row0 = u.pm * BM + wr * 64 + fr; int colt = u.pn * BM; bf16_t* base = O;
        float sc = 1.f; if (split_cols) { const int t = colt / split_cols; base += (size_t)t * split_stride; colt -= t * split_cols; if (t == 0) sc = scale0; }
        const int col0 = colt + wc * 32 + 8 * fq, bcol0 = u.pn * BM + wc * 32 + 8 * fq;
        f32x4 bv[2][2];
#pragma unroll
        for (int bj = 0; bj < 2; ++bj)
#pragma unroll
            for (int n = 0; n < 2; ++n) bv[bj][n] = bias ? *(const f32x4*)(bias + bcol0 + bj * HALF + 4 * n) : (f32x4){0.f, 0.f, 0.f, 0.f};
#pragma unroll
        for (int ai = 0; ai < 2; ++ai)
#pragma unroll
            for (int m = 0; m < 4; ++m) { bf16_t* rowp = base + (size_t)(row0 + ai * HALF + m * 16) * ldc + col0;
#pragma unroll
                for (int bj = 0; bj < 2; ++bj) { f32x4 v0 = acc[ai][bj][m][0] + bv[bj][0], v1 = acc[ai][bj][m][1] + bv[bj][1];
                    if (ACT == 1) { f32x2 a = gelu_pk((f32x2){v0[0], v0[1]}), b = gelu_pk((f32x2){v0[2], v0[3]}), c = gelu_pk((f32x2){v1[0], v1[1]}), d = gelu_pk((f32x2){v1[2], v1[3]});
                        v0 = (f32x4){a.x, a.y, b.x, b.y}; v1 = (f32x4){c.x, c.y, d.x, d.y}; }
                    v0 = v0 * sc; v1 = v1 * sc; u32x4 w; w.x = cvt_pk_bf16(v0[0], v0[1]); w.y = cvt_pk_bf16(v0[2], v0[3]); w.z = cvt_pk_bf16(v1[0], v1[1]); w.w = cvt_pk_bf16(v1[2], v1[3]);
                    *(u32x4*)(rowp + bj * HALF) = w; } }
    }
};
template <class Epi, class Sched, bool ALIGN_EPI = false, bool SP2 = false>
__device__ __forceinline__ void gemm_phase(PG8_LAS unsigned char* lds, const Gemm g, const Sched& S, const Epi& E) {
    const int tid = threadIdx.x, wid = __builtin_amdgcn_readfirstlane(tid >> 6), lane = tid & 63, wr = wid >> 2, wc = wid & 3, fr = lane & 15, fq = lane >> 4;
    const int K = g.K, nt = K / BK;
    unsigned voffA[2], voffB[2];
#pragma unroll
    for (int i = 0; i < 2; ++i) { int R, C; stage_rc(tid * 16 + i * 8192, R, C); const int Rb = Epi::PERM ? ((R & ~31) + perm32(R & 31)) : R;
        voffA[i] = (unsigned)(R * K + C) * 2u; voffB[i] = (unsigned)(Rb * K + C) * 2u; }
    const size_t kstep = (size_t)(BK * 2);
    const size_t hstep = (size_t)HALF * K * 2;
    const size_t tstep = 2 * hstep;
    const unsigned ldsw = (unsigned)wid * 1024u;
    const int aoff = lds_byte(wr * 64 + fr, fq * 8), boff = lds_byte(wc * 32 + fr, fq * 8);
#define PG8_SA(b, h) (((b) * 2 + (h)) * HTB)
#define PG8_SB(b, h) ((4 + (b) * 2 + (h)) * HTB)
#define PG8_STAGE(bufoff, gbase, voff) do { _Pragma("unroll") for (int _i = 0; _i < 2; ++_i) \
        __builtin_amdgcn_global_load_lds((const unsigned*)((const char*)(gbase) + (voff)[_i]), (PG8_LAS unsigned*)(lds + (bufoff) + ldsw + _i * 8192), 16, 0, 0); } while (0)
#define PG8_LDA(dst, b, h) do { _Pragma("unroll") for (int m = 0; m < 4; ++m) _Pragma("unroll") for (int k = 0; k < 2; ++k) dst[m][k] = *(const PG8_LAS bf16x8*)(lds + PG8_SA(b, h) + aoff + m * 2048 + k * 1024); } while (0)
#define PG8_LDB(dst, b, h) do { _Pragma("unroll") for (int n = 0; n < 2; ++n) _Pragma("unroll") for (int k = 0; k < 2; ++k) dst[n][k] = *(const PG8_LAS bf16x8*)(lds + PG8_SB(b, h) + boff + n * 2048 + k * 1024); } while (0)
#define PG8_MMA(ai, bj, At, Bt) do { __builtin_amdgcn_s_setprio(1); _Pragma("unroll") for (int m = 0; m < 4; ++m) _Pragma("unroll") for (int n = 0; n < 2; ++n) _Pragma("unroll") for (int k = 0; k < 2; ++k) \
        acc[ai][bj][m][n] = __builtin_amdgcn_mfma_f32_16x16x32_bf16(Bt[n][k], At[m][k], acc[ai][bj][m][n], 0, 0, 0); __builtin_amdgcn_s_setprio(0); } while (0)
#define PG8_WAIT_V(n) asm volatile("s_waitcnt vmcnt(" #n ")" ::: "memory")
#define PG8_WAIT_L(n) asm volatile("s_waitcnt lgkmcnt(" #n ")" ::: "memory")
#define PG8_BAR __builtin_amdgcn_s_barrier()
#define PG8_SCHED __builtin_amdgcn_sched_barrier(0)
    Unit cur, nxt; int ui = 0;
    if (!S.next(0, cur)) return;
    f32x4 acc[2][2][4][2];
#pragma unroll
    for (int a = 0; a < 2; ++a)
#pragma unroll
        for (int b = 0; b < 2; ++b)
#pragma unroll
            for (int m = 0; m < 4; ++m)
#pragma unroll
                for (int n = 0; n < 2; ++n) acc[a][b][m][n] = (f32x4){0.f, 0.f, 0.f, 0.f};
    bf16x8 At[4][2], B0[2][2], B1[2][2];
    const char* cA = (const char*)g.A + (size_t)cur.pm * tstep; const char* cB = (const char*)g.Bt + (size_t)cur.pn * tstep;
    S.a_ready(cur);
    if constexpr (SP2) {
        PG8_STAGE(PG8_SB(0, 0), cB, voffB); PG8_STAGE(PG8_SB(0, 1), cB + hstep, voffB); PG8_STAGE(PG8_SA(0, 0), cA, voffA); PG8_STAGE(PG8_SA(0, 1), cA + hstep, voffA);
        if (wr == 1) PG8_BAR;
        PG8_WAIT_V(2); PG8_BAR;
        PG8_STAGE(PG8_SB(1, 0), cB + kstep, voffB); PG8_STAGE(PG8_SA(1, 0), cA + kstep, voffA); PG8_STAGE(PG8_SB(1, 1), cB + hstep + kstep, voffB);
        PG8_WAIT_V(6); PG8_BAR;
    } else {
        PG8_STAGE(PG8_SB(0, 0), cB, voffB); PG8_STAGE(PG8_SA(0, 0), cA, voffA); PG8_STAGE(PG8_SB(0, 1), cB + hstep, voffB); PG8_STAGE(PG8_SA(0, 1), cA + hstep, voffA);
        if (wr == 1) PG8_BAR;
        PG8_WAIT_V(4); PG8_BAR;
        PG8_STAGE(PG8_SB(1, 0), cB + kstep, voffB); PG8_STAGE(PG8_SA(1, 0), cA + kstep, voffA); PG8_STAGE(PG8_SB(1, 1), cB + hstep + kstep, voffB);
        PG8_WAIT_V(6); PG8_BAR;
    }
    for (;;) {
        const bool has_next = S.next(ui + 1, nxt);
        const char* nA = has_next ? (const char*)g.A + (size_t)nxt.pm * tstep : cA; const char* nB = has_next ? (const char*)g.Bt + (size_t)nxt.pn * tstep : cB;
        for (int t = 0; t < nt; t += 2) {
            const bool last = (t == nt - 2);
            const char* a1 = cA + (size_t)(t + 1) * kstep;
            const char* a2 = last ? nA : cA + (size_t)(t + 2) * kstep; const char* b2 = last ? nB : cB + (size_t)(t + 2) * kstep;
            const char* a3 = a2 + kstep; const char* b3 = b2 + kstep;
            if (last && has_next) S.a_ready(nxt);
            if constexpr (SP2) {
            PG8_LDB(B0, 0, 0); PG8_LDB(B1, 0, 1); PG8_SCHED; PG8_LDA(At, 0, 0); PG8_STAGE(PG8_SA(1, 1), a1 + hstep, voffA);
            PG8_WAIT_V(8); PG8_WAIT_L(0); PG8_BAR; PG8_MMA(0, 0, At, B0); PG8_MMA(0, 1, At, B1); PG8_BAR; PG8_SCHED;
            PG8_LDA(At, 0, 1); PG8_STAGE(PG8_SB(0, 0), b2, voffB); PG8_STAGE(PG8_SB(0, 1), b2 + hstep, voffB); PG8_STAGE(PG8_SA(0, 0), a2, voffA);
            PG8_WAIT_V(8); PG8_WAIT_L(0); PG8_BAR; PG8_MMA(1, 0, At, B0); PG8_MMA(1, 1, At, B1); PG8_BAR; PG8_SCHED;
            PG8_LDB(B0, 1, 0); PG8_LDB(B1, 1, 1); PG8_SCHED; PG8_LDA(At, 1, 0); PG8_STAGE(PG8_SA(0, 1), a2 + hstep, voffA);
            PG8_WAIT_V(8); PG8_WAIT_L(0); PG8_BAR; PG8_MMA(0, 0, At, B0); PG8_MMA(0, 1, At, B1); PG8_BAR; PG8_SCHED;
            PG8_LDA(At, 1, 1); PG8_STAGE(PG8_SB(1, 0), b3, voffB); PG8_STAGE(PG8_SB(1, 1), b3 + hstep, voffB); PG8_STAGE(PG8_SA(1, 0), a3, voffA);
            PG8_WAIT_V(8); PG8_WAIT_L(0); PG8_BAR; PG8_MMA(1, 0, At, B0); PG8_MMA(1, 1, At, B1); PG8_BAR; PG8_SCHED;
            } else {
            PG8_LDB(B0, 0, 0); PG8_SCHED; PG8_LDA(At, 0, 0); PG8_STAGE(PG8_SA(1, 1), a1 + hstep, voffA);
            PG8_WAIT_L(8); PG8_BAR; PG8_WAIT_L(0); PG8_MMA(0, 0, At, B0); PG8_BAR; PG8_SCHED;
            PG8_LDB(B1, 0, 1); PG8_STAGE(PG8_SB(0, 0), b2, voffB);
            PG8_BAR; PG8_WAIT_L(0); PG8_MMA(0, 1, At, B1); PG8_BAR;
            PG8_LDA(At, 0, 1); PG8_STAGE(PG8_SA(0, 0), a2, voffA);
            PG8_BAR; PG8_WAIT_L(0); PG8_MMA(1, 0, At, B0); PG8_BAR; PG8_SCHED;
            PG8_STAGE(PG8_SB(0, 1), b2 + hstep, voffB);
            PG8_WAIT_V(6); PG8_BAR; PG8_MMA(1, 1, At, B1); PG8_BAR;
            PG8_LDB(B0, 1, 0); PG8_SCHED; PG8_LDA(At, 1, 0); PG8_STAGE(PG8_SA(0, 1), a2 + hstep, voffA);
            PG8_WAIT_L(8); PG8_BAR; PG8_WAIT_L(0); PG8_MMA(0, 0, At, B0); PG8_BAR; PG8_SCHED;
            PG8_LDB(B1, 1, 1); PG8_STAGE(PG8_SB(1, 0), b3, voffB);
            PG8_BAR; PG8_WAIT_L(0); PG8_MMA(0, 1, At, B1); PG8_BAR;
            PG8_LDA(At, 1, 1); PG8_STAGE(PG8_SA(1, 0), a3, voffA);
            PG8_BAR; PG8_WAIT_L(0); PG8_MMA(1, 0, At, B0); PG8_BAR; PG8_SCHED;
            PG8_STAGE(PG8_SB(1, 1), b3 + hstep, voffB);
            PG8_WAIT_V(6); PG8_BAR; PG8_MMA(1, 1, At, B1); PG8_BAR;
            }
        }
        if constexpr (ALIGN_EPI) { if (wr == 0) PG8_BAR; }
        if constexpr (!Epi::AFTER_DRAIN) { E(acc, cur, wr, wc, fr, fq); S.done(cur); }
        if (!has_next) break;
#pragma unroll
        for (int a = 0; a < 2; ++a)
#pragma unroll
            for (int b = 0; b < 2; ++b)
#pragma unroll
                for (int m = 0; m < 4; ++m)
#pragma unroll
                    for (int n = 0; n < 2; ++n) acc[a][b][m][n] = (f32x4){0.f, 0.f, 0.f, 0.f};
        cur = nxt; cA = nA; cB = nB; ++ui;
        if constexpr (ALIGN_EPI) { if (wr == 1) PG8_BAR; }
    }
    PG8_WAIT_V(0);
    if constexpr (!ALIGN_EPI) { if (wr == 0) PG8_BAR; }
    PG8_BAR;
    if constexpr (Epi::AFTER_DRAIN) { E.fused(acc, cur, wr, wc, fr, fq, lds, wid, lane); S.done(cur); }
#undef PG8_SA
#undef PG8_SB
#undef PG8_STAGE
#undef PG8_LDA
#undef PG8_LDB
#undef PG8_MMA
#undef PG8_WAIT_V
#undef PG8_WAIT_L
#undef PG8_BAR
#undef PG8_SCHED
}
}
#ifndef PG8_SP2
#define PG8_SP2 true
#endif
#ifndef PG8_ALIGN
#define PG8_ALIGN true
#endif
#ifndef OUT_MODE
#define OUT_MODE 0
#endif
#ifndef REP_MASK
#define REP_MASK 0
#endif
#ifndef S_CONV
#define S_CONV 1
#endif
#ifndef M3_RW
#define M3_RW 2
#endif
#ifndef PU_RSHIFT
#define PU_RSHIFT 11
#endif
#ifndef PU_NB
#define PU_NB 6
#endif
#ifndef PVQ_RB
#define PVQ_RB 16
#endif
#ifndef PUQ_RB
#define PUQ_RB 16
#endif
#ifndef PE_SORT
#define PE_SORT 1
#endif
#ifndef PH_MASK
#define PH_MASK 0xFFFFF
#endif
#ifndef MK_N_LAUNCHES
#define MK_N_LAUNCHES 1
#endif

constexpr int NWAVES = 8, NTHR = NWAVES * 64;
constexpr int BATCH = 2, SEQ = 8192, D = 2048, T = BATCH * SEQ;
constexpr int LRU_W = 1024, CONF_W = 1024, IN_COLS = 4096, LRU_HD = 128;
constexpr int NH = 8, NKEY = 128, TOPK = 16, NEXP = NKEY * NKEY, KSEL = NH * TOPK;
constexpr int NMOD = 6 * D;
constexpr int CHUNK = 64, NCHUNK = SEQ / CHUNK;
constexpr int CONF_K = 31;
constexpr float EPS = 1e-6f;
constexpr int N_PHASES = 13;

constexpr size_t MiB = 1u << 20;
constexpr size_t WS_CTL = 0, CTL_ZERO_BYTES = 64 * 1024;
constexpr size_t WS_MODP = 1 * MiB;
constexpr size_t WS_CFIN = 2 * MiB;
constexpr size_t WS_CARRY = 3 * MiB;
constexpr size_t WS_AGG = 4 * MiB;
constexpr size_t WS_WG = 6 * MiB;
constexpr size_t WS_SUBK = 7 * MiB;
constexpr size_t WS_BT1 = 8 * MiB;
constexpr size_t WS_BT2 = 24 * MiB;
constexpr size_t WS_BT3 = 32 * MiB;
constexpr size_t WS_IDX = 40 * MiB;
constexpr size_t WS_GATE = 48 * MiB;
constexpr size_t WS_USC = 56 * MiB;
constexpr size_t WS_VSC = 57 * MiB;
constexpr size_t WS_RA = 64 * MiB;
constexpr size_t WS_Y1 = 128 * MiB;
constexpr size_t WS_PROJ = 192 * MiB;
constexpr size_t WS_Q = 192 * MiB;
constexpr size_t WS_UB = 256 * MiB;
constexpr size_t WS_XL = 320 * MiB;
constexpr size_t WS_ZC = 352 * MiB;
constexpr size_t WS_Y2 = 384 * MiB;
constexpr size_t WS_SSQ = 58 * MiB;
constexpr size_t WS_HLOC = 384 * MiB;
constexpr size_t WS_PC = 416 * MiB;
constexpr size_t WS_VB = 320 * MiB;
constexpr size_t WS_ACTP = 192 * MiB;
constexpr size_t WS_ACT = 448 * MiB;
constexpr size_t WS_H2Q = 456 * MiB;
constexpr size_t WS_HSC = 488 * MiB;
constexpr size_t WS_END = 489 * MiB;
constexpr int CW_TMO = 0, CW_BAR = 4096;

constexpr int RING_OFF = 0, RING_BYTES = 131072;
constexpr int LDSCTL_OFF = 146432, MISC_OFF = LDSCTL_OFF + 320;
constexpr int LDS_BYTES = 147456;

#define GAS __attribute__((address_space(1)))
#define LAS __attribute__((address_space(3)))
typedef unsigned short bf16;
typedef unsigned v4u __attribute__((ext_vector_type(4)));
typedef unsigned v2u __attribute__((ext_vector_type(2)));
typedef float f32x4 __attribute__((ext_vector_type(4)));
typedef float f32x16 __attribute__((ext_vector_type(16)));
typedef float f32x2 __attribute__((ext_vector_type(2)));
typedef short bf16x8 __attribute__((ext_vector_type(8)));
typedef __bf16 bfp2 __attribute__((ext_vector_type(2)));
typedef GAS unsigned gu32;
#define RLX_AGENT __ATOMIC_RELAXED, __HIP_MEMORY_SCOPE_AGENT
#define LDS_WAIT() asm volatile("s_waitcnt lgkmcnt(0)" ::: "memory")
#define VM_WAIT() asm volatile("s_waitcnt vmcnt(0)" ::: "memory")
__device__ __forceinline__ unsigned f2bf(float f) { unsigned u = __builtin_bit_cast(unsigned, f); return (u + 0x7fffu + ((u >> 16) & 1u)) >> 16; }
__device__ __forceinline__ unsigned pk2(float lo, float hi) { return f2bf(lo) | (f2bf(hi) << 16); }
__device__ __forceinline__ float bflo(unsigned u) { return __builtin_bit_cast(float, u << 16); }
__device__ __forceinline__ float bfhi(unsigned u) { return __builtin_bit_cast(float, u & 0xffff0000u); }
__device__ __forceinline__ float wave_sum(float v) {
#pragma unroll
    for (int o = 1; o < 64; o <<= 1) v += __shfl_xor(v, o);
    return v;
}
__device__ __forceinline__ float dpp_sum63(float v) {
    v += __builtin_bit_cast(float, __builtin_amdgcn_update_dpp(0, __builtin_bit_cast(int, v), 0xB1, 0xF, 0xF, false));
    v += __builtin_bit_cast(float, __builtin_amdgcn_update_dpp(0, __builtin_bit_cast(int, v), 0x4E, 0xF, 0xF, false));
    v += __builtin_bit_cast(float, __builtin_amdgcn_update_dpp(0, __builtin_bit_cast(int, v), 0x141, 0xF, 0xF, false));
    v += __builtin_bit_cast(float, __builtin_amdgcn_update_dpp(0, __builtin_bit_cast(int, v), 0x140, 0xF, 0xF, false));
    v += __builtin_bit_cast(float, __builtin_amdgcn_update_dpp(0, __builtin_bit_cast(int, v), 0x142, 0xA, 0xF, false));
    v += __builtin_bit_cast(float, __builtin_amdgcn_update_dpp(0, __builtin_bit_cast(int, v), 0x143, 0xC, 0xF, false));
    return v;
}

__device__ __forceinline__ float sigmoidf_(float x) { return __builtin_amdgcn_rcpf(1.0f + __expf(-x)); }
__device__ __forceinline__ float gelu_tanh(float x) { return x * sigmoidf_(1.5957691216057308f * (x + 0.044715f * x * x * x)); }
__device__ __forceinline__ float rdlane(float v, int l) { return __builtin_bit_cast(float, __builtin_amdgcn_readlane(__builtin_bit_cast(int, v), l)); }
__device__ __forceinline__ float wave_total(float v) { return rdlane(dpp_sum63(v), 63); }

#define XB_TMO      128
#define XB_XCNT(j)  (256  + 64 * (j))
#define XB_XSUB(j)  (1280 + 64 * (j))
#define XB_XGEN(j)  (2304 + 64 * (j))
#define XB_TOP      3328
#define XB_TOPGEN   3392
#define XCD_BAR_WORDS 3456
#define XB_SPIN_CAP (1u << 18)

__device__ __forceinline__ unsigned xb_ld(unsigned* p)              { return __hip_atomic_load(p, __ATOMIC_RELAXED, __HIP_MEMORY_SCOPE_AGENT); }
__device__ __forceinline__ unsigned xb_add(unsigned* p, unsigned v) { return __hip_atomic_fetch_add(p, v, __ATOMIC_RELAXED, __HIP_MEMORY_SCOPE_AGENT); }
__device__ __forceinline__ unsigned xb_xcc_id() { return (unsigned)__builtin_amdgcn_s_getreg((3 << 11) | 20) & 0xFu; }
#define XB_SPIN(cond, bar) do { unsigned _sp = 0; while (cond) { __builtin_amdgcn_s_sleep(1); \
    if ((++_sp & 255u) == 0u) { if (xb_ld(&(bar)[XB_TMO])) break; if (_sp > XB_SPIN_CAP) { atomicAdd(&(bar)[XB_TMO], 1u); break; } } } } while (0)

struct XcdBarrier {
    unsigned* bar; unsigned x;
    volatile LAS unsigned* st;
};

__device__ __forceinline__ XcdBarrier xcd_barrier_post(unsigned* bar, volatile LAS unsigned* st) {
    XcdBarrier b; b.bar = bar; b.x = xb_xcc_id(); b.st = st;
    if (threadIdx.x == 0) (void)xb_add(&bar[XB_XCNT(b.x)], 1u);
    return b;
}
__device__ __forceinline__ void xcd_barrier_complete(unsigned* bar, unsigned x, unsigned& nloc, unsigned& nx) {
    const unsigned G = gridDim.x * gridDim.y * gridDim.z;
    unsigned sum, cnt, mine, sp = 0u;
    for (;;) {
        sum = 0u; cnt = 0u; mine = 0u;
#pragma unroll
        for (unsigned j = 0; j < 16; ++j) { const unsigned c = xb_ld(&bar[XB_XCNT(j)]); sum += c; cnt += (c > 0u) ? 1u : 0u; mine = (j == x) ? c : mine; }
        if (sum == G) break;
        __builtin_amdgcn_s_sleep(1);
        if ((++sp & 255u) == 0u) { if (xb_ld(&bar[XB_TMO])) break; if (sp > XB_SPIN_CAP) { atomicAdd(&bar[XB_TMO], 1u); break; } }
    }
    nloc = mine > 0u ? mine : 1u; nx = cnt > 0u ? cnt : 1u;
}

__device__ __forceinline__ void xcd_barrier(const XcdBarrier& b) {
    asm volatile("s_waitcnt vmcnt(0)" ::: "memory");
    __syncthreads();
    if (threadIdx.x == 0) {
        unsigned* bar = b.bar;
        __builtin_amdgcn_s_waitcnt(0);
        unsigned nloc = b.st[0], nx = b.st[1];
        if (nloc == 0u) { xcd_barrier_complete(bar, b.x, nloc, nx); b.st[0] = nloc; b.st[1] = nx; }
        const unsigned old = xb_add(&bar[XB_XSUB(b.x)], 1u);
        const unsigned gen = old / nloc;
        if (old + 1u == (gen + 1u) * nloc) {
            __builtin_amdgcn_fence(__ATOMIC_RELEASE, "agent");
            asm volatile("s_waitcnt vmcnt(0)" ::: "memory");
            const unsigned og = xb_add(&bar[XB_TOP], 1u);
            const unsigned tg = og / nx;
            if (og + 1u == (tg + 1u) * nx) xb_add(&bar[XB_TOPGEN], 1u);
            else XB_SPIN(xb_ld(&bar[XB_TOPGEN]) == tg, bar);
            __builtin_amdgcn_fence(__ATOMIC_ACQUIRE, "agent");
            xb_add(&bar[XB_XGEN(b.x)], 1u);
            asm volatile("s_waitcnt vmcnt(0)" ::: "memory");
        } else {
            XB_SPIN(xb_ld(&bar[XB_XGEN(b.x)]) == gen, bar);
            __builtin_amdgcn_fence(__ATOMIC_ACQUIRE, "agent");
            asm volatile("s_waitcnt vmcnt(0)" ::: "memory");
        }
    }
    __syncthreads();
}
struct Args { const float* in[25]; float* out; unsigned char* ws; int ph_lo, ph_hi, li, pad; };
enum { I_X = 0, I_C, I_WMOD, I_BMOD, I_GPREMIX, I_GPOSTMIX, I_GPREFFN, I_GPOSTFFN, I_WIN, I_LCW, I_LCB, I_WA, I_BA, I_WX, I_BX, I_LAMBDA,
       I_CDW, I_CDB, I_LNG, I_LNB, I_WOUT, I_WQ, I_SUBK, I_PU, I_PV };

__device__ __forceinline__ float mod_at(const float* modp, int b, int n) {
    return (modp[(0 * 2 + b) * NMOD + n] + modp[(1 * 2 + b) * NMOD + n]) + (modp[(2 * 2 + b) * NMOD + n] + modp[(3 * 2 + b) * NMOD + n]);
}

__device__ __forceinline__ void p0_transpose_item(const float* W, int K, int N, bf16* WT, LAS float* scr, int item, int lane) {
    const int nblk = N / 32, kb = item / nblk, nb = item % nblk, k0 = 64 * kb, n0 = 32 * nb;
#pragma unroll 8
    for (int i = 0; i < 32; ++i) { const int kk = 2 * i + (lane >> 5); scr[kk * 33 + (lane & 31)] = W[(size_t)(k0 + kk) * N + n0 + (lane & 31)]; }
    LDS_WAIT(); asm volatile("" ::: "memory");
    const int c = lane & 7;
#pragma unroll
    for (int j = 0; j < 4; ++j) { const int n = (lane >> 3) + 8 * j; const LAS float* s = scr + (8 * c) * 33 + n;
        v4u o; o.x = pk2(s[0 * 33], s[1 * 33]); o.y = pk2(s[2 * 33], s[3 * 33]); o.z = pk2(s[4 * 33], s[5 * 33]); o.w = pk2(s[6 * 33], s[7 * 33]);
        *(GAS v4u*)(WT + (size_t)(n0 + n) * K + k0 + 8 * c) = o; }
    LDS_WAIT(); asm volatile("" ::: "memory");
}
__device__ __forceinline__ void cvt_rows_bf16(const float* src, bf16* dst, size_t n8, size_t gt, size_t ngt) {
    for (size_t i = gt; i < n8; i += ngt) {
        const f32x4 a = ((const GAS f32x4*)src)[2 * i], b = ((const GAS f32x4*)src)[2 * i + 1];
        v4u o; o.x = pk2(a.x, a.y); o.y = pk2(a.z, a.w); o.z = pk2(b.x, b.y); o.w = pk2(b.z, b.w);
        ((GAS v4u*)dst)[i] = o; }
}
__device__ __forceinline__ void phase_p0(const Args& A, LAS unsigned char* lds, int tid, int lane, int wave, int bid, int G) {
    float* modp = (float*)(A.ws + WS_MODP);
    for (int item = bid; item < 192; item += G) {
        const int cg = item % 48, kq = item / 48, k0 = kq * 512 + wave * 64, n0 = cg * 256 + lane * 4;
        const float c0 = A.in[I_C][k0 + lane], c1 = A.in[I_C][D + k0 + lane];
        const float ca0 = c0 * sigmoidf_(c0), ca1 = c1 * sigmoidf_(c1);
        f32x4 a0 = {0.f, 0.f, 0.f, 0.f}, a1 = {0.f, 0.f, 0.f, 0.f};
        const float* wp = A.in[I_WMOD] + (size_t)k0 * NMOD + n0;
#pragma unroll 8
        for (int kk = 0; kk < 64; ++kk) {
            const f32x4 w = *(const GAS f32x4*)(wp + (size_t)kk * NMOD);
            const float s0 = __shfl(ca0, kk), s1 = __shfl(ca1, kk);
            a0 += w * s0; a1 += w * s1;
        }
        LAS f32x4* red = (LAS f32x4*)lds;
        red[(wave * 2 + 0) * 64 + lane] = a0; red[(wave * 2 + 1) * 64 + lane] = a1;
        __syncthreads();
        { const int b = tid >> 8, col = tid & 255; const LAS float* rf = (const LAS float*)lds; float s = 0.f;
#pragma unroll
          for (int w = 0; w < 8; ++w) s += rf[((w * 2 + b) * 64) * 4 + col];
          if (kq == 0) s += A.in[I_BMOD][cg * 256 + col];
          modp[(kq * 2 + b) * NMOD + cg * 256 + col] = s; }
        __syncthreads();
    }
    {
        LAS float* scr = (LAS float*)(lds + wave * 16384);
        const int gw = bid * NWAVES + wave, NGW = G * NWAVES;
        constexpr int I1 = (D / 64) * (IN_COLS / 32), I2 = (D / 64) * (D / 32);
        for (int it = gw; it < I1 + 2 * I2; it += NGW) {
            int r = it;
            if (r < I1) { p0_transpose_item(A.in[I_WIN], D, IN_COLS, (bf16*)(A.ws + WS_BT1), scr, r, lane); continue; } r -= I1;
            if (r < I2) { p0_transpose_item(A.in[I_WOUT], D, D, (bf16*)(A.ws + WS_BT2), scr, r, lane); continue; } r -= I2;
            p0_transpose_item(A.in[I_WQ], D, D, (bf16*)(A.ws + WS_BT3), scr, r, lane);
        }
    }
    {
        const int gt = bid * NTHR + tid, ngt = G * NTHR;
        bf16* wg = (bf16*)(A.ws + WS_WG);
        for (int e = gt; e < NH * 256 * 128; e += ngt) {
            const int h = e >> 15, n = (e >> 7) & 255, k = e & 127;
            const float v = (n < 128 ? A.in[I_WA] : A.in[I_WX])[h * 16384 + k * 128 + (n & 127)];
            wg[e] = (bf16)f2bf(v);
        }
        cvt_rows_bf16(A.in[I_SUBK], (bf16*)(A.ws + WS_SUBK), (size_t)NH * 2 * NKEY * 128 / 8, gt, ngt);
    }
}

__device__ __forceinline__ void phase_p1(const Args& A, int tid, int lane, int wave, int bid, int G) {
    const float* modp = (const float*)(A.ws + WS_MODP);
    {
        float* cfin = (float*)(A.ws + WS_CFIN);
        for (int e = bid * NTHR + tid; e < 2 * 2 * D; e += G * NTHR) {
            const int b = e >> 12, arr = (e >> 11) & 1, col = e & (D - 1);
            cfin[e] = arr == 0 ? mod_at(modp, b, 2 * D + col) * A.in[I_GPOSTMIX][col] : mod_at(modp, b, 5 * D + col) * A.in[I_GPOSTFFN][col];
        }
        float* cfe = (float*)(A.ws + WS_CFIN) + 4 * D;
        for (int e = bid * NTHR + tid; e < 2 * 2 * D; e += G * NTHR) {
            const int b = e >> 12, arr = (e >> 11) & 1, col = e & (D - 1);
            cfe[e] = arr == 0 ? A.in[I_GPREFFN][col] * (1.0f + mod_at(modp, b, 4 * D + col)) : mod_at(modp, b, 3 * D + col);
        }
    }
    const int gw = bid * NWAVES + wave, NGW = G * NWAVES;
    bf16* h1 = (bf16*)(A.ws + WS_RA);
    int cb = -1; float gs[4][8], sh[4][8];
    for (int row = gw; row < T; row += NGW) {
        const int b = row >> 13;
        if (b != cb) { cb = b;
#pragma unroll
            for (int j = 0; j < 4; ++j)
#pragma unroll
                for (int e = 0; e < 8; ++e) { const int col = j * 512 + lane * 8 + e;
                    gs[j][e] = A.in[I_GPREMIX][col] * (1.0f + mod_at(modp, b, D + col)); sh[j][e] = mod_at(modp, b, col); } }
        const GAS f32x4* xr = (const GAS f32x4*)(A.in[I_X] + (size_t)row * D) + lane * 2;
        f32x4 v[4][2]; float s = 0.f;
#pragma unroll
        for (int j = 0; j < 4; ++j) { v[j][0] = xr[j * 128]; v[j][1] = xr[j * 128 + 1];
            s += (v[j][0].x * v[j][0].x + v[j][0].y * v[j][0].y) + (v[j][0].z * v[j][0].z + v[j][0].w * v[j][0].w);
            s += (v[j][1].x * v[j][1].x + v[j][1].y * v[j][1].y) + (v[j][1].z * v[j][1].z + v[j][1].w * v[j][1].w); }
        const float rstd = __builtin_amdgcn_rsqf(wave_total(s) * (1.0f / D) + EPS);
        GAS v4u* orow = (GAS v4u*)(h1 + (size_t)row * D) + lane;
#pragma unroll
        for (int j = 0; j < 4; ++j) { float o[8];
#pragma unroll
            for (int e = 0; e < 8; ++e) o[e] = v[j][e >> 2][e & 3] * rstd * gs[j][e] + sh[j][e];
            v4u w; w.x = pk2(o[0], o[1]); w.y = pk2(o[2], o[3]); w.z = pk2(o[4], o[5]); w.w = pk2(o[6], o[7]);
            orow[j * 64] = w; }
    }
}

__device__ __forceinline__ void m1a_tile_issue(const bf16* proj, int item, int tid, v4u (&rv)[5], v4u (&rg)[5]) {
    const int b = item >> 9, tt = (item >> 3) & 63, ct = item & 7, t0 = tt * 128;
#pragma unroll
    for (int i = 0; i < 5; ++i) {
        const int e = tid + i * NTHR, r = e >> 4, c8 = (e & 15) * 8, t = t0 - 30 + r;
        rv[i] = (v4u){0u, 0u, 0u, 0u}; rg[i] = (v4u){0u, 0u, 0u, 0u};
        if (e < 158 * 16 && t >= 0) { const bf16* p = proj + (size_t)(b * SEQ + t) * IN_COLS + 2048 + ct * 128 + c8; rv[i] = *(const GAS v4u*)p; rg[i] = *(const GAS v4u*)(p + 1024); }
    }
}
__device__ __forceinline__ void phase_m1a(const Args& A, LAS unsigned char* lds, int tid, int lane, int wave, int bid, int G) {
    const bf16* proj = (const bf16*)(A.ws + WS_PROJ);
    {
        bf16* zc = (bf16*)(A.ws + WS_ZC);
        const float* w31 = A.in[I_CDW]; const float* b31 = A.in[I_CDB];
        LAS float* zt = (LAS float*)lds;
        const int cp = tid & 63, tg = tid >> 6;
        v4u rv[5], rg[5];
        int item = bid;
        if (item < 2 * 64 * 8) m1a_tile_issue(proj, item, tid, rv, rg);
        float w0[CONF_K], w1[CONF_K], bias0 = 0.f, bias1 = 0.f; int wct = -1;
        for (; item < 2 * 64 * 8; item += G) {
            const int b = item >> 9, tt = (item >> 3) & 63, ct = item & 7, t0 = tt * 128, ch = ct * 128 + 2 * cp;
            if (ct != wct) { wct = ct;
#pragma unroll
                for (int j = 0; j < CONF_K; ++j) { const f32x2 ww = *(const GAS f32x2*)(w31 + j * CONF_W + ch); w0[j] = ww.x; w1[j] = ww.y; }
                const f32x2 bw = *(const GAS f32x2*)(b31 + ch); bias0 = bw.x; bias1 = bw.y; }
            __syncthreads();
#pragma unroll
            for (int i = 0; i < 5; ++i) {
                const int e = tid + i * NTHR, r = e >> 4, c8 = (e & 15) * 8;
                if (e < 158 * 16) { const v4u v = rv[i], g = rg[i]; f32x4 z0, z1;
                    z0.x = bflo(v.x) * sigmoidf_(bflo(g.x)); z0.y = bfhi(v.x) * sigmoidf_(bfhi(g.x)); z0.z = bflo(v.y) * sigmoidf_(bflo(g.y)); z0.w = bfhi(v.y) * sigmoidf_(bfhi(g.y));
                    z1.x = bflo(v.z) * sigmoidf_(bflo(g.z)); z1.y = bfhi(v.z) * sigmoidf_(bfhi(g.z)); z1.z = bflo(v.w) * sigmoidf_(bflo(g.w)); z1.w = bfhi(v.w) * sigmoidf_(bfhi(g.w));
                    *(LAS f32x4*)(zt + r * 128 + c8) = z0; *(LAS f32x4*)(zt + r * 128 + c8 + 4) = z1; }
            }
            __syncthreads();
            if (item + G < 2 * 64 * 8) m1a_tile_issue(proj, item + G, tid, rv, rg);
            float a0[16], a1[16];
#pragma unroll
            for (int i = 0; i < 16; ++i) { a0[i] = bias0; a1[i] = bias1; }
#pragma unroll
            for (int s_ = 0; s_ < 46; ++s_) {
                const f32x2 v = *(const LAS f32x2*)(zt + (tg * 16 + s_) * 128 + 2 * cp);
#pragma unroll
                for (int i = 0; i < 16; ++i) if (s_ - i >= 0 && s_ - i < CONF_K) { a0[i] += w0[s_ - i] * v.x; a1[i] += w1[s_ - i] * v.y; }
            }
            bf16* zo = zc + (size_t)(b * SEQ + t0 + tg * 16) * CONF_W + ch;
#pragma unroll
            for (int i = 0; i < 16; ++i) *(GAS unsigned*)(zo + (size_t)i * CONF_W) = pk2(a0[i], a1[i]);
        }
        __syncthreads();
    }
}

template <int CTRL> __device__ __forceinline__ float dpp_shr(float v, float ident) {
    return __builtin_bit_cast(float, __builtin_amdgcn_update_dpp(__builtin_bit_cast(int, ident), __builtin_bit_cast(int, v), CTRL, 0xF, 0xF, false));
}
constexpr int XT_PITCH = 2064;   static_assert(64 * 2064 <= LDSCTL_OFF, "xl tile vs LDS control words");
__device__ __forceinline__ void phase_m1b(const Args& A, LAS unsigned char* lds, int tid, int lane, int wave, int bid, int G) {
    const bf16* proj = (const bf16*)(A.ws + WS_PROJ); const bf16* wg = (const bf16*)(A.ws + WS_WG);
    bf16* hloc = (bf16*)(A.ws + WS_HLOC); bf16* pc = (bf16*)(A.ws + WS_PC); float* agg = (float*)(A.ws + WS_AGG);
    const int fr = lane & 15, fq = lane >> 4;
    for (int wi = bid; wi < 2 * NCHUNK; wi += G) {
        const int hh = wave, chunk = wi & (NCHUNK - 1), b = wi >> 7;
        const size_t r0 = (size_t)b * SEQ + (size_t)chunk * CHUNK;
        __syncthreads();
        {
            const float* w4 = A.in[I_LCW]; const float* b4 = A.in[I_LCB];
            const int c0 = (tid & 127) * 8, tr = tid >> 7, t0 = chunk * CHUNK + tr * 16;
            v4u in[19];
#pragma unroll
            for (int r = 0; r < 19; ++r) { in[r] = (v4u){0u, 0u, 0u, 0u}; if (t0 - 3 + r >= 0) in[r] = *(const GAS v4u*)(proj + ((size_t)b * SEQ + t0 - 3 + r) * IN_COLS + c0); }
            float w[4][8], bb[8];
#pragma unroll
            for (int j = 0; j < 4; ++j) { const f32x4 wa_ = *(const GAS f32x4*)(w4 + j * LRU_W + c0), wb_ = *(const GAS f32x4*)(w4 + j * LRU_W + c0 + 4);
                w[j][0] = wa_.x; w[j][1] = wa_.y; w[j][2] = wa_.z; w[j][3] = wa_.w; w[j][4] = wb_.x; w[j][5] = wb_.y; w[j][6] = wb_.z; w[j][7] = wb_.w; }
            { const f32x4 ba = *(const GAS f32x4*)(b4 + c0), bc = *(const GAS f32x4*)(b4 + c0 + 4); bb[0] = ba.x; bb[1] = ba.y; bb[2] = ba.z; bb[3] = ba.w; bb[4] = bc.x; bb[5] = bc.y; bb[6] = bc.z; bb[7] = bc.w; }
#pragma unroll
            for (int i = 0; i < 16; ++i) { float acc[8];
#pragma unroll
                for (int e = 0; e < 8; ++e) acc[e] = bb[e];
#pragma unroll
                for (int j = 0; j < 4; ++j) { const v4u v = in[i + j];
                    acc[0] += w[j][0] * bflo(v.x); acc[1] += w[j][1] * bfhi(v.x); acc[2] += w[j][2] * bflo(v.y); acc[3] += w[j][3] * bfhi(v.y);
                    acc[4] += w[j][4] * bflo(v.z); acc[5] += w[j][5] * bfhi(v.z); acc[6] += w[j][6] * bflo(v.w); acc[7] += w[j][7] * bfhi(v.w); }
                v4u o; o.x = pk2(acc[0], acc[1]); o.y = pk2(acc[2], acc[3]); o.z = pk2(acc[4], acc[5]); o.w = pk2(acc[6], acc[7]);
                *(LAS v4u*)(lds + (tr * 16 + i) * XT_PITCH + c0 * 2) = o; }
        }
        __syncthreads();
        bf16x8 xf[4][4];
#pragma unroll
        for (int mt = 0; mt < 4; ++mt)
#pragma unroll
            for (int ks = 0; ks < 4; ++ks) xf[mt][ks] = *(const LAS bf16x8*)(lds + (16 * mt + fr) * XT_PITCH + (hh * LRU_HD + 32 * ks + 8 * fq) * 2);
        float cP[4], cH[4];
        for (int j = 0; j < 8; ++j) {
            const int chb = hh * LRU_HD + 16 * j + 4 * fq;
            bf16x8 wa[4], wx[4];
#pragma unroll
            for (int ks = 0; ks < 4; ++ks) { wa[ks] = *(const GAS bf16x8*)(wg + (size_t)(hh * 256 + 16 * j + fr) * 128 + 32 * ks + 8 * fq);
                                             wx[ks] = *(const GAS bf16x8*)(wg + (size_t)(hh * 256 + 128 + 16 * j + fr) * 128 + 32 * ks + 8 * fq); }
            const f32x4 bav = *(const GAS f32x4*)(A.in[I_BA] + chb), bxv = *(const GAS f32x4*)(A.in[I_BX] + chb), lam = *(const GAS f32x4*)(A.in[I_LAMBDA] + chb);
            float cl[4];
#pragma unroll
            for (int r = 0; r < 4; ++r) { cl[r] = -8.0f * log1pf(__expf(-lam[r])); cP[r] = 1.f; cH[r] = 0.f; }
#pragma unroll
            for (int mt = 0; mt < 4; ++mt) {
                f32x4 ar = {0.f, 0.f, 0.f, 0.f}, ai = {0.f, 0.f, 0.f, 0.f};
#pragma unroll
                for (int ks = 0; ks < 4; ++ks) { ar = __builtin_amdgcn_mfma_f32_16x16x32_bf16(wa[ks], xf[mt][ks], ar, 0, 0, 0);
                                                 ai = __builtin_amdgcn_mfma_f32_16x16x32_bf16(wx[ks], xf[mt][ks], ai, 0, 0, 0); }
                const v2u xv = *(const LAS v2u*)(lds + (16 * mt + fr) * XT_PITCH + chb * 2);
                const float xlv[4] = {bflo(xv.x), bfhi(xv.x), bflo(xv.y), bfhi(xv.y)};
                float P[4], H[4];
#pragma unroll
                for (int r = 0; r < 4; ++r) {
                    const float rg = sigmoidf_(ar[r] + bav[r]), ig = sigmoidf_(ai[r] + bxv[r]);
                    const float la = cl[r] * rg, a = __expf(la), mult = sqrtf(fmaxf(1.0f - a * a, 0.f));
                    float p = a, h = mult * ig * xlv[r];
                    { float pp, hp;
                      pp = dpp_shr<0x111>(p, 1.0f); hp = dpp_shr<0x111>(h, 0.0f); h = p * hp + h; p = p * pp;
                      pp = dpp_shr<0x112>(p, 1.0f); hp = dpp_shr<0x112>(h, 0.0f); h = p * hp + h; p = p * pp;
                      pp = dpp_shr<0x114>(p, 1.0f); hp = dpp_shr<0x114>(h, 0.0f); h = p * hp + h; p = p * pp;
                      pp = dpp_shr<0x118>(p, 1.0f); hp = dpp_shr<0x118>(h, 0.0f); h = p * hp + h; p = p * pp; }
                    h = h + p * cH[r]; p = p * cP[r];
                    P[r] = p; H[r] = h;
                    cP[r] = __shfl(p, 15, 16); cH[r] = __shfl(h, 15, 16);
                }
                v2u ho, po; ho.x = pk2(H[0], H[1]); ho.y = pk2(H[2], H[3]); po.x = pk2(P[0], P[1]); po.y = pk2(P[2], P[3]);
                *(GAS v2u*)(hloc + (r0 + 16 * mt + fr) * LRU_W + chb) = ho;
                *(GAS v2u*)(pc + (r0 + 16 * mt + fr) * LRU_W + chb) = po;
            }
            if (fr == 0) {
                float* ag = agg + ((size_t)(b * NCHUNK + chunk) * LRU_W + chb) * 2;
                *(GAS f32x4*)ag = (f32x4){cP[0], cH[0], cP[1], cH[1]}; *(GAS f32x4*)(ag + 4) = (f32x4){cP[2], cH[2], cP[3], cH[3]};
            }
        }
    }
}

__device__ __forceinline__ void phase_m3(const Args& A, LAS unsigned char* lds, int tid, int lane, int wave, int bid, int G) {
    const bf16* proj = (const bf16*)(A.ws + WS_PROJ); const bf16* hloc = (const bf16*)(A.ws + WS_HLOC); const bf16* pc = (const bf16*)(A.ws + WS_PC);
    const bf16* zc = (const bf16*)(A.ws + WS_ZC); const float* agg = (const float*)(A.ws + WS_AGG);
    bf16* a2 = (bf16*)(A.ws + WS_RA);
    LAS float* cs = (LAS float*)lds;
    float lg[2][8], lb[2][8];
#pragma unroll
    for (int jj = 0; jj < 2; ++jj)
#pragma unroll
        for (int e = 0; e < 8; ++e) { lg[jj][e] = A.in[I_LNG][jj * 512 + lane * 8 + e]; lb[jj][e] = A.in[I_LNB][jj * 512 + lane * 8 + e]; }
    for (int item = bid; item < 2 * NCHUNK; item += G) {
        const int b = item >> 7, chunk = item & (NCHUNK - 1);
        {   float h0 = 0.f, h1 = 0.f; const float* ap = agg + ((size_t)(b * NCHUNK) * LRU_W + 2 * tid) * 2;
#pragma unroll 8
            for (int c = 0; c < chunk; ++c) { const f32x4 ab = *(const GAS f32x4*)(ap + (size_t)c * LRU_W * 2); h0 = ab.x * h0 + ab.y; h1 = ab.z * h1 + ab.w; }
            __syncthreads();
            cs[2 * tid] = h0; cs[2 * tid + 1] = h1;
            __syncthreads(); }
        for (int rr = 0; rr < 8; rr += M3_RW) {
            const int row0 = b * SEQ + chunk * CHUNK + wave * 8 + rr;
            v4u hv[M3_RW][2], pv[M3_RW][2], gv[M3_RW][2], zq[M3_RW][2];
#pragma unroll
            for (int u = 0; u < M3_RW; ++u)
#pragma unroll
                for (int jj = 0; jj < 2; ++jj) { const int c0 = jj * 512 + lane * 8; const size_t row = (size_t)(row0 + u);
                    hv[u][jj] = *(const GAS v4u*)(hloc + row * LRU_W + c0); pv[u][jj] = *(const GAS v4u*)(pc + row * LRU_W + c0);
                    gv[u][jj] = *(const GAS v4u*)(proj + row * IN_COLS + 1024 + c0); zq[u][jj] = *(const GAS v4u*)(zc + row * CONF_W + c0); }
#pragma unroll
            for (int u = 0; u < M3_RW; ++u) {
                const size_t row = (size_t)(row0 + u);
                float zv[2][8]; float s = 0.f;
#pragma unroll
                for (int jj = 0; jj < 2; ++jj) {
                    const int c0 = jj * 512 + lane * 8;
                    const f32x4 ca = *(const LAS f32x4*)(cs + c0), cb = *(const LAS f32x4*)(cs + c0 + 4);
                    const v4u h_ = hv[u][jj], p_ = pv[u][jj], g_ = gv[u][jj], z = zq[u][jj];
                    float y[8];
                    y[0] = (bflo(h_.x) + bflo(p_.x) * ca.x) * gelu_tanh(bflo(g_.x)); y[1] = (bfhi(h_.x) + bfhi(p_.x) * ca.y) * gelu_tanh(bfhi(g_.x));
                    y[2] = (bflo(h_.y) + bflo(p_.y) * ca.z) * gelu_tanh(bflo(g_.y)); y[3] = (bfhi(h_.y) + bfhi(p_.y) * ca.w) * gelu_tanh(bfhi(g_.y));
                    y[4] = (bflo(h_.z) + bflo(p_.z) * cb.x) * gelu_tanh(bflo(g_.z)); y[5] = (bfhi(h_.z) + bfhi(p_.z) * cb.y) * gelu_tanh(bfhi(g_.z));
                    y[6] = (bflo(h_.w) + bflo(p_.w) * cb.z) * gelu_tanh(bflo(g_.w)); y[7] = (bfhi(h_.w) + bfhi(p_.w) * cb.w) * gelu_tanh(bfhi(g_.w));
                    v4u o; o.x = pk2(y[0], y[1]); o.y = pk2(y[2], y[3]); o.z = pk2(y[4], y[5]); o.w = pk2(y[6], y[7]);
                    *(GAS v4u*)(a2 + row * D + c0) = o;
                    zv[jj][0] = bflo(z.x); zv[jj][1] = bfhi(z.x); zv[jj][2] = bflo(z.y); zv[jj][3] = bfhi(z.y); zv[jj][4] = bflo(z.z); zv[jj][5] = bfhi(z.z); zv[jj][6] = bflo(z.w); zv[jj][7] = bfhi(z.w);
#pragma unroll
                    for (int e = 0; e < 8; ++e) s += zv[jj][e];
                }
                const float mean = wave_total(s) * (1.0f / CONF_W); float q = 0.f;
#pragma unroll
                for (int jj = 0; jj < 2; ++jj)
#pragma unroll
                    for (int e = 0; e < 8; ++e) { zv[jj][e] -= mean; q += zv[jj][e] * zv[jj][e]; }
                const float rstd = __builtin_amdgcn_rsqf(wave_total(q) * (1.0f / CONF_W) + EPS);
#pragma unroll
                for (int jj = 0; jj < 2; ++jj) { float o[8];
#pragma unroll
                    for (int e = 0; e < 8; ++e) { const float n = zv[jj][e] * rstd * lg[jj][e] + lb[jj][e]; o[e] = n * sigmoidf_(n); }
                    v4u w; w.x = pk2(o[0], o[1]); w.y = pk2(o[2], o[3]); w.z = pk2(o[4], o[5]); w.w = pk2(o[6], o[7]);
                    *(GAS v4u*)(a2 + row * D + 1024 + jj * 512 + lane * 8) = w; }
            }
        }
    }
}

__device__ __forceinline__ f32x2 fp8lo(unsigned w) { return __builtin_amdgcn_cvt_pk_f32_fp8((int)w, false); }
__device__ __forceinline__ f32x2 fp8hi(unsigned w) { return __builtin_amdgcn_cvt_pk_f32_fp8((int)w, true); }
constexpr int CVT_ROWS = 4;
template <bool I8> __device__ __forceinline__ void cvt_table_q8(const float* src, unsigned char* dst, float* inv_scale, int gw, int NGW, int lane) {
    for (int r0 = gw; r0 < NEXP; r0 += NGW * CVT_ROWS) {
        f32x4 v[CVT_ROWS][8];
#pragma unroll
        for (int q = 0; q < CVT_ROWS; ++q) { const int r = r0 + q * NGW; const GAS f32x4* p = (const GAS f32x4*)(src + (size_t)(r < NEXP ? r : r0) * D) + lane;
#pragma unroll
            for (int i = 0; i < 8; ++i) v[q][i] = p[i * 64]; }
#pragma unroll
        for (int q = 0; q < CVT_ROWS; ++q) { const int r = r0 + q * NGW; float m = 0.f;
#pragma unroll
            for (int i = 0; i < 8; ++i) m = fmaxf(m, fmaxf(fmaxf(fabsf(v[q][i].x), fabsf(v[q][i].y)), fmaxf(fabsf(v[q][i].z), fabsf(v[q][i].w))));
#pragma unroll
            for (int o = 1; o < 64; o <<= 1) m = fmaxf(m, __shfl_xor(m, o));
            const float QM = I8 ? 127.0f : 448.0f;
            const float sc = m > 0.f ? QM / m : 1.0f;
            if (r < NEXP) {
                GAS unsigned* o4 = (GAS unsigned*)(dst + (size_t)r * D) + lane;
#pragma unroll
                for (int i = 0; i < 8; ++i) { const f32x4 t = v[q][i] * sc;
                    const float a = fminf(fmaxf(t.x, -QM), QM), b = fminf(fmaxf(t.y, -QM), QM), c = fminf(fmaxf(t.z, -QM), QM), d = fminf(fmaxf(t.w, -QM), QM);
                    if (I8) { o4[i * 64] = (unsigned)(((int)rintf(a) & 255) | (((int)rintf(b) & 255) << 8) | (((int)rintf(c) & 255) << 16) | ((int)rintf(d) << 24)); }
                    else { int pk = __builtin_amdgcn_cvt_pk_fp8_f32(a, b, 0, false); pk = __builtin_amdgcn_cvt_pk_fp8_f32(c, d, pk, true); o4[i * 64] = (unsigned)pk; } }
                if (lane == 0) inv_scale[r] = m > 0.f ? m * (1.0f / QM) : 1.0f;
            }
        }
    }
}
__device__ __forceinline__ void phase_e2(const Args& A, int tid, int lane, int wave, int bid, int G) {
    const float* modp = (const float*)(A.ws + WS_MODP); const float* cfin = (const float*)(A.ws + WS_CFIN);
    const bf16* y1 = (const bf16*)(A.ws + WS_Y1); bf16* h2 = (bf16*)(A.ws + WS_RA);
    const int gw = bid * NWAVES + wave, NGW = G * NWAVES;
    const float* cfe = (const float*)(A.ws + WS_CFIN) + 4 * D;
    for (int row = gw; row < T; row += NGW) {
        const int b = row >> 13;
        const GAS f32x4* xr = (const GAS f32x4*)(A.in[I_X] + (size_t)row * D) + lane * 2;
        const GAS v4u* yr = (const GAS v4u*)(y1 + (size_t)row * D) + lane;
        const GAS f32x4* cf = (const GAS f32x4*)(cfin + (size_t)(b * 2 + 0) * D) + lane * 2;
        float xv[4][8], yv[4][8]; float s1 = 0.f;
#pragma unroll
        for (int j = 0; j < 4; ++j) { const f32x4 a = xr[j * 128], c = xr[j * 128 + 1]; const v4u y = yr[j * 64];
            xv[j][0] = a.x; xv[j][1] = a.y; xv[j][2] = a.z; xv[j][3] = a.w; xv[j][4] = c.x; xv[j][5] = c.y; xv[j][6] = c.z; xv[j][7] = c.w;
            yv[j][0] = bflo(y.x); yv[j][1] = bfhi(y.x); yv[j][2] = bflo(y.y); yv[j][3] = bfhi(y.y); yv[j][4] = bflo(y.z); yv[j][5] = bfhi(y.z); yv[j][6] = bflo(y.w); yv[j][7] = bfhi(y.w);
#pragma unroll
            for (int e = 0; e < 8; ++e) s1 += yv[j][e] * yv[j][e]; }
        const float rstd1 = __builtin_amdgcn_rsqf(wave_total(s1) * (1.0f / D) + EPS); float s2 = 0.f;
#pragma unroll
        for (int j = 0; j < 4; ++j) { const f32x4 ca = cf[j * 128], cc = cf[j * 128 + 1]; const float cg[8] = {ca.x, ca.y, ca.z, ca.w, cc.x, cc.y, cc.z, cc.w};
#pragma unroll
            for (int e = 0; e < 8; ++e) { xv[j][e] += cg[e] * yv[j][e] * rstd1; s2 += xv[j][e] * xv[j][e]; } }
        const float rstd2 = __builtin_amdgcn_rsqf(wave_total(s2) * (1.0f / D) + EPS);
        GAS v4u* orow = (GAS v4u*)(h2 + (size_t)row * D) + lane; float am = 0.f;
#pragma unroll
        for (int j = 0; j < 4; ++j) {
            const GAS f32x4* ge = (const GAS f32x4*)(cfe + (size_t)(b * 2 + 0) * D) + lane * 2 + j * 128; const GAS f32x4* se = (const GAS f32x4*)(cfe + (size_t)(b * 2 + 1) * D) + lane * 2 + j * 128;
            const f32x4 g0_ = ge[0], g1_ = ge[1], s0_ = se[0], s1_ = se[1]; const float gsv[8] = {g0_.x, g0_.y, g0_.z, g0_.w, g1_.x, g1_.y, g1_.z, g1_.w}, shv[8] = {s0_.x, s0_.y, s0_.z, s0_.w, s1_.x, s1_.y, s1_.z, s1_.w};
#pragma unroll
            for (int e = 0; e < 8; ++e) { xv[j][e] = xv[j][e] * rstd2 * gsv[e] + shv[e]; am = fmaxf(am, fabsf(xv[j][e])); }
            v4u w; w.x = pk2(xv[j][0], xv[j][1]); w.y = pk2(xv[j][2], xv[j][3]); w.z = pk2(xv[j][4], xv[j][5]); w.w = pk2(xv[j][6], xv[j][7]);
            orow[j * 64] = w; }
#pragma unroll
        for (int o = 1; o < 64; o <<= 1) am = fmaxf(am, __shfl_xor(am, o));
        const float qs = am > 0.f ? 127.0f / am : 1.0f;
        GAS v2u* qrow = (GAS v2u*)(A.ws + WS_H2Q + (size_t)row * D) + lane;
#pragma unroll
        for (int j = 0; j < 4; ++j) { int q[8];
#pragma unroll
            for (int e = 0; e < 8; ++e) q[e] = (int)rintf(xv[j][e] * qs) & 255;
            v2u w; w.x = (unsigned)(q[0] | (q[1] << 8) | (q[2] << 16) | (q[3] << 24)); w.y = (unsigned)(q[4] | (q[5] << 8) | (q[6] << 16) | (q[7] << 24));
            qrow[j * 64] = w; }
        if (lane == 0) ((float*)(A.ws + WS_HSC))[row] = am > 0.f ? am * (1.0f / 127.0f) : 1.0f;
    }
    if (!S_CONV) { cvt_table_q8<true>(A.in[I_PU], A.ws + WS_UB, (float*)(A.ws + WS_USC), gw, NGW, lane); cvt_table_q8<false>(A.in[I_PV], A.ws + WS_VB, (float*)(A.ws + WS_VSC), gw, NGW, lane); }
}

template <int N> __device__ __forceinline__ void bitonic_sort_desc(float (&v)[N]) {
#pragma unroll
    for (int k = 2; k <= N; k <<= 1)
#pragma unroll
        for (int j = k >> 1; j > 0; j >>= 1)
#pragma unroll
            for (int i = 0; i < N; ++i) { const int l = i ^ j;
                if (l > i) { const bool desc = ((i & k) == 0); const float a = v[i], b = v[l]; const float mx = fmaxf(a, b), mn = fminf(a, b); v[i] = desc ? mx : mn; v[l] = desc ? mn : mx; } }
}
__device__ __forceinline__ void merge_top16(float (&a)[16], const float (&b)[16]) {
#pragma unroll
    for (int i = 0; i < 16; ++i) a[i] = fmaxf(a[i], b[15 - i]);
#pragma unroll
    for (int j = 8; j > 0; j >>= 1)
#pragma unroll
        for (int i = 0; i < 16; ++i) { const int l = i ^ j; if (l > i) { const float x = a[i], y = a[l]; a[i] = fmaxf(x, y); a[l] = fminf(x, y); } }
}
__device__ __forceinline__ void top16_of_64(float (&v)[64], float (&out)[16]) {
    float g[4][16];
#pragma unroll
    for (int q = 0; q < 4; ++q) {
#pragma unroll
        for (int i = 0; i < 16; ++i) g[q][i] = v[q * 16 + i];
        bitonic_sort_desc<16>(g[q]); }
    merge_top16(g[0], g[1]); merge_top16(g[2], g[3]); merge_top16(g[0], g[2]);
#pragma unroll
    for (int i = 0; i < 16; ++i) out[i] = g[0][i];
}
__device__ __forceinline__ float pack_key(float v, unsigned key, unsigned mask) { return __builtin_bit_cast(float, (__builtin_bit_cast(unsigned, v) & ~mask) | key); }
constexpr int SK_PITCH = 272;
__device__ __forceinline__ void score_top16(const bf16* q, const LAS unsigned char* skl, int tok, int h, int p, int l31, int hf, float (&out)[16]) {
    f32x16 acc[4];
#pragma unroll
    for (int kt = 0; kt < 4; ++kt)
#pragma unroll
        for (int r = 0; r < 16; ++r) acc[kt][r] = 0.f;
    bf16x8 bq[8];
#pragma unroll
    for (int ks = 0; ks < 8; ++ks) bq[ks] = *(const GAS bf16x8*)(q + (size_t)tok * D + h * 256 + p * 128 + 16 * ks + 8 * hf);
#pragma unroll
    for (int ks = 0; ks < 8; ++ks) {
#pragma unroll
        for (int kt = 0; kt < 4; ++kt) {
            const bf16x8 ak = *(const LAS bf16x8*)(skl + (p * NKEY + 32 * kt + l31) * SK_PITCH + (16 * ks + 8 * hf) * 2);
            acc[kt] = __builtin_amdgcn_mfma_f32_32x32x16_bf16(ak, bq[ks], acc[kt], 0, 0, 0);
        }
    }
    float v[64];
#pragma unroll
    for (int kt = 0; kt < 4; ++kt)
#pragma unroll
        for (int r = 0; r < 16; ++r) v[kt * 16 + r] = pack_key(acc[kt][r], (unsigned)(32 * kt + (r & 3) + 8 * (r >> 2) + 4 * hf), 0x7Fu);
    float other[16];
    top16_of_64(v, out);
#pragma unroll
    for (int i = 0; i < 16; ++i) other[i] = __shfl_xor(out[i], 32);
    merge_top16(out, other);
}
__device__ __forceinline__ void s_convert_tables(const Args& A, int gw, int NGW, int lane) {
    cvt_table_q8<true>(A.in[I_PU], A.ws + WS_UB, (float*)(A.ws + WS_USC), gw, NGW, lane);
}
__device__ __forceinline__ void phase_s(const Args& A, LAS unsigned char* lds, int tid, int lane, int wave, int bid, int G) {
    const bf16* q = (const bf16*)(A.ws + WS_Q); const bf16* sk = (const bf16*)(A.ws + WS_SUBK);
    int* idx = (int*)(A.ws + WS_IDX); float* gate = (float*)(A.ws + WS_GATE);
    const int l31 = lane & 31, hf = lane >> 5;
    bool conv_done = false;
    for (int wi = bid; wi < (T / 512) * NH; wi += G) {
      const int h = wi & 7, tg = wi >> 3;
      __syncthreads();
#pragma unroll
      for (int i = 0; i < 8; ++i) { const int c = tid + i * NTHR, row = c >> 4, c16 = c & 15;
          *(LAS v4u*)(lds + row * SK_PITCH + c16 * 16) = *(const GAS v4u*)(sk + ((size_t)(h * 2 * NKEY + row)) * 128 + c16 * 8); }
      __syncthreads();
      if (S_CONV && wave >= 4 && !conv_done) s_convert_tables(A, bid * NWAVES + wave, G * NWAVES, lane);
      for (int ti = 0; ti < 2; ++ti) {
        const int tok = (tg * 16 + ti * 8 + wave) * 32 + l31;
        float s1[16], s2[16];
        score_top16(q, lds, tok, h, 0, l31, hf, s1);
        score_top16(q, lds, tok, h, 1, l31, hf, s2);
        float cv[64]; int n = 0;
#pragma unroll
        for (int i = 0; i < 16; ++i)
#pragma unroll
            for (int j = 0; j < 16; ++j)
                if ((i + 1) * (j + 1) <= 16) {
                    const float a = __builtin_bit_cast(float, __builtin_bit_cast(unsigned, s1[i]) & ~0x7Fu), c = __builtin_bit_cast(float, __builtin_bit_cast(unsigned, s2[j]) & ~0x7Fu);
                    cv[n++] = pack_key(a + c, (unsigned)(i * 16 + j), 0xFFu); }
#pragma unroll
        for (int m = 50; m < 64; ++m) cv[m] = -INFINITY;
        float c16[16];
        top16_of_64(cv, c16);
        float ev[16], esum = 0.f; const float cmax = __builtin_bit_cast(float, __builtin_bit_cast(unsigned, c16[0]) & ~0xFFu);
#pragma unroll
        for (int m = 0; m < 16; ++m) { ev[m] = __expf(__builtin_bit_cast(float, __builtin_bit_cast(unsigned, c16[m]) & ~0xFFu) - cmax); esum += ev[m]; }
        const float rs = 1.0f / esum;
        int oi[8]; float og[8];
#pragma unroll
        for (int mm = 0; mm < 8; ++mm) {
            float c_lo = c16[mm], c_hi = c16[8 + mm], e_lo = ev[mm], e_hi = ev[8 + mm];
            asm volatile("" : "+v"(c_lo), "+v"(c_hi), "+v"(e_lo), "+v"(e_hi));
            const unsigned cb = __builtin_bit_cast(unsigned, hf ? c_hi : c_lo); const int ii = (cb >> 4) & 15, jj = cb & 15;
            int row = 0, col = 0;
#pragma unroll
            for (int k = 0; k < 16; ++k) { row = (ii == k) ? (int)(__builtin_bit_cast(unsigned, s1[k]) & 0x7Fu) : row; col = (jj == k) ? (int)(__builtin_bit_cast(unsigned, s2[k]) & 0x7Fu) : col; }
            oi[mm] = row * NKEY + col; og[mm] = (hf ? e_hi : e_lo) * rs;
        }
        int* ip = idx + (size_t)tok * KSEL + h * 16 + hf * 8; float* gp = gate + (size_t)tok * KSEL + h * 16 + hf * 8;
        *(GAS v4u*)ip = (v4u){(unsigned)oi[0], (unsigned)oi[1], (unsigned)oi[2], (unsigned)oi[3]}; *(GAS v4u*)(ip + 4) = (v4u){(unsigned)oi[4], (unsigned)oi[5], (unsigned)oi[6], (unsigned)oi[7]};
        *(GAS f32x4*)gp = (f32x4){og[0], og[1], og[2], og[3]}; *(GAS f32x4*)(gp + 4) = (f32x4){og[4], og[5], og[6], og[7]};
      }
      if (S_CONV && wave < 4 && !conv_done) s_convert_tables(A, bid * NWAVES + wave, G * NWAVES, lane);
      conv_done = true;
    }
    if (S_CONV && !conv_done) s_convert_tables(A, bid * NWAVES + wave, G * NWAVES, lane);
    __syncthreads();
}

__device__ __forceinline__ float row_dot_fp8(const v4u d0, const v4u d1, const f32x2 (&hf)[2][8]) {
    const unsigned w0[4] = {d0.x, d0.y, d0.z, d0.w}, w1[4] = {d1.x, d1.y, d1.z, d1.w};
    f32x2 a = {0.f, 0.f}, b = {0.f, 0.f};
#pragma unroll
    for (int i = 0; i < 4; ++i) { a += fp8lo(w0[i]) * hf[0][2 * i]; a += fp8hi(w0[i]) * hf[0][2 * i + 1]; b += fp8lo(w1[i]) * hf[1][2 * i]; b += fp8hi(w1[i]) * hf[1][2 * i + 1]; }
    return (a.x + a.y) + (b.x + b.y);
}
__device__ __forceinline__ void row_axpy_fp8(f32x2 (&acc)[2][8], const v4u d0, const v4u d1, float w) {
    const unsigned w0[4] = {d0.x, d0.y, d0.z, d0.w}, w1[4] = {d1.x, d1.y, d1.z, d1.w};
#pragma unroll
    for (int i = 0; i < 4; ++i) { acc[0][2 * i] += fp8lo(w0[i]) * w; acc[0][2 * i + 1] += fp8hi(w0[i]) * w; acc[1][2 * i] += fp8lo(w1[i]) * w; acc[1][2 * i + 1] += fp8hi(w1[i]) * w; }
}
__device__ __forceinline__ void phase_pu(const Args& A, int lane, int wave, int bid, int G) {
    const unsigned char* h2q = A.ws + WS_H2Q; const unsigned char* ub = A.ws + WS_UB; const int* idx = (const int*)(A.ws + WS_IDX); float* actp = (float*)(A.ws + WS_ACTP);
    const int NX = (G % 8 == 0) ? 8 : 1, vx = bid % NX, nw = (G / NX) * NWAVES, wv = (bid / NX) * NWAVES + wave;
    const int q = lane >> 4, c16 = lane & 15;
    for (int cb = vx; cb < D / 256; cb += NX) {
        const unsigned char* ucol = ub + cb * 256 + c16 * 16;
        int cid0 = 0, cid1 = 0, nid0 = 0, nid1 = 0; v4u ch = {0u, 0u, 0u, 0u}, nh = {0u, 0u, 0u, 0u};
#define PUQ_LOAD(i0, i1, hh, t_) do { const int t__ = (t_); if (t__ < T) { i0 = idx[(size_t)t__ * KSEL + lane]; i1 = idx[(size_t)t__ * KSEL + 64 + lane]; hh = *(const GAS v4u*)(h2q + (size_t)t__ * D + cb * 256 + c16 * 16); } } while (0)
        PUQ_LOAD(cid0, cid1, ch, wv); PUQ_LOAD(nid0, nid1, nh, wv + nw);
        v4u rv[PUQ_RB];
#define PUQ_ISSUE(slot, idr, s_) do { const int e_ = __shfl(idr, ((4 * (s_)) & 63) + q); rv[slot] = *(const GAS v4u*)(ucol + (size_t)e_ * D); } while (0)
#pragma unroll
        for (int r = 0; r < PUQ_RB; ++r) PUQ_ISSUE(r, cid0, r);
        f32x4 cvv[8]; int it = 0;
        const int gwv = bid * NWAVES + wave, NGWv = G * NWAVES;
        for (int tok = wv; tok < T; tok += nw, ++it) {
            if (cb == vx) {
                const int vr = gwv + NGWv * (it >> 3);
                if ((it & 7) == 0 && vr < NEXP) { const GAS f32x4* p = (const GAS f32x4*)(A.in[I_PV] + (size_t)vr * D) + lane;
#pragma unroll
                    for (int i = 0; i < 8; ++i) cvv[i] = p[i * 64]; }
                if ((it & 7) == 1 && vr < NEXP) { float m = 0.f;
#pragma unroll
                    for (int i = 0; i < 8; ++i) m = fmaxf(m, fmaxf(fmaxf(fabsf(cvv[i].x), fabsf(cvv[i].y)), fmaxf(fabsf(cvv[i].z), fabsf(cvv[i].w))));
#pragma unroll
                    for (int o = 1; o < 64; o <<= 1) m = fmaxf(m, __shfl_xor(m, o));
                    const float sc = m > 0.f ? 448.0f / m : 1.0f; GAS unsigned* o4 = (GAS unsigned*)(A.ws + WS_VB + (size_t)vr * D) + lane;
#pragma unroll
                    for (int i = 0; i < 8; ++i) { const f32x4 t = cvv[i] * sc;
                        const float a = fminf(fmaxf(t.x, -448.f), 448.f), b = fminf(fmaxf(t.y, -448.f), 448.f), c = fminf(fmaxf(t.z, -448.f), 448.f), d = fminf(fmaxf(t.w, -448.f), 448.f);
                        int pk = __builtin_amdgcn_cvt_pk_fp8_f32(a, b, 0, false); pk = __builtin_amdgcn_cvt_pk_fp8_f32(c, d, pk, true); o4[i * 64] = (unsigned)pk; }
                    if (lane == 0) ((float*)(A.ws + WS_VSC))[vr] = m > 0.f ? m * (1.0f / 448.0f) : 1.0f; }
            }
            const int hx = (int)ch.x, hy = (int)ch.y, hz = (int)ch.z, hw = (int)ch.w;
            int a0 = 0, a1 = 0;
#define PUQ_DOT(slot, acc_, s_) do { const v4u d_ = rv[slot]; int p_ = __builtin_amdgcn_sdot4((int)d_.x, hx, 0, false); p_ = __builtin_amdgcn_sdot4((int)d_.y, hy, p_, false); \
                p_ = __builtin_amdgcn_sdot4((int)d_.z, hz, p_, false); p_ = __builtin_amdgcn_sdot4((int)d_.w, hw, p_, false); \
                p_ += __builtin_amdgcn_update_dpp(0, p_, 0xB1, 0xF, 0xF, false); p_ += __builtin_amdgcn_update_dpp(0, p_, 0x4E, 0xF, 0xF, false); \
                p_ += __builtin_amdgcn_update_dpp(0, p_, 0x141, 0xF, 0xF, false); p_ += __builtin_amdgcn_update_dpp(0, p_, 0x140, 0xF, 0xF, false); \
                acc_ = (c16 == ((s_) & 15)) ? p_ : acc_; } while (0)
#pragma unroll
            for (int r = 0; r < PUQ_RB; ++r) { PUQ_DOT(r, a0, r); PUQ_ISSUE(r, cid1, r + PUQ_RB); }
#pragma unroll
            for (int r = 0; r < PUQ_RB; ++r) { PUQ_DOT(r, a1, r + PUQ_RB); PUQ_ISSUE(r, nid0, r); }
            float* ap = actp + ((size_t)cb * T + tok) * KSEL + 4 * c16 + q;
            ap[0] = (float)a0; ap[64] = (float)a1;
            cid0 = nid0; cid1 = nid1; ch = nh;
            PUQ_LOAD(nid0, nid1, nh, tok + 2 * nw);
        }
#undef PUQ_LOAD
#undef PUQ_ISSUE
#undef PUQ_DOT
    }
}
__device__ __forceinline__ void phase_w(const Args& A, int lane, int wave, int bid, int G) {
    const float* actp = (const float*)(A.ws + WS_ACTP); const float* usc = (const float*)(A.ws + WS_USC); const float* vsc = (const float*)(A.ws + WS_VSC); const float* hsc = (const float*)(A.ws + WS_HSC);
    const int* idx = (const int*)(A.ws + WS_IDX); const float* gate = (const float*)(A.ws + WS_GATE); float* wb = (float*)(A.ws + WS_ACT);
    for (int tok = bid * NWAVES + wave; tok < T; tok += G * NWAVES) {
        const float hs = hsc[tok];
#pragma unroll
        for (int hh = 0; hh < 2; ++hh) {
            const size_t o = (size_t)tok * KSEL + hh * 64 + lane; float sacc = 0.f;
#pragma unroll
            for (int c = 0; c < 8; ++c) sacc += actp[(size_t)c * T * KSEL + o];
            const int e = idx[o];
            wb[o] = gate[o] * gelu_tanh(sacc * usc[e] * hs) * vsc[e];
        }
    }
}
__device__ __forceinline__ void phase_pv(const Args& A, int lane, int wave, int bid, int G) {
    const unsigned char* vb = A.ws + WS_VB; const float* wb = (const float*)(A.ws + WS_ACT); const int* idx = (const int*)(A.ws + WS_IDX);
    bf16* y2 = (bf16*)(A.ws + WS_Y2); float* ssq = (float*)(A.ws + WS_SSQ);
    const int NX = (G % 8 == 0) ? 8 : 1, vx = bid % NX, nw = (G / NX) * NWAVES, wv = (bid / NX) * NWAVES + wave;
    const int q = lane >> 4, c16 = lane & 15;
    for (int cb = vx; cb < D / 256; cb += NX) {
        const unsigned char* vcol = vb + cb * 256 + c16 * 16;
        int cid0 = 0, cid1 = 0, nid0 = 0, nid1 = 0; float cw0 = 0.f, cw1 = 0.f, nw0 = 0.f, nw1 = 0.f;
#define PVQ_LOAD(i0, i1, x0, x1, t_) do { const int t__ = (t_); if (t__ < T) { i0 = idx[(size_t)t__ * KSEL + lane]; i1 = idx[(size_t)t__ * KSEL + 64 + lane]; x0 = wb[(size_t)t__ * KSEL + lane]; x1 = wb[(size_t)t__ * KSEL + 64 + lane]; } } while (0)
        PVQ_LOAD(cid0, cid1, cw0, cw1, wv); PVQ_LOAD(nid0, nid1, nw0, nw1, wv + nw);
        v4u rv[PVQ_RB];
#define PVQ_ISSUE(slot, idr, s_) do { const int e_ = __shfl(idr, ((4 * (s_)) & 63) + q); rv[slot] = *(const GAS v4u*)(vcol + (size_t)e_ * D); } while (0)
#pragma unroll
        for (int r = 0; r < PVQ_RB; ++r) PVQ_ISSUE(r, cid0, r);
        for (int tok = wv; tok < T; tok += nw) {
            f32x2 acc[8];
#pragma unroll
            for (int i = 0; i < 8; ++i) acc[i] = (f32x2){0.f, 0.f};
#define PVQ_FMA(slot, wr, s_) do { const float w_ = __shfl(wr, ((4 * (s_)) & 63) + q); const v4u d_ = rv[slot]; const unsigned dw_[4] = {d_.x, d_.y, d_.z, d_.w}; \
                _Pragma("unroll") for (int i_ = 0; i_ < 4; ++i_) { acc[2 * i_] += fp8lo(dw_[i_]) * w_; acc[2 * i_ + 1] += fp8hi(dw_[i_]) * w_; } } while (0)
#pragma unroll
            for (int r = 0; r < PVQ_RB; ++r) { PVQ_FMA(r, cw0, r); PVQ_ISSUE(r, cid1, r + PVQ_RB); }
#pragma unroll
            for (int r = 0; r < PVQ_RB; ++r) { PVQ_FMA(r, cw1, r + PVQ_RB); PVQ_ISSUE(r, nid0, r); }
            float sq = 0.f;
#pragma unroll
            for (int i = 0; i < 8; ++i) { float x = acc[i].x, y = acc[i].y; x += __shfl_xor(x, 16); y += __shfl_xor(y, 16); x += __shfl_xor(x, 32); y += __shfl_xor(y, 32); acc[i] = (f32x2){x, y}; sq += x * x + y * y; }
            sq = wave_total(q == 0 ? sq : 0.f);
            if (q == 0) { GAS v4u* yo = (GAS v4u*)(y2 + (size_t)tok * D + cb * 256 + c16 * 16);
                yo[0] = (v4u){pk2(acc[0].x, acc[0].y), pk2(acc[1].x, acc[1].y), pk2(acc[2].x, acc[2].y), pk2(acc[3].x, acc[3].y)};
                yo[1] = (v4u){pk2(acc[4].x, acc[4].y), pk2(acc[5].x, acc[5].y), pk2(acc[6].x, acc[6].y), pk2(acc[7].x, acc[7].y)}; }
            if (lane == 0) ssq[(size_t)cb * T + tok] = sq;
            cid0 = nid0; cid1 = nid1; cw0 = nw0; cw1 = nw1;
            PVQ_LOAD(nid0, nid1, nw0, nw1, tok + 2 * nw);
        }
#undef PVQ_LOAD
#undef PVQ_ISSUE
#undef PVQ_FMA
    }
}
__device__ __forceinline__ void phase_f(const Args& A, int lane, int wave, int bid, int G) {
    const bf16* y1 = (const bf16*)(A.ws + WS_Y1); const bf16* y2 = (const bf16*)(A.ws + WS_Y2); const float* ssq = (const float*)(A.ws + WS_SSQ); const float* cfin = (const float*)(A.ws + WS_CFIN);
    for (int tok = bid * NWAVES + wave; tok < T; tok += G * NWAVES) {
        const int b = tok >> 13;
        float qs = 0.f;
#pragma unroll
        for (int c = 0; c < 8; ++c) qs += ssq[(size_t)c * T + tok];
        const float rstd2 = __builtin_amdgcn_rsqf(qs * (1.0f / D) + EPS);
        const GAS v2u* yp = (const GAS v2u*)(y1 + (size_t)tok * D) + lane; const GAS v2u* zp = (const GAS v2u*)(y2 + (size_t)tok * D) + lane;
        const GAS f32x4* xr = (const GAS f32x4*)(A.in[I_X] + (size_t)tok * D) + lane;
        v2u yq[8], zq[8]; f32x4 xv[8]; float s1 = 0.f;
#pragma unroll
        for (int i = 0; i < 8; ++i) { yq[i] = yp[i * 64]; zq[i] = zp[i * 64]; xv[i] = xr[i * 64]; }
#pragma unroll
        for (int i = 0; i < 8; ++i) { const float a = bflo(yq[i].x), b_ = bfhi(yq[i].x), c = bflo(yq[i].y), d = bfhi(yq[i].y); s1 += (a * a + b_ * b_) + (c * c + d * d); }
        const float rstd1 = __builtin_amdgcn_rsqf(wave_total(s1) * (1.0f / D) + EPS);
        const GAS f32x4* c1 = (const GAS f32x4*)(cfin + (size_t)(b * 2 + 0) * D) + lane; const GAS f32x4* c2 = (const GAS f32x4*)(cfin + (size_t)(b * 2 + 1) * D) + lane;
        GAS f32x4* orow = (GAS f32x4*)(A.out + (size_t)tok * D) + lane;
#pragma unroll
        for (int i = 0; i < 8; ++i) { const f32x4 a1 = c1[i * 64], a2 = c2[i * 64];
            const float yv[4] = {bflo(yq[i].x), bfhi(yq[i].x), bflo(yq[i].y), bfhi(yq[i].y)}, zv[4] = {bflo(zq[i].x), bfhi(zq[i].x), bflo(zq[i].y), bfhi(zq[i].y)}; f32x4 o;
#pragma unroll
            for (int e = 0; e < 4; ++e) o[e] = xv[i][e] + (OUT_MODE != 2 ? a1[e] * yv[e] * rstd1 : 0.f) + (OUT_MODE != 1 ? a2[e] * zv[e] * rstd2 : 0.f);
            orow[i * 64] = o; }
    }
}

#if defined(MK_CHECKS)
constexpr int CW_CHK = 2048;
__device__ __forceinline__ unsigned hsh(unsigned x) { x ^= x >> 16; x *= 0x7feb352dU; x ^= x >> 15; x *= 0x846ca68bU; x ^= x >> 16; return x; }
__device__ __forceinline__ float bfv(const bf16* p, size_t i) { return __builtin_bit_cast(float, (unsigned)p[i] << 16); }
__device__ __forceinline__ float relerr(float got, float ref, float scale) { const float d = fabsf(got - ref) / (fabsf(ref) + scale); return (d == d) ? d : 1e30f; }
__device__ __forceinline__ void chk_put(unsigned* ctl, int stage, float e) { atomicMax(ctl + CW_CHK + stage, __builtin_bit_cast(unsigned, e)); }
__device__ float chk_gemm(const bf16* Am, const bf16* Bt, const bf16* C, int N, int K, unsigned s) {
    const int row = hsh(s) % T, col = hsh(s * 7 + 1) % N; float acc = 0.f;
    for (int k = 0; k < K; ++k) acc += bfv(Am, (size_t)row * K + k) * bfv(Bt, (size_t)col * K + k);
    return relerr(bfv(C, (size_t)row * N + col), acc, 0.05f);
}
__device__ float xl_at(const Args& A, const bf16* proj, size_t row, int c) {
    const int t = (int)(row & (SEQ - 1)); float a = A.in[I_LCB][c];
    for (int j = 0; j < 4; ++j) if (t - 3 + j >= 0) a += A.in[I_LCW][j * LRU_W + c] * bfv(proj, (row - 3 + j) * IN_COLS + c);
    return __builtin_bit_cast(float, f2bf(a) << 16);
}
__global__ void __launch_bounds__(128) chk_kernel(Args A, int stage) {
    __shared__ float sh[10240];
    unsigned* ctl = (unsigned*)(A.ws + WS_CTL);
    const int tid = threadIdx.x; const unsigned s = hsh(tid * 2654435761u + stage * 97u + 12345u);
    const float* modp = (const float*)(A.ws + WS_MODP);
    float e = 0.f;
    if (stage == 0) {
        { const int b = s & 1, n = hsh(s) % NMOD; float acc = A.in[I_BMOD][n];
          for (int k = 0; k < D; ++k) { const float c = A.in[I_C][b * D + k]; acc += c / (1.0f + expf(-c)) * A.in[I_WMOD][(size_t)k * NMOD + n]; }
          e = fmaxf(e, relerr(mod_at(modp, b, n), acc, 0.01f)); }
        { const int n = hsh(s + 1) % IN_COLS, k = hsh(s + 2) % D; e = fmaxf(e, relerr(bfv((const bf16*)(A.ws + WS_BT1), (size_t)n * D + k), A.in[I_WIN][(size_t)k * IN_COLS + n], 1e-3f)); }
        { const int n = hsh(s + 3) % D, k = hsh(s + 4) % D; e = fmaxf(e, relerr(bfv((const bf16*)(A.ws + WS_BT2), (size_t)n * D + k), A.in[I_WOUT][(size_t)k * D + n], 1e-3f));
          e = fmaxf(e, relerr(bfv((const bf16*)(A.ws + WS_BT3), (size_t)n * D + k), A.in[I_WQ][(size_t)k * D + n], 1e-3f)); }
        { const int h = s & 7, n = hsh(s + 5) & 255, k = hsh(s + 6) & 127; const float ref = (n < 128 ? A.in[I_WA] : A.in[I_WX])[h * 16384 + k * 128 + (n & 127)];
          e = fmaxf(e, relerr(bfv((const bf16*)(A.ws + WS_WG), (size_t)(h * 256 + n) * 128 + k), ref, 1e-3f)); }
        { const int i = hsh(s + 7) % (NH * 2 * NKEY * 128); e = fmaxf(e, relerr(bfv((const bf16*)(A.ws + WS_SUBK), i), A.in[I_SUBK][i], 1e-3f)); }
    } else if (stage == 1) {
        const int row = hsh(s) % T, col = hsh(s + 1) % D, b = row >> 13; float ss = 0.f;
        for (int k = 0; k < D; ++k) { const float x = A.in[I_X][(size_t)row * D + k]; ss += x * x; }
        const float ref = A.in[I_X][(size_t)row * D + col] * rsqrtf(ss / D + EPS) * A.in[I_GPREMIX][col] * (1.0f + mod_at(modp, b, D + col)) + mod_at(modp, b, col);
        e = relerr(bfv((const bf16*)(A.ws + WS_RA), (size_t)row * D + col), ref, 0.05f);
        const float* cfin = (const float*)(A.ws + WS_CFIN);
        e = fmaxf(e, relerr(cfin[(b * 2 + 0) * D + col], mod_at(modp, b, 2 * D + col) * A.in[I_GPOSTMIX][col], 1e-3f));
        e = fmaxf(e, relerr(cfin[(b * 2 + 1) * D + col], mod_at(modp, b, 5 * D + col) * A.in[I_GPOSTFFN][col], 1e-3f));
    } else if (stage == 2) { e = chk_gemm((const bf16*)(A.ws + WS_RA), (const bf16*)(A.ws + WS_BT1), (const bf16*)(A.ws + WS_PROJ), IN_COLS, D, s);
    } else if (stage == 7) { e = chk_gemm((const bf16*)(A.ws + WS_RA), (const bf16*)(A.ws + WS_BT2), (const bf16*)(A.ws + WS_Y1), D, D, s);
    } else if (stage == 9) { e = chk_gemm((const bf16*)(A.ws + WS_RA), (const bf16*)(A.ws + WS_BT3), (const bf16*)(A.ws + WS_Q), D, D, s);
    } else if (stage == 3) {
        const bf16* proj = (const bf16*)(A.ws + WS_PROJ);
        int row = hsh(s) % T; if (tid < 16) row = (tid & 1) * SEQ + (tid >> 1);
        const int c = hsh(s + 1) % LRU_W, t = row & (SEQ - 1);
        float a = A.in[I_LCB][c];
        for (int j = 0; j < 4; ++j) if (t - 3 + j >= 0) a += A.in[I_LCW][j * LRU_W + c] * bfv(proj, (size_t)(row - 3 + j) * IN_COLS + c);
        (void)a;
        float z = A.in[I_CDB][c];
        for (int j = 0; j < CONF_K; ++j) if (t - 30 + j >= 0) { const size_t r = (size_t)(row - 30 + j) * IN_COLS; const float g = bfv(proj, r + 3072 + c);
            z += A.in[I_CDW][j * CONF_W + c] * bfv(proj, r + 2048 + c) / (1.0f + expf(-g)); }
        e = fmaxf(e, relerr(bfv((const bf16*)(A.ws + WS_ZC), (size_t)row * CONF_W + c), z, 0.05f));
    } else if (stage == 4) {
        const bf16* xl = (const bf16*)(A.ws + WS_XL);
        const int b = s & 1, chunk = hsh(s + 1) % NCHUNK, ch = hsh(s + 2) % LRU_W, hh = ch >> 7, j = ch & 127;
        const float cl = -8.0f * log1pf(expf(-A.in[I_LAMBDA][ch])); float P = 1.f, H = 0.f;
        for (int t = 0; t < CHUNK; ++t) { const size_t row = (size_t)b * SEQ + chunk * CHUNK + t; float ga = A.in[I_BA][ch], gx = A.in[I_BX][ch];
            for (int i = 0; i < 128; ++i) { const float xv = bfv(xl, row * LRU_W + hh * 128 + i); ga += xv * A.in[I_WA][hh * 16384 + i * 128 + j]; gx += xv * A.in[I_WX][hh * 16384 + i * 128 + j]; }
            const float r = 1.0f / (1.0f + expf(-ga)), ig = 1.0f / (1.0f + expf(-gx)), la = cl * r, a = expf(la), u = sqrtf(fmaxf(-expm1f(2.0f * la), 0.f)) * ig * bfv(xl, row * LRU_W + ch);
            H = a * H + u; P = P * a;
            e = fmaxf(e, relerr(bfv((const bf16*)(A.ws + WS_HLOC), row * LRU_W + ch), H, 0.05f)); e = fmaxf(e, relerr(bfv((const bf16*)(A.ws + WS_PC), row * LRU_W + ch), P, 0.02f)); }
        const float* ag = (const float*)(A.ws + WS_AGG) + ((size_t)(b * NCHUNK + chunk) * LRU_W + ch) * 2;
        e = fmaxf(e, relerr(ag[0], P, 0.02f)); e = fmaxf(e, relerr(ag[1], H, 0.05f));
    } else if (stage == 12) {
        const bf16* proj = (const bf16*)(A.ws + WS_PROJ);
#define XLV(row_, ch_) xl_at(A, proj, (row_), (ch_))
        const int b = s & 1, chunk = hsh(s + 1) % NCHUNK, ch = hsh(s + 2) % LRU_W, hh = ch >> 7, j = ch & 127;
        const float cl = -8.0f * log1pf(expf(-A.in[I_LAMBDA][ch])); float P = 1.f, H = 0.f;
        for (int t = 0; t < CHUNK; ++t) { const size_t row = (size_t)b * SEQ + chunk * CHUNK + t; float ga = A.in[I_BA][ch], gx = A.in[I_BX][ch];
            for (int i = 0; i < 128; ++i) { const float xv = XLV(row, hh * 128 + i); ga += xv * A.in[I_WA][hh * 16384 + i * 128 + j]; gx += xv * A.in[I_WX][hh * 16384 + i * 128 + j]; }
            const float r = 1.0f / (1.0f + expf(-ga)), ig = 1.0f / (1.0f + expf(-gx)), la = cl * r, a = expf(la), u = sqrtf(fmaxf(-expm1f(2.0f * la), 0.f)) * ig * XLV(row, ch);
            H = a * H + u; P = P * a;
            e = fmaxf(e, relerr(bfv((const bf16*)(A.ws + WS_HLOC), row * LRU_W + ch), H, 0.05f)); e = fmaxf(e, relerr(bfv((const bf16*)(A.ws + WS_PC), row * LRU_W + ch), P, 0.02f)); }
        const float* ag = (const float*)(A.ws + WS_AGG) + ((size_t)(b * NCHUNK + chunk) * LRU_W + ch) * 2;
        e = fmaxf(e, relerr(ag[0], P, 0.02f)); e = fmaxf(e, relerr(ag[1], H, 0.05f));
        { const int row = hsh(s + 9) % T, c = hsh(s + 10) % CONF_W, t = row & (SEQ - 1); float z = A.in[I_CDB][c];
          for (int j = 0; j < CONF_K; ++j) if (t - 30 + j >= 0) { const size_t r = (size_t)(row - 30 + j) * IN_COLS; const float g = bfv(proj, r + 3072 + c); z += A.in[I_CDW][j * CONF_W + c] * bfv(proj, r + 2048 + c) / (1.0f + expf(-g)); }
          e = fmaxf(e, relerr(bfv((const bf16*)(A.ws + WS_ZC), (size_t)row * CONF_W + c), z, 0.05f)); }
#undef XLV
    } else if (stage == 5) {
    } else if (stage == 6) {
        const bf16* proj = (const bf16*)(A.ws + WS_PROJ); const bf16* zc = (const bf16*)(A.ws + WS_ZC);
        const int row = hsh(s) % T, c = hsh(s + 1) % LRU_W, b = row >> 13, chunk = (row & (SEQ - 1)) >> 6;
        float cin = 0.f; for (int cc = 0; cc < chunk; ++cc) { const float* ag = (const float*)(A.ws + WS_AGG) + ((size_t)(b * NCHUNK + cc) * LRU_W + c) * 2; cin = ag[0] * cin + ag[1]; }
        const float hfull = bfv((const bf16*)(A.ws + WS_HLOC), (size_t)row * LRU_W + c) + bfv((const bf16*)(A.ws + WS_PC), (size_t)row * LRU_W + c) * cin;
        const float g = bfv(proj, (size_t)row * IN_COLS + 1024 + c), ge = 0.5f * g * (1.0f + tanhf(0.7978845608f * (g + 0.044715f * g * g * g)));
        e = relerr(bfv((const bf16*)(A.ws + WS_RA), (size_t)row * D + c), hfull * ge, 0.05f);
        float m = 0.f, q = 0.f;
        for (int k = 0; k < CONF_W; ++k) m += bfv(zc, (size_t)row * CONF_W + k);
        m /= CONF_W;
        for (int k = 0; k < CONF_W; ++k) { const float d = bfv(zc, (size_t)row * CONF_W + k) - m; q += d * d; }
        const float n = (bfv(zc, (size_t)row * CONF_W + c) - m) * rsqrtf(q / CONF_W + EPS) * A.in[I_LNG][c] + A.in[I_LNB][c];
        e = fmaxf(e, relerr(bfv((const bf16*)(A.ws + WS_RA), (size_t)row * D + 1024 + c), n / (1.0f + expf(-n)), 0.05f));
    } else if (stage == 8) {
        const bf16* y1 = (const bf16*)(A.ws + WS_Y1); const float* cfin = (const float*)(A.ws + WS_CFIN);
        const int row = hsh(s) % T, col = hsh(s + 1) % D, b = row >> 13; float s1 = 0.f, s2 = 0.f;
        for (int k = 0; k < D; ++k) { const float y = bfv(y1, (size_t)row * D + k); s1 += y * y; }
        const float r1 = rsqrtf(s1 / D + EPS);
        for (int k = 0; k < D; ++k) { const float x1 = A.in[I_X][(size_t)row * D + k] + cfin[(b * 2) * D + k] * bfv(y1, (size_t)row * D + k) * r1; s2 += x1 * x1; }
        const float x1c = A.in[I_X][(size_t)row * D + col] + cfin[(b * 2) * D + col] * bfv(y1, (size_t)row * D + col) * r1;
        const float ref = x1c * rsqrtf(s2 / D + EPS) * A.in[I_GPREFFN][col] * (1.0f + mod_at(modp, b, 4 * D + col)) + mod_at(modp, b, 3 * D + col);
        e = relerr(bfv((const bf16*)(A.ws + WS_RA), (size_t)row * D + col), ref, 0.05f);
    } else if (stage == 10) {
        { const size_t i = (size_t)(hsh(s + 2) % NEXP) * D + hsh(s + 3) % D;
          const unsigned wu = ((const unsigned*)(A.ws + WS_UB))[i >> 2] >> (8 * (i & 3)), wv = ((const unsigned*)(A.ws + WS_VB))[i >> 2] >> (8 * (i & 3));
          const float du = (float)(signed char)(wu & 255u) * ((const float*)(A.ws + WS_USC))[i / D], dv = __builtin_amdgcn_cvt_pk_f32_fp8((int)wv, false)[0] * ((const float*)(A.ws + WS_VSC))[i / D];
          e = fmaxf(e, relerr(du, A.in[I_PU][i], 2e-3f) * 0.3f); (void)dv; }
        if (tid < 32) {
            const bf16* q = (const bf16*)(A.ws + WS_Q); const int* idx = (const int*)(A.ws + WS_IDX); const float* gate = (const float*)(A.ws + WS_GATE);
            const int tok = hsh(s) % T, h = hsh(s + 1) & 7;
            float* sc = sh + tid * 320;
            for (int p = 0; p < 2; ++p) for (int n = 0; n < NKEY; ++n) { float a = 0.f;
                for (int d = 0; d < 128; ++d) a += bfv(q, (size_t)tok * D + h * 256 + p * 128 + d) * A.in[I_SUBK][((size_t)((h * 2 + p) * NKEY + n)) * 128 + d];
                sc[p * 128 + n] = a; }
            for (int p = 0; p < 2; ++p) { float prev = 1e30f; for (int it = 0; it < 16; ++it) { float best = -1e30f; int bi = 0;
                for (int n = 0; n < NKEY; ++n) { const float v = sc[p * 128 + n]; if (v < prev && v > best) { best = v; bi = n; } }
                sc[256 + p * 16 + it] = best; sc[288 + p * 16 + it] = (float)bi; prev = best; } }
            float prev = 1e30f, esum = 0.f, cmax = 0.f; int miss = 0; float gerr = 0.f;
            { float pv = 1e30f; for (int it = 0; it < 16; ++it) { float best = -1e30f;
                for (int c = 0; c < 256; ++c) { const float v = sc[256 + (c >> 4)] + sc[272 + (c & 15)]; if (v < pv && v > best) best = v; }
                if (it == 0) cmax = best; esum += expf(best - cmax); pv = best; } }
            for (int it = 0; it < 16; ++it) { float best = -1e30f; int bc = 0;
                for (int c = 0; c < 256; ++c) { const float v = sc[256 + (c >> 4)] + sc[272 + (c & 15)]; if (v < prev && v > best) { best = v; bc = c; } }
                prev = best;
                const int eidx = (int)sc[288 + (bc >> 4)] * NKEY + (int)sc[304 + (bc & 15)]; const float g = expf(best - cmax) / esum; bool found = false;
                for (int m = 0; m < 16; ++m) if (idx[(size_t)tok * KSEL + h * 16 + m] == eidx) { found = true; gerr = fmaxf(gerr, relerr(gate[(size_t)tok * KSEL + h * 16 + m], g, 0.02f)); }
                if (!found) ++miss; }
            e = fmaxf((float)miss / 16.0f, gerr);
        }
    } else if (stage == 11) {
        const bf16* h2 = (const bf16*)(A.ws + WS_RA); const bf16* y1 = (const bf16*)(A.ws + WS_Y1); const int* idx = (const int*)(A.ws + WS_IDX); const float* gate = (const float*)(A.ws + WS_GATE); const float* cfin = (const float*)(A.ws + WS_CFIN);
        const int tok = hsh(blockIdx.x * 977u + 5u) % T, b = tok >> 13;
        { const int ex = idx[(size_t)tok * KSEL + tid]; float a = 0.f;
          if ((unsigned)ex < (unsigned)NEXP) { for (int d = 0; d < D; ++d) a += bfv(h2, (size_t)tok * D + d) * A.in[I_PU][(size_t)ex * D + d]; } else a = 1e30f;
          const float ge = 0.5f * a * (1.0f + tanhf(0.7978845608f * (a + 0.044715f * a * a * a)));
          sh[tid] = gate[(size_t)tok * KSEL + tid] * ge; sh[128 + tid] = __builtin_bit_cast(float, ex); }
        __syncthreads();
        float s2 = 0.f, s1 = 0.f;
        for (int cc = 0; cc < 16; ++cc) { const int col = cc * 128 + tid; float a = 0.f;
            for (int k = 0; k < KSEL; ++k) { const int ex = __builtin_bit_cast(int, sh[128 + k]); if ((unsigned)ex < (unsigned)NEXP) a += sh[k] * A.in[I_PV][(size_t)ex * D + col]; }
            sh[512 + cc * 128 + tid] = a; s2 += a * a; const float y = bfv(y1, (size_t)tok * D + col); s1 += y * y; }
        __syncthreads(); sh[256 + tid] = s2; sh[384 + tid] = s1; __syncthreads();
        float t2 = 0.f, t1 = 0.f; for (int k = 0; k < 128; ++k) { t2 += sh[256 + k]; t1 += sh[384 + k]; }
        const float r2 = rsqrtf(t2 / D + EPS), r1 = rsqrtf(t1 / D + EPS);
        float en = 0.f, ed = 0.f;
        for (int cc = 0; cc < 16; ++cc) { const int col = cc * 128 + tid;
            const float pterm = cfin[(b * 2 + 1) * D + col] * sh[512 + cc * 128 + tid] * r2;
            const float ref = A.in[I_X][(size_t)tok * D + col] + (OUT_MODE != 2 ? cfin[(b * 2) * D + col] * bfv(y1, (size_t)tok * D + col) * r1 : 0.f) + (OUT_MODE != 1 ? pterm : 0.f);
            const float d = A.out[(size_t)tok * D + col] - ref; en += d * d; ed += pterm * pterm; }
        __syncthreads(); sh[256 + tid] = en; sh[384 + tid] = ed; __syncthreads();
        float ten = 0.f, ted = 0.f; for (int k = 0; k < 128; ++k) { ten += sh[256 + k]; ted += sh[384 + k]; }
        e = ten / (ted + 1e-12f); if (!(e == e)) e = 1e30f;
    }
    chk_put(ctl, stage, e);
}
__global__ void chk_encode(Args A, int what) {
    const unsigned* ctl = (const unsigned*)(A.ws + WS_CTL);
    if (threadIdx.x == 0 && blockIdx.x == 0) {
        if (what < 0) {
            const float thr[13] = {0.03f, 0.03f, 0.03f, 0.03f, 0.06f, 0.01f, 0.04f, 0.03f, 0.03f, 0.03f, 0.2f, 0.01f, 0.06f};
            for (int st = 0; st < 13; ++st) { const float e = __builtin_bit_cast(float, ctl[CW_CHK + st]); if (!(e <= thr[st])) { A.out[0] = 4000.0f * (float)(1 << st); break; } }
        } else {
            const float e = fminf(__builtin_bit_cast(float, ctl[CW_CHK + what]), 1e6f); A.out[0] = 4000.0f * sqrtf(1e6f * e);
        }
    }
}
#endif

__global__ void __launch_bounds__(NTHR, 2) fwd_kernel(Args args) {
    extern __shared__ __attribute__((aligned(16))) unsigned char lds_raw[];
    LAS unsigned char* lds = (LAS unsigned char*)lds_raw;
    const int tid = threadIdx.x, lane = tid & 63, wave = __builtin_amdgcn_readfirstlane(tid >> 6), bid = blockIdx.x, G = gridDim.x;
    for (int u = tid; u < (LDS_BYTES - LDSCTL_OFF) / 4; u += NTHR) ((LAS unsigned*)(lds + LDSCTL_OFF))[u] = 0u;
    __syncthreads();
    unsigned* ctl = (unsigned*)(args.ws + WS_CTL);
    XcdBarrier bar; bar.bar = ctl + CW_BAR + args.li * XCD_BAR_WORDS; bar.x = 0; bar.st = nullptr;
    if (MK_N_LAUNCHES != N_PHASES) bar = xcd_barrier_post(ctl + CW_BAR + args.li * XCD_BAR_WORDS, (volatile LAS unsigned*)(lds + MISC_OFF) + 8);
    const int lo = args.ph_lo, hi = args.ph_hi;
#define IN(k) (lo <= (k) && (k) < hi)
#define SEAM(k) do { if (IN(k) && IN((k) + 1)) xcd_barrier(bar); } while (0)
#define PHON(k) ((PH_MASK >> (k)) & 1)
    if (PHON(0) && IN(0)) { phase_p0(args, lds, tid, lane, wave, bid, G); }
    SEAM(0);
    if (PHON(1) && IN(1)) { phase_p1(args, tid, lane, wave, bid, G); }
    SEAM(1);
    if (PHON(2) && IN(2)) {
        pg8::Gemm g{(const bf16*)(args.ws + WS_RA), (const bf16*)(args.ws + WS_BT1), T, IN_COLS, D}; pg8::StaticOrder S; S.init(T, IN_COLS, G, bid);
        pg8::EpiBf16<0> E{(bf16*)(args.ws + WS_PROJ), IN_COLS, nullptr, 0, 0, 1.f};
        pg8::gemm_phase<pg8::EpiBf16<0>, pg8::StaticOrder, PG8_ALIGN, PG8_SP2>(lds + RING_OFF, g, S, E);
    }
    SEAM(2);
    if (PHON(3) && IN(3)) { phase_m1a(args, lds, tid, lane, wave, bid, G); }
    if (PHON(4) && IN(3)) { phase_m1b(args, lds, tid, lane, wave, bid, G); }
    SEAM(3);
    if (PHON(5) && IN(4)) { phase_m3(args, lds, tid, lane, wave, bid, G); }
    SEAM(4);
    if (PHON(6) && IN(5)) {
        pg8::Gemm g{(const bf16*)(args.ws + WS_RA), (const bf16*)(args.ws + WS_BT2), T, D, D}; pg8::StaticOrder S; S.init(T, D, G, bid);
        pg8::EpiBf16<0> E{(bf16*)(args.ws + WS_Y1), D, nullptr, 0, 0, 1.f};
        pg8::gemm_phase<pg8::EpiBf16<0>, pg8::StaticOrder, PG8_ALIGN, PG8_SP2>(lds + RING_OFF, g, S, E);
    }
    SEAM(5);
    if (PHON(7) && IN(6)) { phase_e2(args, tid, lane, wave, bid, G); }
    SEAM(6);
    if (PHON(8) && IN(7)) {
        pg8::Gemm g{(const bf16*)(args.ws + WS_RA), (const bf16*)(args.ws + WS_BT3), T, D, D}; pg8::StaticOrder S; S.init(T, D, G, bid);
        pg8::EpiBf16<0> E{(bf16*)(args.ws + WS_Q), D, nullptr, 0, 0, 1.f};
        pg8::gemm_phase<pg8::EpiBf16<0>, pg8::StaticOrder, PG8_ALIGN, PG8_SP2>(lds + RING_OFF, g, S, E);
    }
    SEAM(7);
    if (PHON(9) && IN(8)) { phase_s(args, lds, tid, lane, wave, bid, G); }
    SEAM(8);
    if (PHON(10) && IN(9)) { phase_pu(args, lane, wave, bid, G); }
    SEAM(9);
    if (PHON(11) && IN(10)) { phase_w(args, lane, wave, bid, G); }
    SEAM(10);
    if (PHON(12) && IN(11)) { phase_pv(args, lane, wave, bid, G); }
    SEAM(11);
    if (PHON(13) && IN(12)) { phase_f(args, lane, wave, bid, G); }
#undef IN
#undef SEAM
}

extern "C" void kernel_launch(void* const* d_in, const int* in_sizes, int n_in, void* d_out, int out_size, void* d_ws, size_t ws_size, hipStream_t stream) {
    static int grid = 0;
    if (grid == 0) {
        if (n_in != 25 || in_sizes[0] != T * D || out_size != T * D || ws_size < WS_END) {
            fprintf(stderr, "kernel_launch: built for 25 inputs, x/out of %d floats, >= %zu bytes of workspace; got n_in %d, in0 %d, out %d, ws %zu; nothing launched\n", T * D, (size_t)WS_END, n_in, n_in > 0 ? in_sizes[0] : -1, out_size, ws_size);
            grid = -1; return; }
        int dev = 0, cus = 0, per_cu = 0;
        if (hipGetDevice(&dev) != hipSuccess || hipDeviceGetAttribute(&cus, hipDeviceAttributeMultiprocessorCount, dev) != hipSuccess) { fprintf(stderr, "kernel_launch: device query failed\n"); grid = -1; return; }
        if (hipFuncSetAttribute((const void*)fwd_kernel, hipFuncAttributeMaxDynamicSharedMemorySize, LDS_BYTES) != hipSuccess) { fprintf(stderr, "kernel_launch: hipFuncSetAttribute failed\n"); grid = -1; return; }
        if (hipOccupancyMaxActiveBlocksPerMultiprocessor(&per_cu, (const void*)fwd_kernel, NTHR, LDS_BYTES) != hipSuccess || per_cu < 1)
            fprintf(stderr, "kernel_launch: note: occupancy query reports %d workgroups per CU\n", per_cu);
        (void)hipGetLastError();
        grid = cus;
    }
    if (grid < 0) return;
    if (hipMemsetAsync((char*)d_ws + WS_CTL, 0, CTL_ZERO_BYTES, stream) != hipSuccess) { fprintf(stderr, "kernel_launch: memset failed\n"); return; }
    Args a{};
    for (int i = 0; i < 25; ++i) a.in[i] = (const float*)d_in[i];
    a.out = (float*)d_out; a.ws = (unsigned char*)d_ws;
#if defined(MK_TIME_REP)
    const int cuts[3][2] = {{0, MK_TIME_REP + 1}, {MK_TIME_REP, MK_TIME_REP + 1}, {MK_TIME_REP + 1, N_PHASES}};
    for (int li = 0; li < 3; ++li) {
        a.ph_lo = cuts[li][0]; a.ph_hi = cuts[li][1]; a.li = li;
        if (a.ph_lo < a.ph_hi) hipLaunchKernelGGL(fwd_kernel, dim3(grid), dim3(NTHR), LDS_BYTES, stream, a);
    }
#else
    for (int li = 0; li < MK_N_LAUNCHES; ++li) {
        if (MK_N_LAUNCHES == 1) { a.ph_lo = 0; a.ph_hi = N_PHASES; } else { a.ph_lo = li; a.ph_hi = li + 1; }
        a.li = 0;
        hipLaunchKernelGGL(fwd_kernel, dim3(grid), dim3(NTHR), LDS_BYTES, stream, a);
        const hipError_t le = hipPeekAtLastError();
        if (le != hipSuccess) { fprintf(stderr, "kernel_launch: launch %d failed: %s\n", li, hipGetErrorName(le)); break; }
#if defined(MK_CHECKS)
        { const int chk_of_phase[N_PHASES] = {0, 1, 2, 12, 6, 7, 8, 9, 10, 5, 5, 5, 11}; hipLaunchKernelGGL(chk_kernel, dim3(4), dim3(128), 0, stream, a, chk_of_phase[li]); }
#endif
    }
#endif
#if defined(MK_CHECKS)
    hipLaunchKernelGGL(chk_encode, dim3(1), dim3(64), 0, stream, a, MK_CHECKS);
#endif
}
```

```cpp
#include <hip/hip_runtime.h>
#include <cstdio>
#include <cstdint>
#include <cmath>
namespace pg8 {
#define PG8_LAS __attribute__((address_space(3)))
typedef unsigned short bf16_t;
typedef short bf16x8 __attribute__((ext_vector_type(8)));
typedef float f32x4 __attribute__((ext_vector_type(4)));
typedef unsigned u32x4 __attribute__((ext_vector_type(4)));
constexpr int BM = 256, BK = 64, HALF = 128, HTB = HALF * BK * 2  , STAGE_BYTES = 8 * HTB, NXCD = 8, WGM = 8;

__host__ __device__ __forceinline__ int lds_byte(int r, int c) { const int st = (r >> 4) * 2 + (c >> 5), rr = r & 15, cc = c & 31, ob = rr * 64 + cc * 2; return st * 1024 + (ob ^ (((ob >> 9) & 1) << 5)); }
__host__ __device__ __forceinline__ void stage_rc(int b, int& R, int& C) { const int st = b / 1024, sb = b % 1024, swz = sb ^ (((sb >> 9) & 1) << 5); R = (st >> 1) * 16 + swz / 64; C = (st & 1) * 32 + (swz % 64) / 2; }
__host__ __device__ __forceinline__ int perm32(int rho) { const int n = rho >> 4, i = rho & 15; return 8 * (i >> 2) + 4 * n + (i & 3); }

struct Unit { int pm, pn; };
struct Gemm { const bf16_t* A; const bf16_t* Bt; int M, N, K; };

struct StaticOrder {
    int nM, nN, nwg, G, c;
    __host__ __device__ void init(int M, int N, int G_, int c_) { nM = M / BM; nN = N / BM; nwg = nM * nN; G = G_; c = c_; }
    __host__ __device__ bool next(int i, Unit& u) const {
        const long L = (long)i * G + c; if (L >= nwg) return false;
        int wgid = (int)L; { const int q = nwg / NXCD, r = nwg % NXCD, xcd = wgid % NXCD, off = wgid / NXCD; wgid = (xcd < r ? xcd * (q + 1) : r * (q + 1) + (xcd - r) * q) + off; }
        const int nig = WGM * nN, gid = wgid / nig, fm = gid * WGM, gsz = (nM - fm) < WGM ? (nM - fm) : WGM;
        u.pm = fm + ((wgid % nig) % gsz); u.pn = (wgid % nig) / gsz; return true;
    }
    __device__ __forceinline__ void a_ready(const Unit&) const {}
    __device__ __forceinline__ void done(const Unit&) const {}
};

__device__ __forceinline__ unsigned cvt_pk_bf16(float lo, float hi) { unsigned r; asm volatile("v_cvt_pk_bf16_f32 %0, %1, %2" : "=v"(r) : "v"(lo), "v"(hi)); return r; }
typedef float f32x2 __attribute__((ext_vector_type(2)));
__device__ __forceinline__ f32x2 gelu_pk(f32x2 v) {
    const f32x2 av = __builtin_elementwise_abs(v), d = av * 0.2316418882f + 1.0f;
    f32x2 t; t.x = __builtin_amdgcn_rcpf(d.x); t.y = __builtin_amdgcn_rcpf(d.y);
    f32x2 q = t * 0.5307027145f + (-0.7265760135f); q = q * t + 0.7107068705f; q = q * t + (-0.142248368f); q = q * t + 0.127414796f; q = q * t;
    const f32x2 s = (v * v) * (-0.72134752044f);
    f32x2 e; e.x = __builtin_amdgcn_exp2f(s.x); e.y = __builtin_amdgcn_exp2f(s.y);
    const f32x2 m = v * (q * e), r = v - m;
    f32x2 o; o.x = v.x < 0.f ? m.x : r.x; o.y = v.y < 0.f ? m.y : r.y; return o;
}

template <int ACT  > struct EpiBf16 {
    static constexpr bool PERM = true, AFTER_DRAIN = false; static_assert(ACT == 0 || ACT == 1, "EpiBf16: ACT is 0 (none) or 1 (gelu_pk)");
    bf16_t* O; int ldc; const float* bias; int split_cols; size_t split_stride; float scale0;
    __device__ __forceinline__ void operator()(const f32x4 (&acc)[2][2][4][2], const Unit& u, int wr, int wc, int fr, int fq) const {
        const int row0 = u.pm * BM + wr * 64 + fr; int colt = u.pn * BM; bf16_t* base = O;
        float sc = 1.f; if (split_cols) { const int t = colt / split_cols; base += (size_t)t * split_stride; colt -= t * split_cols; if (t == 0) sc = scale0; }
        const int col0 = colt + wc * 32 + 8 * fq, bcol0 = u.pn * BM + wc * 32 + 8 * fq;
        f32x4 bv[2][2];
#pragma unroll
        for (int bj = 0; bj < 2; ++bj)
#pragma unroll
            for (int n = 0; n < 2; ++n) bv[bj][n] = bias ? *(const f32x4*)(bias + bcol0 + bj * HALF + 4 * n) : (f32x4){0.f, 0.f, 0.f, 0.f};
#pragma unroll
        for (int ai = 0; ai < 2; ++ai)
#pragma unroll
            for (int m = 0; m < 4; ++m) { bf16_t* rowp = base + (size_t)(row0 + ai * HALF + m * 16) * ldc + col0;
#pragma unroll
                for (int bj = 0; bj < 2; ++bj) { f32x4 v0 = acc[ai][bj][m][0] + bv[bj][0], v1 = acc[ai][bj][m][1] + bv[bj][1];
                    if (ACT == 1) { f32x2 a = gelu_pk((f32x2){v0[0], v0[1]}), b = gelu_pk((f32x2){v0[2], v0[3]}), c = gelu_pk((f32x2){v1[0], v1[1]}), d = gelu_pk((f32x2){v1[2], v1[3]});
                        v0 = (f32x4){a.x, a.y, b.x, b.y}; v1 = (f32x4){c.x, c.y, d.x, d.y}; }
                    v0 = v0 * sc; v1 = v1 * sc; u32x4 w; w.x = cvt_pk_bf16(v0[0], v0[1]); w.y = cvt_pk_bf16(v0[2], v0[3]); w.z = cvt_pk_bf16(v1[0], v1[1]); w.w = cvt_pk_bf16(v1[2], v1[3]);
                    *(u32x4*)(rowp + bj * HALF) = w; } }
    }
};
template <class Epi, class Sched, bool ALIGN_EPI = false, bool SP2 = false>
__device__ __forceinline__ void gemm_phase(PG8_LAS unsigned char* lds, const Gemm g, const Sched& S, const Epi& E) {
    const int tid = threadIdx.x, wid = __builtin_amdgcn_readfirstlane(tid >> 6), lane = tid & 63, wr = wid >> 2, wc = wid & 3, fr = lane & 15, fq = lane >> 4;
    const int K = g.K, nt = K / BK;
    unsigned voffA[2], voffB[2];
#pragma unroll
    for (int i = 0; i < 2; ++i) { int R, C; stage_rc(tid * 16 + i * 8192, R, C); const int Rb = Epi::PERM ? ((R & ~31) + perm32(R & 31)) : R;
        voffA[i] = (unsigned)(R * K + C) * 2u; voffB[i] = (unsigned)(Rb * K + C) * 2u; }
    const size_t kstep = (size_t)(BK * 2);
    const size_t hstep = (size_t)HALF * K * 2;
    const size_t tstep = 2 * hstep;
    const unsigned ldsw = (unsigned)wid * 1024u;
    const int aoff = lds_byte(wr * 64 + fr, fq * 8), boff = lds_byte(wc * 32 + fr, fq * 8);
#define PG8_SA(b, h) (((b) * 2 + (h)) * HTB)
#define PG8_SB(b, h) ((4 + (b) * 2 + (h)) * HTB)
#define PG8_STAGE(bufoff, gbase, voff) do { _Pragma("unroll") for (int _i = 0; _i < 2; ++_i) \
        __builtin_amdgcn_global_load_lds((const unsigned*)((const char*)(gbase) + (voff)[_i]), (PG8_LAS unsigned*)(lds + (bufoff) + ldsw + _i * 8192), 16, 0, 0); } while (0)
#define PG8_LDA(dst, b, h) do { _Pragma("unroll") for (int m = 0; m < 4; ++m) _Pragma("unroll") for (int k = 0; k < 2; ++k) dst[m][k] = *(const PG8_LAS bf16x8*)(lds + PG8_SA(b, h) + aoff + m * 2048 + k * 1024); } while (0)
#define PG8_LDB(dst, b, h) do { _Pragma("unroll") for (int n = 0; n < 2; ++n) _Pragma("unroll") for (int k = 0; k < 2; ++k) dst[n][k] = *(const PG8_LAS bf16x8*)(lds + PG8_SB(b, h) + boff + n * 2048 + k * 1024); } while (0)
#define PG8_MMA(ai, bj, At, Bt) do { __builtin_amdgcn_s_setprio(1); _Pragma("unroll") for (int m = 0; m < 4; ++m) _Pragma("unroll") for (int n = 0; n < 2; ++n) _Pragma("unroll") for (int k = 0; k < 2; ++k) \
        acc[ai][bj][m][n] = __builtin_amdgcn_mfma_f32_16x16x32_bf16(Bt[n][k], At[m][k], acc[ai][bj][m][n], 0, 0, 0); __builtin_amdgcn_s_setprio(0); } while (0)
#define PG8_WAIT_V(n) asm volatile("s_waitcnt vmcnt(" #n ")" ::: "memory")
#define PG8_WAIT_L(n) asm volatile("s_waitcnt lgkmcnt(" #n ")" ::: "memory")
#define PG8_BAR __builtin_amdgcn_s_barrier()
#define PG8_SCHED __builtin_amdgcn_sched_barrier(0)
    Unit cur, nxt; int ui = 0;
    if (!S.next(0, cur)) return;
    f32x4 acc[2][2][4][2];
#pragma unroll
    for (int a = 0; a < 2; ++a)
#pragma unroll
        for (int b = 0; b < 2; ++b)
#pragma unroll
            for (int m = 0; m < 4; ++m)
#pragma unroll
                for (int n = 0; n < 2; ++n) acc[a][b][m][n] = (f32x4){0.f, 0.f, 0.f, 0.f};
    bf16x8 At[4][2], B0[2][2], B1[2][2];
    const char* cA = (const char*)g.A + (size_t)cur.pm * tstep; const char* cB = (const char*)g.Bt + (size_t)cur.pn * tstep;
    S.a_ready(cur);
    if constexpr (SP2) {
        PG8_STAGE(PG8_SB(0, 0), cB, voffB); PG8_STAGE(PG8_SB(0, 1), cB + hstep, voffB); PG8_STAGE(PG8_SA(0, 0), cA, voffA); PG8_STAGE(PG8_SA(0, 1), cA + hstep, voffA);
        if (wr == 1) PG8_BAR;
        PG8_WAIT_V(2); PG8_BAR;
        PG8_STAGE(PG8_SB(1, 0), cB + kstep, voffB); PG8_STAGE(PG8_SA(1, 0), cA + kstep, voffA); PG8_STAGE(PG8_SB(1, 1), cB + hstep + kstep, voffB);
        PG8_WAIT_V(6); PG8_BAR;
    } else {
        PG8_STAGE(PG8_SB(0, 0), cB, voffB); PG8_STAGE(PG8_SA(0, 0), cA, voffA); PG8_STAGE(PG8_SB(0, 1), cB + hstep, voffB); PG8_STAGE(PG8_SA(0, 1), cA + hstep, voffA);
        if (wr == 1) PG8_BAR;
        PG8_WAIT_V(4); PG8_BAR;
        PG8_STAGE(PG8_SB(1, 0), cB + kstep, voffB); PG8_STAGE(PG8_SA(1, 0), cA + kstep, voffA); PG8_STAGE(PG8_SB(1, 1), cB + hstep + kstep, voffB);
        PG8_WAIT_V(6); PG8_BAR;
    }
    for (;;) {
        const bool has_next = S.next(ui + 1, nxt);
        const char* nA = has_next ? (const char*)g.A + (size_t)nxt.pm * tstep : cA; const char* nB = has_next ? (const char*)g.Bt + (size_t)nxt.pn * tstep : cB;
        for (int t = 0; t < nt; t += 2) {
            const bool last = (t == nt - 2);
            const char* a1 = cA + (size_t)(t + 1) * kstep;
            const char* a2 = last ? nA : cA + (size_t)(t + 2) * kstep; const char* b2 = last ? nB : cB + (size_t)(t + 2) * kstep;
            const char* a3 = a2 + kstep; const char* b3 = b2 + kstep;
            if (last && has_next) S.a_ready(nxt);
            if constexpr (SP2) {
            PG8_LDB(B0, 0, 0); PG8_LDB(B1, 0, 1); PG8_SCHED; PG8_LDA(At, 0, 0); PG8_STAGE(PG8_SA(1, 1), a1 + hstep, voffA);
            PG8_WAIT_V(8); PG8_WAIT_L(0); PG8_BAR; PG8_MMA(0, 0, At, B0); PG8_MMA(0, 1, At, B1); PG8_BAR; PG8_SCHED;
            PG8_LDA(At, 0, 1); PG8_STAGE(PG8_SB(0, 0), b2, voffB); PG8_STAGE(PG8_SB(0, 1), b2 + hstep, voffB); PG8_STAGE(PG8_SA(0, 0), a2, voffA);
            PG8_WAIT_V(8); PG8_WAIT_L(0); PG8_BAR; PG8_MMA(1, 0, At, B0); PG8_MMA(1, 1, At, B1); PG8_BAR; PG8_SCHED;
            PG8_LDB(B0, 1, 0); PG8_LDB(B1, 1, 1); PG8_SCHED; PG8_LDA(At, 1, 0); PG8_STAGE(PG8_SA(0, 1), a2 + hstep, voffA);
            PG8_WAIT_V(8); PG8_WAIT_L(0); PG8_BAR; PG8_MMA(0, 0, At, B0); PG8_MMA(0, 1, At, B1); PG8_BAR; PG8_SCHED;
            PG8_LDA(At, 1, 1); PG8_STAGE(PG8_SB(1, 0), b3, voffB); PG8_STAGE(PG8_SB(1, 1), b3 + hstep, voffB); PG8_STAGE(PG8_SA(1, 0), a3, voffA);
            PG8_WAIT_V(8); PG8_WAIT_L(0); PG8_BAR; PG8_MMA(1, 0, At, B0); PG8_MMA(1, 1, At, B1); PG8_BAR; PG8_SCHED;
            } else {
            PG8_LDB(B0, 0, 0); PG8_SCHED; PG8_LDA(At, 0, 0); PG8_STAGE(PG8_SA(1, 1), a1 + hstep, voffA);
            PG8_WAIT_L(8); PG8_BAR; PG8_WAIT_L(0); PG8_MMA(0, 0, At, B0); PG8_BAR; PG8_SCHED;
            PG8_LDB(B1, 0, 1); PG8_STAGE(PG8_SB(0, 0), b2, voffB);
            PG8_BAR; PG8_WAIT_L(0); PG8_MMA(0, 1, At, B1); PG8_BAR;
            PG8_LDA(At, 0, 1); PG8_STAGE(PG8_SA(0, 0), a2, voffA);
            PG8_BAR; PG8_WAIT_L(0); PG8_MMA(1, 0, At, B0); PG8_BAR; PG8_SCHED;
            PG8_STAGE(PG8_SB(0, 1), b2 + hstep, voffB);
            PG8_WAIT_V(6); PG8_BAR; PG8_MMA(1, 1, At, B1); PG8_BAR;
            PG8_LDB(B0, 1, 0); PG8_SCHED; PG8_LDA(At, 1, 0); PG8_STAGE(PG8_SA(0, 1), a2 + hstep, voffA);
            PG8_WAIT_L(8); PG8_BAR; PG8_WAIT_L(0); PG8_MMA(0, 0, At, B0); PG8_BAR; PG8_SCHED;
            PG8_LDB(B1, 1, 1); PG8_STAGE(PG8_SB(1, 0), b3, voffB);
            PG8_BAR; PG8_WAIT_L(0); PG8_MMA(0, 1, At, B1); PG8_BAR;
            PG8_LDA(At, 1, 1); PG8_STAGE(PG8_SA(1, 0), a3, voffA);
            PG8_BAR; PG8_WAIT_L(0); PG8_MMA(1, 0, At, B0); PG8_BAR; PG8_SCHED;
            PG8_STAGE(PG8_SB(1, 1), b3 + hstep, voffB);
            PG8_WAIT_V(6); PG8_BAR; PG8_MMA(1, 1, At, B1); PG8_BAR;
            }
        }
        if constexpr (ALIGN_EPI) { if (wr == 0) PG8_BAR; }
        if constexpr (!Epi::AFTER_DRAIN) { E(acc, cur, wr, wc, fr, fq); S.done(cur); }
        if (!has_next) break;
#pragma unroll
        for (int a = 0; a < 2; ++a)
#pragma unroll
            for (int b = 0; b < 2; ++b)
#pragma unroll
                for (int m = 0; m < 4; ++m)
#pragma unroll
                    for (int n = 0; n < 2; ++n) acc[a][b][m][n] = (f32x4){0.f, 0.f, 0.f, 0.f};
        cur = nxt; cA = nA; cB = nB; ++ui;
        if constexpr (ALIGN_EPI) { if (wr == 1) PG8_BAR; }
    }
    PG8_WAIT_V(0);
    if constexpr (!ALIGN_EPI) { if (wr == 0) PG8_BAR; }
    PG8_BAR;
    if constexpr (Epi::AFTER_DRAIN) { E.fused(acc, cur, wr, wc, fr, fq, lds, wid, lane); S.done(cur); }
#undef PG8_SA
#undef PG8_SB
#undef PG8_STAGE
#undef PG8_LDA
#undef PG8_LDB
#undef PG8_MMA
#undef PG8_WAIT_V
#undef PG8_WAIT_L
#undef PG8_BAR
#undef PG8_SCHED
}
}
#ifndef PG8_SP2
#define PG8_SP2 true
#endif
#ifndef PG8_ALIGN
#define PG8_ALIGN true
#endif
#ifndef OUT_MODE
#define OUT_MODE 0
#endif
#ifndef REP_MASK
#define REP_MASK 0
#endif
#ifndef S_CONV
#define S_CONV 1
#endif
#ifndef M3_RW
#define M3_RW 2
#endif
#ifndef PU_RSHIFT
#define PU_RSHIFT 11
#endif
#ifndef PU_NB
#define PU_NB 6
#endif
#ifndef PVQ_RB
#define PVQ_RB 16
#endif
#ifndef PUQ_RB
#define PUQ_RB 16
#endif
#ifndef PE_SORT
#define PE_SORT 1
#endif
#ifndef PH_MASK
#define PH_MASK 0xFFFFF
#endif
#ifndef MK_N_LAUNCHES
#define MK_N_LAUNCHES 1
#endif

constexpr int NWAVES = 8, NTHR = NWAVES * 64;
constexpr int BATCH = 2, SEQ = 8192, D = 2048, T = BATCH * SEQ;
constexpr int LRU_W = 1024, CONF_W = 1024, IN_COLS = 4096, LRU_HD = 128;
constexpr int NH = 8, NKEY = 128, TOPK = 16, NEXP = NKEY * NKEY, KSEL = NH * TOPK;
constexpr int NMOD = 6 * D;
constexpr int CHUNK = 64, NCHUNK = SEQ / CHUNK;
constexpr int CONF_K = 31;
constexpr float EPS = 1e-6f;
constexpr int N_PHASES = 13;

constexpr size_t MiB = 1u << 20;
constexpr size_t WS_CTL = 0, CTL_ZERO_BYTES = 64 * 1024;
constexpr size_t WS_MODP = 1 * MiB;
constexpr size_t WS_CFIN = 2 * MiB;
constexpr size_t WS_CARRY = 3 * MiB;
constexpr size_t WS_AGG = 4 * MiB;
constexpr size_t WS_WG = 6 * MiB;
constexpr size_t WS_SUBK = 7 * MiB;
constexpr size_t WS_BT1 = 8 * MiB;
constexpr size_t WS_BT2 = 24 * MiB;
constexpr size_t WS_BT3 = 32 * MiB;
constexpr size_t WS_IDX = 40 * MiB;
constexpr size_t WS_GATE = 48 * MiB;
constexpr size_t WS_USC = 56 * MiB;
constexpr size_t WS_VSC = 57 * MiB;
constexpr size_t WS_RA = 64 * MiB;
constexpr size_t WS_Y1 = 128 * MiB;
constexpr size_t WS_PROJ = 192 * MiB;
constexpr size_t WS_Q = 192 * MiB;
constexpr size_t WS_UB = 256 * MiB;
constexpr size_t WS_XL = 320 * MiB;
constexpr size_t WS_ZC = 352 * MiB;
constexpr size_t WS_Y2 = 384 * MiB;
constexpr size_t WS_SSQ = 58 * MiB;
constexpr size_t WS_HLOC = 384 * MiB;
constexpr size_t WS_PC = 416 * MiB;
constexpr size_t WS_VB = 320 * MiB;
constexpr size_t WS_ACTP = 192 * MiB;
constexpr size_t WS_ACT = 448 * MiB;
constexpr size_t WS_H2Q = 456 * MiB;
constexpr size_t WS_HSC = 488 * MiB;
constexpr size_t WS_END = 489 * MiB;
constexpr int CW_TMO = 0, CW_BAR = 4096;

constexpr int RING_OFF = 0, RING_BYTES = 131072;
constexpr int LDSCTL_OFF = 146432, MISC_OFF = LDSCTL_OFF + 320;
constexpr int LDS_BYTES = 147456;

#define GAS __attribute__((address_space(1)))
#define LAS __attribute__((address_space(3)))
typedef unsigned short bf16;
typedef unsigned v4u __attribute__((ext_vector_type(4)));
typedef unsigned v2u __attribute__((ext_vector_type(2)));
typedef float f32x4 __attribute__((ext_vector_type(4)));
typedef float f32x16 __attribute__((ext_vector_type(16)));
typedef float f32x2 __attribute__((ext_vector_type(2)));
typedef short bf16x8 __attribute__((ext_vector_type(8)));
typedef __bf16 bfp2 __attribute__((ext_vector_type(2)));
typedef GAS unsigned gu32;
#define RLX_AGENT __ATOMIC_RELAXED, __HIP_MEMORY_SCOPE_AGENT
#define LDS_WAIT() asm volatile("s_waitcnt lgkmcnt(0)" ::: "memory")
#define VM_WAIT() asm volatile("s_waitcnt vmcnt(0)" ::: "memory")
__device__ __forceinline__ unsigned f2bf(float f) { unsigned u = __builtin_bit_cast(unsigned, f); return (u + 0x7fffu + ((u >> 16) & 1u)) >> 16; }
__device__ __forceinline__ unsigned pk2(float lo, float hi) { return f2bf(lo) | (f2bf(hi) << 16); }
__device__ __forceinline__ float bflo(unsigned u) { return __builtin_bit_cast(float, u << 16); }
__device__ __forceinline__ float bfhi(unsigned u) { return __builtin_bit_cast(float, u & 0xffff0000u); }
__device__ __forceinline__ float wave_sum(float v) {
#pragma unroll
    for (int o = 1; o < 64; o <<= 1) v += __shfl_xor(v, o);
    return v;
}
__device__ __forceinline__ float dpp_sum63(float v) {
    v += __builtin_bit_cast(float, __builtin_amdgcn_update_dpp(0, __builtin_bit_cast(int, v), 0xB1, 0xF, 0xF, false));
    v += __builtin_bit_cast(float, __builtin_amdgcn_update_dpp(0, __builtin_bit_cast(int, v), 0x4E, 0xF, 0xF, false));
    v += __builtin_bit_cast(float, __builtin_amdgcn_update_dpp(0, __builtin_bit_cast(int, v), 0x141, 0xF, 0xF, false));
    v += __builtin_bit_cast(float, __builtin_amdgcn_update_dpp(0, __builtin_bit_cast(int, v), 0x140, 0xF, 0xF, false));
    v += __builtin_bit_cast(float, __builtin_amdgcn_update_dpp(0, __builtin_bit_cast(int, v), 0x142, 0xA, 0xF, false));
    v += __builtin_bit_cast(float, __builtin_amdgcn_update_dpp(0, __builtin_bit_cast(int, v), 0x143, 0xC, 0xF, false));
    return v;
}

__device__ __forceinline__ float sigmoidf_(float x) { return __builtin_amdgcn_rcpf(1.0f + __expf(-x)); }
__device__ __forceinline__ float gelu_tanh(float x) { return x * sigmoidf_(1.5957691216057308f * (x + 0.044715f * x * x * x)); }
__device__ __forceinline__ float rdlane(float v, int l) { return __builtin_bit_cast(float, __builtin_amdgcn_readlane(__builtin_bit_cast(int, v), l)); }
__device__ __forceinline__ float wave_total(float v) { return rdlane(dpp_sum63(v), 63); }

#define XB_TMO      128
#define XB_XCNT(j)  (256  + 64 * (j))
#define XB_XSUB(j)  (1280 + 64 * (j))
#define XB_XGEN(j)  (2304 + 64 * (j))
#define XB_TOP      3328
#define XB_TOPGEN   3392
#define XCD_BAR_WORDS 3456
#define XB_SPIN_CAP (1u << 18)

__device__ __forceinline__ unsigned xb_ld(unsigned* p)              { return __hip_atomic_load(p, __ATOMIC_RELAXED, __HIP_MEMORY_SCOPE_AGENT); }
__device__ __forceinline__ unsigned xb_add(unsigned* p, unsigned v) { return __hip_atomic_fetch_add(p, v, __ATOMIC_RELAXED, __HIP_MEMORY_SCOPE_AGENT); }
__device__ __forceinline__ unsigned xb_xcc_id() { return (unsigned)__builtin_amdgcn_s_getreg((3 << 11) | 20) & 0xFu; }
#define XB_SPIN(cond, bar) do { unsigned _sp = 0; while (cond) { __builtin_amdgcn_s_sleep(1); \
    if ((++_sp & 255u) == 0u) { if (xb_ld(&(bar)[XB_TMO])) break; if (_sp > XB_SPIN_CAP) { atomicAdd(&(bar)[XB_TMO], 1u); break; } } } } while (0)

struct XcdBarrier {
    unsigned* bar; unsigned x;
    volatile LAS unsigned* st;
};

__device__ __forceinline__ XcdBarrier xcd_barrier_post(unsigned* bar, volatile LAS unsigned* st) {
    XcdBarrier b; b.bar = bar; b.x = xb_xcc_id(); b.st = st;
    if (threadIdx.x == 0) (void)xb_add(&bar[XB_XCNT(b.x)], 1u);
    return b;
}
__device__ __forceinline__ void xcd_barrier_complete(unsigned* bar, unsigned x, unsigned& nloc, unsigned& nx) {
    const unsigned G = gridDim.x * gridDim.y * gridDim.z;
    unsigned sum, cnt, mine, sp = 0u;
    for (;;) {
        sum = 0u; cnt = 0u; mine = 0u;
#pragma unroll
        for (unsigned j = 0; j < 16; ++j) { const unsigned c = xb_ld(&bar[XB_XCNT(j)]); sum += c; cnt += (c > 0u) ? 1u : 0u; mine = (j == x) ? c : mine; }
        if (sum == G) break;
        __builtin_amdgcn_s_sleep(1);
        if ((++sp & 255u) == 0u) { if (xb_ld(&bar[XB_TMO])) break; if (sp > XB_SPIN_CAP) { atomicAdd(&bar[XB_TMO], 1u); break; } }
    }
    nloc = mine > 0u ? mine : 1u; nx = cnt > 0u ? cnt : 1u;
}

__device__ __forceinline__ void xcd_barrier(const XcdBarrier& b) {
    asm volatile("s_waitcnt vmcnt(0)" ::: "memory");
    __syncthreads();
    if (threadIdx.x == 0) {
        unsigned* bar = b.bar;
        __builtin_amdgcn_s_waitcnt(0);
        unsigned nloc = b.st[0], nx = b.st[1];
        if (nloc == 0u) { xcd_barrier_complete(bar, b.x, nloc, nx); b.st[0] = nloc; b.st[1] = nx; }
        const unsigned old = xb_add(&bar[XB_XSUB(b.x)], 1u);
        const unsigned gen = old / nloc;
        if (old + 1u == (gen + 1u) * nloc) {
            __builtin_amdgcn_fence(__ATOMIC_RELEASE, "agent");
            asm volatile("s_waitcnt vmcnt(0)" ::: "memory");
            const unsigned og = xb_add(&bar[XB_TOP], 1u);
            const unsigned tg = og / nx;
            if (og + 1u == (tg + 1u) * nx) xb_add(&bar[XB_TOPGEN], 1u);
            else XB_SPIN(xb_ld(&bar[XB_TOPGEN]) == tg, bar);
            __builtin_amdgcn_fence(__ATOMIC_ACQUIRE, "agent");
            xb_add(&bar[XB_XGEN(b.x)], 1u);
            asm volatile("s_waitcnt vmcnt(0)" ::: "memory");
        } else {
            XB_SPIN(xb_ld(&bar[XB_XGEN(b.x)]) == gen, bar);
            __builtin_amdgcn_fence(__ATOMIC_ACQUIRE, "agent");
            asm volatile("s_waitcnt vmcnt(0)" ::: "memory");
        }
    }
    __syncthreads();
}
struct Args { const float* in[25]; float* out; unsigned char* ws; int ph_lo, ph_hi, li, pad; };
enum { I_X = 0, I_C, I_WMOD, I_BMOD, I_GPREMIX, I_GPOSTMIX, I_GPREFFN, I_GPOSTFFN, I_WIN, I_LCW, I_LCB, I_WA, I_BA, I_WX, I_BX, I_LAMBDA,
       I_CDW, I_CDB, I_LNG, I_LNB, I_WOUT, I_WQ, I_SUBK, I_PU, I_PV };

__device__ __forceinline__ float mod_at(const float* modp, int b, int n) {
    return (modp[(0 * 2 + b) * NMOD + n] + modp[(1 * 2 + b) * NMOD + n]) + (modp[(2 * 2 + b) * NMOD + n] + modp[(3 * 2 + b) * NMOD + n]);
}

__device__ __forceinline__ void p0_transpose_item(const float* W, int K, int N, bf16* WT, LAS float* scr, int item, int lane) {
    const int nblk = N / 32, kb = item / nblk, nb = item % nblk, k0 = 64 * kb, n0 = 32 * nb;
#pragma unroll 8
    for (int i = 0; i < 32; ++i) { const int kk = 2 * i + (lane >> 5); scr[kk * 33 + (lane & 31)] = W[(size_t)(k0 + kk) * N + n0 + (lane & 31)]; }
    LDS_WAIT(); asm volatile("" ::: "memory");
    const int c = lane & 7;
#pragma unroll
    for (int j = 0; j < 4; ++j) { const int n = (lane >> 3) + 8 * j; const LAS float* s = scr + (8 * c) * 33 + n;
        v4u o; o.x = pk2(s[0 * 33], s[1 * 33]); o.y = pk2(s[2 * 33], s[3 * 33]); o.z = pk2(s[4 * 33], s[5 * 33]); o.w = pk2(s[6 * 33], s[7 * 33]);
        *(GAS v4u*)(WT + (size_t)(n0 + n) * K + k0 + 8 * c) = o; }
    LDS_WAIT(); asm volatile("" ::: "memory");
}
__device__ __forceinline__ void cvt_rows_bf16(const float* src, bf16* dst, size_t n8, size_t gt, size_t ngt) {
    for (size_t i = gt; i < n8; i += ngt) {
        const f32x4 a = ((const GAS f32x4*)src)[2 * i], b = ((const GAS f32x4*)src)[2 * i + 1];
        v4u o; o.x = pk2(a.x, a.y); o.y = pk2(a.z, a.w); o.z = pk2(b.x, b.y); o.w = pk2(b.z, b.w);
        ((GAS v4u*)dst)[i] = o; }
}
__device__ __forceinline__ void phase_p0(const Args& A, LAS unsigned char* lds, int tid, int lane, int wave, int bid, int G) {
    float* modp = (float*)(A.ws + WS_MODP);
    for (int item = bid; item < 192; item += G) {
        const int cg = item % 48, kq = item / 48, k0 = kq * 512 + wave * 64, n0 = cg * 256 + lane * 4;
        const float c0 = A.in[I_C][k0 + lane], c1 = A.in[I_C][D + k0 + lane];
        const float ca0 = c0 * sigmoidf_(c0), ca1 = c1 * sigmoidf_(c1);
        f32x4 a0 = {0.f, 0.f, 0.f, 0.f}, a1 = {0.f, 0.f, 0.f, 0.f};
        const float* wp = A.in[I_WMOD] + (size_t)k0 * NMOD + n0;
#pragma unroll 8
        for (int kk = 0; kk < 64; ++kk) {
            const f32x4 w = *(const GAS f32x4*)(wp + (size_t)kk * NMOD);
            const float s0 = __shfl(ca0, kk), s1 = __shfl(ca1, kk);
            a0 += w * s0; a1 += w * s1;
        }
        LAS f32x4* red = (LAS f32x4*)lds;
        red[(wave * 2 + 0) * 64 + lane] = a0; red[(wave * 2 + 1) * 64 + lane] = a1;
        __syncthreads();
        { const int b = tid >> 8, col = tid & 255; const LAS float* rf = (const LAS float*)lds; float s = 0.f;
#pragma unroll
          for (int w = 0; w < 8; ++w) s += rf[((w * 2 + b) * 64) * 4 + col];
          if (kq == 0) s += A.in[I_BMOD][cg * 256 + col];
          modp[(kq * 2 + b) * NMOD + cg * 256 + col] = s; }
        __syncthreads();
    }
    {
        LAS float* scr = (LAS float*)(lds + wave * 16384);
        const int gw = bid * NWAVES + wave, NGW = G * NWAVES;
        constexpr int I1 = (D / 64) * (IN_COLS / 32), I2 = (D / 64) * (D / 32);
        for (int it = gw; it < I1 + 2 * I2; it += NGW) {
            int r = it;
            if (r < I1) { p0_transpose_item(A.in[I_WIN], D, IN_COLS, (bf16*)(A.ws + WS_BT1), scr, r, lane); continue; } r -= I1;
            if (r < I2) { p0_transpose_item(A.in[I_WOUT], D, D, (bf16*)(A.ws + WS_BT2), scr, r, lane); continue; } r -= I2;
            p0_transpose_item(A.in[I_WQ], D, D, (bf16*)(A.ws + WS_BT3), scr, r, lane);
        }
    }
    {
        const int gt = bid * NTHR + tid, ngt = G * NTHR;
        bf16* wg = (bf16*)(A.ws + WS_WG);
        for (int e = gt; e < NH * 256 * 128; e += ngt) {
            const int h = e >> 15, n = (e >> 7) & 255, k = e & 127;
            const float v = (n < 128 ? A.in[I_WA] : A.in[I_WX])[h * 16384 + k * 128 + (n & 127)];
            wg[e] = (bf16)f2bf(v);
        }
        cvt_rows_bf16(A.in[I_SUBK], (bf16*)(A.ws + WS_SUBK), (size_t)NH * 2 * NKEY * 128 / 8, gt, ngt);
    }
}

__device__ __forceinline__ void phase_p1(const Args& A, int tid, int lane, int wave, int bid, int G) {
    const float* modp = (const float*)(A.ws + WS_MODP);
    {
        float* cfin = (float*)(A.ws + WS_CFIN);
        for (int e = bid * NTHR + tid; e < 2 * 2 * D; e += G * NTHR) {
            const int b = e >> 12, arr = (e >> 11) & 1, col = e & (D - 1);
            cfin[e] = arr == 0 ? mod_at(modp, b, 2 * D + col) * A.in[I_GPOSTMIX][col] : mod_at(modp, b, 5 * D + col) * A.in[I_GPOSTFFN][col];
        }
        float* cfe = (float*)(A.ws + WS_CFIN) + 4 * D;
        for (int e = bid * NTHR + tid; e < 2 * 2 * D; e += G * NTHR) {
            const int b = e >> 12, arr = (e >> 11) & 1, col = e & (D - 1);
            cfe[e] = arr == 0 ? A.in[I_GPREFFN][col] * (1.0f + mod_at(modp, b, 4 * D + col)) : mod_at(modp, b, 3 * D + col);
        }
    }
    const int gw = bid * NWAVES + wave, NGW = G * NWAVES;
    bf16* h1 = (bf16*)(A.ws + WS_RA);
    int cb = -1; float gs[4][8], sh[4][8];
    for (int row = gw; row < T; row += NGW) {
        const int b = row >> 13;
        if (b != cb) { cb = b;
#pragma unroll
            for (int j = 0; j < 4; ++j)
#pragma unroll
                for (int e = 0; e < 8; ++e) { const int col = j * 512 + lane * 8 + e;
                    gs[j][e] = A.in[I_GPREMIX][col] * (1.0f + mod_at(modp, b, D + col)); sh[j][e] = mod_at(modp, b, col); } }
        const GAS f32x4* xr = (const GAS f32x4*)(A.in[I_X] + (size_t)row * D) + lane * 2;
        f32x4 v[4][2]; float s = 0.f;
#pragma unroll
        for (int j = 0; j < 4; ++j) { v[j][0] = xr[j * 128]; v[j][1] = xr[j * 128 + 1];
            s += (v[j][0].x * v[j][0].x + v[j][0].y * v[j][0].y) + (v[j][0].z * v[j][0].z + v[j][0].w * v[j][0].w);
            s += (v[j][1].x * v[j][1].x + v[j][1].y * v[j][1].y) + (v[j][1].z * v[j][1].z + v[j][1].w * v[j][1].w); }
        const float rstd = __builtin_amdgcn_rsqf(wave_total(s) * (1.0f / D) + EPS);
        GAS v4u* orow = (GAS v4u*)(h1 + (size_t)row * D) + lane;
#pragma unroll
        for (int j = 0; j < 4; ++j) { float o[8];
#pragma unroll
            for (int e = 0; e < 8; ++e) o[e] = v[j][e >> 2][e & 3] * rstd * gs[j][e] + sh[j][e];
            v4u w; w.x = pk2(o[0], o[1]); w.y = pk2(o[2], o[3]); w.z = pk2(o[4], o[5]); w.w = pk2(o[6], o[7]);
            orow[j * 64] = w; }
    }
}

__device__ __forceinline__ void m1a_tile_issue(const bf16* proj, int item, int tid, v4u (&rv)[5], v4u (&rg)[5]) {
    const int b = item >> 9, tt = (item >> 3) & 63, ct = item & 7, t0 = tt * 128;
#pragma unroll
    for (int i = 0; i < 5; ++i) {
        const int e = tid + i * NTHR, r = e >> 4, c8 = (e & 15) * 8, t = t0 - 30 + r;
        rv[i] = (v4u){0u, 0u, 0u, 0u}; rg[i] = (v4u){0u, 0u, 0u, 0u};
        if (e < 158 * 16 && t >= 0) { const bf16* p = proj + (size_t)(b * SEQ + t) * IN_COLS + 2048 + ct * 128 + c8; rv[i] = *(const GAS v4u*)p; rg[i] = *(const GAS v4u*)(p + 1024); }
    }
}
__device__ __forceinline__ void phase_m1a(const Args& A, LAS unsigned char* lds, int tid, int lane, int wave, int bid, int G) {
    const bf16* proj = (const bf16*)(A.ws + WS_PROJ);
    {
        bf16* zc = (bf16*)(A.ws + WS_ZC);
        const float* w31 = A.in[I_CDW]; const float* b31 = A.in[I_CDB];
        LAS float* zt = (LAS float*)lds;
        const int cp = tid & 63, tg = tid >> 6;
        v4u rv[5], rg[5];
        int item = bid;
        if (item < 2 * 64 * 8) m1a_tile_issue(proj, item, tid, rv, rg);
        float w0[CONF_K], w1[CONF_K], bias0 = 0.f, bias1 = 0.f; int wct = -1;
        for (; item < 2 * 64 * 8; item += G) {
            const int b = item >> 9, tt = (item >> 3) & 63, ct = item & 7, t0 = tt * 128, ch = ct * 128 + 2 * cp;
            if (ct != wct) { wct = ct;
#pragma unroll
                for (int j = 0; j < CONF_K; ++j) { const f32x2 ww = *(const GAS f32x2*)(w31 + j * CONF_W + ch); w0[j] = ww.x; w1[j] = ww.y; }
                const f32x2 bw = *(const GAS f32x2*)(b31 + ch); bias0 = bw.x; bias1 = bw.y; }
            __syncthreads();
#pragma unroll
            for (int i = 0; i < 5; ++i) {
                const int e = tid + i * NTHR, r = e >> 4, c8 = (e & 15) * 8;
                if (e < 158 * 16) { const v4u v = rv[i], g = rg[i]; f32x4 z0, z1;
                    z0.x = bflo(v.x) * sigmoidf_(bflo(g.x)); z0.y = bfhi(v.x) * sigmoidf_(bfhi(g.x)); z0.z = bflo(v.y) * sigmoidf_(bflo(g.y)); z0.w = bfhi(v.y) * sigmoidf_(bfhi(g.y));
                    z1.x = bflo(v.z) * sigmoidf_(bflo(g.z)); z1.y = bfhi(v.z) * sigmoidf_(bfhi(g.z)); z1.z = bflo(v.w) * sigmoidf_(bflo(g.w)); z1.w = bfhi(v.w) * sigmoidf_(bfhi(g.w));
                    *(LAS f32x4*)(zt + r * 128 + c8) = z0; *(LAS f32x4*)(zt + r * 128 + c8 + 4) = z1; }
            }
            __syncthreads();
            if (item + G < 2 * 64 * 8) m1a_tile_issue(proj, item + G, tid, rv, rg);
            float a0[16], a1[16];
#pragma unroll
            for (int i = 0; i < 16; ++i) { a0[i] = bias0; a1[i] = bias1; }
#pragma unroll
            for (int s_ = 0; s_ < 46; ++s_) {
                const f32x2 v = *(const LAS f32x2*)(zt + (tg * 16 + s_) * 128 + 2 * cp);
#pragma unroll
                for (int i = 0; i < 16; ++i) if (s_ - i >= 0 && s_ - i < CONF_K) { a0[i] += w0[s_ - i] * v.x; a1[i] += w1[s_ - i] * v.y; }
            }
            bf16* zo = zc + (size_t)(b * SEQ + t0 + tg * 16) * CONF_W + ch;
#pragma unroll
            for (int i = 0; i < 16; ++i) *(GAS unsigned*)(zo + (size_t)i * CONF_W) = pk2(a0[i], a1[i]);
        }
        __syncthreads();
    }
}

template <int CTRL> __device__ __forceinline__ float dpp_shr(float v, float ident) {
    return __builtin_bit_cast(float, __builtin_amdgcn_update_dpp(__builtin_bit_cast(int, ident), __builtin_bit_cast(int, v), CTRL, 0xF, 0xF, false));
}
constexpr int XT_PITCH = 2064;   static_assert(64 * 2064 <= LDSCTL_OFF, "xl tile vs LDS control words");
__device__ __forceinline__ void phase_m1b(const Args& A, LAS unsigned char* lds, int tid, int lane, int wave, int bid, int G) {
    const bf16* proj = (const bf16*)(A.ws + WS_PROJ); const bf16* wg = (const bf16*)(A.ws + WS_WG);
    bf16* hloc = (bf16*)(A.ws + WS_HLOC); bf16* pc = (bf16*)(A.ws + WS_PC); float* agg = (float*)(A.ws + WS_AGG);
    const int fr = lane & 15, fq = lane >> 4;
    for (int wi = bid; wi < 2 * NCHUNK; wi += G) {
        const int hh = wave, chunk = wi & (NCHUNK - 1), b = wi >> 7;
        const size_t r0 = (size_t)b * SEQ + (size_t)chunk * CHUNK;
        __syncthreads();
        {
            const float* w4 = A.in[I_LCW]; const float* b4 = A.in[I_LCB];
            const int c0 = (tid & 127) * 8, tr = tid >> 7, t0 = chunk * CHUNK + tr * 16;
            v4u in[19];
#pragma unroll
            for (int r = 0; r < 19; ++r) { in[r] = (v4u){0u, 0u, 0u, 0u}; if (t0 - 3 + r >= 0) in[r] = *(const GAS v4u*)(proj + ((size_t)b * SEQ + t0 - 3 + r) * IN_COLS + c0); }
            float w[4][8], bb[8];
#pragma unroll
            for (int j = 0; j < 4; ++j) { const f32x4 wa_ = *(const GAS f32x4*)(w4 + j * LRU_W + c0), wb_ = *(const GAS f32x4*)(w4 + j * LRU_W + c0 + 4);
                w[j][0] = wa_.x; w[j][1] = wa_.y; w[j][2] = wa_.z; w[j][3] = wa_.w; w[j][4] = wb_.x; w[j][5] = wb_.y; w[j][6] = wb_.z; w[j][7] = wb_.w; }
            { const f32x4 ba = *(const GAS f32x4*)(b4 + c0), bc = *(const GAS f32x4*)(b4 + c0 + 4); bb[0] = ba.x; bb[1] = ba.y; bb[2] = ba.z; bb[3] = ba.w; bb[4] = bc.x; bb[5] = bc.y; bb[6] = bc.z; bb[7] = bc.w; }
#pragma unroll
            for (int i = 0; i < 16; ++i) { float acc[8];
#pragma unroll
                for (int e = 0; e < 8; ++e) acc[e] = bb[e];
#pragma unroll
                for (int j = 0; j < 4; ++j) { const v4u v = in[i + j];
                    acc[0] += w[j][0] * bflo(v.x); acc[1] += w[j][1] * bfhi(v.x); acc[2] += w[j][2] * bflo(v.y); acc[3] += w[j][3] * bfhi(v.y);
                    acc[4] += w[j][4] * bflo(v.z); acc[5] += w[j][5] * bfhi(v.z); acc[6] += w[j][6] * bflo(v.w); acc[7] += w[j][7] * bfhi(v.w); }
                v4u o; o.x = pk2(acc[0], acc[1]); o.y = pk2(acc[2], acc[3]); o.z = pk2(acc[4], acc[5]); o.w = pk2(acc[6], acc[7]);
                *(LAS v4u*)(lds + (tr * 16 + i) * XT_PITCH + c0 * 2) = o; }
        }
        __syncthreads();
        bf16x8 xf[4][4];
#pragma unroll
        for (int mt = 0; mt < 4; ++mt)
#pragma unroll
            for (int ks = 0; ks < 4; ++ks) xf[mt][ks] = *(const LAS bf16x8*)(lds + (16 * mt + fr) * XT_PITCH + (hh * LRU_HD + 32 * ks + 8 * fq) * 2);
        float cP[4], cH[4];
        for (int j = 0; j < 8; ++j) {
            const int chb = hh * LRU_HD + 16 * j + 4 * fq;
            bf16x8 wa[4], wx[4];
#pragma unroll
            for (int ks = 0; ks < 4; ++ks) { wa[ks] = *(const GAS bf16x8*)(wg + (size_t)(hh * 256 + 16 * j + fr) * 128 + 32 * ks + 8 * fq);
                                             wx[ks] = *(const GAS bf16x8*)(wg + (size_t)(hh * 256 + 128 + 16 * j + fr) * 128 + 32 * ks + 8 * fq); }
            const f32x4 bav = *(const GAS f32x4*)(A.in[I_BA] + chb), bxv = *(const GAS f32x4*)(A.in[I_BX] + chb), lam = *(const GAS f32x4*)(A.in[I_LAMBDA] + chb);
            float cl[4];
#pragma unroll
            for (int r = 0; r < 4; ++r) { cl[r] = -8.0f * log1pf(__expf(-lam[r])); cP[r] = 1.f; cH[r] = 0.f; }
#pragma unroll
            for (int mt = 0; mt < 4; ++mt) {
                f32x4 ar = {0.f, 0.f, 0.f, 0.f}, ai = {0.f, 0.f, 0.f, 0.f};
#pragma unroll
                for (int ks = 0; ks < 4; ++ks) { ar = __builtin_amdgcn_mfma_f32_16x16x32_bf16(wa[ks], xf[mt][ks], ar, 0, 0, 0);
                                                 ai = __builtin_amdgcn_mfma_f32_16x16x32_bf16(wx[ks], xf[mt][ks], ai, 0, 0, 0); }
                const v2u xv = *(const LAS v2u*)(lds + (16 * mt + fr) * XT_PITCH + chb * 2);
                const float xlv[4] = {bflo(xv.x), bfhi(xv.x), bflo(xv.y), bfhi(xv.y)};
                float P[4], H[4];
#pragma unroll
                for (int r = 0; r < 4; ++r) {
                    const float rg = sigmoidf_(ar[r] + bav[r]), ig = sigmoidf_(ai[r] + bxv[r]);
                    const float la = cl[r] * rg, a = __expf(la), mult = sqrtf(fmaxf(1.0f - a * a, 0.f));
                    float p = a, h = mult * ig * xlv[r];
                    { float pp, hp;
                      pp = dpp_shr<0x111>(p, 1.0f); hp = dpp_shr<0x111>(h, 0.0f); h = p * hp + h; p = p * pp;
                      pp = dpp_shr<0x112>(p, 1.0f); hp = dpp_shr<0x112>(h, 0.0f); h = p * hp + h; p = p * pp;
                      pp = dpp_shr<0x114>(p, 1.0f); hp = dpp_shr<0x114>(h, 0.0f); h = p * hp + h; p = p * pp;
                      pp = dpp_shr<0x118>(p, 1.0f); hp = dpp_shr<0x118>(h, 0.0f); h = p * hp + h; p = p * pp; }
                    h = h + p * cH[r]; p = p * cP[r];
                    P[r] = p; H[r] = h;
                    cP[r] = __shfl(p, 15, 16); cH[r] = __shfl(h, 15, 16);
                }
                v2u ho, po; ho.x = pk2(H[0], H[1]); ho.y = pk2(H[2], H[3]); po.x = pk2(P[0], P[1]); po.y = pk2(P[2], P[3]);
                *(GAS v2u*)(hloc + (r0 + 16 * mt + fr) * LRU_W + chb) = ho;
                *(GAS v2u*)(pc + (r0 + 16 * mt + fr) * LRU_W + chb) = po;
            }
            if (fr == 0) {
                float* ag = agg + ((size_t)(b * NCHUNK + chunk) * LRU_W + chb) * 2;
                *(GAS f32x4*)ag = (f32x4){cP[0], cH[0], cP[1], cH[1]}; *(GAS f32x4*)(ag + 4) = (f32x4){cP[2], cH[2], cP[3], cH[3]};
            }
        }
    }
}

__device__ __forceinline__ void phase_m3(const Args& A, LAS unsigned char* lds, int tid, int lane, int wave, int bid, int G) {
    const bf16* proj = (const bf16*)(A.ws + WS_PROJ); const bf16* hloc = (const bf16*)(A.ws + WS_HLOC); const bf16* pc = (const bf16*)(A.ws + WS_PC);
    const bf16* zc = (const bf16*)(A.ws + WS_ZC); const float* agg = (const float*)(A.ws + WS_AGG);
    bf16* a2 = (bf16*)(A.ws + WS_RA);
    LAS float* cs = (LAS float*)lds;
    float lg[2][8], lb[2][8];
#pragma unroll
    for (int jj = 0; jj < 2; ++jj)
#pragma unroll
        for (int e = 0; e < 8; ++e) { lg[jj][e] = A.in[I_LNG][jj * 512 + lane * 8 + e]; lb[jj][e] = A.in[I_LNB][jj * 512 + lane * 8 + e]; }
    for (int item = bid; item < 2 * NCHUNK; item += G) {
        const int b = item >> 7, chunk = item & (NCHUNK - 1);
        {   float h0 = 0.f, h1 = 0.f; const float* ap = agg + ((size_t)(b * NCHUNK) * LRU_W + 2 * tid) * 2;
#pragma unroll 8
            for (int c = 0; c < chunk; ++c) { const f32x4 ab = *(const GAS f32x4*)(ap + (size_t)c * LRU_W * 2); h0 = ab.x * h0 + ab.y; h1 = ab.z * h1 + ab.w; }
            __syncthreads();
            cs[2 * tid] = h0; cs[2 * tid + 1] = h1;
            __syncthreads(); }
        for (int rr = 0; rr < 8; rr += M3_RW) {
            const int row0 = b * SEQ + chunk * CHUNK + wave * 8 + rr;
            v4u hv[M3_RW][2], pv[M3_RW][2], gv[M3_RW][2], zq[M3_RW][2];
#pragma unroll
            for (int u = 0; u < M3_RW; ++u)
#pragma unroll
                for (int jj = 0; jj < 2; ++jj) { const int c0 = jj * 512 + lane * 8; const size_t row = (size_t)(row0 + u);
                    hv[u][jj] = *(const GAS v4u*)(hloc + row * LRU_W + c0); pv[u][jj] = *(const GAS v4u*)(pc + row * LRU_W + c0);
                    gv[u][jj] = *(const GAS v4u*)(proj + row * IN_COLS + 1024 + c0); zq[u][jj] = *(const GAS v4u*)(zc + row * CONF_W + c0); }
#pragma unroll
            for (int u = 0; u < M3_RW; ++u) {
                const size_t row = (size_t)(row0 + u);
                float zv[2][8]; float s = 0.f;
#pragma unroll
                for (int jj = 0; jj < 2; ++jj) {
                    const int c0 = jj * 512 + lane * 8;
                    const f32x4 ca = *(const LAS f32x4*)(cs + c0), cb = *(const LAS f32x4*)(cs + c0 + 4);
                    const v4u h_ = hv[u][jj], p_ = pv[u][jj], g_ = gv[u][jj], z = zq[u][jj];
                    float y[8];
                    y[0] = (bflo(h_.x) + bflo(p_.x) * ca.x) * gelu_tanh(bflo(g_.x)); y[1] = (bfhi(h_.x) + bfhi(p_.x) * ca.y) * gelu_tanh(bfhi(g_.x));
                    y[2] = (bflo(h_.y) + bflo(p_.y) * ca.z) * gelu_tanh(bflo(g_.y)); y[3] = (bfhi(h_.y) + bfhi(p_.y) * ca.w) * gelu_tanh(bfhi(g_.y));
                    y[4] = (bflo(h_.z) + bflo(p_.z) * cb.x) * gelu_tanh(bflo(g_.z)); y[5] = (bfhi(h_.z) + bfhi(p_.z) * cb.y) * gelu_tanh(bfhi(g_.z));
                    y[6] = (bflo(h_.w) + bflo(p_.w) * cb.z) * gelu_tanh(bflo(g_.w)); y[7] = (bfhi(h_.w) + bfhi(p_.w) * cb.w) * gelu_tanh(bfhi(g_.w));
                    v4u o; o.x = pk2(y[0], y[1]); o.y = pk2(y[2], y[3]); o.z = pk2(y[4], y[5]); o.w = pk2(y[6], y[7]);
                    *(GAS v4u*)(a2 + row * D + c0) = o;
                    zv[jj][0] = bflo(z.x); zv[jj][1] = bfhi(z.x); zv[jj][2] = bflo(z.y); zv[jj][3] = bfhi(z.y); zv[jj][4] = bflo(z.z); zv[jj][5] = bfhi(z.z); zv[jj][6] = bflo(z.w); zv[jj][7] = bfhi(z.w);
#pragma unroll
                    for (int e = 0; e < 8; ++e) s += zv[jj][e];
                }
                const float mean = wave_total(s) * (1.0f / CONF_W); float q = 0.f;
#pragma unroll
                for (int jj = 0; jj < 2; ++jj)
#pragma unroll
                    for (int e = 0; e < 8; ++e) { zv[jj][e] -= mean; q += zv[jj][e] * zv[jj][e]; }
                const float rstd = __builtin_amdgcn_rsqf(wave_total(q) * (1.0f / CONF_W) + EPS);
#pragma unroll
                for (int jj = 0; jj < 2; ++jj) { float o[8];
#pragma unroll
                    for (int e = 0; e < 8; ++e) { const float n = zv[jj][e] * rstd * lg[jj][e] + lb[jj][e]; o[e] = n * sigmoidf_(n); }
                    v4u w; w.x = pk2(o[0], o[1]); w.y = pk2(o[2], o[3]); w.z = pk2(o[4], o[5]); w.w = pk2(o[6], o[7]);
                    *(GAS v4u*)(a2 + row * D + 1024 + jj * 512 + lane * 8) = w; }
            }
        }
    }
}

__device__ __forceinline__ f32x2 fp8lo(unsigned w) { return __builtin_amdgcn_cvt_pk_f32_fp8((int)w, false); }
__device__ __forceinline__ f32x2 fp8hi(unsigned w) { return __builtin_amdgcn_cvt_pk_f32_fp8((int)w, true); }
constexpr int CVT_ROWS = 4;
template <bool I8> __device__ __forceinline__ void cvt_table_q8(const float* src, unsigned char* dst, float* inv_scale, int gw, int NGW, int lane) {
    for (int r0 = gw; r0 < NEXP; r0 += NGW * CVT_ROWS) {
        f32x4 v[CVT_ROWS][8];
#pragma unroll
        for (int q = 0; q < CVT_ROWS; ++q) { const int r = r0 + q * NGW; const GAS f32x4* p = (const GAS f32x4*)(src + (size_t)(r < NEXP ? r : r0) * D) + lane;
#pragma unroll
            for (int i = 0; i < 8; ++i) v[q][i] = p[i * 64]; }
#pragma unroll
        for (int q = 0; q < CVT_ROWS; ++q) { const int r = r0 + q * NGW; float m = 0.f;
#pragma unroll
            for (int i = 0; i < 8; ++i) m = fmaxf(m, fmaxf(fmaxf(fabsf(v[q][i].x), fabsf(v[q][i].y)), fmaxf(fabsf(v[q][i].z), fabsf(v[q][i].w))));
#pragma unroll
            for (int o = 1; o < 64; o <<= 1) m = fmaxf(m, __shfl_xor(m, o));
            const float QM = I8 ? 127.0f : 448.0f;
            const float sc = m > 0.f ? QM / m : 1.0f;
            if (r < NEXP) {
                GAS unsigned* o4 = (GAS unsigned*)(dst + (size_t)r * D) + lane;
#pragma unroll
                for (int i = 0; i < 8; ++i) { const f32x4 t = v[q][i] * sc;
                    const float a = fminf(fmaxf(t.x, -QM), QM), b = fminf(fmaxf(t.y, -QM), QM), c = fminf(fmaxf(t.z, -QM), QM), d = fminf(fmaxf(t.w, -QM), QM);
                    if (I8) { o4[i * 64] = (unsigned)(((int)rintf(a) & 255) | (((int)rintf(b) & 255) << 8) | (((int)rintf(c) & 255) << 16) | ((int)rintf(d) << 24)); }
                    else { int pk = __builtin_amdgcn_cvt_pk_fp8_f32(a, b, 0, false); pk = __builtin_amdgcn_cvt_pk_fp8_f32(c, d, pk, true); o4[i * 64] = (unsigned)pk; } }
                if (lane == 0) inv_scale[r] = m > 0.f ? m * (1.0f / QM) : 1.0f;
            }
        }
    }
}
__device__ __forceinline__ void phase_e2(const Args& A, int tid, int lane, int wave, int bid, int G) {
    const float* modp = (const float*)(A.ws + WS_MODP); const float* cfin = (const float*)(A.ws + WS_CFIN);
    const bf16* y1 = (const bf16*)(A.ws + WS_Y1); bf16* h2 = (bf16*)(A.ws + WS_RA);
    const int gw = bid * NWAVES + wave, NGW = G * NWAVES;
    const float* cfe = (const float*)(A.ws + WS_CFIN) + 4 * D;
    for (int row = gw; row < T; row += NGW) {
        const int b = row >> 13;
        const GAS f32x4* xr = (const GAS f32x4*)(A.in[I_X] + (size_t)row * D) + lane * 2;
        const GAS v4u* yr = (const GAS v4u*)(y1 + (size_t)row * D) + lane;
        const GAS f32x4* cf = (const GAS f32x4*)(cfin + (size_t)(b * 2 + 0) * D) + lane * 2;
        float xv[4][8], yv[4][8]; float s1 = 0.f;
#pragma unroll
        for (int j = 0; j < 4; ++j) { const f32x4 a = xr[j * 128], c = xr[j * 128 + 1]; const v4u y = yr[j * 64];
            xv[j][0] = a.x; xv[j][1] = a.y; xv[j][2] = a.z; xv[j][3] = a.w; xv[j][4] = c.x; xv[j][5] = c.y; xv[j][6] = c.z; xv[j][7] = c.w;
            yv[j][0] = bflo(y.x); yv[j][1] = bfhi(y.x); yv[j][2] = bflo(y.y); yv[j][3] = bfhi(y.y); yv[j][4] = bflo(y.z); yv[j][5] = bfhi(y.z); yv[j][6] = bflo(y.w); yv[j][7] = bfhi(y.w);
#pragma unroll
            for (int e = 0; e < 8; ++e) s1 += yv[j][e] * yv[j][e]; }
        const float rstd1 = __builtin_amdgcn_rsqf(wave_total(s1) * (1.0f / D) + EPS); float s2 = 0.f;
#pragma unroll
        for (int j = 0; j < 4; ++j) { const f32x4 ca = cf[j * 128], cc = cf[j * 128 + 1]; const float cg[8] = {ca.x, ca.y, ca.z, ca.w, cc.x, cc.y, cc.z, cc.w};
#pragma unroll
            for (int e = 0; e < 8; ++e) { xv[j][e] += cg[e] * yv[j][e] * rstd1; s2 += xv[j][e] * xv[j][e]; } }
        const float rstd2 = __builtin_amdgcn_rsqf(wave_total(s2) * (1.0f / D) + EPS);
        GAS v4u* orow = (GAS v4u*)(h2 + (size_t)row * D) + lane; float am = 0.f;
#pragma unroll
        for (int j = 0; j < 4; ++j) {
            const GAS f32x4* ge = (const GAS f32x4*)(cfe + (size_t)(b * 2 + 0) * D) + lane * 2 + j * 128; const GAS f32x4* se = (const GAS f32x4*)(cfe + (size_t)(b * 2 + 1) * D) + lane * 2 + j * 128;
            const f32x4 g0_ = ge[0], g1_ = ge[1], s0_ = se[0], s1_ = se[1]; const float gsv[8] = {g0_.x, g0_.y, g0_.z, g0_.w, g1_.x, g1_.y, g1_.z, g1_.w}, shv[8] = {s0_.x, s0_.y, s0_.z, s0_.w, s1_.x, s1_.y, s1_.z, s1_.w};
#pragma unroll
            for (int e = 0; e < 8; ++e) { xv[j][e] = xv[j][e] * rstd2 * gsv[e] + shv[e]; am = fmaxf(am, fabsf(xv[j][e])); }
            v4u w; w.x = pk2(xv[j][0], xv[j][1]); w.y = pk2(xv[j][2], xv[j][3]); w.z = pk2(xv[j][4], xv[j][5]); w.w = pk2(xv[j][6], xv[j][7]);
            orow[j * 64] = w; }
#pragma unroll
        for (int o = 1; o < 64; o <<= 1) am = fmaxf(am, __shfl_xor(am, o));
        const float qs = am > 0.f ? 127.0f / am : 1.0f;
        GAS v2u* qrow = (GAS v2u*)(A.ws + WS_H2Q + (size_t)row * D) + lane;
#pragma unroll
        for (int j = 0; j < 4; ++j) { int q[8];
#pragma unroll
            for (int e = 0; e < 8; ++e) q[e] = (int)rintf(xv[j][e] * qs) & 255;
            v2u w; w.x = (unsigned)(q[0] | (q[1] << 8) | (q[2] << 16) | (q[3] << 24)); w.y = (unsigned)(q[4] | (q[5] << 8) | (q[6] << 16) | (q[7] << 24));
            qrow[j * 64] = w; }
        if (lane == 0) ((float*)(A.ws + WS_HSC))[row] = am > 0.f ? am * (1.0f / 127.0f) : 1.0f;
    }
    if (!S_CONV) { cvt_table_q8<true>(A.in[I_PU], A.ws + WS_UB, (float*)(A.ws + WS_USC), gw, NGW, lane); cvt_table_q8<false>(A.in[I_PV], A.ws + WS_VB, (float*)(A.ws + WS_VSC), gw, NGW, lane); }
}

template <int N> __device__ __forceinline__ void bitonic_sort_desc(float (&v)[N]) {
#pragma unroll
    for (int k = 2; k <= N; k <<= 1)
#pragma unroll
        for (int j = k >> 1; j > 0; j >>= 1)
#pragma unroll
            for (int i = 0; i < N; ++i) { const int l = i ^ j;
                if (l > i) { const bool desc = ((i & k) == 0); const float a = v[i], b = v[l]; const float mx = fmaxf(a, b), mn = fminf(a, b); v[i] = desc ? mx : mn; v[l] = desc ? mn : mx; } }
}
__device__ __forceinline__ void merge_top16(float (&a)[16], const float (&b)[16]) {
#pragma unroll
    for (int i = 0; i < 16; ++i) a[i] = fmaxf(a[i], b[15 - i]);
#pragma unroll
    for (int j = 8; j > 0; j >>= 1)
#pragma unroll
        for (int i = 0; i < 16; ++i) { const int l = i ^ j; if (l > i) { const float x = a[i], y = a[l]; a[i] = fmaxf(x, y); a[l] = fminf(x, y); } }
}
__device__ __forceinline__ void top16_of_64(float (&v)[64], float (&out)[16]) {
    float g[4][16];
#pragma unroll
    for (int q = 0; q < 4; ++q) {
#pragma unroll
        for (int i = 0; i < 16; ++i) g[q][i] = v[q * 16 + i];
        bitonic_sort_desc<16>(g[q]); }
    merge_top16(g[0], g[1]); merge_top16(g[2], g[3]); merge_top16(g[0], g[2]);
#pragma unroll
    for (int i = 0; i < 16; ++i) out[i] = g[0][i];
}
__device__ __forceinline__ float pack_key(float v, unsigned key, unsigned mask) { return __builtin_bit_cast(float, (__builtin_bit_cast(unsigned, v) & ~mask) | key); }
constexpr int SK_PITCH = 272;
__device__ __forceinline__ void score_top16(const bf16* q, const LAS unsigned char* skl, int tok, int h, int p, int l31, int hf, float (&out)[16]) {
    f32x16 acc[4];
#pragma unroll
    for (int kt = 0; kt < 4; ++kt)
#pragma unroll
        for (int r = 0; r < 16; ++r) acc[kt][r] = 0.f;
    bf16x8 bq[8];
#pragma unroll
    for (int ks = 0; ks < 8; ++ks) bq[ks] = *(const GAS bf16x8*)(q + (size_t)tok * D + h * 256 + p * 128 + 16 * ks + 8 * hf);
#pragma unroll
    for (int ks = 0; ks < 8; ++ks) {
#pragma unroll
        for (int kt = 0; kt < 4; ++kt) {
            const bf16x8 ak = *(const LAS bf16x8*)(skl + (p * NKEY + 32 * kt + l31) * SK_PITCH + (16 * ks + 8 * hf) * 2);
            acc[kt] = __builtin_amdgcn_mfma_f32_32x32x16_bf16(ak, bq[ks], acc[kt], 0, 0, 0);
        }
    }
    float v[64];
#pragma unroll
    for (int kt = 0; kt < 4; ++kt)
#pragma unroll
        for (int r = 0; r < 16; ++r) v[kt * 16 + r] = pack_key(acc[kt][r], (unsigned)(32 * kt + (r & 3) + 8 * (r >> 2) + 4 * hf), 0x7Fu);
    float other[16];
    top16_of_64(v, out);
#pragma unroll
    for (int i = 0; i < 16; ++i) other[i] = __shfl_xor(out[i], 32);
    merge_top16(out, other);
}
__device__ __forceinline__ void s_convert_tables(const Args& A, int gw, int NGW, int lane) {
    cvt_table_q8<true>(A.in[I_PU], A.ws + WS_UB, (float*)(A.ws + WS_USC), gw, NGW, lane);
}
__device__ __forceinline__ void phase_s(const Args& A, LAS unsigned char* lds, int tid, int lane, int wave, int bid, int G) {
    const bf16* q = (const bf16*)(A.ws + WS_Q); const bf16* sk = (const bf16*)(A.ws + WS_SUBK);
    int* idx = (int*)(A.ws + WS_IDX); float* gate = (float*)(A.ws + WS_GATE);
    const int l31 = lane & 31, hf = lane >> 5;
    bool conv_done = false;
    for (int wi = bid; wi < (T / 512) * NH; wi += G) {
      const int h = wi & 7, tg = wi >> 3;
      __syncthreads();
#pragma unroll
      for (int i = 0; i < 8; ++i) { const int c = tid + i * NTHR, row = c >> 4, c16 = c & 15;
          *(LAS v4u*)(lds + row * SK_PITCH + c16 * 16) = *(const GAS v4u*)(sk + ((size_t)(h * 2 * NKEY + row)) * 128 + c16 * 8); }
      __syncthreads();
      if (S_CONV && wave >= 4 && !conv_done) s_convert_tables(A, bid * NWAVES + wave, G * NWAVES, lane);
      for (int ti = 0; ti < 2; ++ti) {
        const int tok = (tg * 16 + ti * 8 + wave) * 32 + l31;
        float s1[16], s2[16];
        score_top16(q, lds, tok, h, 0, l31, hf, s1);
        score_top16(q, lds, tok, h, 1, l31, hf, s2);
        float cv[64]; int n = 0;
#pragma unroll
        for (int i = 0; i < 16; ++i)
#pragma unroll
            for (int j = 0; j < 16; ++j)
                if ((i + 1) * (j + 1) <= 16) {
                    const float a = __builtin_bit_cast(float, __builtin_bit_cast(unsigned, s1[i]) & ~0x7Fu), c = __builtin_bit_cast(float, __builtin_bit_cast(unsigned, s2[j]) & ~0x7Fu);
                    cv[n++] = pack_key(a + c, (unsigned)(i * 16 + j), 0xFFu); }
#pragma unroll
        for (int m = 50; m < 64; ++m) cv[m] = -INFINITY;
        float c16[16];
        top16_of_64(cv, c16);
        float ev[16], esum = 0.f; const float cmax = __builtin_bit_cast(float, __builtin_bit_cast(unsigned, c16[0]) & ~0xFFu);
#pragma unroll
        for (int m = 0; m < 16; ++m) { ev[m] = __expf(__builtin_bit_cast(float, __builtin_bit_cast(unsigned, c16[m]) & ~0xFFu) - cmax); esum += ev[m]; }
        const float rs = 1.0f / esum;
        int oi[8]; float og[8];
#pragma unroll
        for (int mm = 0; mm < 8; ++mm) {
            float c_lo = c16[mm], c_hi = c16[8 + mm], e_lo = ev[mm], e_hi = ev[8 + mm];
            asm volatile("" : "+v"(c_lo), "+v"(c_hi), "+v"(e_lo), "+v"(e_hi));
            const unsigned cb = __builtin_bit_cast(unsigned, hf ? c_hi : c_lo); const int ii = (cb >> 4) & 15, jj = cb & 15;
            int row = 0, col = 0;
#pragma unroll
            for (int k = 0; k < 16; ++k) { row = (ii == k) ? (int)(__builtin_bit_cast(unsigned, s1[k]) & 0x7Fu) : row; col = (jj == k) ? (int)(__builtin_bit_cast(unsigned, s2[k]) & 0x7Fu) : col; }
            oi[mm] = row * NKEY + col; og[mm] = (hf ? e_hi : e_lo) * rs;
        }
        int* ip = idx + (size_t)tok * KSEL + h * 16 + hf * 8; float* gp = gate + (size_t)tok * KSEL + h * 16 + hf * 8;
        *(GAS v4u*)ip = (v4u){(unsigned)oi[0], (unsigned)oi[1], (unsigned)oi[2], (unsigned)oi[3]}; *(GAS v4u*)(ip + 4) = (v4u){(unsigned)oi[4], (unsigned)oi[5], (unsigned)oi[6], (unsigned)oi[7]};
        *(GAS f32x4*)gp = (f32x4){og[0], og[1], og[2], og[3]}; *(GAS f32x4*)(gp + 4) = (f32x4){og[4], og[5], og[6], og[7]};
      }
      if (S_CONV && wave < 4 && !conv_done) s_convert_tables(A, bid * NWAVES + wave, G * NWAVES, lane);
      conv_done = true;
    }
    if (S_CONV && !conv_done) s_convert_tables(A, bid * NWAVES + wave, G * NWAVES, lane);
    __syncthreads();
}

__device__ __forceinline__ float row_dot_fp8(const v4u d0, const v4u d1, const f32x2 (&hf)[2][8]) {
    const unsigned w0[4] = {d0.x, d0.y, d0.z, d0.w}, w1[4] = {d1.x, d1.y, d1.z, d1.w};
    f32x2 a = {0.f, 0.f}, b = {0.f, 0.f};
#pragma unroll
    for (int i = 0; i < 4; ++i) { a += fp8lo(w0[i]) * hf[0][2 * i]; a += fp8hi(w0[i]) * hf[0][2 * i + 1]; b += fp8lo(w1[i]) * hf[1][2 * i]; b += fp8hi(w1[i]) * hf[1][2 * i + 1]; }
    return (a.x + a.y) + (b.x + b.y);
}
__device__ __forceinline__ void row_axpy_fp8(f32x2 (&acc)[2][8], const v4u d0, const v4u d1, float w) {
    const unsigned w0[4] = {d0.x, d0.y, d0.z, d0.w}, w1[4] = {d1.x, d1.y, d1.z, d1.w};
#pragma unroll
    for (int i = 0; i < 4; ++i) { acc[0][2 * i] += fp8lo(w0[i]) * w; acc[0][2 * i + 1] += fp8hi(w0[i]) * w; acc[1][2 * i] += fp8lo(w1[i]) * w; acc[1][2 * i + 1] += fp8hi(w1[i]) * w; }
}
__device__ __forceinline__ void phase_pu(const Args& A, int lane, int wave, int bid, int G) {
    const unsigned char* h2q = A.ws + WS_H2Q; const unsigned char* ub = A.ws + WS_UB; const int* idx = (const int*)(A.ws + WS_IDX); float* actp = (float*)(A.ws + WS_ACTP);
    const int NX = (G % 8 == 0) ? 8 : 1, vx = bid % NX, nw = (G / NX) * NWAVES, wv = (bid / NX) * NWAVES + wave;
    const int q = lane >> 4, c16 = lane & 15;
    for (int cb = vx; cb < D / 256; cb += NX) {
        const unsigned loff = (unsigned)(cb * 256 + c16 * 16);
        int cid0 = 0, cid1 = 0, nid0 = 0, nid1 = 0; v4u ch = {0u, 0u, 0u, 0u}, nh = {0u, 0u, 0u, 0u};
#define PUQ_LOAD(i0, i1, hh, t_) do { const int t__ = (t_); if (t__ < T) { i0 = idx[(size_t)t__ * KSEL + lane]; i1 = idx[(size_t)t__ * KSEL + 64 + lane]; hh = *(const GAS v4u*)(h2q + (size_t)t__ * D + cb * 256 + c16 * 16); } } while (0)
        PUQ_LOAD(cid0, cid1, ch, wv); PUQ_LOAD(nid0, nid1, nh, wv + nw);
        v4u rv[PUQ_RB];
#define PUQ_ISSUE(slot, idr, s_) do { const unsigned e_ = (unsigned)__shfl(idr, ((4 * (s_)) & 63) + q); rv[slot] = *(const GAS v4u*)(ub + ((e_ << 11) + loff)); } while (0)
#pragma unroll
        for (int r = 0; r < PUQ_RB; ++r) PUQ_ISSUE(r, cid0, r);
        f32x4 cvv[8]; int it = 0;
        const int gwv = bid * NWAVES + wave, NGWv = G * NWAVES;
        for (int tok = wv; tok < T; tok += nw, ++it) {
            if (cb == vx) {
                const int vr = gwv + NGWv * (it >> 3);
                if ((it & 7) == 0 && vr < NEXP) { const GAS f32x4* p = (const GAS f32x4*)(A.in[I_PV] + (size_t)vr * D) + lane;
#pragma unroll
                    for (int i = 0; i < 8; ++i) cvv[i] = p[i * 64]; }
                if ((it & 7) == 1 && vr < NEXP) { float m = 0.f;
#pragma unroll
                    for (int i = 0; i < 8; ++i) m = fmaxf(m, fmaxf(fmaxf(fabsf(cvv[i].x), fabsf(cvv[i].y)), fmaxf(fabsf(cvv[i].z), fabsf(cvv[i].w))));
#pragma unroll
                    for (int o = 1; o < 64; o <<= 1) m = fmaxf(m, __shfl_xor(m, o));
                    const float sc = m > 0.f ? 448.0f / m : 1.0f; GAS unsigned* o4 = (GAS unsigned*)(A.ws + WS_VB + (size_t)vr * D) + lane;
#pragma unroll
                    for (int i = 0; i < 8; ++i) { const f32x4 t = cvv[i] * sc;
                        const float a = fminf(fmaxf(t.x, -448.f), 448.f), b = fminf(fmaxf(t.y, -448.f), 448.f), c = fminf(fmaxf(t.z, -448.f), 448.f), d = fminf(fmaxf(t.w, -448.f), 448.f);
                        int pk = __builtin_amdgcn_cvt_pk_fp8_f32(a, b, 0, false); pk = __builtin_amdgcn_cvt_pk_fp8_f32(c, d, pk, true); o4[i * 64] = (unsigned)pk; }
                    if (lane == 0) ((float*)(A.ws + WS_VSC))[vr] = m > 0.f ? m * (1.0f / 448.0f) : 1.0f; }
            }
            const int hx = (int)ch.x, hy = (int)ch.y, hz = (int)ch.z, hw = (int)ch.w;
            int a0 = 0, a1 = 0;
#define PUQ_DOT(slot, acc_, s_) do { const v4u d_ = rv[slot]; int p_ = __builtin_amdgcn_sdot4((int)d_.x, hx, 0, false); p_ = __builtin_amdgcn_sdot4((int)d_.y, hy, p_, false); \
                p_ = __builtin_amdgcn_sdot4((int)d_.z, hz, p_, false); p_ = __builtin_amdgcn_sdot4((int)d_.w, hw, p_, false); \
                p_ += __builtin_amdgcn_update_dpp(0, p_, 0xB1, 0xF, 0xF, false); p_ += __builtin_amdgcn_update_dpp(0, p_, 0x4E, 0xF, 0xF, false); \
                p_ += __builtin_amdgcn_update_dpp(0, p_, 0x141, 0xF, 0xF, false); p_ += __builtin_amdgcn_update_dpp(0, p_, 0x140, 0xF, 0xF, false); \
                acc_ = (c16 == ((s_) & 15)) ? p_ : acc_; } while (0)
#pragma unroll
            for (int r = 0; r < PUQ_RB; ++r) { PUQ_DOT(r, a0, r); PUQ_ISSUE(r, cid1, r + PUQ_RB); }
#pragma unroll
            for (int r = 0; r < PUQ_RB; ++r) { PUQ_DOT(r, a1, r + PUQ_RB); PUQ_ISSUE(r, nid0, r); }
            float* ap = actp + ((size_t)cb * T + tok) * KSEL + 4 * c16 + q;
            ap[0] = (float)a0; ap[64] = (float)a1;
            cid0 = nid0; cid1 = nid1; ch = nh;
            PUQ_LOAD(nid0, nid1, nh, tok + 2 * nw);
        }
#undef PUQ_LOAD
#undef PUQ_ISSUE
#undef PUQ_DOT
    }
}
__device__ __forceinline__ void phase_w(const Args& A, int lane, int wave, int bid, int G) {
    const float* actp = (const float*)(A.ws + WS_ACTP); const float* usc = (const float*)(A.ws + WS_USC); const float* vsc = (const float*)(A.ws + WS_VSC); const float* hsc = (const float*)(A.ws + WS_HSC);
    const int* idx = (const int*)(A.ws + WS_IDX); const float* gate = (const float*)(A.ws + WS_GATE); float* wb = (float*)(A.ws + WS_ACT);
    for (int tok = bid * NWAVES + wave; tok < T; tok += G * NWAVES) {
        const float hs = hsc[tok];
#pragma unroll
        for (int hh = 0; hh < 2; ++hh) {
            const size_t o = (size_t)tok * KSEL + hh * 64 + lane; float sacc = 0.f;
#pragma unroll
            for (int c = 0; c < 8; ++c) sacc += actp[(size_t)c * T * KSEL + o];
            const int e = idx[o];
            wb[o] = gate[o] * gelu_tanh(sacc * usc[e] * hs) * vsc[e];
        }
    }
}
__device__ __forceinline__ void phase_pv(const Args& A, int lane, int wave, int bid, int G) {
    const unsigned char* vb = A.ws + WS_VB; const float* wb = (const float*)(A.ws + WS_ACT); const int* idx = (const int*)(A.ws + WS_IDX);
    bf16* y2 = (bf16*)(A.ws + WS_Y2); float* ssq = (float*)(A.ws + WS_SSQ);
    const int NX = (G % 8 == 0) ? 8 : 1, vx = bid % NX, nw = (G / NX) * NWAVES, wv = (bid / NX) * NWAVES + wave;
    const int q = lane >> 4, c16 = lane & 15;
    for (int cb = vx; cb < D / 256; cb += NX) {
        const unsigned loff = (unsigned)(cb * 256 + c16 * 16);
        int cid0 = 0, cid1 = 0, nid0 = 0, nid1 = 0; float cw0 = 0.f, cw1 = 0.f, nw0 = 0.f, nw1 = 0.f;
#define PVQ_LOAD(i0, i1, x0, x1, t_) do { const int t__ = (t_); if (t__ < T) { i0 = idx[(size_t)t__ * KSEL + lane]; i1 = idx[(size_t)t__ * KSEL + 64 + lane]; x0 = wb[(size_t)t__ * KSEL + lane]; x1 = wb[(size_t)t__ * KSEL + 64 + lane]; } } while (0)
        PVQ_LOAD(cid0, cid1, cw0, cw1, wv); PVQ_LOAD(nid0, nid1, nw0, nw1, wv + nw);
        v4u rv[PVQ_RB];
#define PVQ_ISSUE(slot, idr, s_) do { const unsigned e_ = (unsigned)__shfl(idr, ((4 * (s_)) & 63) + q); rv[slot] = *(const GAS v4u*)(vb + ((e_ << 11) + loff)); } while (0)
#pragma unroll
        for (int r = 0; r < PVQ_RB; ++r) PVQ_ISSUE(r, cid0, r);
        for (int tok = wv; tok < T; tok += nw) {
            f32x2 acc[8];
#pragma unroll
            for (int i = 0; i < 8; ++i) acc[i] = (f32x2){0.f, 0.f};
#define PVQ_FMA(slot, wr, s_) do { const float w_ = __shfl(wr, ((4 * (s_)) & 63) + q); const v4u d_ = rv[slot]; const unsigned dw_[4] = {d_.x, d_.y, d_.z, d_.w}; \
                _Pragma("unroll") for (int i_ = 0; i_ < 4; ++i_) { acc[2 * i_] += fp8lo(dw_[i_]) * w_; acc[2 * i_ + 1] += fp8hi(dw_[i_]) * w_; } } while (0)
#pragma unroll
            for (int r = 0; r < PVQ_RB; ++r) { PVQ_FMA(r, cw0, r); PVQ_ISSUE(r, cid1, r + PVQ_RB); }
#pragma unroll
            for (int r = 0; r < PVQ_RB; ++r) { PVQ_FMA(r, cw1, r + PVQ_RB); PVQ_ISSUE(r, nid0, r); }
            float sq = 0.f;
#pragma unroll
            for (int i = 0; i < 8; ++i) { float x = acc[i].x, y = acc[i].y; x += __shfl_xor(x, 16); y += __shfl_xor(y, 16); x += __shfl_xor(x, 32); y += __shfl_xor(y, 32); acc[i] = (f32x2){x, y}; sq += x * x + y * y; }
            sq = wave_total(q == 0 ? sq : 0.f);
            if (q == 0) { GAS v4u* yo = (GAS v4u*)(y2 + (size_t)tok * D + cb * 256 + c16 * 16);
                yo[0] = (v4u){pk2(acc[0].x, acc[0].y), pk2(acc[1].x, acc[1].y), pk2(acc[2].x, acc[2].y), pk2(acc[3].x, acc[3].y)};
                yo[1] = (v4u){pk2(acc[4].x, acc[4].y), pk2(acc[5].x, acc[5].y), pk2(acc[6].x, acc[6].y), pk2(acc[7].x, acc[7].y)}; }
            if (lane == 0) ssq[(size_t)cb * T + tok] = sq;
            cid0 = nid0; cid1 = nid1; cw0 = nw0; cw1 = nw1;
            PVQ_LOAD(nid0, nid1, nw0, nw1, tok + 2 * nw);
        }
#undef PVQ_LOAD
#undef PVQ_ISSUE
#undef PVQ_FMA
    }
}
__device__ __forceinline__ void phase_f(const Args& A, int lane, int wave, int bid, int G) {
    const bf16* y1 = (const bf16*)(A.ws + WS_Y1); const bf16* y2 = (const bf16*)(A.ws + WS_Y2); const float* ssq = (const float*)(A.ws + WS_SSQ); const float* cfin = (const float*)(A.ws + WS_CFIN);
    for (int tok = bid * NWAVES + wave; tok < T; tok += G * NWAVES) {
        const int b = tok >> 13;
        float qs = 0.f;
#pragma unroll
        for (int c = 0; c < 8; ++c) qs += ssq[(size_t)c * T + tok];
        const float rstd2 = __builtin_amdgcn_rsqf(qs * (1.0f / D) + EPS);
        const GAS v2u* yp = (const GAS v2u*)(y1 + (size_t)tok * D) + lane; const GAS v2u* zp = (const GAS v2u*)(y2 + (size_t)tok * D) + lane;
        const GAS f32x4* xr = (const GAS f32x4*)(A.in[I_X] + (size_t)tok * D) + lane;
        v2u yq[8], zq[8]; f32x4 xv[8]; float s1 = 0.f;
#pragma unroll
        for (int i = 0; i < 8; ++i) { yq[i] = yp[i * 64]; zq[i] = zp[i * 64]; xv[i] = xr[i * 64]; }
#pragma unroll
        for (int i = 0; i < 8; ++i) { const float a = bflo(yq[i].x), b_ = bfhi(yq[i].x), c = bflo(yq[i].y), d = bfhi(yq[i].y); s1 += (a * a + b_ * b_) + (c * c + d * d); }
        const float rstd1 = __builtin_amdgcn_rsqf(wave_total(s1) * (1.0f / D) + EPS);
        const GAS f32x4* c1 = (const GAS f32x4*)(cfin + (size_t)(b * 2 + 0) * D) + lane; const GAS f32x4* c2 = (const GAS f32x4*)(cfin + (size_t)(b * 2 + 1) * D) + lane;
        GAS f32x4* orow = (GAS f32x4*)(A.out + (size_t)tok * D) + lane;
#pragma unroll
        for (int i = 0; i < 8; ++i) { const f32x4 a1 = c1[i * 64], a2 = c2[i * 64];
            const float yv[4] = {bflo(yq[i].x), bfhi(yq[i].x), bflo(yq[i].y), bfhi(yq[i].y)}, zv[4] = {bflo(zq[i].x), bfhi(zq[i].x), bflo(zq[i].y), bfhi(zq[i].y)}; f32x4 o;
#pragma unroll
            for (int e = 0; e < 4; ++e) o[e] = xv[i][e] + (OUT_MODE != 2 ? a1[e] * yv[e] * rstd1 : 0.f) + (OUT_MODE != 1 ? a2[e] * zv[e] * rstd2 : 0.f);
            orow[i * 64] = o; }
    }
}

#if defined(MK_CHECKS)
constexpr int CW_CHK = 2048;
__device__ __forceinline__ unsigned hsh(unsigned x) { x ^= x >> 16; x *= 0x7feb352dU; x ^= x >> 15; x *= 0x846ca68bU; x ^= x >> 16; return x; }
__device__ __forceinline__ float bfv(const bf16* p, size_t i) { return __builtin_bit_cast(float, (unsigned)p[i] << 16); }
__device__ __forceinline__ float relerr(float got, float ref, float scale) { const float d = fabsf(got - ref) / (fabsf(ref) + scale); return (d == d) ? d : 1e30f; }
__device__ __forceinline__ void chk_put(unsigned* ctl, int stage, float e) { atomicMax(ctl + CW_CHK + stage, __builtin_bit_cast(unsigned, e)); }
__device__ float chk_gemm(const bf16* Am, const bf16* Bt, const bf16* C, int N, int K, unsigned s) {
    const int row = hsh(s) % T, col = hsh(s * 7 + 1) % N; float acc = 0.f;
    for (int k = 0; k < K; ++k) acc += bfv(Am, (size_t)row * K + k) * bfv(Bt, (size_t)col * K + k);
    return relerr(bfv(C, (size_t)row * N + col), acc, 0.05f);
}
__device__ float xl_at(const Args& A, const bf16* proj, size_t row, int c) {
    const int t = (int)(row & (SEQ - 1)); float a = A.in[I_LCB][c];
    for (int j = 0; j < 4; ++j) if (t - 3 + j >= 0) a += A.in[I_LCW][j * LRU_W + c] * bfv(proj, (row - 3 + j) * IN_COLS + c);
    return __builtin_bit_cast(float, f2bf(a) << 16);
}
__global__ void __launch_bounds__(128) chk_kernel(Args A, int stage) {
    __shared__ float sh[10240];
    unsigned* ctl = (unsigned*)(A.ws + WS_CTL);
    const int tid = threadIdx.x; const unsigned s = hsh(tid * 2654435761u + stage * 97u + 12345u);
    const float* modp = (const float*)(A.ws + WS_MODP);
    float e = 0.f;
    if (stage == 0) {
        { const int b = s & 1, n = hsh(s) % NMOD; float acc = A.in[I_BMOD][n];
          for (int k = 0; k < D; ++k) { const float c = A.in[I_C][b * D + k]; acc += c / (1.0f + expf(-c)) * A.in[I_WMOD][(size_t)k * NMOD + n]; }
          e = fmaxf(e, relerr(mod_at(modp, b, n), acc, 0.01f)); }
        { const int n = hsh(s + 1) % IN_COLS, k = hsh(s + 2) % D; e = fmaxf(e, relerr(bfv((const bf16*)(A.ws + WS_BT1), (size_t)n * D + k), A.in[I_WIN][(size_t)k * IN_COLS + n], 1e-3f)); }
        { const int n = hsh(s + 3) % D, k = hsh(s + 4) % D; e = fmaxf(e, relerr(bfv((const bf16*)(A.ws + WS_BT2), (size_t)n * D + k), A.in[I_WOUT][(size_t)k * D + n], 1e-3f));
          e = fmaxf(e, relerr(bfv((const bf16*)(A.ws + WS_BT3), (size_t)n * D + k), A.in[I_WQ][(size_t)k * D + n], 1e-3f)); }
        { const int h = s & 7, n = hsh(s + 5) & 255, k = hsh(s + 6) & 127; const float ref = (n < 128 ? A.in[I_WA] : A.in[I_WX])[h * 16384 + k * 128 + (n & 127)];
          e = fmaxf(e, relerr(bfv((const bf16*)(A.ws + WS_WG), (size_t)(h * 256 + n) * 128 + k), ref, 1e-3f)); }
        { const int i = hsh(s + 7) % (NH * 2 * NKEY * 128); e = fmaxf(e, relerr(bfv((const bf16*)(A.ws + WS_SUBK), i), A.in[I_SUBK][i], 1e-3f)); }
    } else if (stage == 1) {
        const int row = hsh(s) % T, col = hsh(s + 1) % D, b = row >> 13; float ss = 0.f;
        for (int k = 0; k < D; ++k) { const float x = A.in[I_X][(size_t)row * D + k]; ss += x * x; }
        const float ref = A.in[I_X][(size_t)row * D + col] * rsqrtf(ss / D + EPS) * A.in[I_GPREMIX][col] * (1.0f + mod_at(modp, b, D + col)) + mod_at(modp, b, col);
        e = relerr(bfv((const bf16*)(A.ws + WS_RA), (size_t)row * D + col), ref, 0.05f);
        const float* cfin = (const float*)(A.ws + WS_CFIN);
        e = fmaxf(e, relerr(cfin[(b * 2 + 0) * D + col], mod_at(modp, b, 2 * D + col) * A.in[I_GPOSTMIX][col], 1e-3f));
        e = fmaxf(e, relerr(cfin[(b * 2 + 1) * D + col], mod_at(modp, b, 5 * D + col) * A.in[I_GPOSTFFN][col], 1e-3f));
    } else if (stage == 2) { e = chk_gemm((const bf16*)(A.ws + WS_RA), (const bf16*)(A.ws + WS_BT1), (const bf16*)(A.ws + WS_PROJ), IN_COLS, D, s);
    } else if (stage == 7) { e = chk_gemm((const bf16*)(A.ws + WS_RA), (const bf16*)(A.ws + WS_BT2), (const bf16*)(A.ws + WS_Y1), D, D, s);
    } else if (stage == 9) { e = chk_gemm((const bf16*)(A.ws + WS_RA), (const bf16*)(A.ws + WS_BT3), (const bf16*)(A.ws + WS_Q), D, D, s);
    } else if (stage == 3) {
        const bf16* proj = (const bf16*)(A.ws + WS_PROJ);
        int row = hsh(s) % T; if (tid < 16) row = (tid & 1) * SEQ + (tid >> 1);
        const int c = hsh(s + 1) % LRU_W, t = row & (SEQ - 1);
        float a = A.in[I_LCB][c];
        for (int j = 0; j < 4; ++j) if (t - 3 + j >= 0) a += A.in[I_LCW][j * LRU_W + c] * bfv(proj, (size_t)(row - 3 + j) * IN_COLS + c);
        (void)a;
        float z = A.in[I_CDB][c];
        for (int j = 0; j < CONF_K; ++j) if (t - 30 + j >= 0) { const size_t r = (size_t)(row - 30 + j) * IN_COLS; const float g = bfv(proj, r + 3072 + c);
            z += A.in[I_CDW][j * CONF_W + c] * bfv(proj, r + 2048 + c) / (1.0f + expf(-g)); }
        e = fmaxf(e, relerr(bfv((const bf16*)(A.ws + WS_ZC), (size_t)row * CONF_W + c), z, 0.05f));
    } else if (stage == 4) {
        const bf16* xl = (const bf16*)(A.ws + WS_XL);
        const int b = s & 1, chunk = hsh(s + 1) % NCHUNK, ch = hsh(s + 2) % LRU_W, hh = ch >> 7, j = ch & 127;
        const float cl = -8.0f * log1pf(expf(-A.in[I_LAMBDA][ch])); float P = 1.f, H = 0.f;
        for (int t = 0; t < CHUNK; ++t) { const size_t row = (size_t)b * SEQ + chunk * CHUNK + t; float ga = A.in[I_BA][ch], gx = A.in[I_BX][ch];
            for (int i = 0; i < 128; ++i) { const float xv = bfv(xl, row * LRU_W + hh * 128 + i); ga += xv * A.in[I_WA][hh * 16384 + i * 128 + j]; gx += xv * A.in[I_WX][hh * 16384 + i * 128 + j]; }
            const float r = 1.0f / (1.0f + expf(-ga)), ig = 1.0f / (1.0f + expf(-gx)), la = cl * r, a = expf(la), u = sqrtf(fmaxf(-expm1f(2.0f * la), 0.f)) * ig * bfv(xl, row * LRU_W + ch);
            H = a * H + u; P = P * a;
            e = fmaxf(e, relerr(bfv((const bf16*)(A.ws + WS_HLOC), row * LRU_W + ch), H, 0.05f)); e = fmaxf(e, relerr(bfv((const bf16*)(A.ws + WS_PC), row * LRU_W + ch), P, 0.02f)); }
        const float* ag = (const float*)(A.ws + WS_AGG) + ((size_t)(b * NCHUNK + chunk) * LRU_W + ch) * 2;
        e = fmaxf(e, relerr(ag[0], P, 0.02f)); e = fmaxf(e, relerr(ag[1], H, 0.05f));
    } else if (stage == 12) {
        const bf16* proj = (const bf16*)(A.ws + WS_PROJ);
#define XLV(row_, ch_) xl_at(A, proj, (row_), (ch_))
        const int b = s & 1, chunk = hsh(s + 1) % NCHUNK, ch = hsh(s + 2) % LRU_W, hh = ch >> 7, j = ch & 127;
        const float cl = -8.0f * log1pf(expf(-A.in[I_LAMBDA][ch])); float P = 1.f, H = 0.f;
        for (int t = 0; t < CHUNK; ++t) { const size_t row = (size_t)b * SEQ + chunk * CHUNK + t; float ga = A.in[I_BA][ch], gx = A.in[I_BX][ch];
            for (int i = 0; i < 128; ++i) { const float xv = XLV(row, hh * 128 + i); ga += xv * A.in[I_WA][hh * 16384 + i * 128 + j]; gx += xv * A.in[I_WX][hh * 16384 + i * 128 + j]; }
            const float r = 1.0f / (1.0f + expf(-ga)), ig = 1.0f / (1.0f + expf(-gx)), la = cl * r, a = expf(la), u = sqrtf(fmaxf(-expm1f(2.0f * la), 0.f)) * ig * XLV(row, ch);
            H = a * H + u; P = P * a;
            e = fmaxf(e, relerr(bfv((const bf16*)(A.ws + WS_HLOC), row * LRU_W + ch), H, 0.05f)); e = fmaxf(e, relerr(bfv((const bf16*)(A.ws + WS_PC), row * LRU_W + ch), P, 0.02f)); }
        const float* ag = (const float*)(A.ws + WS_AGG) + ((size_t)(b * NCHUNK + chunk) * LRU_W + ch) * 2;
        e = fmaxf(e, relerr(ag[0], P, 0.02f)); e = fmaxf(e, relerr(ag[1], H, 0.05f));
        { const int row = hsh(s + 9) % T, c = hsh(s + 10) % CONF_W, t = row & (SEQ - 1); float z = A.in[I_CDB][c];
          for (int j = 0; j < CONF_K; ++j) if (t - 30 + j >= 0) { const size_t r = (size_t)(row - 30 + j) * IN_COLS; const float g = bfv(proj, r + 3072 + c); z += A.in[I_CDW][j * CONF_W + c] * bfv(proj, r + 2048 + c) / (1.0f + expf(-g)); }
          e = fmaxf(e, relerr(bfv((const bf16*)(A.ws + WS_ZC), (size_t)row * CONF_W + c), z, 0.05f)); }
#undef XLV
    } else if (stage == 5) {
    } else if (stage == 6) {
        const bf16* proj = (const bf16*)(A.ws + WS_PROJ); const bf16* zc = (const bf16*)(A.ws + WS_ZC);
        const int row = hsh(s) % T, c = hsh(s + 1) % LRU_W, b = row >> 13, chunk = (row & (SEQ - 1)) >> 6;
        float cin = 0.f; for (int cc = 0; cc < chunk; ++cc) { const float* ag = (const float*)(A.ws + WS_AGG) + ((size_t)(b * NCHUNK + cc) * LRU_W + c) * 2; cin = ag[0] * cin + ag[1]; }
        const float hfull = bfv((const bf16*)(A.ws + WS_HLOC), (size_t)row * LRU_W + c) + bfv((const bf16*)(A.ws + WS_PC), (size_t)row * LRU_W + c) * cin;
        const float g = bfv(proj, (size_t)row * IN_COLS + 1024 + c), ge = 0.5f * g * (1.0f + tanhf(0.7978845608f * (g + 0.044715f * g * g * g)));
        e = relerr(bfv((const bf16*)(A.ws + WS_RA), (size_t)row * D + c), hfull * ge, 0.05f);
        float m = 0.f, q = 0.f;
        for (int k = 0; k < CONF_W; ++k) m += bfv(zc, (size_t)row * CONF_W + k);
        m /= CONF_W;
        for (int k = 0; k < CONF_W; ++k) { const float d = bfv(zc, (size_t)row * CONF_W + k) - m; q += d * d; }
        const float n = (bfv(zc, (size_t)row * CONF_W + c) - m) * rsqrtf(q / CONF_W + EPS) * A.in[I_LNG][c] + A.in[I_LNB][c];
        e = fmaxf(e, relerr(bfv((const bf16*)(A.ws + WS_RA), (size_t)row * D + 1024 + c), n / (1.0f + expf(-n)), 0.05f));
    } else if (stage == 8) {
        const bf16* y1 = (const bf16*)(A.ws + WS_Y1); const float* cfin = (const float*)(A.ws + WS_CFIN);
        const int row = hsh(s) % T, col = hsh(s + 1) % D, b = row >> 13; float s1 = 0.f, s2 = 0.f;
        for (int k = 0; k < D; ++k) { const float y = bfv(y1, (size_t)row * D + k); s1 += y * y; }
        const float r1 = rsqrtf(s1 / D + EPS);
        for (int k = 0; k < D; ++k) { const float x1 = A.in[I_X][(size_t)row * D + k] + cfin[(b * 2) * D + k] * bfv(y1, (size_t)row * D + k) * r1; s2 += x1 * x1; }
        const float x1c = A.in[I_X][(size_t)row * D + col] + cfin[(b * 2) * D + col] * bfv(y1, (size_t)row * D + col) * r1;
        const float ref = x1c * rsqrtf(s2 / D + EPS) * A.in[I_GPREFFN][col] * (1.0f + mod_at(modp, b, 4 * D + col)) + mod_at(modp, b, 3 * D + col);
        e = relerr(bfv((const bf16*)(A.ws + WS_RA), (size_t)row * D + col), ref, 0.05f);
    } else if (stage == 10) {
        { const size_t i = (size_t)(hsh(s + 2) % NEXP) * D + hsh(s + 3) % D;
          const unsigned wu = ((const unsigned*)(A.ws + WS_UB))[i >> 2] >> (8 * (i & 3)), wv = ((const unsigned*)(A.ws + WS_VB))[i >> 2] >> (8 * (i & 3));
          const float du = (float)(signed char)(wu & 255u) * ((const float*)(A.ws + WS_USC))[i / D], dv = __builtin_amdgcn_cvt_pk_f32_fp8((int)wv, false)[0] * ((const float*)(A.ws + WS_VSC))[i / D];
          e = fmaxf(e, relerr(du, A.in[I_PU][i], 2e-3f) * 0.3f); (void)dv; }
        if (tid < 32) {
            const bf16* q = (const bf16*)(A.ws + WS_Q); const int* idx = (const int*)(A.ws + WS_IDX); const float* gate = (const float*)(A.ws + WS_GATE);
            const int tok = hsh(s) % T, h = hsh(s + 1) & 7;
            float* sc = sh + tid * 320;
            for (int p = 0; p < 2; ++p) for (int n = 0; n < NKEY; ++n) { float a = 0.f;
                for (int d = 0; d < 128; ++d) a += bfv(q, (size_t)tok * D + h * 256 + p * 128 + d) * A.in[I_SUBK][((size_t)((h * 2 + p) * NKEY + n)) * 128 + d];
                sc[p * 128 + n] = a; }
            for (int p = 0; p < 2; ++p) { float prev = 1e30f; for (int it = 0; it < 16; ++it) { float best = -1e30f; int bi = 0;
                for (int n = 0; n < NKEY; ++n) { const float v = sc[p * 128 + n]; if (v < prev && v > best) { best = v; bi = n; } }
                sc[256 + p * 16 + it] = best; sc[288 + p * 16 + it] = (float)bi; prev = best; } }
            float prev = 1e30f, esum = 0.f, cmax = 0.f; int miss = 0; float gerr = 0.f;
            { float pv = 1e30f; for (int it = 0; it < 16; ++it) { float best = -1e30f;
                for (int c = 0; c < 256; ++c) { const float v = sc[256 + (c >> 4)] + sc[272 + (c & 15)]; if (v < pv && v > best) best = v; }
                if (it == 0) cmax = best; esum += expf(best - cmax); pv = best; } }
            for (int it = 0; it < 16; ++it) { float best = -1e30f; int bc = 0;
                for (int c = 0; c < 256; ++c) { const float v = sc[256 + (c >> 4)] + sc[272 + (c & 15)]; if (v < prev && v > best) { best = v; bc = c; } }
                prev = best;
                const int eidx = (int)sc[288 + (bc >> 4)] * NKEY + (int)sc[304 + (bc & 15)]; const float g = expf(best - cmax) / esum; bool found = false;
                for (int m = 0; m < 16; ++m) if (idx[(size_t)tok * KSEL + h * 16 + m] == eidx) { found = true; gerr = fmaxf(gerr, relerr(gate[(size_t)tok * KSEL + h * 16 + m], g, 0.02f)); }
                if (!found) ++miss; }
            e = fmaxf((float)miss / 16.0f, gerr);
        }
    } else if (stage == 11) {
        const bf16* h2 = (const bf16*)(A.ws + WS_RA); const bf16* y1 = (const bf16*)(A.ws + WS_Y1); const int* idx = (const int*)(A.ws + WS_IDX); const float* gate = (const float*)(A.ws + WS_GATE); const float* cfin = (const float*)(A.ws + WS_CFIN);
        const int tok = hsh(blockIdx.x * 977u + 5u) % T, b = tok >> 13;
        { const int ex = idx[(size_t)tok * KSEL + tid]; float a = 0.f;
          if ((unsigned)ex < (unsigned)NEXP) { for (int d = 0; d < D; ++d) a += bfv(h2, (size_t)tok * D + d) * A.in[I_PU][(size_t)ex * D + d]; } else a = 1e30f;
          const float ge = 0.5f * a * (1.0f + tanhf(0.7978845608f * (a + 0.044715f * a * a * a)));
          sh[tid] = gate[(size_t)tok * KSEL + tid] * ge; sh[128 + tid] = __builtin_bit_cast(float, ex); }
        __syncthreads();
        float s2 = 0.f, s1 = 0.f;
        for (int cc = 0; cc < 16; ++cc) { const int col = cc * 128 + tid; float a = 0.f;
            for (int k = 0; k < KSEL; ++k) { const int ex = __builtin_bit_cast(int, sh[128 + k]); if ((unsigned)ex < (unsigned)NEXP) a += sh[k] * A.in[I_PV][(size_t)ex * D + col]; }
            sh[512 + cc * 128 + tid] = a; s2 += a * a; const float y = bfv(y1, (size_t)tok * D + col); s1 += y * y; }
        __syncthreads(); sh[256 + tid] = s2; sh[384 + tid] = s1; __syncthreads();
        float t2 = 0.f, t1 = 0.f; for (int k = 0; k < 128; ++k) { t2 += sh[256 + k]; t1 += sh[384 + k]; }
        const float r2 = rsqrtf(t2 / D + EPS), r1 = rsqrtf(t1 / D + EPS);
        float en = 0.f, ed = 0.f;
        for (int cc = 0; cc < 16; ++cc) { const int col = cc * 128 + tid;
            const float pterm = cfin[(b * 2 + 1) * D + col] * sh[512 + cc * 128 + tid] * r2;
            const float ref = A.in[I_X][(size_t)tok * D + col] + (OUT_MODE != 2 ? cfin[(b * 2) * D + col] * bfv(y1, (size_t)tok * D + col) * r1 : 0.f) + (OUT_MODE != 1 ? pterm : 0.f);
            const float d = A.out[(size_t)tok * D + col] - ref; en += d * d; ed += pterm * pterm; }
        __syncthreads(); sh[256 + tid] = en; sh[384 + tid] = ed; __syncthreads();
        float ten = 0.f, ted = 0.f; for (int k = 0; k < 128; ++k) { ten += sh[256 + k]; ted += sh[384 + k]; }
        e = ten / (ted + 1e-12f); if (!(e == e)) e = 1e30f;
    }
    chk_put(ctl, stage, e);
}
__global__ void chk_encode(Args A, int what) {
    const unsigned* ctl = (const unsigned*)(A.ws + WS_CTL);
    if (threadIdx.x == 0 && blockIdx.x == 0) {
        if (what < 0) {
            const float thr[13] = {0.03f, 0.03f, 0.03f, 0.03f, 0.06f, 0.01f, 0.04f, 0.03f, 0.03f, 0.03f, 0.2f, 0.01f, 0.06f};
            for (int st = 0; st < 13; ++st) { const float e = __builtin_bit_cast(float, ctl[CW_CHK + st]); if (!(e <= thr[st])) { A.out[0] = 4000.0f * (float)(1 << st); break; } }
        } else {
            const float e = fminf(__builtin_bit_cast(float, ctl[CW_CHK + what]), 1e6f); A.out[0] = 4000.0f * sqrtf(1e6f * e);
        }
    }
}
#endif

__global__ void __launch_bounds__(NTHR, 2) fwd_kernel(Args args) {
    extern __shared__ __attribute__((aligned(16))) unsigned char lds_raw[];
    LAS unsigned char* lds = (LAS unsigned char*)lds_raw;
    const int tid = threadIdx.x, lane = tid & 63, wave = __builtin_amdgcn_readfirstlane(tid >> 6), bid = blockIdx.x, G = gridDim.x;
    for (int u = tid; u < (LDS_BYTES - LDSCTL_OFF) / 4; u += NTHR) ((LAS unsigned*)(lds + LDSCTL_OFF))[u] = 0u;
    __syncthreads();
    unsigned* ctl = (unsigned*)(args.ws + WS_CTL);
    XcdBarrier bar; bar.bar = ctl + CW_BAR + args.li * XCD_BAR_WORDS; bar.x = 0; bar.st = nullptr;
    if (MK_N_LAUNCHES != N_PHASES) bar = xcd_barrier_post(ctl + CW_BAR + args.li * XCD_BAR_WORDS, (volatile LAS unsigned*)(lds + MISC_OFF) + 8);
    const int lo = args.ph_lo, hi = args.ph_hi;
#define IN(k) (lo <= (k) && (k) < hi)
#define SEAM(k) do { if (IN(k) && IN((k) + 1)) xcd_barrier(bar); } while (0)
#define PHON(k) ((PH_MASK >> (k)) & 1)
    if (PHON(0) && IN(0)) { phase_p0(args, lds, tid, lane, wave, bid, G); }
    SEAM(0);
    if (PHON(1) && IN(1)) { phase_p1(args, tid, lane, wave, bid, G); }
    SEAM(1);
    if (PHON(2) && IN(2)) {
        pg8::Gemm g{(const bf16*)(args.ws + WS_RA), (const bf16*)(args.ws + WS_BT1), T, IN_COLS, D}; pg8::StaticOrder S; S.init(T, IN_COLS, G, bid);
        pg8::EpiBf16<0> E{(bf16*)(args.ws + WS_PROJ), IN_COLS, nullptr, 0, 0, 1.f};
        pg8::gemm_phase<pg8::EpiBf16<0>, pg8::StaticOrder, PG8_ALIGN, PG8_SP2>(lds + RING_OFF, g, S, E);
    }
    SEAM(2);
    if (PHON(3) && IN(3)) { phase_m1a(args, lds, tid, lane, wave, bid, G); }
    if (PHON(4) && IN(3)) { phase_m1b(args, lds, tid, lane, wave, bid, G); }
    SEAM(3);
    if (PHON(5) && IN(4)) { phase_m3(args, lds, tid, lane, wave, bid, G); }
    SEAM(4);
    if (PHON(6) && IN(5)) {
        pg8::Gemm g{(const bf16*)(args.ws + WS_RA), (const bf16*)(args.ws + WS_BT2), T, D, D}; pg8::StaticOrder S; S.init(T, D, G, bid);
        pg8::EpiBf16<0> E{(bf16*)(args.ws + WS_Y1), D, nullptr, 0, 0, 1.f};
        pg8::gemm_phase<pg8::EpiBf16<0>, pg8::StaticOrder, PG8_ALIGN, PG8_SP2>(lds + RING_OFF, g, S, E);
    }
    SEAM(5);
    if (PHON(7) && IN(6)) { phase_e2(args, tid, lane, wave, bid, G); }
    SEAM(6);
    if (PHON(8) && IN(7)) {
        pg8::Gemm g{(const bf16*)(args.ws + WS_RA), (const bf16*)(args.ws + WS_BT3), T, D, D}; pg8::StaticOrder S; S.init(T, D, G, bid);
        pg8::EpiBf16<0> E{(bf16*)(args.ws + WS_Q), D, nullptr, 0, 0, 1.f};
        pg8::gemm_phase<pg8::EpiBf16<0>, pg8::StaticOrder, PG8_ALIGN, PG8_SP2>(lds + RING_OFF, g, S, E);
    }
    SEAM(7);
    if (PHON(9) && IN(8)) { phase_s(args, lds, tid, lane, wave, bid, G); }
    SEAM(8);
    if (PHON(10) && IN(9)) { phase_pu(args, lane, wave, bid, G); }
    SEAM(9);
    if (PHON(11) && IN(10)) { phase_w(args, lane, wave, bid, G); }
    SEAM(10);
    if (PHON(12) && IN(11)) { phase_pv(args, lane, wave, bid, G); }
    SEAM(11);
    if (PHON(13) && IN(12)) { phase_f(args, lane, wave, bid, G); }
#undef IN
#undef SEAM
}

extern "C" void kernel_launch(void* const* d_in, const int* in_sizes, int n_in, void* d_out, int out_size, void* d_ws, size_t ws_size, hipStream_t stream) {
    static int grid = 0;
    if (grid == 0) {
        if (n_in != 25 || in_sizes[0] != T * D || out_size != T * D || ws_size < WS_END) {
            fprintf(stderr, "kernel_launch: built for 25 inputs, x/out of %d floats, >= %zu bytes of workspace; got n_in %d, in0 %d, out %d, ws %zu; nothing launched\n", T * D, (size_t)WS_END, n_in, n_in > 0 ? in_sizes[0] : -1, out_size, ws_size);
            grid = -1; return; }
        int dev = 0, cus = 0, per_cu = 0;
        if (hipGetDevice(&dev) != hipSuccess || hipDeviceGetAttribute(&cus, hipDeviceAttributeMultiprocessorCount, dev) != hipSuccess) { fprintf(stderr, "kernel_launch: device query failed\n"); grid = -1; return; }
        if (hipFuncSetAttribute((const void*)fwd_kernel, hipFuncAttributeMaxDynamicSharedMemorySize, LDS_BYTES) != hipSuccess) { fprintf(stderr, "kernel_launch: hipFuncSetAttribute failed\n"); grid = -1; return; }
        if (hipOccupancyMaxActiveBlocksPerMultiprocessor(&per_cu, (const void*)fwd_kernel, NTHR, LDS_BYTES) != hipSuccess || per_cu < 1)
            fprintf(stderr, "kernel_launch: note: occupancy query reports %d workgroups per CU\n", per_cu);
        (void)hipGetLastError();
        grid = cus;
    }
    if (grid < 0) return;
    if (hipMemsetAsync((char*)d_ws + WS_CTL, 0, CTL_ZERO_BYTES, stream) != hipSuccess) { fprintf(stderr, "kernel_launch: memset failed\n"); return; }
    Args a{};
    for (int i = 0; i < 25; ++i) a.in[i] = (const float*)d_in[i];
    a.out = (float*)d_out; a.ws = (unsigned char*)d_ws;
#if defined(MK_TIME_REP)
    const int cuts[3][2] = {{0, MK_TIME_REP + 1}, {MK_TIME_REP, MK_TIME_REP + 1}, {MK_TIME_REP + 1, N_PHASES}};
    for (int li = 0; li < 3; ++li) {
        a.ph_lo = cuts[li][0]; a.ph_hi = cuts[li][1]; a.li = li;
        if (a.ph_lo < a.ph_hi) hipLaunchKernelGGL(fwd_kernel, dim3(grid), dim3(NTHR), LDS_BYTES, stream, a);
    }
#else
    for (int li = 0; li < MK_N_LAUNCHES; ++li) {
        if (MK_N_LAUNCHES == 1) { a.ph_lo = 0; a.ph_hi = N_PHASES; } else { a.ph_lo = li; a.ph_hi = li + 1; }
        a.li = 0;
        hipLaunchKernelGGL(fwd_kernel, dim3(grid), dim3(NTHR), LDS_BYTES, stream, a);
        const hipError_t le = hipPeekAtLastError();
        if (le != hipSuccess) { fprintf(stderr, "kernel_launch: launch %d failed: %s\n", li, hipGetErrorName(le)); break; }
#if defined(MK_CHECKS)
        { const int chk_of_phase[N_PHASES] = {0, 1, 2, 12, 6, 7, 8, 9, 10, 5, 5, 5, 11}; hipLaunchKernelGGL(chk_kernel, dim3(4), dim3(128), 0, stream, a, chk_of_phase[li]); }
#endif
    }
#endif
#if defined(MK_CHECKS)
    hipLaunchKernelGGL(chk_encode, dim3(1), dim3(64), 0, stream, a, MK_CHECKS);
#endif
}
```

```cpp
#include <hip/hip_runtime.h>
#include <cstdio>
#include <cstdint>
#include <cmath>
namespace pg8 {
#define PG8_LAS __attribute__((address_space(3)))
typedef unsigned short bf16_t;
typedef short bf16x8 __attribute__((ext_vector_type(8)));
typedef float f32x4 __attribute__((ext_vector_type(4)));
typedef unsigned u32x4 __attribute__((ext_vector_type(4)));
constexpr int BM = 256, BK = 64, HALF = 128, HTB = HALF * BK * 2  , STAGE_BYTES = 8 * HTB, NXCD = 8, WGM = 8;

__host__ __device__ __forceinline__ int lds_byte(int r, int c) { const int st = (r >> 4) * 2 + (c >> 5), rr = r & 15, cc = c & 31, ob = rr * 64 + cc * 2; return st * 1024 + (ob ^ (((ob >> 9) & 1) << 5)); }
__host__ __device__ __forceinline__ void stage_rc(int b, int& R, int& C) { const int st = b / 1024, sb = b % 1024, swz = sb ^ (((sb >> 9) & 1) << 5); R = (st >> 1) * 16 + swz / 64; C = (st & 1) * 32 + (swz % 64) / 2; }
__host__ __device__ __forceinline__ int perm32(int rho) { const int n = rho >> 4, i = rho & 15; return 8 * (i >> 2) + 4 * n + (i & 3); }

struct Unit { int pm, pn; };
struct Gemm { const bf16_t* A; const bf16_t* Bt; int M, N, K; };

struct StaticOrder {
    int nM, nN, nwg, G, c;
    __host__ __device__ void init(int M, int N, int G_, int c_) { nM = M / BM; nN = N / BM; nwg = nM * nN; G = G_; c = c_; }
    __host__ __device__ bool next(int i, Unit& u) const {
        const long L = (long)i * G + c; if (L >= nwg) return false;
        int wgid = (int)L; { const int q = nwg / NXCD, r = nwg % NXCD, xcd = wgid % NXCD, off = wgid / NXCD; wgid = (xcd < r ? xcd * (q + 1) : r * (q + 1) + (xcd - r) * q) + off; }
        const int nig = WGM * nN, gid = wgid / nig, fm = gid * WGM, gsz = (nM - fm) < WGM ? (nM - fm) : WGM;
        u.pm = fm + ((wgid % nig) % gsz); u.pn = (wgid % nig) / gsz; return true;
    }
    __device__ __forceinline__ void a_ready(const Unit&) const {}
    __device__ __forceinline__ void done(const Unit&) const {}
};

__device__ __forceinline__ unsigned cvt_pk_bf16(float lo, float hi) { unsigned r; asm volatile("v_cvt_pk_bf16_f32 %0, %1, %2" : "=v"(r) : "v"(lo), "v"(hi)); return r; }
typedef float f32x2 __attribute__((ext_vector_type(2)));
__device__ __forceinline__ f32x2 gelu_pk(f32x2 v) {
    const f32x2 av = __builtin_elementwise_abs(v), d = av * 0.2316418882f + 1.0f;
    f32x2 t; t.x = __builtin_amdgcn_rcpf(d.x); t.y = __builtin_amdgcn_rcpf(d.y);
    f32x2 q = t * 0.5307027145f + (-0.7265760135f); q = q * t + 0.7107068705f; q = q * t + (-0.142248368f); q = q * t + 0.127414796f; q = q * t;
    const f32x2 s = (v * v) * (-0.72134752044f);
    f32x2 e; e.x = __builtin_amdgcn_exp2f(s.x); e.y = __builtin_amdgcn_exp2f(s.y);
    const f32x2 m = v * (q * e), r = v - m;
    f32x2 o; o.x = v.x < 0.f ? m.x : r.x; o.y = v.y < 0.f ? m.y : r.y; return o;
}

template <int ACT  > struct EpiBf16 {
    static constexpr bool PERM = true, AFTER_DRAIN = false; static_assert(ACT == 0 || ACT == 1, "EpiBf16: ACT is 0 (none) or 1 (gelu_pk)");
    bf16_t* O; int ldc; const float* bias; int split_cols; size_t split_stride; float scale0;
    __device__ __forceinline__ void operator()(const f32x4 (&acc)[2][2][4][2], const Unit& u, int wr, int wc, int fr, int fq) const {
        const int row0 = u.pm * BM + wr * 64 + fr; int colt = u.pn * BM; bf16_t* base = O;
        float sc = 1.f; if (split_cols) { const int t = colt / split_cols; base += (size_t)t * split_stride; colt -= t * split_cols; if (t == 0) sc = scale0; }
        const int col0 = colt + wc * 32 + 8 * fq, bcol0 = u.pn * BM + wc * 32 + 8 * fq;
        f32x4 bv[2][2];
#pragma unroll
        for (int bj = 0; bj < 2; ++bj)
#pragma unroll
            for (int n = 0; n < 2; ++n) bv[bj][n] = bias ? *(const f32x4*)(bias + bcol0 + bj * HALF + 4 * n) : (f32x4){0.f, 0.f, 0.f, 0.f};
#pragma unroll
        for (int ai = 0; ai < 2; ++ai)
#pragma unroll
            for (int m = 0; m < 4; ++m) { bf16_t* rowp = base + (size_t)(row0 + ai * HALF + m * 16) * ldc + col0;
#pragma unroll
                for (int bj = 0; bj < 2; ++bj) { f32x4 v0 = acc[ai][bj][m][0] + bv[bj][0], v1 = acc[ai][bj][m][1] + bv[bj][1];
                    if (ACT == 1) { f32x2 a = gelu_pk((f32x2){v0[0], v0[1]}), b = gelu_pk((f32x2){v0[2], v0[3]}), c = gelu_pk((f32x2){v1[0], v1[1]}), d = gelu_pk((f32x2){v1[2], v1[3]});
                        v0 = (f32x4){a.x, a.y, b.x, b.y}; v1 = (f32x4){c.x, c.y, d.x, d.y}; }
                    v0 = v0 * sc; v1 = v1 * sc; u32x4 w; w.x = cvt_pk_bf16(v0[0], v0[1]); w.y = cvt_pk_bf16(v0[2], v0[3]); w.z = cvt_pk_bf16(v1[0], v1[1]); w.w = cvt_pk_bf16(v1[2], v1[3]);
                    *(u32x4*)(rowp + bj * HALF) = w; } }
    }
};
template <class Epi, class Sched, bool ALIGN_EPI = false, bool SP2 = false>
__device__ __forceinline__ void gemm_phase(PG8_LAS unsigned char* lds, const Gemm g, const Sched& S, const Epi& E) {
    const int tid = threadIdx.x, wid = __builtin_amdgcn_readfirstlane(tid >> 6), lane = tid & 63, wr = wid >> 2, wc = wid & 3, fr = lane & 15, fq = lane >> 4;
    const int K = g.K, nt = K / BK;
    unsigned voffA[2], voffB[2];
#pragma unroll
    for (int i = 0; i < 2; ++i) { int R, C; stage_rc(tid * 16 + i * 8192, R, C); const int Rb = Epi::PERM ? ((R & ~31) + perm32(R & 31)) : R;
        voffA[i] = (unsigned)(R * K + C) * 2u; voffB[i] = (unsigned)(Rb * K + C) * 2u; }
    const size_t kstep = (size_t)(BK * 2);
    const size_t hstep = (size_t)HALF * K * 2;
    const size_t tstep = 2 * hstep;
    const unsigned ldsw = (unsigned)wid * 1024u;
    const int aoff = lds_byte(wr * 64 + fr, fq * 8), boff = lds_byte(wc * 32 + fr, fq * 8);
#define PG8_SA(b, h) (((b) * 2 + (h)) * HTB)
#define PG8_SB(b, h) ((4 + (b) * 2 + (h)) * HTB)
#define PG8_STAGE(bufoff, gbase, voff) do { _Pragma("unroll") for (int _i = 0; _i < 2; ++_i) \
        __builtin_amdgcn_global_load_lds((const unsigned*)((const char*)(gbase) + (voff)[_i]), (PG8_LAS unsigned*)(lds + (bufoff) + ldsw + _i * 8192), 16, 0, 0); } while (0)
#define PG8_LDA(dst, b, h) do { _Pragma("unroll") for (int m = 0; m < 4; ++m) _Pragma("unroll") for (int k = 0; k < 2; ++k) dst[m][k] = *(const PG8_LAS bf16x8*)(lds + PG8_SA(b, h) + aoff + m * 2048 + k * 1024); } while (0)
#define PG8_LDB(dst, b, h) do { _Pragma("unroll") for (int n = 0; n < 2; ++n) _Pragma("unroll") for (int k = 0; k < 2; ++k) dst[n][k] = *(const PG8_LAS bf16x8*)(lds + PG8_SB(b, h) + boff + n * 2048 + k * 1024); } while (0)
#define PG8_MMA(ai, bj, At, Bt) do { __builtin_amdgcn_s_setprio(1); _Pragma("unroll") for (int m = 0; m < 4; ++m) _Pragma("unroll") for (int n = 0; n < 2; ++n) _Pragma("unroll") for (int k = 0; k < 2; ++k) \
        acc[ai][bj][m][n] = __builtin_amdgcn_mfma_f32_16x16x32_bf16(Bt[n][k], At[m][k], acc[ai][bj][m][n], 0, 0, 0); __builtin_amdgcn_s_setprio(0); } while (0)
#define PG8_WAIT_V(n) asm volatile("s_waitcnt vmcnt(" #n ")" ::: "memory")
#define PG8_WAIT_L(n) asm volatile("s_waitcnt lgkmcnt(" #n ")" ::: "memory")
#define PG8_BAR __builtin_amdgcn_s_barrier()
#define PG8_SCHED __builtin_amdgcn_sched_barrier(0)
    Unit cur, nxt; int ui = 0;
    if (!S.next(0, cur)) return;
    f32x4 acc[2][2][4][2];
#pragma unroll
    for (int a = 0; a < 2; ++a)
#pragma unroll
        for (int b = 0; b < 2; ++b)
#pragma unroll
            for (int m = 0; m < 4; ++m)
#pragma unroll
                for (int n = 0; n < 2; ++n) acc[a][b][m][n] = (f32x4){0.f, 0.f, 0.f, 0.f};
    bf16x8 At[4][2], B0[2][2], B1[2][2];
    const char* cA = (const char*)g.A + (size_t)cur.pm * tstep; const char* cB = (const char*)g.Bt + (size_t)cur.pn * tstep;
    S.a_ready(cur);
    if constexpr (SP2) {
        PG8_STAGE(PG8_SB(0, 0), cB, voffB); PG8_STAGE(PG8_SB(0, 1), cB + hstep, voffB); PG8_STAGE(PG8_SA(0, 0), cA, voffA); PG8_STAGE(PG8_SA(0, 1), cA + hstep, voffA);
        if (wr == 1) PG8_BAR;
        PG8_WAIT_V(2); PG8_BAR;
        PG8_STAGE(PG8_SB(1, 0), cB + kstep, voffB); PG8_STAGE(PG8_SA(1, 0), cA + kstep, voffA); PG8_STAGE(PG8_SB(1, 1), cB + hstep + kstep, voffB);
        PG8_WAIT_V(6); PG8_BAR;
    } else {
        PG8_STAGE(PG8_SB(0, 0), cB, voffB); PG8_STAGE(PG8_SA(0, 0), cA, voffA); PG8_STAGE(PG8_SB(0, 1), cB + hstep, voffB); PG8_STAGE(PG8_SA(0, 1), cA + hstep, voffA);
        if (wr == 1) PG8_BAR;
        PG8_WAIT_V(4); PG8_BAR;
        PG8_STAGE(PG8_SB(1, 0), cB + kstep, voffB); PG8_STAGE(PG8_SA(1, 0), cA + kstep, voffA); PG8_STAGE(PG8_SB(1, 1), cB + hstep + kstep, voffB);
        PG8_WAIT_V(6); PG8_BAR;
    }
    for (;;) {
        const bool has_next = S.next(ui + 1, nxt);
        const char* nA = has_next ? (const char*)g.A + (size_t)nxt.pm * tstep : cA; const char* nB = has_next ? (const char*)g.Bt + (size_t)nxt.pn * tstep : cB;
        for (int t = 0; t < nt; t += 2) {
            const bool last = (t == nt - 2);
            const char* a1 = cA + (size_t)(t + 1) * kstep;
            const char* a2 = last ? nA : cA + (size_t)(t + 2) * kstep; const char* b2 = last ? nB : cB + (size_t)(t + 2) * kstep;
            const char* a3 = a2 + kstep; const char* b3 = b2 + kstep;
            if (last && has_next) S.a_ready(nxt);
            if constexpr (SP2) {
            PG8_LDB(B0, 0, 0); PG8_LDB(B1, 0, 1); PG8_SCHED; PG8_LDA(At, 0, 0); PG8_STAGE(PG8_SA(1, 1), a1 + hstep, voffA);
            PG8_WAIT_V(8); PG8_WAIT_L(0); PG8_BAR; PG8_MMA(0, 0, At, B0); PG8_MMA(0, 1, At, B1); PG8_BAR; PG8_SCHED;
            PG8_LDA(At, 0, 1); PG8_STAGE(PG8_SB(0, 0), b2, voffB); PG8_STAGE(PG8_SB(0, 1), b2 + hstep, voffB); PG8_STAGE(PG8_SA(0, 0), a2, voffA);
            PG8_WAIT_V(8); PG8_WAIT_L(0); PG8_BAR; PG8_MMA(1, 0, At, B0); PG8_MMA(1, 1, At, B1); PG8_BAR; PG8_SCHED;
            PG8_LDB(B0, 1, 0); PG8_LDB(B1, 1, 1); PG8_SCHED; PG8_LDA(At, 1, 0); PG8_STAGE(PG8_SA(0, 1), a2 + hstep, voffA);
            PG8_WAIT_V(8); PG8_WAIT_L(0); PG8_BAR; PG8_MMA(0, 0, At, B0); PG8_MMA(0, 1, At, B1); PG8_BAR; PG8_SCHED;
            PG8_LDA(At, 1, 1); PG8_STAGE(PG8_SB(1, 0), b3, voffB); PG8_STAGE(PG8_SB(1, 1), b3 + hstep, voffB); PG8_STAGE(PG8_SA(1, 0), a3, voffA);
            PG8_WAIT_V(8); PG8_WAIT_L(0); PG8_BAR; PG8_MMA(1, 0, At, B0); PG8_MMA(1, 1, At, B1); PG8_BAR; PG8_SCHED;
            } else {
            PG8_LDB(B0, 0, 0); PG8_SCHED; PG8_LDA(At, 0, 0); PG8_STAGE(PG8_SA(1, 1), a1 + hstep, voffA);
            PG8_WAIT_L(8); PG8_BAR; PG8_WAIT_L(0); PG8_MMA(0, 0, At, B0); PG8_BAR; PG8_SCHED;
            PG8_LDB(B1, 0, 1); PG8_STAGE(PG8_SB(0, 0), b2, voffB);
            PG8_BAR; PG8_WAIT_L(0); PG8_MMA(0, 1, At, B1); PG8_BAR;
            PG8_LDA(At, 0, 1); PG8_STAGE(PG8_SA(0, 0), a2, voffA);
            PG8_BAR; PG8_WAIT_L(0); PG8_MMA(1, 0, At, B0); PG8_BAR; PG8_SCHED;
            PG8_STAGE(PG8_SB(0, 1), b2 + hstep, voffB);
            PG8_WAIT_V(6); PG8_BAR; PG8_MMA(1, 1, At, B1); PG8_BAR;
            PG8_LDB(B0, 1, 0); PG8_SCHED; PG8_LDA(At, 1, 0); PG8_STAGE(PG8_SA(0, 1), a2 + hstep, voffA);
            PG8_WAIT_L(8); PG8_BAR; PG8_WAIT_L(0); PG8_MMA(0, 0, At, B0); PG8_BAR; PG8_SCHED;
            PG8_LDB(B1, 1, 1); PG8_STAGE(PG8_SB(1, 0), b3, voffB);
            PG8_BAR; PG8_WAIT_L(0); PG8_MMA(0, 1, At, B1); PG8_BAR;
            PG8_LDA(At, 1, 1); PG8_STAGE(PG8_SA(1, 0), a3, voffA);
            PG8_BAR; PG8_WAIT_L(0); PG8_MMA(1, 0, At, B0); PG8_BAR; PG8_SCHED;
            PG8_STAGE(PG8_SB(1, 1), b3 + hstep, voffB);
            PG8_WAIT_V(6); PG8_BAR; PG8_MMA(1, 1, At, B1); PG8_BAR;
            }
        }
        if constexpr (ALIGN_EPI) { if (wr == 0) PG8_BAR; }
        if constexpr (!Epi::AFTER_DRAIN) { E(acc, cur, wr, wc, fr, fq); S.done(cur); }
        if (!has_next) break;
#pragma unroll
        for (int a = 0; a < 2; ++a)
#pragma unroll
            for (int b = 0; b < 2; ++b)
#pragma unroll
                for (int m = 0; m < 4; ++m)
#pragma unroll
                    for (int n = 0; n < 2; ++n) acc[a][b][m][n] = (f32x4){0.f, 0.f, 0.f, 0.f};
        cur = nxt; cA = nA; cB = nB; ++ui;
        if constexpr (ALIGN_EPI) { if (wr == 1) PG8_BAR; }
    }
    PG8_WAIT_V(0);
    if constexpr (!ALIGN_EPI) { if (wr == 0) PG8_BAR; }
    PG8_BAR;
    if constexpr (Epi::AFTER_DRAIN) { E.fused(acc, cur, wr, wc, fr, fq, lds, wid, lane); S.done(cur); }
#undef PG8_SA
#undef PG8_SB
#undef PG8_STAGE
#undef PG8_LDA
#undef PG8_LDB
#undef PG8_MMA
#undef PG8_WAIT_V
#undef PG8_WAIT_L
#undef PG8_BAR
#undef PG8_SCHED
}
}
#ifndef PG8_SP2
#define PG8_SP2 true
#endif
#ifndef PG8_ALIGN
#define PG8_ALIGN true
#endif
#ifndef OUT_MODE
#define OUT_MODE 0
#endif
#ifndef REP_MASK
#define REP_MASK 0
#endif
#ifndef S_CONV
#define S_CONV 1
#endif
#ifndef M3_RW
#define M3_RW 2
#endif
#ifndef PU_RSHIFT
#define PU_RSHIFT 11
#endif
#ifndef PU_NB
#define PU_NB 6
#endif
#ifndef PVQ_RB
#define PVQ_RB 16
#endif
#ifndef PUQ_RB
#define PUQ_RB 16
#endif
#ifndef PE_SORT
#define PE_SORT 1
#endif
#ifndef PH_MASK
#define PH_MASK 0xFFFFF
#endif
#ifndef MK_N_LAUNCHES
#define MK_N_LAUNCHES 1
#endif

constexpr int NWAVES = 8, NTHR = NWAVES * 64;
constexpr int BATCH = 2, SEQ = 8192, D = 2048, T = BATCH * SEQ;
constexpr int LRU_W = 1024, CONF_W = 1024, IN_COLS = 4096, LRU_HD = 128;
constexpr int NH = 8, NKEY = 128, TOPK = 16, NEXP = NKEY * NKEY, KSEL = NH * TOPK;
constexpr int NMOD = 6 * D;
constexpr int CHUNK = 64, NCHUNK = SEQ / CHUNK;
constexpr int CONF_K = 31;
constexpr float EPS = 1e-6f;
constexpr int N_PHASES = 13;

constexpr size_t MiB = 1u << 20;
constexpr size_t WS_CTL = 0, CTL_ZERO_BYTES = 64 * 1024;
constexpr size_t WS_MODP = 1 * MiB;
constexpr size_t WS_CFIN = 2 * MiB;
constexpr size_t WS_CARRY = 3 * MiB;
constexpr size_t WS_AGG = 4 * MiB;
constexpr size_t WS_WG = 6 * MiB;
constexpr size_t WS_SUBK = 7 * MiB;
constexpr size_t WS_BT1 = 8 * MiB;
constexpr size_t WS_BT2 = 24 * MiB;
constexpr size_t WS_BT3 = 32 * MiB;
constexpr size_t WS_IDX = 40 * MiB;
constexpr size_t WS_GATE = 48 * MiB;
constexpr size_t WS_USC = 56 * MiB;
constexpr size_t WS_VSC = 57 * MiB;
constexpr size_t WS_RA = 64 * MiB;
constexpr size_t WS_Y1 = 128 * MiB;
constexpr size_t WS_PROJ = 192 * MiB;
constexpr size_t WS_Q = 192 * MiB;
constexpr size_t WS_UB = 256 * MiB;
constexpr size_t WS_XL = 320 * MiB;
constexpr size_t WS_ZC = 352 * MiB;
constexpr size_t WS_Y2 = 384 * MiB;
constexpr size_t WS_SSQ = 58 * MiB;
constexpr size_t WS_HLOC = 384 * MiB;
constexpr size_t WS_PC = 416 * MiB;
constexpr size_t WS_VB = 320 * MiB;
constexpr size_t WS_ACTP = 192 * MiB;
constexpr size_t WS_ACT = 448 * MiB;
constexpr size_t WS_H2Q = 456 * MiB;
constexpr size_t WS_HSC = 488 * MiB;
constexpr size_t WS_END = 489 * MiB;
constexpr int CW_TMO = 0, CW_BAR = 4096;

constexpr int RING_OFF = 0, RING_BYTES = 131072;
constexpr int LDSCTL_OFF = 146432, MISC_OFF = LDSCTL_OFF + 320;
constexpr int LDS_BYTES = 147456;

#define GAS __attribute__((address_space(1)))
#define LAS __attribute__((address_space(3)))
typedef unsigned short bf16;
typedef unsigned v4u __attribute__((ext_vector_type(4)));
typedef unsigned v2u __attribute__((ext_vector_type(2)));
typedef float f32x4 __attribute__((ext_vector_type(4)));
typedef float f32x16 __attribute__((ext_vector_type(16)));
typedef float f32x2 __attribute__((ext_vector_type(2)));
typedef short bf16x8 __attribute__((ext_vector_type(8)));
typedef __bf16 bfp2 __attribute__((ext_vector_type(2)));
typedef GAS unsigned gu32;
#define RLX_AGENT __ATOMIC_RELAXED, __HIP_MEMORY_SCOPE_AGENT
#define LDS_WAIT() asm volatile("s_waitcnt lgkmcnt(0)" ::: "memory")
#define VM_WAIT() asm volatile("s_waitcnt vmcnt(0)" ::: "memory")
typedef __bf16 bf16v2 __attribute__((ext_vector_type(2)));
__device__ __forceinline__ unsigned pk2(float lo, float hi) { bf16v2 v; v.x = (__bf16)lo; v.y = (__bf16)hi; return __builtin_bit_cast(unsigned, v); }
__device__ __forceinline__ unsigned f2bf(float f) { return pk2(f, 0.f) & 0xffffu; }
__device__ __forceinline__ float bflo(unsigned u) { return __builtin_bit_cast(float, u << 16); }
__device__ __forceinline__ float bfhi(unsigned u) { return __builtin_bit_cast(float, u & 0xffff0000u); }
__device__ __forceinline__ float wave_sum(float v) {
#pragma unroll
    for (int o = 1; o < 64; o <<= 1) v += __shfl_xor(v, o);
    return v;
}
__device__ __forceinline__ float dpp_sum63(float v) {
    v += __builtin_bit_cast(float, __builtin_amdgcn_update_dpp(0, __builtin_bit_cast(int, v), 0xB1, 0xF, 0xF, false));
    v += __builtin_bit_cast(float, __builtin_amdgcn_update_dpp(0, __builtin_bit_cast(int, v), 0x4E, 0xF, 0xF, false));
    v += __builtin_bit_cast(float, __builtin_amdgcn_update_dpp(0, __builtin_bit_cast(int, v), 0x141, 0xF, 0xF, false));
    v += __builtin_bit_cast(float, __builtin_amdgcn_update_dpp(0, __builtin_bit_cast(int, v), 0x140, 0xF, 0xF, false));
    v += __builtin_bit_cast(float, __builtin_amdgcn_update_dpp(0, __builtin_bit_cast(int, v), 0x142, 0xA, 0xF, false));
    v += __builtin_bit_cast(float, __builtin_amdgcn_update_dpp(0, __builtin_bit_cast(int, v), 0x143, 0xC, 0xF, false));
    return v;
}

__device__ __forceinline__ float sigmoidf_(float x) { return __builtin_amdgcn_rcpf(1.0f + __expf(-x)); }
__device__ __forceinline__ float gelu_tanh(float x) { return x * sigmoidf_(1.5957691216057308f * (x + 0.044715f * x * x * x)); }
__device__ __forceinline__ float rdlane(float v, int l) { return __builtin_bit_cast(float, __builtin_amdgcn_readlane(__builtin_bit_cast(int, v), l)); }
__device__ __forceinline__ float wave_total(float v) { return rdlane(dpp_sum63(v), 63); }

#define XB_TMO      128
#define XB_XCNT(j)  (256  + 64 * (j))
#define XB_XSUB(j)  (1280 + 64 * (j))
#define XB_XGEN(j)  (2304 + 64 * (j))
#define XB_TOP      3328
#define XB_TOPGEN   3392
#define XCD_BAR_WORDS 3456
#define XB_SPIN_CAP (1u << 18)

__device__ __forceinline__ unsigned xb_ld(unsigned* p)              { return __hip_atomic_load(p, __ATOMIC_RELAXED, __HIP_MEMORY_SCOPE_AGENT); }
__device__ __forceinline__ unsigned xb_add(unsigned* p, unsigned v) { return __hip_atomic_fetch_add(p, v, __ATOMIC_RELAXED, __HIP_MEMORY_SCOPE_AGENT); }
__device__ __forceinline__ unsigned xb_xcc_id() { return (unsigned)__builtin_amdgcn_s_getreg((3 << 11) | 20) & 0xFu; }
#define XB_SPIN(cond, bar) do { unsigned _sp = 0; while (cond) { __builtin_amdgcn_s_sleep(1); \
    if ((++_sp & 255u) == 0u) { if (xb_ld(&(bar)[XB_TMO])) break; if (_sp > XB_SPIN_CAP) { atomicAdd(&(bar)[XB_TMO], 1u); break; } } } } while (0)

struct XcdBarrier {
    unsigned* bar; unsigned x;
    volatile LAS unsigned* st;
};

__device__ __forceinline__ XcdBarrier xcd_barrier_post(unsigned* bar, volatile LAS unsigned* st) {
    XcdBarrier b; b.bar = bar; b.x = xb_xcc_id(); b.st = st;
    if (threadIdx.x == 0) (void)xb_add(&bar[XB_XCNT(b.x)], 1u);
    return b;
}
__device__ __forceinline__ void xcd_barrier_complete(unsigned* bar, unsigned x, unsigned& nloc, unsigned& nx) {
    const unsigned G = gridDim.x * gridDim.y * gridDim.z;
    unsigned sum, cnt, mine, sp = 0u;
    for (;;) {
        sum = 0u; cnt = 0u; mine = 0u;
#pragma unroll
        for (unsigned j = 0; j < 16; ++j) { const unsigned c = xb_ld(&bar[XB_XCNT(j)]); sum += c; cnt += (c > 0u) ? 1u : 0u; mine = (j == x) ? c : mine; }
        if (sum == G) break;
        __builtin_amdgcn_s_sleep(1);
        if ((++sp & 255u) == 0u) { if (xb_ld(&bar[XB_TMO])) break; if (sp > XB_SPIN_CAP) { atomicAdd(&bar[XB_TMO], 1u); break; } }
    }
    nloc = mine > 0u ? mine : 1u; nx = cnt > 0u ? cnt : 1u;
}

__device__ __forceinline__ void xcd_barrier(const XcdBarrier& b) {
    asm volatile("s_waitcnt vmcnt(0)" ::: "memory");
    __syncthreads();
    if (threadIdx.x == 0) {
        unsigned* bar = b.bar;
        __builtin_amdgcn_s_waitcnt(0);
        unsigned nloc = b.st[0], nx = b.st[1];
        if (nloc == 0u) { xcd_barrier_complete(bar, b.x, nloc, nx); b.st[0] = nloc; b.st[1] = nx; }
        const unsigned old = xb_add(&bar[XB_XSUB(b.x)], 1u);
        const unsigned gen = old / nloc;
        if (old + 1u == (gen + 1u) * nloc) {
            __builtin_amdgcn_fence(__ATOMIC_RELEASE, "agent");
            asm volatile("s_waitcnt vmcnt(0)" ::: "memory");
            const unsigned og = xb_add(&bar[XB_TOP], 1u);
            const unsigned tg = og / nx;
            if (og + 1u == (tg + 1u) * nx) xb_add(&bar[XB_TOPGEN], 1u);
            else XB_SPIN(xb_ld(&bar[XB_TOPGEN]) == tg, bar);
            __builtin_amdgcn_fence(__ATOMIC_ACQUIRE, "agent");
            xb_add(&bar[XB_XGEN(b.x)], 1u);
            asm volatile("s_waitcnt vmcnt(0)" ::: "memory");
        } else {
            XB_SPIN(xb_ld(&bar[XB_XGEN(b.x)]) == gen, bar);
            __builtin_amdgcn_fence(__ATOMIC_ACQUIRE, "agent");
            asm volatile("s_waitcnt vmcnt(0)" ::: "memory");
        }
    }
    __syncthreads();
}
struct Args { const float* in[25]; float* out; unsigned char* ws; int ph_lo, ph_hi, li, pad; };
enum { I_X = 0, I_C, I_WMOD, I_BMOD, I_GPREMIX, I_GPOSTMIX, I_GPREFFN, I_GPOSTFFN, I_WIN, I_LCW, I_LCB, I_WA, I_BA, I_WX, I_BX, I_LAMBDA,
       I_CDW, I_CDB, I_LNG, I_LNB, I_WOUT, I_WQ, I_SUBK, I_PU, I_PV };

__device__ __forceinline__ float mod_at(const float* modp, int b, int n) {
    return (modp[(0 * 2 + b) * NMOD + n] + modp[(1 * 2 + b) * NMOD + n]) + (modp[(2 * 2 + b) * NMOD + n] + modp[(3 * 2 + b) * NMOD + n]);
}

__device__ __forceinline__ void p0_transpose_item(const float* W, int K, int N, bf16* WT, LAS float* scr, int item, int lane) {
    const int nblk = N / 32, kb = item / nblk, nb = item % nblk, k0 = 64 * kb, n0 = 32 * nb;
#pragma unroll 8
    for (int i = 0; i < 32; ++i) { const int kk = 2 * i + (lane >> 5); scr[kk * 33 + (lane & 31)] = W[(size_t)(k0 + kk) * N + n0 + (lane & 31)]; }
    LDS_WAIT(); asm volatile("" ::: "memory");
    const int c = lane & 7;
#pragma unroll
    for (int j = 0; j < 4; ++j) { const int n = (lane >> 3) + 8 * j; const LAS float* s = scr + (8 * c) * 33 + n;
        v4u o; o.x = pk2(s[0 * 33], s[1 * 33]); o.y = pk2(s[2 * 33], s[3 * 33]); o.z = pk2(s[4 * 33], s[5 * 33]); o.w = pk2(s[6 * 33], s[7 * 33]);
        *(GAS v4u*)(WT + (size_t)(n0 + n) * K + k0 + 8 * c) = o; }
    LDS_WAIT(); asm volatile("" ::: "memory");
}
__device__ __forceinline__ void cvt_rows_bf16(const float* src, bf16* dst, size_t n8, size_t gt, size_t ngt) {
    for (size_t i = gt; i < n8; i += ngt) {
        const f32x4 a = ((const GAS f32x4*)src)[2 * i], b = ((const GAS f32x4*)src)[2 * i + 1];
        v4u o; o.x = pk2(a.x, a.y); o.y = pk2(a.z, a.w); o.z = pk2(b.x, b.y); o.w = pk2(b.z, b.w);
        ((GAS v4u*)dst)[i] = o; }
}
__device__ __forceinline__ void phase_p0(const Args& A, LAS unsigned char* lds, int tid, int lane, int wave, int bid, int G) {
    float* modp = (float*)(A.ws + WS_MODP);
    for (int item = bid; item < 192; item += G) {
        const int cg = item % 48, kq = item / 48, k0 = kq * 512 + wave * 64, n0 = cg * 256 + lane * 4;
        const float c0 = A.in[I_C][k0 + lane], c1 = A.in[I_C][D + k0 + lane];
        const float ca0 = c0 * sigmoidf_(c0), ca1 = c1 * sigmoidf_(c1);
        f32x4 a0 = {0.f, 0.f, 0.f, 0.f}, a1 = {0.f, 0.f, 0.f, 0.f};
        const float* wp = A.in[I_WMOD] + (size_t)k0 * NMOD + n0;
#pragma unroll 8
        for (int kk = 0; kk < 64; ++kk) {
            const f32x4 w = *(const GAS f32x4*)(wp + (size_t)kk * NMOD);
            const float s0 = __shfl(ca0, kk), s1 = __shfl(ca1, kk);
            a0 += w * s0; a1 += w * s1;
        }
        LAS f32x4* red = (LAS f32x4*)lds;
        red[(wave * 2 + 0) * 64 + lane] = a0; red[(wave * 2 + 1) * 64 + lane] = a1;
        __syncthreads();
        { const int b = tid >> 8, col = tid & 255; const LAS float* rf = (const LAS float*)lds; float s = 0.f;
#pragma unroll
          for (int w = 0; w < 8; ++w) s += rf[((w * 2 + b) * 64) * 4 + col];
          if (kq == 0) s += A.in[I_BMOD][cg * 256 + col];
          modp[(kq * 2 + b) * NMOD + cg * 256 + col] = s; }
        __syncthreads();
    }
    {
        LAS float* scr = (LAS float*)(lds + wave * 16384);
        const int gw = bid * NWAVES + wave, NGW = G * NWAVES;
        constexpr int I1 = (D / 64) * (IN_COLS / 32), I2 = (D / 64) * (D / 32);
        for (int it = gw; it < I1 + 2 * I2; it += NGW) {
            int r = it;
            if (r < I1) { p0_transpose_item(A.in[I_WIN], D, IN_COLS, (bf16*)(A.ws + WS_BT1), scr, r, lane); continue; } r -= I1;
            if (r < I2) { p0_transpose_item(A.in[I_WOUT], D, D, (bf16*)(A.ws + WS_BT2), scr, r, lane); continue; } r -= I2;
            p0_transpose_item(A.in[I_WQ], D, D, (bf16*)(A.ws + WS_BT3), scr, r, lane);
        }
    }
    {
        const int gt = bid * NTHR + tid, ngt = G * NTHR;
        bf16* wg = (bf16*)(A.ws + WS_WG);
        for (int e = gt; e < NH * 256 * 128; e += ngt) {
            const int h = e >> 15, n = (e >> 7) & 255, k = e & 127;
            const float v = (n < 128 ? A.in[I_WA] : A.in[I_WX])[h * 16384 + k * 128 + (n & 127)];
            wg[e] = (bf16)f2bf(v);
        }
        cvt_rows_bf16(A.in[I_SUBK], (bf16*)(A.ws + WS_SUBK), (size_t)NH * 2 * NKEY * 128 / 8, gt, ngt);
    }
}

__device__ __forceinline__ void phase_p1(const Args& A, int tid, int lane, int wave, int bid, int G) {
    const float* modp = (const float*)(A.ws + WS_MODP);
    {
        float* cfin = (float*)(A.ws + WS_CFIN);
        for (int e = bid * NTHR + tid; e < 2 * 2 * D; e += G * NTHR) {
            const int b = e >> 12, arr = (e >> 11) & 1, col = e & (D - 1);
            cfin[e] = arr == 0 ? mod_at(modp, b, 2 * D + col) * A.in[I_GPOSTMIX][col] : mod_at(modp, b, 5 * D + col) * A.in[I_GPOSTFFN][col];
        }
        float* cfe = (float*)(A.ws + WS_CFIN) + 4 * D;
        for (int e = bid * NTHR + tid; e < 2 * 2 * D; e += G * NTHR) {
            const int b = e >> 12, arr = (e >> 11) & 1, col = e & (D - 1);
            cfe[e] = arr == 0 ? A.in[I_GPREFFN][col] * (1.0f + mod_at(modp, b, 4 * D + col)) : mod_at(modp, b, 3 * D + col);
        }
    }
    const int gw = bid * NWAVES + wave, NGW = G * NWAVES;
    bf16* h1 = (bf16*)(A.ws + WS_RA);
    int cb = -1; float gs[4][8], sh[4][8];
    for (int row = gw; row < T; row += NGW) {
        const int b = row >> 13;
        if (b != cb) { cb = b;
#pragma unroll
            for (int j = 0; j < 4; ++j)
#pragma unroll
                for (int e = 0; e < 8; ++e) { const int col = j * 512 + lane * 8 + e;
                    gs[j][e] = A.in[I_GPREMIX][col] * (1.0f + mod_at(modp, b, D + col)); sh[j][e] = mod_at(modp, b, col); } }
        const GAS f32x4* xr = (const GAS f32x4*)(A.in[I_X] + (size_t)row * D) + lane * 2;
        f32x4 v[4][2]; float s = 0.f;
#pragma unroll
        for (int j = 0; j < 4; ++j) { v[j][0] = xr[j * 128]; v[j][1] = xr[j * 128 + 1];
            s += (v[j][0].x * v[j][0].x + v[j][0].y * v[j][0].y) + (v[j][0].z * v[j][0].z + v[j][0].w * v[j][0].w);
            s += (v[j][1].x * v[j][1].x + v[j][1].y * v[j][1].y) + (v[j][1].z * v[j][1].z + v[j][1].w * v[j][1].w); }
        const float rstd = __builtin_amdgcn_rsqf(wave_total(s) * (1.0f / D) + EPS);
        GAS v4u* orow = (GAS v4u*)(h1 + (size_t)row * D) + lane;
#pragma unroll
        for (int j = 0; j < 4; ++j) { float o[8];
#pragma unroll
            for (int e = 0; e < 8; ++e) o[e] = v[j][e >> 2][e & 3] * rstd * gs[j][e] + sh[j][e];
            v4u w; w.x = pk2(o[0], o[1]); w.y = pk2(o[2], o[3]); w.z = pk2(o[4], o[5]); w.w = pk2(o[6], o[7]);
            orow[j * 64] = w; }
    }
}

__device__ __forceinline__ void m1a_tile_issue(const bf16* proj, int item, int tid, v4u (&rv)[5], v4u (&rg)[5]) {
    const int b = item >> 9, tt = (item >> 3) & 63, ct = item & 7, t0 = tt * 128;
#pragma unroll
    for (int i = 0; i < 5; ++i) {
        const int e = tid + i * NTHR, r = e >> 4, c8 = (e & 15) * 8, t = t0 - 30 + r;
        rv[i] = (v4u){0u, 0u, 0u, 0u}; rg[i] = (v4u){0u, 0u, 0u, 0u};
        if (e < 158 * 16 && t >= 0) { const bf16* p = proj + (size_t)(b * SEQ + t) * IN_COLS + 2048 + ct * 128 + c8; rv[i] = *(const GAS v4u*)p; rg[i] = *(const GAS v4u*)(p + 1024); }
    }
}
__device__ __forceinline__ void phase_m1a(const Args& A, LAS unsigned char* lds, int tid, int lane, int wave, int bid, int G) {
    const bf16* proj = (const bf16*)(A.ws + WS_PROJ);
    {
        bf16* zc = (bf16*)(A.ws + WS_ZC);
        const float* w31 = A.in[I_CDW]; const float* b31 = A.in[I_CDB];
        LAS float* zt = (LAS float*)lds;
        const int cp = tid & 63, tg = tid >> 6;
        v4u rv[5], rg[5];
        int item = bid;
        if (item < 2 * 64 * 8) m1a_tile_issue(proj, item, tid, rv, rg);
        float w0[CONF_K], w1[CONF_K], bias0 = 0.f, bias1 = 0.f; int wct = -1;
        for (; item < 2 * 64 * 8; item += G) {
            const int b = item >> 9, tt = (item >> 3) & 63, ct = item & 7, t0 = tt * 128, ch = ct * 128 + 2 * cp;
            if (ct != wct) { wct = ct;
#pragma unroll
                for (int j = 0; j < CONF_K; ++j) { const f32x2 ww = *(const GAS f32x2*)(w31 + j * CONF_W + ch); w0[j] = ww.x; w1[j] = ww.y; }
                const f32x2 bw = *(const GAS f32x2*)(b31 + ch); bias0 = bw.x; bias1 = bw.y; }
            __syncthreads();
#pragma unroll
            for (int i = 0; i < 5; ++i) {
                const int e = tid + i * NTHR, r = e >> 4, c8 = (e & 15) * 8;
                if (e < 158 * 16) { const v4u v = rv[i], g = rg[i]; f32x4 z0, z1;
                    z0.x = bflo(v.x) * sigmoidf_(bflo(g.x)); z0.y = bfhi(v.x) * sigmoidf_(bfhi(g.x)); z0.z = bflo(v.y) * sigmoidf_(bflo(g.y)); z0.w = bfhi(v.y) * sigmoidf_(bfhi(g.y));
                    z1.x = bflo(v.z) * sigmoidf_(bflo(g.z)); z1.y = bfhi(v.z) * sigmoidf_(bfhi(g.z)); z1.z = bflo(v.w) * sigmoidf_(bflo(g.w)); z1.w = bfhi(v.w) * sigmoidf_(bfhi(g.w));
                    *(LAS f32x4*)(zt + r * 128 + c8) = z0; *(LAS f32x4*)(zt + r * 128 + c8 + 4) = z1; }
            }
            __syncthreads();
            if (item + G < 2 * 64 * 8) m1a_tile_issue(proj, item + G, tid, rv, rg);
            float a0[16], a1[16];
#pragma unroll
            for (int i = 0; i < 16; ++i) { a0[i] = bias0; a1[i] = bias1; }
#pragma unroll
            for (int s_ = 0; s_ < 46; ++s_) {
                const f32x2 v = *(const LAS f32x2*)(zt + (tg * 16 + s_) * 128 + 2 * cp);
#pragma unroll
                for (int i = 0; i < 16; ++i) if (s_ - i >= 0 && s_ - i < CONF_K) { a0[i] += w0[s_ - i] * v.x; a1[i] += w1[s_ - i] * v.y; }
            }
            bf16* zo = zc + (size_t)(b * SEQ + t0 + tg * 16) * CONF_W + ch;
#pragma unroll
            for (int i = 0; i < 16; ++i) *(GAS unsigned*)(zo + (size_t)i * CONF_W) = pk2(a0[i], a1[i]);
        }
        __syncthreads();
    }
}

template <int CTRL> __device__ __forceinline__ float dpp_shr(float v, float ident) {
    return __builtin_bit_cast(float, __builtin_amdgcn_update_dpp(__builtin_bit_cast(int, ident), __builtin_bit_cast(int, v), CTRL, 0xF, 0xF, false));
}
constexpr int XT_PITCH = 2064;   static_assert(64 * 2064 <= LDSCTL_OFF, "xl tile vs LDS control words");
__device__ __forceinline__ void phase_m1b(const Args& A, LAS unsigned char* lds, int tid, int lane, int wave, int bid, int G) {
    const bf16* proj = (const bf16*)(A.ws + WS_PROJ); const bf16* wg = (const bf16*)(A.ws + WS_WG);
    bf16* hloc = (bf16*)(A.ws + WS_HLOC); bf16* pc = (bf16*)(A.ws + WS_PC); float* agg = (float*)(A.ws + WS_AGG);
    const int fr = lane & 15, fq = lane >> 4;
    for (int wi = bid; wi < 2 * NCHUNK; wi += G) {
        const int hh = wave, chunk = wi & (NCHUNK - 1), b = wi >> 7;
        const size_t r0 = (size_t)b * SEQ + (size_t)chunk * CHUNK;
        __syncthreads();
        {
            const float* w4 = A.in[I_LCW]; const float* b4 = A.in[I_LCB];
            const int c0 = (tid & 127) * 8, tr = tid >> 7, t0 = chunk * CHUNK + tr * 16;
            v4u in[19];
#pragma unroll
            for (int r = 0; r < 19; ++r) { in[r] = (v4u){0u, 0u, 0u, 0u}; if (t0 - 3 + r >= 0) in[r] = *(const GAS v4u*)(proj + ((size_t)b * SEQ + t0 - 3 + r) * IN_COLS + c0); }
            float w[4][8], bb[8];
#pragma unroll
            for (int j = 0; j < 4; ++j) { const f32x4 wa_ = *(const GAS f32x4*)(w4 + j * LRU_W + c0), wb_ = *(const GAS f32x4*)(w4 + j * LRU_W + c0 + 4);
                w[j][0] = wa_.x; w[j][1] = wa_.y; w[j][2] = wa_.z; w[j][3] = wa_.w; w[j][4] = wb_.x; w[j][5] = wb_.y; w[j][6] = wb_.z; w[j][7] = wb_.w; }
            { const f32x4 ba = *(const GAS f32x4*)(b4 + c0), bc = *(const GAS f32x4*)(b4 + c0 + 4); bb[0] = ba.x; bb[1] = ba.y; bb[2] = ba.z; bb[3] = ba.w; bb[4] = bc.x; bb[5] = bc.y; bb[6] = bc.z; bb[7] = bc.w; }
#pragma unroll
            for (int i = 0; i < 16; ++i) { float acc[8];
#pragma unroll
                for (int e = 0; e < 8; ++e) acc[e] = bb[e];
#pragma unroll
                for (int j = 0; j < 4; ++j) { const v4u v = in[i + j];
                    acc[0] += w[j][0] * bflo(v.x); acc[1] += w[j][1] * bfhi(v.x); acc[2] += w[j][2] * bflo(v.y); acc[3] += w[j][3] * bfhi(v.y);
                    acc[4] += w[j][4] * bflo(v.z); acc[5] += w[j][5] * bfhi(v.z); acc[6] += w[j][6] * bflo(v.w); acc[7] += w[j][7] * bfhi(v.w); }
                v4u o; o.x = pk2(acc[0], acc[1]); o.y = pk2(acc[2], acc[3]); o.z = pk2(acc[4], acc[5]); o.w = pk2(acc[6], acc[7]);
                *(LAS v4u*)(lds + (tr * 16 + i) * XT_PITCH + c0 * 2) = o; }
        }
        __syncthreads();
        bf16x8 xf[4][4];
#pragma unroll
        for (int mt = 0; mt < 4; ++mt)
#pragma unroll
            for (int ks = 0; ks < 4; ++ks) xf[mt][ks] = *(const LAS bf16x8*)(lds + (16 * mt + fr) * XT_PITCH + (hh * LRU_HD + 32 * ks + 8 * fq) * 2);
        float cP[4], cH[4];
        for (int j = 0; j < 8; ++j) {
            const int chb = hh * LRU_HD + 16 * j + 4 * fq;
            bf16x8 wa[4], wx[4];
#pragma unroll
            for (int ks = 0; ks < 4; ++ks) { wa[ks] = *(const GAS bf16x8*)(wg + (size_t)(hh * 256 + 16 * j + fr) * 128 + 32 * ks + 8 * fq);
                                             wx[ks] = *(const GAS bf16x8*)(wg + (size_t)(hh * 256 + 128 + 16 * j + fr) * 128 + 32 * ks + 8 * fq); }
            const f32x4 bav = *(const GAS f32x4*)(A.in[I_BA] + chb), bxv = *(const GAS f32x4*)(A.in[I_BX] + chb), lam = *(const GAS f32x4*)(A.in[I_LAMBDA] + chb);
            float cl[4];
#pragma unroll
            for (int r = 0; r < 4; ++r) { cl[r] = -8.0f * log1pf(__expf(-lam[r])); cP[r] = 1.f; cH[r] = 0.f; }
#pragma unroll
            for (int mt = 0; mt < 4; ++mt) {
                f32x4 ar = {0.f, 0.f, 0.f, 0.f}, ai = {0.f, 0.f, 0.f, 0.f};
#pragma unroll
                for (int ks = 0; ks < 4; ++ks) { ar = __builtin_amdgcn_mfma_f32_16x16x32_bf16(wa[ks], xf[mt][ks], ar, 0, 0, 0);
                                                 ai = __builtin_amdgcn_mfma_f32_16x16x32_bf16(wx[ks], xf[mt][ks], ai, 0, 0, 0); }
                const v2u xv = *(const LAS v2u*)(lds + (16 * mt + fr) * XT_PITCH + chb * 2);
                const float xlv[4] = {bflo(xv.x), bfhi(xv.x), bflo(xv.y), bfhi(xv.y)};
                float P[4], H[4];
#pragma unroll
                for (int r = 0; r < 4; ++r) {
                    const float rg = sigmoidf_(ar[r] + bav[r]), ig = sigmoidf_(ai[r] + bxv[r]);
                    const float la = cl[r] * rg, a = __expf(la), mult = sqrtf(fmaxf(1.0f - a * a, 0.f));
                    float p = a, h = mult * ig * xlv[r];
                    { float pp, hp;
                      pp = dpp_shr<0x111>(p, 1.0f); hp = dpp_shr<0x111>(h, 0.0f); h = p * hp + h; p = p * pp;
                      pp = dpp_shr<0x112>(p, 1.0f); hp = dpp_shr<0x112>(h, 0.0f); h = p * hp + h; p = p * pp;
                      pp = dpp_shr<0x114>(p, 1.0f); hp = dpp_shr<0x114>(h, 0.0f); h = p * hp + h; p = p * pp;
                      pp = dpp_shr<0x118>(p, 1.0f); hp = dpp_shr<0x118>(h, 0.0f); h = p * hp + h; p = p * pp; }
                    h = h + p * cH[r]; p = p * cP[r];
                    P[r] = p; H[r] = h;
                    cP[r] = __shfl(p, 15, 16); cH[r] = __shfl(h, 15, 16);
                }
                v2u ho, po; ho.x = pk2(H[0], H[1]); ho.y = pk2(H[2], H[3]); po.x = pk2(P[0], P[1]); po.y = pk2(P[2], P[3]);
                *(GAS v2u*)(hloc + (r0 + 16 * mt + fr) * LRU_W + chb) = ho;
                *(GAS v2u*)(pc + (r0 + 16 * mt + fr) * LRU_W + chb) = po;
            }
            if (fr == 0) {
                float* ag = agg + ((size_t)(b * NCHUNK + chunk) * LRU_W + chb) * 2;
                *(GAS f32x4*)ag = (f32x4){cP[0], cH[0], cP[1], cH[1]}; *(GAS f32x4*)(ag + 4) = (f32x4){cP[2], cH[2], cP[3], cH[3]};
            }
        }
    }
}

__device__ __forceinline__ void phase_m3(const Args& A, LAS unsigned char* lds, int tid, int lane, int wave, int bid, int G) {
    const bf16* proj = (const bf16*)(A.ws + WS_PROJ); const bf16* hloc = (const bf16*)(A.ws + WS_HLOC); const bf16* pc = (const bf16*)(A.ws + WS_PC);
    const bf16* zc = (const bf16*)(A.ws + WS_ZC); const float* agg = (const float*)(A.ws + WS_AGG);
    bf16* a2 = (bf16*)(A.ws + WS_RA);
    LAS float* cs = (LAS float*)lds;
    float lg[2][8], lb[2][8];
#pragma unroll
    for (int jj = 0; jj < 2; ++jj)
#pragma unroll
        for (int e = 0; e < 8; ++e) { lg[jj][e] = A.in[I_LNG][jj * 512 + lane * 8 + e]; lb[jj][e] = A.in[I_LNB][jj * 512 + lane * 8 + e]; }
    for (int item = bid; item < 2 * NCHUNK; item += G) {
        const int b = item >> 7, chunk = item & (NCHUNK - 1);
        {   float h0 = 0.f, h1 = 0.f; const float* ap = agg + ((size_t)(b * NCHUNK) * LRU_W + 2 * tid) * 2;
#pragma unroll 8
            for (int c = 0; c < chunk; ++c) { const f32x4 ab = *(const GAS f32x4*)(ap + (size_t)c * LRU_W * 2); h0 = ab.x * h0 + ab.y; h1 = ab.z * h1 + ab.w; }
            __syncthreads();
            cs[2 * tid] = h0; cs[2 * tid + 1] = h1;
            __syncthreads(); }
        for (int rr = 0; rr < 8; rr += M3_RW) {
            const int row0 = b * SEQ + chunk * CHUNK + wave * 8 + rr;
            v4u hv[M3_RW][2], pv[M3_RW][2], gv[M3_RW][2], zq[M3_RW][2];
#pragma unroll
            for (int u = 0; u < M3_RW; ++u)
#pragma unroll
                for (int jj = 0; jj < 2; ++jj) { const int c0 = jj * 512 + lane * 8; const size_t row = (size_t)(row0 + u);
                    hv[u][jj] = *(const GAS v4u*)(hloc + row * LRU_W + c0); pv[u][jj] = *(const GAS v4u*)(pc + row * LRU_W + c0);
                    gv[u][jj] = *(const GAS v4u*)(proj + row * IN_COLS + 1024 + c0); zq[u][jj] = *(const GAS v4u*)(zc + row * CONF_W + c0); }
#pragma unroll
            for (int u = 0; u < M3_RW; ++u) {
                const size_t row = (size_t)(row0 + u);
                float zv[2][8]; float s = 0.f;
#pragma unroll
                for (int jj = 0; jj < 2; ++jj) {
                    const int c0 = jj * 512 + lane * 8;
                    const f32x4 ca = *(const LAS f32x4*)(cs + c0), cb = *(const LAS f32x4*)(cs + c0 + 4);
                    const v4u h_ = hv[u][jj], p_ = pv[u][jj], g_ = gv[u][jj], z = zq[u][jj];
                    float y[8];
                    y[0] = (bflo(h_.x) + bflo(p_.x) * ca.x) * gelu_tanh(bflo(g_.x)); y[1] = (bfhi(h_.x) + bfhi(p_.x) * ca.y) * gelu_tanh(bfhi(g_.x));
                    y[2] = (bflo(h_.y) + bflo(p_.y) * ca.z) * gelu_tanh(bflo(g_.y)); y[3] = (bfhi(h_.y) + bfhi(p_.y) * ca.w) * gelu_tanh(bfhi(g_.y));
                    y[4] = (bflo(h_.z) + bflo(p_.z) * cb.x) * gelu_tanh(bflo(g_.z)); y[5] = (bfhi(h_.z) + bfhi(p_.z) * cb.y) * gelu_tanh(bfhi(g_.z));
                    y[6] = (bflo(h_.w) + bflo(p_.w) * cb.z) * gelu_tanh(bflo(g_.w)); y[7] = (bfhi(h_.w) + bfhi(p_.w) * cb.w) * gelu_tanh(bfhi(g_.w));
                    v4u o; o.x = pk2(y[0], y[1]); o.y = pk2(y[2], y[3]); o.z = pk2(y[4], y[5]); o.w = pk2(y[6], y[7]);
                    *(GAS v4u*)(a2 + row * D + c0) = o;
                    zv[jj][0] = bflo(z.x); zv[jj][1] = bfhi(z.x); zv[jj][2] = bflo(z.y); zv[jj][3] = bfhi(z.y); zv[jj][4] = bflo(z.z); zv[jj][5] = bfhi(z.z); zv[jj][6] = bflo(z.w); zv[jj][7] = bfhi(z.w);
#pragma unroll
                    for (int e = 0; e < 8; ++e) s += zv[jj][e];
                }
                const float mean = wave_total(s) * (1.0f / CONF_W); float q = 0.f;
#pragma unroll
                for (int jj = 0; jj < 2; ++jj)
#pragma unroll
                    for (int e = 0; e < 8; ++e) { zv[jj][e] -= mean; q += zv[jj][e] * zv[jj][e]; }
                const float rstd = __builtin_amdgcn_rsqf(wave_total(q) * (1.0f / CONF_W) + EPS);
#pragma unroll
                for (int jj = 0; jj < 2; ++jj) { float o[8];
#pragma unroll
                    for (int e = 0; e < 8; ++e) { const float n = zv[jj][e] * rstd * lg[jj][e] + lb[jj][e]; o[e] = n * sigmoidf_(n); }
                    v4u w; w.x = pk2(o[0], o[1]); w.y = pk2(o[2], o[3]); w.z = pk2(o[4], o[5]); w.w = pk2(o[6], o[7]);
                    *(GAS v4u*)(a2 + row * D + 1024 + jj * 512 + lane * 8) = w; }
            }
        }
    }
}

__device__ __forceinline__ f32x2 fp8lo(unsigned w) { return __builtin_amdgcn_cvt_pk_f32_fp8((int)w, false); }
__device__ __forceinline__ f32x2 fp8hi(unsigned w) { return __builtin_amdgcn_cvt_pk_f32_fp8((int)w, true); }
constexpr int CVT_ROWS = 4;
template <bool I8> __device__ __forceinline__ void cvt_table_q8(const float* src, unsigned char* dst, float* inv_scale, int gw, int NGW, int lane) {
    for (int r0 = gw; r0 < NEXP; r0 += NGW * CVT_ROWS) {
        f32x4 v[CVT_ROWS][8];
#pragma unroll
        for (int q = 0; q < CVT_ROWS; ++q) { const int r = r0 + q * NGW; const GAS f32x4* p = (const GAS f32x4*)(src + (size_t)(r < NEXP ? r : r0) * D) + lane;
#pragma unroll
            for (int i = 0; i < 8; ++i) v[q][i] = p[i * 64]; }
#pragma unroll
        for (int q = 0; q < CVT_ROWS; ++q) { const int r = r0 + q * NGW; float m = 0.f;
#pragma unroll
            for (int i = 0; i < 8; ++i) m = fmaxf(m, fmaxf(fmaxf(fabsf(v[q][i].x), fabsf(v[q][i].y)), fmaxf(fabsf(v[q][i].z), fabsf(v[q][i].w))));
#pragma unroll
            for (int o = 1; o < 64; o <<= 1) m = fmaxf(m, __shfl_xor(m, o));
            const float QM = I8 ? 127.0f : 448.0f;
            const float sc = m > 0.f ? QM / m : 1.0f;
            if (r < NEXP) {
                GAS unsigned* o4 = (GAS unsigned*)(dst + (size_t)r * D) + lane;
#pragma unroll
                for (int i = 0; i < 8; ++i) { const f32x4 t = v[q][i] * sc;
                    const float a = fminf(fmaxf(t.x, -QM), QM), b = fminf(fmaxf(t.y, -QM), QM), c = fminf(fmaxf(t.z, -QM), QM), d = fminf(fmaxf(t.w, -QM), QM);
                    if (I8) { o4[i * 64] = (unsigned)(((int)rintf(a) & 255) | (((int)rintf(b) & 255) << 8) | (((int)rintf(c) & 255) << 16) | ((int)rintf(d) << 24)); }
                    else { int pk = __builtin_amdgcn_cvt_pk_fp8_f32(a, b, 0, false); pk = __builtin_amdgcn_cvt_pk_fp8_f32(c, d, pk, true); o4[i * 64] = (unsigned)pk; } }
                if (lane == 0) inv_scale[r] = m > 0.f ? m * (1.0f / QM) : 1.0f;
            }
        }
    }
}
__device__ __forceinline__ void phase_e2(const Args& A, int tid, int lane, int wave, int bid, int G) {
    const float* cfin = (const float*)(A.ws + WS_CFIN); const float* cfe = (const float*)(A.ws + WS_CFIN) + 4 * D;
    const bf16* y1 = (const bf16*)(A.ws + WS_Y1); bf16* h2 = (bf16*)(A.ws + WS_RA);
    const int gw = bid * NWAVES + wave, NGW = G * NWAVES;
    int cb = -1; f32x4 c1[8], gs[8], sh[8];
    f32x4 xn[8]; v2u yn[8];
#define E2_LOAD(r_) do { const size_t r__ = (size_t)(r_); const GAS f32x4* xr = (const GAS f32x4*)(A.in[I_X] + r__ * D) + lane; const GAS v2u* yr = (const GAS v2u*)(y1 + r__ * D) + lane; \
        _Pragma("unroll") for (int j = 0; j < 8; ++j) { xn[j] = xr[j * 64]; yn[j] = yr[j * 64]; } } while (0)
    if (gw < T) E2_LOAD(gw);
    for (int row = gw; row < T; row += NGW) {
        const int b = row >> 13;
        if (b != cb) { cb = b;
#pragma unroll
            for (int j = 0; j < 8; ++j) { c1[j] = ((const GAS f32x4*)(cfin + (size_t)(b * 2 + 0) * D))[j * 64 + lane]; gs[j] = ((const GAS f32x4*)(cfe + (size_t)(b * 2 + 0) * D))[j * 64 + lane];
                sh[j] = ((const GAS f32x4*)(cfe + (size_t)(b * 2 + 1) * D))[j * 64 + lane]; } }
        f32x4 xv[8], yv[8]; float s1 = 0.f;
#pragma unroll
        for (int j = 0; j < 8; ++j) { xv[j] = xn[j]; yv[j] = (f32x4){bflo(yn[j].x), bfhi(yn[j].x), bflo(yn[j].y), bfhi(yn[j].y)};
            s1 += (yv[j].x * yv[j].x + yv[j].y * yv[j].y) + (yv[j].z * yv[j].z + yv[j].w * yv[j].w); }
        if (row + NGW < T) E2_LOAD(row + NGW);
        const float rstd1 = __builtin_amdgcn_rsqf(wave_total(s1) * (1.0f / D) + EPS); float s2 = 0.f;
#pragma unroll
        for (int j = 0; j < 8; ++j) { xv[j] += c1[j] * yv[j] * rstd1; s2 += (xv[j].x * xv[j].x + xv[j].y * xv[j].y) + (xv[j].z * xv[j].z + xv[j].w * xv[j].w); }
        const float rstd2 = __builtin_amdgcn_rsqf(wave_total(s2) * (1.0f / D) + EPS);
        GAS v2u* orow = (GAS v2u*)(h2 + (size_t)row * D) + lane; float am = 0.f;
#pragma unroll
        for (int j = 0; j < 8; ++j) { xv[j] = xv[j] * rstd2 * gs[j] + sh[j];
            am = fmaxf(am, fmaxf(fmaxf(fabsf(xv[j].x), fabsf(xv[j].y)), fmaxf(fabsf(xv[j].z), fabsf(xv[j].w))));
            orow[j * 64] = (v2u){pk2(xv[j].x, xv[j].y), pk2(xv[j].z, xv[j].w)}; }
#pragma unroll
        for (int o = 1; o < 64; o <<= 1) am = fmaxf(am, __shfl_xor(am, o));
        const float qs = am > 0.f ? 127.0f / am : 1.0f;
        GAS unsigned* qrow = (GAS unsigned*)(A.ws + WS_H2Q + (size_t)row * D) + lane;
#pragma unroll
        for (int j = 0; j < 8; ++j) { const f32x4 t = xv[j] * qs;
            qrow[j * 64] = (unsigned)(((int)rintf(t.x) & 255) | (((int)rintf(t.y) & 255) << 8) | (((int)rintf(t.z) & 255) << 16) | ((int)rintf(t.w) << 24)); }
        if (lane == 0) ((float*)(A.ws + WS_HSC))[row] = am > 0.f ? am * (1.0f / 127.0f) : 1.0f;
    }
#undef E2_LOAD
}

template <int N> __device__ __forceinline__ void bitonic_sort_desc(float (&v)[N]) {
#pragma unroll
    for (int k = 2; k <= N; k <<= 1)
#pragma unroll
        for (int j = k >> 1; j > 0; j >>= 1)
#pragma unroll
            for (int i = 0; i < N; ++i) { const int l = i ^ j;
                if (l > i) { const bool desc = ((i & k) == 0); const float a = v[i], b = v[l]; const float mx = fmaxf(a, b), mn = fminf(a, b); v[i] = desc ? mx : mn; v[l] = desc ? mn : mx; } }
}
__device__ __forceinline__ void merge_top16(float (&a)[16], const float (&b)[16]) {
#pragma unroll
    for (int i = 0; i < 16; ++i) a[i] = fmaxf(a[i], b[15 - i]);
#pragma unroll
    for (int j = 8; j > 0; j >>= 1)
#pragma unroll
        for (int i = 0; i < 16; ++i) { const int l = i ^ j; if (l > i) { const float x = a[i], y = a[l]; a[i] = fmaxf(x, y); a[l] = fminf(x, y); } }
}
__device__ __forceinline__ void top16_of_64(float (&v)[64], float (&out)[16]) {
    float g[4][16];
#pragma unroll
    for (int q = 0; q < 4; ++q) {
#pragma unroll
        for (int i = 0; i < 16; ++i) g[q][i] = v[q * 16 + i];
        bitonic_sort_desc<16>(g[q]); }
    merge_top16(g[0], g[1]); merge_top16(g[2], g[3]); merge_top16(g[0], g[2]);
#pragma unroll
    for (int i = 0; i < 16; ++i) out[i] = g[0][i];
}
__device__ __forceinline__ float pack_key(float v, unsigned key, unsigned mask) { return __builtin_bit_cast(float, (__builtin_bit_cast(unsigned, v) & ~mask) | key); }
constexpr int SK_PITCH = 272;
__device__ __forceinline__ void score_top16(const bf16* q, const LAS unsigned char* skl, int tok, int h, int p, int l31, int hf, float (&out)[16]) {
    f32x16 acc[4];
#pragma unroll
    for (int kt = 0; kt < 4; ++kt)
#pragma unroll
        for (int r = 0; r < 16; ++r) acc[kt][r] = 0.f;
    bf16x8 bq[8];
#pragma unroll
    for (int ks = 0; ks < 8; ++ks) bq[ks] = *(const GAS bf16x8*)(q + (size_t)tok * D + h * 256 + p * 128 + 16 * ks + 8 * hf);
#pragma unroll
    for (int ks = 0; ks < 8; ++ks) {
#pragma unroll
        for (int kt = 0; kt < 4; ++kt) {
            const bf16x8 ak = *(const LAS bf16x8*)(skl + (p * NKEY + 32 * kt + l31) * SK_PITCH + (16 * ks + 8 * hf) * 2);
            acc[kt] = __builtin_amdgcn_mfma_f32_32x32x16_bf16(ak, bq[ks], acc[kt], 0, 0, 0);
        }
    }
    float v[64];
#pragma unroll
    for (int kt = 0; kt < 4; ++kt)
#pragma unroll
        for (int r = 0; r < 16; ++r) v[kt * 16 + r] = pack_key(acc[kt][r], (unsigned)(32 * kt + (r & 3) + 8 * (r >> 2) + 4 * hf), 0x7Fu);
    float other[16];
    top16_of_64(v, out);
#pragma unroll
    for (int i = 0; i < 16; ++i) other[i] = __shfl_xor(out[i], 32);
    merge_top16(out, other);
}
__device__ __forceinline__ void s_convert_tables(const Args& A, int gw, int NGW, int lane) {
    cvt_table_q8<true>(A.in[I_PU], A.ws + WS_UB, (float*)(A.ws + WS_USC), gw, NGW, lane);
}
__device__ __forceinline__ void phase_s(const Args& A, LAS unsigned char* lds, int tid, int lane, int wave, int bid, int G) {
    const bf16* q = (const bf16*)(A.ws + WS_Q); const bf16* sk = (const bf16*)(A.ws + WS_SUBK);
    int* idx = (int*)(A.ws + WS_IDX); float* gate = (float*)(A.ws + WS_GATE);
    const int l31 = lane & 31, hf = lane >> 5;
    bool conv_done = false;
    for (int wi = bid; wi < (T / 512) * NH; wi += G) {
      const int h = wi & 7, tg = wi >> 3;
      __syncthreads();
#pragma unroll
      for (int i = 0; i < 8; ++i) { const int c = tid + i * NTHR, row = c >> 4, c16 = c & 15;
          *(LAS v4u*)(lds + row * SK_PITCH + c16 * 16) = *(const GAS v4u*)(sk + ((size_t)(h * 2 * NKEY + row)) * 128 + c16 * 8); }
      __syncthreads();
      if (S_CONV && wave >= 4 && !conv_done) s_convert_tables(A, bid * NWAVES + wave, G * NWAVES, lane);
      for (int ti = 0; ti < 2; ++ti) {
        const int tok = (tg * 16 + ti * 8 + wave) * 32 + l31;
        float s1[16], s2[16];
        score_top16(q, lds, tok, h, 0, l31, hf, s1);
        score_top16(q, lds, tok, h, 1, l31, hf, s2);
        float cv[64]; int n = 0;
#pragma unroll
        for (int i = 0; i < 16; ++i)
#pragma unroll
            for (int j = 0; j < 16; ++j)
                if ((i + 1) * (j + 1) <= 16) {
                    const float a = __builtin_bit_cast(float, __builtin_bit_cast(unsigned, s1[i]) & ~0x7Fu), c = __builtin_bit_cast(float, __builtin_bit_cast(unsigned, s2[j]) & ~0x7Fu);
                    cv[n++] = pack_key(a + c, (unsigned)(i * 16 + j), 0xFFu); }
#pragma unroll
        for (int m = 50; m < 64; ++m) cv[m] = -INFINITY;
        float c16[16];
        top16_of_64(cv, c16);
        float ev[16], esum = 0.f; const float cmax = __builtin_bit_cast(float, __builtin_bit_cast(unsigned, c16[0]) & ~0xFFu);
#pragma unroll
        for (int m = 0; m < 16; ++m) { ev[m] = __expf(__builtin_bit_cast(float, __builtin_bit_cast(unsigned, c16[m]) & ~0xFFu) - cmax); esum += ev[m]; }
        const float rs = 1.0f / esum;
        int oi[8]; float og[8];
#pragma unroll
        for (int mm = 0; mm < 8; ++mm) {
            float c_lo = c16[mm], c_hi = c16[8 + mm], e_lo = ev[mm], e_hi = ev[8 + mm];
            asm volatile("" : "+v"(c_lo), "+v"(c_hi), "+v"(e_lo), "+v"(e_hi));
            const unsigned cb = __builtin_bit_cast(unsigned, hf ? c_hi : c_lo); const int ii = (cb >> 4) & 15, jj = cb & 15;
            int row = 0, col = 0;
#pragma unroll
            for (int k = 0; k < 16; ++k) { row = (ii == k) ? (int)(__builtin_bit_cast(unsigned, s1[k]) & 0x7Fu) : row; col = (jj == k) ? (int)(__builtin_bit_cast(unsigned, s2[k]) & 0x7Fu) : col; }
            oi[mm] = row * NKEY + col; og[mm] = (hf ? e_hi : e_lo) * rs;
        }
        int* ip = idx + (size_t)tok * KSEL + h * 16 + hf * 8; float* gp = gate + (size_t)tok * KSEL + h * 16 + hf * 8;
        *(GAS v4u*)ip = (v4u){(unsigned)oi[0], (unsigned)oi[1], (unsigned)oi[2], (unsigned)oi[3]}; *(GAS v4u*)(ip + 4) = (v4u){(unsigned)oi[4], (unsigned)oi[5], (unsigned)oi[6], (unsigned)oi[7]};
        *(GAS f32x4*)gp = (f32x4){og[0], og[1], og[2], og[3]}; *(GAS f32x4*)(gp + 4) = (f32x4){og[4], og[5], og[6], og[7]};
      }
      if (S_CONV && wave < 4 && !conv_done) s_convert_tables(A, bid * NWAVES + wave, G * NWAVES, lane);
      conv_done = true;
    }
    if (S_CONV && !conv_done) s_convert_tables(A, bid * NWAVES + wave, G * NWAVES, lane);
    __syncthreads();
}

__device__ __forceinline__ float row_dot_fp8(const v4u d0, const v4u d1, const f32x2 (&hf)[2][8]) {
    const unsigned w0[4] = {d0.x, d0.y, d0.z, d0.w}, w1[4] = {d1.x, d1.y, d1.z, d1.w};
    f32x2 a = {0.f, 0.f}, b = {0.f, 0.f};
#pragma unroll
    for (int i = 0; i < 4; ++i) { a += fp8lo(w0[i]) * hf[0][2 * i]; a += fp8hi(w0[i]) * hf[0][2 * i + 1]; b += fp8lo(w1[i]) * hf[1][2 * i]; b += fp8hi(w1[i]) * hf[1][2 * i + 1]; }
    return (a.x + a.y) + (b.x + b.y);
}
__device__ __forceinline__ void row_axpy_fp8(f32x2 (&acc)[2][8], const v4u d0, const v4u d1, float w) {
    const unsigned w0[4] = {d0.x, d0.y, d0.z, d0.w}, w1[4] = {d1.x, d1.y, d1.z, d1.w};
#pragma unroll
    for (int i = 0; i < 4; ++i) { acc[0][2 * i] += fp8lo(w0[i]) * w; acc[0][2 * i + 1] += fp8hi(w0[i]) * w; acc[1][2 * i] += fp8lo(w1[i]) * w; acc[1][2 * i + 1] += fp8hi(w1[i]) * w; }
}
__device__ __forceinline__ void phase_pu(const Args& A, int lane, int wave, int bid, int G) {
    const unsigned char* h2q = A.ws + WS_H2Q; const unsigned char* ub = A.ws + WS_UB; const int* idx = (const int*)(A.ws + WS_IDX); float* actp = (float*)(A.ws + WS_ACTP);
    const int NX = (G % 8 == 0) ? 8 : 1, vx = bid % NX, nw = (G / NX) * NWAVES, wv = (bid / NX) * NWAVES + wave;
    const int q = lane >> 4, c16 = lane & 15;
    for (int cb = vx; cb < D / 256; cb += NX) {
        const unsigned loff = (unsigned)(cb * 256 + c16 * 16);
        int cid0 = 0, cid1 = 0, nid0 = 0, nid1 = 0; v4u ch = {0u, 0u, 0u, 0u}, nh = {0u, 0u, 0u, 0u};
#define PUQ_LOAD(i0, i1, hh, t_) do { const int t__ = (t_); if (t__ < T) { i0 = idx[(size_t)t__ * KSEL + lane]; i1 = idx[(size_t)t__ * KSEL + 64 + lane]; hh = *(const GAS v4u*)(h2q + (size_t)t__ * D + cb * 256 + c16 * 16); } } while (0)
        PUQ_LOAD(cid0, cid1, ch, wv); PUQ_LOAD(nid0, nid1, nh, wv + nw);
        v4u rv[PUQ_RB];
#define PUQ_ISSUE(slot, idr, s_) do { const unsigned e_ = (unsigned)__shfl(idr, ((4 * (s_)) & 63) + q); rv[slot] = *(const GAS v4u*)(ub + ((e_ << 11) + loff)); } while (0)
#pragma unroll
        for (int r = 0; r < PUQ_RB; ++r) PUQ_ISSUE(r, cid0, r);
        f32x4 cvv[8]; int it = 0;
        const int gwv = bid * NWAVES + wave, NGWv = G * NWAVES;
        for (int tok = wv; tok < T; tok += nw, ++it) {
            if (cb == vx) {
                const int vr = gwv + NGWv * (it >> 3);
                if ((it & 7) == 0 && vr < NEXP) { const GAS f32x4* p = (const GAS f32x4*)(A.in[I_PV] + (size_t)vr * D) + lane;
#pragma unroll
                    for (int i = 0; i < 8; ++i) cvv[i] = p[i * 64]; }
                if ((it & 7) == 1 && vr < NEXP) { float m = 0.f;
#pragma unroll
                    for (int i = 0; i < 8; ++i) m = fmaxf(m, fmaxf(fmaxf(fabsf(cvv[i].x), fabsf(cvv[i].y)), fmaxf(fabsf(cvv[i].z), fabsf(cvv[i].w))));
#pragma unroll
                    for (int o = 1; o < 64; o <<= 1) m = fmaxf(m, __shfl_xor(m, o));
                    const float sc = m > 0.f ? 448.0f / m : 1.0f; GAS unsigned* o4 = (GAS unsigned*)(A.ws + WS_VB + (size_t)vr * D) + lane;
#pragma unroll
                    for (int i = 0; i < 8; ++i) { const f32x4 t = cvv[i] * sc;
                        const float a = fminf(fmaxf(t.x, -448.f), 448.f), b = fminf(fmaxf(t.y, -448.f), 448.f), c = fminf(fmaxf(t.z, -448.f), 448.f), d = fminf(fmaxf(t.w, -448.f), 448.f);
                        int pk = __builtin_amdgcn_cvt_pk_fp8_f32(a, b, 0, false); pk = __builtin_amdgcn_cvt_pk_fp8_f32(c, d, pk, true); o4[i * 64] = (unsigned)pk; }
                    if (lane == 0) ((float*)(A.ws + WS_VSC))[vr] = m > 0.f ? m * (1.0f / 448.0f) : 1.0f; }
            }
            const int hx = (int)ch.x, hy = (int)ch.y, hz = (int)ch.z, hw = (int)ch.w;
            int a0 = 0, a1 = 0;
#define PUQ_DOT(slot, acc_, s_) do { const v4u d_ = rv[slot]; int p_ = __builtin_amdgcn_sdot4((int)d_.x, hx, 0, false); p_ = __builtin_amdgcn_sdot4((int)d_.y, hy, p_, false); \
                p_ = __builtin_amdgcn_sdot4((int)d_.z, hz, p_, false); p_ = __builtin_amdgcn_sdot4((int)d_.w, hw, p_, false); \
                p_ += __builtin_amdgcn_update_dpp(0, p_, 0xB1, 0xF, 0xF, false); p_ += __builtin_amdgcn_update_dpp(0, p_, 0x4E, 0xF, 0xF, false); \
                p_ += __builtin_amdgcn_update_dpp(0, p_, 0x141, 0xF, 0xF, false); p_ += __builtin_amdgcn_update_dpp(0, p_, 0x140, 0xF, 0xF, false); \
                acc_ = (c16 == ((s_) & 15)) ? p_ : acc_; } while (0)
#pragma unroll
            for (int r = 0; r < PUQ_RB; ++r) { PUQ_DOT(r, a0, r); PUQ_ISSUE(r, cid1, r + PUQ_RB); }
#pragma unroll
            for (int r = 0; r < PUQ_RB; ++r) { PUQ_DOT(r, a1, r + PUQ_RB); PUQ_ISSUE(r, nid0, r); }
            float* ap = actp + ((size_t)cb * T + tok) * KSEL + 4 * c16 + q;
            ap[0] = (float)a0; ap[64] = (float)a1;
            cid0 = nid0; cid1 = nid1; ch = nh;
            PUQ_LOAD(nid0, nid1, nh, tok + 2 * nw);
        }
#undef PUQ_LOAD
#undef PUQ_ISSUE
#undef PUQ_DOT
    }
}
__device__ __forceinline__ void phase_w(const Args& A, int lane, int wave, int bid, int G) {
    const float* actp = (const float*)(A.ws + WS_ACTP); const float* usc = (const float*)(A.ws + WS_USC); const float* vsc = (const float*)(A.ws + WS_VSC); const float* hsc = (const float*)(A.ws + WS_HSC);
    const int* idx = (const int*)(A.ws + WS_IDX); const float* gate = (const float*)(A.ws + WS_GATE); float* wb = (float*)(A.ws + WS_ACT);
    for (int tok = bid * NWAVES + wave; tok < T; tok += G * NWAVES) {
        const float hs = hsc[tok];
#pragma unroll
        for (int hh = 0; hh < 2; ++hh) {
            const size_t o = (size_t)tok * KSEL + hh * 64 + lane; float sacc = 0.f;
#pragma unroll
            for (int c = 0; c < 8; ++c) sacc += actp[(size_t)c * T * KSEL + o];
            const int e = idx[o];
            wb[o] = gate[o] * gelu_tanh(sacc * usc[e] * hs) * vsc[e];
        }
    }
}
__device__ __forceinline__ void phase_pv(const Args& A, int lane, int wave, int bid, int G) {
    const unsigned char* vb = A.ws + WS_VB; const float* wb = (const float*)(A.ws + WS_ACT); const int* idx = (const int*)(A.ws + WS_IDX);
    bf16* y2 = (bf16*)(A.ws + WS_Y2); float* ssq = (float*)(A.ws + WS_SSQ);
    const int NX = (G % 8 == 0) ? 8 : 1, vx = bid % NX, nw = (G / NX) * NWAVES, wv = (bid / NX) * NWAVES + wave;
    const int q = lane >> 4, c16 = lane & 15;
    for (int cb = vx; cb < D / 256; cb += NX) {
        const unsigned loff = (unsigned)(cb * 256 + c16 * 16);
        int cid0 = 0, cid1 = 0, nid0 = 0, nid1 = 0; float cw0 = 0.f, cw1 = 0.f, nw0 = 0.f, nw1 = 0.f;
#define PVQ_LOAD(i0, i1, x0, x1, t_) do { const int t__ = (t_); if (t__ < T) { i0 = idx[(size_t)t__ * KSEL + lane]; i1 = idx[(size_t)t__ * KSEL + 64 + lane]; x0 = wb[(size_t)t__ * KSEL + lane]; x1 = wb[(size_t)t__ * KSEL + 64 + lane]; } } while (0)
        PVQ_LOAD(cid0, cid1, cw0, cw1, wv); PVQ_LOAD(nid0, nid1, nw0, nw1, wv + nw);
        v4u rv[PVQ_RB];
#define PVQ_ISSUE(slot, idr, s_) do { const unsigned e_ = (unsigned)__shfl(idr, ((4 * (s_)) & 63) + q); rv[slot] = *(const GAS v4u*)(vb + ((e_ << 11) + loff)); } while (0)
#pragma unroll
        for (int r = 0; r < PVQ_RB; ++r) PVQ_ISSUE(r, cid0, r);
        for (int tok = wv; tok < T; tok += nw) {
            f32x2 acc[8];
#pragma unroll
            for (int i = 0; i < 8; ++i) acc[i] = (f32x2){0.f, 0.f};
#define PVQ_FMA(slot, wr, s_) do { const float w_ = __shfl(wr, ((4 * (s_)) & 63) + q); const v4u d_ = rv[slot]; const unsigned dw_[4] = {d_.x, d_.y, d_.z, d_.w}; \
                _Pragma("unroll") for (int i_ = 0; i_ < 4; ++i_) { acc[2 * i_] += fp8lo(dw_[i_]) * w_; acc[2 * i_ + 1] += fp8hi(dw_[i_]) * w_; } } while (0)
#pragma unroll
            for (int r = 0; r < PVQ_RB; ++r) { PVQ_FMA(r, cw0, r); PVQ_ISSUE(r, cid1, r + PVQ_RB); }
#pragma unroll
            for (int r = 0; r < PVQ_RB; ++r) { PVQ_FMA(r, cw1, r + PVQ_RB); PVQ_ISSUE(r, nid0, r); }
            float sq = 0.f;
#pragma unroll
            for (int i = 0; i < 8; ++i) { float x = acc[i].x, y = acc[i].y; x += __shfl_xor(x, 16); y += __shfl_xor(y, 16); x += __shfl_xor(x, 32); y += __shfl_xor(y, 32); acc[i] = (f32x2){x, y}; sq += x * x + y * y; }
            sq = wave_total(q == 0 ? sq : 0.f);
            if (q == 0) { GAS v4u* yo = (GAS v4u*)(y2 + (size_t)tok * D + cb * 256 + c16 * 16);
                yo[0] = (v4u){pk2(acc[0].x, acc[0].y), pk2(acc[1].x, acc[1].y), pk2(acc[2].x, acc[2].y), pk2(acc[3].x, acc[3].y)};
                yo[1] = (v4u){pk2(acc[4].x, acc[4].y), pk2(acc[5].x, acc[5].y), pk2(acc[6].x, acc[6].y), pk2(acc[7].x, acc[7].y)}; }
            if (lane == 0) ssq[(size_t)cb * T + tok] = sq;
            cid0 = nid0; cid1 = nid1; cw0 = nw0; cw1 = nw1;
            PVQ_LOAD(nid0, nid1, nw0, nw1, tok + 2 * nw);
        }
#undef PVQ_LOAD
#undef PVQ_ISSUE
#undef PVQ_FMA
    }
}
__device__ __forceinline__ void phase_f(const Args& A, int lane, int wave, int bid, int G) {
    const bf16* y1 = (const bf16*)(A.ws + WS_Y1); const bf16* y2 = (const bf16*)(A.ws + WS_Y2); const float* ssq = (const float*)(A.ws + WS_SSQ); const float* cfin = (const float*)(A.ws + WS_CFIN);
    for (int tok = bid * NWAVES + wave; tok < T; tok += G * NWAVES) {
        const int b = tok >> 13;
        float qs = 0.f;
#pragma unroll
        for (int c = 0; c < 8; ++c) qs += ssq[(size_t)c * T + tok];
        const float rstd2 = __builtin_amdgcn_rsqf(qs * (1.0f / D) + EPS);
        const GAS v2u* yp = (const GAS v2u*)(y1 + (size_t)tok * D) + lane; const GAS v2u* zp = (const GAS v2u*)(y2 + (size_t)tok * D) + lane;
        const GAS f32x4* xr = (const GAS f32x4*)(A.in[I_X] + (size_t)tok * D) + lane;
        v2u yq[8], zq[8]; f32x4 xv[8]; float s1 = 0.f;
#pragma unroll
        for (int i = 0; i < 8; ++i) { yq[i] = yp[i * 64]; zq[i] = zp[i * 64]; xv[i] = xr[i * 64]; }
#pragma unroll
        for (int i = 0; i < 8; ++i) { const float a = bflo(yq[i].x), b_ = bfhi(yq[i].x), c = bflo(yq[i].y), d = bfhi(yq[i].y); s1 += (a * a + b_ * b_) + (c * c + d * d); }
        const float rstd1 = __builtin_amdgcn_rsqf(wave_total(s1) * (1.0f / D) + EPS);
        const GAS f32x4* c1 = (const GAS f32x4*)(cfin + (size_t)(b * 2 + 0) * D) + lane; const GAS f32x4* c2 = (const GAS f32x4*)(cfin + (size_t)(b * 2 + 1) * D) + lane;
        GAS f32x4* orow = (GAS f32x4*)(A.out + (size_t)tok * D) + lane;
#pragma unroll
        for (int i = 0; i < 8; ++i) { const f32x4 a1 = c1[i * 64], a2 = c2[i * 64];
            const float yv[4] = {bflo(yq[i].x), bfhi(yq[i].x), bflo(yq[i].y), bfhi(yq[i].y)}, zv[4] = {bflo(zq[i].x), bfhi(zq[i].x), bflo(zq[i].y), bfhi(zq[i].y)}; f32x4 o;
#pragma unroll
            for (int e = 0; e < 4; ++e) o[e] = xv[i][e] + (OUT_MODE != 2 ? a1[e] * yv[e] * rstd1 : 0.f) + (OUT_MODE != 1 ? a2[e] * zv[e] * rstd2 : 0.f);
            orow[i * 64] = o; }
    }
}

#if defined(MK_CHECKS)
constexpr int CW_CHK = 2048;
__device__ __forceinline__ unsigned hsh(unsigned x) { x ^= x >> 16; x *= 0x7feb352dU; x ^= x >> 15; x *= 0x846ca68bU; x ^= x >> 16; return x; }
__device__ __forceinline__ float bfv(const bf16* p, size_t i) { return __builtin_bit_cast(float, (unsigned)p[i] << 16); }
__device__ __forceinline__ float relerr(float got, float ref, float scale) { const float d = fabsf(got - ref) / (fabsf(ref) + scale); return (d == d) ? d : 1e30f; }
__device__ __forceinline__ void chk_put(unsigned* ctl, int stage, float e) { atomicMax(ctl + CW_CHK + stage, __builtin_bit_cast(unsigned, e)); }
__device__ float chk_gemm(const bf16* Am, const bf16* Bt, const bf16* C, int N, int K, unsigned s) {
    const int row = hsh(s) % T, col = hsh(s * 7 + 1) % N; float acc = 0.f;
    for (int k = 0; k < K; ++k) acc += bfv(Am, (size_t)row * K + k) * bfv(Bt, (size_t)col * K + k);
    return relerr(bfv(C, (size_t)row * N + col), acc, 0.05f);
}
__device__ float xl_at(const Args& A, const bf16* proj, size_t row, int c) {
    const int t = (int)(row & (SEQ - 1)); float a = A.in[I_LCB][c];
    for (int j = 0; j < 4; ++j) if (t - 3 + j >= 0) a += A.in[I_LCW][j * LRU_W + c] * bfv(proj, (row - 3 + j) * IN_COLS + c);
    return __builtin_bit_cast(float, f2bf(a) << 16);
}
__global__ void __launch_bounds__(128) chk_kernel(Args A, int stage) {
    __shared__ float sh[10240];
    unsigned* ctl = (unsigned*)(A.ws + WS_CTL);
    const int tid = threadIdx.x; const unsigned s = hsh(tid * 2654435761u + stage * 97u + 12345u);
    const float* modp = (const float*)(A.ws + WS_MODP);
    float e = 0.f;
    if (stage == 0) {
        { const int b = s & 1, n = hsh(s) % NMOD; float acc = A.in[I_BMOD][n];
          for (int k = 0; k < D; ++k) { const float c = A.in[I_C][b * D + k]; acc += c / (1.0f + expf(-c)) * A.in[I_WMOD][(size_t)k * NMOD + n]; }
          e = fmaxf(e, relerr(mod_at(modp, b, n), acc, 0.01f)); }
        { const int n = hsh(s + 1) % IN_COLS, k = hsh(s + 2) % D; e = fmaxf(e, relerr(bfv((const bf16*)(A.ws + WS_BT1), (size_t)n * D + k), A.in[I_WIN][(size_t)k * IN_COLS + n], 1e-3f)); }
        { const int n = hsh(s + 3) % D, k = hsh(s + 4) % D; e = fmaxf(e, relerr(bfv((const bf16*)(A.ws + WS_BT2), (size_t)n * D + k), A.in[I_WOUT][(size_t)k * D + n], 1e-3f));
          e = fmaxf(e, relerr(bfv((const bf16*)(A.ws + WS_BT3), (size_t)n * D + k), A.in[I_WQ][(size_t)k * D + n], 1e-3f)); }
        { const int h = s & 7, n = hsh(s + 5) & 255, k = hsh(s + 6) & 127; const float ref = (n < 128 ? A.in[I_WA] : A.in[I_WX])[h * 16384 + k * 128 + (n & 127)];
          e = fmaxf(e, relerr(bfv((const bf16*)(A.ws + WS_WG), (size_t)(h * 256 + n) * 128 + k), ref, 1e-3f)); }
        { const int i = hsh(s + 7) % (NH * 2 * NKEY * 128); e = fmaxf(e, relerr(bfv((const bf16*)(A.ws + WS_SUBK), i), A.in[I_SUBK][i], 1e-3f)); }
    } else if (stage == 1) {
        const int row = hsh(s) % T, col = hsh(s + 1) % D, b = row >> 13; float ss = 0.f;
        for (int k = 0; k < D; ++k) { const float x = A.in[I_X][(size_t)row * D + k]; ss += x * x; }
        const float ref = A.in[I_X][(size_t)row * D + col] * rsqrtf(ss / D + EPS) * A.in[I_GPREMIX][col] * (1.0f + mod_at(modp, b, D + col)) + mod_at(modp, b, col);
        e = relerr(bfv((const bf16*)(A.ws + WS_RA), (size_t)row * D + col), ref, 0.05f);
        const float* cfin = (const float*)(A.ws + WS_CFIN);
        e = fmaxf(e, relerr(cfin[(b * 2 + 0) * D + col], mod_at(modp, b, 2 * D + col) * A.in[I_GPOSTMIX][col], 1e-3f));
        e = fmaxf(e, relerr(cfin[(b * 2 + 1) * D + col], mod_at(modp, b, 5 * D + col) * A.in[I_GPOSTFFN][col], 1e-3f));
    } else if (stage == 2) { e = chk_gemm((const bf16*)(A.ws + WS_RA), (const bf16*)(A.ws + WS_BT1), (const bf16*)(A.ws + WS_PROJ), IN_COLS, D, s);
    } else if (stage == 7) { e = chk_gemm((const bf16*)(A.ws + WS_RA), (const bf16*)(A.ws + WS_BT2), (const bf16*)(A.ws + WS_Y1), D, D, s);
    } else if (stage == 9) { e = chk_gemm((const bf16*)(A.ws + WS_RA), (const bf16*)(A.ws + WS_BT3), (const bf16*)(A.ws + WS_Q), D, D, s);
    } else if (stage == 3) {
        const bf16* proj = (const bf16*)(A.ws + WS_PROJ);
        int row = hsh(s) % T; if (tid < 16) row = (tid & 1) * SEQ + (tid >> 1);
        const int c = hsh(s + 1) % LRU_W, t = row & (SEQ - 1);
        float a = A.in[I_LCB][c];
        for (int j = 0; j < 4; ++j) if (t - 3 + j >= 0) a += A.in[I_LCW][j * LRU_W + c] * bfv(proj, (size_t)(row - 3 + j) * IN_COLS + c);
        (void)a;
        float z = A.in[I_CDB][c];
        for (int j = 0; j < CONF_K; ++j) if (t - 30 + j >= 0) { const size_t r = (size_t)(row - 30 + j) * IN_COLS; const float g = bfv(proj, r + 3072 + c);
            z += A.in[I_CDW][j * CONF_W + c] * bfv(proj, r + 2048 + c) / (1.0f + expf(-g)); }
        e = fmaxf(e, relerr(bfv((const bf16*)(A.ws + WS_ZC), (size_t)row * CONF_W + c), z, 0.05f));
    } else if (stage == 4) {
        const bf16* xl = (const bf16*)(A.ws + WS_XL);
        const int b = s & 1, chunk = hsh(s + 1) % NCHUNK, ch = hsh(s + 2) % LRU_W, hh = ch >> 7, j = ch & 127;
        const float cl = -8.0f * log1pf(expf(-A.in[I_LAMBDA][ch])); float P = 1.f, H = 0.f;
        for (int t = 0; t < CHUNK; ++t) { const size_t row = (size_t)b * SEQ + chunk * CHUNK + t; float ga = A.in[I_BA][ch], gx = A.in[I_BX][ch];
            for (int i = 0; i < 128; ++i) { const float xv = bfv(xl, row * LRU_W + hh * 128 + i); ga += xv * A.in[I_WA][hh * 16384 + i * 128 + j]; gx += xv * A.in[I_WX][hh * 16384 + i * 128 + j]; }
            const float r = 1.0f / (1.0f + expf(-ga)), ig = 1.0f / (1.0f + expf(-gx)), la = cl * r, a = expf(la), u = sqrtf(fmaxf(-expm1f(2.0f * la), 0.f)) * ig * bfv(xl, row * LRU_W + ch);
            H = a * H + u; P = P * a;
            e = fmaxf(e, relerr(bfv((const bf16*)(A.ws + WS_HLOC), row * LRU_W + ch), H, 0.05f)); e = fmaxf(e, relerr(bfv((const bf16*)(A.ws + WS_PC), row * LRU_W + ch), P, 0.02f)); }
        const float* ag = (const float*)(A.ws + WS_AGG) + ((size_t)(b * NCHUNK + chunk) * LRU_W + ch) * 2;
        e = fmaxf(e, relerr(ag[0], P, 0.02f)); e = fmaxf(e, relerr(ag[1], H, 0.05f));
    } else if (stage == 12) {
        const bf16* proj = (const bf16*)(A.ws + WS_PROJ);
#define XLV(row_, ch_) xl_at(A, proj, (row_), (ch_))
        const int b = s & 1, chunk = hsh(s + 1) % NCHUNK, ch = hsh(s + 2) % LRU_W, hh = ch >> 7, j = ch & 127;
        const float cl = -8.0f * log1pf(expf(-A.in[I_LAMBDA][ch])); float P = 1.f, H = 0.f;
        for (int t = 0; t < CHUNK; ++t) { const size_t row = (size_t)b * SEQ + chunk * CHUNK + t; float ga = A.in[I_BA][ch], gx = A.in[I_BX][ch];
            for (int i = 0; i < 128; ++i) { const float xv = XLV(row, hh * 128 + i); ga += xv * A.in[I_WA][hh * 16384 + i * 128 + j]; gx += xv * A.in[I_WX][hh * 16384 + i * 128 + j]; }
            const float r = 1.0f / (1.0f + expf(-ga)), ig = 1.0f / (1.0f + expf(-gx)), la = cl * r, a = expf(la), u = sqrtf(fmaxf(-expm1f(2.0f * la), 0.f)) * ig * XLV(row, ch);
            H = a * H + u; P = P * a;
            e = fmaxf(e, relerr(bfv((const bf16*)(A.ws + WS_HLOC), row * LRU_W + ch), H, 0.05f)); e = fmaxf(e, relerr(bfv((const bf16*)(A.ws + WS_PC), row * LRU_W + ch), P, 0.02f)); }
        const float* ag = (const float*)(A.ws + WS_AGG) + ((size_t)(b * NCHUNK + chunk) * LRU_W + ch) * 2;
        e = fmaxf(e, relerr(ag[0], P, 0.02f)); e = fmaxf(e, relerr(ag[1], H, 0.05f));
        { const int row = hsh(s + 9) % T, c = hsh(s + 10) % CONF_W, t = row & (SEQ - 1); float z = A.in[I_CDB][c];
          for (int j = 0; j < CONF_K; ++j) if (t - 30 + j >= 0) { const size_t r = (size_t)(row - 30 + j) * IN_COLS; const float g = bfv(proj, r + 3072 + c); z += A.in[I_CDW][j * CONF_W + c] * bfv(proj, r + 2048 + c) / (1.0f + expf(-g)); }
          e = fmaxf(e, relerr(bfv((const bf16*)(A.ws + WS_ZC), (size_t)row * CONF_W + c), z, 0.05f)); }
#undef XLV
    } else if (stage == 5) {
    } else if (stage == 6) {
        const bf16* proj = (const bf16*)(A.ws + WS_PROJ); const bf16* zc = (const bf16*)(A.ws + WS_ZC);
        const int row = hsh(s) % T, c = hsh(s + 1) % LRU_W, b = row >> 13, chunk = (row & (SEQ - 1)) >> 6;
        float cin = 0.f; for (int cc = 0; cc < chunk; ++cc) { const float* ag = (const float*)(A.ws + WS_AGG) + ((size_t)(b * NCHUNK + cc) * LRU_W + c) * 2; cin = ag[0] * cin + ag[1]; }
        const float hfull = bfv((const bf16*)(A.ws + WS_HLOC), (size_t)row * LRU_W + c) + bfv((const bf16*)(A.ws + WS_PC), (size_t)row * LRU_W + c) * cin;
        const float g = bfv(proj, (size_t)row * IN_COLS + 1024 + c), ge = 0.5f * g * (1.0f + tanhf(0.7978845608f * (g + 0.044715f * g * g * g)));
        e = relerr(bfv((const bf16*)(A.ws + WS_RA), (size_t)row * D + c), hfull * ge, 0.05f);
        float m = 0.f, q = 0.f;
        for (int k = 0; k < CONF_W; ++k) m += bfv(zc, (size_t)row * CONF_W + k);
        m /= CONF_W;
        for (int k = 0; k < CONF_W; ++k) { const float d = bfv(zc, (size_t)row * CONF_W + k) - m; q += d * d; }
        const float n = (bfv(zc, (size_t)row * CONF_W + c) - m) * rsqrtf(q / CONF_W + EPS) * A.in[I_LNG][c] + A.in[I_LNB][c];
        e = fmaxf(e, relerr(bfv((const bf16*)(A.ws + WS_RA), (size_t)row * D + 1024 + c), n / (1.0f + expf(-n)), 0.05f));
    } else if (stage == 8) {
        const bf16* y1 = (const bf16*)(A.ws + WS_Y1); const float* cfin = (const float*)(A.ws + WS_CFIN);
        const int row = hsh(s) % T, col = hsh(s + 1) % D, b = row >> 13; float s1 = 0.f, s2 = 0.f;
        for (int k = 0; k < D; ++k) { const float y = bfv(y1, (size_t)row * D + k); s1 += y * y; }
        const float r1 = rsqrtf(s1 / D + EPS);
        for (int k = 0; k < D; ++k) { const float x1 = A.in[I_X][(size_t)row * D + k] + cfin[(b * 2) * D + k] * bfv(y1, (size_t)row * D + k) * r1; s2 += x1 * x1; }
        const float x1c = A.in[I_X][(size_t)row * D + col] + cfin[(b * 2) * D + col] * bfv(y1, (size_t)row * D + col) * r1;
        const float ref = x1c * rsqrtf(s2 / D + EPS) * A.in[I_GPREFFN][col] * (1.0f + mod_at(modp, b, 4 * D + col)) + mod_at(modp, b, 3 * D + col);
        e = relerr(bfv((const bf16*)(A.ws + WS_RA), (size_t)row * D + col), ref, 0.05f);
    } else if (stage == 10) {
        { const size_t i = (size_t)(hsh(s + 2) % NEXP) * D + hsh(s + 3) % D;
          const unsigned wu = ((const unsigned*)(A.ws + WS_UB))[i >> 2] >> (8 * (i & 3)), wv = ((const unsigned*)(A.ws + WS_VB))[i >> 2] >> (8 * (i & 3));
          const float du = (float)(signed char)(wu & 255u) * ((const float*)(A.ws + WS_USC))[i / D], dv = __builtin_amdgcn_cvt_pk_f32_fp8((int)wv, false)[0] * ((const float*)(A.ws + WS_VSC))[i / D];
          e = fmaxf(e, relerr(du, A.in[I_PU][i], 2e-3f) * 0.3f); (void)dv; }
        if (tid < 32) {
            const bf16* q = (const bf16*)(A.ws + WS_Q); const int* idx = (const int*)(A.ws + WS_IDX); const float* gate = (const float*)(A.ws + WS_GATE);
            const int tok = hsh(s) % T, h = hsh(s + 1) & 7;
            float* sc = sh + tid * 320;
            for (int p = 0; p < 2; ++p) for (int n = 0; n < NKEY; ++n) { float a = 0.f;
                for (int d = 0; d < 128; ++d) a += bfv(q, (size_t)tok * D + h * 256 + p * 128 + d) * A.in[I_SUBK][((size_t)((h * 2 + p) * NKEY + n)) * 128 + d];
                sc[p * 128 + n] = a; }
            for (int p = 0; p < 2; ++p) { float prev = 1e30f; for (int it = 0; it < 16; ++it) { float best = -1e30f; int bi = 0;
                for (int n = 0; n < NKEY; ++n) { const float v = sc[p * 128 + n]; if (v < prev && v > best) { best = v; bi = n; } }
                sc[256 + p * 16 + it] = best; sc[288 + p * 16 + it] = (float)bi; prev = best; } }
            float prev = 1e30f, esum = 0.f, cmax = 0.f; int miss = 0; float gerr = 0.f;
            { float pv = 1e30f; for (int it = 0; it < 16; ++it) { float best = -1e30f;
                for (int c = 0; c < 256; ++c) { const float v = sc[256 + (c >> 4)] + sc[272 + (c & 15)]; if (v < pv && v > best) best = v; }
                if (it == 0) cmax = best; esum += expf(best - cmax); pv = best; } }
            for (int it = 0; it < 16; ++it) { float best = -1e30f; int bc = 0;
                for (int c = 0; c < 256; ++c) { const float v = sc[256 + (c >> 4)] + sc[272 + (c & 15)]; if (v < prev && v > best) { best = v; bc = c; } }
                prev = best;
                const int eidx = (int)sc[288 + (bc >> 4)] * NKEY + (int)sc[304 + (bc & 15)]; const float g = expf(best - cmax) / esum; bool found = false;
                for (int m = 0; m < 16; ++m) if (idx[(size_t)tok * KSEL + h * 16 + m] == eidx) { found = true; gerr = fmaxf(gerr, relerr(gate[(size_t)tok * KSEL + h * 16 + m], g, 0.02f)); }
                if (!found) ++miss; }
            e = fmaxf((float)miss / 16.0f, gerr);
        }
    } else if (stage == 11) {
        const bf16* h2 = (const bf16*)(A.ws + WS_RA); const bf16* y1 = (const bf16*)(A.ws + WS_Y1); const int* idx = (const int*)(A.ws + WS_IDX); const float* gate = (const float*)(A.ws + WS_GATE); const float* cfin = (const float*)(A.ws + WS_CFIN);
        const int tok = hsh(blockIdx.x * 977u + 5u) % T, b = tok >> 13;
        { const int ex = idx[(size_t)tok * KSEL + tid]; float a = 0.f;
          if ((unsigned)ex < (unsigned)NEXP) { for (int d = 0; d < D; ++d) a += bfv(h2, (size_t)tok * D + d) * A.in[I_PU][(size_t)ex * D + d]; } else a = 1e30f;
          const float ge = 0.5f * a * (1.0f + tanhf(0.7978845608f * (a + 0.044715f * a * a * a)));
          sh[tid] = gate[(size_t)tok * KSEL + tid] * ge; sh[128 + tid] = __builtin_bit_cast(float, ex); }
        __syncthreads();
        float s2 = 0.f, s1 = 0.f;
        for (int cc = 0; cc < 16; ++cc) { const int col = cc * 128 + tid; float a = 0.f;
            for (int k = 0; k < KSEL; ++k) { const int ex = __builtin_bit_cast(int, sh[128 + k]); if ((unsigned)ex < (unsigned)NEXP) a += sh[k] * A.in[I_PV][(size_t)ex * D + col]; }
            sh[512 + cc * 128 + tid] = a; s2 += a * a; const float y = bfv(y1, (size_t)tok * D + col); s1 += y * y; }
        __syncthreads(); sh[256 + tid] = s2; sh[384 + tid] = s1; __syncthreads();
        float t2 = 0.f, t1 = 0.f; for (int k = 0; k < 128; ++k) { t2 += sh[256 + k]; t1 += sh[384 + k]; }
        const float r2 = rsqrtf(t2 / D + EPS), r1 = rsqrtf(t1 / D + EPS);
        float en = 0.f, ed = 0.f;
        for (int cc = 0; cc < 16; ++cc) { const int col = cc * 128 + tid;
            const float pterm = cfin[(b * 2 + 1) * D + col] * sh[512 + cc * 128 + tid] * r2;
            const float ref = A.in[I_X][(size_t)tok * D + col] + (OUT_MODE != 2 ? cfin[(b * 2) * D + col] * bfv(y1, (size_t)tok * D + col) * r1 : 0.f) + (OUT_MODE != 1 ? pterm : 0.f);
            const float d = A.out[(size_t)tok * D + col] - ref; en += d * d; ed += pterm * pterm; }
        __syncthreads(); sh[256 + tid] = en; sh[384 + tid] = ed; __syncthreads();
        float ten = 0.f, ted = 0.f; for (int k = 0; k < 128; ++k) { ten += sh[256 + k]; ted += sh[384 + k]; }
        e = ten / (ted + 1e-12f); if (!(e == e)) e = 1e30f;
    }
    chk_put(ctl, stage, e);
}
__global__ void chk_encode(Args A, int what) {
    const unsigned* ctl = (const unsigned*)(A.ws + WS_CTL);
    if (threadIdx.x == 0 && blockIdx.x == 0) {
        if (what < 0) {
            const float thr[13] = {0.03f, 0.03f, 0.03f, 0.03f, 0.06f, 0.01f, 0.04f, 0.03f, 0.03f, 0.03f, 0.2f, 0.01f, 0.06f};
            for (int st = 0; st < 13; ++st) { const float e = __builtin_bit_cast(float, ctl[CW_CHK + st]); if (!(e <= thr[st])) { A.out[0] = 4000.0f * (float)(1 << st); break; } }
        } else {
            const float e = fminf(__builtin_bit_cast(float, ctl[CW_CHK + what]), 1e6f); A.out[0] = 4000.0f * sqrtf(1e6f * e);
        }
    }
}
#endif

__global__ void __launch_bounds__(NTHR, 2) fwd_kernel(Args args) {
    extern __shared__ __attribute__((aligned(16))) unsigned char lds_raw[];
    LAS unsigned char* lds = (LAS unsigned char*)lds_raw;
    const int tid = threadIdx.x, lane = tid & 63, wave = __builtin_amdgcn_readfirstlane(tid >> 6), bid = blockIdx.x, G = gridDim.x;
    for (int u = tid; u < (LDS_BYTES - LDSCTL_OFF) / 4; u += NTHR) ((LAS unsigned*)(lds + LDSCTL_OFF))[u] = 0u;
    __syncthreads();
    unsigned* ctl = (unsigned*)(args.ws + WS_CTL);
    XcdBarrier bar; bar.bar = ctl + CW_BAR + args.li * XCD_BAR_WORDS; bar.x = 0; bar.st = nullptr;
    if (MK_N_LAUNCHES != N_PHASES) bar = xcd_barrier_post(ctl + CW_BAR + args.li * XCD_BAR_WORDS, (volatile LAS unsigned*)(lds + MISC_OFF) + 8);
    const int lo = args.ph_lo, hi = args.ph_hi;
#define IN(k) (lo <= (k) && (k) < hi)
#define SEAM(k) do { if (IN(k) && IN((k) + 1)) xcd_barrier(bar); } while (0)
#define PHON(k) ((PH_MASK >> (k)) & 1)
    if (PHON(0) && IN(0)) { phase_p0(args, lds, tid, lane, wave, bid, G); }
    SEAM(0);
    if (PHON(1) && IN(1)) { phase_p1(args, tid, lane, wave, bid, G); }
    SEAM(1);
    if (PHON(2) && IN(2)) {
        pg8::Gemm g{(const bf16*)(args.ws + WS_RA), (const bf16*)(args.ws + WS_BT1), T, IN_COLS, D}; pg8::StaticOrder S; S.init(T, IN_COLS, G, bid);
        pg8::EpiBf16<0> E{(bf16*)(args.ws + WS_PROJ), IN_COLS, nullptr, 0, 0, 1.f};
        pg8::gemm_phase<pg8::EpiBf16<0>, pg8::StaticOrder, PG8_ALIGN, PG8_SP2>(lds + RING_OFF, g, S, E);
    }
    SEAM(2);
    if (PHON(3) && IN(3)) { phase_m1a(args, lds, tid, lane, wave, bid, G); }
    if (PHON(4) && IN(3)) { phase_m1b(args, lds, tid, lane, wave, bid, G); }
    SEAM(3);
    if (PHON(5) && IN(4)) { phase_m3(args, lds, tid, lane, wave, bid, G); }
    SEAM(4);
    if (PHON(6) && IN(5)) {
        pg8::Gemm g{(const bf16*)(args.ws + WS_RA), (const bf16*)(args.ws + WS_BT2), T, D, D}; pg8::StaticOrder S; S.init(T, D, G, bid);
        pg8::EpiBf16<0> E{(bf16*)(args.ws + WS_Y1), D, nullptr, 0, 0, 1.f};
        pg8::gemm_phase<pg8::EpiBf16<0>, pg8::StaticOrder, PG8_ALIGN, PG8_SP2>(lds + RING_OFF, g, S, E);
    }
    SEAM(5);
    if (PHON(7) && IN(6)) { phase_e2(args, tid, lane, wave, bid, G); }
    SEAM(6);
    if (PHON(8) && IN(7)) {
        pg8::Gemm g{(const bf16*)(args.ws + WS_RA), (const bf16*)(args.ws + WS_BT3), T, D, D}; pg8::StaticOrder S; S.init(T, D, G, bid);
        pg8::EpiBf16<0> E{(bf16*)(args.ws + WS_Q), D, nullptr, 0, 0, 1.f};
        pg8::gemm_phase<pg8::EpiBf16<0>, pg8::StaticOrder, PG8_ALIGN, PG8_SP2>(lds + RING_OFF, g, S, E);
    }
    SEAM(7);
    if (PHON(9) && IN(8)) { phase_s(args, lds, tid, lane, wave, bid, G); }
    SEAM(8);
    if (PHON(10) && IN(9)) { phase_pu(args, lane, wave, bid, G); }
    SEAM(9);
    if (PHON(11) && IN(10)) { phase_w(args, lane, wave, bid, G); }
    SEAM(10);
    if (PHON(12) && IN(11)) { phase_pv(args, lane, wave, bid, G); }
    SEAM(11);
    if (PHON(13) && IN(12)) { phase_f(args, lane, wave, bid, G); }
#undef IN
#undef SEAM
}

extern "C" void kernel_launch(void* const* d_in, const int* in_sizes, int n_in, void* d_out, int out_size, void* d_ws, size_t ws_size, hipStream_t stream) {
    static int grid = 0;
    if (grid == 0) {
        if (n_in != 25 || in_sizes[0] != T * D || out_size != T * D || ws_size < WS_END) {
            fprintf(stderr, "kernel_launch: built for 25 inputs, x/out of %d floats, >= %zu bytes of workspace; got n_in %d, in0 %d, out %d, ws %zu; nothing launched\n", T * D, (size_t)WS_END, n_in, n_in > 0 ? in_sizes[0] : -1, out_size, ws_size);
            grid = -1; return; }
        int dev = 0, cus = 0, per_cu = 0;
        if (hipGetDevice(&dev) != hipSuccess || hipDeviceGetAttribute(&cus, hipDeviceAttributeMultiprocessorCount, dev) != hipSuccess) { fprintf(stderr, "kernel_launch: device query failed\n"); grid = -1; return; }
        if (hipFuncSetAttribute((const void*)fwd_kernel, hipFuncAttributeMaxDynamicSharedMemorySize, LDS_BYTES) != hipSuccess) { fprintf(stderr, "kernel_launch: hipFuncSetAttribute failed\n"); grid = -1; return; }
        if (hipOccupancyMaxActiveBlocksPerMultiprocessor(&per_cu, (const void*)fwd_kernel, NTHR, LDS_BYTES) != hipSuccess || per_cu < 1)
            fprintf(stderr, "kernel_launch: note: occupancy query reports %d workgroups per CU\n", per_cu);
        (void)hipGetLastError();
        grid = cus;
    }
    if (grid < 0) return;
    if (hipMemsetAsync((char*)d_ws + WS_CTL, 0, CTL_ZERO_BYTES, stream) != hipSuccess) { fprintf(stderr, "kernel_launch: memset failed\n"); return; }
    Args a{};
    for (int i = 0; i < 25; ++i) a.in[i] = (const float*)d_in[i];
    a.out = (float*)d_out; a.ws = (unsigned char*)d_ws;
#if defined(MK_TIME_REP)
    const int cuts[3][2] = {{0, MK_TIME_REP + 1}, {MK_TIME_REP, MK_TIME_REP + 1}, {MK_TIME_REP + 1, N_PHASES}};
    for (int li = 0; li < 3; ++li) {
        a.ph_lo = cuts[li][0]; a.ph_hi = cuts[li][1]; a.li = li;
        if (a.ph_lo < a.ph_hi) hipLaunchKernelGGL(fwd_kernel, dim3(grid), dim3(NTHR), LDS_BYTES, stream, a);
    }
#else
    for (int li = 0; li < MK_N_LAUNCHES; ++li) {
        if (MK_N_LAUNCHES == 1) { a.ph_lo = 0; a.ph_hi = N_PHASES; } else { a.ph_lo = li; a.ph_hi = li + 1; }
        a.li = 0;
        hipLaunchKernelGGL(fwd_kernel, dim3(grid), dim3(NTHR), LDS_BYTES, stream, a);
        const hipError_t le = hipPeekAtLastError();
        if (le != hipSuccess) { fprintf(stderr, "kernel_launch: launch %d failed: %s\n", li, hipGetErrorName(le)); break; }
#if defined(MK_CHECKS)
        { const int chk_of_phase[N_PHASES] = {0, 1, 2, 12, 6, 7, 8, 9, 10, 5, 5, 5, 11}; hipLaunchKernelGGL(chk_kernel, dim3(4), dim3(128), 0, stream, a, chk_of_phase[li]); }
#endif
    }
#endif
#if defined(MK_CHECKS)
    hipLaunchKernelGGL(chk_encode, dim3(1), dim3(64), 0, stream, a, MK_CHECKS);
#endif
}
```

```cpp
#include <hip/hip_runtime.h>
#include <cstdio>
#include <cstdint>
#include <cmath>
namespace pg8 {
#define PG8_LAS __attribute__((address_space(3)))
typedef unsigned short bf16_t;
typedef short bf16x8 __attribute__((ext_vector_type(8)));
typedef float f32x4 __attribute__((ext_vector_type(4)));
typedef unsigned u32x4 __attribute__((ext_vector_type(4)));
constexpr int BM = 256, BK = 64, HALF = 128, HTB = HALF * BK * 2  , STAGE_BYTES = 8 * HTB, NXCD = 8, WGM = 8;

__host__ __device__ __forceinline__ int lds_byte(int r, int c) { const int st = (r >> 4) * 2 + (c >> 5), rr = r & 15, cc = c & 31, ob = rr * 64 + cc * 2; return st * 1024 + (ob ^ (((ob >> 9) & 1) << 5)); }
__host__ __device__ __forceinline__ void stage_rc(int b, int& R, int& C) { const int st = b / 1024, sb = b % 1024, swz = sb ^ (((sb >> 9) & 1) << 5); R = (st >> 1) * 16 + swz / 64; C = (st & 1) * 32 + (swz % 64) / 2; }
__host__ __device__ __forceinline__ int perm32(int rho) { const int n = rho >> 4, i = rho & 15; return 8 * (i >> 2) + 4 * n + (i & 3); }

struct Unit { int pm, pn; };
struct Gemm { const bf16_t* A; const bf16_t* Bt; int M, N, K; };

struct StaticOrder {
    int nM, nN, nwg, G, c;
    __host__ __device__ void init(int M, int N, int G_, int c_) { nM = M / BM; nN = N / BM; nwg = nM * nN; G = G_; c = c_; }
    __host__ __device__ bool next(int i, Unit& u) const {
        const long L = (long)i * G + c; if (L >= nwg) return false;
        int wgid = (int)L; { const int q = nwg / NXCD, r = nwg % NXCD, xcd = wgid % NXCD, off = wgid / NXCD; wgid = (xcd < r ? xcd * (q + 1) : r * (q + 1) + (xcd - r) * q) + off; }
        const int nig = WGM * nN, gid = wgid / nig, fm = gid * WGM, gsz = (nM - fm) < WGM ? (nM - fm) : WGM;
        u.pm = fm + ((wgid % nig) % gsz); u.pn = (wgid % nig) / gsz; return true;
    }
    __device__ __forceinline__ void a_ready(const Unit&) const {}
    __device__ __forceinline__ void done(const Unit&) const {}
};

__device__ __forceinline__ unsigned cvt_pk_bf16(float lo, float hi) { unsigned r; asm volatile("v_cvt_pk_bf16_f32 %0, %1, %2" : "=v"(r) : "v"(lo), "v"(hi)); return r; }
typedef float f32x2 __attribute__((ext_vector_type(2)));
__device__ __forceinline__ f32x2 gelu_pk(f32x2 v) {
    const f32x2 av = __builtin_elementwise_abs(v), d = av * 0.2316418882f + 1.0f;
    f32x2 t; t.x = __builtin_amdgcn_rcpf(d.x); t.y = __builtin_amdgcn_rcpf(d.y);
    f32x2 q = t * 0.5307027145f + (-0.7265760135f); q = q * t + 0.7107068705f; q = q * t + (-0.142248368f); q = q * t + 0.127414796f; q = q * t;
    const f32x2 s = (v * v) * (-0.72134752044f);
    f32x2 e; e.x = __builtin_amdgcn_exp2f(s.x); e.y = __builtin_amdgcn_exp2f(s.y);
    const f32x2 m = v * (q * e), r = v - m;
    f32x2 o; o.x = v.x < 0.f ? m.x : r.x; o.y = v.y < 0.f ? m.y : r.y; return o;
}

template <int ACT  > struct EpiBf16 {
    static constexpr bool PERM = true, AFTER_DRAIN = false; static_assert(ACT == 0 || ACT == 1, "EpiBf16: ACT is 0 (none) or 1 (gelu_pk)");
    bf16_t* O; int ldc; const float* bias; int split_cols; size_t split_stride; float scale0;
    __device__ __forceinline__ void operator()(const f32x4 (&acc)[2][2][4][2], const Unit& u, int wr, int wc, int fr, int fq) const {
        const int row0 = u.pm * BM + wr * 64 + fr; int colt = u.pn * BM; bf16_t* base = O;
        float sc = 1.f; if (split_cols) { const int t = colt / split_cols; base += (size_t)t * split_stride; colt -= t * split_cols; if (t == 0) sc = scale0; }
        const int col0 = colt + wc * 32 + 8 * fq, bcol0 = u.pn * BM + wc * 32 + 8 * fq;
        f32x4 bv[2][2];
#pragma unroll
        for (int bj = 0; bj < 2; ++bj)
#pragma unroll
            for (int n = 0; n < 2; ++n) bv[bj][n] = bias ? *(const f32x4*)(bias + bcol0 + bj * HALF + 4 * n) : (f32x4){0.f, 0.f, 0.f, 0.f};
#pragma unroll
        for (int ai = 0; ai < 2; ++ai)
#pragma unroll
            for (int m = 0; m < 4; ++m) { bf16_t* rowp = base + (size_t)(row0 + ai * HALF + m * 16) * ldc + col0;
#pragma unroll
                for (int bj = 0; bj < 2; ++bj) { f32x4 v0 = acc[ai][bj][m][0] + bv[bj][0], v1 = acc[ai][bj][m][1] + bv[bj][1];
                    if (ACT == 1) { f32x2 a = gelu_pk((f32x2){v0[0], v0[1]}), b = gelu_pk((f32x2){v0[2], v0[3]}), c = gelu_pk((f32x2){v1[0], v1[1]}), d = gelu_pk((f32x2){v1[2], v1[3]});
                        v0 = (f32x4){a.x, a.y, b.x, b.y}; v1 = (f32x4){c.x, c.y, d.x, d.y}; }
                    v0 = v0 * sc; v1 = v1 * sc; u32x4 w; w.x = cvt_pk_bf16(v0[0], v0[1]); w.y = cvt_pk_bf16(v0[2], v0[3]); w.z = cvt_pk_bf16(v1[0], v1[1]); w.w = cvt_pk_bf16(v1[2], v1[3]);
                    *(u32x4*)(rowp + bj * HALF) = w; } }
    }
};
template <class Epi, class Sched, bool ALIGN_EPI = false, bool SP2 = false>
__device__ __forceinline__ void gemm_phase(PG8_LAS unsigned char* lds, const Gemm g, const Sched& S, const Epi& E) {
    const int tid = threadIdx.x, wid = __builtin_amdgcn_readfirstlane(tid >> 6), lane = tid & 63, wr = wid >> 2, wc = wid & 3, fr = lane & 15, fq = lane >> 4;
    const int K = g.K, nt = K / BK;
    unsigned voffA[2], voffB[2];
#pragma unroll
    for (int i = 0; i < 2; ++i) { int R, C; stage_rc(tid * 16 + i * 8192, R, C); const int Rb = Epi::PERM ? ((R & ~31) + perm32(R & 31)) : R;
        voffA[i] = (unsigned)(R * K + C) * 2u; voffB[i] = (unsigned)(Rb * K + C) * 2u; }
    const size_t kstep = (size_t)(BK * 2);
    const size_t hstep = (size_t)HALF * K * 2;
    const size_t tstep = 2 * hstep;
    const unsigned ldsw = (unsigned)wid * 1024u;
    const int aoff = lds_byte(wr * 64 + fr, fq * 8), boff = lds_byte(wc * 32 + fr, fq * 8);
#define PG8_SA(b, h) (((b) * 2 + (h)) * HTB)
#define PG8_SB(b, h) ((4 + (b) * 2 + (h)) * HTB)
#define PG8_STAGE(bufoff, gbase, voff) do { _Pragma("unroll") for (int _i = 0; _i < 2; ++_i) \
        __builtin_amdgcn_global_load_lds((const unsigned*)((const char*)(gbase) + (voff)[_i]), (PG8_LAS unsigned*)(lds + (bufoff) + ldsw + _i * 8192), 16, 0, 0); } while (0)
#define PG8_LDA(dst, b, h) do { _Pragma("unroll") for (int m = 0; m < 4; ++m) _Pragma("unroll") for (int k = 0; k < 2; ++k) dst[m][k] = *(const PG8_LAS bf16x8*)(lds + PG8_SA(b, h) + aoff + m * 2048 + k * 1024); } while (0)
#define PG8_LDB(dst, b, h) do { _Pragma("unroll") for (int n = 0; n < 2; ++n) _Pragma("unroll") for (int k = 0; k < 2; ++k) dst[n][k] = *(const PG8_LAS bf16x8*)(lds + PG8_SB(b, h) + boff + n * 2048 + k * 1024); } while (0)
#define PG8_MMA(ai, bj, At, Bt) do { __builtin_amdgcn_s_setprio(1); _Pragma("unroll") for (int m = 0; m < 4; ++m) _Pragma("unroll") for (int n = 0; n < 2; ++n) _Pragma("unroll") for (int k = 0; k < 2; ++k) \
        acc[ai][bj][m][n] = __builtin_amdgcn_mfma_f32_16x16x32_bf16(Bt[n][k], At[m][k], acc[ai][bj][m][n], 0, 0, 0); __builtin_amdgcn_s_setprio(0); } while (0)
#define PG8_WAIT_V(n) asm volatile("s_waitcnt vmcnt(" #n ")" ::: "memory")
#define PG8_WAIT_L(n) asm volatile("s_waitcnt lgkmcnt(" #n ")" ::: "memory")
#define PG8_BAR __builtin_amdgcn_s_barrier()
#define PG8_SCHED __builtin_amdgcn_sched_barrier(0)
    Unit cur, nxt; int ui = 0;
    if (!S.next(0, cur)) return;
    f32x4 acc[2][2][4][2];
#pragma unroll
    for (int a = 0; a < 2; ++a)
#pragma unroll
        for (int b = 0; b < 2; ++b)
#pragma unroll
            for (int m = 0; m < 4; ++m)
#pragma unroll
                for (int n = 0; n < 2; ++n) acc[a][b][m][n] = (f32x4){0.f, 0.f, 0.f, 0.f};
    bf16x8 At[4][2], B0[2][2], B1[2][2];
    const char* cA = (const char*)g.A + (size_t)cur.pm * tstep; const char* cB = (const char*)g.Bt + (size_t)cur.pn * tstep;
    S.a_ready(cur);
    if constexpr (SP2) {
        PG8_STAGE(PG8_SB(0, 0), cB, voffB); PG8_STAGE(PG8_SB(0, 1), cB + hstep, voffB); PG8_STAGE(PG8_SA(0, 0), cA, voffA); PG8_STAGE(PG8_SA(0, 1), cA + hstep, voffA);
        if (wr == 1) PG8_BAR;
        PG8_WAIT_V(2); PG8_BAR;
        PG8_STAGE(PG8_SB(1, 0), cB + kstep, voffB); PG8_STAGE(PG8_SA(1, 0), cA + kstep, voffA); PG8_STAGE(PG8_SB(1, 1), cB + hstep + kstep, voffB);
        PG8_WAIT_V(6); PG8_BAR;
    } else {
        PG8_STAGE(PG8_SB(0, 0), cB, voffB); PG8_STAGE(PG8_SA(0, 0), cA, voffA); PG8_STAGE(PG8_SB(0, 1), cB + hstep, voffB); PG8_STAGE(PG8_SA(0, 1), cA + hstep, voffA);
        if (wr == 1) PG8_BAR;
        PG8_WAIT_V(4); PG8_BAR;
        PG8_STAGE(PG8_SB(1, 0), cB + kstep, voffB); PG8_STAGE(PG8_SA(1, 0), cA + kstep, voffA); PG8_STAGE(PG8_SB(1, 1), cB + hstep + kstep, voffB);
        PG8_WAIT_V(6); PG8_BAR;
    }
    for (;;) {
        const bool has_next = S.next(ui + 1, nxt);
        const char* nA = has_next ? (const char*)g.A + (size_t)nxt.pm * tstep : cA; const char* nB = has_next ? (const char*)g.Bt + (size_t)nxt.pn * tstep : cB;
        for (int t = 0; t < nt; t += 2) {
            const bool last = (t == nt - 2);
            const char* a1 = cA + (size_t)(t + 1) * kstep;
            const char* a2 = last ? nA : cA + (size_t)(t + 2) * kstep; const char* b2 = last ? nB : cB + (size_t)(t + 2) * kstep;
            const char* a3 = a2 + kstep; const char* b3 = b2 + kstep;
            if (last && has_next) S.a_ready(nxt);
            if constexpr (SP2) {
            PG8_LDB(B0, 0, 0); PG8_LDB(B1, 0, 1); PG8_SCHED; PG8_LDA(At, 0, 0); PG8_STAGE(PG8_SA(1, 1), a1 + hstep, voffA);
            PG8_WAIT_V(8); PG8_WAIT_L(0); PG8_BAR; PG8_MMA(0, 0, At, B0); PG8_MMA(0, 1, At, B1); PG8_BAR; PG8_SCHED;
            PG8_LDA(At, 0, 1); PG8_STAGE(PG8_SB(0, 0), b2, voffB); PG8_STAGE(PG8_SB(0, 1), b2 + hstep, voffB); PG8_STAGE(PG8_SA(0, 0), a2, voffA);
            PG8_WAIT_V(8); PG8_WAIT_L(0); PG8_BAR; PG8_MMA(1, 0, At, B0); PG8_MMA(1, 1, At, B1); PG8_BAR; PG8_SCHED;
            PG8_LDB(B0, 1, 0); PG8_LDB(B1, 1, 1); PG8_SCHED; PG8_LDA(At, 1, 0); PG8_STAGE(PG8_SA(0, 1), a2 + hstep, voffA);
            PG8_WAIT_V(8); PG8_WAIT_L(0); PG8_BAR; PG8_MMA(0, 0, At, B0); PG8_MMA(0, 1, At, B1); PG8_BAR; PG8_SCHED;
            PG8_LDA(At, 1, 1); PG8_STAGE(PG8_SB(1, 0), b3, voffB); PG8_STAGE(PG8_SB(1, 1), b3 + hstep, voffB); PG8_STAGE(PG8_SA(1, 0), a3, voffA);
            PG8_WAIT_V(8); PG8_WAIT_L(0); PG8_BAR; PG8_MMA(1, 0, At, B0); PG8_MMA(1, 1, At, B1); PG8_BAR; PG8_SCHED;
            } else {
            PG8_LDB(B0, 0, 0); PG8_SCHED; PG8_LDA(At, 0, 0); PG8_STAGE(PG8_SA(1, 1), a1 + hstep, voffA);
            PG8_WAIT_L(8); PG8_BAR; PG8_WAIT_L(0); PG8_MMA(0, 0, At, B0); PG8_BAR; PG8_SCHED;
            PG8_LDB(B1, 0, 1); PG8_STAGE(PG8_SB(0, 0), b2, voffB);
            PG8_BAR; PG8_WAIT_L(0); PG8_MMA(0, 1, At, B1); PG8_BAR;
            PG8_LDA(At, 0, 1); PG8_STAGE(PG8_SA(0, 0), a2, voffA);
            PG8_BAR; PG8_WAIT_L(0); PG8_MMA(1, 0, At, B0); PG8_BAR; PG8_SCHED;
            PG8_STAGE(PG8_SB(0, 1), b2 + hstep, voffB);
            PG8_WAIT_V(6); PG8_BAR; PG8_MMA(1, 1, At, B1); PG8_BAR;
            PG8_LDB(B0, 1, 0); PG8_SCHED; PG8_LDA(At, 1, 0); PG8_STAGE(PG8_SA(0, 1), a2 + hstep, voffA);
            PG8_WAIT_L(8); PG8_BAR; PG8_WAIT_L(0); PG8_MMA(0, 0, At, B0); PG8_BAR; PG8_SCHED;
            PG8_LDB(B1, 1, 1); PG8_STAGE(PG8_SB(1, 0), b3, voffB);
            PG8_BAR; PG8_WAIT_L(0); PG8_MMA(0, 1, At, B1); PG8_BAR;
            PG8_LDA(At, 1, 1); PG8_STAGE(PG8_SA(1, 0), a3, voffA);
            PG8_BAR; PG8_WAIT_L(0); PG8_MMA(1, 0, At, B0); PG8_BAR; PG8_SCHED;
            PG8_STAGE(PG8_SB(1, 1), b3 + hstep, voffB);
            PG8_WAIT_V(6); PG8_BAR; PG8_MMA(1, 1, At, B1); PG8_BAR;
            }
        }
        if constexpr (ALIGN_EPI) { if (wr == 0) PG8_BAR; }
        if constexpr (!Epi::AFTER_DRAIN) { E(acc, cur, wr, wc, fr, fq); S.done(cur); }
        if (!has_next) break;
#pragma unroll
        for (int a = 0; a < 2; ++a)
#pragma unroll
            for (int b = 0; b < 2; ++b)
#pragma unroll
                for (int m = 0; m < 4; ++m)
#pragma unroll
                    for (int n = 0; n < 2; ++n) acc[a][b][m][n] = (f32x4){0.f, 0.f, 0.f, 0.f};
        cur = nxt; cA = nA; cB = nB; ++ui;
        if constexpr (ALIGN_EPI) { if (wr == 1) PG8_BAR; }
    }
    PG8_WAIT_V(0);
    if constexpr (!ALIGN_EPI) { if (wr == 0) PG8_BAR; }
    PG8_BAR;
    if constexpr (Epi::AFTER_DRAIN) { E.fused(acc, cur, wr, wc, fr, fq, lds, wid, lane); S.done(cur); }
#undef PG8_SA
#undef PG8_SB
#undef PG8_STAGE
#undef PG8_LDA
#undef PG8_LDB
#undef PG8_MMA
#undef PG8_WAIT_V
#undef PG8_WAIT_L
#undef PG8_BAR
#undef PG8_SCHED
}
}
#ifndef PG8_SP2
#define PG8_SP2 true
#endif
#ifndef PG8_ALIGN
#define PG8_ALIGN true
#endif
#ifndef OUT_MODE
#define OUT_MODE 0
#endif
#ifndef REP_MASK
#define REP_MASK 0
#endif
#ifndef S_CONV
#define S_CONV 1
#endif
#ifndef M3_RW
#define M3_RW 2
#endif
#ifndef PU_RSHIFT
#define PU_RSHIFT 11
#endif
#ifndef PU_NB
#define PU_NB 6
#endif
#ifndef PVQ_RB
#define PVQ_RB 16
#endif
#ifndef PUQ_RB
#define PUQ_RB 16
#endif
#ifndef PE_SORT
#define PE_SORT 1
#endif
#ifndef PH_MASK
#define PH_MASK 0xFFFFF
#endif
#ifndef MK_N_LAUNCHES
#define MK_N_LAUNCHES 1
#endif

constexpr int NWAVES = 8, NTHR = NWAVES * 64;
constexpr int BATCH = 2, SEQ = 8192, D = 2048, T = BATCH * SEQ;
constexpr int LRU_W = 1024, CONF_W = 1024, IN_COLS = 4096, LRU_HD = 128;
constexpr int NH = 8, NKEY = 128, TOPK = 16, NEXP = NKEY * NKEY, KSEL = NH * TOPK;
constexpr int NMOD = 6 * D;
constexpr int CHUNK = 64, NCHUNK = SEQ / CHUNK;
constexpr int CONF_K = 31;
constexpr float EPS = 1e-6f;
constexpr int N_PHASES = 13;

constexpr size_t MiB = 1u << 20;
constexpr size_t WS_CTL = 0, CTL_ZERO_BYTES = 64 * 1024;
constexpr size_t WS_MODP = 1 * MiB;
constexpr size_t WS_CFIN = 2 * MiB;
constexpr size_t WS_CARRY = 3 * MiB;
constexpr size_t WS_AGG = 4 * MiB;
constexpr size_t WS_WG = 6 * MiB;
constexpr size_t WS_SUBK = 7 * MiB;
constexpr size_t WS_BT1 = 8 * MiB;
constexpr size_t WS_BT2 = 24 * MiB;
constexpr size_t WS_BT3 = 32 * MiB;
constexpr size_t WS_IDX = 40 * MiB;
constexpr size_t WS_GATE = 48 * MiB;
constexpr size_t WS_USC = 56 * MiB;
constexpr size_t WS_VSC = 57 * MiB;
constexpr size_t WS_RA = 64 * MiB;
constexpr size_t WS_Y1 = 128 * MiB;
constexpr size_t WS_PROJ = 192 * MiB;
constexpr size_t WS_Q = 192 * MiB;
constexpr size_t WS_UB = 256 * MiB;
constexpr size_t WS_XL = 320 * MiB;
constexpr size_t WS_ZC = 352 * MiB;
constexpr size_t WS_Y2 = 384 * MiB;
constexpr size_t WS_SSQ = 58 * MiB;
constexpr size_t WS_HLOC = 384 * MiB;
constexpr size_t WS_PC = 416 * MiB;
constexpr size_t WS_VB = 320 * MiB;
constexpr size_t WS_ACTP = 192 * MiB;
constexpr size_t WS_ACT = 448 * MiB;
constexpr size_t WS_H2Q = 456 * MiB;
constexpr size_t WS_HSC = 488 * MiB;
constexpr size_t WS_END = 489 * MiB;
constexpr int CW_TMO = 0, CW_BAR = 4096;

constexpr int RING_OFF = 0, RING_BYTES = 131072;
constexpr int LDSCTL_OFF = 146432, MISC_OFF = LDSCTL_OFF + 320;
constexpr int LDS_BYTES = 147456;

#define GAS __attribute__((address_space(1)))
#define LAS __attribute__((address_space(3)))
typedef unsigned short bf16;
typedef unsigned v4u __attribute__((ext_vector_type(4)));
typedef unsigned v2u __attribute__((ext_vector_type(2)));
typedef float f32x4 __attribute__((ext_vector_type(4)));
typedef float f32x16 __attribute__((ext_vector_type(16)));
typedef float f32x2 __attribute__((ext_vector_type(2)));
typedef short bf16x8 __attribute__((ext_vector_type(8)));
typedef __bf16 bfp2 __attribute__((ext_vector_type(2)));
typedef GAS unsigned gu32;
#define RLX_AGENT __ATOMIC_RELAXED, __HIP_MEMORY_SCOPE_AGENT
#define LDS_WAIT() asm volatile("s_waitcnt lgkmcnt(0)" ::: "memory")
#define VM_WAIT() asm volatile("s_waitcnt vmcnt(0)" ::: "memory")
typedef __bf16 bf16v2 __attribute__((ext_vector_type(2)));
__device__ __forceinline__ unsigned pk2(float lo, float hi) { bf16v2 v; v.x = (__bf16)lo; v.y = (__bf16)hi; return __builtin_bit_cast(unsigned, v); }
__device__ __forceinline__ unsigned f2bf(float f) { return pk2(f, 0.f) & 0xffffu; }
__device__ __forceinline__ float bflo(unsigned u) { return __builtin_bit_cast(float, u << 16); }
__device__ __forceinline__ float bfhi(unsigned u) { return __builtin_bit_cast(float, u & 0xffff0000u); }
__device__ __forceinline__ float wave_sum(float v) {
#pragma unroll
    for (int o = 1; o < 64; o <<= 1) v += __shfl_xor(v, o);
    return v;
}
__device__ __forceinline__ float dpp_sum63(float v) {
    v += __builtin_bit_cast(float, __builtin_amdgcn_update_dpp(0, __builtin_bit_cast(int, v), 0xB1, 0xF, 0xF, false));
    v += __builtin_bit_cast(float, __builtin_amdgcn_update_dpp(0, __builtin_bit_cast(int, v), 0x4E, 0xF, 0xF, false));
    v += __builtin_bit_cast(float, __builtin_amdgcn_update_dpp(0, __builtin_bit_cast(int, v), 0x141, 0xF, 0xF, false));
    v += __builtin_bit_cast(float, __builtin_amdgcn_update_dpp(0, __builtin_bit_cast(int, v), 0x140, 0xF, 0xF, false));
    v += __builtin_bit_cast(float, __builtin_amdgcn_update_dpp(0, __builtin_bit_cast(int, v), 0x142, 0xA, 0xF, false));
    v += __builtin_bit_cast(float, __builtin_amdgcn_update_dpp(0, __builtin_bit_cast(int, v), 0x143, 0xC, 0xF, false));
    return v;
}

__device__ __forceinline__ float sigmoidf_(float x) { return __builtin_amdgcn_rcpf(1.0f + __expf(-x)); }
__device__ __forceinline__ float gelu_tanh(float x) { return x * sigmoidf_(1.5957691216057308f * (x + 0.044715f * x * x * x)); }
__device__ __forceinline__ float rdlane(float v, int l) { return __builtin_bit_cast(float, __builtin_amdgcn_readlane(__builtin_bit_cast(int, v), l)); }
__device__ __forceinline__ float wave_total(float v) { return rdlane(dpp_sum63(v), 63); }

#define XB_TMO      128
#define XB_XCNT(j)  (256  + 64 * (j))
#define XB_XSUB(j)  (1280 + 64 * (j))
#define XB_XGEN(j)  (2304 + 64 * (j))
#define XB_TOP      3328
#define XB_TOPGEN   3392
#define XCD_BAR_WORDS 3456
#define XB_SPIN_CAP (1u << 18)

__device__ __forceinline__ unsigned xb_ld(unsigned* p)              { return __hip_atomic_load(p, __ATOMIC_RELAXED, __HIP_MEMORY_SCOPE_AGENT); }
__device__ __forceinline__ unsigned xb_add(unsigned* p, unsigned v) { return __hip_atomic_fetch_add(p, v, __ATOMIC_RELAXED, __HIP_MEMORY_SCOPE_AGENT); }
__device__ __forceinline__ unsigned xb_xcc_id() { return (unsigned)__builtin_amdgcn_s_getreg((3 << 11) | 20) & 0xFu; }
#define XB_SPIN(cond, bar) do { unsigned _sp = 0; while (cond) { __builtin_amdgcn_s_sleep(1); \
    if ((++_sp & 255u) == 0u) { if (xb_ld(&(bar)[XB_TMO])) break; if (_sp > XB_SPIN_CAP) { atomicAdd(&(bar)[XB_TMO], 1u); break; } } } } while (0)

struct XcdBarrier {
    unsigned* bar; unsigned x;
    volatile LAS unsigned* st;
};

__device__ __forceinline__ XcdBarrier xcd_barrier_post(unsigned* bar, volatile LAS unsigned* st) {
    XcdBarrier b; b.bar = bar; b.x = xb_xcc_id(); b.st = st;
    if (threadIdx.x == 0) (void)xb_add(&bar[XB_XCNT(b.x)], 1u);
    return b;
}
__device__ __forceinline__ void xcd_barrier_complete(unsigned* bar, unsigned x, unsigned& nloc, unsigned& nx) {
    const unsigned G = gridDim.x * gridDim.y * gridDim.z;
    unsigned sum, cnt, mine, sp = 0u;
    for (;;) {
        sum = 0u; cnt = 0u; mine = 0u;
#pragma unroll
        for (unsigned j = 0; j < 16; ++j) { const unsigned c = xb_ld(&bar[XB_XCNT(j)]); sum += c; cnt += (c > 0u) ? 1u : 0u; mine = (j == x) ? c : mine; }
        if (sum == G) break;
        __builtin_amdgcn_s_sleep(1);
        if ((++sp & 255u) == 0u) { if (xb_ld(&bar[XB_TMO])) break; if (sp > XB_SPIN_CAP) { atomicAdd(&bar[XB_TMO], 1u); break; } }
    }
    nloc = mine > 0u ? mine : 1u; nx = cnt > 0u ? cnt : 1u;
}

__device__ __forceinline__ void xcd_barrier(const XcdBarrier& b) {
    asm volatile("s_waitcnt vmcnt(0)" ::: "memory");
    __syncthreads();
    if (threadIdx.x == 0) {
        unsigned* bar = b.bar;
        __builtin_amdgcn_s_waitcnt(0);
        unsigned nloc = b.st[0], nx = b.st[1];
        if (nloc == 0u) { xcd_barrier_complete(bar, b.x, nloc, nx); b.st[0] = nloc; b.st[1] = nx; }
        const unsigned old = xb_add(&bar[XB_XSUB(b.x)], 1u);
        const unsigned gen = old / nloc;
        if (old + 1u == (gen + 1u) * nloc) {
            __builtin_amdgcn_fence(__ATOMIC_RELEASE, "agent");
            asm volatile("s_waitcnt vmcnt(0)" ::: "memory");
            const unsigned og = xb_add(&bar[XB_TOP], 1u);
            const unsigned tg = og / nx;
            if (og + 1u == (tg + 1u) * nx) xb_add(&bar[XB_TOPGEN], 1u);
            else XB_SPIN(xb_ld(&bar[XB_TOPGEN]) == tg, bar);
            __builtin_amdgcn_fence(__ATOMIC_ACQUIRE, "agent");
            xb_add(&bar[XB_XGEN(b.x)], 1u);
            asm volatile("s_waitcnt vmcnt(0)" ::: "memory");
        } else {
            XB_SPIN(xb_ld(&bar[XB_XGEN(b.x)]) == gen, bar);
            __builtin_amdgcn_fence(__ATOMIC_ACQUIRE, "agent");
            asm volatile("s_waitcnt vmcnt(0)" ::: "memory");
        }
    }
    __syncthreads();
}
struct Args { const float* in[25]; float* out; unsigned char* ws; int ph_lo, ph_hi, li, pad; };
enum { I_X = 0, I_C, I_WMOD, I_BMOD, I_GPREMIX, I_GPOSTMIX, I_GPREFFN, I_GPOSTFFN, I_WIN, I_LCW, I_LCB, I_WA, I_BA, I_WX, I_BX, I_LAMBDA,
       I_CDW, I_CDB, I_LNG, I_LNB, I_WOUT, I_WQ, I_SUBK, I_PU, I_PV };

__device__ __forceinline__ float mod_at(const float* modp, int b, int n) {
    return (modp[(0 * 2 + b) * NMOD + n] + modp[(1 * 2 + b) * NMOD + n]) + (modp[(2 * 2 + b) * NMOD + n] + modp[(3 * 2 + b) * NMOD + n]);
}

__device__ __forceinline__ void p0_transpose_item(const float* W, int K, int N, bf16* WT, LAS float* scr, int item, int lane) {
    const int nblk = N / 32, kb = item / nblk, nb = item % nblk, k0 = 64 * kb, n0 = 32 * nb;
#pragma unroll 8
    for (int i = 0; i < 32; ++i) { const int kk = 2 * i + (lane >> 5); scr[kk * 33 + (lane & 31)] = W[(size_t)(k0 + kk) * N + n0 + (lane & 31)]; }
    LDS_WAIT(); asm volatile("" ::: "memory");
    const int c = lane & 7;
#pragma unroll
    for (int j = 0; j < 4; ++j) { const int n = (lane >> 3) + 8 * j; const LAS float* s = scr + (8 * c) * 33 + n;
        v4u o; o.x = pk2(s[0 * 33], s[1 * 33]); o.y = pk2(s[2 * 33], s[3 * 33]); o.z = pk2(s[4 * 33], s[5 * 33]); o.w = pk2(s[6 * 33], s[7 * 33]);
        *(GAS v4u*)(WT + (size_t)(n0 + n) * K + k0 + 8 * c) = o; }
    LDS_WAIT(); asm volatile("" ::: "memory");
}
__device__ __forceinline__ void cvt_rows_bf16(const float* src, bf16* dst, size_t n8, size_t gt, size_t ngt) {
    for (size_t i = gt; i < n8; i += ngt) {
        const f32x4 a = ((const GAS f32x4*)src)[2 * i], b = ((const GAS f32x4*)src)[2 * i + 1];
        v4u o; o.x = pk2(a.x, a.y); o.y = pk2(a.z, a.w); o.z = pk2(b.x, b.y); o.w = pk2(b.z, b.w);
        ((GAS v4u*)dst)[i] = o; }
}
__device__ __forceinline__ void phase_p0(const Args& A, LAS unsigned char* lds, int tid, int lane, int wave, int bid, int G) {
    float* modp = (float*)(A.ws + WS_MODP);
    for (int item = bid; item < 192; item += G) {
        const int cg = item % 48, kq = item / 48, k0 = kq * 512 + wave * 64, n0 = cg * 256 + lane * 4;
        const float c0 = A.in[I_C][k0 + lane], c1 = A.in[I_C][D + k0 + lane];
        const float ca0 = c0 * sigmoidf_(c0), ca1 = c1 * sigmoidf_(c1);
        f32x4 a0 = {0.f, 0.f, 0.f, 0.f}, a1 = {0.f, 0.f, 0.f, 0.f};
        const float* wp = A.in[I_WMOD] + (size_t)k0 * NMOD + n0;
#pragma unroll 8
        for (int kk = 0; kk < 64; ++kk) {
            const f32x4 w = *(const GAS f32x4*)(wp + (size_t)kk * NMOD);
            const float s0 = __shfl(ca0, kk), s1 = __shfl(ca1, kk);
            a0 += w * s0; a1 += w * s1;
        }
        LAS f32x4* red = (LAS f32x4*)lds;
        red[(wave * 2 + 0) * 64 + lane] = a0; red[(wave * 2 + 1) * 64 + lane] = a1;
        __syncthreads();
        { const int b = tid >> 8, col = tid & 255; const LAS float* rf = (const LAS float*)lds; float s = 0.f;
#pragma unroll
          for (int w = 0; w < 8; ++w) s += rf[((w * 2 + b) * 64) * 4 + col];
          if (kq == 0) s += A.in[I_BMOD][cg * 256 + col];
          modp[(kq * 2 + b) * NMOD + cg * 256 + col] = s; }
        __syncthreads();
    }
    {
        LAS float* scr = (LAS float*)(lds + wave * 16384);
        const int gw = bid * NWAVES + wave, NGW = G * NWAVES;
        constexpr int I1 = (D / 64) * (IN_COLS / 32);
        for (int it = gw; it < I1; it += NGW) p0_transpose_item(A.in[I_WIN], D, IN_COLS, (bf16*)(A.ws + WS_BT1), scr, it, lane);
    }
    {
        const int gt = bid * NTHR + tid, ngt = G * NTHR;
        bf16* wg = (bf16*)(A.ws + WS_WG);
        for (int e = gt; e < NH * 256 * 128; e += ngt) {
            const int h = e >> 15, n = (e >> 7) & 255, k = e & 127;
            const float v = (n < 128 ? A.in[I_WA] : A.in[I_WX])[h * 16384 + k * 128 + (n & 127)];
            wg[e] = (bf16)f2bf(v);
        }
        cvt_rows_bf16(A.in[I_SUBK], (bf16*)(A.ws + WS_SUBK), (size_t)NH * 2 * NKEY * 128 / 8, gt, ngt);
    }
}

__device__ __forceinline__ void phase_p1(const Args& A, int tid, int lane, int wave, int bid, int G) {
    const float* modp = (const float*)(A.ws + WS_MODP);
    {
        float* cfin = (float*)(A.ws + WS_CFIN);
        for (int e = bid * NTHR + tid; e < 2 * 2 * D; e += G * NTHR) {
            const int b = e >> 12, arr = (e >> 11) & 1, col = e & (D - 1);
            cfin[e] = arr == 0 ? mod_at(modp, b, 2 * D + col) * A.in[I_GPOSTMIX][col] : mod_at(modp, b, 5 * D + col) * A.in[I_GPOSTFFN][col];
        }
        float* cfe = (float*)(A.ws + WS_CFIN) + 4 * D;
        for (int e = bid * NTHR + tid; e < 2 * 2 * D; e += G * NTHR) {
            const int b = e >> 12, arr = (e >> 11) & 1, col = e & (D - 1);
            cfe[e] = arr == 0 ? A.in[I_GPREFFN][col] * (1.0f + mod_at(modp, b, 4 * D + col)) : mod_at(modp, b, 3 * D + col);
        }
    }
    const int gw = bid * NWAVES + wave, NGW = G * NWAVES;
    bf16* h1 = (bf16*)(A.ws + WS_RA);
    int cb = -1; float gs[4][8], sh[4][8];
    for (int row = gw; row < T; row += NGW) {
        const int b = row >> 13;
        if (b != cb) { cb = b;
#pragma unroll
            for (int j = 0; j < 4; ++j)
#pragma unroll
                for (int e = 0; e < 8; ++e) { const int col = j * 512 + lane * 8 + e;
                    gs[j][e] = A.in[I_GPREMIX][col] * (1.0f + mod_at(modp, b, D + col)); sh[j][e] = mod_at(modp, b, col); } }
        const GAS f32x4* xr = (const GAS f32x4*)(A.in[I_X] + (size_t)row * D) + lane * 2;
        f32x4 v[4][2]; float s = 0.f;
#pragma unroll
        for (int j = 0; j < 4; ++j) { v[j][0] = xr[j * 128]; v[j][1] = xr[j * 128 + 1];
            s += (v[j][0].x * v[j][0].x + v[j][0].y * v[j][0].y) + (v[j][0].z * v[j][0].z + v[j][0].w * v[j][0].w);
            s += (v[j][1].x * v[j][1].x + v[j][1].y * v[j][1].y) + (v[j][1].z * v[j][1].z + v[j][1].w * v[j][1].w); }
        const float rstd = __builtin_amdgcn_rsqf(wave_total(s) * (1.0f / D) + EPS);
        GAS v4u* orow = (GAS v4u*)(h1 + (size_t)row * D) + lane;
#pragma unroll
        for (int j = 0; j < 4; ++j) { float o[8];
#pragma unroll
            for (int e = 0; e < 8; ++e) o[e] = v[j][e >> 2][e & 3] * rstd * gs[j][e] + sh[j][e];
            v4u w; w.x = pk2(o[0], o[1]); w.y = pk2(o[2], o[3]); w.z = pk2(o[4], o[5]); w.w = pk2(o[6], o[7]);
            orow[j * 64] = w; }
    }
}

__device__ __forceinline__ void m1a_tile_issue(const bf16* proj, int item, int tid, v4u (&rv)[5], v4u (&rg)[5]) {
    const int b = item >> 9, tt = (item >> 3) & 63, ct = item & 7, t0 = tt * 128;
#pragma unroll
    for (int i = 0; i < 5; ++i) {
        const int e = tid + i * NTHR, r = e >> 4, c8 = (e & 15) * 8, t = t0 - 30 + r;
        rv[i] = (v4u){0u, 0u, 0u, 0u}; rg[i] = (v4u){0u, 0u, 0u, 0u};
        if (e < 158 * 16 && t >= 0) { const bf16* p = proj + (size_t)(b * SEQ + t) * IN_COLS + 2048 + ct * 128 + c8; rv[i] = *(const GAS v4u*)p; rg[i] = *(const GAS v4u*)(p + 1024); }
    }
}
__device__ __forceinline__ void phase_m1a(const Args& A, LAS unsigned char* lds, int tid, int lane, int wave, int bid, int G) {
    const bf16* proj = (const bf16*)(A.ws + WS_PROJ);
    {
        LAS float* scr = (LAS float*)(lds + wave * 16384);
        constexpr int I2 = (D / 64) * (D / 32);
        for (int it = bid * NWAVES + wave; it < 2 * I2; it += G * NWAVES) {
            if (it < I2) p0_transpose_item(A.in[I_WOUT], D, D, (bf16*)(A.ws + WS_BT2), scr, it, lane);
            else p0_transpose_item(A.in[I_WQ], D, D, (bf16*)(A.ws + WS_BT3), scr, it - I2, lane);
        }
        __syncthreads();
    }
    {
        bf16* zc = (bf16*)(A.ws + WS_ZC);
        const float* w31 = A.in[I_CDW]; const float* b31 = A.in[I_CDB];
        LAS float* zt = (LAS float*)lds;
        const int cp = tid & 63, tg = tid >> 6;
        v4u rv[5], rg[5];
        int item = bid;
        if (item < 2 * 64 * 8) m1a_tile_issue(proj, item, tid, rv, rg);
        float w0[CONF_K], w1[CONF_K], bias0 = 0.f, bias1 = 0.f; int wct = -1;
        for (; item < 2 * 64 * 8; item += G) {
            const int b = item >> 9, tt = (item >> 3) & 63, ct = item & 7, t0 = tt * 128, ch = ct * 128 + 2 * cp;
            if (ct != wct) { wct = ct;
#pragma unroll
                for (int j = 0; j < CONF_K; ++j) { const f32x2 ww = *(const GAS f32x2*)(w31 + j * CONF_W + ch); w0[j] = ww.x; w1[j] = ww.y; }
                const f32x2 bw = *(const GAS f32x2*)(b31 + ch); bias0 = bw.x; bias1 = bw.y; }
            __syncthreads();
#pragma unroll
            for (int i = 0; i < 5; ++i) {
                const int e = tid + i * NTHR, r = e >> 4, c8 = (e & 15) * 8;
                if (e < 158 * 16) { const v4u v = rv[i], g = rg[i]; f32x4 z0, z1;
                    z0.x = bflo(v.x) * sigmoidf_(bflo(g.x)); z0.y = bfhi(v.x) * sigmoidf_(bfhi(g.x)); z0.z = bflo(v.y) * sigmoidf_(bflo(g.y)); z0.w = bfhi(v.y) * sigmoidf_(bfhi(g.y));
                    z1.x = bflo(v.z) * sigmoidf_(bflo(g.z)); z1.y = bfhi(v.z) * sigmoidf_(bfhi(g.z)); z1.z = bflo(v.w) * sigmoidf_(bflo(g.w)); z1.w = bfhi(v.w) * sigmoidf_(bfhi(g.w));
                    *(LAS f32x4*)(zt + r * 128 + c8) = z0; *(LAS f32x4*)(zt + r * 128 + c8 + 4) = z1; }
            }
            __syncthreads();
            if (item + G < 2 * 64 * 8) m1a_tile_issue(proj, item + G, tid, rv, rg);
            float a0[16], a1[16];
#pragma unroll
            for (int i = 0; i < 16; ++i) { a0[i] = bias0; a1[i] = bias1; }
#pragma unroll
            for (int s_ = 0; s_ < 46; ++s_) {
                const f32x2 v = *(const LAS f32x2*)(zt + (tg * 16 + s_) * 128 + 2 * cp);
#pragma unroll
                for (int i = 0; i < 16; ++i) if (s_ - i >= 0 && s_ - i < CONF_K) { a0[i] += w0[s_ - i] * v.x; a1[i] += w1[s_ - i] * v.y; }
            }
            bf16* zo = zc + (size_t)(b * SEQ + t0 + tg * 16) * CONF_W + ch;
#pragma unroll
            for (int i = 0; i < 16; ++i) *(GAS unsigned*)(zo + (size_t)i * CONF_W) = pk2(a0[i], a1[i]);
        }
        __syncthreads();
    }
}

template <int CTRL> __device__ __forceinline__ float dpp_shr(float v, float ident) {
    return __builtin_bit_cast(float, __builtin_amdgcn_update_dpp(__builtin_bit_cast(int, ident), __builtin_bit_cast(int, v), CTRL, 0xF, 0xF, false));
}
constexpr int XT_PITCH = 2064;   static_assert(64 * 2064 <= LDSCTL_OFF, "xl tile vs LDS control words");
__device__ __forceinline__ void phase_m1b(const Args& A, LAS unsigned char* lds, int tid, int lane, int wave, int bid, int G) {
    const bf16* proj = (const bf16*)(A.ws + WS_PROJ); const bf16* wg = (const bf16*)(A.ws + WS_WG);
    bf16* hloc = (bf16*)(A.ws + WS_HLOC); bf16* pc = (bf16*)(A.ws + WS_PC); float* agg = (float*)(A.ws + WS_AGG);
    const int fr = lane & 15, fq = lane >> 4;
    for (int wi = bid; wi < 2 * NCHUNK; wi += G) {
        const int hh = wave, chunk = wi & (NCHUNK - 1), b = wi >> 7;
        const size_t r0 = (size_t)b * SEQ + (size_t)chunk * CHUNK;
        __syncthreads();
        {
            const float* w4 = A.in[I_LCW]; const float* b4 = A.in[I_LCB];
            const int c0 = (tid & 127) * 8, tr = tid >> 7, t0 = chunk * CHUNK + tr * 16;
            v4u in[19];
#pragma unroll
            for (int r = 0; r < 19; ++r) { in[r] = (v4u){0u, 0u, 0u, 0u}; if (t0 - 3 + r >= 0) in[r] = *(const GAS v4u*)(proj + ((size_t)b * SEQ + t0 - 3 + r) * IN_COLS + c0); }
            float w[4][8], bb[8];
#pragma unroll
            for (int j = 0; j < 4; ++j) { const f32x4 wa_ = *(const GAS f32x4*)(w4 + j * LRU_W + c0), wb_ = *(const GAS f32x4*)(w4 + j * LRU_W + c0 + 4);
                w[j][0] = wa_.x; w[j][1] = wa_.y; w[j][2] = wa_.z; w[j][3] = wa_.w; w[j][4] = wb_.x; w[j][5] = wb_.y; w[j][6] = wb_.z; w[j][7] = wb_.w; }
            { const f32x4 ba = *(const GAS f32x4*)(b4 + c0), bc = *(const GAS f32x4*)(b4 + c0 + 4); bb[0] = ba.x; bb[1] = ba.y; bb[2] = ba.z; bb[3] = ba.w; bb[4] = bc.x; bb[5] = bc.y; bb[6] = bc.z; bb[7] = bc.w; }
#pragma unroll
            for (int i = 0; i < 16; ++i) { float acc[8];
#pragma unroll
                for (int e = 0; e < 8; ++e) acc[e] = bb[e];
#pragma unroll
                for (int j = 0; j < 4; ++j) { const v4u v = in[i + j];
                    acc[0] += w[j][0] * bflo(v.x); acc[1] += w[j][1] * bfhi(v.x); acc[2] += w[j][2] * bflo(v.y); acc[3] += w[j][3] * bfhi(v.y);
                    acc[4] += w[j][4] * bflo(v.z); acc[5] += w[j][5] * bfhi(v.z); acc[6] += w[j][6] * bflo(v.w); acc[7] += w[j][7] * bfhi(v.w); }
                v4u o; o.x = pk2(acc[0], acc[1]); o.y = pk2(acc[2], acc[3]); o.z = pk2(acc[4], acc[5]); o.w = pk2(acc[6], acc[7]);
                *(LAS v4u*)(lds + (tr * 16 + i) * XT_PITCH + c0 * 2) = o; }
        }
        __syncthreads();
        bf16x8 xf[4][4];
#pragma unroll
        for (int mt = 0; mt < 4; ++mt)
#pragma unroll
            for (int ks = 0; ks < 4; ++ks) xf[mt][ks] = *(const LAS bf16x8*)(lds + (16 * mt + fr) * XT_PITCH + (hh * LRU_HD + 32 * ks + 8 * fq) * 2);
        float cP[4], cH[4];
        for (int j = 0; j < 8; ++j) {
            const int chb = hh * LRU_HD + 16 * j + 4 * fq;
            bf16x8 wa[4], wx[4];
#pragma unroll
            for (int ks = 0; ks < 4; ++ks) { wa[ks] = *(const GAS bf16x8*)(wg + (size_t)(hh * 256 + 16 * j + fr) * 128 + 32 * ks + 8 * fq);
                                             wx[ks] = *(const GAS bf16x8*)(wg + (size_t)(hh * 256 + 128 + 16 * j + fr) * 128 + 32 * ks + 8 * fq); }
            const f32x4 bav = *(const GAS f32x4*)(A.in[I_BA] + chb), bxv = *(const GAS f32x4*)(A.in[I_BX] + chb), lam = *(const GAS f32x4*)(A.in[I_LAMBDA] + chb);
            float cl[4];
#pragma unroll
            for (int r = 0; r < 4; ++r) { cl[r] = -8.0f * log1pf(__expf(-lam[r])); cP[r] = 1.f; cH[r] = 0.f; }
#pragma unroll
            for (int mt = 0; mt < 4; ++mt) {
                f32x4 ar = {0.f, 0.f, 0.f, 0.f}, ai = {0.f, 0.f, 0.f, 0.f};
#pragma unroll
                for (int ks = 0; ks < 4; ++ks) { ar = __builtin_amdgcn_mfma_f32_16x16x32_bf16(wa[ks], xf[mt][ks], ar, 0, 0, 0);
                                                 ai = __builtin_amdgcn_mfma_f32_16x16x32_bf16(wx[ks], xf[mt][ks], ai, 0, 0, 0); }
                const v2u xv = *(const LAS v2u*)(lds + (16 * mt + fr) * XT_PITCH + chb * 2);
                const float xlv[4] = {bflo(xv.x), bfhi(xv.x), bflo(xv.y), bfhi(xv.y)};
                float P[4], H[4];
#pragma unroll
                for (int r = 0; r < 4; ++r) {
                    const float rg = sigmoidf_(ar[r] + bav[r]), ig = sigmoidf_(ai[r] + bxv[r]);
                    const float la = cl[r] * rg, a = __expf(la), mult = sqrtf(fmaxf(1.0f - a * a, 0.f));
                    float p = a, h = mult * ig * xlv[r];
                    { float pp, hp;
                      pp = dpp_shr<0x111>(p, 1.0f); hp = dpp_shr<0x111>(h, 0.0f); h = p * hp + h; p = p * pp;
                      pp = dpp_shr<0x112>(p, 1.0f); hp = dpp_shr<0x112>(h, 0.0f); h = p * hp + h; p = p * pp;
                      pp = dpp_shr<0x114>(p, 1.0f); hp = dpp_shr<0x114>(h, 0.0f); h = p * hp + h; p = p * pp;
                      pp = dpp_shr<0x118>(p, 1.0f); hp = dpp_shr<0x118>(h, 0.0f); h = p * hp + h; p = p * pp; }
                    h = h + p * cH[r]; p = p * cP[r];
                    P[r] = p; H[r] = h;
                    cP[r] = __shfl(p, 15, 16); cH[r] = __shfl(h, 15, 16);
                }
                v2u ho, po; ho.x = pk2(H[0], H[1]); ho.y = pk2(H[2], H[3]); po.x = pk2(P[0], P[1]); po.y = pk2(P[2], P[3]);
                *(GAS v2u*)(hloc + (r0 + 16 * mt + fr) * LRU_W + chb) = ho;
                *(GAS v2u*)(pc + (r0 + 16 * mt + fr) * LRU_W + chb) = po;
            }
            if (fr == 0) {
                float* ag = agg + ((size_t)(b * NCHUNK + chunk) * LRU_W + chb) * 2;
                *(GAS f32x4*)ag = (f32x4){cP[0], cH[0], cP[1], cH[1]}; *(GAS f32x4*)(ag + 4) = (f32x4){cP[2], cH[2], cP[3], cH[3]};
            }
        }
    }
}

__device__ __forceinline__ void phase_m3(const Args& A, LAS unsigned char* lds, int tid, int lane, int wave, int bid, int G) {
    const bf16* proj = (const bf16*)(A.ws + WS_PROJ); const bf16* hloc = (const bf16*)(A.ws + WS_HLOC); const bf16* pc = (const bf16*)(A.ws + WS_PC);
    const bf16* zc = (const bf16*)(A.ws + WS_ZC); const float* agg = (const float*)(A.ws + WS_AGG);
    bf16* a2 = (bf16*)(A.ws + WS_RA);
    LAS float* cs = (LAS float*)lds;
    float lg[2][8], lb[2][8];
#pragma unroll
    for (int jj = 0; jj < 2; ++jj)
#pragma unroll
        for (int e = 0; e < 8; ++e) { lg[jj][e] = A.in[I_LNG][jj * 512 + lane * 8 + e]; lb[jj][e] = A.in[I_LNB][jj * 512 + lane * 8 + e]; }
    for (int item = bid; item < 2 * NCHUNK; item += G) {
        const int b = item >> 7, chunk = item & (NCHUNK - 1);
        {   float h0 = 0.f, h1 = 0.f; const float* ap = agg + ((size_t)(b * NCHUNK) * LRU_W + 2 * tid) * 2;
#pragma unroll 8
            for (int c = 0; c < chunk; ++c) { const f32x4 ab = *(const GAS f32x4*)(ap + (size_t)c * LRU_W * 2); h0 = ab.x * h0 + ab.y; h1 = ab.z * h1 + ab.w; }
            __syncthreads();
            cs[2 * tid] = h0; cs[2 * tid + 1] = h1;
            __syncthreads(); }
        for (int rr = 0; rr < 8; rr += M3_RW) {
            const int row0 = b * SEQ + chunk * CHUNK + wave * 8 + rr;
            v4u hv[M3_RW][2], pv[M3_RW][2], gv[M3_RW][2], zq[M3_RW][2];
#pragma unroll
            for (int u = 0; u < M3_RW; ++u)
#pragma unroll
                for (int jj = 0; jj < 2; ++jj) { const int c0 = jj * 512 + lane * 8; const size_t row = (size_t)(row0 + u);
                    hv[u][jj] = *(const GAS v4u*)(hloc + row * LRU_W + c0); pv[u][jj] = *(const GAS v4u*)(pc + row * LRU_W + c0);
                    gv[u][jj] = *(const GAS v4u*)(proj + row * IN_COLS + 1024 + c0); zq[u][jj] = *(const GAS v4u*)(zc + row * CONF_W + c0); }
#pragma unroll
            for (int u = 0; u < M3_RW; ++u) {
                const size_t row = (size_t)(row0 + u);
                float zv[2][8]; float s = 0.f;
#pragma unroll
                for (int jj = 0; jj < 2; ++jj) {
                    const int c0 = jj * 512 + lane * 8;
                    const f32x4 ca = *(const LAS f32x4*)(cs + c0), cb = *(const LAS f32x4*)(cs + c0 + 4);
                    const v4u h_ = hv[u][jj], p_ = pv[u][jj], g_ = gv[u][jj], z = zq[u][jj];
                    float y[8];
                    y[0] = (bflo(h_.x) + bflo(p_.x) * ca.x) * gelu_tanh(bflo(g_.x)); y[1] = (bfhi(h_.x) + bfhi(p_.x) * ca.y) * gelu_tanh(bfhi(g_.x));
                    y[2] = (bflo(h_.y) + bflo(p_.y) * ca.z) * gelu_tanh(bflo(g_.y)); y[3] = (bfhi(h_.y) + bfhi(p_.y) * ca.w) * gelu_tanh(bfhi(g_.y));
                    y[4] = (bflo(h_.z) + bflo(p_.z) * cb.x) * gelu_tanh(bflo(g_.z)); y[5] = (bfhi(h_.z) + bfhi(p_.z) * cb.y) * gelu_tanh(bfhi(g_.z));
                    y[6] = (bflo(h_.w) + bflo(p_.w) * cb.z) * gelu_tanh(bflo(g_.w)); y[7] = (bfhi(h_.w) + bfhi(p_.w) * cb.w) * gelu_tanh(bfhi(g_.w));
                    v4u o; o.x = pk2(y[0], y[1]); o.y = pk2(y[2], y[3]); o.z = pk2(y[4], y[5]); o.w = pk2(y[6], y[7]);
                    *(GAS v4u*)(a2 + row * D + c0) = o;
                    zv[jj][0] = bflo(z.x); zv[jj][1] = bfhi(z.x); zv[jj][2] = bflo(z.y); zv[jj][3] = bfhi(z.y); zv[jj][4] = bflo(z.z); zv[jj][5] = bfhi(z.z); zv[jj][6] = bflo(z.w); zv[jj][7] = bfhi(z.w);
#pragma unroll
                    for (int e = 0; e < 8; ++e) s += zv[jj][e];
                }
                const float mean = wave_total(s) * (1.0f / CONF_W); float q = 0.f;
#pragma unroll
                for (int jj = 0; jj < 2; ++jj)
#pragma unroll
                    for (int e = 0; e < 8; ++e) { zv[jj][e] -= mean; q += zv[jj][e] * zv[jj][e]; }
                const float rstd = __builtin_amdgcn_rsqf(wave_total(q) * (1.0f / CONF_W) + EPS);
#pragma unroll
                for (int jj = 0; jj < 2; ++jj) { float o[8];
#pragma unroll
                    for (int e = 0; e < 8; ++e) { const float n = zv[jj][e] * rstd * lg[jj][e] + lb[jj][e]; o[e] = n * sigmoidf_(n); }
                    v4u w; w.x = pk2(o[0], o[1]); w.y = pk2(o[2], o[3]); w.z = pk2(o[4], o[5]); w.w = pk2(o[6], o[7]);
                    *(GAS v4u*)(a2 + row * D + 1024 + jj * 512 + lane * 8) = w; }
            }
        }
    }
}

__device__ __forceinline__ f32x2 fp8lo(unsigned w) { return __builtin_amdgcn_cvt_pk_f32_fp8((int)w, false); }
__device__ __forceinline__ f32x2 fp8hi(unsigned w) { return __builtin_amdgcn_cvt_pk_f32_fp8((int)w, true); }
constexpr int CVT_ROWS = 4;
template <bool I8> __device__ __forceinline__ void cvt_table_q8(const float* src, unsigned char* dst, float* inv_scale, int gw, int NGW, int lane) {
    for (int r0 = gw; r0 < NEXP; r0 += NGW * CVT_ROWS) {
        f32x4 v[CVT_ROWS][8];
#pragma unroll
        for (int q = 0; q < CVT_ROWS; ++q) { const int r = r0 + q * NGW; const GAS f32x4* p = (const GAS f32x4*)(src + (size_t)(r < NEXP ? r : r0) * D) + lane;
#pragma unroll
            for (int i = 0; i < 8; ++i) v[q][i] = p[i * 64]; }
#pragma unroll
        for (int q = 0; q < CVT_ROWS; ++q) { const int r = r0 + q * NGW; float m = 0.f;
#pragma unroll
            for (int i = 0; i < 8; ++i) m = fmaxf(m, fmaxf(fmaxf(fabsf(v[q][i].x), fabsf(v[q][i].y)), fmaxf(fabsf(v[q][i].z), fabsf(v[q][i].w))));
#pragma unroll
            for (int o = 1; o < 64; o <<= 1) m = fmaxf(m, __shfl_xor(m, o));
            const float QM = I8 ? 127.0f : 448.0f;
            const float sc = m > 0.f ? QM / m : 1.0f;
            if (r < NEXP) {
                GAS unsigned* o4 = (GAS unsigned*)(dst + (size_t)r * D) + lane;
#pragma unroll
                for (int i = 0; i < 8; ++i) { const f32x4 t = v[q][i] * sc;
                    const float a = fminf(fmaxf(t.x, -QM), QM), b = fminf(fmaxf(t.y, -QM), QM), c = fminf(fmaxf(t.z, -QM), QM), d = fminf(fmaxf(t.w, -QM), QM);
                    if (I8) { o4[i * 64] = (unsigned)(((int)rintf(a) & 255) | (((int)rintf(b) & 255) << 8) | (((int)rintf(c) & 255) << 16) | ((int)rintf(d) << 24)); }
                    else { int pk = __builtin_amdgcn_cvt_pk_fp8_f32(a, b, 0, false); pk = __builtin_amdgcn_cvt_pk_fp8_f32(c, d, pk, true); o4[i * 64] = (unsigned)pk; } }
                if (lane == 0) inv_scale[r] = m > 0.f ? m * (1.0f / QM) : 1.0f;
            }
        }
    }
}
__device__ __forceinline__ void phase_e2(const Args& A, int tid, int lane, int wave, int bid, int G) {
    const float* cfin = (const float*)(A.ws + WS_CFIN); const float* cfe = (const float*)(A.ws + WS_CFIN) + 4 * D;
    const bf16* y1 = (const bf16*)(A.ws + WS_Y1); bf16* h2 = (bf16*)(A.ws + WS_RA);
    const int gw = bid * NWAVES + wave, NGW = G * NWAVES;
    int cb = -1; f32x4 c1[8], gs[8], sh[8];
    f32x4 xn[8]; v2u yn[8];
#define E2_LOAD(r_) do { const size_t r__ = (size_t)(r_); const GAS f32x4* xr = (const GAS f32x4*)(A.in[I_X] + r__ * D) + lane; const GAS v2u* yr = (const GAS v2u*)(y1 + r__ * D) + lane; \
        _Pragma("unroll") for (int j = 0; j < 8; ++j) { xn[j] = xr[j * 64]; yn[j] = yr[j * 64]; } } while (0)
    if (gw < T) E2_LOAD(gw);
    for (int row = gw; row < T; row += NGW) {
        const int b = row >> 13;
        if (b != cb) { cb = b;
#pragma unroll
            for (int j = 0; j < 8; ++j) { c1[j] = ((const GAS f32x4*)(cfin + (size_t)(b * 2 + 0) * D))[j * 64 + lane]; gs[j] = ((const GAS f32x4*)(cfe + (size_t)(b * 2 + 0) * D))[j * 64 + lane];
                sh[j] = ((const GAS f32x4*)(cfe + (size_t)(b * 2 + 1) * D))[j * 64 + lane]; } }
        f32x4 xv[8], yv[8]; float s1 = 0.f;
#pragma unroll
        for (int j = 0; j < 8; ++j) { xv[j] = xn[j]; yv[j] = (f32x4){bflo(yn[j].x), bfhi(yn[j].x), bflo(yn[j].y), bfhi(yn[j].y)};
            s1 += (yv[j].x * yv[j].x + yv[j].y * yv[j].y) + (yv[j].z * yv[j].z + yv[j].w * yv[j].w); }
        if (row + NGW < T) E2_LOAD(row + NGW);
        const float rstd1 = __builtin_amdgcn_rsqf(wave_total(s1) * (1.0f / D) + EPS); float s2 = 0.f;
#pragma unroll
        for (int j = 0; j < 8; ++j) { xv[j] += c1[j] * yv[j] * rstd1; s2 += (xv[j].x * xv[j].x + xv[j].y * xv[j].y) + (xv[j].z * xv[j].z + xv[j].w * xv[j].w); }
        const float rstd2 = __builtin_amdgcn_rsqf(wave_total(s2) * (1.0f / D) + EPS);
        GAS v2u* orow = (GAS v2u*)(h2 + (size_t)row * D) + lane; float am = 0.f;
#pragma unroll
        for (int j = 0; j < 8; ++j) { xv[j] = xv[j] * rstd2 * gs[j] + sh[j];
            am = fmaxf(am, fmaxf(fmaxf(fabsf(xv[j].x), fabsf(xv[j].y)), fmaxf(fabsf(xv[j].z), fabsf(xv[j].w))));
            orow[j * 64] = (v2u){pk2(xv[j].x, xv[j].y), pk2(xv[j].z, xv[j].w)}; }
#pragma unroll
        for (int o = 1; o < 64; o <<= 1) am = fmaxf(am, __shfl_xor(am, o));
        const float qs = am > 0.f ? 127.0f / am : 1.0f;
        GAS unsigned* qrow = (GAS unsigned*)(A.ws + WS_H2Q + (size_t)row * D) + lane;
#pragma unroll
        for (int j = 0; j < 8; ++j) { const f32x4 t = xv[j] * qs;
            qrow[j * 64] = (unsigned)(((int)rintf(t.x) & 255) | (((int)rintf(t.y) & 255) << 8) | (((int)rintf(t.z) & 255) << 16) | ((int)rintf(t.w) << 24)); }
        if (lane == 0) ((float*)(A.ws + WS_HSC))[row] = am > 0.f ? am * (1.0f / 127.0f) : 1.0f;
    }
#undef E2_LOAD
}

template <int N> __device__ __forceinline__ void bitonic_sort_desc(float (&v)[N]) {
#pragma unroll
    for (int k = 2; k <= N; k <<= 1)
#pragma unroll
        for (int j = k >> 1; j > 0; j >>= 1)
#pragma unroll
            for (int i = 0; i < N; ++i) { const int l = i ^ j;
                if (l > i) { const bool desc = ((i & k) == 0); const float a = v[i], b = v[l]; const float mx = fmaxf(a, b), mn = fminf(a, b); v[i] = desc ? mx : mn; v[l] = desc ? mn : mx; } }
}
__device__ __forceinline__ void merge_top16(float (&a)[16], const float (&b)[16]) {
#pragma unroll
    for (int i = 0; i < 16; ++i) a[i] = fmaxf(a[i], b[15 - i]);
#pragma unroll
    for (int j = 8; j > 0; j >>= 1)
#pragma unroll
        for (int i = 0; i < 16; ++i) { const int l = i ^ j; if (l > i) { const float x = a[i], y = a[l]; a[i] = fmaxf(x, y); a[l] = fminf(x, y); } }
}
__device__ __forceinline__ void top16_of_64(float (&v)[64], float (&out)[16]) {
    float g[4][16];
#pragma unroll
    for (int q = 0; q < 4; ++q) {
#pragma unroll
        for (int i = 0; i < 16; ++i) g[q][i] = v[q * 16 + i];
        bitonic_sort_desc<16>(g[q]); }
    merge_top16(g[0], g[1]); merge_top16(g[2], g[3]); merge_top16(g[0], g[2]);
#pragma unroll
    for (int i = 0; i < 16; ++i) out[i] = g[0][i];
}
__device__ __forceinline__ float pack_key(float v, unsigned key, unsigned mask) { return __builtin_bit_cast(float, (__builtin_bit_cast(unsigned, v) & ~mask) | key); }
constexpr int SK_PITCH = 272;
__device__ __forceinline__ void score_top16(const bf16* q, const LAS unsigned char* skl, int tok, int h, int p, int l31, int hf, float (&out)[16]) {
    f32x16 acc[4];
#pragma unroll
    for (int kt = 0; kt < 4; ++kt)
#pragma unroll
        for (int r = 0; r < 16; ++r) acc[kt][r] = 0.f;
    bf16x8 bq[8];
#pragma unroll
    for (int ks = 0; ks < 8; ++ks) bq[ks] = *(const GAS bf16x8*)(q + (size_t)tok * D + h * 256 + p * 128 + 16 * ks + 8 * hf);
#pragma unroll
    for (int ks = 0; ks < 8; ++ks) {
#pragma unroll
        for (int kt = 0; kt < 4; ++kt) {
            const bf16x8 ak = *(const LAS bf16x8*)(skl + (p * NKEY + 32 * kt + l31) * SK_PITCH + (16 * ks + 8 * hf) * 2);
            acc[kt] = __builtin_amdgcn_mfma_f32_32x32x16_bf16(ak, bq[ks], acc[kt], 0, 0, 0);
        }
    }
    float v[64];
#pragma unroll
    for (int kt = 0; kt < 4; ++kt)
#pragma unroll
        for (int r = 0; r < 16; ++r) v[kt * 16 + r] = pack_key(acc[kt][r], (unsigned)(32 * kt + (r & 3) + 8 * (r >> 2) + 4 * hf), 0x7Fu);
    float other[16];
    top16_of_64(v, out);
#pragma unroll
    for (int i = 0; i < 16; ++i) other[i] = __shfl_xor(out[i], 32);
    merge_top16(out, other);
}
__device__ __forceinline__ void s_convert_tables(const Args& A, int gw, int NGW, int lane) {
    cvt_table_q8<true>(A.in[I_PU], A.ws + WS_UB, (float*)(A.ws + WS_USC), gw, NGW, lane);
}
__device__ __forceinline__ void phase_s(const Args& A, LAS unsigned char* lds, int tid, int lane, int wave, int bid, int G) {
    const bf16* q = (const bf16*)(A.ws + WS_Q); const bf16* sk = (const bf16*)(A.ws + WS_SUBK);
    int* idx = (int*)(A.ws + WS_IDX); float* gate = (float*)(A.ws + WS_GATE);
    const int l31 = lane & 31, hf = lane >> 5;
    bool conv_done = false;
    for (int wi = bid; wi < (T / 512) * NH; wi += G) {
      const int h = wi & 7, tg = wi >> 3;
      __syncthreads();
#pragma unroll
      for (int i = 0; i < 8; ++i) { const int c = tid + i * NTHR, row = c >> 4, c16 = c & 15;
          *(LAS v4u*)(lds + row * SK_PITCH + c16 * 16) = *(const GAS v4u*)(sk + ((size_t)(h * 2 * NKEY + row)) * 128 + c16 * 8); }
      __syncthreads();
      if (S_CONV && wave >= 4 && !conv_done) s_convert_tables(A, bid * NWAVES + wave, G * NWAVES, lane);
      for (int ti = 0; ti < 2; ++ti) {
        const int tok = (tg * 16 + ti * 8 + wave) * 32 + l31;
        float s1[16], s2[16];
        score_top16(q, lds, tok, h, 0, l31, hf, s1);
        score_top16(q, lds, tok, h, 1, l31, hf, s2);
        float cv[64]; int n = 0;
#pragma unroll
        for (int i = 0; i < 16; ++i)
#pragma unroll
            for (int j = 0; j < 16; ++j)
                if ((i + 1) * (j + 1) <= 16) {
                    const float a = __builtin_bit_cast(float, __builtin_bit_cast(unsigned, s1[i]) & ~0x7Fu), c = __builtin_bit_cast(float, __builtin_bit_cast(unsigned, s2[j]) & ~0x7Fu);
                    cv[n++] = pack_key(a + c, (unsigned)(i * 16 + j), 0xFFu); }
#pragma unroll
        for (int m = 50; m < 64; ++m) cv[m] = -INFINITY;
        float c16[16];
        top16_of_64(cv, c16);
        float ev[16], esum = 0.f; const float cmax = __builtin_bit_cast(float, __builtin_bit_cast(unsigned, c16[0]) & ~0xFFu);
#pragma unroll
        for (int m = 0; m < 16; ++m) { ev[m] = __expf(__builtin_bit_cast(float, __builtin_bit_cast(unsigned, c16[m]) & ~0xFFu) - cmax); esum += ev[m]; }
        const float rs = 1.0f / esum;
        int oi[8]; float og[8];
#pragma unroll
        for (int mm = 0; mm < 8; ++mm) {
            float c_lo = c16[mm], c_hi = c16[8 + mm], e_lo = ev[mm], e_hi = ev[8 + mm];
            asm volatile("" : "+v"(c_lo), "+v"(c_hi), "+v"(e_lo), "+v"(e_hi));
            const unsigned cb = __builtin_bit_cast(unsigned, hf ? c_hi : c_lo); const int ii = (cb >> 4) & 15, jj = cb & 15;
            int row = 0, col = 0;
#pragma unroll
            for (int k = 0; k < 16; ++k) { row = (ii == k) ? (int)(__builtin_bit_cast(unsigned, s1[k]) & 0x7Fu) : row; col = (jj == k) ? (int)(__builtin_bit_cast(unsigned, s2[k]) & 0x7Fu) : col; }
            oi[mm] = row * NKEY + col; og[mm] = (hf ? e_hi : e_lo) * rs;
        }
        int* ip = idx + (size_t)tok * KSEL + h * 16 + hf * 8; float* gp = gate + (size_t)tok * KSEL + h * 16 + hf * 8;
        *(GAS v4u*)ip = (v4u){(unsigned)oi[0], (unsigned)oi[1], (unsigned)oi[2], (unsigned)oi[3]}; *(GAS v4u*)(ip + 4) = (v4u){(unsigned)oi[4], (unsigned)oi[5], (unsigned)oi[6], (unsigned)oi[7]};
        *(GAS f32x4*)gp = (f32x4){og[0], og[1], og[2], og[3]}; *(GAS f32x4*)(gp + 4) = (f32x4){og[4], og[5], og[6], og[7]};
      }
      if (S_CONV && wave < 4 && !conv_done) s_convert_tables(A, bid * NWAVES + wave, G * NWAVES, lane);
      conv_done = true;
    }
    if (S_CONV && !conv_done) s_convert_tables(A, bid * NWAVES + wave, G * NWAVES, lane);
    __syncthreads();
}

__device__ __forceinline__ float row_dot_fp8(const v4u d0, const v4u d1, const f32x2 (&hf)[2][8]) {
    const unsigned w0[4] = {d0.x, d0.y, d0.z, d0.w}, w1[4] = {d1.x, d1.y, d1.z, d1.w};
    f32x2 a = {0.f, 0.f}, b = {0.f, 0.f};
#pragma unroll
    for (int i = 0; i < 4; ++i) { a += fp8lo(w0[i]) * hf[0][2 * i]; a += fp8hi(w0[i]) * hf[0][2 * i + 1]; b += fp8lo(w1[i]) * hf[1][2 * i]; b += fp8hi(w1[i]) * hf[1][2 * i + 1]; }
    return (a.x + a.y) + (b.x + b.y);
}
__device__ __forceinline__ void row_axpy_fp8(f32x2 (&acc)[2][8], const v4u d0, const v4u d1, float w) {
    const unsigned w0[4] = {d0.x, d0.y, d0.z, d0.w}, w1[4] = {d1.x, d1.y, d1.z, d1.w};
#pragma unroll
    for (int i = 0; i < 4; ++i) { acc[0][2 * i] += fp8lo(w0[i]) * w; acc[0][2 * i + 1] += fp8hi(w0[i]) * w; acc[1][2 * i] += fp8lo(w1[i]) * w; acc[1][2 * i + 1] += fp8hi(w1[i]) * w; }
}
__device__ __forceinline__ void phase_pu(const Args& A, int lane, int wave, int bid, int G) {
    const unsigned char* h2q = A.ws + WS_H2Q; const unsigned char* ub = A.ws + WS_UB; const int* idx = (const int*)(A.ws + WS_IDX); float* actp = (float*)(A.ws + WS_ACTP);
    const int NX = (G % 8 == 0) ? 8 : 1, vx = bid % NX, nw = (G / NX) * NWAVES, wv = (bid / NX) * NWAVES + wave;
    const int q = lane >> 4, c16 = lane & 15;
    for (int cb = vx; cb < D / 256; cb += NX) {
        const unsigned loff = (unsigned)(cb * 256 + c16 * 16);
        int cid0 = 0, cid1 = 0, nid0 = 0, nid1 = 0; v4u ch = {0u, 0u, 0u, 0u}, nh = {0u, 0u, 0u, 0u};
#define PUQ_LOAD(i0, i1, hh, t_) do { const int t__ = (t_); if (t__ < T) { i0 = idx[(size_t)t__ * KSEL + lane]; i1 = idx[(size_t)t__ * KSEL + 64 + lane]; hh = *(const GAS v4u*)(h2q + (size_t)t__ * D + cb * 256 + c16 * 16); } } while (0)
        PUQ_LOAD(cid0, cid1, ch, wv); PUQ_LOAD(nid0, nid1, nh, wv + nw);
        v4u rv[PUQ_RB];
#define PUQ_ISSUE(slot, idr, s_) do { const unsigned e_ = (unsigned)__shfl(idr, ((4 * (s_)) & 63) + q); rv[slot] = *(const GAS v4u*)(ub + ((e_ << 11) + loff)); } while (0)
#pragma unroll
        for (int r = 0; r < PUQ_RB; ++r) PUQ_ISSUE(r, cid0, r);
        f32x4 cvv[8]; int it = 0;
        const int gwv = bid * NWAVES + wave, NGWv = G * NWAVES;
        for (int tok = wv; tok < T; tok += nw, ++it) {
            if (cb == vx) {
                const int vr = gwv + NGWv * (it >> 3);
                if ((it & 7) == 0 && vr < NEXP) { const GAS f32x4* p = (const GAS f32x4*)(A.in[I_PV] + (size_t)vr * D) + lane;
#pragma unroll
                    for (int i = 0; i < 8; ++i) cvv[i] = p[i * 64]; }
                if ((it & 7) == 1 && vr < NEXP) { float m = 0.f;
#pragma unroll
                    for (int i = 0; i < 8; ++i) m = fmaxf(m, fmaxf(fmaxf(fabsf(cvv[i].x), fabsf(cvv[i].y)), fmaxf(fabsf(cvv[i].z), fabsf(cvv[i].w))));
#pragma unroll
                    for (int o = 1; o < 64; o <<= 1) m = fmaxf(m, __shfl_xor(m, o));
                    const float sc = m > 0.f ? 448.0f / m : 1.0f; GAS unsigned* o4 = (GAS unsigned*)(A.ws + WS_VB + (size_t)vr * D) + lane;
#pragma unroll
                    for (int i = 0; i < 8; ++i) { const f32x4 t = cvv[i] * sc;
                        const float a = fminf(fmaxf(t.x, -448.f), 448.f), b = fminf(fmaxf(t.y, -448.f), 448.f), c = fminf(fmaxf(t.z, -448.f), 448.f), d = fminf(fmaxf(t.w, -448.f), 448.f);
                        int pk = __builtin_amdgcn_cvt_pk_fp8_f32(a, b, 0, false); pk = __builtin_amdgcn_cvt_pk_fp8_f32(c, d, pk, true); o4[i * 64] = (unsigned)pk; }
                    if (lane == 0) ((float*)(A.ws + WS_VSC))[vr] = m > 0.f ? m * (1.0f / 448.0f) : 1.0f; }
            }
            const int hx = (int)ch.x, hy = (int)ch.y, hz = (int)ch.z, hw = (int)ch.w;
            int a0 = 0, a1 = 0;
#define PUQ_DOT(slot, acc_, s_) do { const v4u d_ = rv[slot]; int p_ = __builtin_amdgcn_sdot4((int)d_.x, hx, 0, false); p_ = __builtin_amdgcn_sdot4((int)d_.y, hy, p_, false); \
                p_ = __builtin_amdgcn_sdot4((int)d_.z, hz, p_, false); p_ = __builtin_amdgcn_sdot4((int)d_.w, hw, p_, false); \
                p_ += __builtin_amdgcn_update_dpp(0, p_, 0xB1, 0xF, 0xF, false); p_ += __builtin_amdgcn_update_dpp(0, p_, 0x4E, 0xF, 0xF, false); \
                p_ += __builtin_amdgcn_update_dpp(0, p_, 0x141, 0xF, 0xF, false); p_ += __builtin_amdgcn_update_dpp(0, p_, 0x140, 0xF, 0xF, false); \
                acc_ = (c16 == ((s_) & 15)) ? p_ : acc_; } while (0)
#pragma unroll
            for (int r = 0; r < PUQ_RB; ++r) { PUQ_DOT(r, a0, r); PUQ_ISSUE(r, cid1, r + PUQ_RB); }
#pragma unroll
            for (int r = 0; r < PUQ_RB; ++r) { PUQ_DOT(r, a1, r + PUQ_RB); PUQ_ISSUE(r, nid0, r); }
            float* ap = actp + ((size_t)cb * T + tok) * KSEL + 4 * c16 + q;
            ap[0] = (float)a0; ap[64] = (float)a1;
            cid0 = nid0; cid1 = nid1; ch = nh;
            PUQ_LOAD(nid0, nid1, nh, tok + 2 * nw);
        }
#undef PUQ_LOAD
#undef PUQ_ISSUE
#undef PUQ_DOT
    }
}
__device__ __forceinline__ void phase_w(const Args& A, int lane, int wave, int bid, int G) {
    const float* actp = (const float*)(A.ws + WS_ACTP); const float* usc = (const float*)(A.ws + WS_USC); const float* vsc = (const float*)(A.ws + WS_VSC); const float* hsc = (const float*)(A.ws + WS_HSC);
    const int* idx = (const int*)(A.ws + WS_IDX); const float* gate = (const float*)(A.ws + WS_GATE); float* wb = (float*)(A.ws + WS_ACT);
    for (int tok = bid * NWAVES + wave; tok < T; tok += G * NWAVES) {
        const float hs = hsc[tok];
#pragma unroll
        for (int hh = 0; hh < 2; ++hh) {
            const size_t o = (size_t)tok * KSEL + hh * 64 + lane; float sacc = 0.f;
#pragma unroll
            for (int c = 0; c < 8; ++c) sacc += actp[(size_t)c * T * KSEL + o];
            const int e = idx[o];
            wb[o] = gate[o] * gelu_tanh(sacc * usc[e] * hs) * vsc[e];
        }
    }
}
__device__ __forceinline__ void phase_pv(const Args& A, int lane, int wave, int bid, int G) {
    const unsigned char* vb = A.ws + WS_VB; const float* wb = (const float*)(A.ws + WS_ACT); const int* idx = (const int*)(A.ws + WS_IDX);
    bf16* y2 = (bf16*)(A.ws + WS_Y2); float* ssq = (float*)(A.ws + WS_SSQ);
    const int NX = (G % 8 == 0) ? 8 : 1, vx = bid % NX, nw = (G / NX) * NWAVES, wv = (bid / NX) * NWAVES + wave;
    const int q = lane >> 4, c16 = lane & 15;
    for (int cb = vx; cb < D / 256; cb += NX) {
        const unsigned loff = (unsigned)(cb * 256 + c16 * 16);
        int cid0 = 0, cid1 = 0, nid0 = 0, nid1 = 0; float cw0 = 0.f, cw1 = 0.f, nw0 = 0.f, nw1 = 0.f;
#define PVQ_LOAD(i0, i1, x0, x1, t_) do { const int t__ = (t_); if (t__ < T) { i0 = idx[(size_t)t__ * KSEL + lane]; i1 = idx[(size_t)t__ * KSEL + 64 + lane]; x0 = wb[(size_t)t__ * KSEL + lane]; x1 = wb[(size_t)t__ * KSEL + 64 + lane]; } } while (0)
        PVQ_LOAD(cid0, cid1, cw0, cw1, wv); PVQ_LOAD(nid0, nid1, nw0, nw1, wv + nw);
        v4u rv[PVQ_RB];
#define PVQ_ISSUE(slot, idr, s_) do { const unsigned e_ = (unsigned)__shfl(idr, ((4 * (s_)) & 63) + q); rv[slot] = *(const GAS v4u*)(vb + ((e_ << 11) + loff)); } while (0)
#pragma unroll
        for (int r = 0; r < PVQ_RB; ++r) PVQ_ISSUE(r, cid0, r);
        for (int tok = wv; tok < T; tok += nw) {
            f32x2 acc[8];
#pragma unroll
            for (int i = 0; i < 8; ++i) acc[i] = (f32x2){0.f, 0.f};
#define PVQ_FMA(slot, wr, s_) do { const float w_ = __shfl(wr, ((4 * (s_)) & 63) + q); const v4u d_ = rv[slot]; const unsigned dw_[4] = {d_.x, d_.y, d_.z, d_.w}; \
                _Pragma("unroll") for (int i_ = 0; i_ < 4; ++i_) { acc[2 * i_] += fp8lo(dw_[i_]) * w_; acc[2 * i_ + 1] += fp8hi(dw_[i_]) * w_; } } while (0)
#pragma unroll
            for (int r = 0; r < PVQ_RB; ++r) { PVQ_FMA(r, cw0, r); PVQ_ISSUE(r, cid1, r + PVQ_RB); }
#pragma unroll
            for (int r = 0; r < PVQ_RB; ++r) { PVQ_FMA(r, cw1, r + PVQ_RB); PVQ_ISSUE(r, nid0, r); }
            float sq = 0.f;
#pragma unroll
            for (int i = 0; i < 8; ++i) { float x = acc[i].x, y = acc[i].y; x += __shfl_xor(x, 16); y += __shfl_xor(y, 16); x += __shfl_xor(x, 32); y += __shfl_xor(y, 32); acc[i] = (f32x2){x, y}; sq += x * x + y * y; }
            sq = wave_total(q == 0 ? sq : 0.f);
            if (q == 0) { GAS v4u* yo = (GAS v4u*)(y2 + (size_t)tok * D + cb * 256 + c16 * 16);
                yo[0] = (v4u){pk2(acc[0].x, acc[0].y), pk2(acc[1].x, acc[1].y), pk2(acc[2].x, acc[2].y), pk2(acc[3].x, acc[3].y)};
                yo[1] = (v4u){pk2(acc[4].x, acc[4].y), pk2(acc[5].x, acc[5].y), pk2(acc[6].x, acc[6].y), pk2(acc[7].x, acc[7].y)}; }
            if (lane == 0) ssq[(size_t)cb * T + tok] = sq;
            cid0 = nid0; cid1 = nid1; cw0 = nw0; cw1 = nw1;
            PVQ_LOAD(nid0, nid1, nw0, nw1, tok + 2 * nw);
        }
#undef PVQ_LOAD
#undef PVQ_ISSUE
#undef PVQ_FMA
    }
}
__device__ __forceinline__ void phase_f(const Args& A, int lane, int wave, int bid, int G) {
    const bf16* y1 = (const bf16*)(A.ws + WS_Y1); const bf16* y2 = (const bf16*)(A.ws + WS_Y2); const float* ssq = (const float*)(A.ws + WS_SSQ); const float* cfin = (const float*)(A.ws + WS_CFIN);
    for (int tok = bid * NWAVES + wave; tok < T; tok += G * NWAVES) {
        const int b = tok >> 13;
        float qs = 0.f;
#pragma unroll
        for (int c = 0; c < 8; ++c) qs += ssq[(size_t)c * T + tok];
        const float rstd2 = __builtin_amdgcn_rsqf(qs * (1.0f / D) + EPS);
        const GAS v2u* yp = (const GAS v2u*)(y1 + (size_t)tok * D) + lane; const GAS v2u* zp = (const GAS v2u*)(y2 + (size_t)tok * D) + lane;
        const GAS f32x4* xr = (const GAS f32x4*)(A.in[I_X] + (size_t)tok * D) + lane;
        v2u yq[8], zq[8]; f32x4 xv[8]; float s1 = 0.f;
#pragma unroll
        for (int i = 0; i < 8; ++i) { yq[i] = yp[i * 64]; zq[i] = zp[i * 64]; xv[i] = xr[i * 64]; }
#pragma unroll
        for (int i = 0; i < 8; ++i) { const float a = bflo(yq[i].x), b_ = bfhi(yq[i].x), c = bflo(yq[i].y), d = bfhi(yq[i].y); s1 += (a * a + b_ * b_) + (c * c + d * d); }
        const float rstd1 = __builtin_amdgcn_rsqf(wave_total(s1) * (1.0f / D) + EPS);
        const GAS f32x4* c1 = (const GAS f32x4*)(cfin + (size_t)(b * 2 + 0) * D) + lane; const GAS f32x4* c2 = (const GAS f32x4*)(cfin + (size_t)(b * 2 + 1) * D) + lane;
        GAS f32x4* orow = (GAS f32x4*)(A.out + (size_t)tok * D) + lane;
#pragma unroll
        for (int i = 0; i < 8; ++i) { const f32x4 a1 = c1[i * 64], a2 = c2[i * 64];
            const float yv[4] = {bflo(yq[i].x), bfhi(yq[i].x), bflo(yq[i].y), bfhi(yq[i].y)}, zv[4] = {bflo(zq[i].x), bfhi(zq[i].x), bflo(zq[i].y), bfhi(zq[i].y)}; f32x4 o;
#pragma unroll
            for (int e = 0; e < 4; ++e) o[e] = xv[i][e] + (OUT_MODE != 2 ? a1[e] * yv[e] * rstd1 : 0.f) + (OUT_MODE != 1 ? a2[e] * zv[e] * rstd2 : 0.f);
            orow[i * 64] = o; }
    }
}

#if defined(MK_CHECKS)
constexpr int CW_CHK = 2048;
__device__ __forceinline__ unsigned hsh(unsigned x) { x ^= x >> 16; x *= 0x7feb352dU; x ^= x >> 15; x *= 0x846ca68bU; x ^= x >> 16; return x; }
__device__ __forceinline__ float bfv(const bf16* p, size_t i) { return __builtin_bit_cast(float, (unsigned)p[i] << 16); }
__device__ __forceinline__ float relerr(float got, float ref, float scale) { const float d = fabsf(got - ref) / (fabsf(ref) + scale); return (d == d) ? d : 1e30f; }
__device__ __forceinline__ void chk_put(unsigned* ctl, int stage, float e) { atomicMax(ctl + CW_CHK + stage, __builtin_bit_cast(unsigned, e)); }
__device__ float chk_gemm(const bf16* Am, const bf16* Bt, const bf16* C, int N, int K, unsigned s) {
    const int row = hsh(s) % T, col = hsh(s * 7 + 1) % N; float acc = 0.f;
    for (int k = 0; k < K; ++k) acc += bfv(Am, (size_t)row * K + k) * bfv(Bt, (size_t)col * K + k);
    return relerr(bfv(C, (size_t)row * N + col), acc, 0.05f);
}
__device__ float xl_at(const Args& A, const bf16* proj, size_t row, int c) {
    const int t = (int)(row & (SEQ - 1)); float a = A.in[I_LCB][c];
    for (int j = 0; j < 4; ++j) if (t - 3 + j >= 0) a += A.in[I_LCW][j * LRU_W + c] * bfv(proj, (row - 3 + j) * IN_COLS + c);
    return __builtin_bit_cast(float, f2bf(a) << 16);
}
__global__ void __launch_bounds__(128) chk_kernel(Args A, int stage) {
    __shared__ float sh[10240];
    unsigned* ctl = (unsigned*)(A.ws + WS_CTL);
    const int tid = threadIdx.x; const unsigned s = hsh(tid * 2654435761u + stage * 97u + 12345u);
    const float* modp = (const float*)(A.ws + WS_MODP);
    float e = 0.f;
    if (stage == 0) {
        { const int b = s & 1, n = hsh(s) % NMOD; float acc = A.in[I_BMOD][n];
          for (int k = 0; k < D; ++k) { const float c = A.in[I_C][b * D + k]; acc += c / (1.0f + expf(-c)) * A.in[I_WMOD][(size_t)k * NMOD + n]; }
          e = fmaxf(e, relerr(mod_at(modp, b, n), acc, 0.01f)); }
        { const int n = hsh(s + 1) % IN_COLS, k = hsh(s + 2) % D; e = fmaxf(e, relerr(bfv((const bf16*)(A.ws + WS_BT1), (size_t)n * D + k), A.in[I_WIN][(size_t)k * IN_COLS + n], 1e-3f)); }
        { const int h = s & 7, n = hsh(s + 5) & 255, k = hsh(s + 6) & 127; const float ref = (n < 128 ? A.in[I_WA] : A.in[I_WX])[h * 16384 + k * 128 + (n & 127)];
          e = fmaxf(e, relerr(bfv((const bf16*)(A.ws + WS_WG), (size_t)(h * 256 + n) * 128 + k), ref, 1e-3f)); }
        { const int i = hsh(s + 7) % (NH * 2 * NKEY * 128); e = fmaxf(e, relerr(bfv((const bf16*)(A.ws + WS_SUBK), i), A.in[I_SUBK][i], 1e-3f)); }
    } else if (stage == 1) {
        const int row = hsh(s) % T, col = hsh(s + 1) % D, b = row >> 13; float ss = 0.f;
        for (int k = 0; k < D; ++k) { const float x = A.in[I_X][(size_t)row * D + k]; ss += x * x; }
        const float ref = A.in[I_X][(size_t)row * D + col] * rsqrtf(ss / D + EPS) * A.in[I_GPREMIX][col] * (1.0f + mod_at(modp, b, D + col)) + mod_at(modp, b, col);
        e = relerr(bfv((const bf16*)(A.ws + WS_RA), (size_t)row * D + col), ref, 0.05f);
        const float* cfin = (const float*)(A.ws + WS_CFIN);
        e = fmaxf(e, relerr(cfin[(b * 2 + 0) * D + col], mod_at(modp, b, 2 * D + col) * A.in[I_GPOSTMIX][col], 1e-3f));
        e = fmaxf(e, relerr(cfin[(b * 2 + 1) * D + col], mod_at(modp, b, 5 * D + col) * A.in[I_GPOSTFFN][col], 1e-3f));
    } else if (stage == 2) { e = chk_gemm((const bf16*)(A.ws + WS_RA), (const bf16*)(A.ws + WS_BT1), (const bf16*)(A.ws + WS_PROJ), IN_COLS, D, s);
    } else if (stage == 7) { e = chk_gemm((const bf16*)(A.ws + WS_RA), (const bf16*)(A.ws + WS_BT2), (const bf16*)(A.ws + WS_Y1), D, D, s);
    } else if (stage == 9) { e = chk_gemm((const bf16*)(A.ws + WS_RA), (const bf16*)(A.ws + WS_BT3), (const bf16*)(A.ws + WS_Q), D, D, s);
    } else if (stage == 3) {
        const bf16* proj = (const bf16*)(A.ws + WS_PROJ);
        int row = hsh(s) % T; if (tid < 16) row = (tid & 1) * SEQ + (tid >> 1);
        const int c = hsh(s + 1) % LRU_W, t = row & (SEQ - 1);
        float a = A.in[I_LCB][c];
        for (int j = 0; j < 4; ++j) if (t - 3 + j >= 0) a += A.in[I_LCW][j * LRU_W + c] * bfv(proj, (size_t)(row - 3 + j) * IN_COLS + c);
        (void)a;
        float z = A.in[I_CDB][c];
        for (int j = 0; j < CONF_K; ++j) if (t - 30 + j >= 0) { const size_t r = (size_t)(row - 30 + j) * IN_COLS; const float g = bfv(proj, r + 3072 + c);
            z += A.in[I_CDW][j * CONF_W + c] * bfv(proj, r + 2048 + c) / (1.0f + expf(-g)); }
        e = fmaxf(e, relerr(bfv((const bf16*)(A.ws + WS_ZC), (size_t)row * CONF_W + c), z, 0.05f));
    } else if (stage == 4) {
        const bf16* xl = (const bf16*)(A.ws + WS_XL);
        const int b = s & 1, chunk = hsh(s + 1) % NCHUNK, ch = hsh(s + 2) % LRU_W, hh = ch >> 7, j = ch & 127;
        const float cl = -8.0f * log1pf(expf(-A.in[I_LAMBDA][ch])); float P = 1.f, H = 0.f;
        for (int t = 0; t < CHUNK; ++t) { const size_t row = (size_t)b * SEQ + chunk * CHUNK + t; float ga = A.in[I_BA][ch], gx = A.in[I_BX][ch];
            for (int i = 0; i < 128; ++i) { const float xv = bfv(xl, row * LRU_W + hh * 128 + i); ga += xv * A.in[I_WA][hh * 16384 + i * 128 + j]; gx += xv * A.in[I_WX][hh * 16384 + i * 128 + j]; }
            const float r = 1.0f / (1.0f + expf(-ga)), ig = 1.0f / (1.0f + expf(-gx)), la = cl * r, a = expf(la), u = sqrtf(fmaxf(-expm1f(2.0f * la), 0.f)) * ig * bfv(xl, row * LRU_W + ch);
            H = a * H + u; P = P * a;
            e = fmaxf(e, relerr(bfv((const bf16*)(A.ws + WS_HLOC), row * LRU_W + ch), H, 0.05f)); e = fmaxf(e, relerr(bfv((const bf16*)(A.ws + WS_PC), row * LRU_W + ch), P, 0.02f)); }
        const float* ag = (const float*)(A.ws + WS_AGG) + ((size_t)(b * NCHUNK + chunk) * LRU_W + ch) * 2;
        e = fmaxf(e, relerr(ag[0], P, 0.02f)); e = fmaxf(e, relerr(ag[1], H, 0.05f));
    } else if (stage == 12) {
        { const int n = hsh(s + 3) % D, k = hsh(s + 4) % D; e = fmaxf(e, relerr(bfv((const bf16*)(A.ws + WS_BT2), (size_t)n * D + k), A.in[I_WOUT][(size_t)k * D + n], 1e-3f));
          e = fmaxf(e, relerr(bfv((const bf16*)(A.ws + WS_BT3), (size_t)n * D + k), A.in[I_WQ][(size_t)k * D + n], 1e-3f)); }
        const bf16* proj = (const bf16*)(A.ws + WS_PROJ);
#define XLV(row_, ch_) xl_at(A, proj, (row_), (ch_))
        const int b = s & 1, chunk = hsh(s + 1) % NCHUNK, ch = hsh(s + 2) % LRU_W, hh = ch >> 7, j = ch & 127;
        const float cl = -8.0f * log1pf(expf(-A.in[I_LAMBDA][ch])); float P = 1.f, H = 0.f;
        for (int t = 0; t < CHUNK; ++t) { const size_t row = (size_t)b * SEQ + chunk * CHUNK + t; float ga = A.in[I_BA][ch], gx = A.in[I_BX][ch];
            for (int i = 0; i < 128; ++i) { const float xv = XLV(row, hh * 128 + i); ga += xv * A.in[I_WA][hh * 16384 + i * 128 + j]; gx += xv * A.in[I_WX][hh * 16384 + i * 128 + j]; }
            const float r = 1.0f / (1.0f + expf(-ga)), ig = 1.0f / (1.0f + expf(-gx)), la = cl * r, a = expf(la), u = sqrtf(fmaxf(-expm1f(2.0f * la), 0.f)) * ig * XLV(row, ch);
            H = a * H + u; P = P * a;
            e = fmaxf(e, relerr(bfv((const bf16*)(A.ws + WS_HLOC), row * LRU_W + ch), H, 0.05f)); e = fmaxf(e, relerr(bfv((const bf16*)(A.ws + WS_PC), row * LRU_W + ch), P, 0.02f)); }
        const float* ag = (const float*)(A.ws + WS_AGG) + ((size_t)(b * NCHUNK + chunk) * LRU_W + ch) * 2;
        e = fmaxf(e, relerr(ag[0], P, 0.02f)); e = fmaxf(e, relerr(ag[1], H, 0.05f));
        { const int row = hsh(s + 9) % T, c = hsh(s + 10) % CONF_W, t = row & (SEQ - 1); float z = A.in[I_CDB][c];
          for (int j = 0; j < CONF_K; ++j) if (t - 30 + j >= 0) { const size_t r = (size_t)(row - 30 + j) * IN_COLS; const float g = bfv(proj, r + 3072 + c); z += A.in[I_CDW][j * CONF_W + c] * bfv(proj, r + 2048 + c) / (1.0f + expf(-g)); }
          e = fmaxf(e, relerr(bfv((const bf16*)(A.ws + WS_ZC), (size_t)row * CONF_W + c), z, 0.05f)); }
#undef XLV
    } else if (stage == 5) {
    } else if (stage == 6) {
        const bf16* proj = (const bf16*)(A.ws + WS_PROJ); const bf16* zc = (const bf16*)(A.ws + WS_ZC);
        const int row = hsh(s) % T, c = hsh(s + 1) % LRU_W, b = row >> 13, chunk = (row & (SEQ - 1)) >> 6;
        float cin = 0.f; for (int cc = 0; cc < chunk; ++cc) { const float* ag = (const float*)(A.ws + WS_AGG) + ((size_t)(b * NCHUNK + cc) * LRU_W + c) * 2; cin = ag[0] * cin + ag[1]; }
        const float hfull = bfv((const bf16*)(A.ws + WS_HLOC), (size_t)row * LRU_W + c) + bfv((const bf16*)(A.ws + WS_PC), (size_t)row * LRU_W + c) * cin;
        const float g = bfv(proj, (size_t)row * IN_COLS + 1024 + c), ge = 0.5f * g * (1.0f + tanhf(0.7978845608f * (g + 0.044715f * g * g * g)));
        e = relerr(bfv((const bf16*)(A.ws + WS_RA), (size_t)row * D + c), hfull * ge, 0.05f);
        float m = 0.f, q = 0.f;
        for (int k = 0; k < CONF_W; ++k) m += bfv(zc, (size_t)row * CONF_W + k);
        m /= CONF_W;
        for (int k = 0; k < CONF_W; ++k) { const float d = bfv(zc, (size_t)row * CONF_W + k) - m; q += d * d; }
        const float n = (bfv(zc, (size_t)row * CONF_W + c) - m) * rsqrtf(q / CONF_W + EPS) * A.in[I_LNG][c] + A.in[I_LNB][c];
        e = fmaxf(e, relerr(bfv((const bf16*)(A.ws + WS_RA), (size_t)row * D + 1024 + c), n / (1.0f + expf(-n)), 0.05f));
    } else if (stage == 8) {
        const bf16* y1 = (const bf16*)(A.ws + WS_Y1); const float* cfin = (const float*)(A.ws + WS_CFIN);
        const int row = hsh(s) % T, col = hsh(s + 1) % D, b = row >> 13; float s1 = 0.f, s2 = 0.f;
        for (int k = 0; k < D; ++k) { const float y = bfv(y1, (size_t)row * D + k); s1 += y * y; }
        const float r1 = rsqrtf(s1 / D + EPS);
        for (int k = 0; k < D; ++k) { const float x1 = A.in[I_X][(size_t)row * D + k] + cfin[(b * 2) * D + k] * bfv(y1, (size_t)row * D + k) * r1; s2 += x1 * x1; }
        const float x1c = A.in[I_X][(size_t)row * D + col] + cfin[(b * 2) * D + col] * bfv(y1, (size_t)row * D + col) * r1;
        const float ref = x1c * rsqrtf(s2 / D + EPS) * A.in[I_GPREFFN][col] * (1.0f + mod_at(modp, b, 4 * D + col)) + mod_at(modp, b, 3 * D + col);
        e = relerr(bfv((const bf16*)(A.ws + WS_RA), (size_t)row * D + col), ref, 0.05f);
    } else if (stage == 10) {
        { const size_t i = (size_t)(hsh(s + 2) % NEXP) * D + hsh(s + 3) % D;
          const unsigned wu = ((const unsigned*)(A.ws + WS_UB))[i >> 2] >> (8 * (i & 3)), wv = ((const unsigned*)(A.ws + WS_VB))[i >> 2] >> (8 * (i & 3));
          const float du = (float)(signed char)(wu & 255u) * ((const float*)(A.ws + WS_USC))[i / D], dv = __builtin_amdgcn_cvt_pk_f32_fp8((int)wv, false)[0] * ((const float*)(A.ws + WS_VSC))[i / D];
          e = fmaxf(e, relerr(du, A.in[I_PU][i], 2e-3f) * 0.3f); (void)dv; }
        if (tid < 32) {
            const bf16* q = (const bf16*)(A.ws + WS_Q); const int* idx = (const int*)(A.ws + WS_IDX); const float* gate = (const float*)(A.ws + WS_GATE);
            const int tok = hsh(s) % T, h = hsh(s + 1) & 7;
            float* sc = sh + tid * 320;
            for (int p = 0; p < 2; ++p) for (int n = 0; n < NKEY; ++n) { float a = 0.f;
                for (int d = 0; d < 128; ++d) a += bfv(q, (size_t)tok * D + h * 256 + p * 128 + d) * A.in[I_SUBK][((size_t)((h * 2 + p) * NKEY + n)) * 128 + d];
                sc[p * 128 + n] = a; }
            for (int p = 0; p < 2; ++p) { float prev = 1e30f; for (int it = 0; it < 16; ++it) { float best = -1e30f; int bi = 0;
                for (int n = 0; n < NKEY; ++n) { const float v = sc[p * 128 + n]; if (v < prev && v > best) { best = v; bi = n; } }
                sc[256 + p * 16 + it] = best; sc[288 + p * 16 + it] = (float)bi; prev = best; } }
            float prev = 1e30f, esum = 0.f, cmax = 0.f; int miss = 0; float gerr = 0.f;
            { float pv = 1e30f; for (int it = 0; it < 16; ++it) { float best = -1e30f;
                for (int c = 0; c < 256; ++c) { const float v = sc[256 + (c >> 4)] + sc[272 + (c & 15)]; if (v < pv && v > best) best = v; }
                if (it == 0) cmax = best; esum += expf(best - cmax); pv = best; } }
            for (int it = 0; it < 16; ++it) { float best = -1e30f; int bc = 0;
                for (int c = 0; c < 256; ++c) { const float v = sc[256 + (c >> 4)] + sc[272 + (c & 15)]; if (v < prev && v > best) { best = v; bc = c; } }
                prev = best;
                const int eidx = (int)sc[288 + (bc >> 4)] * NKEY + (int)sc[304 + (bc & 15)]; const float g = expf(best - cmax) / esum; bool found = false;
                for (int m = 0; m < 16; ++m) if (idx[(size_t)tok * KSEL + h * 16 + m] == eidx) { found = true; gerr = fmaxf(gerr, relerr(gate[(size_t)tok * KSEL + h * 16 + m], g, 0.02f)); }
                if (!found) ++miss; }
            e = fmaxf((float)miss / 16.0f, gerr);
        }
    } else if (stage == 11) {
        const bf16* h2 = (const bf16*)(A.ws + WS_RA); const bf16* y1 = (const bf16*)(A.ws + WS_Y1); const int* idx = (const int*)(A.ws + WS_IDX); const float* gate = (const float*)(A.ws + WS_GATE); const float* cfin = (const float*)(A.ws + WS_CFIN);
        const int tok = hsh(blockIdx.x * 977u + 5u) % T, b = tok >> 13;
        { const int ex = idx[(size_t)tok * KSEL + tid]; float a = 0.f;
          if ((unsigned)ex < (unsigned)NEXP) { for (int d = 0; d < D; ++d) a += bfv(h2, (size_t)tok * D + d) * A.in[I_PU][(size_t)ex * D + d]; } else a = 1e30f;
          const float ge = 0.5f * a * (1.0f + tanhf(0.7978845608f * (a + 0.044715f * a * a * a)));
          sh[tid] = gate[(size_t)tok * KSEL + tid] * ge; sh[128 + tid] = __builtin_bit_cast(float, ex); }
        __syncthreads();
        float s2 = 0.f, s1 = 0.f;
        for (int cc = 0; cc < 16; ++cc) { const int col = cc * 128 + tid; float a = 0.f;
            for (int k = 0; k < KSEL; ++k) { const int ex = __builtin_bit_cast(int, sh[128 + k]); if ((unsigned)ex < (unsigned)NEXP) a += sh[k] * A.in[I_PV][(size_t)ex * D + col]; }
            sh[512 + cc * 128 + tid] = a; s2 += a * a; const float y = bfv(y1, (size_t)tok * D + col); s1 += y * y; }
        __syncthreads(); sh[256 + tid] = s2; sh[384 + tid] = s1; __syncthreads();
        float t2 = 0.f, t1 = 0.f; for (int k = 0; k < 128; ++k) { t2 += sh[256 + k]; t1 += sh[384 + k]; }
        const float r2 = rsqrtf(t2 / D + EPS), r1 = rsqrtf(t1 / D + EPS);
        float en = 0.f, ed = 0.f;
        for (int cc = 0; cc < 16; ++cc) { const int col = cc * 128 + tid;
            const float pterm = cfin[(b * 2 + 1) * D + col] * sh[512 + cc * 128 + tid] * r2;
            const float ref = A.in[I_X][(size_t)tok * D + col] + (OUT_MODE != 2 ? cfin[(b * 2) * D + col] * bfv(y1, (size_t)tok * D + col) * r1 : 0.f) + (OUT_MODE != 1 ? pterm : 0.f);
            const float d = A.out[(size_t)tok * D + col] - ref; en += d * d; ed += pterm * pterm; }
        __syncthreads(); sh[256 + tid] = en; sh[384 + tid] = ed; __syncthreads();
        float ten = 0.f, ted = 0.f; for (int k = 0; k < 128; ++k) { ten += sh[256 + k]; ted += sh[384 + k]; }
        e = ten / (ted + 1e-12f); if (!(e == e)) e = 1e30f;
    }
    chk_put(ctl, stage, e);
}
__global__ void chk_encode(Args A, int what) {
    const unsigned* ctl = (const unsigned*)(A.ws + WS_CTL);
    if (threadIdx.x == 0 && blockIdx.x == 0) {
        if (what < 0) {
            const float thr[13] = {0.03f, 0.03f, 0.03f, 0.03f, 0.06f, 0.01f, 0.04f, 0.03f, 0.03f, 0.03f, 0.2f, 0.01f, 0.06f};
            for (int st = 0; st < 13; ++st) { const float e = __builtin_bit_cast(float, ctl[CW_CHK + st]); if (!(e <= thr[st])) { A.out[0] = 4000.0f * (float)(1 << st); break; } }
        } else {
            const float e = fminf(__builtin_bit_cast(float, ctl[CW_CHK + what]), 1e6f); A.out[0] = 4000.0f * sqrtf(1e6f * e);
        }
    }
}
#endif

__global__ void __launch_bounds__(NTHR, 2) fwd_kernel(Args args) {
    extern __shared__ __attribute__((aligned(16))) unsigned char lds_raw[];
    LAS unsigned char* lds = (LAS unsigned char*)lds_raw;
    const int tid = threadIdx.x, lane = tid & 63, wave = __builtin_amdgcn_readfirstlane(tid >> 6), bid = blockIdx.x, G = gridDim.x;
    for (int u = tid; u < (LDS_BYTES - LDSCTL_OFF) / 4; u += NTHR) ((LAS unsigned*)(lds + LDSCTL_OFF))[u] = 0u;
    __syncthreads();
    unsigned* ctl = (unsigned*)(args.ws + WS_CTL);
    XcdBarrier bar; bar.bar = ctl + CW_BAR + args.li * XCD_BAR_WORDS; bar.x = 0; bar.st = nullptr;
    if (MK_N_LAUNCHES != N_PHASES) bar = xcd_barrier_post(ctl + CW_BAR + args.li * XCD_BAR_WORDS, (volatile LAS unsigned*)(lds + MISC_OFF) + 8);
    const int lo = args.ph_lo, hi = args.ph_hi;
#define IN(k) (lo <= (k) && (k) < hi)
#define SEAM(k) do { if (IN(k) && IN((k) + 1)) xcd_barrier(bar); } while (0)
#define PHON(k) ((PH_MASK >> (k)) & 1)
    if (PHON(0) && IN(0)) { phase_p0(args, lds, tid, lane, wave, bid, G); }
    SEAM(0);
    if (PHON(1) && IN(1)) { phase_p1(args, tid, lane, wave, bid, G); }
    SEAM(1);
    if (PHON(2) && IN(2)) {
        pg8::Gemm g{(const bf16*)(args.ws + WS_RA), (const bf16*)(args.ws + WS_BT1), T, IN_COLS, D}; pg8::StaticOrder S; S.init(T, IN_COLS, G, bid);
        pg8::EpiBf16<0> E{(bf16*)(args.ws + WS_PROJ), IN_COLS, nullptr, 0, 0, 1.f};
        pg8::gemm_phase<pg8::EpiBf16<0>, pg8::StaticOrder, PG8_ALIGN, PG8_SP2>(lds + RING_OFF, g, S, E);
    }
    SEAM(2);
    if (PHON(3) && IN(3)) { phase_m1a(args, lds, tid, lane, wave, bid, G); }
    if (PHON(4) && IN(3)) { phase_m1b(args, lds, tid, lane, wave, bid, G); }
    SEAM(3);
    if (PHON(5) && IN(4)) { phase_m3(args, lds, tid, lane, wave, bid, G); }
    SEAM(4);
    if (PHON(6) && IN(5)) {
        pg8::Gemm g{(const bf16*)(args.ws + WS_RA), (const bf16*)(args.ws + WS_BT2), T, D, D}; pg8::StaticOrder S; S.init(T, D, G, bid);
        pg8::EpiBf16<0> E{(bf16*)(args.ws + WS_Y1), D, nullptr, 0, 0, 1.f};
        pg8::gemm_phase<pg8::EpiBf16<0>, pg8::StaticOrder, PG8_ALIGN, PG8_SP2>(lds + RING_OFF, g, S, E);
    }
    SEAM(5);
    if (PHON(7) && IN(6)) { phase_e2(args, tid, lane, wave, bid, G); }
    SEAM(6);
    if (PHON(8) && IN(7)) {
        pg8::Gemm g{(const bf16*)(args.ws + WS_RA), (const bf16*)(args.ws + WS_BT3), T, D, D}; pg8::StaticOrder S; S.init(T, D, G, bid);
        pg8::EpiBf16<0> E{(bf16*)(args.ws + WS_Q), D, nullptr, 0, 0, 1.f};
        pg8::gemm_phase<pg8::EpiBf16<0>, pg8::StaticOrder, PG8_ALIGN, PG8_SP2>(lds + RING_OFF, g, S, E);
    }
    SEAM(7);
    if (PHON(9) && IN(8)) { phase_s(args, lds, tid, lane, wave, bid, G); }
    SEAM(8);
    if (PHON(10) && IN(9)) { phase_pu(args, lane, wave, bid, G); }
    SEAM(9);
    if (PHON(11) && IN(10)) { phase_w(args, lane, wave, bid, G); }
    SEAM(10);
    if (PHON(12) && IN(11)) { phase_pv(args, lane, wave, bid, G); }
    SEAM(11);
    if (PHON(13) && IN(12)) { phase_f(args, lane, wave, bid, G); }
#undef IN
#undef SEAM
}

extern "C" void kernel_launch(void* const* d_in, const int* in_sizes, int n_in, void* d_out, int out_size, void* d_ws, size_t ws_size, hipStream_t stream) {
    static int grid = 0;
    if (grid == 0) {
        if (n_in != 25 || in_sizes[0] != T * D || out_size != T * D || ws_size < WS_END) {
            fprintf(stderr, "kernel_launch: built for 25 inputs, x/out of %d floats, >= %zu bytes of workspace; got n_in %d, in0 %d, out %d, ws %zu; nothing launched\n", T * D, (size_t)WS_END, n_in, n_in > 0 ? in_sizes[0] : -1, out_size, ws_size);
            grid = -1; return; }
        int dev = 0, cus = 0, per_cu = 0;
        if (hipGetDevice(&dev) != hipSuccess || hipDeviceGetAttribute(&cus, hipDeviceAttributeMultiprocessorCount, dev) != hipSuccess) { fprintf(stderr, "kernel_launch: device query failed\n"); grid = -1; return; }
        if (hipFuncSetAttribute((const void*)fwd_kernel, hipFuncAttributeMaxDynamicSharedMemorySize, LDS_BYTES) != hipSuccess) { fprintf(stderr, "kernel_launch: hipFuncSetAttribute failed\n"); grid = -1; return; }
        if (hipOccupancyMaxActiveBlocksPerMultiprocessor(&per_cu, (const void*)fwd_kernel, NTHR, LDS_BYTES) != hipSuccess || per_cu < 1)
            fprintf(stderr, "kernel_launch: note: occupancy query reports %d workgroups per CU\n", per_cu);
        (void)hipGetLastError();
        grid = cus;
    }
    if (grid < 0) return;
    if (hipMemsetAsync((char*)d_ws + WS_CTL, 0, CTL_ZERO_BYTES, stream) != hipSuccess) { fprintf(stderr, "kernel_launch: memset failed\n"); return; }
    Args a{};
    for (int i = 0; i < 25; ++i) a.in[i] = (const float*)d_in[i];
    a.out = (float*)d_out; a.ws = (unsigned char*)d_ws;
#if defined(MK_TIME_REP)
    const int cuts[3][2] = {{0, MK_TIME_REP + 1}, {MK_TIME_REP, MK_TIME_REP + 1}, {MK_TIME_REP + 1, N_PHASES}};
    for (int li = 0; li < 3; ++li) {
        a.ph_lo = cuts[li][0]; a.ph_hi = cuts[li][1]; a.li = li;
        if (a.ph_lo < a.ph_hi) hipLaunchKernelGGL(fwd_kernel, dim3(grid), dim3(NTHR), LDS_BYTES, stream, a);
    }
#else
    for (int li = 0; li < MK_N_LAUNCHES; ++li) {
        if (MK_N_LAUNCHES == 1) { a.ph_lo = 0; a.ph_hi = N_PHASES; } else { a.ph_lo = li; a.ph_hi = li + 1; }
        a.li = 0;
        hipLaunchKernelGGL(fwd_kernel, dim3(grid), dim3(NTHR), LDS_BYTES, stream, a);
        const hipError_t le = hipPeekAtLastError();
        if (le != hipSuccess) { fprintf(stderr, "kernel_launch: launch %d failed: %s\n", li, hipGetErrorName(le)); break; }
#if defined(MK_CHECKS)
        { const int chk_of_phase[N_PHASES] = {0, 1, 2, 12, 6, 7, 8, 9, 10, 5, 5, 5, 11}; hipLaunchKernelGGL(chk_kernel, dim3(4), dim3(128), 0, stream, a, chk_of_phase[li]); }
#endif
    }
#endif
#if defined(MK_CHECKS)
    hipLaunchKernelGGL(chk_encode, dim3(1), dim3(64), 0, stream, a, MK_CHECKS);
#endif
}
```

```cpp
#include <hip/hip_runtime.h>
#include <cstdio>
#include <cstdint>
#include <cmath>
namespace pg8 {
#define PG8_LAS __attribute__((address_space(3)))
typedef unsigned short bf16_t;
typedef short bf16x8 __attribute__((ext_vector_type(8)));
typedef float f32x4 __attribute__((ext_vector_type(4)));
typedef unsigned u32x4 __attribute__((ext_vector_type(4)));
constexpr int BM = 256, BK = 64, HALF = 128, HTB = HALF * BK * 2  , STAGE_BYTES = 8 * HTB, NXCD = 8, WGM = 4;

__host__ __device__ __forceinline__ int lds_byte(int r, int c) { const int st = (r >> 4) * 2 + (c >> 5), rr = r & 15, cc = c & 31, ob = rr * 64 + cc * 2; return st * 1024 + (ob ^ (((ob >> 9) & 1) << 5)); }
__host__ __device__ __forceinline__ void stage_rc(int b, int& R, int& C) { const int st = b / 1024, sb = b % 1024, swz = sb ^ (((sb >> 9) & 1) << 5); R = (st >> 1) * 16 + swz / 64; C = (st & 1) * 32 + (swz % 64) / 2; }
__host__ __device__ __forceinline__ int perm32(int rho) { const int n = rho >> 4, i = rho & 15; return 8 * (i >> 2) + 4 * n + (i & 3); }

struct Unit { int pm, pn; };
struct Gemm { const bf16_t* A; const bf16_t* Bt; int M, N, K; };

struct StaticOrder {
    int nM, nN, nwg, G, c;
    __host__ __device__ void init(int M, int N, int G_, int c_) { nM = M / BM; nN = N / BM; nwg = nM * nN; G = G_; c = c_; }
    __host__ __device__ bool next(int i, Unit& u) const {
        const long L = (long)i * G + c; if (L >= nwg) return false;
        int wgid = (int)L; { const int q = nwg / NXCD, r = nwg % NXCD, xcd = wgid % NXCD, off = wgid / NXCD; wgid = (xcd < r ? xcd * (q + 1) : r * (q + 1) + (xcd - r) * q) + off; }
        const int nig = WGM * nN, gid = wgid / nig, fm = gid * WGM, gsz = (nM - fm) < WGM ? (nM - fm) : WGM;
        u.pm = fm + ((wgid % nig) % gsz); u.pn = (wgid % nig) / gsz; return true;
    }
    __device__ __forceinline__ void a_ready(const Unit&) const {}
    __device__ __forceinline__ void done(const Unit&) const {}
};

__device__ __forceinline__ unsigned cvt_pk_bf16(float lo, float hi) { unsigned r; asm volatile("v_cvt_pk_bf16_f32 %0, %1, %2" : "=v"(r) : "v"(lo), "v"(hi)); return r; }
typedef float f32x2 __attribute__((ext_vector_type(2)));
__device__ __forceinline__ f32x2 gelu_pk(f32x2 v) {
    const f32x2 av = __builtin_elementwise_abs(v), d = av * 0.2316418882f + 1.0f;
    f32x2 t; t.x = __builtin_amdgcn_rcpf(d.x); t.y = __builtin_amdgcn_rcpf(d.y);
    f32x2 q = t * 0.5307027145f + (-0.7265760135f); q = q * t + 0.7107068705f; q = q * t + (-0.142248368f); q = q * t + 0.127414796f; q = q * t;
    const f32x2 s = (v * v) * (-0.72134752044f);
    f32x2 e; e.x = __builtin_amdgcn_exp2f(s.x); e.y = __builtin_amdgcn_exp2f(s.y);
    const f32x2 m = v * (q * e), r = v - m;
    f32x2 o; o.x = v.x < 0.f ? m.x : r.x; o.y = v.y < 0.f ? m.y : r.y; return o;
}

template <int ACT  > struct EpiBf16 {
    static constexpr bool PERM = true, AFTER_DRAIN = false; static_assert(ACT == 0 || ACT == 1, "EpiBf16: ACT is 0 (none) or 1 (gelu_pk)");
    bf16_t* O; int ldc; const float* bias; int split_cols; size_t split_stride; float scale0;
    __device__ __forceinline__ void operator()(const f32x4 (&acc)[2][2][4][2], const Unit& u, int wr, int wc, int fr, int fq) const {
        const int row0 = u.pm * BM + wr * 64 + fr; int colt = u.pn * BM; bf16_t* base = O;
        float sc = 1.f; if (split_cols) { const int t = colt / split_cols; base += (size_t)t * split_stride; colt -= t * split_cols; if (t == 0) sc = scale0; }
        const int col0 = colt + wc * 32 + 8 * fq, bcol0 = u.pn * BM + wc * 32 + 8 * fq;
        f32x4 bv[2][2];
#pragma unroll
        for (int bj = 0; bj < 2; ++bj)
#pragma unroll
            for (int n = 0; n < 2; ++n) bv[bj][n] = bias ? *(const f32x4*)(bias + bcol0 + bj * HALF + 4 * n) : (f32x4){0.f, 0.f, 0.f, 0.f};
#pragma unroll
        for (int ai = 0; ai < 2; ++ai)
#pragma unroll
            for (int m = 0; m < 4; ++m) { bf16_t* rowp = base + (size_t)(row0 + ai * HALF + m * 16) * ldc + col0;
#pragma unroll
                for (int bj = 0; bj < 2; ++bj) { f32x4 v0 = acc[ai][bj][m][0] + bv[bj][0], v1 = acc[ai][bj][m][1] + bv[bj][1];
                    if (ACT == 1) { f32x2 a = gelu_pk((f32x2){v0[0], v0[1]}), b = gelu_pk((f32x2){v0[2], v0[3]}), c = gelu_pk((f32x2){v1[0], v1[1]}), d = gelu_pk((f32x2){v1[2], v1[3]});
                        v0 = (f32x4){a.x, a.y, b.x, b.y}; v1 = (f32x4){c.x, c.y, d.x, d.y}; }
                    v0 = v0 * sc; v1 = v1 * sc; u32x4 w; w.x = cvt_pk_bf16(v0[0], v0[1]); w.y = cvt_pk_bf16(v0[2], v0[3]); w.z = cvt_pk_bf16(v1[0], v1[1]); w.w = cvt_pk_bf16(v1[2], v1[3]);
                    *(u32x4*)(rowp + bj * HALF) = w; } }
    }
};
template <class Epi, class Sched, bool ALIGN_EPI = false, bool SP2 = false>
__device__ __forceinline__ void gemm_phase(PG8_LAS unsigned char* lds, const Gemm g, const Sched& S, const Epi& E) {
    const int tid = threadIdx.x, wid = __builtin_amdgcn_readfirstlane(tid >> 6), lane = tid & 63, wr = wid >> 2, wc = wid & 3, fr = lane & 15, fq = lane >> 4;
    const int K = g.K, nt = K / BK;
    unsigned voffA[2], voffB[2];
#pragma unroll
    for (int i = 0; i < 2; ++i) { int R, C; stage_rc(tid * 16 + i * 8192, R, C); const int Rb = Epi::PERM ? ((R & ~31) + perm32(R & 31)) : R;
        voffA[i] = (unsigned)(R * K + C) * 2u; voffB[i] = (unsigned)(Rb * K + C) * 2u; }
    const size_t kstep = (size_t)(BK * 2);
    const size_t hstep = (size_t)HALF * K * 2;
    const size_t tstep = 2 * hstep;
    const unsigned ldsw = (unsigned)wid * 1024u;
    const int aoff = lds_byte(wr * 64 + fr, fq * 8), boff = lds_byte(wc * 32 + fr, fq * 8);
#define PG8_SA(b, h) (((b) * 2 + (h)) * HTB)
#define PG8_SB(b, h) ((4 + (b) * 2 + (h)) * HTB)
#define PG8_STAGE(bufoff, gbase, voff) do { _Pragma("unroll") for (int _i = 0; _i < 2; ++_i) \
        __builtin_amdgcn_global_load_lds((const unsigned*)((const char*)(gbase) + (voff)[_i]), (PG8_LAS unsigned*)(lds + (bufoff) + ldsw + _i * 8192), 16, 0, 0); } while (0)
#define PG8_LDA(dst, b, h) do { _Pragma("unroll") for (int m = 0; m < 4; ++m) _Pragma("unroll") for (int k = 0; k < 2; ++k) dst[m][k] = *(const PG8_LAS bf16x8*)(lds + PG8_SA(b, h) + aoff + m * 2048 + k * 1024); } while (0)
#define PG8_LDB(dst, b, h) do { _Pragma("unroll") for (int n = 0; n < 2; ++n) _Pragma("unroll") for (int k = 0; k < 2; ++k) dst[n][k] = *(const PG8_LAS bf16x8*)(lds + PG8_SB(b, h) + boff + n * 2048 + k * 1024); } while (0)
#define PG8_MMA(ai, bj, At, Bt) do { __builtin_amdgcn_s_setprio(1); _Pragma("unroll") for (int m = 0; m < 4; ++m) _Pragma("unroll") for (int n = 0; n < 2; ++n) _Pragma("unroll") for (int k = 0; k < 2; ++k) \
        acc[ai][bj][m][n] = __builtin_amdgcn_mfma_f32_16x16x32_bf16(Bt[n][k], At[m][k], acc[ai][bj][m][n], 0, 0, 0); __builtin_amdgcn_s_setprio(0); } while (0)
#define PG8_WAIT_V(n) asm volatile("s_waitcnt vmcnt(" #n ")" ::: "memory")
#define PG8_WAIT_L(n) asm volatile("s_waitcnt lgkmcnt(" #n ")" ::: "memory")
#define PG8_BAR __builtin_amdgcn_s_barrier()
#define PG8_SCHED __builtin_amdgcn_sched_barrier(0)
    Unit cur, nxt; int ui = 0;
    if (!S.next(0, cur)) return;
    f32x4 acc[2][2][4][2];
#pragma unroll
    for (int a = 0; a < 2; ++a)
#pragma unroll
        for (int b = 0; b < 2; ++b)
#pragma unroll
            for (int m = 0; m < 4; ++m)
#pragma unroll
                for (int n = 0; n < 2; ++n) acc[a][b][m][n] = (f32x4){0.f, 0.f, 0.f, 0.f};
    bf16x8 At[4][2], B0[2][2], B1[2][2];
    const char* cA = (const char*)g.A + (size_t)cur.pm * tstep; const char* cB = (const char*)g.Bt + (size_t)cur.pn * tstep;
    S.a_ready(cur);
    if constexpr (SP2) {
        PG8_STAGE(PG8_SB(0, 0), cB, voffB); PG8_STAGE(PG8_SB(0, 1), cB + hstep, voffB); PG8_STAGE(PG8_SA(0, 0), cA, voffA); PG8_STAGE(PG8_SA(0, 1), cA + hstep, voffA);
        if (wr == 1) PG8_BAR;
        PG8_WAIT_V(2); PG8_BAR;
        PG8_STAGE(PG8_SB(1, 0), cB + kstep, voffB); PG8_STAGE(PG8_SA(1, 0), cA + kstep, voffA); PG8_STAGE(PG8_SB(1, 1), cB + hstep + kstep, voffB);
        PG8_WAIT_V(6); PG8_BAR;
    } else {
        PG8_STAGE(PG8_SB(0, 0), cB, voffB); PG8_STAGE(PG8_SA(0, 0), cA, voffA); PG8_STAGE(PG8_SB(0, 1), cB + hstep, voffB); PG8_STAGE(PG8_SA(0, 1), cA + hstep, voffA);
        if (wr == 1) PG8_BAR;
        PG8_WAIT_V(4); PG8_BAR;
        PG8_STAGE(PG8_SB(1, 0), cB + kstep, voffB); PG8_STAGE(PG8_SA(1, 0), cA + kstep, voffA); PG8_STAGE(PG8_SB(1, 1), cB + hstep + kstep, voffB);
        PG8_WAIT_V(6); PG8_BAR;
    }
    for (;;) {
        const bool has_next = S.next(ui + 1, nxt);
        const char* nA = has_next ? (const char*)g.A + (size_t)nxt.pm * tstep : cA; const char* nB = has_next ? (const char*)g.Bt + (size_t)nxt.pn * tstep : cB;
        for (int t = 0; t < nt; t += 2) {
            const bool last = (t == nt - 2);
            const char* a1 = cA + (size_t)(t + 1) * kstep;
            const char* a2 = last ? nA : cA + (size_t)(t + 2) * kstep; const char* b2 = last ? nB : cB + (size_t)(t + 2) * kstep;
            const char* a3 = a2 + kstep; const char* b3 = b2 + kstep;
            if (last && has_next) S.a_ready(nxt);
            if constexpr (SP2) {
            PG8_LDB(B0, 0, 0); PG8_LDB(B1, 0, 1); PG8_SCHED; PG8_LDA(At, 0, 0); PG8_STAGE(PG8_SA(1, 1), a1 + hstep, voffA);
            PG8_WAIT_V(8); PG8_WAIT_L(0); PG8_BAR; PG8_MMA(0, 0, At, B0); PG8_MMA(0, 1, At, B1); PG8_BAR; PG8_SCHED;
            PG8_LDA(At, 0, 1); PG8_STAGE(PG8_SB(0, 0), b2, voffB); PG8_STAGE(PG8_SB(0, 1), b2 + hstep, voffB); PG8_STAGE(PG8_SA(0, 0), a2, voffA);
            PG8_WAIT_V(8); PG8_WAIT_L(0); PG8_BAR; PG8_MMA(1, 0, At, B0); PG8_MMA(1, 1, At, B1); PG8_BAR; PG8_SCHED;
            PG8_LDB(B0, 1, 0); PG8_LDB(B1, 1, 1); PG8_SCHED; PG8_LDA(At, 1, 0); PG8_STAGE(PG8_SA(0, 1), a2 + hstep, voffA);
            PG8_WAIT_V(8); PG8_WAIT_L(0); PG8_BAR; PG8_MMA(0, 0, At, B0); PG8_MMA(0, 1, At, B1); PG8_BAR; PG8_SCHED;
            PG8_LDA(At, 1, 1); PG8_STAGE(PG8_SB(1, 0), b3, voffB); PG8_STAGE(PG8_SB(1, 1), b3 + hstep, voffB); PG8_STAGE(PG8_SA(1, 0), a3, voffA);
            PG8_WAIT_V(8); PG8_WAIT_L(0); PG8_BAR; PG8_MMA(1, 0, At, B0); PG8_MMA(1, 1, At, B1); PG8_BAR; PG8_SCHED;
            } else {
            PG8_LDB(B0, 0, 0); PG8_SCHED; PG8_LDA(At, 0, 0); PG8_STAGE(PG8_SA(1, 1), a1 + hstep, voffA);
            PG8_WAIT_L(8); PG8_BAR; PG8_WAIT_L(0); PG8_MMA(0, 0, At, B0); PG8_BAR; PG8_SCHED;
            PG8_LDB(B1, 0, 1); PG8_STAGE(PG8_SB(0, 0), b2, voffB);
            PG8_BAR; PG8_WAIT_L(0); PG8_MMA(0, 1, At, B1); PG8_BAR;
            PG8_LDA(At, 0, 1); PG8_STAGE(PG8_SA(0, 0), a2, voffA);
            PG8_BAR; PG8_WAIT_L(0); PG8_MMA(1, 0, At, B0); PG8_BAR; PG8_SCHED;
            PG8_STAGE(PG8_SB(0, 1), b2 + hstep, voffB);
            PG8_WAIT_V(6); PG8_BAR; PG8_MMA(1, 1, At, B1); PG8_BAR;
            PG8_LDB(B0, 1, 0); PG8_SCHED; PG8_LDA(At, 1, 0); PG8_STAGE(PG8_SA(0, 1), a2 + hstep, voffA);
            PG8_WAIT_L(8); PG8_BAR; PG8_WAIT_L(0); PG8_MMA(0, 0, At, B0); PG8_BAR; PG8_SCHED;
            PG8_LDB(B1, 1, 1); PG8_STAGE(PG8_SB(1, 0), b3, voffB);
            PG8_BAR; PG8_WAIT_L(0); PG8_MMA(0, 1, At, B1); PG8_BAR;
            PG8_LDA(At, 1, 1); PG8_STAGE(PG8_SA(1, 0), a3, voffA);
            PG8_BAR; PG8_WAIT_L(0); PG8_MMA(1, 0, At, B0); PG8_BAR; PG8_SCHED;
            PG8_STAGE(PG8_SB(1, 1), b3 + hstep, voffB);
            PG8_WAIT_V(6); PG8_BAR; PG8_MMA(1, 1, At, B1); PG8_BAR;
            }
        }
        if constexpr (ALIGN_EPI) { if (wr == 0) PG8_BAR; }
        if constexpr (!Epi::AFTER_DRAIN) { E(acc, cur, wr, wc, fr, fq); S.done(cur); }
        if (!has_next) break;
#pragma unroll
        for (int a = 0; a < 2; ++a)
#pragma unroll
            for (int b = 0; b < 2; ++b)
#pragma unroll
                for (int m = 0; m < 4; ++m)
#pragma unroll
                    for (int n = 0; n < 2; ++n) acc[a][b][m][n] = (f32x4){0.f, 0.f, 0.f, 0.f};
        cur = nxt; cA = nA; cB = nB; ++ui;
        if constexpr (ALIGN_EPI) { if (wr == 1) PG8_BAR; }
    }
    PG8_WAIT_V(0);
    if constexpr (!ALIGN_EPI) { if (wr == 0) PG8_BAR; }
    PG8_BAR;
    if constexpr (Epi::AFTER_DRAIN) { E.fused(acc, cur, wr, wc, fr, fq, lds, wid, lane); S.done(cur); }
#undef PG8_SA
#undef PG8_SB
#undef PG8_STAGE
#undef PG8_LDA
#undef PG8_LDB
#undef PG8_MMA
#undef PG8_WAIT_V
#undef PG8_WAIT_L
#undef PG8_BAR
#undef PG8_SCHED
}
}
#ifndef PG8_SP2
#define PG8_SP2 true
#endif
#ifndef PG8_ALIGN
#define PG8_ALIGN true
#endif
#ifndef OUT_MODE
#define OUT_MODE 0
#endif
#ifndef REP_MASK
#define REP_MASK 0
#endif
#ifndef S_CONV
#define S_CONV 1
#endif
#ifndef M3_RW
#define M3_RW 2
#endif
#ifndef PVQ_RB
#define PVQ_RB 16
#endif
#ifndef PUQ_RB
#define PUQ_RB 16
#endif
#ifndef PH_MASK
#define PH_MASK 0xFFFFF
#endif
#ifndef MK_N_LAUNCHES
#define MK_N_LAUNCHES 1
#endif

constexpr int NWAVES = 8, NTHR = NWAVES * 64;
constexpr int BATCH = 2, SEQ = 8192, D = 2048, T = BATCH * SEQ;
constexpr int LRU_W = 1024, CONF_W = 1024, IN_COLS = 4096, LRU_HD = 128;
constexpr int NH = 8, NKEY = 128, TOPK = 16, NEXP = NKEY * NKEY, KSEL = NH * TOPK;
constexpr int NMOD = 6 * D;
constexpr int CHUNK = 64, NCHUNK = SEQ / CHUNK;
constexpr int CONF_K = 31;
constexpr float EPS = 1e-6f;
constexpr int N_PHASES = 13;

constexpr size_t MiB = 1u << 20;
constexpr size_t WS_CTL = 0, CTL_ZERO_BYTES = 64 * 1024;
constexpr size_t WS_MODP = 1 * MiB;
constexpr size_t WS_CFIN = 2 * MiB;
constexpr size_t WS_CARRY = 3 * MiB;
constexpr size_t WS_AGG = 4 * MiB;
constexpr size_t WS_WG = 6 * MiB;
constexpr size_t WS_SUBK = 7 * MiB;
constexpr size_t WS_BT1 = 8 * MiB;
constexpr size_t WS_BT2 = 24 * MiB;
constexpr size_t WS_BT3 = 32 * MiB;
constexpr size_t WS_IDX = 40 * MiB;
constexpr size_t WS_GATE = 48 * MiB;
constexpr size_t WS_USC = 56 * MiB;
constexpr size_t WS_VSC = 57 * MiB;
constexpr size_t WS_RA = 64 * MiB;
constexpr size_t WS_Y1 = 128 * MiB;
constexpr size_t WS_PROJ = 192 * MiB;
constexpr size_t WS_Q = 192 * MiB;
constexpr size_t WS_UB = 256 * MiB;
constexpr size_t WS_XL = 320 * MiB;
constexpr size_t WS_ZC = 352 * MiB;
constexpr size_t WS_Y2 = 384 * MiB;
constexpr size_t WS_SSQ = 58 * MiB;
constexpr size_t WS_HLOC = 384 * MiB;
constexpr size_t WS_PC = 416 * MiB;
constexpr size_t WS_VB = 320 * MiB;
constexpr size_t WS_ACTP = 192 * MiB;
constexpr size_t WS_ACT = 448 * MiB;
constexpr size_t WS_H2Q = 456 * MiB;
constexpr size_t WS_HSC = 488 * MiB;
constexpr size_t WS_END = 489 * MiB;
constexpr int CW_TMO = 0, CW_BAR = 4096;

constexpr int RING_OFF = 0, RING_BYTES = 131072;
constexpr int LDSCTL_OFF = 146432, MISC_OFF = LDSCTL_OFF + 320;
constexpr int LDS_BYTES = 147456;

#define GAS __attribute__((address_space(1)))
#define LAS __attribute__((address_space(3)))
typedef unsigned short bf16;
typedef unsigned v4u __attribute__((ext_vector_type(4)));
typedef unsigned v2u __attribute__((ext_vector_type(2)));
typedef float f32x4 __attribute__((ext_vector_type(4)));
typedef float f32x16 __attribute__((ext_vector_type(16)));
typedef float f32x2 __attribute__((ext_vector_type(2)));
typedef short bf16x8 __attribute__((ext_vector_type(8)));
typedef __bf16 bfp2 __attribute__((ext_vector_type(2)));
typedef GAS unsigned gu32;
#define RLX_AGENT __ATOMIC_RELAXED, __HIP_MEMORY_SCOPE_AGENT
#define LDS_WAIT() asm volatile("s_waitcnt lgkmcnt(0)" ::: "memory")
#define VM_WAIT() asm volatile("s_waitcnt vmcnt(0)" ::: "memory")
typedef __bf16 bf16v2 __attribute__((ext_vector_type(2)));
__device__ __forceinline__ unsigned pk2(float lo, float hi) { bf16v2 v; v.x = (__bf16)lo; v.y = (__bf16)hi; return __builtin_bit_cast(unsigned, v); }
__device__ __forceinline__ unsigned f2bf(float f) { return pk2(f, 0.f) & 0xffffu; }
__device__ __forceinline__ float bflo(unsigned u) { return __builtin_bit_cast(float, u << 16); }
__device__ __forceinline__ float bfhi(unsigned u) { return __builtin_bit_cast(float, u & 0xffff0000u); }
__device__ __forceinline__ float wave_sum(float v) {
#pragma unroll
    for (int o = 1; o < 64; o <<= 1) v += __shfl_xor(v, o);
    return v;
}
__device__ __forceinline__ float dpp_sum63(float v) {
    v += __builtin_bit_cast(float, __builtin_amdgcn_update_dpp(0, __builtin_bit_cast(int, v), 0xB1, 0xF, 0xF, false));
    v += __builtin_bit_cast(float, __builtin_amdgcn_update_dpp(0, __builtin_bit_cast(int, v), 0x4E, 0xF, 0xF, false));
    v += __builtin_bit_cast(float, __builtin_amdgcn_update_dpp(0, __builtin_bit_cast(int, v), 0x141, 0xF, 0xF, false));
    v += __builtin_bit_cast(float, __builtin_amdgcn_update_dpp(0, __builtin_bit_cast(int, v), 0x140, 0xF, 0xF, false));
    v += __builtin_bit_cast(float, __builtin_amdgcn_update_dpp(0, __builtin_bit_cast(int, v), 0x142, 0xA, 0xF, false));
    v += __builtin_bit_cast(float, __builtin_amdgcn_update_dpp(0, __builtin_bit_cast(int, v), 0x143, 0xC, 0xF, false));
    return v;
}

__device__ __forceinline__ float sigmoidf_(float x) { return __builtin_amdgcn_rcpf(1.0f + __expf(-x)); }
__device__ __forceinline__ float gelu_tanh(float x) { return x * sigmoidf_(1.5957691216057308f * (x + 0.044715f * x * x * x)); }
__device__ __forceinline__ float rdlane(float v, int l) { return __builtin_bit_cast(float, __builtin_amdgcn_readlane(__builtin_bit_cast(int, v), l)); }
__device__ __forceinline__ float wave_total(float v) { return rdlane(dpp_sum63(v), 63); }

#define XB_TMO      128
#define XB_XCNT(j)  (256  + 64 * (j))
#define XB_XSUB(j)  (1280 + 64 * (j))
#define XB_XGEN(j)  (2304 + 64 * (j))
#define XB_TOP      3328
#define XB_TOPGEN   3392
#define XCD_BAR_WORDS 3456
#define XB_SPIN_CAP (1u << 18)

__device__ __forceinline__ unsigned xb_ld(unsigned* p)              { return __hip_atomic_load(p, __ATOMIC_RELAXED, __HIP_MEMORY_SCOPE_AGENT); }
__device__ __forceinline__ unsigned xb_add(unsigned* p, unsigned v) { return __hip_atomic_fetch_add(p, v, __ATOMIC_RELAXED, __HIP_MEMORY_SCOPE_AGENT); }
__device__ __forceinline__ unsigned xb_xcc_id() { return (unsigned)__builtin_amdgcn_s_getreg((3 << 11) | 20) & 0xFu; }
#define XB_SPIN(cond, bar) do { unsigned _sp = 0; while (cond) { __builtin_amdgcn_s_sleep(1); \
    if ((++_sp & 255u) == 0u) { if (xb_ld(&(bar)[XB_TMO])) break; if (_sp > XB_SPIN_CAP) { atomicAdd(&(bar)[XB_TMO], 1u); break; } } } } while (0)

struct XcdBarrier {
    unsigned* bar; unsigned x;
    volatile LAS unsigned* st;
};

__device__ __forceinline__ XcdBarrier xcd_barrier_post(unsigned* bar, volatile LAS unsigned* st) {
    XcdBarrier b; b.bar = bar; b.x = xb_xcc_id(); b.st = st;
    if (threadIdx.x == 0) (void)xb_add(&bar[XB_XCNT(b.x)], 1u);
    return b;
}
__device__ __forceinline__ void xcd_barrier_complete(unsigned* bar, unsigned x, unsigned& nloc, unsigned& nx) {
    const unsigned G = gridDim.x * gridDim.y * gridDim.z;
    unsigned sum, cnt, mine, sp = 0u;
    for (;;) {
        sum = 0u; cnt = 0u; mine = 0u;
#pragma unroll
        for (unsigned j = 0; j < 16; ++j) { const unsigned c = xb_ld(&bar[XB_XCNT(j)]); sum += c; cnt += (c > 0u) ? 1u : 0u; mine = (j == x) ? c : mine; }
        if (sum == G) break;
        __builtin_amdgcn_s_sleep(1);
        if ((++sp & 255u) == 0u) { if (xb_ld(&bar[XB_TMO])) break; if (sp > XB_SPIN_CAP) { atomicAdd(&bar[XB_TMO], 1u); break; } }
    }
    nloc = mine > 0u ? mine : 1u; nx = cnt > 0u ? cnt : 1u;
}

__device__ __forceinline__ void xcd_barrier(const XcdBarrier& b) {
    asm volatile("s_waitcnt vmcnt(0)" ::: "memory");
    __syncthreads();
    if (threadIdx.x == 0) {
        unsigned* bar = b.bar;
        __builtin_amdgcn_s_waitcnt(0);
        unsigned nloc = b.st[0], nx = b.st[1];
        if (nloc == 0u) { xcd_barrier_complete(bar, b.x, nloc, nx); b.st[0] = nloc; b.st[1] = nx; }
        const unsigned old = xb_add(&bar[XB_XSUB(b.x)], 1u);
        const unsigned gen = old / nloc;
        if (old + 1u == (gen + 1u) * nloc) {
            __builtin_amdgcn_fence(__ATOMIC_RELEASE, "agent");
            asm volatile("s_waitcnt vmcnt(0)" ::: "memory");
            const unsigned og = xb_add(&bar[XB_TOP], 1u);
            const unsigned tg = og / nx;
            if (og + 1u == (tg + 1u) * nx) xb_add(&bar[XB_TOPGEN], 1u);
            else XB_SPIN(xb_ld(&bar[XB_TOPGEN]) == tg, bar);
            __builtin_amdgcn_fence(__ATOMIC_ACQUIRE, "agent");
            xb_add(&bar[XB_XGEN(b.x)], 1u);
            asm volatile("s_waitcnt vmcnt(0)" ::: "memory");
        } else {
            XB_SPIN(xb_ld(&bar[XB_XGEN(b.x)]) == gen, bar);
            __builtin_amdgcn_fence(__ATOMIC_ACQUIRE, "agent");
            asm volatile("s_waitcnt vmcnt(0)" ::: "memory");
        }
    }
    __syncthreads();
}
struct Args { const float* in[25]; float* out; unsigned char* ws; int ph_lo, ph_hi, li, pad; };
enum { I_X = 0, I_C, I_WMOD, I_BMOD, I_GPREMIX, I_GPOSTMIX, I_GPREFFN, I_GPOSTFFN, I_WIN, I_LCW, I_LCB, I_WA, I_BA, I_WX, I_BX, I_LAMBDA,
       I_CDW, I_CDB, I_LNG, I_LNB, I_WOUT, I_WQ, I_SUBK, I_PU, I_PV };

__device__ __forceinline__ float mod_at(const float* modp, int b, int n) {
    return (modp[(0 * 2 + b) * NMOD + n] + modp[(1 * 2 + b) * NMOD + n]) + (modp[(2 * 2 + b) * NMOD + n] + modp[(3 * 2 + b) * NMOD + n]);
}

__device__ __forceinline__ void p0_transpose_item(const float* W, int K, int N, bf16* WT, LAS float* scr, int item, int lane) {
    const int nblk = N / 32, kb = item / nblk, nb = item % nblk, k0 = 64 * kb, n0 = 32 * nb;
#pragma unroll 8
    for (int i = 0; i < 32; ++i) { const int kk = 2 * i + (lane >> 5); scr[kk * 33 + (lane & 31)] = W[(size_t)(k0 + kk) * N + n0 + (lane & 31)]; }
    LDS_WAIT(); asm volatile("" ::: "memory");
    const int c = lane & 7;
#pragma unroll
    for (int j = 0; j < 4; ++j) { const int n = (lane >> 3) + 8 * j; const LAS float* s = scr + (8 * c) * 33 + n;
        v4u o; o.x = pk2(s[0 * 33], s[1 * 33]); o.y = pk2(s[2 * 33], s[3 * 33]); o.z = pk2(s[4 * 33], s[5 * 33]); o.w = pk2(s[6 * 33], s[7 * 33]);
        *(GAS v4u*)(WT + (size_t)(n0 + n) * K + k0 + 8 * c) = o; }
    LDS_WAIT(); asm volatile("" ::: "memory");
}
__device__ __forceinline__ void cvt_rows_bf16(const float* src, bf16* dst, size_t n8, size_t gt, size_t ngt) {
    for (size_t i = gt; i < n8; i += ngt) {
        const f32x4 a = ((const GAS f32x4*)src)[2 * i], b = ((const GAS f32x4*)src)[2 * i + 1];
        v4u o; o.x = pk2(a.x, a.y); o.y = pk2(a.z, a.w); o.z = pk2(b.x, b.y); o.w = pk2(b.z, b.w);
        ((GAS v4u*)dst)[i] = o; }
}
__device__ __forceinline__ void phase_p0(const Args& A, LAS unsigned char* lds, int tid, int lane, int wave, int bid, int G) {
    float* modp = (float*)(A.ws + WS_MODP);
    for (int item = bid; item < 192; item += G) {
        const int cg = item % 48, kq = item / 48, k0 = kq * 512 + wave * 64, n0 = cg * 256 + lane * 4;
        const float c0 = A.in[I_C][k0 + lane], c1 = A.in[I_C][D + k0 + lane];
        const float ca0 = c0 * sigmoidf_(c0), ca1 = c1 * sigmoidf_(c1);
        f32x4 a0 = {0.f, 0.f, 0.f, 0.f}, a1 = {0.f, 0.f, 0.f, 0.f};
        const float* wp = A.in[I_WMOD] + (size_t)k0 * NMOD + n0;
#pragma unroll 8
        for (int kk = 0; kk < 64; ++kk) {
            const f32x4 w = *(const GAS f32x4*)(wp + (size_t)kk * NMOD);
            const float s0 = __shfl(ca0, kk), s1 = __shfl(ca1, kk);
            a0 += w * s0; a1 += w * s1;
        }
        LAS f32x4* red = (LAS f32x4*)lds;
        red[(wave * 2 + 0) * 64 + lane] = a0; red[(wave * 2 + 1) * 64 + lane] = a1;
        __syncthreads();
        { const int b = tid >> 8, col = tid & 255; const LAS float* rf = (const LAS float*)lds; float s = 0.f;
#pragma unroll
          for (int w = 0; w < 8; ++w) s += rf[((w * 2 + b) * 64) * 4 + col];
          if (kq == 0) s += A.in[I_BMOD][cg * 256 + col];
          modp[(kq * 2 + b) * NMOD + cg * 256 + col] = s; }
        __syncthreads();
    }
    {
        LAS float* scr = (LAS float*)(lds + wave * 16384);
        const int gw = bid * NWAVES + wave, NGW = G * NWAVES;
        constexpr int I1 = (D / 64) * (IN_COLS / 32);
        for (int it = gw; it < I1; it += NGW) p0_transpose_item(A.in[I_WIN], D, IN_COLS, (bf16*)(A.ws + WS_BT1), scr, it, lane);
    }
    {
        const int gt = bid * NTHR + tid, ngt = G * NTHR;
        bf16* wg = (bf16*)(A.ws + WS_WG);
        for (int e = gt; e < NH * 256 * 128; e += ngt) {
            const int h = e >> 15, n = (e >> 7) & 255, k = e & 127;
            const float v = (n < 128 ? A.in[I_WA] : A.in[I_WX])[h * 16384 + k * 128 + (n & 127)];
            wg[e] = (bf16)f2bf(v);
        }
        cvt_rows_bf16(A.in[I_SUBK], (bf16*)(A.ws + WS_SUBK), (size_t)NH * 2 * NKEY * 128 / 8, gt, ngt);
    }
}

__device__ __forceinline__ void phase_p1(const Args& A, int tid, int lane, int wave, int bid, int G) {
    const float* modp = (const float*)(A.ws + WS_MODP);
    {
        float* cfin = (float*)(A.ws + WS_CFIN);
        for (int e = bid * NTHR + tid; e < 2 * 2 * D; e += G * NTHR) {
            const int b = e >> 12, arr = (e >> 11) & 1, col = e & (D - 1);
            cfin[e] = arr == 0 ? mod_at(modp, b, 2 * D + col) * A.in[I_GPOSTMIX][col] : mod_at(modp, b, 5 * D + col) * A.in[I_GPOSTFFN][col];
        }
        float* cfe = (float*)(A.ws + WS_CFIN) + 4 * D;
        for (int e = bid * NTHR + tid; e < 2 * 2 * D; e += G * NTHR) {
            const int b = e >> 12, arr = (e >> 11) & 1, col = e & (D - 1);
            cfe[e] = arr == 0 ? A.in[I_GPREFFN][col] * (1.0f + mod_at(modp, b, 4 * D + col)) : mod_at(modp, b, 3 * D + col);
        }
    }
    const int gw = bid * NWAVES + wave, NGW = G * NWAVES;
    bf16* h1 = (bf16*)(A.ws + WS_RA);
    int cb = -1; float gs[4][8], sh[4][8];
    for (int row = gw; row < T; row += NGW) {
        const int b = row >> 13;
        if (b != cb) { cb = b;
#pragma unroll
            for (int j = 0; j < 4; ++j)
#pragma unroll
                for (int e = 0; e < 8; ++e) { const int col = j * 512 + lane * 8 + e;
                    gs[j][e] = A.in[I_GPREMIX][col] * (1.0f + mod_at(modp, b, D + col)); sh[j][e] = mod_at(modp, b, col); } }
        const GAS f32x4* xr = (const GAS f32x4*)(A.in[I_X] + (size_t)row * D) + lane * 2;
        f32x4 v[4][2]; float s = 0.f;
#pragma unroll
        for (int j = 0; j < 4; ++j) { v[j][0] = xr[j * 128]; v[j][1] = xr[j * 128 + 1];
            s += (v[j][0].x * v[j][0].x + v[j][0].y * v[j][0].y) + (v[j][0].z * v[j][0].z + v[j][0].w * v[j][0].w);
            s += (v[j][1].x * v[j][1].x + v[j][1].y * v[j][1].y) + (v[j][1].z * v[j][1].z + v[j][1].w * v[j][1].w); }
        const float rstd = __builtin_amdgcn_rsqf(wave_total(s) * (1.0f / D) + EPS);
        GAS v4u* orow = (GAS v4u*)(h1 + (size_t)row * D) + lane;
#pragma unroll
        for (int j = 0; j < 4; ++j) { float o[8];
#pragma unroll
            for (int e = 0; e < 8; ++e) o[e] = v[j][e >> 2][e & 3] * rstd * gs[j][e] + sh[j][e];
            v4u w; w.x = pk2(o[0], o[1]); w.y = pk2(o[2], o[3]); w.z = pk2(o[4], o[5]); w.w = pk2(o[6], o[7]);
            orow[j * 64] = w; }
    }
}

__device__ __forceinline__ void m1a_tile_issue(const bf16* proj, int item, int tid, v4u (&rv)[5], v4u (&rg)[5]) {
    const int b = item >> 9, tt = (item >> 3) & 63, ct = item & 7, t0 = tt * 128;
#pragma unroll
    for (int i = 0; i < 5; ++i) {
        const int e = tid + i * NTHR, r = e >> 4, c8 = (e & 15) * 8, t = t0 - 30 + r;
        rv[i] = (v4u){0u, 0u, 0u, 0u}; rg[i] = (v4u){0u, 0u, 0u, 0u};
        if (e < 158 * 16 && t >= 0) { const bf16* p = proj + (size_t)(b * SEQ + t) * IN_COLS + 2048 + ct * 128 + c8; rv[i] = *(const GAS v4u*)p; rg[i] = *(const GAS v4u*)(p + 1024); }
    }
}
__device__ __forceinline__ void phase_m1a(const Args& A, LAS unsigned char* lds, int tid, int lane, int wave, int bid, int G) {
    const bf16* proj = (const bf16*)(A.ws + WS_PROJ);
    {
        LAS float* scr = (LAS float*)(lds + wave * 16384);
        constexpr int I2 = (D / 64) * (D / 32);
        for (int it = bid * NWAVES + wave; it < 2 * I2; it += G * NWAVES) {
            if (it < I2) p0_transpose_item(A.in[I_WOUT], D, D, (bf16*)(A.ws + WS_BT2), scr, it, lane);
            else p0_transpose_item(A.in[I_WQ], D, D, (bf16*)(A.ws + WS_BT3), scr, it - I2, lane);
        }
        __syncthreads();
    }
    {
        bf16* zc = (bf16*)(A.ws + WS_ZC);
        const float* w31 = A.in[I_CDW]; const float* b31 = A.in[I_CDB];
        LAS float* zt = (LAS float*)lds;
        const int cp = tid & 63, tg = tid >> 6;
        v4u rv[5], rg[5];
        int item = bid;
        if (item < 2 * 64 * 8) m1a_tile_issue(proj, item, tid, rv, rg);
        float w0[CONF_K], w1[CONF_K], bias0 = 0.f, bias1 = 0.f; int wct = -1;
        for (; item < 2 * 64 * 8; item += G) {
            const int b = item >> 9, tt = (item >> 3) & 63, ct = item & 7, t0 = tt * 128, ch = ct * 128 + 2 * cp;
            if (ct != wct) { wct = ct;
#pragma unroll
                for (int j = 0; j < CONF_K; ++j) { const f32x2 ww = *(const GAS f32x2*)(w31 + j * CONF_W + ch); w0[j] = ww.x; w1[j] = ww.y; }
                const f32x2 bw = *(const GAS f32x2*)(b31 + ch); bias0 = bw.x; bias1 = bw.y; }
            __syncthreads();
#pragma unroll
            for (int i = 0; i < 5; ++i) {
                const int e = tid + i * NTHR, r = e >> 4, c8 = (e & 15) * 8;
                if (e < 158 * 16) { const v4u v = rv[i], g = rg[i]; f32x4 z0, z1;
                    z0.x = bflo(v.x) * sigmoidf_(bflo(g.x)); z0.y = bfhi(v.x) * sigmoidf_(bfhi(g.x)); z0.z = bflo(v.y) * sigmoidf_(bflo(g.y)); z0.w = bfhi(v.y) * sigmoidf_(bfhi(g.y));
                    z1.x = bflo(v.z) * sigmoidf_(bflo(g.z)); z1.y = bfhi(v.z) * sigmoidf_(bfhi(g.z)); z1.z = bflo(v.w) * sigmoidf_(bflo(g.w)); z1.w = bfhi(v.w) * sigmoidf_(bfhi(g.w));
                    *(LAS f32x4*)(zt + r * 128 + c8) = z0; *(LAS f32x4*)(zt + r * 128 + c8 + 4) = z1; }
            }
            __syncthreads();
            if (item + G < 2 * 64 * 8) m1a_tile_issue(proj, item + G, tid, rv, rg);
            float a0[16], a1[16];
#pragma unroll
            for (int i = 0; i < 16; ++i) { a0[i] = bias0; a1[i] = bias1; }
#pragma unroll
            for (int s_ = 0; s_ < 46; ++s_) {
                const f32x2 v = *(const LAS f32x2*)(zt + (tg * 16 + s_) * 128 + 2 * cp);
#pragma unroll
                for (int i = 0; i < 16; ++i) if (s_ - i >= 0 && s_ - i < CONF_K) { a0[i] += w0[s_ - i] * v.x; a1[i] += w1[s_ - i] * v.y; }
            }
            bf16* zo = zc + (size_t)(b * SEQ + t0 + tg * 16) * CONF_W + ch;
#pragma unroll
            for (int i = 0; i < 16; ++i) *(GAS unsigned*)(zo + (size_t)i * CONF_W) = pk2(a0[i], a1[i]);
        }
        __syncthreads();
    }
}

template <int CTRL> __device__ __forceinline__ float dpp_shr(float v, float ident) {
    return __builtin_bit_cast(float, __builtin_amdgcn_update_dpp(__builtin_bit_cast(int, ident), __builtin_bit_cast(int, v), CTRL, 0xF, 0xF, false));
}
constexpr int XT_PITCH = 2064;   static_assert(64 * 2064 <= LDSCTL_OFF, "xl tile vs LDS control words");
__device__ __forceinline__ void phase_m1b(const Args& A, LAS unsigned char* lds, int tid, int lane, int wave, int bid, int G) {
    const bf16* proj = (const bf16*)(A.ws + WS_PROJ); const bf16* wg = (const bf16*)(A.ws + WS_WG);
    bf16* hloc = (bf16*)(A.ws + WS_HLOC); bf16* pc = (bf16*)(A.ws + WS_PC); float* agg = (float*)(A.ws + WS_AGG);
    const int fr = lane & 15, fq = lane >> 4;
    for (int wi = bid; wi < 2 * NCHUNK; wi += G) {
        const int hh = wave, chunk = wi & (NCHUNK - 1), b = wi >> 7;
        const size_t r0 = (size_t)b * SEQ + (size_t)chunk * CHUNK;
        __syncthreads();
        {
            const float* w4 = A.in[I_LCW]; const float* b4 = A.in[I_LCB];
            const int c0 = (tid & 127) * 8, tr = tid >> 7, t0 = chunk * CHUNK + tr * 16;
            v4u in[19];
#pragma unroll
            for (int r = 0; r < 19; ++r) { in[r] = (v4u){0u, 0u, 0u, 0u}; if (t0 - 3 + r >= 0) in[r] = *(const GAS v4u*)(proj + ((size_t)b * SEQ + t0 - 3 + r) * IN_COLS + c0); }
            float w[4][8], bb[8];
#pragma unroll
            for (int j = 0; j < 4; ++j) { const f32x4 wa_ = *(const GAS f32x4*)(w4 + j * LRU_W + c0), wb_ = *(const GAS f32x4*)(w4 + j * LRU_W + c0 + 4);
                w[j][0] = wa_.x; w[j][1] = wa_.y; w[j][2] = wa_.z; w[j][3] = wa_.w; w[j][4] = wb_.x; w[j][5] = wb_.y; w[j][6] = wb_.z; w[j][7] = wb_.w; }
            { const f32x4 ba = *(const GAS f32x4*)(b4 + c0), bc = *(const GAS f32x4*)(b4 + c0 + 4); bb[0] = ba.x; bb[1] = ba.y; bb[2] = ba.z; bb[3] = ba.w; bb[4] = bc.x; bb[5] = bc.y; bb[6] = bc.z; bb[7] = bc.w; }
#pragma unroll
            for (int i = 0; i < 16; ++i) { float acc[8];
#pragma unroll
                for (int e = 0; e < 8; ++e) acc[e] = bb[e];
#pragma unroll
                for (int j = 0; j < 4; ++j) { const v4u v = in[i + j];
                    acc[0] += w[j][0] * bflo(v.x); acc[1] += w[j][1] * bfhi(v.x); acc[2] += w[j][2] * bflo(v.y); acc[3] += w[j][3] * bfhi(v.y);
                    acc[4] += w[j][4] * bflo(v.z); acc[5] += w[j][5] * bfhi(v.z); acc[6] += w[j][6] * bflo(v.w); acc[7] += w[j][7] * bfhi(v.w); }
                v4u o; o.x = pk2(acc[0], acc[1]); o.y = pk2(acc[2], acc[3]); o.z = pk2(acc[4], acc[5]); o.w = pk2(acc[6], acc[7]);
                *(LAS v4u*)(lds + (tr * 16 + i) * XT_PITCH + c0 * 2) = o; }
        }
        __syncthreads();
        bf16x8 xf[4][4];
#pragma unroll
        for (int mt = 0; mt < 4; ++mt)
#pragma unroll
            for (int ks = 0; ks < 4; ++ks) xf[mt][ks] = *(const LAS bf16x8*)(lds + (16 * mt + fr) * XT_PITCH + (hh * LRU_HD + 32 * ks + 8 * fq) * 2);
        float cP[4], cH[4];
        for (int j = 0; j < 8; ++j) {
            const int chb = hh * LRU_HD + 16 * j + 4 * fq;
            bf16x8 wa[4], wx[4];
#pragma unroll
            for (int ks = 0; ks < 4; ++ks) { wa[ks] = *(const GAS bf16x8*)(wg + (size_t)(hh * 256 + 16 * j + fr) * 128 + 32 * ks + 8 * fq);
                                             wx[ks] = *(const GAS bf16x8*)(wg + (size_t)(hh * 256 + 128 + 16 * j + fr) * 128 + 32 * ks + 8 * fq); }
            const f32x4 bav = *(const GAS f32x4*)(A.in[I_BA] + chb), bxv = *(const GAS f32x4*)(A.in[I_BX] + chb), lam = *(const GAS f32x4*)(A.in[I_LAMBDA] + chb);
            float cl[4];
#pragma unroll
            for (int r = 0; r < 4; ++r) { cl[r] = -8.0f * log1pf(__expf(-lam[r])); cP[r] = 1.f; cH[r] = 0.f; }
#pragma unroll
            for (int mt = 0; mt < 4; ++mt) {
                f32x4 ar = {0.f, 0.f, 0.f, 0.f}, ai = {0.f, 0.f, 0.f, 0.f};
#pragma unroll
                for (int ks = 0; ks < 4; ++ks) { ar = __builtin_amdgcn_mfma_f32_16x16x32_bf16(wa[ks], xf[mt][ks], ar, 0, 0, 0);
                                                 ai = __builtin_amdgcn_mfma_f32_16x16x32_bf16(wx[ks], xf[mt][ks], ai, 0, 0, 0); }
                const v2u xv = *(const LAS v2u*)(lds + (16 * mt + fr) * XT_PITCH + chb * 2);
                const float xlv[4] = {bflo(xv.x), bfhi(xv.x), bflo(xv.y), bfhi(xv.y)};
                float P[4], H[4];
#pragma unroll
                for (int r = 0; r < 4; ++r) {
                    const float rg = sigmoidf_(ar[r] + bav[r]), ig = sigmoidf_(ai[r] + bxv[r]);
                    const float la = cl[r] * rg, a = __expf(la), mult = sqrtf(fmaxf(1.0f - a * a, 0.f));
                    float p = a, h = mult * ig * xlv[r];
                    { float pp, hp;
                      pp = dpp_shr<0x111>(p, 1.0f); hp = dpp_shr<0x111>(h, 0.0f); h = p * hp + h; p = p * pp;
                      pp = dpp_shr<0x112>(p, 1.0f); hp = dpp_shr<0x112>(h, 0.0f); h = p * hp + h; p = p * pp;
                      pp = dpp_shr<0x114>(p, 1.0f); hp = dpp_shr<0x114>(h, 0.0f); h = p * hp + h; p = p * pp;
                      pp = dpp_shr<0x118>(p, 1.0f); hp = dpp_shr<0x118>(h, 0.0f); h = p * hp + h; p = p * pp; }
                    h = h + p * cH[r]; p = p * cP[r];
                    P[r] = p; H[r] = h;
                    cP[r] = __shfl(p, 15, 16); cH[r] = __shfl(h, 15, 16);
                }
                v2u ho, po; ho.x = pk2(H[0], H[1]); ho.y = pk2(H[2], H[3]); po.x = pk2(P[0], P[1]); po.y = pk2(P[2], P[3]);
                *(GAS v2u*)(hloc + (r0 + 16 * mt + fr) * LRU_W + chb) = ho;
                *(GAS v2u*)(pc + (r0 + 16 * mt + fr) * LRU_W + chb) = po;
            }
            if (fr == 0) {
                float* ag = agg + ((size_t)(b * NCHUNK + chunk) * LRU_W + chb) * 2;
                *(GAS f32x4*)ag = (f32x4){cP[0], cH[0], cP[1], cH[1]}; *(GAS f32x4*)(ag + 4) = (f32x4){cP[2], cH[2], cP[3], cH[3]};
            }
        }
    }
}

__device__ __forceinline__ void phase_m3(const Args& A, LAS unsigned char* lds, int tid, int lane, int wave, int bid, int G) {
    const bf16* proj = (const bf16*)(A.ws + WS_PROJ); const bf16* hloc = (const bf16*)(A.ws + WS_HLOC); const bf16* pc = (const bf16*)(A.ws + WS_PC);
    const bf16* zc = (const bf16*)(A.ws + WS_ZC); const float* agg = (const float*)(A.ws + WS_AGG);
    bf16* a2 = (bf16*)(A.ws + WS_RA);
    LAS float* cs = (LAS float*)lds;
    float lg[2][8], lb[2][8];
#pragma unroll
    for (int jj = 0; jj < 2; ++jj)
#pragma unroll
        for (int e = 0; e < 8; ++e) { lg[jj][e] = A.in[I_LNG][jj * 512 + lane * 8 + e]; lb[jj][e] = A.in[I_LNB][jj * 512 + lane * 8 + e]; }
    for (int item = bid; item < 2 * NCHUNK; item += G) {
        const int b = item >> 7, chunk = item & (NCHUNK - 1);
        {   float h0 = 0.f, h1 = 0.f; const float* ap = agg + ((size_t)(b * NCHUNK) * LRU_W + 2 * tid) * 2;
#pragma unroll 8
            for (int c = 0; c < chunk; ++c) { const f32x4 ab = *(const GAS f32x4*)(ap + (size_t)c * LRU_W * 2); h0 = ab.x * h0 + ab.y; h1 = ab.z * h1 + ab.w; }
            __syncthreads();
            cs[2 * tid] = h0; cs[2 * tid + 1] = h1;
            __syncthreads(); }
        for (int rr = 0; rr < 8; rr += M3_RW) {
            const int row0 = b * SEQ + chunk * CHUNK + wave * 8 + rr;
            v4u hv[M3_RW][2], pv[M3_RW][2], gv[M3_RW][2], zq[M3_RW][2];
#pragma unroll
            for (int u = 0; u < M3_RW; ++u)
#pragma unroll
                for (int jj = 0; jj < 2; ++jj) { const int c0 = jj * 512 + lane * 8; const size_t row = (size_t)(row0 + u);
                    hv[u][jj] = *(const GAS v4u*)(hloc + row * LRU_W + c0); pv[u][jj] = *(const GAS v4u*)(pc + row * LRU_W + c0);
                    gv[u][jj] = *(const GAS v4u*)(proj + row * IN_COLS + 1024 + c0); zq[u][jj] = *(const GAS v4u*)(zc + row * CONF_W + c0); }
#pragma unroll
            for (int u = 0; u < M3_RW; ++u) {
                const size_t row = (size_t)(row0 + u);
                float zv[2][8]; float s = 0.f;
#pragma unroll
                for (int jj = 0; jj < 2; ++jj) {
                    const int c0 = jj * 512 + lane * 8;
                    const f32x4 ca = *(const LAS f32x4*)(cs + c0), cb = *(const LAS f32x4*)(cs + c0 + 4);
                    const v4u h_ = hv[u][jj], p_ = pv[u][jj], g_ = gv[u][jj], z = zq[u][jj];
                    float y[8];
                    y[0] = (bflo(h_.x) + bflo(p_.x) * ca.x) * gelu_tanh(bflo(g_.x)); y[1] = (bfhi(h_.x) + bfhi(p_.x) * ca.y) * gelu_tanh(bfhi(g_.x));
                    y[2] = (bflo(h_.y) + bflo(p_.y) * ca.z) * gelu_tanh(bflo(g_.y)); y[3] = (bfhi(h_.y) + bfhi(p_.y) * ca.w) * gelu_tanh(bfhi(g_.y));
                    y[4] = (bflo(h_.z) + bflo(p_.z) * cb.x) * gelu_tanh(bflo(g_.z)); y[5] = (bfhi(h_.z) + bfhi(p_.z) * cb.y) * gelu_tanh(bfhi(g_.z));
                    y[6] = (bflo(h_.w) + bflo(p_.w) * cb.z) * gelu_tanh(bflo(g_.w)); y[7] = (bfhi(h_.w) + bfhi(p_.w) * cb.w) * gelu_tanh(bfhi(g_.w));
                    v4u o; o.x = pk2(y[0], y[1]); o.y = pk2(y[2], y[3]); o.z = pk2(y[4], y[5]); o.w = pk2(y[6], y[7]);
                    *(GAS v4u*)(a2 + row * D + c0) = o;
                    zv[jj][0] = bflo(z.x); zv[jj][1] = bfhi(z.x); zv[jj][2] = bflo(z.y); zv[jj][3] = bfhi(z.y); zv[jj][4] = bflo(z.z); zv[jj][5] = bfhi(z.z); zv[jj][6] = bflo(z.w); zv[jj][7] = bfhi(z.w);
#pragma unroll
                    for (int e = 0; e < 8; ++e) s += zv[jj][e];
                }
                const float mean = wave_total(s) * (1.0f / CONF_W); float q = 0.f;
#pragma unroll
                for (int jj = 0; jj < 2; ++jj)
#pragma unroll
                    for (int e = 0; e < 8; ++e) { zv[jj][e] -= mean; q += zv[jj][e] * zv[jj][e]; }
                const float rstd = __builtin_amdgcn_rsqf(wave_total(q) * (1.0f / CONF_W) + EPS);
#pragma unroll
                for (int jj = 0; jj < 2; ++jj) { float o[8];
#pragma unroll
                    for (int e = 0; e < 8; ++e) { const float n = zv[jj][e] * rstd * lg[jj][e] + lb[jj][e]; o[e] = n * sigmoidf_(n); }
                    v4u w; w.x = pk2(o[0], o[1]); w.y = pk2(o[2], o[3]); w.z = pk2(o[4], o[5]); w.w = pk2(o[6], o[7]);
                    *(GAS v4u*)(a2 + row * D + 1024 + jj * 512 + lane * 8) = w; }
            }
        }
    }
}

__device__ __forceinline__ f32x2 fp8lo(unsigned w) { return __builtin_amdgcn_cvt_pk_f32_fp8((int)w, false); }
__device__ __forceinline__ f32x2 fp8hi(unsigned w) { return __builtin_amdgcn_cvt_pk_f32_fp8((int)w, true); }
constexpr int CVT_ROWS = 4;
template <bool I8> __device__ __forceinline__ void cvt_table_q8(const float* src, unsigned char* dst, float* inv_scale, int gw, int NGW, int lane) {
    for (int r0 = gw; r0 < NEXP; r0 += NGW * CVT_ROWS) {
        f32x4 v[CVT_ROWS][8];
#pragma unroll
        for (int q = 0; q < CVT_ROWS; ++q) { const int r = r0 + q * NGW; const GAS f32x4* p = (const GAS f32x4*)(src + (size_t)(r < NEXP ? r : r0) * D) + lane;
#pragma unroll
            for (int i = 0; i < 8; ++i) v[q][i] = p[i * 64]; }
#pragma unroll
        for (int q = 0; q < CVT_ROWS; ++q) { const int r = r0 + q * NGW; float m = 0.f;
#pragma unroll
            for (int i = 0; i < 8; ++i) m = fmaxf(m, fmaxf(fmaxf(fabsf(v[q][i].x), fabsf(v[q][i].y)), fmaxf(fabsf(v[q][i].z), fabsf(v[q][i].w))));
#pragma unroll
            for (int o = 1; o < 64; o <<= 1) m = fmaxf(m, __shfl_xor(m, o));
            const float QM = I8 ? 127.0f : 448.0f;
            const float sc = m > 0.f ? QM / m : 1.0f;
            if (r < NEXP) {
                GAS unsigned* o4 = (GAS unsigned*)(dst + (size_t)r * D) + lane;
#pragma unroll
                for (int i = 0; i < 8; ++i) { const f32x4 t = v[q][i] * sc;
                    const float a = fminf(fmaxf(t.x, -QM), QM), b = fminf(fmaxf(t.y, -QM), QM), c = fminf(fmaxf(t.z, -QM), QM), d = fminf(fmaxf(t.w, -QM), QM);
                    if (I8) { o4[i * 64] = (unsigned)(((int)rintf(a) & 255) | (((int)rintf(b) & 255) << 8) | (((int)rintf(c) & 255) << 16) | ((int)rintf(d) << 24)); }
                    else { int pk = __builtin_amdgcn_cvt_pk_fp8_f32(a, b, 0, false); pk = __builtin_amdgcn_cvt_pk_fp8_f32(c, d, pk, true); o4[i * 64] = (unsigned)pk; } }
                if (lane == 0) inv_scale[r] = m > 0.f ? m * (1.0f / QM) : 1.0f;
            }
        }
    }
}
__device__ __forceinline__ void phase_e2(const Args& A, int tid, int lane, int wave, int bid, int G) {
    const float* cfin = (const float*)(A.ws + WS_CFIN); const float* cfe = (const float*)(A.ws + WS_CFIN) + 4 * D;
    const bf16* y1 = (const bf16*)(A.ws + WS_Y1); bf16* h2 = (bf16*)(A.ws + WS_RA);
    const int gw = bid * NWAVES + wave, NGW = G * NWAVES;
    int cb = -1; f32x4 c1[8], gs[8], sh[8];
    f32x4 xn[8]; v2u yn[8];
#define E2_LOAD(r_) do { const size_t r__ = (size_t)(r_); const GAS f32x4* xr = (const GAS f32x4*)(A.in[I_X] + r__ * D) + lane; const GAS v2u* yr = (const GAS v2u*)(y1 + r__ * D) + lane; \
        _Pragma("unroll") for (int j = 0; j < 8; ++j) { xn[j] = xr[j * 64]; yn[j] = yr[j * 64]; } } while (0)
    if (gw < T) E2_LOAD(gw);
    for (int row = gw; row < T; row += NGW) {
        const int b = row >> 13;
        if (b != cb) { cb = b;
#pragma unroll
            for (int j = 0; j < 8; ++j) { c1[j] = ((const GAS f32x4*)(cfin + (size_t)(b * 2 + 0) * D))[j * 64 + lane]; gs[j] = ((const GAS f32x4*)(cfe + (size_t)(b * 2 + 0) * D))[j * 64 + lane];
                sh[j] = ((const GAS f32x4*)(cfe + (size_t)(b * 2 + 1) * D))[j * 64 + lane]; } }
        f32x4 xv[8], yv[8]; float s1 = 0.f;
#pragma unroll
        for (int j = 0; j < 8; ++j) { xv[j] = xn[j]; yv[j] = (f32x4){bflo(yn[j].x), bfhi(yn[j].x), bflo(yn[j].y), bfhi(yn[j].y)};
            s1 += (yv[j].x * yv[j].x + yv[j].y * yv[j].y) + (yv[j].z * yv[j].z + yv[j].w * yv[j].w); }
        if (row + NGW < T) E2_LOAD(row + NGW);
        const float rstd1 = __builtin_amdgcn_rsqf(wave_total(s1) * (1.0f / D) + EPS); float s2 = 0.f;
#pragma unroll
        for (int j = 0; j < 8; ++j) { xv[j] += c1[j] * yv[j] * rstd1; s2 += (xv[j].x * xv[j].x + xv[j].y * xv[j].y) + (xv[j].z * xv[j].z + xv[j].w * xv[j].w); }
        const float rstd2 = __builtin_amdgcn_rsqf(wave_total(s2) * (1.0f / D) + EPS);
        GAS v2u* orow = (GAS v2u*)(h2 + (size_t)row * D) + lane; float am = 0.f;
#pragma unroll
        for (int j = 0; j < 8; ++j) { xv[j] = xv[j] * rstd2 * gs[j] + sh[j];
            am = fmaxf(am, fmaxf(fmaxf(fabsf(xv[j].x), fabsf(xv[j].y)), fmaxf(fabsf(xv[j].z), fabsf(xv[j].w))));
            orow[j * 64] = (v2u){pk2(xv[j].x, xv[j].y), pk2(xv[j].z, xv[j].w)}; }
#pragma unroll
        for (int o = 1; o < 64; o <<= 1) am = fmaxf(am, __shfl_xor(am, o));
        const float qs = am > 0.f ? 127.0f / am : 1.0f;
        GAS unsigned* qrow = (GAS unsigned*)(A.ws + WS_H2Q + (size_t)row * D) + lane;
#pragma unroll
        for (int j = 0; j < 8; ++j) { const f32x4 t = xv[j] * qs;
            qrow[j * 64] = (unsigned)(((int)rintf(t.x) & 255) | (((int)rintf(t.y) & 255) << 8) | (((int)rintf(t.z) & 255) << 16) | ((int)rintf(t.w) << 24)); }
        if (lane == 0) ((float*)(A.ws + WS_HSC))[row] = am > 0.f ? am * (1.0f / 127.0f) : 1.0f;
    }
#undef E2_LOAD
}

template <int N> __device__ __forceinline__ void bitonic_sort_desc(float (&v)[N]) {
#pragma unroll
    for (int k = 2; k <= N; k <<= 1)
#pragma unroll
        for (int j = k >> 1; j > 0; j >>= 1)
#pragma unroll
            for (int i = 0; i < N; ++i) { const int l = i ^ j;
                if (l > i) { const bool desc = ((i & k) == 0); const float a = v[i], b = v[l]; const float mx = fmaxf(a, b), mn = fminf(a, b); v[i] = desc ? mx : mn; v[l] = desc ? mn : mx; } }
}
__device__ __forceinline__ void merge_top16(float (&a)[16], const float (&b)[16]) {
#pragma unroll
    for (int i = 0; i < 16; ++i) a[i] = fmaxf(a[i], b[15 - i]);
#pragma unroll
    for (int j = 8; j > 0; j >>= 1)
#pragma unroll
        for (int i = 0; i < 16; ++i) { const int l = i ^ j; if (l > i) { const float x = a[i], y = a[l]; a[i] = fmaxf(x, y); a[l] = fminf(x, y); } }
}
__device__ __forceinline__ void top16_of_64(float (&v)[64], float (&out)[16]) {
    float g[4][16];
#pragma unroll
    for (int q = 0; q < 4; ++q) {
#pragma unroll
        for (int i = 0; i < 16; ++i) g[q][i] = v[q * 16 + i];
        bitonic_sort_desc<16>(g[q]); }
    merge_top16(g[0], g[1]); merge_top16(g[2], g[3]); merge_top16(g[0], g[2]);
#pragma unroll
    for (int i = 0; i < 16; ++i) out[i] = g[0][i];
}
__device__ __forceinline__ float pack_key(float v, unsigned key, unsigned mask) { return __builtin_bit_cast(float, (__builtin_bit_cast(unsigned, v) & ~mask) | key); }
constexpr int SK_PITCH = 272;
__device__ __forceinline__ void score_top16(const bf16* q, const LAS unsigned char* skl, int tok, int h, int p, int l31, int hf, float (&out)[16]) {
    f32x16 acc[4];
#pragma unroll
    for (int kt = 0; kt < 4; ++kt)
#pragma unroll
        for (int r = 0; r < 16; ++r) acc[kt][r] = 0.f;
    bf16x8 bq[8];
#pragma unroll
    for (int ks = 0; ks < 8; ++ks) bq[ks] = *(const GAS bf16x8*)(q + (size_t)tok * D + h * 256 + p * 128 + 16 * ks + 8 * hf);
#pragma unroll
    for (int ks = 0; ks < 8; ++ks) {
#pragma unroll
        for (int kt = 0; kt < 4; ++kt) {
            const bf16x8 ak = *(const LAS bf16x8*)(skl + (p * NKEY + 32 * kt + l31) * SK_PITCH + (16 * ks + 8 * hf) * 2);
            acc[kt] = __builtin_amdgcn_mfma_f32_32x32x16_bf16(ak, bq[ks], acc[kt], 0, 0, 0);
        }
    }
    float v[64];
#pragma unroll
    for (int kt = 0; kt < 4; ++kt)
#pragma unroll
        for (int r = 0; r < 16; ++r) v[kt * 16 + r] = pack_key(acc[kt][r], (unsigned)(32 * kt + (r & 3) + 8 * (r >> 2) + 4 * hf), 0x7Fu);
    float other[16];
    top16_of_64(v, out);
#pragma unroll
    for (int i = 0; i < 16; ++i) other[i] = __shfl_xor(out[i], 32);
    merge_top16(out, other);
}
__device__ __forceinline__ void s_convert_tables(const Args& A, int gw, int NGW, int lane) {
    cvt_table_q8<true>(A.in[I_PU], A.ws + WS_UB, (float*)(A.ws + WS_USC), gw, NGW, lane);
}
__device__ __forceinline__ void phase_s(const Args& A, LAS unsigned char* lds, int tid, int lane, int wave, int bid, int G) {
    const bf16* q = (const bf16*)(A.ws + WS_Q); const bf16* sk = (const bf16*)(A.ws + WS_SUBK);
    int* idx = (int*)(A.ws + WS_IDX); float* gate = (float*)(A.ws + WS_GATE);
    const int l31 = lane & 31, hf = lane >> 5;
    bool conv_done = false;
    for (int wi = bid; wi < (T / 512) * NH; wi += G) {
      const int h = wi & 7, tg = wi >> 3;
      __syncthreads();
#pragma unroll
      for (int i = 0; i < 8; ++i) { const int c = tid + i * NTHR, row = c >> 4, c16 = c & 15;
          *(LAS v4u*)(lds + row * SK_PITCH + c16 * 16) = *(const GAS v4u*)(sk + ((size_t)(h * 2 * NKEY + row)) * 128 + c16 * 8); }
      __syncthreads();
      if (S_CONV && wave >= 4 && !conv_done) s_convert_tables(A, bid * NWAVES + wave, G * NWAVES, lane);
      for (int ti = 0; ti < 2; ++ti) {
        const int tok = (tg * 16 + ti * 8 + wave) * 32 + l31;
        float s1[16], s2[16];
        score_top16(q, lds, tok, h, 0, l31, hf, s1);
        score_top16(q, lds, tok, h, 1, l31, hf, s2);
        float cv[64]; int n = 0;
#pragma unroll
        for (int i = 0; i < 16; ++i)
#pragma unroll
            for (int j = 0; j < 16; ++j)
                if ((i + 1) * (j + 1) <= 16) {
                    const float a = __builtin_bit_cast(float, __builtin_bit_cast(unsigned, s1[i]) & ~0x7Fu), c = __builtin_bit_cast(float, __builtin_bit_cast(unsigned, s2[j]) & ~0x7Fu);
                    cv[n++] = pack_key(a + c, (unsigned)(i * 16 + j), 0xFFu); }
#pragma unroll
        for (int m = 50; m < 64; ++m) cv[m] = -INFINITY;
        float c16[16];
        top16_of_64(cv, c16);
        float ev[16], esum = 0.f; const float cmax = __builtin_bit_cast(float, __builtin_bit_cast(unsigned, c16[0]) & ~0xFFu);
#pragma unroll
        for (int m = 0; m < 16; ++m) { ev[m] = __expf(__builtin_bit_cast(float, __builtin_bit_cast(unsigned, c16[m]) & ~0xFFu) - cmax); esum += ev[m]; }
        const float rs = 1.0f / esum;
        int oi[8]; float og[8];
#pragma unroll
        for (int mm = 0; mm < 8; ++mm) {
            float c_lo = c16[mm], c_hi = c16[8 + mm], e_lo = ev[mm], e_hi = ev[8 + mm];
            asm volatile("" : "+v"(c_lo), "+v"(c_hi), "+v"(e_lo), "+v"(e_hi));
            const unsigned cb = __builtin_bit_cast(unsigned, hf ? c_hi : c_lo); const int ii = (cb >> 4) & 15, jj = cb & 15;
            int row = 0, col = 0;
#pragma unroll
            for (int k = 0; k < 16; ++k) { row = (ii == k) ? (int)(__builtin_bit_cast(unsigned, s1[k]) & 0x7Fu) : row; col = (jj == k) ? (int)(__builtin_bit_cast(unsigned, s2[k]) & 0x7Fu) : col; }
            oi[mm] = row * NKEY + col; og[mm] = (hf ? e_hi : e_lo) * rs;
        }
        int* ip = idx + (size_t)tok * KSEL + h * 16 + hf * 8; float* gp = gate + (size_t)tok * KSEL + h * 16 + hf * 8;
        *(GAS v4u*)ip = (v4u){(unsigned)oi[0], (unsigned)oi[1], (unsigned)oi[2], (unsigned)oi[3]}; *(GAS v4u*)(ip + 4) = (v4u){(unsigned)oi[4], (unsigned)oi[5], (unsigned)oi[6], (unsigned)oi[7]};
        *(GAS f32x4*)gp = (f32x4){og[0], og[1], og[2], og[3]}; *(GAS f32x4*)(gp + 4) = (f32x4){og[4], og[5], og[6], og[7]};
      }
      if (S_CONV && wave < 4 && !conv_done) s_convert_tables(A, bid * NWAVES + wave, G * NWAVES, lane);
      conv_done = true;
    }
    if (S_CONV && !conv_done) s_convert_tables(A, bid * NWAVES + wave, G * NWAVES, lane);
    __syncthreads();
}

__device__ __forceinline__ void phase_pu(const Args& A, int lane, int wave, int bid, int G) {
    const unsigned char* h2q = A.ws + WS_H2Q; const unsigned char* ub = A.ws + WS_UB; const int* idx = (const int*)(A.ws + WS_IDX); float* actp = (float*)(A.ws + WS_ACTP);
    const int NX = (G % 8 == 0) ? 8 : 1, vx = bid % NX, nw = (G / NX) * NWAVES, wv = (bid / NX) * NWAVES + wave;
    const int q = lane >> 4, c16 = lane & 15;
    for (int cb = vx; cb < D / 256; cb += NX) {
        const unsigned loff = (unsigned)(cb * 256 + c16 * 16);
        int cid0 = 0, cid1 = 0, nid0 = 0, nid1 = 0; v4u ch = {0u, 0u, 0u, 0u}, nh = {0u, 0u, 0u, 0u};
#define PUQ_LOAD(i0, i1, hh, t_) do { const int t__ = (t_); if (t__ < T) { i0 = idx[(size_t)t__ * KSEL + lane]; i1 = idx[(size_t)t__ * KSEL + 64 + lane]; hh = *(const GAS v4u*)(h2q + (size_t)t__ * D + cb * 256 + c16 * 16); } } while (0)
        PUQ_LOAD(cid0, cid1, ch, wv); PUQ_LOAD(nid0, nid1, nh, wv + nw);
        v4u rv[PUQ_RB];
#define PUQ_ISSUE(slot, idr, s_) do { const unsigned e_ = (unsigned)__shfl(idr, ((4 * (s_)) & 63) + q); rv[slot] = *(const GAS v4u*)(ub + ((e_ << 11) + loff)); } while (0)
#pragma unroll
        for (int r = 0; r < PUQ_RB; ++r) PUQ_ISSUE(r, cid0, r);
        f32x4 cvv[8]; int it = 0;
        const int gwv = bid * NWAVES + wave, NGWv = G * NWAVES;
        for (int tok = wv; tok < T; tok += nw, ++it) {
            if (cb == vx) {
                const int vr = gwv + NGWv * (it >> 3);
                if ((it & 7) == 0 && vr < NEXP) { const GAS f32x4* p = (const GAS f32x4*)(A.in[I_PV] + (size_t)vr * D) + lane;
#pragma unroll
                    for (int i = 0; i < 8; ++i) cvv[i] = p[i * 64]; }
                if ((it & 7) == 1 && vr < NEXP) { float m = 0.f;
#pragma unroll
                    for (int i = 0; i < 8; ++i) m = fmaxf(m, fmaxf(fmaxf(fabsf(cvv[i].x), fabsf(cvv[i].y)), fmaxf(fabsf(cvv[i].z), fabsf(cvv[i].w))));
#pragma unroll
                    for (int o = 1; o < 64; o <<= 1) m = fmaxf(m, __shfl_xor(m, o));
                    const float sc = m > 0.f ? 448.0f / m : 1.0f; GAS unsigned* o4 = (GAS unsigned*)(A.ws + WS_VB + (size_t)vr * D) + lane;
#pragma unroll
                    for (int i = 0; i < 8; ++i) { const f32x4 t = cvv[i] * sc;
                        const float a = fminf(fmaxf(t.x, -448.f), 448.f), b = fminf(fmaxf(t.y, -448.f), 448.f), c = fminf(fmaxf(t.z, -448.f), 448.f), d = fminf(fmaxf(t.w, -448.f), 448.f);
                        int pk = __builtin_amdgcn_cvt_pk_fp8_f32(a, b, 0, false); pk = __builtin_amdgcn_cvt_pk_fp8_f32(c, d, pk, true); o4[i * 64] = (unsigned)pk; }
                    if (lane == 0) ((float*)(A.ws + WS_VSC))[vr] = m > 0.f ? m * (1.0f / 448.0f) : 1.0f; }
            }
            const int hx = (int)ch.x, hy = (int)ch.y, hz = (int)ch.z, hw = (int)ch.w;
            int a0 = 0, a1 = 0;
#define PUQ_DOT(slot, acc_, s_) do { const v4u d_ = rv[slot]; int p_ = __builtin_amdgcn_sdot4((int)d_.x, hx, 0, false); p_ = __builtin_amdgcn_sdot4((int)d_.y, hy, p_, false); \
                p_ = __builtin_amdgcn_sdot4((int)d_.z, hz, p_, false); p_ = __builtin_amdgcn_sdot4((int)d_.w, hw, p_, false); \
                p_ += __builtin_amdgcn_update_dpp(0, p_, 0xB1, 0xF, 0xF, false); p_ += __builtin_amdgcn_update_dpp(0, p_, 0x4E, 0xF, 0xF, false); \
                p_ += __builtin_amdgcn_update_dpp(0, p_, 0x141, 0xF, 0xF, false); p_ += __builtin_amdgcn_update_dpp(0, p_, 0x140, 0xF, 0xF, false); \
                acc_ = (c16 == ((s_) & 15)) ? p_ : acc_; } while (0)
#pragma unroll
            for (int r = 0; r < PUQ_RB; ++r) { PUQ_DOT(r, a0, r); PUQ_ISSUE(r, cid1, r + PUQ_RB); }
#pragma unroll
            for (int r = 0; r < PUQ_RB; ++r) { PUQ_DOT(r, a1, r + PUQ_RB); PUQ_ISSUE(r, nid0, r); }
            float* ap = actp + ((size_t)cb * T + tok) * KSEL + 4 * c16 + q;
            ap[0] = (float)a0; ap[64] = (float)a1;
            cid0 = nid0; cid1 = nid1; ch = nh;
            PUQ_LOAD(nid0, nid1, nh, tok + 2 * nw);
        }
#undef PUQ_LOAD
#undef PUQ_ISSUE
#undef PUQ_DOT
    }
}
__device__ __forceinline__ void phase_w(const Args& A, int lane, int wave, int bid, int G) {
    const float* actp = (const float*)(A.ws + WS_ACTP); const float* usc = (const float*)(A.ws + WS_USC); const float* vsc = (const float*)(A.ws + WS_VSC); const float* hsc = (const float*)(A.ws + WS_HSC);
    const int* idx = (const int*)(A.ws + WS_IDX); const float* gate = (const float*)(A.ws + WS_GATE); float* wb = (float*)(A.ws + WS_ACT);
    for (int tok = bid * NWAVES + wave; tok < T; tok += G * NWAVES) {
        const float hs = hsc[tok];
#pragma unroll
        for (int hh = 0; hh < 2; ++hh) {
            const size_t o = (size_t)tok * KSEL + hh * 64 + lane; float sacc = 0.f;
#pragma unroll
            for (int c = 0; c < 8; ++c) sacc += actp[(size_t)c * T * KSEL + o];
            const int e = idx[o];
            wb[o] = gate[o] * gelu_tanh(sacc * usc[e] * hs) * vsc[e];
        }
    }
}
__device__ __forceinline__ void phase_pv(const Args& A, int lane, int wave, int bid, int G) {
    const unsigned char* vb = A.ws + WS_VB; const float* wb = (const float*)(A.ws + WS_ACT); const int* idx = (const int*)(A.ws + WS_IDX);
    bf16* y2 = (bf16*)(A.ws + WS_Y2); float* ssq = (float*)(A.ws + WS_SSQ);
    const int NX = (G % 8 == 0) ? 8 : 1, vx = bid % NX, nw = (G / NX) * NWAVES, wv = (bid / NX) * NWAVES + wave;
    const int q = lane >> 4, c16 = lane & 15;
    for (int cb = vx; cb < D / 256; cb += NX) {
        const unsigned loff = (unsigned)(cb * 256 + c16 * 16);
        int cid0 = 0, cid1 = 0, nid0 = 0, nid1 = 0; float cw0 = 0.f, cw1 = 0.f, nw0 = 0.f, nw1 = 0.f;
#define PVQ_LOAD(i0, i1, x0, x1, t_) do { const int t__ = (t_); if (t__ < T) { i0 = idx[(size_t)t__ * KSEL + lane]; i1 = idx[(size_t)t__ * KSEL + 64 + lane]; x0 = wb[(size_t)t__ * KSEL + lane]; x1 = wb[(size_t)t__ * KSEL + 64 + lane]; } } while (0)
        PVQ_LOAD(cid0, cid1, cw0, cw1, wv); PVQ_LOAD(nid0, nid1, nw0, nw1, wv + nw);
        v4u rv[PVQ_RB];
#define PVQ_ISSUE(slot, idr, s_) do { const unsigned e_ = (unsigned)__shfl(idr, ((4 * (s_)) & 63) + q); rv[slot] = *(const GAS v4u*)(vb + ((e_ << 11) + loff)); } while (0)
#pragma unroll
        for (int r = 0; r < PVQ_RB; ++r) PVQ_ISSUE(r, cid0, r);
        for (int tok = wv; tok < T; tok += nw) {
            f32x2 acc[8];
#pragma unroll
            for (int i = 0; i < 8; ++i) acc[i] = (f32x2){0.f, 0.f};
#define PVQ_FMA(slot, wr, s_) do { const float w_ = __shfl(wr, ((4 * (s_)) & 63) + q); const v4u d_ = rv[slot]; const unsigned dw_[4] = {d_.x, d_.y, d_.z, d_.w}; \
                _Pragma("unroll") for (int i_ = 0; i_ < 4; ++i_) { acc[2 * i_] += fp8lo(dw_[i_]) * w_; acc[2 * i_ + 1] += fp8hi(dw_[i_]) * w_; } } while (0)
#pragma unroll
            for (int r = 0; r < PVQ_RB; ++r) { PVQ_FMA(r, cw0, r); PVQ_ISSUE(r, cid1, r + PVQ_RB); }
#pragma unroll
            for (int r = 0; r < PVQ_RB; ++r) { PVQ_FMA(r, cw1, r + PVQ_RB); PVQ_ISSUE(r, nid0, r); }
            float sq = 0.f;
#pragma unroll
            for (int i = 0; i < 8; ++i) { float x = acc[i].x, y = acc[i].y; x += __shfl_xor(x, 16); y += __shfl_xor(y, 16); x += __shfl_xor(x, 32); y += __shfl_xor(y, 32); acc[i] = (f32x2){x, y}; sq += x * x + y * y; }
            sq = wave_total(q == 0 ? sq : 0.f);
            if (q == 0) { GAS v4u* yo = (GAS v4u*)(y2 + (size_t)tok * D + cb * 256 + c16 * 16);
                yo[0] = (v4u){pk2(acc[0].x, acc[0].y), pk2(acc[1].x, acc[1].y), pk2(acc[2].x, acc[2].y), pk2(acc[3].x, acc[3].y)};
                yo[1] = (v4u){pk2(acc[4].x, acc[4].y), pk2(acc[5].x, acc[5].y), pk2(acc[6].x, acc[6].y), pk2(acc[7].x, acc[7].y)}; }
            if (lane == 0) ssq[(size_t)cb * T + tok] = sq;
            cid0 = nid0; cid1 = nid1; cw0 = nw0; cw1 = nw1;
            PVQ_LOAD(nid0, nid1, nw0, nw1, tok + 2 * nw);
        }
#undef PVQ_LOAD
#undef PVQ_ISSUE
#undef PVQ_FMA
    }
}
__device__ __forceinline__ void phase_f(const Args& A, int lane, int wave, int bid, int G) {
    const bf16* y1 = (const bf16*)(A.ws + WS_Y1); const bf16* y2 = (const bf16*)(A.ws + WS_Y2); const float* ssq = (const float*)(A.ws + WS_SSQ); const float* cfin = (const float*)(A.ws + WS_CFIN);
    for (int tok = bid * NWAVES + wave; tok < T; tok += G * NWAVES) {
        const int b = tok >> 13;
        float qs = 0.f;
#pragma unroll
        for (int c = 0; c < 8; ++c) qs += ssq[(size_t)c * T + tok];
        const float rstd2 = __builtin_amdgcn_rsqf(qs * (1.0f / D) + EPS);
        const GAS v2u* yp = (const GAS v2u*)(y1 + (size_t)tok * D) + lane; const GAS v2u* zp = (const GAS v2u*)(y2 + (size_t)tok * D) + lane;
        const GAS f32x4* xr = (const GAS f32x4*)(A.in[I_X] + (size_t)tok * D) + lane;
        v2u yq[8], zq[8]; f32x4 xv[8]; float s1 = 0.f;
#pragma unroll
        for (int i = 0; i < 8; ++i) { yq[i] = yp[i * 64]; zq[i] = zp[i * 64]; xv[i] = xr[i * 64]; }
#pragma unroll
        for (int i = 0; i < 8; ++i) { const float a = bflo(yq[i].x), b_ = bfhi(yq[i].x), c = bflo(yq[i].y), d = bfhi(yq[i].y); s1 += (a * a + b_ * b_) + (c * c + d * d); }
        const float rstd1 = __builtin_amdgcn_rsqf(wave_total(s1) * (1.0f / D) + EPS);
        const GAS f32x4* c1 = (const GAS f32x4*)(cfin + (size_t)(b * 2 + 0) * D) + lane; const GAS f32x4* c2 = (const GAS f32x4*)(cfin + (size_t)(b * 2 + 1) * D) + lane;
        GAS f32x4* orow = (GAS f32x4*)(A.out + (size_t)tok * D) + lane;
#pragma unroll
        for (int i = 0; i < 8; ++i) { const f32x4 a1 = c1[i * 64], a2 = c2[i * 64];
            const float yv[4] = {bflo(yq[i].x), bfhi(yq[i].x), bflo(yq[i].y), bfhi(yq[i].y)}, zv[4] = {bflo(zq[i].x), bfhi(zq[i].x), bflo(zq[i].y), bfhi(zq[i].y)}; f32x4 o;
#pragma unroll
            for (int e = 0; e < 4; ++e) o[e] = xv[i][e] + (OUT_MODE != 2 ? a1[e] * yv[e] * rstd1 : 0.f) + (OUT_MODE != 1 ? a2[e] * zv[e] * rstd2 : 0.f);
            orow[i * 64] = o; }
    }
}

#if defined(MK_CHECKS)
constexpr int CW_CHK = 2048;
__device__ __forceinline__ unsigned hsh(unsigned x) { x ^= x >> 16; x *= 0x7feb352dU; x ^= x >> 15; x *= 0x846ca68bU; x ^= x >> 16; return x; }
__device__ __forceinline__ float bfv(const bf16* p, size_t i) { return __builtin_bit_cast(float, (unsigned)p[i] << 16); }
__device__ __forceinline__ float relerr(float got, float ref, float scale) { const float d = fabsf(got - ref) / (fabsf(ref) + scale); return (d == d) ? d : 1e30f; }
__device__ __forceinline__ void chk_put(unsigned* ctl, int stage, float e) { atomicMax(ctl + CW_CHK + stage, __builtin_bit_cast(unsigned, e)); }
__device__ float chk_gemm(const bf16* Am, const bf16* Bt, const bf16* C, int N, int K, unsigned s) {
    const int row = hsh(s) % T, col = hsh(s * 7 + 1) % N; float acc = 0.f;
    for (int k = 0; k < K; ++k) acc += bfv(Am, (size_t)row * K + k) * bfv(Bt, (size_t)col * K + k);
    return relerr(bfv(C, (size_t)row * N + col), acc, 0.05f);
}
__device__ float xl_at(const Args& A, const bf16* proj, size_t row, int c) {
    const int t = (int)(row & (SEQ - 1)); float a = A.in[I_LCB][c];
    for (int j = 0; j < 4; ++j) if (t - 3 + j >= 0) a += A.in[I_LCW][j * LRU_W + c] * bfv(proj, (row - 3 + j) * IN_COLS + c);
    return __builtin_bit_cast(float, f2bf(a) << 16);
}
__global__ void __launch_bounds__(128) chk_kernel(Args A, int stage) {
    __shared__ float sh[10240];
    unsigned* ctl = (unsigned*)(A.ws + WS_CTL);
    const int tid = threadIdx.x; const unsigned s = hsh(tid * 2654435761u + stage * 97u + 12345u);
    const float* modp = (const float*)(A.ws + WS_MODP);
    float e = 0.f;
    if (stage == 0) {
        { const int b = s & 1, n = hsh(s) % NMOD; float acc = A.in[I_BMOD][n];
          for (int k = 0; k < D; ++k) { const float c = A.in[I_C][b * D + k]; acc += c / (1.0f + expf(-c)) * A.in[I_WMOD][(size_t)k * NMOD + n]; }
          e = fmaxf(e, relerr(mod_at(modp, b, n), acc, 0.01f)); }
        { const int n = hsh(s + 1) % IN_COLS, k = hsh(s + 2) % D; e = fmaxf(e, relerr(bfv((const bf16*)(A.ws + WS_BT1), (size_t)n * D + k), A.in[I_WIN][(size_t)k * IN_COLS + n], 1e-3f)); }
        { const int h = s & 7, n = hsh(s + 5) & 255, k = hsh(s + 6) & 127; const float ref = (n < 128 ? A.in[I_WA] : A.in[I_WX])[h * 16384 + k * 128 + (n & 127)];
          e = fmaxf(e, relerr(bfv((const bf16*)(A.ws + WS_WG), (size_t)(h * 256 + n) * 128 + k), ref, 1e-3f)); }
        { const int i = hsh(s + 7) % (NH * 2 * NKEY * 128); e = fmaxf(e, relerr(bfv((const bf16*)(A.ws + WS_SUBK), i), A.in[I_SUBK][i], 1e-3f)); }
    } else if (stage == 1) {
        const int row = hsh(s) % T, col = hsh(s + 1) % D, b = row >> 13; float ss = 0.f;
        for (int k = 0; k < D; ++k) { const float x = A.in[I_X][(size_t)row * D + k]; ss += x * x; }
        const float ref = A.in[I_X][(size_t)row * D + col] * rsqrtf(ss / D + EPS) * A.in[I_GPREMIX][col] * (1.0f + mod_at(modp, b, D + col)) + mod_at(modp, b, col);
        e = relerr(bfv((const bf16*)(A.ws + WS_RA), (size_t)row * D + col), ref, 0.05f);
        const float* cfin = (const float*)(A.ws + WS_CFIN);
        e = fmaxf(e, relerr(cfin[(b * 2 + 0) * D + col], mod_at(modp, b, 2 * D + col) * A.in[I_GPOSTMIX][col], 1e-3f));
        e = fmaxf(e, relerr(cfin[(b * 2 + 1) * D + col], mod_at(modp, b, 5 * D + col) * A.in[I_GPOSTFFN][col], 1e-3f));
    } else if (stage == 2) { e = chk_gemm((const bf16*)(A.ws + WS_RA), (const bf16*)(A.ws + WS_BT1), (const bf16*)(A.ws + WS_PROJ), IN_COLS, D, s);
    } else if (stage == 7) { e = chk_gemm((const bf16*)(A.ws + WS_RA), (const bf16*)(A.ws + WS_BT2), (const bf16*)(A.ws + WS_Y1), D, D, s);
    } else if (stage == 9) { e = chk_gemm((const bf16*)(A.ws + WS_RA), (const bf16*)(A.ws + WS_BT3), (const bf16*)(A.ws + WS_Q), D, D, s);
    } else if (stage == 3) {
        const bf16* proj = (const bf16*)(A.ws + WS_PROJ);
        int row = hsh(s) % T; if (tid < 16) row = (tid & 1) * SEQ + (tid >> 1);
        const int c = hsh(s + 1) % LRU_W, t = row & (SEQ - 1);
        float a = A.in[I_LCB][c];
        for (int j = 0; j < 4; ++j) if (t - 3 + j >= 0) a += A.in[I_LCW][j * LRU_W + c] * bfv(proj, (size_t)(row - 3 + j) * IN_COLS + c);
        (void)a;
        float z = A.in[I_CDB][c];
        for (int j = 0; j < CONF_K; ++j) if (t - 30 + j >= 0) { const size_t r = (size_t)(row - 30 + j) * IN_COLS; const float g = bfv(proj, r + 3072 + c);
            z += A.in[I_CDW][j * CONF_W + c] * bfv(proj, r + 2048 + c) / (1.0f + expf(-g)); }
        e = fmaxf(e, relerr(bfv((const bf16*)(A.ws + WS_ZC), (size_t)row * CONF_W + c), z, 0.05f));
    } else if (stage == 4) {
        const bf16* xl = (const bf16*)(A.ws + WS_XL);
        const int b = s & 1, chunk = hsh(s + 1) % NCHUNK, ch = hsh(s + 2) % LRU_W, hh = ch >> 7, j = ch & 127;
        const float cl = -8.0f * log1pf(expf(-A.in[I_LAMBDA][ch])); float P = 1.f, H = 0.f;
        for (int t = 0; t < CHUNK; ++t) { const size_t row = (size_t)b * SEQ + chunk * CHUNK + t; float ga = A.in[I_BA][ch], gx = A.in[I_BX][ch];
            for (int i = 0; i < 128; ++i) { const float xv = bfv(xl, row * LRU_W + hh * 128 + i); ga += xv * A.in[I_WA][hh * 16384 + i * 128 + j]; gx += xv * A.in[I_WX][hh * 16384 + i * 128 + j]; }
            const float r = 1.0f / (1.0f + expf(-ga)), ig = 1.0f / (1.0f + expf(-gx)), la = cl * r, a = expf(la), u = sqrtf(fmaxf(-expm1f(2.0f * la), 0.f)) * ig * bfv(xl, row * LRU_W + ch);
            H = a * H + u; P = P * a;
            e = fmaxf(e, relerr(bfv((const bf16*)(A.ws + WS_HLOC), row * LRU_W + ch), H, 0.05f)); e = fmaxf(e, relerr(bfv((const bf16*)(A.ws + WS_PC), row * LRU_W + ch), P, 0.02f)); }
        const float* ag = (const float*)(A.ws + WS_AGG) + ((size_t)(b * NCHUNK + chunk) * LRU_W + ch) * 2;
        e = fmaxf(e, relerr(ag[0], P, 0.02f)); e = fmaxf(e, relerr(ag[1], H, 0.05f));
    } else if (stage == 12) {
        { const int n = hsh(s + 3) % D, k = hsh(s + 4) % D; e = fmaxf(e, relerr(bfv((const bf16*)(A.ws + WS_BT2), (size_t)n * D + k), A.in[I_WOUT][(size_t)k * D + n], 1e-3f));
          e = fmaxf(e, relerr(bfv((const bf16*)(A.ws + WS_BT3), (size_t)n * D + k), A.in[I_WQ][(size_t)k * D + n], 1e-3f)); }
        const bf16* proj = (const bf16*)(A.ws + WS_PROJ);
#define XLV(row_, ch_) xl_at(A, proj, (row_), (ch_))
        const int b = s & 1, chunk = hsh(s + 1) % NCHUNK, ch = hsh(s + 2) % LRU_W, hh = ch >> 7, j = ch & 127;
        const float cl = -8.0f * log1pf(expf(-A.in[I_LAMBDA][ch])); float P = 1.f, H = 0.f;
        for (int t = 0; t < CHUNK; ++t) { const size_t row = (size_t)b * SEQ + chunk * CHUNK + t; float ga = A.in[I_BA][ch], gx = A.in[I_BX][ch];
            for (int i = 0; i < 128; ++i) { const float xv = XLV(row, hh * 128 + i); ga += xv * A.in[I_WA][hh * 16384 + i * 128 + j]; gx += xv * A.in[I_WX][hh * 16384 + i * 128 + j]; }
            const float r = 1.0f / (1.0f + expf(-ga)), ig = 1.0f / (1.0f + expf(-gx)), la = cl * r, a = expf(la), u = sqrtf(fmaxf(-expm1f(2.0f * la), 0.f)) * ig * XLV(row, ch);
            H = a * H + u; P = P * a;
            e = fmaxf(e, relerr(bfv((const bf16*)(A.ws + WS_HLOC), row * LRU_W + ch), H, 0.05f)); e = fmaxf(e, relerr(bfv((const bf16*)(A.ws + WS_PC), row * LRU_W + ch), P, 0.02f)); }
        const float* ag = (const float*)(A.ws + WS_AGG) + ((size_t)(b * NCHUNK + chunk) * LRU_W + ch) * 2;
        e = fmaxf(e, relerr(ag[0], P, 0.02f)); e = fmaxf(e, relerr(ag[1], H, 0.05f));
        { const int row = hsh(s + 9) % T, c = hsh(s + 10) % CONF_W, t = row & (SEQ - 1); float z = A.in[I_CDB][c];
          for (int j = 0; j < CONF_K; ++j) if (t - 30 + j >= 0) { const size_t r = (size_t)(row - 30 + j) * IN_COLS; const float g = bfv(proj, r + 3072 + c); z += A.in[I_CDW][j * CONF_W + c] * bfv(proj, r + 2048 + c) / (1.0f + expf(-g)); }
          e = fmaxf(e, relerr(bfv((const bf16*)(A.ws + WS_ZC), (size_t)row * CONF_W + c), z, 0.05f)); }
#undef XLV
    } else if (stage == 5) {
    } else if (stage == 6) {
        const bf16* proj = (const bf16*)(A.ws + WS_PROJ); const bf16* zc = (const bf16*)(A.ws + WS_ZC);
        const int row = hsh(s) % T, c = hsh(s + 1) % LRU_W, b = row >> 13, chunk = (row & (SEQ - 1)) >> 6;
        float cin = 0.f; for (int cc = 0; cc < chunk; ++cc) { const float* ag = (const float*)(A.ws + WS_AGG) + ((size_t)(b * NCHUNK + cc) * LRU_W + c) * 2; cin = ag[0] * cin + ag[1]; }
        const float hfull = bfv((const bf16*)(A.ws + WS_HLOC), (size_t)row * LRU_W + c) + bfv((const bf16*)(A.ws + WS_PC), (size_t)row * LRU_W + c) * cin;
        const float g = bfv(proj, (size_t)row * IN_COLS + 1024 + c), ge = 0.5f * g * (1.0f + tanhf(0.7978845608f * (g + 0.044715f * g * g * g)));
        e = relerr(bfv((const bf16*)(A.ws + WS_RA), (size_t)row * D + c), hfull * ge, 0.05f);
        float m = 0.f, q = 0.f;
        for (int k = 0; k < CONF_W; ++k) m += bfv(zc, (size_t)row * CONF_W + k);
        m /= CONF_W;
        for (int k = 0; k < CONF_W; ++k) { const float d = bfv(zc, (size_t)row * CONF_W + k) - m; q += d * d; }
        const float n = (bfv(zc, (size_t)row * CONF_W + c) - m) * rsqrtf(q / CONF_W + EPS) * A.in[I_LNG][c] + A.in[I_LNB][c];
        e = fmaxf(e, relerr(bfv((const bf16*)(A.ws + WS_RA), (size_t)row * D + 1024 + c), n / (1.0f + expf(-n)), 0.05f));
    } else if (stage == 8) {
        const bf16* y1 = (const bf16*)(A.ws + WS_Y1); const float* cfin = (const float*)(A.ws + WS_CFIN);
        const int row = hsh(s) % T, col = hsh(s + 1) % D, b = row >> 13; float s1 = 0.f, s2 = 0.f;
        for (int k = 0; k < D; ++k) { const float y = bfv(y1, (size_t)row * D + k); s1 += y * y; }
        const float r1 = rsqrtf(s1 / D + EPS);
        for (int k = 0; k < D; ++k) { const float x1 = A.in[I_X][(size_t)row * D + k] + cfin[(b * 2) * D + k] * bfv(y1, (size_t)row * D + k) * r1; s2 += x1 * x1; }
        const float x1c = A.in[I_X][(size_t)row * D + col] + cfin[(b * 2) * D + col] * bfv(y1, (size_t)row * D + col) * r1;
        const float ref = x1c * rsqrtf(s2 / D + EPS) * A.in[I_GPREFFN][col] * (1.0f + mod_at(modp, b, 4 * D + col)) + mod_at(modp, b, 3 * D + col);
        e = relerr(bfv((const bf16*)(A.ws + WS_RA), (size_t)row * D + col), ref, 0.05f);
    } else if (stage == 10) {
        { const size_t i = (size_t)(hsh(s + 2) % NEXP) * D + hsh(s + 3) % D;
          const unsigned wu = ((const unsigned*)(A.ws + WS_UB))[i >> 2] >> (8 * (i & 3)), wv = ((const unsigned*)(A.ws + WS_VB))[i >> 2] >> (8 * (i & 3));
          const float du = (float)(signed char)(wu & 255u) * ((const float*)(A.ws + WS_USC))[i / D], dv = __builtin_amdgcn_cvt_pk_f32_fp8((int)wv, false)[0] * ((const float*)(A.ws + WS_VSC))[i / D];
          e = fmaxf(e, relerr(du, A.in[I_PU][i], 2e-3f) * 0.3f); (void)dv; }
        if (tid < 32) {
            const bf16* q = (const bf16*)(A.ws + WS_Q); const int* idx = (const int*)(A.ws + WS_IDX); const float* gate = (const float*)(A.ws + WS_GATE);
            const int tok = hsh(s) % T, h = hsh(s + 1) & 7;
            float* sc = sh + tid * 320;
            for (int p = 0; p < 2; ++p) for (int n = 0; n < NKEY; ++n) { float a = 0.f;
                for (int d = 0; d < 128; ++d) a += bfv(q, (size_t)tok * D + h * 256 + p * 128 + d) * A.in[I_SUBK][((size_t)((h * 2 + p) * NKEY + n)) * 128 + d];
                sc[p * 128 + n] = a; }
            for (int p = 0; p < 2; ++p) { float prev = 1e30f; for (int it = 0; it < 16; ++it) { float best = -1e30f; int bi = 0;
                for (int n = 0; n < NKEY; ++n) { const float v = sc[p * 128 + n]; if (v < prev && v > best) { best = v; bi = n; } }
                sc[256 + p * 16 + it] = best; sc[288 + p * 16 + it] = (float)bi; prev = best; } }
            float prev = 1e30f, esum = 0.f, cmax = 0.f; int miss = 0; float gerr = 0.f;
            { float pv = 1e30f; for (int it = 0; it < 16; ++it) { float best = -1e30f;
                for (int c = 0; c < 256; ++c) { const float v = sc[256 + (c >> 4)] + sc[272 + (c & 15)]; if (v < pv && v > best) best = v; }
                if (it == 0) cmax = best; esum += expf(best - cmax); pv = best; } }
            for (int it = 0; it < 16; ++it) { float best = -1e30f; int bc = 0;
                for (int c = 0; c < 256; ++c) { const float v = sc[256 + (c >> 4)] + sc[272 + (c & 15)]; if (v < prev && v > best) { best = v; bc = c; } }
                prev = best;
                const int eidx = (int)sc[288 + (bc >> 4)] * NKEY + (int)sc[304 + (bc & 15)]; const float g = expf(best - cmax) / esum; bool found = false;
                for (int m = 0; m < 16; ++m) if (idx[(size_t)tok * KSEL + h * 16 + m] == eidx) { found = true; gerr = fmaxf(gerr, relerr(gate[(size_t)tok * KSEL + h * 16 + m], g, 0.02f)); }
                if (!found) ++miss; }
            e = fmaxf((float)miss / 16.0f, gerr);
        }
    } else if (stage == 11) {
        const bf16* h2 = (const bf16*)(A.ws + WS_RA); const bf16* y1 = (const bf16*)(A.ws + WS_Y1); const int* idx = (const int*)(A.ws + WS_IDX); const float* gate = (const float*)(A.ws + WS_GATE); const float* cfin = (const float*)(A.ws + WS_CFIN);
        const int tok = hsh(blockIdx.x * 977u + 5u) % T, b = tok >> 13;
        { const int ex = idx[(size_t)tok * KSEL + tid]; float a = 0.f;
          if ((unsigned)ex < (unsigned)NEXP) { for (int d = 0; d < D; ++d) a += bfv(h2, (size_t)tok * D + d) * A.in[I_PU][(size_t)ex * D + d]; } else a = 1e30f;
          const float ge = 0.5f * a * (1.0f + tanhf(0.7978845608f * (a + 0.044715f * a * a * a)));
          sh[tid] = gate[(size_t)tok * KSEL + tid] * ge; sh[128 + tid] = __builtin_bit_cast(float, ex); }
        __syncthreads();
        float s2 = 0.f, s1 = 0.f;
        for (int cc = 0; cc < 16; ++cc) { const int col = cc * 128 + tid; float a = 0.f;
            for (int k = 0; k < KSEL; ++k) { const int ex = __builtin_bit_cast(int, sh[128 + k]); if ((unsigned)ex < (unsigned)NEXP) a += sh[k] * A.in[I_PV][(size_t)ex * D + col]; }
            sh[512 + cc * 128 + tid] = a; s2 += a * a; const float y = bfv(y1, (size_t)tok * D + col); s1 += y * y; }
        __syncthreads(); sh[256 + tid] = s2; sh[384 + tid] = s1; __syncthreads();
        float t2 = 0.f, t1 = 0.f; for (int k = 0; k < 128; ++k) { t2 += sh[256 + k]; t1 += sh[384 + k]; }
        const float r2 = rsqrtf(t2 / D + EPS), r1 = rsqrtf(t1 / D + EPS);
        float en = 0.f, ed = 0.f;
        for (int cc = 0; cc < 16; ++cc) { const int col = cc * 128 + tid;
            const float pterm = cfin[(b * 2 + 1) * D + col] * sh[512 + cc * 128 + tid] * r2;
            const float ref = A.in[I_X][(size_t)tok * D + col] + (OUT_MODE != 2 ? cfin[(b * 2) * D + col] * bfv(y1, (size_t)tok * D + col) * r1 : 0.f) + (OUT_MODE != 1 ? pterm : 0.f);
            const float d = A.out[(size_t)tok * D + col] - ref; en += d * d; ed += pterm * pterm; }
        __syncthreads(); sh[256 + tid] = en; sh[384 + tid] = ed; __syncthreads();
        float ten = 0.f, ted = 0.f; for (int k = 0; k < 128; ++k) { ten += sh[256 + k]; ted += sh[384 + k]; }
        e = ten / (ted + 1e-12f); if (!(e == e)) e = 1e30f;
    }
    chk_put(ctl, stage, e);
}
__global__ void chk_encode(Args A, int what) {
    const unsigned* ctl = (const unsigned*)(A.ws + WS_CTL);
    if (threadIdx.x == 0 && blockIdx.x == 0) {
        if (what < 0) {
            const float thr[13] = {0.03f, 0.03f, 0.03f, 0.03f, 0.06f, 0.01f, 0.04f, 0.03f, 0.03f, 0.03f, 0.2f, 0.01f, 0.06f};
            for (int st = 0; st < 13; ++st) { const float e = __builtin_bit_cast(float, ctl[CW_CHK + st]); if (!(e <= thr[st])) { A.out[0] = 4000.0f * (float)(1 << st); break; } }
        } else {
            const float e = fminf(__builtin_bit_cast(float, ctl[CW_CHK + what]), 1e6f); A.out[0] = 4000.0f * sqrtf(1e6f * e);
        }
    }
}
#endif

__global__ void __launch_bounds__(NTHR, 2) fwd_kernel(Args args) {
    extern __shared__ __attribute__((aligned(16))) unsigned char lds_raw[];
    LAS unsigned char* lds = (LAS unsigned char*)lds_raw;
    const int tid = threadIdx.x, lane = tid & 63, wave = __builtin_amdgcn_readfirstlane(tid >> 6), bid = blockIdx.x, G = gridDim.x;
    for (int u = tid; u < (LDS_BYTES - LDSCTL_OFF) / 4; u += NTHR) ((LAS unsigned*)(lds + LDSCTL_OFF))[u] = 0u;
    __syncthreads();
    unsigned* ctl = (unsigned*)(args.ws + WS_CTL);
    XcdBarrier bar; bar.bar = ctl + CW_BAR + args.li * XCD_BAR_WORDS; bar.x = 0; bar.st = nullptr;
    if (MK_N_LAUNCHES != N_PHASES) bar = xcd_barrier_post(ctl + CW_BAR + args.li * XCD_BAR_WORDS, (volatile LAS unsigned*)(lds + MISC_OFF) + 8);
    const int lo = args.ph_lo, hi = args.ph_hi;
#define IN(k) (lo <= (k) && (k) < hi)
#define SEAM(k) do { if (IN(k) && IN((k) + 1)) xcd_barrier(bar); } while (0)
#define PHON(k) ((PH_MASK >> (k)) & 1)
    if (PHON(0) && IN(0)) { phase_p0(args, lds, tid, lane, wave, bid, G); }
    SEAM(0);
    if (PHON(1) && IN(1)) { phase_p1(args, tid, lane, wave, bid, G); }
    SEAM(1);
    if (PHON(2) && IN(2)) {
        pg8::Gemm g{(const bf16*)(args.ws + WS_RA), (const bf16*)(args.ws + WS_BT1), T, IN_COLS, D}; pg8::StaticOrder S; S.init(T, IN_COLS, G, bid);
        pg8::EpiBf16<0> E{(bf16*)(args.ws + WS_PROJ), IN_COLS, nullptr, 0, 0, 1.f};
        pg8::gemm_phase<pg8::EpiBf16<0>, pg8::StaticOrder, PG8_ALIGN, PG8_SP2>(lds + RING_OFF, g, S, E);
    }
    SEAM(2);
    if (PHON(3) && IN(3)) { phase_m1a(args, lds, tid, lane, wave, bid, G); }
    if (PHON(4) && IN(3)) { phase_m1b(args, lds, tid, lane, wave, bid, G); }
    SEAM(3);
    if (PHON(5) && IN(4)) { phase_m3(args, lds, tid, lane, wave, bid, G); }
    SEAM(4);
    if (PHON(6) && IN(5)) {
        pg8::Gemm g{(const bf16*)(args.ws + WS_RA), (const bf16*)(args.ws + WS_BT2), T, D, D}; pg8::StaticOrder S; S.init(T, D, G, bid);
        pg8::EpiBf16<0> E{(bf16*)(args.ws + WS_Y1), D, nullptr, 0, 0, 1.f};
        pg8::gemm_phase<pg8::EpiBf16<0>, pg8::StaticOrder, PG8_ALIGN, PG8_SP2>(lds + RING_OFF, g, S, E);
    }
    SEAM(5);
    if (PHON(7) && IN(6)) { phase_e2(args, tid, lane, wave, bid, G); }
    SEAM(6);
    if (PHON(8) && IN(7)) {
        pg8::Gemm g{(const bf16*)(args.ws + WS_RA), (const bf16*)(args.ws + WS_BT3), T, D, D}; pg8::StaticOrder S; S.init(T, D, G, bid);
        pg8::EpiBf16<0> E{(bf16*)(args.ws + WS_Q), D, nullptr, 0, 0, 1.f};
        pg8::gemm_phase<pg8::EpiBf16<0>, pg8::StaticOrder, PG8_ALIGN, PG8_SP2>(lds + RING_OFF, g, S, E);
    }
    SEAM(7);
    if (PHON(9) && IN(8)) { phase_s(args, lds, tid, lane, wave, bid, G); }
    SEAM(8);
    if (PHON(10) && IN(9)) { phase_pu(args, lane, wave, bid, G); }
    SEAM(9);
    if (PHON(11) && IN(10)) { phase_w(args, lane, wave, bid, G); }
    SEAM(10);
    if (PHON(12) && IN(11)) { phase_pv(args, lane, wave, bid, G); }
    SEAM(11);
    if (PHON(13) && IN(12)) { phase_f(args, lane, wave, bid, G); }
#undef IN
#undef SEAM
}

extern "C" void kernel_launch(void* const* d_in, const int* in_sizes, int n_in, void* d_out, int out_size, void* d_ws, size_t ws_size, hipStream_t stream) {
    static int grid = 0;
    if (grid == 0) {
        if (n_in != 25 || in_sizes[0] != T * D || out_size != T * D || ws_size < WS_END) {
            fprintf(stderr, "kernel_launch: built for 25 inputs, x/out of %d floats, >= %zu bytes of workspace; got n_in %d, in0 %d, out %d, ws %zu; nothing launched\n", T * D, (size_t)WS_END, n_in, n_in > 0 ? in_sizes[0] : -1, out_size, ws_size);
            grid = -1; return; }
        int dev = 0, cus = 0, per_cu = 0;
        if (hipGetDevice(&dev) != hipSuccess || hipDeviceGetAttribute(&cus, hipDeviceAttributeMultiprocessorCount, dev) != hipSuccess) { fprintf(stderr, "kernel_launch: device query failed\n"); grid = -1; return; }
        if (hipFuncSetAttribute((const void*)fwd_kernel, hipFuncAttributeMaxDynamicSharedMemorySize, LDS_BYTES) != hipSuccess) { fprintf(stderr, "kernel_launch: hipFuncSetAttribute failed\n"); grid = -1; return; }
        if (hipOccupancyMaxActiveBlocksPerMultiprocessor(&per_cu, (const void*)fwd_kernel, NTHR, LDS_BYTES) != hipSuccess || per_cu < 1)
            fprintf(stderr, "kernel_launch: note: occupancy query reports %d workgroups per CU\n", per_cu);
        (void)hipGetLastError();
        grid = cus;
    }
    if (grid < 0) return;
    if (hipMemsetAsync((char*)d_ws + WS_CTL, 0, CTL_ZERO_BYTES, stream) != hipSuccess) { fprintf(stderr, "kernel_launch: memset failed\n"); return; }
    Args a{};
    for (int i = 0; i < 25; ++i) a.in[i] = (const float*)d_in[i];
    a.out = (float*)d_out; a.ws = (unsigned char*)d_ws;
#if defined(MK_TIME_REP)
    const int cuts[3][2] = {{0, MK_TIME_REP + 1}, {MK_TIME_REP, MK_TIME_REP + 1}, {MK_TIME_REP + 1, N_PHASES}};
    for (int li = 0; li < 3; ++li) {
        a.ph_lo = cuts[li][0]; a.ph_hi = cuts[li][1]; a.li = li;
        if (a.ph_lo < a.ph_hi) hipLaunchKernelGGL(fwd_kernel, dim3(grid), dim3(NTHR), LDS_BYTES, stream, a);
    }
#else
    for (int li = 0; li < MK_N_LAUNCHES; ++li) {
        if (MK_N_LAUNCHES == 1) { a.ph_lo = 0; a.ph_hi = N_PHASES; } else { a.ph_lo = li; a.ph_hi = li + 1; }
        a.li = 0;
        hipLaunchKernelGGL(fwd_kernel, dim3(grid), dim3(NTHR), LDS_BYTES, stream, a);
        const hipError_t le = hipPeekAtLastError();
        if (le != hipSuccess) { fprintf(stderr, "kernel_launch: launch %d failed: %s\n", li, hipGetErrorName(le)); break; }
#if defined(MK_CHECKS)
        { const int chk_of_phase[N_PHASES] = {0, 1, 2, 12, 6, 7, 8, 9, 10, 5, 5, 5, 11}; hipLaunchKernelGGL(chk_kernel, dim3(4), dim3(128), 0, stream, a, chk_of_phase[li]); }
#endif
    }
#endif
#if defined(MK_CHECKS)
    hipLaunchKernelGGL(chk_encode, dim3(1), dim3(64), 0, stream, a, MK_CHECKS);
#endif
}
```
